# Optimizing an MI355X kernel written in HIP

```python
import math
import jax, jax.numpy as jnp
from jax import lax
import numpy as np

D_MODEL = 1024
BATCH = 8
SEQ = 2048
DEPTH = 1

MEM_LEN = 256
RET_HEADS = 4
RET_DK = 256
RET_DV = 512
RET_CHUNK = 128
ROPE_BASE = 10000.0
DIFF_HEADS = 8
DIFF_D = 64
Q_BLOCK = 128
MEM_HEADS = 4
MEM_D = 256
D_FF = 2816
FFN_RES = 0.5
EPS = 1e-6
NEG = -1e30
N_BRANCH = 3

RET_QK_W = RET_HEADS * RET_DK
RET_V_W = RET_HEADS * RET_DV
DIFF_QK_W = DIFF_HEADS * 2 * DIFF_D
DIFF_V_W = DIFF_HEADS * 2 * DIFF_D
MEM_Q_W = MEM_HEADS * MEM_D
IN_SPLITS = (RET_QK_W, RET_QK_W, RET_V_W, RET_V_W, DIFF_QK_W, DIFF_QK_W, DIFF_V_W, MEM_Q_W, N_BRANCH * D_MODEL)
IN_WIDTH = sum(IN_SPLITS)

kernel_name = "hybrid_retention_diffattn_memory_macaron"


def rms_norm(x, g=None):
    xf = x.astype(jnp.float32)
    y = xf * lax.rsqrt(jnp.mean(xf * xf, axis=-1, keepdims=True) + EPS)
    if g is not None:
        y = y * g.astype(jnp.float32)
    return y.astype(x.dtype)


def swiglu_ffn(h, w_in, w_out):
    gate, up = jnp.split(h @ w_in, 2, axis=-1)
    return (jax.nn.silu(gate) * up) @ w_out


def rotary(x, positions):
    half = x.shape[-1] // 2
    inv = ROPE_BASE ** (-jnp.arange(half, dtype=jnp.float32) / half)
    ang = positions.astype(jnp.float32)[..., None] * inv
    cos = jnp.cos(ang)[:, :, None, :]
    sin = jnp.sin(ang)[:, :, None, :]
    x1, x2 = x[..., :half], x[..., half:]
    return jnp.concatenate([x1 * cos - x2 * sin, x1 * sin + x2 * cos], axis=-1)


def retention(q, k, v, positions):
    B, S, H, dk = q.shape
    dv = v.shape[-1]
    C = RET_CHUNK
    n = S // C
    q = rotary(q.astype(jnp.float32), positions)
    k = rotary(k.astype(jnp.float32), positions) * (dk ** -0.5)
    v = v.astype(jnp.float32)

    def chunks(t):
        return t.reshape(B, n, C, H, t.shape[-1]).transpose(1, 0, 3, 2, 4)

    log_g = jnp.log1p(-(2.0 ** (-5.0 - jnp.arange(H, dtype=jnp.float32))))
    idx = jnp.arange(C, dtype=jnp.float32)
    dist = idx[:, None] - idx[None, :]
    intra_decay = jnp.where(dist >= 0, jnp.exp(log_g[:, None, None] * jnp.maximum(dist, 0.0)), 0.0)
    q_decay = jnp.exp(log_g[:, None] * (idx + 1.0))[:, :, None]
    k_decay = jnp.exp(log_g[:, None] * (C - 1.0 - idx))[:, :, None]
    chunk_decay = jnp.exp(log_g * C)[:, None, None]

    def step(state, qkv):
        qc, kc, vc = qkv
        scores = jnp.einsum('bhid,bhjd->bhij', qc, kc) * intra_decay
        out = (jnp.einsum('bhij,bhje->bhie', scores, vc)
               + jnp.einsum('bhid,bhde->bhie', qc * q_decay, state))
        state = chunk_decay * state + jnp.einsum('bhjd,bhje->bhde', kc * k_decay, vc)
        return state, out

    state0 = jnp.zeros((B, H, dk, dv), jnp.float32)
    _, out = lax.scan(step, state0, (chunks(q), chunks(k), chunks(v)))
    return out.transpose(1, 0, 3, 2, 4).reshape(B, S, H, dv)


def diff_attention(q, k, v, lam):
    B, S, H, _, d = q.shape
    nb = S // Q_BLOCK
    kh = k.transpose(0, 2, 3, 1, 4)
    vh = v.transpose(0, 2, 1, 3)
    qb = q.transpose(0, 2, 3, 1, 4).reshape(B, H, 2, nb, Q_BLOCK, d).transpose(3, 0, 1, 2, 4, 5)
    starts = jnp.arange(nb) * Q_BLOCK
    kpos = jnp.arange(S)
    scale = d ** -0.5

    def block(args):
        qblk, start = args
        s = jnp.einsum('bhcqd,bhckd->bhcqk', qblk, kh).astype(jnp.float32) * scale
        qpos = start + jnp.arange(Q_BLOCK)
        s = jnp.where(kpos[None, :] <= qpos[:, None], s, NEG)
        p = jax.nn.softmax(s, axis=-1)
        a = p[:, :, 0] - lam * p[:, :, 1]
        return jnp.einsum('bhqk,bhke->bhqe', a.astype(vh.dtype), vh)

    out = lax.map(block, (qb, starts))
    return out.transpose(1, 0, 3, 2, 4).reshape(B, S, H, 2 * d)


def memory_attention(q, k, v):
    s = jnp.einsum('bshd,bmhd->bhsm', q, k).astype(jnp.float32) * (q.shape[-1] ** -0.5)
    p = jax.nn.softmax(s, axis=-1)
    return jnp.einsum('bhsm,bmhd->bshd', p.astype(v.dtype), v)


def setup_inputs(seed: int = 0) -> dict:
    key = jax.random.key(seed)
    ks = jax.random.split(key, 32)
    f32 = jnp.float32

    def normal(k, shape, scale):
        return jax.random.normal(k, shape, f32) * scale

    def gain(k, shape):
        return 1.0 + 0.02 * jax.random.normal(k, shape, f32)

    L = DEPTH
    start = jax.random.randint(ks[2], (BATCH, 1), 0, 1024)
    positions = (start + jnp.arange(SEQ)[None, :]).astype(jnp.int32)
    return {
        "x": normal(ks[0], (BATCH, SEQ, D_MODEL), 1.0),
        "mem": normal(ks[1], (BATCH, MEM_LEN, D_MODEL), 1.0),
        "positions": positions,
        "g_ffn1": gain(ks[3], (L, D_MODEL)),
        "w_ffn1_in": normal(ks[4], (L, D_MODEL, 2 * D_FF), D_MODEL ** -0.5),
        "w_ffn1_out": normal(ks[5], (L, D_FF, D_MODEL), D_FF ** -0.5),
        "g_mix": gain(ks[6], (L, D_MODEL)),
        "w_in": normal(ks[7], (L, D_MODEL, IN_WIDTH), D_MODEL ** -0.5),
        "g_diff_q": gain(ks[8], (L, DIFF_D)),
        "g_diff_k": gain(ks[9], (L, DIFF_D)),
        "lam_q1": normal(ks[10], (L, DIFF_D), 0.1),
        "lam_k1": normal(ks[11], (L, DIFF_D), 0.1),
        "lam_q2": normal(ks[12], (L, DIFF_D), 0.1),
        "lam_k2": normal(ks[13], (L, DIFF_D), 0.1),
        "g_diff_out": gain(ks[14], (L, 2 * DIFF_D)),
        "g_mem_q": gain(ks[15], (L, MEM_D)),
        "g_mem_k": gain(ks[16], (L, MEM_D)),
        "g_mem": gain(ks[17], (L, D_MODEL)),
        "w_mem_kv": normal(ks[18], (L, D_MODEL, 2 * MEM_Q_W), D_MODEL ** -0.5),
        "w_br_ret": normal(ks[19], (L, RET_V_W, D_MODEL), RET_V_W ** -0.5),
        "w_br_diff": normal(ks[20], (L, DIFF_V_W, D_MODEL), DIFF_V_W ** -0.5),
        "w_br_mem": normal(ks[21], (L, MEM_Q_W, D_MODEL), MEM_Q_W ** -0.5),
        "w_o": normal(ks[22], (L, D_MODEL, D_MODEL), D_MODEL ** -0.5),
        "g_ffn2": gain(ks[23], (L, D_MODEL)),
        "w_ffn2_in": normal(ks[24], (L, D_MODEL, 2 * D_FF), D_MODEL ** -0.5),
        "w_ffn2_out": normal(ks[25], (L, D_FF, D_MODEL), D_FF ** -0.5),
    }


def reference(x, mem, positions, g_ffn1, w_ffn1_in, w_ffn1_out, g_mix, w_in,
              g_diff_q, g_diff_k, lam_q1, lam_k1, lam_q2, lam_k2, g_diff_out,
              g_mem_q, g_mem_k, g_mem, w_mem_kv, w_br_ret, w_br_diff, w_br_mem,
              w_o, g_ffn2, w_ffn2_in, w_ffn2_out):
    B, S, _ = x.shape
    M = mem.shape[1]
    offsets = np.cumsum(IN_SPLITS)[:-1].tolist()
    for l in range(DEPTH):
        lam_init = 0.8 - 0.6 * math.exp(-0.3 * l)

        x = x + FFN_RES * swiglu_ffn(rms_norm(x, g_ffn1[l]), w_ffn1_in[l], w_ffn1_out[l])

        h = rms_norm(x, g_mix[l])
        rq, rk, rv, rg, dq, dk, dv, mq, gates = jnp.split(h @ w_in[l], offsets, axis=-1)

        ret = retention(rq.reshape(B, S, RET_HEADS, RET_DK), rk.reshape(B, S, RET_HEADS, RET_DK),
                        rv.reshape(B, S, RET_HEADS, RET_DV), positions)
        ret = rms_norm(ret) * jax.nn.silu(rg.reshape(B, S, RET_HEADS, RET_DV).astype(jnp.float32))
        ret = ret.reshape(B, S, RET_V_W).astype(x.dtype)

        lam = (jnp.exp(jnp.sum(lam_q1[l].astype(jnp.float32) * lam_k1[l].astype(jnp.float32)))
               - jnp.exp(jnp.sum(lam_q2[l].astype(jnp.float32) * lam_k2[l].astype(jnp.float32)))
               + lam_init)
        dqn = rms_norm(dq.reshape(B, S, DIFF_HEADS, 2, DIFF_D), g_diff_q[l])
        dkn = rms_norm(dk.reshape(B, S, DIFF_HEADS, 2, DIFF_D), g_diff_k[l])
        dif = diff_attention(dqn, dkn, dv.reshape(B, S, DIFF_HEADS, 2 * DIFF_D), lam)
        dif = (rms_norm(dif, g_diff_out[l]) * (1.0 - lam_init)).reshape(B, S, DIFF_V_W)

        mk, mv = jnp.split(rms_norm(mem, g_mem[l]) @ w_mem_kv[l], 2, axis=-1)
        mo = memory_attention(rms_norm(mq.reshape(B, S, MEM_HEADS, MEM_D), g_mem_q[l]),
                              rms_norm(mk.reshape(B, M, MEM_HEADS, MEM_D), g_mem_k[l]),
                              mv.reshape(B, M, MEM_HEADS, MEM_D)).reshape(B, S, MEM_Q_W)

        gt = jax.nn.sigmoid(gates.reshape(B, S, N_BRANCH, D_MODEL))
        y = (gt[:, :, 0] * (ret @ w_br_ret[l])
             + gt[:, :, 1] * (dif @ w_br_diff[l])
             + gt[:, :, 2] * (mo @ w_br_mem[l]))
        x = x + y @ w_o[l]

        x = x + FFN_RES * swiglu_ffn(rms_norm(x, g_ffn2[l]), w_ffn2_in[l], w_ffn2_out[l])
    return x
```

```cpp
#include <hip/hip_runtime.h>
#include <cstdio>
#include <cstdint>

#define LAS __attribute__((address_space(3)))
#define GAS __attribute__((address_space(1)))
typedef unsigned short bf16_t;
typedef short bf16x8 __attribute__((ext_vector_type(8)));
typedef float f32x4 __attribute__((ext_vector_type(4)));
typedef float f32x2 __attribute__((ext_vector_type(2)));
typedef unsigned u32x4 __attribute__((ext_vector_type(4)));
typedef unsigned u32x2 __attribute__((ext_vector_type(2)));

constexpr int NB = 8, SEQ = 2048, DM = 1024, TOK = NB * SEQ, MEML = 256, DFF = 2816;
constexpr int NMIX = 8192;
constexpr float EPS = 1e-6f;
constexpr float LOG2E = 1.4426950408889634f;
constexpr float C2Q = 0.125f * LOG2E;
constexpr float LAM_INIT = 0.2f;

constexpr size_t MiB = 1u << 20;
constexpr size_t WS_CTL = 0, CTL_ZERO_BYTES = 1 * MiB;
constexpr size_t WS_SSQ1 = 1 * MiB, WS_SSQ2 = 2 * MiB;
constexpr size_t WS_MKN = 3 * MiB, WS_MVT = 7 * MiB;
constexpr size_t WS_WMIX = 11 * MiB;
constexpr size_t WS_XB = 27 * MiB;
constexpr size_t WS_RET = 59 * MiB;
constexpr size_t WS_DIF = 123 * MiB;
constexpr size_t WS_MO = 155 * MiB;
constexpr size_t WS_Q = 187 * MiB, WS_K = 191 * MiB, WS_KTS = 195 * MiB, WS_VT = 199 * MiB, WS_DQ = 207 * MiB, WS_DK = 211 * MiB,
                 WS_DV = 215 * MiB, WS_MQ = 219 * MiB, WS_O0 = 223 * MiB, WS_O1 = 227 * MiB, WS_S = 231 * MiB;
constexpr size_t WS_ROT = 247 * MiB;
constexpr size_t WS_WRG = 249 * MiB;
constexpr size_t WS_ACT = 59 * MiB;
constexpr size_t WS_WF1I = 147 * MiB, WS_WF1O = 158 * MiB;
constexpr size_t WS_MEMN = 164 * MiB, WS_MKVRAW = 168 * MiB, WS_WMKV = 176 * MiB;
constexpr size_t WS_WGATE = 11 * MiB, WS_WBRR = 17 * MiB, WS_WBRD = 21 * MiB, WS_WBRM = 23 * MiB, WS_WO = 25 * MiB;
constexpr size_t WS_Y = 187 * MiB, WS_STASH = 219 * MiB;
constexpr size_t WS_WF2I = 59 * MiB, WS_WF2O = 70 * MiB, WS_ACT2 = 76 * MiB;
constexpr size_t WS_END = 256 * MiB;

constexpr int CW_BAR = 4096;

constexpr int RING_BYTES = 131072, LDSCTL_OFF = RING_BYTES, MISC_OFF = LDSCTL_OFF + 320, LDS_BYTES = 147456;
constexpr int NWAVES = 8;

__device__ __forceinline__ unsigned cvt_pk_bf16(float lo, float hi) { unsigned r; asm volatile("v_cvt_pk_bf16_f32 %0, %1, %2" : "=v"(r) : "v"(lo), "v"(hi)); return r; }
__device__ __forceinline__ u32x2 pack4(f32x4 v) { u32x2 w; w.x = cvt_pk_bf16(v[0], v[1]); w.y = cvt_pk_bf16(v[2], v[3]); return w; }
__device__ __forceinline__ unsigned short bf16_1(float v) { return (unsigned short)(cvt_pk_bf16(v, 0.f) & 0xffffu); }
__device__ __forceinline__ float bf2f(unsigned short b) { return __uint_as_float(((unsigned)b) << 16); }
__device__ __forceinline__ float siluf(float x) { return x * __builtin_amdgcn_rcpf(1.0f + __builtin_amdgcn_exp2f(-x * LOG2E)); }
__device__ __forceinline__ float sigmf(float x) { return __builtin_amdgcn_rcpf(1.0f + __builtin_amdgcn_exp2f(-x * LOG2E)); }
__device__ __forceinline__ float row_rs(const float* ssq, int row) {
    const f32x4* p = (const f32x4*)(ssq + (size_t)row * 16);
    const f32x4 a = p[0], b = p[1], c = p[2], d = p[3];
    const float s = (((a[0] + a[1]) + (a[2] + a[3])) + ((b[0] + b[1]) + (b[2] + b[3]))) + (((c[0] + c[1]) + (c[2] + c[3])) + ((d[0] + d[1]) + (d[2] + d[3])));
    return __builtin_amdgcn_rsqf(s * (1.0f / 1024.0f) + EPS);
}
__device__ __forceinline__ int opaque_tid() { int t = threadIdx.x; asm volatile("" : "+v"(t)); return t; }
__device__ __forceinline__ f32x4 mfma16(bf16x8 a, bf16x8 b, f32x4 c) { return __builtin_amdgcn_mfma_f32_16x16x32_bf16(a, b, c, 0, 0, 0); }

namespace pg8 {
constexpr int BM = 256, BK = 64, HALF = 128, HTB = HALF * BK * 2, STAGE_BYTES = 8 * HTB, NXCD = 8, WGM = 8;
__host__ __device__ __forceinline__ int lds_byte(int r, int c) { const int st = (r >> 4) * 2 + (c >> 5), rr = r & 15, cc = c & 31, ob = rr * 64 + cc * 2; return st * 1024 + (ob ^ (((ob >> 9) & 1) << 5)); }
__host__ __device__ __forceinline__ void stage_rc(int b, int& R, int& C) { const int st = b / 1024, sb = b % 1024, swz = sb ^ (((sb >> 9) & 1) << 5); R = (st >> 1) * 16 + swz / 64; C = (st & 1) * 32 + (swz % 64) / 2; }
struct Unit { int pm, pn, ui; };
struct Gemm { const bf16_t* A; const bf16_t* Bt; int M, N, K; };
struct StaticOrder {
    int nM, nN, nwg, G, c;
    __host__ __device__ void init(int M, int N, int G_, int c_) { nM = M / BM; nN = N / BM; nwg = nM * nN; G = G_; c = c_; }
    __host__ __device__ bool next(int i, Unit& u) const {
        const long L = (long)i * G + c; if (L >= nwg) return false;
        int wgid = (int)L; { const int q = nwg / NXCD, r = nwg % NXCD, xcd = wgid % NXCD, off = wgid / NXCD; wgid = (xcd < r ? xcd * (q + 1) : r * (q + 1) + (xcd - r) * q) + off; }
        const int nig = WGM * nN, gid = wgid / nig, fm = gid * WGM, gsz = (nM - fm) < WGM ? (nM - fm) : WGM;
        u.pm = fm + ((wgid % nig) % gsz); u.pn = (wgid % nig) / gsz; u.ui = i; return true;
    }
};
template <class Epi>
__device__ __forceinline__ void gemm_phase(LAS unsigned char* lds, const Gemm g, const StaticOrder& S, const Epi& E) {
    const int tid = opaque_tid(), wid = __builtin_amdgcn_readfirstlane(tid >> 6), lane = tid & 63, wr = wid >> 2, wc = wid & 3, fr = lane & 15, fq = lane >> 4;
    const int K = g.K, nt = K / BK;
    unsigned voffA[2];
#pragma unroll
    for (int i = 0; i < 2; ++i) { int R, C; stage_rc(tid * 16 + i * 8192, R, C); voffA[i] = (unsigned)(R * K + C) * 2u; }
    const size_t kstep = (size_t)(BK * 2);
    const size_t hstep = (size_t)HALF * K * 2;
    const size_t tstep = 2 * hstep;
    const unsigned ldsw = (unsigned)wid * 1024u;
    const int aoff = lds_byte(wr * 64 + fr, fq * 8), boff = lds_byte(wc * 32 + fr, fq * 8);
#define PG8_SA(b, h) (((b) * 2 + (h)) * HTB)
#define PG8_SB(b, h) ((4 + (b) * 2 + (h)) * HTB)
#define PG8_STAGE(bufoff, gbase, voff) do { _Pragma("unroll") for (int _i = 0; _i < 2; ++_i) \
        __builtin_amdgcn_global_load_lds((const unsigned*)((const char*)(gbase) + (voff)[_i]), (LAS unsigned*)(lds + (bufoff) + ldsw + _i * 8192), 16, 0, 0); } while (0)
#define PG8_LDA(dst, b, h) do { _Pragma("unroll") for (int m = 0; m < 4; ++m) _Pragma("unroll") for (int k = 0; k < 2; ++k) dst[m][k] = *(const LAS bf16x8*)(lds + PG8_SA(b, h) + aoff + m * 2048 + k * 1024); } while (0)
#define PG8_LDB(dst, b, h) do { _Pragma("unroll") for (int n = 0; n < 2; ++n) _Pragma("unroll") for (int k = 0; k < 2; ++k) dst[n][k] = *(const LAS bf16x8*)(lds + PG8_SB(b, h) + boff + n * 2048 + k * 1024); } while (0)
#define PG8_MMA(ai, bj, At, Bt) do { __builtin_amdgcn_s_setprio(1); _Pragma("unroll") for (int m = 0; m < 4; ++m) _Pragma("unroll") for (int n = 0; n < 2; ++n) _Pragma("unroll") for (int k = 0; k < 2; ++k) \
        acc[ai][bj][m][n] = __builtin_amdgcn_mfma_f32_16x16x32_bf16(Bt[n][k], At[m][k], acc[ai][bj][m][n], 0, 0, 0); __builtin_amdgcn_s_setprio(0); } while (0)
#define PG8_WAIT_V(n) asm volatile("s_waitcnt vmcnt(" #n ")" ::: "memory")
#define PG8_WAIT_L(n) asm volatile("s_waitcnt lgkmcnt(" #n ")" ::: "memory")
#define PG8_BAR __builtin_amdgcn_s_barrier()
#define PG8_SCHED __builtin_amdgcn_sched_barrier(0)
    Unit cur, nxt; int ui = 0;
    if (!S.next(0, cur)) return;
    f32x4 acc[2][2][4][2];
#pragma unroll
    for (int a = 0; a < 2; ++a)
#pragma unroll
        for (int b = 0; b < 2; ++b)
#pragma unroll
            for (int m = 0; m < 4; ++m)
#pragma unroll
                for (int n = 0; n < 2; ++n) acc[a][b][m][n] = (f32x4){0.f, 0.f, 0.f, 0.f};
    bf16x8 At[4][2], B0[2][2], B1[2][2];
    const char* cA = (const char*)g.A + (size_t)cur.pm * tstep; const char* cB = (const char*)g.Bt + (size_t)cur.pn * tstep;
    PG8_STAGE(PG8_SB(0, 0), cB, voffA); PG8_STAGE(PG8_SB(0, 1), cB + hstep, voffA); PG8_STAGE(PG8_SA(0, 0), cA, voffA); PG8_STAGE(PG8_SA(0, 1), cA + hstep, voffA);
    if (wr == 1) PG8_BAR;
    PG8_WAIT_V(2); PG8_BAR;
    PG8_STAGE(PG8_SB(1, 0), cB + kstep, voffA); PG8_STAGE(PG8_SA(1, 0), cA + kstep, voffA); PG8_STAGE(PG8_SB(1, 1), cB + hstep + kstep, voffA);
    PG8_WAIT_V(6); PG8_BAR;
    for (;;) {
        const bool has_next = S.next(ui + 1, nxt);
        const char* nA = has_next ? (const char*)g.A + (size_t)nxt.pm * tstep : cA; const char* nB = has_next ? (const char*)g.Bt + (size_t)nxt.pn * tstep : cB;
        for (int t = 0; t < nt; t += 2) {
            const bool last = (t == nt - 2);
            const char* a1 = cA + (size_t)(t + 1) * kstep;
            const char* a2 = last ? nA : cA + (size_t)(t + 2) * kstep; const char* b2 = last ? nB : cB + (size_t)(t + 2) * kstep;
            const char* a3 = a2 + kstep; const char* b3 = b2 + kstep;
            PG8_LDB(B0, 0, 0); PG8_LDB(B1, 0, 1); PG8_SCHED; PG8_LDA(At, 0, 0); PG8_STAGE(PG8_SA(1, 1), a1 + hstep, voffA);
            PG8_WAIT_V(8); PG8_WAIT_L(0); PG8_BAR; PG8_MMA(0, 0, At, B0); PG8_MMA(0, 1, At, B1); PG8_BAR; PG8_SCHED;
            PG8_LDA(At, 0, 1); PG8_STAGE(PG8_SB(0, 0), b2, voffA); PG8_STAGE(PG8_SB(0, 1), b2 + hstep, voffA); PG8_STAGE(PG8_SA(0, 0), a2, voffA);
            PG8_WAIT_V(8); PG8_WAIT_L(0); PG8_BAR; PG8_MMA(1, 0, At, B0); PG8_MMA(1, 1, At, B1); PG8_BAR; PG8_SCHED;
            PG8_LDB(B0, 1, 0); PG8_LDB(B1, 1, 1); PG8_SCHED; PG8_LDA(At, 1, 0); PG8_STAGE(PG8_SA(0, 1), a2 + hstep, voffA);
            PG8_WAIT_V(8); PG8_WAIT_L(0); PG8_BAR; PG8_MMA(0, 0, At, B0); PG8_MMA(0, 1, At, B1); PG8_BAR; PG8_SCHED;
            PG8_LDA(At, 1, 1); PG8_STAGE(PG8_SB(1, 0), b3, voffA); PG8_STAGE(PG8_SB(1, 1), b3 + hstep, voffA); PG8_STAGE(PG8_SA(1, 0), a3, voffA);
            PG8_WAIT_V(8); PG8_WAIT_L(0); PG8_BAR; PG8_MMA(1, 0, At, B0); PG8_MMA(1, 1, At, B1); PG8_BAR; PG8_SCHED;
        }
        if (wr == 0) PG8_BAR;
        { int fr2 = fr, fq2 = fq; asm volatile("" : "+v"(fr2), "+v"(fq2)); E(acc, cur, wr, wc, fr2, fq2); }
        if (!has_next) break;
#pragma unroll
        for (int a = 0; a < 2; ++a)
#pragma unroll
            for (int b = 0; b < 2; ++b)
#pragma unroll
                for (int m = 0; m < 4; ++m)
#pragma unroll
                    for (int n = 0; n < 2; ++n) acc[a][b][m][n] = (f32x4){0.f, 0.f, 0.f, 0.f};
        cur = nxt; cA = nA; cB = nB; ++ui;
        if (wr == 1) PG8_BAR;
    }
    PG8_WAIT_V(0);
    PG8_BAR;
#undef PG8_SA
#undef PG8_SB
#undef PG8_STAGE
#undef PG8_LDA
#undef PG8_LDB
#undef PG8_MMA
#undef PG8_WAIT_V
#undef PG8_WAIT_L
#undef PG8_BAR
#undef PG8_SCHED
}
}

#define ACC_ARG const f32x4 (&acc)[2][2][4][2]
#define EPI_FENCE() asm volatile("" ::: "memory")
constexpr int RTAB_OFF = RING_BYTES + 1024;
__device__ __forceinline__ void prep_rs(const float* ssq, int row_off, const pg8::StaticOrder& S, LAS unsigned char* lds) {
    const int tid = opaque_tid(); LAS float* rtab = (LAS float*)(lds + RTAB_OFF); pg8::Unit u;
    for (int i = 0; i < 6 && S.next(i, u); ++i) if (tid < 256) rtab[i * 256 + tid] = row_rs(ssq, row_off + u.pm * 256 + tid);
    __syncthreads();
}
struct EpiSwiglu {
    bf16_t* O; const LAS float* rtab;
    __device__ __forceinline__ void operator()(ACC_ARG, const pg8::Unit& u, int wr, int wc, int fr, int fq) const {
        const int lr0 = wr * 64 + fr, col0 = u.pn * 128 + wc * 32 + 4 * fq;
#pragma unroll
        for (int ai = 0; ai < 2; ++ai)
#pragma unroll
            for (int m = 0; m < 4; ++m) {
                const int lr = lr0 + ai * 128 + m * 16;
                const float rs = rtab ? rtab[u.ui * 256 + lr] : 1.0f;
#pragma unroll
                for (int n = 0; n < 2; ++n) {
                    const f32x4 gt = acc[ai][0][m][n] * rs, up = acc[ai][1][m][n] * rs; f32x4 v;
#pragma unroll
                    for (int j = 0; j < 4; ++j) v[j] = siluf(gt[j]) * up[j];
                    *(u32x2*)(O + (size_t)(u.pm * 256 + lr) * DFF + col0 + n * 16) = pack4(v);
                }
            }
    }
};
struct EpiResid {
    const float* base; float* out; bf16_t* xb; float* ssq; float scale;
    __device__ __forceinline__ void operator()(ACC_ARG, const pg8::Unit& u, int wr, int wc, int fr, int fq) const {
        const int row0 = u.pm * 256 + wr * 64 + fr, col0 = u.pn * 256 + wc * 32 + 4 * fq;
#pragma unroll
        for (int ai = 0; ai < 2; ++ai)
#pragma unroll
            for (int m = 0; m < 4; ++m) {
                const int row = row0 + ai * 128 + m * 16; float ss = 0.f;
#pragma unroll
                for (int bj = 0; bj < 2; ++bj)
#pragma unroll
                    for (int n = 0; n < 2; ++n) {
                        const size_t off = (size_t)row * DM + col0 + bj * 128 + n * 16;
                        const f32x4 v = *(const f32x4*)(base + off) + acc[ai][bj][m][n] * scale;
                        *(f32x4*)(out + off) = v;
                        if (xb) *(u32x2*)(xb + off) = pack4(v);
                        ss += (v[0] * v[0] + v[1] * v[1]) + (v[2] * v[2] + v[3] * v[3]);
                    }
                if (ssq) { ss += __shfl_xor(ss, 16); ss += __shfl_xor(ss, 32); if (fq == 0) ssq[(size_t)row * 16 + u.pn * 4 + wc] = ss; }
            }
    }
};
struct EpiPlain {
    bf16_t* O; int ldo;
    __device__ __forceinline__ void operator()(ACC_ARG, const pg8::Unit& u, int wr, int wc, int fr, int fq) const {
        const int row0 = u.pm * 256 + wr * 64 + fr, col0 = u.pn * 256 + wc * 32 + 4 * fq;
#pragma unroll
        for (int ai = 0; ai < 2; ++ai)
#pragma unroll
            for (int m = 0; m < 4; ++m)
#pragma unroll
                for (int bj = 0; bj < 2; ++bj)
#pragma unroll
                    for (int n = 0; n < 2; ++n) *(u32x2*)(O + (size_t)(row0 + ai * 128 + m * 16) * ldo + col0 + bj * 128 + n * 16) = pack4(acc[ai][bj][m][n]);
    }
};
struct EpiMix {
    const LAS float* rtab; const float* rot;
    unsigned char* ws; const float *gdq, *gdk;
    __device__ __forceinline__ void operator()(ACC_ARG, const pg8::Unit& u, int wr, int wc, int fr, int fq) const {
        const int pn = u.pn, lr0 = wr * 64 + fr, lrow0 = u.pm * 256 + lr0;
        if (pn < 8) {
            const bool isk = pn >= 4; const int h = pn & 3; bf16_t* dst = (bf16_t*)(ws + (isk ? WS_K : WS_Q)); bf16_t* kts = (bf16_t*)(ws + WS_KTS);
            const float lg2 = log2f(1.0f - __builtin_amdgcn_exp2f(-5.0f - (float)h));
#pragma unroll
            for (int ai = 0; ai < 2; ++ai)
#pragma unroll
                for (int m = 0; m < 4; ++m) {
                    int lrow = lrow0 + ai * 128 + m * 16; asm volatile("" : "+v"(lrow));
                    const float rs = rtab[u.ui * 256 + lr0 + ai * 128 + m * 16] * (isk ? 0.0625f : 1.0f);
                    const float dec = __builtin_amdgcn_exp2f(lg2 * (float)(127 - (lrow & 127)));
#pragma unroll
                    for (int n = 0; n < 2; ++n) {
                        const int i0 = wc * 32 + n * 16 + 4 * fq;
                        const f32x4* cs = (const f32x4*)(rot + ((size_t)lrow * 128 + i0) * 2);
                        const f32x4 c01 = cs[0], c23 = cs[1];
                        const f32x4 cv = (f32x4){c01[0], c01[2], c23[0], c23[2]}, sv = (f32x4){c01[1], c01[3], c23[1], c23[3]};
                        const f32x4 x1 = acc[ai][0][m][n] * rs, x2 = acc[ai][1][m][n] * rs;
                        const f32x4 o1 = x1 * cv - x2 * sv, o2 = x1 * sv + x2 * cv;
                        *(u32x2*)(dst + (size_t)lrow * 1024 + h * 256 + i0) = pack4(o1);
                        *(u32x2*)(dst + (size_t)lrow * 1024 + h * 256 + 128 + i0) = pack4(o2);
                        if (isk) {
#pragma unroll
                            for (int j = 0; j < 4; ++j) {
                                kts[(size_t)(h * 256 + i0 + j) * SEQ + lrow] = bf16_1(o1[j] * dec);
                                kts[(size_t)(h * 256 + 128 + i0 + j) * SEQ + lrow] = bf16_1(o2[j] * dec);
                            }
                        }
                    }
                    EPI_FENCE();
                }
        } else if (pn < 16) {
            const int h = (pn - 8) >> 1, e0 = ((pn - 8) & 1) * 256; bf16_t* vt = (bf16_t*)(ws + WS_VT);
#pragma unroll
            for (int ai = 0; ai < 2; ++ai)
#pragma unroll
                for (int m = 0; m < 4; ++m) {
                    int lrow = lrow0 + ai * 128 + m * 16; asm volatile("" : "+v"(lrow));
                    const float rs = rtab[u.ui * 256 + lr0 + ai * 128 + m * 16];
#pragma unroll
                    for (int bj = 0; bj < 2; ++bj)
#pragma unroll
                        for (int n = 0; n < 2; ++n) {
                            const int ec = e0 + bj * 128 + wc * 32 + n * 16 + 4 * fq; const f32x4 v = acc[ai][bj][m][n] * rs;
#pragma unroll
                            for (int j = 0; j < 4; ++j) vt[(size_t)(h * 512 + ec + j) * SEQ + lrow] = bf16_1(v[j]);
                        }
                    EPI_FENCE();
                }
        } else if (pn < 24) {
            const bool isk = pn >= 20; const int tile = (pn - 16) & 3; bf16_t* dst = (bf16_t*)(ws + (isk ? WS_DK : WS_DQ)); const float* gn = isk ? gdk : gdq; const float mul = isk ? 1.0f : C2Q;
            f32x4 gv[2][2];
#pragma unroll
            for (int bj = 0; bj < 2; ++bj)
#pragma unroll
                for (int n = 0; n < 2; ++n) gv[bj][n] = *(const f32x4*)(gn + 32 * bj + 16 * n + 4 * fq);
#pragma unroll
            for (int ai = 0; ai < 2; ++ai)
#pragma unroll
                for (int m = 0; m < 4; ++m) {
                    int lrow = lrow0 + ai * 128 + m * 16; asm volatile("" : "+v"(lrow));
                    const float rs = rtab[u.ui * 256 + lr0 + ai * 128 + m * 16];
                    f32x4 v[2][2]; float ss = 0.f;
#pragma unroll
                    for (int bj = 0; bj < 2; ++bj)
#pragma unroll
                        for (int n = 0; n < 2; ++n) { v[bj][n] = acc[ai][bj][m][n] * rs; const f32x4 t = v[bj][n]; ss += (t[0] * t[0] + t[1] * t[1]) + (t[2] * t[2] + t[3] * t[3]); }
                    ss += __shfl_xor(ss, 16); ss += __shfl_xor(ss, 32);
                    const float rn = __builtin_amdgcn_rsqf(ss * (1.0f / 64.0f) + EPS) * mul;
#pragma unroll
                    for (int bj = 0; bj < 2; ++bj)
#pragma unroll
                        for (int n = 0; n < 2; ++n)
                            *(u32x2*)(dst + (size_t)lrow * 1024 + tile * 256 + 64 * wc + 32 * bj + 16 * n + 4 * fq) = pack4(v[bj][n] * rn * gv[bj][n]);
                    EPI_FENCE();
                }
        } else {
            bf16_t* dst = (bf16_t*)(ws + (pn < 28 ? WS_DV : WS_MQ)); const int tile = (pn - 24) & 3;
#pragma unroll
            for (int ai = 0; ai < 2; ++ai)
#pragma unroll
                for (int m = 0; m < 4; ++m) {
                    int lrow = lrow0 + ai * 128 + m * 16; asm volatile("" : "+v"(lrow));
                    const float rs = rtab[u.ui * 256 + lr0 + ai * 128 + m * 16];
#pragma unroll
                    for (int bj = 0; bj < 2; ++bj)
#pragma unroll
                        for (int n = 0; n < 2; ++n)
                            *(u32x2*)(dst + (size_t)lrow * 1024 + tile * 256 + bj * 128 + wc * 32 + n * 16 + 4 * fq) = pack4(acc[ai][bj][m][n] * rs);
                    EPI_FENCE();
                }
        }
    }
};
struct EpiRg {
    const LAS float* rtab; bf16_t* ret;
    __device__ __forceinline__ void operator()(ACC_ARG, const pg8::Unit& u, int wr, int wc, int fr, int fq) const {
        const int lr0 = wr * 64 + fr, col0 = u.pn * 256 + wc * 32 + 4 * fq;
#pragma unroll
        for (int ai = 0; ai < 2; ++ai)
#pragma unroll
            for (int m = 0; m < 4; ++m) {
                const int lr = lr0 + ai * 128 + m * 16; const float rs = rtab[u.ui * 256 + lr];
#pragma unroll
                for (int bj = 0; bj < 2; ++bj)
#pragma unroll
                    for (int n = 0; n < 2; ++n) {
                        u32x2* p = (u32x2*)(ret + (size_t)(u.pm * 256 + lr) * 2048 + col0 + bj * 128 + n * 16); const u32x2 w = *p; const f32x4 a = acc[ai][bj][m][n] * rs; f32x4 v;
                        v[0] = __uint_as_float(w.x << 16) * siluf(a[0]); v[1] = __uint_as_float(w.x & 0xffff0000u) * siluf(a[1]);
                        v[2] = __uint_as_float(w.y << 16) * siluf(a[2]); v[3] = __uint_as_float(w.y & 0xffff0000u) * siluf(a[3]);
                        *p = pack4(v);
                    }
                if (m & 1) EPI_FENCE();
            }
    }
};
struct EpiP5 {
    int kind; const LAS float* rtab; bf16_t* gbuf; bf16_t* y; int first;
    __device__ __forceinline__ void operator()(ACC_ARG, const pg8::Unit& u, int wr, int wc, int fr, int fq) const {
        const int lr0 = wr * 64 + fr, col0 = u.pn * 256 + wc * 32 + 4 * fq;
#pragma unroll
        for (int ai = 0; ai < 2; ++ai)
#pragma unroll
            for (int m = 0; m < 4; ++m) {
                const int lr = lr0 + ai * 128 + m * 16; const float rs = rtab[u.ui * 256 + lr];
#pragma unroll
                for (int bj = 0; bj < 2; ++bj)
#pragma unroll
                    for (int n = 0; n < 2; ++n) {
                        const size_t off = (size_t)(u.pm * 256 + lr) * DM + col0 + bj * 128 + n * 16;
                        const f32x4 a = acc[ai][bj][m][n]; f32x4 v;
                        if (kind == 0) {
#pragma unroll
                            for (int j = 0; j < 4; ++j) v[j] = sigmf(a[j] * rs);
                            *(u32x2*)(gbuf + off) = pack4(v);
                        } else {
                            const u32x2 gw = *(const u32x2*)(gbuf + off);
                            v[0] = __uint_as_float(gw.x << 16) * a[0]; v[1] = __uint_as_float(gw.x & 0xffff0000u) * a[1];
                            v[2] = __uint_as_float(gw.y << 16) * a[2]; v[3] = __uint_as_float(gw.y & 0xffff0000u) * a[3];
                            if (!first) { const u32x2 w = *(const u32x2*)(y + off); v[0] += __uint_as_float(w.x << 16); v[1] += __uint_as_float(w.x & 0xffff0000u); v[2] += __uint_as_float(w.y << 16); v[3] += __uint_as_float(w.y & 0xffff0000u); }
                            *(u32x2*)(y + off) = pack4(v);
                        }
                    }
                if (m & 1) EPI_FENCE();
            }
    }
};

#include <hip/hip_bf16.h>
namespace attn_body {
using bf16=__hip_bfloat16;
using bf16x8=__attribute__((ext_vector_type(8)))short;
using s16x4=__attribute__((ext_vector_type(4)))short;
using f32x16=__attribute__((ext_vector_type(16)))float;
using u32x4=__attribute__((ext_vector_type(4)))unsigned;
constexpr int D=64,DM=1024;
constexpr int NW=8,QBLK=32,QB=QBLK*NW,KVBLK=64;
__device__ __forceinline__ int crow(int r,int hi){return (r&3)+8*(r>>2)+4*hi;}
#define SBAR() __builtin_amdgcn_sched_barrier(0)
__device__ __forceinline__ void cmask(f32x16&p0,f32x16&p1,int jb,int qrel,int hi){
  const float NEG=-INFINITY; int kb=64*jb+4*hi;
  #pragma unroll
  for(int r=0;r<16;++r){int kv=kb+(r&3)+8*(r>>2); if(kv>qrel)p0[r]=NEG; if(kv+32>qrel)p1[r]=NEG;}
}
constexpr int NSLOT=3, SLOTB=8192;
constexpr int LDS_K=0, LDS_V=NSLOT*SLOTB, LDS_WS=2*NSLOT*SLOTB, LDS_OST=LDS_WS+NW*64*4, LDS_BYTES=LDS_OST+NW*4096;
__device__ __forceinline__ void glds16(const void*gsrc,unsigned lds_dst){unsigned keep;
  asm volatile("s_mov_b32 %0, m0\n\ts_mov_b32 m0, %2\n\ts_nop 0\n\tglobal_load_lds_dwordx4 %1, off\n\ts_mov_b32 m0, %0":"=&s"(keep):"v"(gsrc),"s"(lds_dst):"memory");}
__device__ __forceinline__ float max3f(float a,float b,float c){float r;asm("v_max3_f32 %0, %1, %2, %3":"=v"(r):"v"(a),"v"(b),"v"(c));return r;}
__device__ __forceinline__ float max2f(float a,float b){float r;asm("v_max_f32_e32 %0, %1, %2":"=v"(r):"v"(a),"v"(b));return r;}
__device__ __forceinline__ float fadd_s(float a,float b){float r;asm("v_add_f32_e32 %0, %1, %2":"=v"(r):"v"(a),"v"(b));return r;}
__device__ __forceinline__ float fsub_s(float a,float b){float r;asm("v_sub_f32_e32 %0, %1, %2":"=v"(r):"v"(a),"v"(b));return r;}
typedef float f32x2_t __attribute__((ext_vector_type(2))); typedef __bf16 bf16x2_t __attribute__((ext_vector_type(2)));
__device__ __forceinline__ unsigned cvtpk_s(float lo,float hi){f32x2_t v={lo,hi};bf16x2_t b=__builtin_convertvector(v,bf16x2_t);return __builtin_bit_cast(unsigned,b);}
#define WAIT_BAR(N) asm volatile("s_waitcnt vmcnt(" #N ") lgkmcnt(0)\n\ts_barrier":::"memory")
__device__ __forceinline__ void qkt(f32x16&p0,f32x16&p1,const char*Kslot,const bf16x8*qr,const f32x16&negm,int r32,int hi){
  const char*kb=Kslot+hi*1024+r32*16;
  #pragma unroll
  for(int d0=0;d0<4;++d0){
    const bf16x8 b0=*reinterpret_cast<const bf16x8*>(kb+d0*2048);
    const bf16x8 b1=*reinterpret_cast<const bf16x8*>(kb+d0*2048+512);
    if(d0==0){p0=__builtin_amdgcn_mfma_f32_32x32x16_bf16(b0,qr[0],negm,0,0,0);p1=__builtin_amdgcn_mfma_f32_32x32x16_bf16(b1,qr[0],negm,0,0,0);}
    else{p0=__builtin_amdgcn_mfma_f32_32x32x16_bf16(b0,qr[d0],p0,0,0,0);p1=__builtin_amdgcn_mfma_f32_32x32x16_bf16(b1,qr[d0],p1,0,0,0);}}
}
typedef __attribute__((address_space(3))) const char* lds_cptr;
typedef short v4i16_t __attribute__((ext_vector_type(4)));
__device__ __forceinline__ void kload8(bf16x8*kf,lds_cptr kp){
  kf[0]=*(const __attribute__((address_space(3))) bf16x8*)(kp);      kf[1]=*(const __attribute__((address_space(3))) bf16x8*)(kp+512);
  kf[2]=*(const __attribute__((address_space(3))) bf16x8*)(kp+2048); kf[3]=*(const __attribute__((address_space(3))) bf16x8*)(kp+2560);
  kf[4]=*(const __attribute__((address_space(3))) bf16x8*)(kp+4096); kf[5]=*(const __attribute__((address_space(3))) bf16x8*)(kp+4608);
  kf[6]=*(const __attribute__((address_space(3))) bf16x8*)(kp+6144); kf[7]=*(const __attribute__((address_space(3))) bf16x8*)(kp+6656);
}
__device__ __forceinline__ void kload2(bf16x8*kf,lds_cptr kp,int j){ kf[2*j]=*(const __attribute__((address_space(3))) bf16x8*)(kp+j*2048); kf[2*j+1]=*(const __attribute__((address_space(3))) bf16x8*)(kp+j*2048+512); }
__device__ __forceinline__ s16x4 vtr(lds_cptr p){ return __builtin_bit_cast(s16x4,__builtin_amdgcn_ds_read_tr16_b64_v4i16((__attribute__((address_space(3))) v4i16_t*)p)); }
__device__ __forceinline__ float rowmax(const f32x16&p0,const f32x16&p1){
  float a=max3f(p0[0],p0[1],p1[0]),b=max3f(p0[2],p0[3],p1[1]);a=max3f(a,p1[2],p1[3]);
  #pragma unroll
  for(int r=4;r<16;r+=4){a=max3f(a,p0[r],p0[r+1]);b=max3f(b,p0[r+2],p0[r+3]);a=max3f(a,p1[r],p1[r+1]);b=max3f(b,p1[r+2],p1[r+3]);}
  const float m=max2f(a,b);
  auto rr=__builtin_amdgcn_permlane32_swap(__float_as_uint(m),__float_as_uint(m),false,false);
  return max2f(__uint_as_float(rr[0]),__uint_as_float(rr[1]));
}
__device__ __forceinline__ void pv(f32x16*o,int vb,bf16x8 pa0,bf16x8 pa1,bf16x8 pa2,bf16x8 pa3){
  #pragma unroll
  for(int d0=0;d0<2;++d0){s16x4 lo[4],hi[4];
    #pragma unroll
    for(int ks=0;ks<4;++ks){
      asm volatile("ds_read_b64_tr_b16 %0,%1 offset:%c2":"=&v"(lo[ks]):"v"(vb),"i"(d0*4096+ks*1024):"memory");
      asm volatile("ds_read_b64_tr_b16 %0,%1 offset:%c2":"=&v"(hi[ks]):"v"(vb),"i"(d0*4096+ks*1024+512):"memory");}
    asm volatile("s_waitcnt lgkmcnt(0)":::"memory");SBAR();
    #define PK(k) (bf16x8){lo[k][0],lo[k][1],lo[k][2],lo[k][3],hi[k][0],hi[k][1],hi[k][2],hi[k][3]}
    o[d0]=__builtin_amdgcn_mfma_f32_32x32x16_bf16(pa0,PK(0),o[d0],0,0,0);
    o[d0]=__builtin_amdgcn_mfma_f32_32x32x16_bf16(pa1,PK(1),o[d0],0,0,0);
    o[d0]=__builtin_amdgcn_mfma_f32_32x32x16_bf16(pa2,PK(2),o[d0],0,0,0);
    o[d0]=__builtin_amdgcn_mfma_f32_32x32x16_bf16(pa3,PK(3),o[d0],0,0,0);
    #undef PK
  }
}
#define ATTN_STORE16(p,v) (*(u32x4*)(p)=(v))
template<int THRL> __device__ __forceinline__ void attn_unit(int hq,int hv,int qb,const bf16*Q,const bf16*__restrict__ K,const bf16*__restrict__ V,bf16*O,char*shm){
  const int tid=opaque_tid(),lane=tid&63,r32=lane&31,hi=lane>>5; const int wid=__builtin_amdgcn_readfirstlane(tid>>6);
  const int q0=qb*QB;
  const bf16*Qw=Q+(long)(q0+wid*QBLK)*DM+hq*D;
  const bf16*Kh=K+hq*D,*Vh=V+hv*D;
  const unsigned lds0=(unsigned)(uintptr_t)shm;
  float*wsf=(float*)(shm+LDS_WS)+wid*64;
  const bf16*ksrc=Kh+(long)lane*DM+wid*8;
  const bf16*vsrc=Vh+(long)(16*(wid&3)+(lane>>2))*DM+(wid>>2)*32+(lane&3)*8;
  const unsigned kdst=lds0+LDS_K+wid*1024, vdst=lds0+LDS_V+wid*1024;
  #define DMA_K(t,slot) glds16(ksrc+(long)(t)*KVBLK*DM,(unsigned)__builtin_amdgcn_readfirstlane(kdst+(slot)))
  #define DMA_V(t,slot) glds16(vsrc+(long)(t)*KVBLK*DM,(unsigned)__builtin_amdgcn_readfirstlane(vdst+(slot)))
  const int vb0=(int)(lds0+LDS_V)+((lane>>4)&1)*32+(lane&3)*8+(4*hi+((lane&15)>>2))*64;
  const char*Kbase=shm+LDS_K; bf16x8 kf[8];
  const lds_cptr shm3=(lds_cptr)shm; const lds_cptr kp0=shm3+LDS_K+hi*1024+r32*16; const lds_cptr vp0=shm3+LDS_V+((lane>>4)&1)*32+(lane&3)*8+(4*hi+((lane&15)>>2))*64;
  const int NT=(q0+QB)/KVBLK;
  DMA_K(0,0);DMA_V(0,0);DMA_K(1,SLOTB);
  bf16x8 qr[4];
  #pragma unroll
  for(int d0=0;d0<4;++d0)qr[d0]=*reinterpret_cast<const bf16x8*>(&Qw[(long)r32*DM+d0*16+hi*8]);
  float mhat=0.f,l_reg=0.f;f32x16 o[2];o[0]=f32x16{};o[1]=f32x16{};f32x16 negm=f32x16{};asm volatile("":"+v"(negm));
  const int qrel=wid*QBLK+r32;
  #define CMASK(P0,P1,t) do{int jb_=(t)-(NT-4); if(jb_>=0)cmask(P0,P1,jb_,qrel,hi);}while(0)
  bool resc=false;
  #define START(P0,P1) do{ const float rm=rowmax(P0,P1); resc=false; \
    { const float dl=rm; mhat=fadd_s(mhat,dl); \
      _Pragma("unroll") for(int r=0;r<16;++r){P0[r]=fsub_s(P0[r],dl);P1[r]=fsub_s(P1[r],dl);} \
      _Pragma("unroll") for(int r=0;r<16;++r)negm[r]=-mhat; asm volatile("":"+v"(negm)); } \
    _Pragma("unroll") for(int r=0;r<16;++r)P0[r]=__builtin_amdgcn_exp2f(P0[r]); }while(0)
  #define RESC() do{ if(resc){ asm volatile("s_waitcnt lgkmcnt(0)":::"memory"); \
      _Pragma("unroll") for(int d_=0;d_<2;++d_) _Pragma("unroll") for(int r=0;r<16;++r)o[d_][r]*=wsf[crow(r,hi)]; } }while(0)
  f32x16 pA0,pA1,pB0,pB1;
  int sl_prev=0,sl_cur=0,sl_next=SLOTB;
  #define ROT() do{sl_prev=sl_cur;sl_cur=sl_next;sl_next=(sl_next==(NSLOT-1)*SLOTB)?0:sl_next+SLOTB;}while(0)
  DMA_K(2,2*SLOTB);
  WAIT_BAR(3);
  qkt(pA0,pA1,Kbase,qr,negm,r32,hi);asm volatile("s_nop 15\n\ts_nop 7":"+v"(pA0),"+v"(pA1));CMASK(pA0,pA1,0);
  START(pA0,pA1);
  _Pragma("unroll") for(int r=0;r<16;++r)pA1[r]=__builtin_amdgcn_exp2f(pA1[r]);
  WAIT_BAR(0);
  DMA_K(3,0);DMA_V(1,SLOTB);
  ROT();
  kload8(kf,kp0+sl_cur);
  WAIT_BAR(2);
  s16x4 vlo[8],vhi[8]; u32x4 pw0,pw1,pw2,pw3;
  #define PKW(P,B) cvtpk_s(P[B],P[B+1])
  #define PAF(k) __builtin_bit_cast(bf16x8,pw##k)
  #define VFR(i) (bf16x8){vlo[i][0],vlo[i][1],vlo[i][2],vlo[i][3],vhi[i][0],vhi[i][1],vhi[i][2],vhi[i][3]}
  #define PIN(x) asm volatile("":"+v"(x))
  #define MX3(a,b,c) __builtin_fmaxf(__builtin_fmaxf((a),(b)),(c))
  #define GAPA(MF,A0,A1,A2,A3,W0,W1,PW) do{ MF; sacc+=A0; sacc+=A1; sacc+=A2; sacc+=A3; PIN(sacc); W0; W1; PIN(PW); SBAR(); }while(0)
  #define EX(v) __builtin_amdgcn_exp2f(v)
  #define GAPB(MF,X,B) do{ MF; X[B]=EX(X[B]); X[B+1]=EX(X[B+1]); X[B+2]=EX(X[B+2]); X[B+3]=EX(X[B+3]); PIN(X); SBAR(); }while(0)
  #define VRD(i) do{ vlo[i]=vtr(vp_+(((i)>>2)*4096+((i)&3)*1024)); vhi[i]=vtr(vp_+(((i)>>2)*4096+((i)&3)*1024+512)); }while(0)
  #define KRD(G,j) do{ if(G){ kload2(kf,kp0+sl_next,j); SBAR(); } }while(0)
  #define STEP(C0,C1,P0,P1,t,GK,GV,GL) do{ SBAR(); \
    const lds_cptr vp_=vp0+sl_prev; \
    VRD(0); SBAR(); float sacc=(P0[0]+P0[1]); \
    GAPA(C0=__builtin_amdgcn_mfma_f32_32x32x16_bf16(kf[0],qr[0],negm,0,0,0), P0[2],P0[3],P0[4],P0[5],     pw0[0]=PKW(P0,0), pw0[1]=PKW(P0,2), pw0); \
    VRD(4); SBAR(); GAPA(C1=__builtin_amdgcn_mfma_f32_32x32x16_bf16(kf[1],qr[0],negm,0,0,0), P0[6],P0[7],P0[8],P0[9],     pw0[2]=PKW(P0,4), pw0[3]=PKW(P0,6), pw0); \
    VRD(1); SBAR(); GAPA(C0=__builtin_amdgcn_mfma_f32_32x32x16_bf16(kf[2],qr[1],C0,0,0,0),   P0[10],P0[11],P0[12],P0[13], pw1[0]=PKW(P0,8), pw1[1]=PKW(P0,10), pw1); \
    VRD(5); SBAR(); GAPA(C1=__builtin_amdgcn_mfma_f32_32x32x16_bf16(kf[3],qr[1],C1,0,0,0),   P0[14],P0[15],P1[0],P1[1],   pw1[2]=PKW(P0,12),pw1[3]=PKW(P0,14), pw1); \
    VRD(2); SBAR(); GAPA(C0=__builtin_amdgcn_mfma_f32_32x32x16_bf16(kf[4],qr[2],C0,0,0,0),   P1[2],P1[3],P1[4],P1[5],     pw2[0]=PKW(P1,0), pw2[1]=PKW(P1,2), pw2); \
    VRD(6); SBAR(); GAPA(C1=__builtin_amdgcn_mfma_f32_32x32x16_bf16(kf[5],qr[2],C1,0,0,0),   P1[6],P1[7],P1[8],P1[9],     pw2[2]=PKW(P1,4), pw2[3]=PKW(P1,6), pw2); \
    VRD(3); SBAR(); GAPA(C0=__builtin_amdgcn_mfma_f32_32x32x16_bf16(kf[6],qr[3],C0,0,0,0),   P1[10],P1[11],P1[12],P1[13], pw3[0]=PKW(P1,8), pw3[1]=PKW(P1,10), pw3); \
    VRD(7); SBAR(); GAPA(C1=__builtin_amdgcn_mfma_f32_32x32x16_bf16(kf[7],qr[3],C1,0,0,0),   P1[14],P1[15],0.f,0.f,       pw3[2]=PKW(P1,12),pw3[3]=PKW(P1,14), pw3); \
    l_reg+=sacc; \
    if(GK){DMA_K((t)+3,sl_cur);} if(GV){DMA_V((t)+1,sl_next);} \
    CMASK(C0,C1,t); \
    { float a=MX3(C0[0],C0[1],C1[0]),b=MX3(C0[2],C0[3],C1[1]); a=MX3(a,C1[2],C1[3]); \
      _Pragma("unroll") for(int r=4;r<16;r+=4){a=MX3(a,C0[r],C0[r+1]);b=MX3(b,C0[r+2],C0[r+3]);a=MX3(a,C1[r],C1[r+1]);b=MX3(b,C1[r+2],C1[r+3]);} \
      float rm=__builtin_fmaxf(a,b); { auto rr=__builtin_amdgcn_permlane32_swap(__float_as_uint(rm),__float_as_uint(rm),false,false); rm=__builtin_fmaxf(__uint_as_float(rr[0]),__uint_as_float(rr[1])); } \
      resc=false; \
      if(__builtin_expect(__any(rm>(float)THRL),0)){ const float dl=__builtin_fmaxf(rm,0.f); mhat+=dl; \
        _Pragma("unroll") for(int r=0;r<16;++r){C0[r]-=dl;C1[r]-=dl;} \
        _Pragma("unroll") for(int r=0;r<16;++r)negm[r]=-mhat; asm volatile("":"+v"(negm)); \
        const float f=__builtin_amdgcn_exp2f(-dl); l_reg*=f; if(hi==0)wsf[r32]=f; resc=true; } } \
    SBAR(); \
    GAPB(o[0]=__builtin_amdgcn_mfma_f32_32x32x16_bf16(PAF(0),VFR(0),o[0],0,0,0), C0,0); \
    GAPB(o[1]=__builtin_amdgcn_mfma_f32_32x32x16_bf16(PAF(0),VFR(4),o[1],0,0,0), C0,4); \
    KRD(GL,0); GAPB(o[0]=__builtin_amdgcn_mfma_f32_32x32x16_bf16(PAF(1),VFR(1),o[0],0,0,0), C0,8); \
    KRD(GL,1); GAPB(o[1]=__builtin_amdgcn_mfma_f32_32x32x16_bf16(PAF(1),VFR(5),o[1],0,0,0), C0,12); \
    KRD(GL,2); GAPB(o[0]=__builtin_amdgcn_mfma_f32_32x32x16_bf16(PAF(2),VFR(2),o[0],0,0,0), C1,0); \
    KRD(GL,3); GAPB(o[1]=__builtin_amdgcn_mfma_f32_32x32x16_bf16(PAF(2),VFR(6),o[1],0,0,0), C1,4); \
    GAPB(o[0]=__builtin_amdgcn_mfma_f32_32x32x16_bf16(PAF(3),VFR(3),o[0],0,0,0), C1,8); \
    GAPB(o[1]=__builtin_amdgcn_mfma_f32_32x32x16_bf16(PAF(3),VFR(7),o[1],0,0,0), C1,12); \
    }while(0)
  int t=1;
  #undef CMASK
  #define CMASK(P0,P1,t) do{}while(0)
  for(;t+5<NT;t+=2){
    STEP(pB0,pB1,pA0,pA1,t,true,true,true);     WAIT_BAR(2); RESC(); ROT();
    STEP(pA0,pA1,pB0,pB1,t+1,true,true,true);   WAIT_BAR(2); RESC(); ROT();
  }
  #undef CMASK
  #define CMASK(P0,P1,t) do{int jb_=(t)-(NT-4); if(jb_>=0)cmask(P0,P1,jb_,qrel,hi);}while(0)
  #define ENDW(tt) do{ if((tt)+3<NT){WAIT_BAR(2);} else if((tt)+2<NT){WAIT_BAR(1);} else {WAIT_BAR(0);} }while(0)
  for(;t+1<NT;t+=2){
    STEP(pB0,pB1,pA0,pA1,t,(t+3<NT),(t+1<NT),(t+1<NT));       ENDW(t);   RESC(); ROT();
    STEP(pA0,pA1,pB0,pB1,t+1,(t+4<NT),(t+2<NT),(t+2<NT));     ENDW(t+1); RESC(); ROT();
  }
  STEP(pB0,pB1,pA0,pA1,NT-1,false,false,false); RESC();
  { float sacc=pB0[0]+pB0[1]; _Pragma("unroll") for(int r=2;r<16;++r)sacc+=pB0[r]; _Pragma("unroll") for(int r=0;r<16;++r)sacc+=pB1[r]; l_reg+=sacc;
    pw0=(u32x4){PKW(pB0,0),PKW(pB0,2),PKW(pB0,4),PKW(pB0,6)};pw1=(u32x4){PKW(pB0,8),PKW(pB0,10),PKW(pB0,12),PKW(pB0,14)};pw2=(u32x4){PKW(pB1,0),PKW(pB1,2),PKW(pB1,4),PKW(pB1,6)};pw3=(u32x4){PKW(pB1,8),PKW(pB1,10),PKW(pB1,12),PKW(pB1,14)};
    SBAR(); pv(o,vb0+sl_cur,PAF(0),PAF(1),PAF(2),PAF(3)); }
  #undef PKW
  #undef PAF
  #undef VFR
  #undef PIN
  #undef MX3
  #undef GAPA
  #undef GAPB
  #undef EX
  #undef VRD
  #undef KRD
  #undef STEP
  #undef ENDW
  {auto rr=__builtin_amdgcn_permlane32_swap(__float_as_uint(l_reg),__float_as_uint(l_reg),false,false);l_reg=__uint_as_float(rr[0])+__uint_as_float(rr[1]);}
  if(hi==0)wsf[32+r32]=l_reg;asm volatile("s_waitcnt lgkmcnt(0)":::"memory");
  float rli[16];
  #pragma unroll
  for(int r=0;r<16;++r)rli[r]=__builtin_amdgcn_rcpf(wsf[32+crow(r,hi)]);
  bf16*Ow=O+(long)(q0+wid*QBLK)*DM+hv*D;
  { bf16*stg=(bf16*)(shm+LDS_OST)+wid*2048;
    #pragma unroll
    for(int r=0;r<16;++r){const int orow=crow(r,hi);
      #pragma unroll
      for(int d0=0;d0<2;++d0)stg[orow*64+d0*32+r32]=__float2bfloat16(o[d0][r]*rli[r]);}
    asm volatile("s_waitcnt lgkmcnt(0)":::"memory");
    #pragma unroll
    for(int i=0;i<4;++i){const int row=i*8+(lane>>3),ch=lane&7; const u32x4 v=*(const u32x4*)(stg+row*64+ch*8); ATTN_STORE16(Ow+(long)row*DM+ch*8,v);} }
  asm volatile("s_waitcnt lgkmcnt(0)\n\ts_barrier":::"memory");
  #undef DMA_K
  #undef DMA_V
  #undef CMASK
  #undef START
  #undef RESC
  #undef ROT
}
constexpr int ATTN_LDS_BYTES=LDS_BYTES;
#undef SBAR
#undef WAIT_BAR
}

typedef GAS unsigned gu32;
#define RLX_AGENT __ATOMIC_RELAXED, __HIP_MEMORY_SCOPE_AGENT
#define LDS_WAIT() asm volatile("s_waitcnt lgkmcnt(0)" ::: "memory")
#define XB_TMO      128
#define XB_XCNT(j)  (256  + 64 * (j))
#define XB_XSUB(j)  (1280 + 64 * (j))
#define XB_XGEN(j)  (2304 + 64 * (j))
#define XB_TOP      3328
#define XB_TOPGEN   3392
#define XCD_BAR_WORDS 3456
#define XB_SPIN_CAP (1u << 18)
__device__ __forceinline__ unsigned xb_ld(unsigned* p)              { return __hip_atomic_load(p, __ATOMIC_RELAXED, __HIP_MEMORY_SCOPE_AGENT); }
__device__ __forceinline__ unsigned xb_add(unsigned* p, unsigned v) { return __hip_atomic_fetch_add(p, v, __ATOMIC_RELAXED, __HIP_MEMORY_SCOPE_AGENT); }
__device__ __forceinline__ unsigned xb_xcc_id() { return (unsigned)__builtin_amdgcn_s_getreg((3 << 11) | 20) & 0xFu; }
#define XB_SPIN(cond, bar) do { unsigned _sp = 0; while (cond) { __builtin_amdgcn_s_sleep(1); \
    if ((++_sp & 255u) == 0u) { if (xb_ld(&(bar)[XB_TMO])) break; if (_sp > XB_SPIN_CAP) { atomicAdd(&(bar)[XB_TMO], 1u); break; } } } } while (0)
struct XcdBarrier { unsigned* bar; unsigned x; volatile LAS unsigned* st; };
__device__ __forceinline__ XcdBarrier xcd_barrier_post(unsigned* bar, volatile LAS unsigned* st) {
    XcdBarrier b; b.bar = bar; b.x = xb_xcc_id(); b.st = st;
    if (threadIdx.x == 0) (void)xb_add(&bar[XB_XCNT(b.x)], 1u);
    return b;
}
__device__ __forceinline__ void xcd_barrier_complete(unsigned* bar, unsigned x, unsigned& nloc, unsigned& nx) {
    const unsigned G = gridDim.x * gridDim.y * gridDim.z;
    unsigned sum, cnt, mine, sp = 0u;
    for (;;) {
        sum = 0u; cnt = 0u; mine = 0u;
#pragma unroll
        for (unsigned j = 0; j < 16; ++j) { const unsigned c = xb_ld(&bar[XB_XCNT(j)]); sum += c; cnt += (c > 0u) ? 1u : 0u; mine = (j == x) ? c : mine; }
        if (sum == G) break;
        __builtin_amdgcn_s_sleep(1);
        if ((++sp & 255u) == 0u) { if (xb_ld(&bar[XB_TMO])) break; if (sp > XB_SPIN_CAP) { atomicAdd(&bar[XB_TMO], 1u); break; } }
    }
    nloc = mine > 0u ? mine : 1u; nx = cnt > 0u ? cnt : 1u;
}
__device__ __forceinline__ void xcd_barrier(const XcdBarrier& b) {
    asm volatile("s_waitcnt vmcnt(0)" ::: "memory");
    __syncthreads();
    if (threadIdx.x == 0) {
        unsigned* bar = b.bar; asm volatile("" : "+v"(bar));
        __builtin_amdgcn_s_waitcnt(0);
        unsigned nloc = b.st[0], nx = b.st[1];
        if (nloc == 0u) { xcd_barrier_complete(bar, b.x, nloc, nx); b.st[0] = nloc; b.st[1] = nx; }
        const unsigned old = xb_add(&bar[XB_XSUB(b.x)], 1u);
        const unsigned gen = old / nloc;
        if (old + 1u == (gen + 1u) * nloc) {
            __builtin_amdgcn_fence(__ATOMIC_RELEASE, "agent");
            asm volatile("s_waitcnt vmcnt(0)" ::: "memory");
            const unsigned og = xb_add(&bar[XB_TOP], 1u);
            const unsigned tg = og / nx;
            if (og + 1u == (tg + 1u) * nx) xb_add(&bar[XB_TOPGEN], 1u);
            else XB_SPIN(xb_ld(&bar[XB_TOPGEN]) == tg, bar);
            __builtin_amdgcn_fence(__ATOMIC_ACQUIRE, "agent");
            xb_add(&bar[XB_XGEN(b.x)], 1u);
            asm volatile("s_waitcnt vmcnt(0)" ::: "memory");
        } else {
            XB_SPIN(xb_ld(&bar[XB_XGEN(b.x)]) == gen, bar);
            __builtin_amdgcn_fence(__ATOMIC_ACQUIRE, "agent");
            asm volatile("s_waitcnt vmcnt(0)" ::: "memory");
        }
    }
    __syncthreads();
}

__device__ __forceinline__ float wave_sum(float v) {
#pragma unroll
    for (int o = 1; o < 64; o <<= 1) v += __shfl_xor(v, o);
    return v;
}
template <class F>
__device__ __forceinline__ void transpose_item(const float* W, int K, int ld, bf16_t* WT, int nrows, F srccol, const float* gk, LAS float* scr, int item, int lane) {
    const int nblk = nrows / 32, kb = item / nblk, nb = item % nblk, k0 = 64 * kb, n0 = 32 * nb, s0 = srccol(n0);
#pragma unroll 8
    for (int i = 0; i < 32; ++i) { const int kk = 2 * i + (lane >> 5); float v = W[(size_t)(k0 + kk) * ld + s0 + (lane & 31)]; if (gk) v *= gk[k0 + kk]; scr[kk * 33 + (lane & 31)] = v; }
    LDS_WAIT(); asm volatile("" ::: "memory");
    const int c = lane & 7;
#pragma unroll
    for (int j = 0; j < 4; ++j) { const int n = (lane >> 3) + 8 * j; const LAS float* s = scr + (8 * c) * 33 + n;
        u32x4 o; o.x = cvt_pk_bf16(s[0 * 33], s[1 * 33]); o.y = cvt_pk_bf16(s[2 * 33], s[3 * 33]); o.z = cvt_pk_bf16(s[4 * 33], s[5 * 33]); o.w = cvt_pk_bf16(s[6 * 33], s[7 * 33]);
        *(u32x4*)(WT + (size_t)(n0 + n) * K + k0 + 8 * c) = o; }
    LDS_WAIT(); asm volatile("" ::: "memory");
}
struct ColIdent { int off; __device__ __forceinline__ int operator()(int r) const { return off + r; } };
struct ColSwiglu { __device__ __forceinline__ int operator()(int r) const { return ((r >> 7) & 1) * DFF + (r >> 8) * 128 + (r & 127); } };
struct ColMix { __device__ __forceinline__ int operator()(int r) const {
    const int tile = r >> 8, p = r & 255, o = 64 * ((p >> 5) & 3) + 32 * (p >> 7) + (p & 31);
    if (tile < 16) return r;
    if (tile < 20) return 6144 + (tile - 16) * 256 + o;
    if (tile < 24) return 7168 + (tile - 20) * 256 + o;
    if (tile < 28) return 8192 + (tile - 24) * 256 + p;
    return 9216 + (tile - 28) * 256 + p; } };
template <class F>
__device__ __forceinline__ void transpose_all(const float* W, int K, int ld, bf16_t* WT, int nrows, F srccol, const float* gk, LAS float* scr, int gw, int ngw, int lane) {
    const int nitems = (K / 64) * (nrows / 32);
    for (int it = gw; it < nitems; it += ngw) transpose_item(W, K, ld, WT, nrows, srccol, gk, scr, it, lane);
}
__device__ __forceinline__ void rms_row_to_bf16(const float* xrow, const float* gain, bf16_t* orow, int lane) {
    const f32x4* xr = (const f32x4*)xrow + lane; const f32x4* gr = (const f32x4*)gain + lane;
    f32x4 v[4]; float s = 0.f;
#pragma unroll
    for (int j = 0; j < 4; ++j) { v[j] = xr[64 * j]; s += (v[j][0] * v[j][0] + v[j][1] * v[j][1]) + (v[j][2] * v[j][2] + v[j][3] * v[j][3]); }
    const float r = __builtin_amdgcn_rsqf(wave_sum(s) * (1.f / 1024.f) + EPS);
    u32x2* o8 = (u32x2*)orow + lane;
#pragma unroll
    for (int j = 0; j < 4; ++j) o8[64 * j] = pack4(v[j] * r * gr[64 * j]);
}
__device__ __forceinline__ void rot_table(const int* pos, float* rot, int gt, int ngt) {
    for (int idx = gt; idx < SEQ * 128; idx += ngt) {
        const int s = idx >> 7, i = idx & 127;
        const float inv = exp2f(-(float)i * (13.287712379549449f / 128.0f));
        const float ang = (float)pos[s] * inv;
        const float kq = rintf(ang * 0.6366197723675814f);
        float r = fmaf(-kq, 1.5703125f, ang); r = fmaf(-kq, 4.837512969970703125e-4f, r); r = fmaf(-kq, 7.54978995489188216e-8f, r);
        const float r2 = r * r;
        const float sn = r + r * r2 * (-1.6666667e-1f + r2 * (8.3333333e-3f + r2 * (-1.9841270e-4f + r2 * 2.7557319e-6f)));
        const float cn = 1.0f + r2 * (-0.5f + r2 * (4.1666668e-2f + r2 * (-1.3888889e-3f + r2 * (2.4801587e-5f + r2 * -2.7557319e-7f))));
        const int qd = ((int)kq) & 3;
        const float c = (qd == 0) ? cn : (qd == 1) ? -sn : (qd == 2) ? -cn : sn;
        const float sv = (qd == 0) ? sn : (qd == 1) ? cn : (qd == 2) ? -sn : -cn;
        *(f32x2*)(rot + (size_t)idx * 2) = (f32x2){c, sv};
    }
}

__device__ __forceinline__ void scan_unit(int h, int es, const bf16_t* kts, const bf16_t* vt, bf16_t* S) {
    const int tid = opaque_tid(), lane = tid & 63, wave = __builtin_amdgcn_readfirstlane(tid >> 6);
    const int fr = lane & 15, fq = lane >> 4;
    const float gC = __builtin_amdgcn_exp2f(128.0f * log2f(1.0f - __builtin_amdgcn_exp2f(-5.0f - (float)h)));
    f32x4 acc[2][2];
#pragma unroll
    for (int a = 0; a < 2; ++a)
#pragma unroll
        for (int b = 0; b < 2; ++b) acc[a][b] = (f32x4){0.f, 0.f, 0.f, 0.f};
    const bf16_t* kbase = kts + (size_t)(h * 256 + 32 * wave + fr) * SEQ + 8 * fq;
    const bf16_t* vbase = vt + (size_t)(h * 512 + 32 * es + fr) * SEQ + 8 * fq;
    for (int c = 0; c < 16; ++c) {
#pragma unroll
        for (int td = 0; td < 2; ++td)
#pragma unroll
            for (int te = 0; te < 2; ++te)
                *(u32x2*)(S + ((size_t)((h * 16 + c) * 512 + 32 * es + 16 * te + fr)) * 256 + 32 * wave + 16 * td + 4 * fq) = pack4(acc[td][te]);
        if (c == 15) break;
#pragma unroll
        for (int td = 0; td < 2; ++td)
#pragma unroll
            for (int te = 0; te < 2; ++te) acc[td][te] = acc[td][te] * gC;
#pragma unroll
        for (int ks = 0; ks < 4; ++ks) {
            const int tok = c * 128 + 32 * ks;
            bf16x8 a[2], b[2];
#pragma unroll
            for (int t = 0; t < 2; ++t) { a[t] = *(const bf16x8*)(kbase + (size_t)(16 * t) * SEQ + tok); b[t] = *(const bf16x8*)(vbase + (size_t)(16 * t) * SEQ + tok); }
#pragma unroll
            for (int td = 0; td < 2; ++td)
#pragma unroll
                for (int te = 0; te < 2; ++te) acc[td][te] = mfma16(a[td], b[te], acc[td][te]);
        }
    }
}
constexpr int SC_LD = 136;
__device__ __forceinline__ void retout_unit(int h, int c, int rq, const bf16_t* q, const bf16_t* k, const bf16_t* vt, const bf16_t* S, bf16_t* ret  ,
                                            LAS unsigned char* lds) {
    const int tid = opaque_tid(), lane = tid & 63, wave = __builtin_amdgcn_readfirstlane(tid >> 6);
    const int fr = lane & 15, fq = lane >> 4;
    LAS bf16_t* sc = (LAS bf16_t*)lds;
    LAS float* part = (LAS float*)(lds + 32 * SC_LD * 2);
    const float lg2 = log2f(1.0f - __builtin_amdgcn_exp2f(-5.0f - (float)h));
    const int tok0 = c * 128;
    {
        const int ti = wave & 1, tj0 = 2 * (wave >> 1);
        f32x4 s2[2] = {(f32x4){0.f, 0.f, 0.f, 0.f}, (f32x4){0.f, 0.f, 0.f, 0.f}};
        const bf16_t* qp = q + (size_t)(tok0 + 32 * rq + 16 * ti + fr) * 1024 + h * 256 + 8 * fq;
        const bf16_t* kp = k + (size_t)(tok0 + 16 * tj0 + fr) * 1024 + h * 256 + 8 * fq;
#pragma unroll
        for (int ks = 0; ks < 8; ++ks) {
            const bf16x8 qf = *(const bf16x8*)(qp + 32 * ks);
#pragma unroll
            for (int t = 0; t < 2; ++t) { const bf16x8 kf = *(const bf16x8*)(kp + (size_t)(16 * t) * 1024 + 32 * ks); s2[t] = mfma16(kf, qf, s2[t]); }
        }
        const int i = 32 * rq + 16 * ti + fr;
#pragma unroll
        for (int t = 0; t < 2; ++t) {
            f32x4 v;
#pragma unroll
            for (int r = 0; r < 4; ++r) { const int j = 16 * (tj0 + t) + 4 * fq + r; v[r] = (i >= j) ? s2[t][r] * __builtin_amdgcn_exp2f(lg2 * (float)(i - j)) : 0.f; }
            *(LAS u32x2*)(sc + (16 * ti + fr) * SC_LD + 16 * (tj0 + t) + 4 * fq) = pack4(v);
        }
    }
    __syncthreads();
    f32x4 ax[2][4], ai[2][4];
#pragma unroll
    for (int a = 0; a < 2; ++a)
#pragma unroll
        for (int b = 0; b < 4; ++b) { ax[a][b] = (f32x4){0.f, 0.f, 0.f, 0.f}; ai[a][b] = (f32x4){0.f, 0.f, 0.f, 0.f}; }
    {
        const bf16_t* qp = q + (size_t)(tok0 + 32 * rq + fr) * 1024 + h * 256 + 8 * fq;
        const bf16_t* sp = S + ((size_t)((h * 16 + c) * 512 + 64 * wave + fr)) * 256 + 8 * fq;
#pragma unroll 2
        for (int ks = 0; ks < 8; ++ks) {
            bf16x8 qf[2], sf[4];
#pragma unroll
            for (int t = 0; t < 2; ++t) qf[t] = *(const bf16x8*)(qp + (size_t)(16 * t) * 1024 + 32 * ks);
#pragma unroll
            for (int t = 0; t < 4; ++t) sf[t] = *(const bf16x8*)(sp + (size_t)(16 * t) * 256 + 32 * ks);
#pragma unroll
            for (int a = 0; a < 2; ++a)
#pragma unroll
                for (int b = 0; b < 4; ++b) ax[a][b] = mfma16(sf[b], qf[a], ax[a][b]);
        }
    }
    {
        const bf16_t* vp = vt + (size_t)(h * 512 + 64 * wave + fr) * SEQ + tok0 + 8 * fq;
#pragma unroll 2
        for (int ks = 0; ks < 4; ++ks) {
            bf16x8 pf[2], vf[4];
#pragma unroll
            for (int t = 0; t < 2; ++t) pf[t] = *(const LAS bf16x8*)(sc + (16 * t + fr) * SC_LD + 32 * ks + 8 * fq);
#pragma unroll
            for (int t = 0; t < 4; ++t) vf[t] = *(const bf16x8*)(vp + (size_t)(16 * t) * SEQ + 32 * ks);
#pragma unroll
            for (int a = 0; a < 2; ++a)
#pragma unroll
                for (int b = 0; b < 4; ++b) ai[a][b] = mfma16(vf[b], pf[a], ai[a][b]);
        }
    }
    float ssq[2];
#pragma unroll
    for (int a = 0; a < 2; ++a) {
        const float qd = __builtin_amdgcn_exp2f(lg2 * (float)(32 * rq + 16 * a + fr + 1));
        float ss = 0.f;
#pragma unroll
        for (int b = 0; b < 4; ++b) { ax[a][b] = ax[a][b] * qd + ai[a][b]; const f32x4 t = ax[a][b]; ss += (t[0] * t[0] + t[1] * t[1]) + (t[2] * t[2] + t[3] * t[3]); }
        ss += __shfl_xor(ss, 16); ss += __shfl_xor(ss, 32);
        ssq[a] = ss;
        if (fq == 0) part[wave * 32 + 16 * a + fr] = ss;
    }
    __syncthreads();
#pragma unroll
    for (int a = 0; a < 2; ++a) {
        float tot = 0.f;
#pragma unroll
        for (int w = 0; w < 8; ++w) tot += part[w * 32 + 16 * a + fr];
        const float rn = __builtin_amdgcn_rsqf(tot * (1.0f / 512.0f) + EPS);
#pragma unroll
        for (int b = 0; b < 4; ++b)
            *(u32x2*)(ret + (size_t)(tok0 + 32 * rq + 16 * a + fr) * 2048 + h * 512 + 64 * wave + 16 * b + 4 * fq) = pack4(ax[a][b] * rn);
    }
    (void)ssq;
    __syncthreads();
}
constexpr int PL_LD = 264;
__device__ __forceinline__ void memattn_unit(int b, int h, int rb, const bf16_t* mq, const bf16_t* mkn, const bf16_t* mvt, bf16_t* mo  ,
                                             LAS unsigned char* lds) {
    const int tid = opaque_tid(), lane = tid & 63, wave = __builtin_amdgcn_readfirstlane(tid >> 6);
    const int fr = lane & 15, fq = lane >> 4;
    LAS bf16_t* pl = (LAS bf16_t*)lds + wave * (16 * PL_LD);
    const int row = 128 * rb + 16 * wave + fr;
    bf16x8 qf[8]; float qs = 0.f;
#pragma unroll
    for (int ks = 0; ks < 8; ++ks) { qf[ks] = *(const bf16x8*)(mq + (size_t)row * 1024 + h * 256 + 32 * ks + 8 * fq);
#pragma unroll
        for (int j = 0; j < 8; ++j) { const float f = bf2f((unsigned short)qf[ks][j]); qs += f * f; } }
    qs += __shfl_xor(qs, 16); qs += __shfl_xor(qs, 32);
    const float scl = __builtin_amdgcn_rsqf(qs * (1.0f / 256.0f) + EPS) * (0.0625f * LOG2E);
    f32x4 sa[16];
    const bf16_t* kp = mkn + (size_t)(b * 256 + fr) * 1024 + h * 256 + 8 * fq;
#pragma unroll
    for (int t = 0; t < 16; ++t) {
        f32x4 a = (f32x4){0.f, 0.f, 0.f, 0.f};
#pragma unroll
        for (int ks = 0; ks < 8; ++ks) { const bf16x8 kf = *(const bf16x8*)(kp + (size_t)(16 * t) * 1024 + 32 * ks); a = mfma16(kf, qf[ks], a); }
        sa[t] = a * scl;
    }
    float mx = -INFINITY;
#pragma unroll
    for (int t = 0; t < 16; ++t) mx = fmaxf(mx, fmaxf(fmaxf(sa[t][0], sa[t][1]), fmaxf(sa[t][2], sa[t][3])));
    mx = fmaxf(mx, __shfl_xor(mx, 16)); mx = fmaxf(mx, __shfl_xor(mx, 32));
    float l = 0.f;
#pragma unroll
    for (int t = 0; t < 16; ++t) {
        f32x4 p;
#pragma unroll
        for (int r = 0; r < 4; ++r) { p[r] = __builtin_amdgcn_exp2f(sa[t][r] - mx); l += p[r]; }
        *(LAS u32x2*)(pl + fr * PL_LD + 16 * t + 4 * fq) = pack4(p);
    }
    l += __shfl_xor(l, 16); l += __shfl_xor(l, 32);
    const float rl = __builtin_amdgcn_rcpf(l);
    LDS_WAIT(); asm volatile("" ::: "memory");
    bf16x8 pf[8];
#pragma unroll
    for (int ks = 0; ks < 8; ++ks) pf[ks] = *(const LAS bf16x8*)(pl + fr * PL_LD + 32 * ks + 8 * fq);
    const bf16_t* vp = mvt + (size_t)((b * 4 + h) * 256 + fr) * 256 + 8 * fq;
#pragma unroll
    for (int td = 0; td < 16; ++td) {
        f32x4 a = (f32x4){0.f, 0.f, 0.f, 0.f};
#pragma unroll
        for (int ks = 0; ks < 8; ++ks) { const bf16x8 vf = *(const bf16x8*)(vp + (size_t)(16 * td) * 256 + 32 * ks); a = mfma16(vf, pf[ks], a); }
        *(u32x2*)(mo + (size_t)row * 1024 + h * 256 + 16 * td + 4 * fq) = pack4(a * rl);
    }
    LDS_WAIT(); asm volatile("" ::: "memory");
}
__device__ __forceinline__ void dif_row(const bf16_t* o0, const bf16_t* o1, bf16_t* dif, const float* gout, float lam, int lane) {
    const u32x4* a = (const u32x4*)o0 + 2 * lane; const u32x4* b = (const u32x4*)o1 + 2 * lane;
    float d[16]; float ss = 0.f;
#pragma unroll
    for (int v = 0; v < 2; ++v) { const u32x4 x = a[v], y = b[v];
#pragma unroll
        for (int w = 0; w < 4; ++w) { const float x0 = __uint_as_float(x[w] << 16), x1 = __uint_as_float(x[w] & 0xffff0000u), y0 = __uint_as_float(y[w] << 16), y1 = __uint_as_float(y[w] & 0xffff0000u);
            const float d0 = x0 - lam * y0, d1 = x1 - lam * y1; d[v * 8 + w * 2] = d0; d[v * 8 + w * 2 + 1] = d1; ss += d0 * d0 + d1 * d1; } }
    ss += __shfl_xor(ss, 1); ss += __shfl_xor(ss, 2); ss += __shfl_xor(ss, 4);
    const float rn = __builtin_amdgcn_rsqf(ss * (1.0f / 128.0f) + EPS) * (1.0f - LAM_INIT);
    const float* gp = gout + (lane & 7) * 16;
    u32x4 o[2];
#pragma unroll
    for (int v = 0; v < 2; ++v)
#pragma unroll
        for (int w = 0; w < 4; ++w) o[v][w] = cvt_pk_bf16(d[v * 8 + w * 2] * rn * gp[v * 8 + w * 2], d[v * 8 + w * 2 + 1] * rn * gp[v * 8 + w * 2 + 1]);
    u32x4* op = (u32x4*)dif + 2 * lane; op[0] = o[0]; op[1] = o[1];
}

#ifndef PH_MASK
#define PH_MASK 0xffffffffu
#endif
#define PH(n) ((PH_MASK >> (n)) & 1u)
struct Args { const void* in[26]; float* out; unsigned char* ws; };
#define CAS __attribute__((address_space(4)))
__device__ __forceinline__ const void* karg(int i) { typedef const GAS void* gptr; const CAS gptr* p = (const CAS gptr*)__builtin_amdgcn_kernarg_segment_ptr(); asm volatile("" : "+s"(p)); return (const void*)p[i]; }
#define INP(i) ((const float*)karg(i))
#define WSP(T, off) ((T*)((unsigned char*)karg(27) + (off)))
#define OUTP ((float*)karg(26))
__global__ void __launch_bounds__(NWAVES * 64, 2) mk_fwd(Args args) {
    extern __shared__ __attribute__((aligned(16))) unsigned char lds_raw[];
    LAS unsigned char* lds = (LAS unsigned char*)lds_raw;
    volatile LAS unsigned* MISC = (volatile LAS unsigned*)(lds + MISC_OFF);
    const int G = gridDim.x, bx = blockIdx.x;
    for (int u = threadIdx.x; u < (LDS_BYTES - LDSCTL_OFF) / 4; u += NWAVES * 64) ((LAS unsigned*)(lds + LDSCTL_OFF))[u] = 0u;
    __syncthreads();
    (void)xcd_barrier_post((unsigned*)WSP(unsigned, WS_CTL) + CW_BAR, MISC + 8);
#define GRID_BAR() do { XcdBarrier b_; b_.bar = (unsigned*)WSP(unsigned, WS_CTL) + CW_BAR; b_.x = xb_xcc_id(); b_.st = (volatile LAS unsigned*)(lds + MISC_OFF) + 8; xcd_barrier(b_); } while (0)
    const int NGW = G * NWAVES, NGT = G * NWAVES * 64;
#define LANE_VARS() const int tid = opaque_tid(), lane = tid & 63, wave = __builtin_amdgcn_readfirstlane(tid >> 6); LAS float* scr = (LAS float*)(lds + wave * 16384); \
    const int gw = bx * NWAVES + wave, gt = bx * (NWAVES * 64) + tid; (void)scr; (void)gw; (void)gt; (void)lane

    if (PH(0)) {
        LANE_VARS();
        transpose_all(INP(4), 1024, 2 * DFF, WSP(bf16_t, WS_WF1I), 2 * DFF, ColSwiglu{}, nullptr, scr, gw, NGW, lane);
        transpose_all(INP(5), DFF, 1024, WSP(bf16_t, WS_WF1O), 1024, ColIdent{0}, nullptr, scr, gw, NGW, lane);
        transpose_all(INP(18), 1024, 2048, WSP(bf16_t, WS_WMKV), 2048, ColIdent{0}, nullptr, scr, gw, NGW, lane);
        transpose_all(INP(7), 1024, 13312, WSP(bf16_t, WS_WMIX), NMIX, ColMix{}, INP(6), scr, gw, NGW, lane);
        transpose_all(INP(7), 1024, 13312, WSP(bf16_t, WS_WRG), 2048, ColIdent{4096}, INP(6), scr, gw, NGW, lane);
        { const float* x = INP(0); const float* g1 = INP(3); bf16_t* xb = WSP(bf16_t, WS_XB);
          for (int m = gw; m < TOK; m += NGW) rms_row_to_bf16(x + (size_t)m * DM, g1, xb + (size_t)m * DM, lane); }
        { const float* mem = INP(1); const float* gm = INP(17); bf16_t* memn = WSP(bf16_t, WS_MEMN);
          for (int m = gw; m < NB * MEML; m += NGW) rms_row_to_bf16(mem + (size_t)m * DM, gm, memn + (size_t)m * DM, lane); }
        rot_table((const int*)karg(2), WSP(float, WS_ROT), gt, NGT);
    }
    GRID_BAR();

    if (PH(1)) {
        pg8::Gemm g{WSP(bf16_t, WS_XB), WSP(bf16_t, WS_WF1I), TOK, 2 * DFF, 1024}; pg8::StaticOrder S; S.init(TOK, 2 * DFF, G, bx);
        EpiSwiglu E{WSP(bf16_t, WS_ACT), nullptr};
        pg8::gemm_phase(lds, g, S, E);
    }
    if (PH(2)) {
        pg8::Gemm g{WSP(bf16_t, WS_MEMN), WSP(bf16_t, WS_WMKV), NB * MEML, 2048, 1024}; pg8::StaticOrder S; S.init(NB * MEML, 2048, G, (bx + G / 2) % G);
        EpiPlain E{WSP(bf16_t, WS_MKVRAW), 2048};
        pg8::gemm_phase(lds, g, S, E);
    }
    GRID_BAR();

    if (PH(3)) {
        pg8::Gemm g{WSP(bf16_t, WS_ACT), WSP(bf16_t, WS_WF1O), TOK, 1024, DFF}; pg8::StaticOrder S; S.init(TOK, 1024, G, bx);
        EpiResid E{INP(0), OUTP, WSP(bf16_t, WS_XB), WSP(float, WS_SSQ1), 0.5f};
        pg8::gemm_phase(lds, g, S, E);
    }
    if (PH(0)) {
        LANE_VARS();
        const bf16_t* mkvraw = WSP(bf16_t, WS_MKVRAW); bf16_t* mkn = WSP(bf16_t, WS_MKN); bf16_t* mvt = WSP(bf16_t, WS_MVT);
        const float* g_mem_k = INP(16); const float* g_mem_q = INP(15);
        for (int j = gw; j < NB * MEML * 4; j += NGW) {
            const int row = j >> 2, h = j & 3;
            const u32x2 w = *((const u32x2*)(mkvraw + (size_t)row * 2048 + h * 256) + lane);
            f32x4 v = (f32x4){__uint_as_float(w.x << 16), __uint_as_float(w.x & 0xffff0000u), __uint_as_float(w.y << 16), __uint_as_float(w.y & 0xffff0000u)};
            const float ss = wave_sum((v[0] * v[0] + v[1] * v[1]) + (v[2] * v[2] + v[3] * v[3]));
            const float rn = __builtin_amdgcn_rsqf(ss * (1.0f / 256.0f) + EPS);
            const f32x4 gk = *((const f32x4*)g_mem_k + lane), gq = *((const f32x4*)g_mem_q + lane);
            *((u32x2*)(mkn + (size_t)row * 1024 + h * 256) + lane) = pack4(v * rn * gk * gq);
        }
        for (int idx = gt; idx < NB * 4 * 256 * 256; idx += NGT) {
            const int key = idx & 255, d = (idx >> 8) & 255, bh = idx >> 16, b = bh >> 2, h = bh & 3;
            mvt[idx] = mkvraw[(size_t)(b * 256 + key) * 2048 + 1024 + h * 256 + d];
        }
    }
    GRID_BAR();

    for (int gb = 0; gb < NB; ++gb) {
        if (PH(4)) {
            pg8::Gemm g{WSP(bf16_t, WS_XB) + (size_t)gb * SEQ * DM, WSP(bf16_t, WS_WMIX), SEQ, NMIX, 1024}; pg8::StaticOrder S; S.init(SEQ, NMIX, G, bx);
            prep_rs(WSP(float, WS_SSQ1), gb * SEQ, S, lds);
            EpiMix E{(const LAS float*)(lds + RTAB_OFF), WSP(float, WS_ROT), WSP(unsigned char, 0), INP(8), INP(9)};
            pg8::gemm_phase(lds, g, S, E);
        }
        GRID_BAR();
        for (int idx = bx; idx < 384; idx += G) {
            if (idx < 64) { if (PH(5)) scan_unit(idx >> 4, idx & 15, WSP(bf16_t, WS_KTS), WSP(bf16_t, WS_VT), WSP(bf16_t, WS_S)); }
            else if (idx < 320) {
                const int a = idx - 64, qb = 7 - (a >> 5), rem = a & 31, hc = rem >> 1, vh = rem & 1, hh = hc >> 1, cc = hc & 1;
                __syncthreads();
                if (PH(6)) attn_body::attn_unit<8>(hc, 2 * hh + vh, qb, WSP(const attn_body::bf16, WS_DQ), WSP(const attn_body::bf16, WS_DK), WSP(const attn_body::bf16, WS_DV),
                                        WSP(attn_body::bf16, (cc ? WS_O1 : WS_O0)), (char*)lds_raw);
            } else {
                const int m = idx - 320;
                __syncthreads();
                if (PH(7)) memattn_unit(gb, m >> 4, m & 15, WSP(bf16_t, WS_MQ), WSP(bf16_t, WS_MKN), WSP(bf16_t, WS_MVT), WSP(bf16_t, WS_MO) + (size_t)gb * SEQ * 1024, lds);
                __syncthreads();
            }
        }
        GRID_BAR();
        for (int idx = bx; idx < 256; idx += G) if (PH(8)) retout_unit(idx >> 6, (idx >> 2) & 15, idx & 3, WSP(bf16_t, WS_Q), WSP(bf16_t, WS_K), WSP(bf16_t, WS_VT), WSP(bf16_t, WS_S),
                                                                     WSP(bf16_t, WS_RET) + (size_t)gb * SEQ * 2048, lds);
        if (PH(0)) {
            LANE_VARS();
            const float s1 = wave_sum(INP(10)[lane] * INP(11)[lane]), s2 = wave_sum(INP(12)[lane] * INP(13)[lane]); const float lam = __expf(s1) - __expf(s2) + LAM_INIT;
            const bf16_t* bo0 = WSP(bf16_t, WS_O0); const bf16_t* bo1 = WSP(bf16_t, WS_O1); bf16_t* difb = WSP(bf16_t, WS_DIF); const float* gdo = INP(14);
            for (int r = gw; r < SEQ; r += NGW) dif_row(bo0 + (size_t)r * 1024, bo1 + (size_t)r * 1024, difb + ((size_t)gb * SEQ + r) * 1024, gdo, lam, lane);
            if (gb + 1 < NB) rot_table((const int*)karg(2) + (gb + 1) * SEQ, WSP(float, WS_ROT), gt, NGT);
        }
        GRID_BAR();
    }

    if (PH(9)) {
        pg8::Gemm g{WSP(bf16_t, WS_XB), WSP(bf16_t, WS_WRG), TOK, 2048, 1024}; pg8::StaticOrder S; S.init(TOK, 2048, G, bx);
        prep_rs(WSP(float, WS_SSQ1), 0, S, lds);
        EpiRg E{(const LAS float*)(lds + RTAB_OFF), WSP(bf16_t, WS_RET)};
        pg8::gemm_phase(lds, g, S, E);
    }
    if (PH(0)) {
        LANE_VARS();
        transpose_all(INP(7), 1024, 13312, WSP(bf16_t, WS_WGATE), 3072, ColIdent{10240}, INP(6), scr, gw, NGW, lane);
        transpose_all(INP(19), 2048, 1024, WSP(bf16_t, WS_WBRR), 1024, ColIdent{0}, nullptr, scr, gw, NGW, lane);
        transpose_all(INP(20), 1024, 1024, WSP(bf16_t, WS_WBRD), 1024, ColIdent{0}, nullptr, scr, gw, NGW, lane);
        transpose_all(INP(21), 1024, 1024, WSP(bf16_t, WS_WBRM), 1024, ColIdent{0}, nullptr, scr, gw, NGW, lane);
        transpose_all(INP(22), 1024, 1024, WSP(bf16_t, WS_WO), 1024, ColIdent{0}, nullptr, scr, gw, NGW, lane);
    }
    GRID_BAR();

    if (PH(10)) {
        pg8::StaticOrder S; S.init(TOK, 1024, G, bx);
        prep_rs(WSP(float, WS_SSQ1), 0, S, lds);
#pragma unroll 1
        for (int job = 0; job < 6; ++job) {
            const int kbr = job >> 1, isterm = job & 1;
            const bf16_t* A = isterm ? (kbr == 0 ? WSP(bf16_t, WS_RET) : kbr == 1 ? WSP(bf16_t, WS_DIF) : WSP(bf16_t, WS_MO)) : WSP(bf16_t, WS_XB);
            const bf16_t* Bt = isterm ? (kbr == 0 ? WSP(bf16_t, WS_WBRR) : kbr == 1 ? WSP(bf16_t, WS_WBRD) : WSP(bf16_t, WS_WBRM)) : WSP(bf16_t, WS_WGATE) + (size_t)kbr * 1024 * 1024;
            pg8::Gemm g{A, Bt, TOK, 1024, (isterm && kbr == 0) ? 2048 : 1024};
            EpiP5 E{isterm, (const LAS float*)(lds + RTAB_OFF), WSP(bf16_t, WS_STASH), WSP(bf16_t, WS_Y), kbr == 0};
            pg8::gemm_phase(lds, g, S, E);
        }
    }
    GRID_BAR();

    if (PH(11)) {
        pg8::Gemm g{WSP(bf16_t, WS_Y), WSP(bf16_t, WS_WO), TOK, 1024, 1024}; pg8::StaticOrder S; S.init(TOK, 1024, G, bx);
        EpiResid E{OUTP, OUTP, WSP(bf16_t, WS_XB), WSP(float, WS_SSQ2), 1.0f};
        pg8::gemm_phase(lds, g, S, E);
    }
    if (PH(0)) {
        LANE_VARS();
        transpose_all(INP(24), 1024, 2 * DFF, WSP(bf16_t, WS_WF2I), 2 * DFF, ColSwiglu{}, INP(23), scr, gw, NGW, lane);
        transpose_all(INP(25), DFF, 1024, WSP(bf16_t, WS_WF2O), 1024, ColIdent{0}, nullptr, scr, gw, NGW, lane);
    }
    GRID_BAR();

    if (PH(12)) {
        pg8::Gemm g{WSP(bf16_t, WS_XB), WSP(bf16_t, WS_WF2I), TOK, 2 * DFF, 1024}; pg8::StaticOrder S; S.init(TOK, 2 * DFF, G, bx);
        prep_rs(WSP(float, WS_SSQ2), 0, S, lds);
        EpiSwiglu E{WSP(bf16_t, WS_ACT2), (const LAS float*)(lds + RTAB_OFF)};
        pg8::gemm_phase(lds, g, S, E);
    }
    GRID_BAR();

    if (PH(13)) {
        pg8::Gemm g{WSP(bf16_t, WS_ACT2), WSP(bf16_t, WS_WF2O), TOK, 1024, DFF}; pg8::StaticOrder S; S.init(TOK, 1024, G, bx);
        EpiResid E{OUTP, OUTP, nullptr, nullptr, 0.5f};
        pg8::gemm_phase(lds, g, S, E);
    }
}

extern "C" void kernel_launch(void* const* d_in, const int* in_sizes, int n_in, void* d_out, int out_size, void* d_ws, size_t ws_size, hipStream_t stream) {
    static int grid = 0;
    if (grid == 0) {
        if (n_in != 26 || ws_size < WS_END) { fprintf(stderr, "kernel_launch: unexpected inputs (n_in %d, ws %zu)\n", n_in, ws_size); grid = -1; return; }
        int dev = 0, cus = 0;
        if (hipGetDevice(&dev) != hipSuccess || hipDeviceGetAttribute(&cus, hipDeviceAttributeMultiprocessorCount, dev) != hipSuccess) { grid = -1; return; }
        if (hipFuncSetAttribute((const void*)mk_fwd, hipFuncAttributeMaxDynamicSharedMemorySize, LDS_BYTES) != hipSuccess) { fprintf(stderr, "kernel_launch: hipFuncSetAttribute failed\n"); grid = -1; return; }
        grid = cus;
    }
    if (grid < 0) return;
    (void)hipMemsetAsync((char*)d_ws + WS_CTL, 0, CTL_ZERO_BYTES, stream);
    Args a{};
    for (int i = 0; i < 26; ++i) a.in[i] = d_in[i];
    a.out = (float*)d_out; a.ws = (unsigned char*)d_ws;
    hipLaunchKernelGGL(mk_fwd, dim3(grid), dim3(NWAVES * 64), LDS_BYTES, stream, a);
}
```

```cpp
#include <hip/hip_runtime.h>
#include <cstdio>
#include <cstdint>

#define LAS __attribute__((address_space(3)))
#define GAS __attribute__((address_space(1)))
typedef unsigned short bf16_t;
typedef short bf16x8 __attribute__((ext_vector_type(8)));
typedef float f32x4 __attribute__((ext_vector_type(4)));
typedef float f32x2 __attribute__((ext_vector_type(2)));
typedef unsigned u32x4 __attribute__((ext_vector_type(4)));
typedef unsigned u32x2 __attribute__((ext_vector_type(2)));

constexpr int NB = 8, SEQ = 2048, DM = 1024, TOK = NB * SEQ, MEML = 256, DFF = 2816;
constexpr int NMIX = 8192;
constexpr float EPS = 1e-6f;
constexpr float LOG2E = 1.4426950408889634f;
constexpr float C2Q = 0.125f * LOG2E;
constexpr float LAM_INIT = 0.2f;

constexpr size_t MiB = 1u << 20;
constexpr size_t WS_CTL = 0, CTL_ZERO_BYTES = 1 * MiB;
constexpr size_t WS_SSQ1 = 1 * MiB, WS_SSQ2 = 2 * MiB;
constexpr size_t WS_MKN = 3 * MiB, WS_MVT = 7 * MiB;
constexpr size_t WS_WMIX = 11 * MiB;
constexpr size_t WS_XB = 27 * MiB;
constexpr size_t WS_RET = 59 * MiB;
constexpr size_t WS_DIF = 123 * MiB;
constexpr size_t WS_MO = 155 * MiB;
constexpr size_t WS_Q = 187 * MiB, WS_K = 191 * MiB, WS_KTS = 195 * MiB, WS_VT = 199 * MiB, WS_DQ = 207 * MiB, WS_DK = 211 * MiB,
                 WS_DV = 215 * MiB, WS_MQ = 219 * MiB, WS_O0 = 223 * MiB, WS_O1 = 227 * MiB, WS_S = 231 * MiB;
constexpr size_t WS_ROT = 247 * MiB;
constexpr size_t WS_WRG = 249 * MiB;
constexpr size_t WS_ACT = 59 * MiB;
constexpr size_t WS_WF1I = 147 * MiB, WS_WF1O = 158 * MiB;
constexpr size_t WS_MEMN = 164 * MiB, WS_MKVRAW = 168 * MiB, WS_WMKV = 176 * MiB;
constexpr size_t WS_WGATE = 11 * MiB, WS_WBRR = 17 * MiB, WS_WBRD = 21 * MiB, WS_WBRM = 23 * MiB, WS_WO = 25 * MiB;
constexpr size_t WS_Y = 187 * MiB, WS_STASH = 219 * MiB;
constexpr size_t WS_WF2I = 59 * MiB, WS_WF2O = 70 * MiB, WS_ACT2 = 76 * MiB;
constexpr size_t WS_END = 256 * MiB;

constexpr int CW_BAR = 4096;

constexpr int RING_BYTES = 131072, LDSCTL_OFF = RING_BYTES, MISC_OFF = LDSCTL_OFF + 320, LDS_BYTES = 147456;
constexpr int NWAVES = 8;

__device__ __forceinline__ unsigned cvt_pk_bf16(float lo, float hi) { unsigned r; asm volatile("v_cvt_pk_bf16_f32 %0, %1, %2" : "=v"(r) : "v"(lo), "v"(hi)); return r; }
__device__ __forceinline__ u32x2 pack4(f32x4 v) { u32x2 w; w.x = cvt_pk_bf16(v[0], v[1]); w.y = cvt_pk_bf16(v[2], v[3]); return w; }
__device__ __forceinline__ unsigned short bf16_1(float v) { return (unsigned short)(cvt_pk_bf16(v, 0.f) & 0xffffu); }
__device__ __forceinline__ float bf2f(unsigned short b) { return __uint_as_float(((unsigned)b) << 16); }
__device__ __forceinline__ float siluf(float x) { return x * __builtin_amdgcn_rcpf(1.0f + __builtin_amdgcn_exp2f(-x * LOG2E)); }
__device__ __forceinline__ float sigmf(float x) { return __builtin_amdgcn_rcpf(1.0f + __builtin_amdgcn_exp2f(-x * LOG2E)); }
__device__ __forceinline__ float row_rs(const float* ssq, int row) {
    const f32x4 a = *(const f32x4*)(ssq + (size_t)row * 4);
    return __builtin_amdgcn_rsqf(((a[0] + a[1]) + (a[2] + a[3])) * (1.0f / 1024.0f) + EPS);
}
__device__ __forceinline__ int opaque_tid() { int t = threadIdx.x; asm volatile("" : "+v"(t)); return t; }
__device__ __forceinline__ f32x4 mfma16(bf16x8 a, bf16x8 b, f32x4 c) { return __builtin_amdgcn_mfma_f32_16x16x32_bf16(a, b, c, 0, 0, 0); }

namespace pg8 {
constexpr int BM = 256, BK = 64, HALF = 128, HTB = HALF * BK * 2, STAGE_BYTES = 8 * HTB, NXCD = 8, WGM = 8;
__host__ __device__ __forceinline__ int lds_byte(int r, int c) { const int st = (r >> 4) * 2 + (c >> 5), rr = r & 15, cc = c & 31, ob = rr * 64 + cc * 2; return st * 1024 + (ob ^ (((ob >> 9) & 1) << 5)); }
__host__ __device__ __forceinline__ void stage_rc(int b, int& R, int& C) { const int st = b / 1024, sb = b % 1024, swz = sb ^ (((sb >> 9) & 1) << 5); R = (st >> 1) * 16 + swz / 64; C = (st & 1) * 32 + (swz % 64) / 2; }
struct Unit { int pm, pn, ui; };
struct Gemm { const bf16_t* A; const bf16_t* Bt; int M, N, K; };
struct StaticOrder {
    int nM, nN, nwg, G, c;
    __host__ __device__ void init(int M, int N, int G_, int c_) { nM = M / BM; nN = N / BM; nwg = nM * nN; G = G_; c = c_; }
    __host__ __device__ bool next(int i, Unit& u) const {
        const long L = (long)i * G + c; if (L >= nwg) return false;
        int wgid = (int)L; { const int q = nwg / NXCD, r = nwg % NXCD, xcd = wgid % NXCD, off = wgid / NXCD; wgid = (xcd < r ? xcd * (q + 1) : r * (q + 1) + (xcd - r) * q) + off; }
        const int nig = WGM * nN, gid = wgid / nig, fm = gid * WGM, gsz = (nM - fm) < WGM ? (nM - fm) : WGM;
        u.pm = fm + ((wgid % nig) % gsz); u.pn = (wgid % nig) / gsz; u.ui = i; return true;
    }
};
template <class Epi>
__device__ __forceinline__ void gemm_phase(LAS unsigned char* lds, const Gemm g, const StaticOrder& S, const Epi& E) {
    const int tid = opaque_tid(), wid = __builtin_amdgcn_readfirstlane(tid >> 6), lane = tid & 63, wr = wid >> 2, wc = wid & 3, fr = lane & 15, fq = lane >> 4;
    const int K = g.K, nt = K / BK;
    unsigned voffA[2];
#pragma unroll
    for (int i = 0; i < 2; ++i) { int R, C; stage_rc(tid * 16 + i * 8192, R, C); voffA[i] = (unsigned)(R * K + C) * 2u; }
    const size_t kstep = (size_t)(BK * 2);
    const size_t hstep = (size_t)HALF * K * 2;
    const size_t tstep = 2 * hstep;
    const unsigned ldsw = (unsigned)wid * 1024u;
    const int aoff = lds_byte(wr * 64 + fr, fq * 8), boff = lds_byte(wc * 32 + fr, fq * 8);
#define PG8_SA(b, h) (((b) * 2 + (h)) * HTB)
#define PG8_SB(b, h) ((4 + (b) * 2 + (h)) * HTB)
#define PG8_STAGE(bufoff, gbase, voff) do { _Pragma("unroll") for (int _i = 0; _i < 2; ++_i) \
        __builtin_amdgcn_global_load_lds((const unsigned*)((const char*)(gbase) + (voff)[_i]), (LAS unsigned*)(lds + (bufoff) + ldsw + _i * 8192), 16, 0, 0); } while (0)
#define PG8_LDA(dst, b, h) do { _Pragma("unroll") for (int m = 0; m < 4; ++m) _Pragma("unroll") for (int k = 0; k < 2; ++k) dst[m][k] = *(const LAS bf16x8*)(lds + PG8_SA(b, h) + aoff + m * 2048 + k * 1024); } while (0)
#define PG8_LDB(dst, b, h) do { _Pragma("unroll") for (int n = 0; n < 2; ++n) _Pragma("unroll") for (int k = 0; k < 2; ++k) dst[n][k] = *(const LAS bf16x8*)(lds + PG8_SB(b, h) + boff + n * 2048 + k * 1024); } while (0)
#define PG8_MMA(ai, bj, At, Bt) do { __builtin_amdgcn_s_setprio(1); _Pragma("unroll") for (int m = 0; m < 4; ++m) _Pragma("unroll") for (int n = 0; n < 2; ++n) _Pragma("unroll") for (int k = 0; k < 2; ++k) \
        acc[ai][bj][m][n] = __builtin_amdgcn_mfma_f32_16x16x32_bf16(Bt[n][k], At[m][k], acc[ai][bj][m][n], 0, 0, 0); __builtin_amdgcn_s_setprio(0); } while (0)
#define PG8_WAIT_V(n) asm volatile("s_waitcnt vmcnt(" #n ")" ::: "memory")
#define PG8_WAIT_L(n) asm volatile("s_waitcnt lgkmcnt(" #n ")" ::: "memory")
#define PG8_BAR __builtin_amdgcn_s_barrier()
#define PG8_SCHED __builtin_amdgcn_sched_barrier(0)
    Unit cur, nxt; int ui = 0;
    if (!S.next(0, cur)) return;
    f32x4 acc[2][2][4][2];
#pragma unroll
    for (int a = 0; a < 2; ++a)
#pragma unroll
        for (int b = 0; b < 2; ++b)
#pragma unroll
            for (int m = 0; m < 4; ++m)
#pragma unroll
                for (int n = 0; n < 2; ++n) acc[a][b][m][n] = (f32x4){0.f, 0.f, 0.f, 0.f};
    bf16x8 At[4][2], B0[2][2], B1[2][2];
    const char* cA = (const char*)g.A + (size_t)cur.pm * tstep; const char* cB = (const char*)g.Bt + (size_t)cur.pn * tstep;
    PG8_STAGE(PG8_SB(0, 0), cB, voffA); PG8_STAGE(PG8_SB(0, 1), cB + hstep, voffA); PG8_STAGE(PG8_SA(0, 0), cA, voffA); PG8_STAGE(PG8_SA(0, 1), cA + hstep, voffA);
    if (wr == 1) PG8_BAR;
    PG8_WAIT_V(2); PG8_BAR;
    PG8_STAGE(PG8_SB(1, 0), cB + kstep, voffA); PG8_STAGE(PG8_SA(1, 0), cA + kstep, voffA); PG8_STAGE(PG8_SB(1, 1), cB + hstep + kstep, voffA);
    PG8_WAIT_V(6); PG8_BAR;
    for (;;) {
        const bool has_next = S.next(ui + 1, nxt);
        const char* nA = has_next ? (const char*)g.A + (size_t)nxt.pm * tstep : cA; const char* nB = has_next ? (const char*)g.Bt + (size_t)nxt.pn * tstep : cB;
        for (int t = 0; t < nt; t += 2) {
            const bool last = (t == nt - 2);
            const char* a1 = cA + (size_t)(t + 1) * kstep;
            const char* a2 = last ? nA : cA + (size_t)(t + 2) * kstep; const char* b2 = last ? nB : cB + (size_t)(t + 2) * kstep;
            const char* a3 = a2 + kstep; const char* b3 = b2 + kstep;
            PG8_LDB(B0, 0, 0); PG8_LDB(B1, 0, 1); PG8_SCHED; PG8_LDA(At, 0, 0); PG8_STAGE(PG8_SA(1, 1), a1 + hstep, voffA);
            PG8_WAIT_V(8); PG8_WAIT_L(0); PG8_BAR; PG8_MMA(0, 0, At, B0); PG8_MMA(0, 1, At, B1); PG8_BAR; PG8_SCHED;
            PG8_LDA(At, 0, 1); PG8_STAGE(PG8_SB(0, 0), b2, voffA); PG8_STAGE(PG8_SB(0, 1), b2 + hstep, voffA); PG8_STAGE(PG8_SA(0, 0), a2, voffA);
            PG8_WAIT_V(8); PG8_WAIT_L(0); PG8_BAR; PG8_MMA(1, 0, At, B0); PG8_MMA(1, 1, At, B1); PG8_BAR; PG8_SCHED;
            PG8_LDB(B0, 1, 0); PG8_LDB(B1, 1, 1); PG8_SCHED; PG8_LDA(At, 1, 0); PG8_STAGE(PG8_SA(0, 1), a2 + hstep, voffA);
            PG8_WAIT_V(8); PG8_WAIT_L(0); PG8_BAR; PG8_MMA(0, 0, At, B0); PG8_MMA(0, 1, At, B1); PG8_BAR; PG8_SCHED;
            PG8_LDA(At, 1, 1); PG8_STAGE(PG8_SB(1, 0), b3, voffA); PG8_STAGE(PG8_SB(1, 1), b3 + hstep, voffA); PG8_STAGE(PG8_SA(1, 0), a3, voffA);
            PG8_WAIT_V(8); PG8_WAIT_L(0); PG8_BAR; PG8_MMA(1, 0, At, B0); PG8_MMA(1, 1, At, B1); PG8_BAR; PG8_SCHED;
        }
        if (wr == 0) PG8_BAR;
        if (!Epi::AFTER_DRAIN || has_next) { int fr2 = fr, fq2 = fq; asm volatile("" : "+v"(fr2), "+v"(fq2)); E(acc, cur, wr, wc, fr2, fq2); }
        if (!has_next) break;
#pragma unroll
        for (int a = 0; a < 2; ++a)
#pragma unroll
            for (int b = 0; b < 2; ++b)
#pragma unroll
                for (int m = 0; m < 4; ++m)
#pragma unroll
                    for (int n = 0; n < 2; ++n) acc[a][b][m][n] = (f32x4){0.f, 0.f, 0.f, 0.f};
        cur = nxt; cA = nA; cB = nB; ++ui;
        if (wr == 1) PG8_BAR;
    }
    PG8_WAIT_V(0);
    PG8_BAR;
    if constexpr (Epi::AFTER_DRAIN) { int fr2 = fr, fq2 = fq; asm volatile("" : "+v"(fr2), "+v"(fq2)); E.fused(acc, cur, wr, wc, fr2, fq2, lds); }
#undef PG8_SA
#undef PG8_SB
#undef PG8_STAGE
#undef PG8_LDA
#undef PG8_LDB
#undef PG8_MMA
#undef PG8_WAIT_V
#undef PG8_WAIT_L
#undef PG8_BAR
#undef PG8_SCHED
}
}

__device__ __forceinline__ float wave_sum(float v);
#define ACC_ARG const f32x4 (&acc)[2][2][4][2]
#define EPI_FENCE() asm volatile("" ::: "memory")
constexpr int RTAB_OFF = RING_BYTES + 1024;
__device__ __forceinline__ void prep_rs(const float* ssq, int row_off, const pg8::StaticOrder& S, LAS unsigned char* lds) {
    const int tid = opaque_tid(); LAS float* rtab = (LAS float*)(lds + RTAB_OFF); pg8::Unit u;
    for (int i = 0; i < 6 && S.next(i, u); ++i) if (tid < 256) rtab[i * 256 + tid] = row_rs(ssq, row_off + u.pm * 256 + tid);
    __syncthreads();
}
struct EpiSwiglu {
    static constexpr bool AFTER_DRAIN = false;
    bf16_t* O; const LAS float* rtab;
    __device__ __forceinline__ void operator()(ACC_ARG, const pg8::Unit& u, int wr, int wc, int fr, int fq) const {
        const int lr0 = wr * 64 + fr, col0 = u.pn * 128 + wc * 32 + 4 * fq;
#pragma unroll
        for (int ai = 0; ai < 2; ++ai)
#pragma unroll
            for (int m = 0; m < 4; ++m) {
                const int lr = lr0 + ai * 128 + m * 16;
                const float rs = rtab ? rtab[u.ui * 256 + lr] : 1.0f;
#pragma unroll
                for (int n = 0; n < 2; ++n) {
                    const f32x4 gt = acc[ai][0][m][n] * rs, up = acc[ai][1][m][n] * rs; f32x4 v;
#pragma unroll
                    for (int j = 0; j < 4; ++j) v[j] = siluf(gt[j]) * up[j];
                    *(u32x2*)(O + (size_t)(u.pm * 256 + lr) * DFF + col0 + n * 16) = pack4(v);
                }
            }
    }
};
struct EpiResid {
    static constexpr bool AFTER_DRAIN = true;
    const float* base; float* out; bf16_t* xb; float* ssq; float scale; int skip;
    __device__ __forceinline__ void operator()(ACC_ARG, const pg8::Unit& u, int wr, int wc, int fr, int fq) const {
        if (skip) return;
        const int row0 = u.pm * 256 + wr * 64 + fr, col0 = u.pn * 256 + wc * 32 + 4 * fq;
#pragma unroll
        for (int ai = 0; ai < 2; ++ai)
#pragma unroll
            for (int m = 0; m < 4; ++m) {
                const int row = row0 + ai * 128 + m * 16; float ss = 0.f;
#pragma unroll
                for (int bj = 0; bj < 2; ++bj)
#pragma unroll
                    for (int n = 0; n < 2; ++n) {
                        const size_t off = (size_t)row * DM + col0 + bj * 128 + n * 16;
                        const f32x4 v = *(const f32x4*)(base + off) + acc[ai][bj][m][n] * scale;
                        *(f32x4*)(out + off) = v;
                        if (xb) *(u32x2*)(xb + off) = pack4(v);
                        ss += (v[0] * v[0] + v[1] * v[1]) + (v[2] * v[2] + v[3] * v[3]);
                    }
                if (ssq) { ss += __shfl_xor(ss, 16); ss += __shfl_xor(ss, 32); if (fq == 0) atomicAdd(ssq + (size_t)row * 4 + u.pn, ss); }
            }
    }
    __device__ __forceinline__ void fused(ACC_ARG, const pg8::Unit& u, int wr, int wc, int fr, int fq, LAS unsigned char* lds) const {
        if (skip) return;
        const int tid = opaque_tid(), lane = tid & 63, wave = __builtin_amdgcn_readfirstlane(tid >> 6);
        LAS float* tl = (LAS float*)lds;
#pragma unroll
        for (int ai = 0; ai < 2; ++ai)
#pragma unroll
            for (int wq = 0; wq < 2; ++wq) {
                if (wr == wq) {
#pragma unroll
                    for (int m = 0; m < 4; ++m)
#pragma unroll
                        for (int bj = 0; bj < 2; ++bj)
#pragma unroll
                            for (int n = 0; n < 2; ++n) *(LAS f32x4*)(tl + (16 * m + fr) * 260 + bj * 128 + wc * 32 + n * 16 + 4 * fq) = acc[ai][bj][m][n] * scale;
                }
                __syncthreads();
                const int rbase = u.pm * 256 + ai * 128 + wq * 64;
                f32x4 bv[8];
#pragma unroll
                for (int r = 0; r < 8; ++r) bv[r] = *(const f32x4*)(base + (size_t)(rbase + wave * 8 + r) * DM + u.pn * 256 + lane * 4);
#pragma unroll
                for (int r = 0; r < 8; ++r) {
                    const int row = rbase + wave * 8 + r; const size_t off = (size_t)row * DM + u.pn * 256 + lane * 4;
                    const f32x4 v = bv[r] + *(const LAS f32x4*)(tl + (wave * 8 + r) * 260 + lane * 4);
                    *(f32x4*)(out + off) = v;
                    if (xb) *(u32x2*)(xb + off) = pack4(v);
                    if (ssq) { const float ss = wave_sum((v[0] * v[0] + v[1] * v[1]) + (v[2] * v[2] + v[3] * v[3])); if (lane == 0) ssq[(size_t)row * 4 + u.pn] = ss; }
                }
                __syncthreads();
            }
    }
};
struct EpiPlain {
    static constexpr bool AFTER_DRAIN = false;
    bf16_t* O; int ldo;
    __device__ __forceinline__ void operator()(ACC_ARG, const pg8::Unit& u, int wr, int wc, int fr, int fq) const {
        const int row0 = u.pm * 256 + wr * 64 + fr, col0 = u.pn * 256 + wc * 32 + 4 * fq;
#pragma unroll
        for (int ai = 0; ai < 2; ++ai)
#pragma unroll
            for (int m = 0; m < 4; ++m)
#pragma unroll
                for (int bj = 0; bj < 2; ++bj)
#pragma unroll
                    for (int n = 0; n < 2; ++n) *(u32x2*)(O + (size_t)(row0 + ai * 128 + m * 16) * ldo + col0 + bj * 128 + n * 16) = pack4(acc[ai][bj][m][n]);
    }
};
struct EpiMix {
    static constexpr bool AFTER_DRAIN = false;
    const LAS float* rtab; const float* rot;
    unsigned char* ws; const float *gdq, *gdk;
    __device__ __forceinline__ void operator()(ACC_ARG, const pg8::Unit& u, int wr, int wc, int fr, int fq) const {
        const int pn = u.pn, lr0 = wr * 64 + fr, lrow0 = u.pm * 256 + lr0;
        if (pn < 8) {
            const bool isk = pn >= 4; const int h = pn & 3; bf16_t* dst = (bf16_t*)(ws + (isk ? WS_K : WS_Q)); bf16_t* kts = (bf16_t*)(ws + WS_KTS);
            const float lg2 = log2f(1.0f - __builtin_amdgcn_exp2f(-5.0f - (float)h));
#pragma unroll
            for (int ai = 0; ai < 2; ++ai) {
                f32x4 cs0[4][2], cs1[4][2];
#pragma unroll
                for (int m = 0; m < 4; ++m)
#pragma unroll
                    for (int n = 0; n < 2; ++n) { const f32x4* cs = (const f32x4*)(rot + ((size_t)(lrow0 + ai * 128 + m * 16) * 128 + wc * 32 + n * 16 + 4 * fq) * 2); cs0[m][n] = cs[0]; cs1[m][n] = cs[1]; }
                EPI_FENCE();
#pragma unroll
                for (int m = 0; m < 4; ++m) {
                    int lrow = lrow0 + ai * 128 + m * 16; asm volatile("" : "+v"(lrow));
                    const float rs = rtab[u.ui * 256 + lr0 + ai * 128 + m * 16] * (isk ? 0.0625f : 1.0f);
                    const float dec = __builtin_amdgcn_exp2f(lg2 * (float)(127 - (lrow & 127)));
#pragma unroll
                    for (int n = 0; n < 2; ++n) {
                        const int i0 = wc * 32 + n * 16 + 4 * fq;
                        const f32x4 c01 = cs0[m][n], c23 = cs1[m][n];
                        const f32x4 cv = (f32x4){c01[0], c01[2], c23[0], c23[2]}, sv = (f32x4){c01[1], c01[3], c23[1], c23[3]};
                        const f32x4 x1 = acc[ai][0][m][n] * rs, x2 = acc[ai][1][m][n] * rs;
                        const f32x4 o1 = x1 * cv - x2 * sv, o2 = x1 * sv + x2 * cv;
                        *(u32x2*)(dst + (size_t)lrow * 1024 + h * 256 + i0) = pack4(o1);
                        *(u32x2*)(dst + (size_t)lrow * 1024 + h * 256 + 128 + i0) = pack4(o2);
                        if (isk) {
#pragma unroll
                            for (int j = 0; j < 4; ++j) {
                                kts[(size_t)(h * 256 + i0 + j) * SEQ + lrow] = bf16_1(o1[j] * dec);
                                kts[(size_t)(h * 256 + 128 + i0 + j) * SEQ + lrow] = bf16_1(o2[j] * dec);
                            }
                        }
                    }
                }
                EPI_FENCE();
            }
        } else if (pn < 16) {
            const int h = (pn - 8) >> 1, e0 = ((pn - 8) & 1) * 256; bf16_t* vt = (bf16_t*)(ws + WS_VT);
#pragma unroll
            for (int ai = 0; ai < 2; ++ai)
#pragma unroll
                for (int m = 0; m < 4; ++m) {
                    int lrow = lrow0 + ai * 128 + m * 16; asm volatile("" : "+v"(lrow));
                    const float rs = rtab[u.ui * 256 + lr0 + ai * 128 + m * 16];
#pragma unroll
                    for (int bj = 0; bj < 2; ++bj)
#pragma unroll
                        for (int n = 0; n < 2; ++n) {
                            const int ec = e0 + bj * 128 + wc * 32 + n * 16 + 4 * fq; const f32x4 v = acc[ai][bj][m][n] * rs;
#pragma unroll
                            for (int j = 0; j < 4; ++j) vt[(size_t)(h * 512 + ec + j) * SEQ + lrow] = bf16_1(v[j]);
                        }
                    EPI_FENCE();
                }
        } else if (pn < 24) {
            const bool isk = pn >= 20; const int tile = (pn - 16) & 3; bf16_t* dst = (bf16_t*)(ws + (isk ? WS_DK : WS_DQ)); const float* gn = isk ? gdk : gdq; const float mul = isk ? 1.0f : C2Q;
            f32x4 gv[2][2];
#pragma unroll
            for (int bj = 0; bj < 2; ++bj)
#pragma unroll
                for (int n = 0; n < 2; ++n) gv[bj][n] = *(const f32x4*)(gn + 32 * bj + 16 * n + 4 * fq);
#pragma unroll
            for (int ai = 0; ai < 2; ++ai)
#pragma unroll
                for (int m = 0; m < 4; ++m) {
                    int lrow = lrow0 + ai * 128 + m * 16; asm volatile("" : "+v"(lrow));
                    const float rs = rtab[u.ui * 256 + lr0 + ai * 128 + m * 16];
                    f32x4 v[2][2]; float ss = 0.f;
#pragma unroll
                    for (int bj = 0; bj < 2; ++bj)
#pragma unroll
                        for (int n = 0; n < 2; ++n) { v[bj][n] = acc[ai][bj][m][n] * rs; const f32x4 t = v[bj][n]; ss += (t[0] * t[0] + t[1] * t[1]) + (t[2] * t[2] + t[3] * t[3]); }
                    ss += __shfl_xor(ss, 16); ss += __shfl_xor(ss, 32);
                    const float rn = __builtin_amdgcn_rsqf(ss * (1.0f / 64.0f) + EPS) * mul;
#pragma unroll
                    for (int bj = 0; bj < 2; ++bj)
#pragma unroll
                        for (int n = 0; n < 2; ++n)
                            *(u32x2*)(dst + (size_t)lrow * 1024 + tile * 256 + 64 * wc + 32 * bj + 16 * n + 4 * fq) = pack4(v[bj][n] * rn * gv[bj][n]);
                    EPI_FENCE();
                }
        } else {
            bf16_t* dst = (bf16_t*)(ws + (pn < 28 ? WS_DV : WS_MQ)); const int tile = (pn - 24) & 3;
#pragma unroll
            for (int ai = 0; ai < 2; ++ai)
#pragma unroll
                for (int m = 0; m < 4; ++m) {
                    int lrow = lrow0 + ai * 128 + m * 16; asm volatile("" : "+v"(lrow));
                    const float rs = rtab[u.ui * 256 + lr0 + ai * 128 + m * 16];
#pragma unroll
                    for (int bj = 0; bj < 2; ++bj)
#pragma unroll
                        for (int n = 0; n < 2; ++n)
                            *(u32x2*)(dst + (size_t)lrow * 1024 + tile * 256 + bj * 128 + wc * 32 + n * 16 + 4 * fq) = pack4(acc[ai][bj][m][n] * rs);
                    EPI_FENCE();
                }
        }
    }
};
struct EpiRg {
    static constexpr bool AFTER_DRAIN = false;
    const LAS float* rtab; bf16_t* ret; const float* rssq;
    __device__ __forceinline__ void operator()(ACC_ARG, const pg8::Unit& u, int wr, int wc, int fr, int fq) const {
        const int lr0 = wr * 64 + fr, col0 = u.pn * 256 + wc * 32 + 4 * fq;
#pragma unroll
        for (int ai = 0; ai < 2; ++ai) {
            u32x2 rv[4][2][2]; f32x2 rq2[4];
#pragma unroll
            for (int m = 0; m < 4; ++m) { const int lr = lr0 + ai * 128 + m * 16;
                rq2[m] = *(const f32x2*)(rssq + (size_t)(u.pm * 256 + lr) * 8 + 2 * (u.pn >> 1));
#pragma unroll
                for (int bj = 0; bj < 2; ++bj)
#pragma unroll
                    for (int n = 0; n < 2; ++n) rv[m][bj][n] = *(const u32x2*)(ret + (size_t)(u.pm * 256 + lr) * 2048 + col0 + bj * 128 + n * 16); }
            EPI_FENCE();
#pragma unroll
            for (int m = 0; m < 4; ++m) {
                const int lr = lr0 + ai * 128 + m * 16; const float rs = rtab[u.ui * 256 + lr];
                const float rr = __builtin_amdgcn_rsqf((rq2[m][0] + rq2[m][1]) * (1.0f / 512.0f) + EPS);
#pragma unroll
                for (int bj = 0; bj < 2; ++bj)
#pragma unroll
                    for (int n = 0; n < 2; ++n) {
                        const u32x2 w = rv[m][bj][n]; const f32x4 a = acc[ai][bj][m][n] * rs; f32x4 v;
                        v[0] = __uint_as_float(w.x << 16) * siluf(a[0]); v[1] = __uint_as_float(w.x & 0xffff0000u) * siluf(a[1]);
                        v[2] = __uint_as_float(w.y << 16) * siluf(a[2]); v[3] = __uint_as_float(w.y & 0xffff0000u) * siluf(a[3]);
                        *(u32x2*)(ret + (size_t)(u.pm * 256 + lr) * 2048 + col0 + bj * 128 + n * 16) = pack4(v * rr);
                    }
            }
            EPI_FENCE();
        }
    }
};
struct EpiP5 {
    static constexpr bool AFTER_DRAIN = false;
    int kind; const LAS float* rtab; bf16_t* gbuf; bf16_t* y; int first;
    __device__ __forceinline__ void operator()(ACC_ARG, const pg8::Unit& u, int wr, int wc, int fr, int fq) const {
        const int lr0 = wr * 64 + fr, col0 = u.pn * 256 + wc * 32 + 4 * fq;
#pragma unroll
        for (int ai = 0; ai < 2; ++ai) {
            u32x2 gv[4][2][2], yv[4][2][2];
            if (kind != 0) {
#pragma unroll
                for (int m = 0; m < 4; ++m)
#pragma unroll
                    for (int bj = 0; bj < 2; ++bj)
#pragma unroll
                        for (int n = 0; n < 2; ++n) { const size_t off = (size_t)(u.pm * 256 + lr0 + ai * 128 + m * 16) * DM + col0 + bj * 128 + n * 16;
                            gv[m][bj][n] = *(const u32x2*)(gbuf + off); yv[m][bj][n] = first ? (u32x2){0u, 0u} : *(const u32x2*)(y + off); }
            }
            EPI_FENCE();
#pragma unroll
            for (int m = 0; m < 4; ++m) {
                const int lr = lr0 + ai * 128 + m * 16; const float rs = rtab[u.ui * 256 + lr];
#pragma unroll
                for (int bj = 0; bj < 2; ++bj)
#pragma unroll
                    for (int n = 0; n < 2; ++n) {
                        const size_t off = (size_t)(u.pm * 256 + lr) * DM + col0 + bj * 128 + n * 16;
                        const f32x4 a = acc[ai][bj][m][n]; f32x4 v;
                        if (kind == 0) {
#pragma unroll
                            for (int j = 0; j < 4; ++j) v[j] = sigmf(a[j] * rs);
                            *(u32x2*)(gbuf + off) = pack4(v);
                        } else {
                            const u32x2 gw = gv[m][bj][n], w = yv[m][bj][n];
                            v[0] = __uint_as_float(gw.x << 16) * a[0] + __uint_as_float(w.x << 16); v[1] = __uint_as_float(gw.x & 0xffff0000u) * a[1] + __uint_as_float(w.x & 0xffff0000u);
                            v[2] = __uint_as_float(gw.y << 16) * a[2] + __uint_as_float(w.y << 16); v[3] = __uint_as_float(gw.y & 0xffff0000u) * a[3] + __uint_as_float(w.y & 0xffff0000u);
                            *(u32x2*)(y + off) = pack4(v);
                        }
                    }
            }
            EPI_FENCE();
        }
    }
};

#include <hip/hip_bf16.h>
namespace attn_body {
using bf16=__hip_bfloat16;
using bf16x8=__attribute__((ext_vector_type(8)))short;
using s16x4=__attribute__((ext_vector_type(4)))short;
using f32x16=__attribute__((ext_vector_type(16)))float;
using u32x4=__attribute__((ext_vector_type(4)))unsigned;
constexpr int D=64,DM=1024;
constexpr int NW=8,QBLK=32,QB=QBLK*NW,KVBLK=64;
__device__ __forceinline__ int crow(int r,int hi){return (r&3)+8*(r>>2)+4*hi;}
#define SBAR() __builtin_amdgcn_sched_barrier(0)
__device__ __forceinline__ void cmask(f32x16&p0,f32x16&p1,int jb,int qrel,int hi){
  const float NEG=-INFINITY; int kb=64*jb+4*hi;
  #pragma unroll
  for(int r=0;r<16;++r){int kv=kb+(r&3)+8*(r>>2); if(kv>qrel)p0[r]=NEG; if(kv+32>qrel)p1[r]=NEG;}
}
constexpr int NSLOT=3, SLOTB=8192;
constexpr int LDS_K=0, LDS_V=NSLOT*SLOTB, LDS_WS=2*NSLOT*SLOTB, LDS_OST=LDS_WS+NW*64*4, LDS_BYTES=LDS_OST+NW*4096;
__device__ __forceinline__ void glds16(const void*gsrc,unsigned lds_dst){unsigned keep;
  asm volatile("s_mov_b32 %0, m0\n\ts_mov_b32 m0, %2\n\ts_nop 0\n\tglobal_load_lds_dwordx4 %1, off\n\ts_mov_b32 m0, %0":"=&s"(keep):"v"(gsrc),"s"(lds_dst):"memory");}
__device__ __forceinline__ float max3f(float a,float b,float c){float r;asm("v_max3_f32 %0, %1, %2, %3":"=v"(r):"v"(a),"v"(b),"v"(c));return r;}
__device__ __forceinline__ float max2f(float a,float b){float r;asm("v_max_f32_e32 %0, %1, %2":"=v"(r):"v"(a),"v"(b));return r;}
__device__ __forceinline__ float fadd_s(float a,float b){float r;asm("v_add_f32_e32 %0, %1, %2":"=v"(r):"v"(a),"v"(b));return r;}
__device__ __forceinline__ float fsub_s(float a,float b){float r;asm("v_sub_f32_e32 %0, %1, %2":"=v"(r):"v"(a),"v"(b));return r;}
typedef float f32x2_t __attribute__((ext_vector_type(2))); typedef __bf16 bf16x2_t __attribute__((ext_vector_type(2)));
__device__ __forceinline__ unsigned cvtpk_s(float lo,float hi){f32x2_t v={lo,hi};bf16x2_t b=__builtin_convertvector(v,bf16x2_t);return __builtin_bit_cast(unsigned,b);}
#define WAIT_BAR(N) asm volatile("s_waitcnt vmcnt(" #N ") lgkmcnt(0)\n\ts_barrier":::"memory")
__device__ __forceinline__ void qkt(f32x16&p0,f32x16&p1,const char*Kslot,const bf16x8*qr,const f32x16&negm,int r32,int hi){
  const char*kb=Kslot+hi*1024+r32*16;
  #pragma unroll
  for(int d0=0;d0<4;++d0){
    const bf16x8 b0=*reinterpret_cast<const bf16x8*>(kb+d0*2048);
    const bf16x8 b1=*reinterpret_cast<const bf16x8*>(kb+d0*2048+512);
    if(d0==0){p0=__builtin_amdgcn_mfma_f32_32x32x16_bf16(b0,qr[0],negm,0,0,0);p1=__builtin_amdgcn_mfma_f32_32x32x16_bf16(b1,qr[0],negm,0,0,0);}
    else{p0=__builtin_amdgcn_mfma_f32_32x32x16_bf16(b0,qr[d0],p0,0,0,0);p1=__builtin_amdgcn_mfma_f32_32x32x16_bf16(b1,qr[d0],p1,0,0,0);}}
}
typedef __attribute__((address_space(3))) const char* lds_cptr;
typedef short v4i16_t __attribute__((ext_vector_type(4)));
__device__ __forceinline__ void kload8(bf16x8*kf,lds_cptr kp){
  kf[0]=*(const __attribute__((address_space(3))) bf16x8*)(kp);      kf[1]=*(const __attribute__((address_space(3))) bf16x8*)(kp+512);
  kf[2]=*(const __attribute__((address_space(3))) bf16x8*)(kp+2048); kf[3]=*(const __attribute__((address_space(3))) bf16x8*)(kp+2560);
  kf[4]=*(const __attribute__((address_space(3))) bf16x8*)(kp+4096); kf[5]=*(const __attribute__((address_space(3))) bf16x8*)(kp+4608);
  kf[6]=*(const __attribute__((address_space(3))) bf16x8*)(kp+6144); kf[7]=*(const __attribute__((address_space(3))) bf16x8*)(kp+6656);
}
__device__ __forceinline__ void kload2(bf16x8*kf,lds_cptr kp,int j){ kf[2*j]=*(const __attribute__((address_space(3))) bf16x8*)(kp+j*2048); kf[2*j+1]=*(const __attribute__((address_space(3))) bf16x8*)(kp+j*2048+512); }
__device__ __forceinline__ s16x4 vtr(lds_cptr p){ return __builtin_bit_cast(s16x4,__builtin_amdgcn_ds_read_tr16_b64_v4i16((__attribute__((address_space(3))) v4i16_t*)p)); }
__device__ __forceinline__ float rowmax(const f32x16&p0,const f32x16&p1){
  float a=max3f(p0[0],p0[1],p1[0]),b=max3f(p0[2],p0[3],p1[1]);a=max3f(a,p1[2],p1[3]);
  #pragma unroll
  for(int r=4;r<16;r+=4){a=max3f(a,p0[r],p0[r+1]);b=max3f(b,p0[r+2],p0[r+3]);a=max3f(a,p1[r],p1[r+1]);b=max3f(b,p1[r+2],p1[r+3]);}
  const float m=max2f(a,b);
  auto rr=__builtin_amdgcn_permlane32_swap(__float_as_uint(m),__float_as_uint(m),false,false);
  return max2f(__uint_as_float(rr[0]),__uint_as_float(rr[1]));
}
__device__ __forceinline__ void pv(f32x16*o,int vb,bf16x8 pa0,bf16x8 pa1,bf16x8 pa2,bf16x8 pa3){
  #pragma unroll
  for(int d0=0;d0<2;++d0){s16x4 lo[4],hi[4];
    #pragma unroll
    for(int ks=0;ks<4;++ks){
      asm volatile("ds_read_b64_tr_b16 %0,%1 offset:%c2":"=&v"(lo[ks]):"v"(vb),"i"(d0*4096+ks*1024):"memory");
      asm volatile("ds_read_b64_tr_b16 %0,%1 offset:%c2":"=&v"(hi[ks]):"v"(vb),"i"(d0*4096+ks*1024+512):"memory");}
    asm volatile("s_waitcnt lgkmcnt(0)":::"memory");SBAR();
    #define PK(k) (bf16x8){lo[k][0],lo[k][1],lo[k][2],lo[k][3],hi[k][0],hi[k][1],hi[k][2],hi[k][3]}
    o[d0]=__builtin_amdgcn_mfma_f32_32x32x16_bf16(pa0,PK(0),o[d0],0,0,0);
    o[d0]=__builtin_amdgcn_mfma_f32_32x32x16_bf16(pa1,PK(1),o[d0],0,0,0);
    o[d0]=__builtin_amdgcn_mfma_f32_32x32x16_bf16(pa2,PK(2),o[d0],0,0,0);
    o[d0]=__builtin_amdgcn_mfma_f32_32x32x16_bf16(pa3,PK(3),o[d0],0,0,0);
    #undef PK
  }
}
#define ATTN_STORE16(p,v) (*(u32x4*)(p)=(v))
template<int THRL> __device__ __forceinline__ void attn_unit(int hq,int hv,int qb,const bf16*Q,const bf16*__restrict__ K,const bf16*__restrict__ V,bf16*O,char*shm){
  const int tid=opaque_tid(),lane=tid&63,r32=lane&31,hi=lane>>5; const int wid=__builtin_amdgcn_readfirstlane(tid>>6);
  const int q0=qb*QB;
  const bf16*Qw=Q+(long)(q0+wid*QBLK)*DM+hq*D;
  const bf16*Kh=K+hq*D,*Vh=V+hv*D;
  const unsigned lds0=(unsigned)(uintptr_t)shm;
  float*wsf=(float*)(shm+LDS_WS)+wid*64;
  const bf16*ksrc=Kh+(long)lane*DM+wid*8;
  const bf16*vsrc=Vh+(long)(16*(wid&3)+(lane>>2))*DM+(wid>>2)*32+(lane&3)*8;
  const unsigned kdst=lds0+LDS_K+wid*1024, vdst=lds0+LDS_V+wid*1024;
  #define DMA_K(t,slot) glds16(ksrc+(long)(t)*KVBLK*DM,(unsigned)__builtin_amdgcn_readfirstlane(kdst+(slot)))
  #define DMA_V(t,slot) glds16(vsrc+(long)(t)*KVBLK*DM,(unsigned)__builtin_amdgcn_readfirstlane(vdst+(slot)))
  const int vb0=(int)(lds0+LDS_V)+((lane>>4)&1)*32+(lane&3)*8+(4*hi+((lane&15)>>2))*64;
  const char*Kbase=shm+LDS_K; bf16x8 kf[8];
  const lds_cptr shm3=(lds_cptr)shm; const lds_cptr kp0=shm3+LDS_K+hi*1024+r32*16; const lds_cptr vp0=shm3+LDS_V+((lane>>4)&1)*32+(lane&3)*8+(4*hi+((lane&15)>>2))*64;
  const int NT=(q0+QB)/KVBLK;
  DMA_K(0,0);DMA_V(0,0);DMA_K(1,SLOTB);
  bf16x8 qr[4];
  #pragma unroll
  for(int d0=0;d0<4;++d0)qr[d0]=*reinterpret_cast<const bf16x8*>(&Qw[(long)r32*DM+d0*16+hi*8]);
  float mhat=0.f,l_reg=0.f;f32x16 o[2];o[0]=f32x16{};o[1]=f32x16{};f32x16 negm=f32x16{};asm volatile("":"+v"(negm));
  const int qrel=wid*QBLK+r32;
  #define CMASK(P0,P1,t) do{int jb_=(t)-(NT-4); if(jb_>=0)cmask(P0,P1,jb_,qrel,hi);}while(0)
  bool resc=false;
  #define START(P0,P1) do{ const float rm=rowmax(P0,P1); resc=false; \
    { const float dl=rm; mhat=fadd_s(mhat,dl); \
      _Pragma("unroll") for(int r=0;r<16;++r){P0[r]=fsub_s(P0[r],dl);P1[r]=fsub_s(P1[r],dl);} \
      _Pragma("unroll") for(int r=0;r<16;++r)negm[r]=-mhat; asm volatile("":"+v"(negm)); } \
    _Pragma("unroll") for(int r=0;r<16;++r)P0[r]=__builtin_amdgcn_exp2f(P0[r]); }while(0)
  #define RESC() do{ if(resc){ asm volatile("s_waitcnt lgkmcnt(0)":::"memory"); \
      _Pragma("unroll") for(int d_=0;d_<2;++d_) _Pragma("unroll") for(int r=0;r<16;++r)o[d_][r]*=wsf[crow(r,hi)]; } }while(0)
  f32x16 pA0,pA1,pB0,pB1;
  int sl_prev=0,sl_cur=0,sl_next=SLOTB;
  #define ROT() do{sl_prev=sl_cur;sl_cur=sl_next;sl_next=(sl_next==(NSLOT-1)*SLOTB)?0:sl_next+SLOTB;}while(0)
  DMA_K(2,2*SLOTB);
  WAIT_BAR(3);
  qkt(pA0,pA1,Kbase,qr,negm,r32,hi);asm volatile("s_nop 15\n\ts_nop 7":"+v"(pA0),"+v"(pA1));CMASK(pA0,pA1,0);
  START(pA0,pA1);
  _Pragma("unroll") for(int r=0;r<16;++r)pA1[r]=__builtin_amdgcn_exp2f(pA1[r]);
  WAIT_BAR(0);
  DMA_K(3,0);DMA_V(1,SLOTB);
  ROT();
  kload8(kf,kp0+sl_cur);
  WAIT_BAR(2);
  s16x4 vlo[8],vhi[8]; u32x4 pw0,pw1,pw2,pw3;
  #define PKW(P,B) cvtpk_s(P[B],P[B+1])
  #define PAF(k) __builtin_bit_cast(bf16x8,pw##k)
  #define VFR(i) (bf16x8){vlo[i][0],vlo[i][1],vlo[i][2],vlo[i][3],vhi[i][0],vhi[i][1],vhi[i][2],vhi[i][3]}
  #define PIN(x) asm volatile("":"+v"(x))
  #define MX3(a,b,c) __builtin_fmaxf(__builtin_fmaxf((a),(b)),(c))
  #define GAPA(MF,A0,A1,A2,A3,W0,W1,PW) do{ MF; sacc+=A0; sacc+=A1; sacc+=A2; sacc+=A3; PIN(sacc); W0; W1; PIN(PW); SBAR(); }while(0)
  #define EX(v) __builtin_amdgcn_exp2f(v)
  #define GAPB(MF,X,B) do{ MF; X[B]=EX(X[B]); X[B+1]=EX(X[B+1]); X[B+2]=EX(X[B+2]); X[B+3]=EX(X[B+3]); PIN(X); SBAR(); }while(0)
  #define VRD(i) do{ vlo[i]=vtr(vp_+(((i)>>2)*4096+((i)&3)*1024)); vhi[i]=vtr(vp_+(((i)>>2)*4096+((i)&3)*1024+512)); }while(0)
  #define KRD(G,j) do{ if(G){ kload2(kf,kp0+sl_next,j); SBAR(); } }while(0)
  #define STEP(C0,C1,P0,P1,t,GK,GV,GL) do{ SBAR(); \
    const lds_cptr vp_=vp0+sl_prev; \
    VRD(0); SBAR(); float sacc=(P0[0]+P0[1]); \
    GAPA(C0=__builtin_amdgcn_mfma_f32_32x32x16_bf16(kf[0],qr[0],negm,0,0,0), P0[2],P0[3],P0[4],P0[5],     pw0[0]=PKW(P0,0), pw0[1]=PKW(P0,2), pw0); \
    VRD(4); SBAR(); GAPA(C1=__builtin_amdgcn_mfma_f32_32x32x16_bf16(kf[1],qr[0],negm,0,0,0), P0[6],P0[7],P0[8],P0[9],     pw0[2]=PKW(P0,4), pw0[3]=PKW(P0,6), pw0); \
    VRD(1); SBAR(); GAPA(C0=__builtin_amdgcn_mfma_f32_32x32x16_bf16(kf[2],qr[1],C0,0,0,0),   P0[10],P0[11],P0[12],P0[13], pw1[0]=PKW(P0,8), pw1[1]=PKW(P0,10), pw1); \
    VRD(5); SBAR(); GAPA(C1=__builtin_amdgcn_mfma_f32_32x32x16_bf16(kf[3],qr[1],C1,0,0,0),   P0[14],P0[15],P1[0],P1[1],   pw1[2]=PKW(P0,12),pw1[3]=PKW(P0,14), pw1); \
    VRD(2); SBAR(); GAPA(C0=__builtin_amdgcn_mfma_f32_32x32x16_bf16(kf[4],qr[2],C0,0,0,0),   P1[2],P1[3],P1[4],P1[5],     pw2[0]=PKW(P1,0), pw2[1]=PKW(P1,2), pw2); \
    VRD(6); SBAR(); GAPA(C1=__builtin_amdgcn_mfma_f32_32x32x16_bf16(kf[5],qr[2],C1,0,0,0),   P1[6],P1[7],P1[8],P1[9],     pw2[2]=PKW(P1,4), pw2[3]=PKW(P1,6), pw2); \
    VRD(3); SBAR(); GAPA(C0=__builtin_amdgcn_mfma_f32_32x32x16_bf16(kf[6],qr[3],C0,0,0,0),   P1[10],P1[11],P1[12],P1[13], pw3[0]=PKW(P1,8), pw3[1]=PKW(P1,10), pw3); \
    VRD(7); SBAR(); GAPA(C1=__builtin_amdgcn_mfma_f32_32x32x16_bf16(kf[7],qr[3],C1,0,0,0),   P1[14],P1[15],0.f,0.f,       pw3[2]=PKW(P1,12),pw3[3]=PKW(P1,14), pw3); \
    l_reg+=sacc; \
    if(GK){DMA_K((t)+3,sl_cur);} if(GV){DMA_V((t)+1,sl_next);} \
    CMASK(C0,C1,t); \
    { float a=MX3(C0[0],C0[1],C1[0]),b=MX3(C0[2],C0[3],C1[1]); a=MX3(a,C1[2],C1[3]); \
      _Pragma("unroll") for(int r=4;r<16;r+=4){a=MX3(a,C0[r],C0[r+1]);b=MX3(b,C0[r+2],C0[r+3]);a=MX3(a,C1[r],C1[r+1]);b=MX3(b,C1[r+2],C1[r+3]);} \
      float rm=__builtin_fmaxf(a,b); { auto rr=__builtin_amdgcn_permlane32_swap(__float_as_uint(rm),__float_as_uint(rm),false,false); rm=__builtin_fmaxf(__uint_as_float(rr[0]),__uint_as_float(rr[1])); } \
      resc=false; \
      if(__builtin_expect(__any(rm>(float)THRL),0)){ const float dl=__builtin_fmaxf(rm,0.f); mhat+=dl; \
        _Pragma("unroll") for(int r=0;r<16;++r){C0[r]-=dl;C1[r]-=dl;} \
        _Pragma("unroll") for(int r=0;r<16;++r)negm[r]=-mhat; asm volatile("":"+v"(negm)); \
        const float f=__builtin_amdgcn_exp2f(-dl); l_reg*=f; if(hi==0)wsf[r32]=f; resc=true; } } \
    SBAR(); \
    GAPB(o[0]=__builtin_amdgcn_mfma_f32_32x32x16_bf16(PAF(0),VFR(0),o[0],0,0,0), C0,0); \
    GAPB(o[1]=__builtin_amdgcn_mfma_f32_32x32x16_bf16(PAF(0),VFR(4),o[1],0,0,0), C0,4); \
    KRD(GL,0); GAPB(o[0]=__builtin_amdgcn_mfma_f32_32x32x16_bf16(PAF(1),VFR(1),o[0],0,0,0), C0,8); \
    KRD(GL,1); GAPB(o[1]=__builtin_amdgcn_mfma_f32_32x32x16_bf16(PAF(1),VFR(5),o[1],0,0,0), C0,12); \
    KRD(GL,2); GAPB(o[0]=__builtin_amdgcn_mfma_f32_32x32x16_bf16(PAF(2),VFR(2),o[0],0,0,0), C1,0); \
    KRD(GL,3); GAPB(o[1]=__builtin_amdgcn_mfma_f32_32x32x16_bf16(PAF(2),VFR(6),o[1],0,0,0), C1,4); \
    GAPB(o[0]=__builtin_amdgcn_mfma_f32_32x32x16_bf16(PAF(3),VFR(3),o[0],0,0,0), C1,8); \
    GAPB(o[1]=__builtin_amdgcn_mfma_f32_32x32x16_bf16(PAF(3),VFR(7),o[1],0,0,0), C1,12); \
    }while(0)
  int t=1;
  #undef CMASK
  #define CMASK(P0,P1,t) do{}while(0)
  for(;t+5<NT;t+=2){
    STEP(pB0,pB1,pA0,pA1,t,true,true,true);     WAIT_BAR(2); RESC(); ROT();
    STEP(pA0,pA1,pB0,pB1,t+1,true,true,true);   WAIT_BAR(2); RESC(); ROT();
  }
  #undef CMASK
  #define CMASK(P0,P1,t) do{int jb_=(t)-(NT-4); if(jb_>=0)cmask(P0,P1,jb_,qrel,hi);}while(0)
  #define ENDW(tt) do{ if((tt)+3<NT){WAIT_BAR(2);} else if((tt)+2<NT){WAIT_BAR(1);} else {WAIT_BAR(0);} }while(0)
  for(;t+1<NT;t+=2){
    STEP(pB0,pB1,pA0,pA1,t,(t+3<NT),(t+1<NT),(t+1<NT));       ENDW(t);   RESC(); ROT();
    STEP(pA0,pA1,pB0,pB1,t+1,(t+4<NT),(t+2<NT),(t+2<NT));     ENDW(t+1); RESC(); ROT();
  }
  STEP(pB0,pB1,pA0,pA1,NT-1,false,false,false); RESC();
  { float sacc=pB0[0]+pB0[1]; _Pragma("unroll") for(int r=2;r<16;++r)sacc+=pB0[r]; _Pragma("unroll") for(int r=0;r<16;++r)sacc+=pB1[r]; l_reg+=sacc;
    pw0=(u32x4){PKW(pB0,0),PKW(pB0,2),PKW(pB0,4),PKW(pB0,6)};pw1=(u32x4){PKW(pB0,8),PKW(pB0,10),PKW(pB0,12),PKW(pB0,14)};pw2=(u32x4){PKW(pB1,0),PKW(pB1,2),PKW(pB1,4),PKW(pB1,6)};pw3=(u32x4){PKW(pB1,8),PKW(pB1,10),PKW(pB1,12),PKW(pB1,14)};
    SBAR(); pv(o,vb0+sl_cur,PAF(0),PAF(1),PAF(2),PAF(3)); }
  #undef PKW
  #undef PAF
  #undef VFR
  #undef PIN
  #undef MX3
  #undef GAPA
  #undef GAPB
  #undef EX
  #undef VRD
  #undef KRD
  #undef STEP
  #undef ENDW
  {auto rr=__builtin_amdgcn_permlane32_swap(__float_as_uint(l_reg),__float_as_uint(l_reg),false,false);l_reg=__uint_as_float(rr[0])+__uint_as_float(rr[1]);}
  if(hi==0)wsf[32+r32]=l_reg;asm volatile("s_waitcnt lgkmcnt(0)":::"memory");
  float rli[16];
  #pragma unroll
  for(int r=0;r<16;++r)rli[r]=__builtin_amdgcn_rcpf(wsf[32+crow(r,hi)]);
  bf16*Ow=O+(long)(q0+wid*QBLK)*DM+hv*D;
  { bf16*stg=(bf16*)(shm+LDS_OST)+wid*2048;
    #pragma unroll
    for(int r=0;r<16;++r){const int orow=crow(r,hi);
      #pragma unroll
      for(int d0=0;d0<2;++d0)stg[orow*64+d0*32+r32]=__float2bfloat16(o[d0][r]*rli[r]);}
    asm volatile("s_waitcnt lgkmcnt(0)":::"memory");
    #pragma unroll
    for(int i=0;i<4;++i){const int row=i*8+(lane>>3),ch=lane&7; const u32x4 v=*(const u32x4*)(stg+row*64+ch*8); ATTN_STORE16(Ow+(long)row*DM+ch*8,v);} }
  asm volatile("s_waitcnt lgkmcnt(0)\n\ts_barrier":::"memory");
  #undef DMA_K
  #undef DMA_V
  #undef CMASK
  #undef START
  #undef RESC
  #undef ROT
}
constexpr int ATTN_LDS_BYTES=LDS_BYTES;
#undef SBAR
#undef WAIT_BAR
}

typedef GAS unsigned gu32;
#define RLX_AGENT __ATOMIC_RELAXED, __HIP_MEMORY_SCOPE_AGENT
#define LDS_WAIT() asm volatile("s_waitcnt lgkmcnt(0)" ::: "memory")
#define XB_TMO      128
#define XB_XCNT(j)  (256  + 64 * (j))
#define XB_XSUB(j)  (1280 + 64 * (j))
#define XB_XGEN(j)  (2304 + 64 * (j))
#define XB_TOP      3328
#define XB_TOPGEN   3392
#define XCD_BAR_WORDS 3456
#define XB_SPIN_CAP (1u << 18)
__device__ __forceinline__ unsigned xb_ld(unsigned* p)              { return __hip_atomic_load(p, __ATOMIC_RELAXED, __HIP_MEMORY_SCOPE_AGENT); }
__device__ __forceinline__ unsigned xb_add(unsigned* p, unsigned v) { return __hip_atomic_fetch_add(p, v, __ATOMIC_RELAXED, __HIP_MEMORY_SCOPE_AGENT); }
__device__ __forceinline__ unsigned xb_xcc_id() { return (unsigned)__builtin_amdgcn_s_getreg((3 << 11) | 20) & 0xFu; }
#define XB_SPIN(cond, bar) do { unsigned _sp = 0; while (cond) { __builtin_amdgcn_s_sleep(1); \
    if ((++_sp & 255u) == 0u) { if (xb_ld(&(bar)[XB_TMO])) break; if (_sp > XB_SPIN_CAP) { atomicAdd(&(bar)[XB_TMO], 1u); break; } } } } while (0)
struct XcdBarrier { unsigned* bar; unsigned x; volatile LAS unsigned* st; };
__device__ __forceinline__ XcdBarrier xcd_barrier_post(unsigned* bar, volatile LAS unsigned* st) {
    XcdBarrier b; b.bar = bar; b.x = xb_xcc_id(); b.st = st;
    if (threadIdx.x == 0) (void)xb_add(&bar[XB_XCNT(b.x)], 1u);
    return b;
}
__device__ __forceinline__ void xcd_barrier_complete(unsigned* bar, unsigned x, unsigned& nloc, unsigned& nx) {
    const unsigned G = gridDim.x * gridDim.y * gridDim.z;
    unsigned sum, cnt, mine, sp = 0u;
    for (;;) {
        sum = 0u; cnt = 0u; mine = 0u;
#pragma unroll
        for (unsigned j = 0; j < 16; ++j) { const unsigned c = xb_ld(&bar[XB_XCNT(j)]); sum += c; cnt += (c > 0u) ? 1u : 0u; mine = (j == x) ? c : mine; }
        if (sum == G) break;
        __builtin_amdgcn_s_sleep(1);
        if ((++sp & 255u) == 0u) { if (xb_ld(&bar[XB_TMO])) break; if (sp > XB_SPIN_CAP) { atomicAdd(&bar[XB_TMO], 1u); break; } }
    }
    nloc = mine > 0u ? mine : 1u; nx = cnt > 0u ? cnt : 1u;
}
__device__ __forceinline__ void xcd_barrier(const XcdBarrier& b) {
    asm volatile("s_waitcnt vmcnt(0)" ::: "memory");
    __syncthreads();
    if (threadIdx.x == 0) {
        unsigned* bar = b.bar; asm volatile("" : "+v"(bar));
        __builtin_amdgcn_s_waitcnt(0);
        unsigned nloc = b.st[0], nx = b.st[1];
        if (nloc == 0u) { xcd_barrier_complete(bar, b.x, nloc, nx); b.st[0] = nloc; b.st[1] = nx; }
        const unsigned old = xb_add(&bar[XB_XSUB(b.x)], 1u);
        const unsigned gen = old / nloc;
        if (old + 1u == (gen + 1u) * nloc) {
            __builtin_amdgcn_fence(__ATOMIC_RELEASE, "agent");
            asm volatile("s_waitcnt vmcnt(0)" ::: "memory");
            const unsigned og = xb_add(&bar[XB_TOP], 1u);
            const unsigned tg = og / nx;
            if (og + 1u == (tg + 1u) * nx) xb_add(&bar[XB_TOPGEN], 1u);
            else XB_SPIN(xb_ld(&bar[XB_TOPGEN]) == tg, bar);
            __builtin_amdgcn_fence(__ATOMIC_ACQUIRE, "agent");
            xb_add(&bar[XB_XGEN(b.x)], 1u);
            asm volatile("s_waitcnt vmcnt(0)" ::: "memory");
        } else {
            XB_SPIN(xb_ld(&bar[XB_XGEN(b.x)]) == gen, bar);
            __builtin_amdgcn_fence(__ATOMIC_ACQUIRE, "agent");
            asm volatile("s_waitcnt vmcnt(0)" ::: "memory");
        }
    }
    __syncthreads();
}

__device__ __forceinline__ float wave_sum(float v) {
#pragma unroll
    for (int o = 1; o < 64; o <<= 1) v += __shfl_xor(v, o);
    return v;
}
template <class F>
__device__ __forceinline__ void transpose_item(const float* W, int K, int ld, bf16_t* WT, int nrows, F srccol, const float* gk, LAS float* scr, int item, int lane) {
    const int nblk = nrows / 32, kb = item / nblk, nb = item % nblk, k0 = 64 * kb, n0 = 32 * nb, s0 = srccol(n0);
#pragma unroll 8
    for (int i = 0; i < 32; ++i) { const int kk = 2 * i + (lane >> 5); float v = W[(size_t)(k0 + kk) * ld + s0 + (lane & 31)]; if (gk) v *= gk[k0 + kk]; scr[kk * 33 + (lane & 31)] = v; }
    LDS_WAIT(); asm volatile("" ::: "memory");
    const int c = lane & 7;
#pragma unroll
    for (int j = 0; j < 4; ++j) { const int n = (lane >> 3) + 8 * j; const LAS float* s = scr + (8 * c) * 33 + n;
        u32x4 o; o.x = cvt_pk_bf16(s[0 * 33], s[1 * 33]); o.y = cvt_pk_bf16(s[2 * 33], s[3 * 33]); o.z = cvt_pk_bf16(s[4 * 33], s[5 * 33]); o.w = cvt_pk_bf16(s[6 * 33], s[7 * 33]);
        *(u32x4*)(WT + (size_t)(n0 + n) * K + k0 + 8 * c) = o; }
    LDS_WAIT(); asm volatile("" ::: "memory");
}
struct ColIdent { int off; __device__ __forceinline__ int operator()(int r) const { return off + r; } };
struct ColSwiglu { __device__ __forceinline__ int operator()(int r) const { return ((r >> 7) & 1) * DFF + (r >> 8) * 128 + (r & 127); } };
struct ColMix { __device__ __forceinline__ int operator()(int r) const {
    const int tile = r >> 8, p = r & 255, o = 64 * ((p >> 5) & 3) + 32 * (p >> 7) + (p & 31);
    if (tile < 16) return r;
    if (tile < 20) return 6144 + (tile - 16) * 256 + o;
    if (tile < 24) return 7168 + (tile - 20) * 256 + o;
    if (tile < 28) return 8192 + (tile - 24) * 256 + p;
    return 9216 + (tile - 28) * 256 + p; } };
template <class F>
__device__ __forceinline__ void transpose_all(const float* W, int K, int ld, bf16_t* WT, int nrows, F srccol, const float* gk, LAS float* scr, int gw, int ngw, int lane) {
    const int nitems = (K / 64) * (nrows / 32);
    for (int it = gw; it < nitems; it += ngw) transpose_item(W, K, ld, WT, nrows, srccol, gk, scr, it, lane);
}
__device__ __forceinline__ void rms_row_to_bf16(const float* xrow, const float* gain, bf16_t* orow, int lane) {
    const f32x4* xr = (const f32x4*)xrow + lane; const f32x4* gr = (const f32x4*)gain + lane;
    f32x4 v[4]; float s = 0.f;
#pragma unroll
    for (int j = 0; j < 4; ++j) { v[j] = xr[64 * j]; s += (v[j][0] * v[j][0] + v[j][1] * v[j][1]) + (v[j][2] * v[j][2] + v[j][3] * v[j][3]); }
    const float r = __builtin_amdgcn_rsqf(wave_sum(s) * (1.f / 1024.f) + EPS);
    u32x2* o8 = (u32x2*)orow + lane;
#pragma unroll
    for (int j = 0; j < 4; ++j) o8[64 * j] = pack4(v[j] * r * gr[64 * j]);
}
__device__ __forceinline__ void rot_table(const int* pos, float* rot, int gt, int ngt) {
    for (int idx = gt; idx < SEQ * 128; idx += ngt) {
        const int s = idx >> 7, i = idx & 127;
        const float inv = exp2f(-(float)i * (13.287712379549449f / 128.0f));
        const float ang = (float)pos[s] * inv;
        const float kq = rintf(ang * 0.6366197723675814f);
        float r = fmaf(-kq, 1.5703125f, ang); r = fmaf(-kq, 4.837512969970703125e-4f, r); r = fmaf(-kq, 7.54978995489188216e-8f, r);
        const float r2 = r * r;
        const float sn = r + r * r2 * (-1.6666667e-1f + r2 * (8.3333333e-3f + r2 * (-1.9841270e-4f + r2 * 2.7557319e-6f)));
        const float cn = 1.0f + r2 * (-0.5f + r2 * (4.1666668e-2f + r2 * (-1.3888889e-3f + r2 * (2.4801587e-5f + r2 * -2.7557319e-7f))));
        const int qd = ((int)kq) & 3;
        const float c = (qd == 0) ? cn : (qd == 1) ? -sn : (qd == 2) ? -cn : sn;
        const float sv = (qd == 0) ? sn : (qd == 1) ? cn : (qd == 2) ? -sn : -cn;
        *(f32x2*)(rot + (size_t)idx * 2) = (f32x2){c, sv};
    }
}

constexpr int SCN_LD = 136, SCN_V_OFF = 32 * SCN_LD * 2;
__device__ __forceinline__ void scan_unit(int u, const bf16_t* kts, const bf16_t* vt, bf16_t* S, LAS unsigned char* lds) {
    const int tid = opaque_tid(), lane = tid & 63, wave = __builtin_amdgcn_readfirstlane(tid >> 6);
    const int fr = lane & 15, fq = lane >> 4, h = u >> 6, dg = (u >> 3) & 7, eg = u & 7, wd = wave & 1, we = wave >> 1;
    LAS bf16_t* lk = (LAS bf16_t*)lds; LAS bf16_t* lv = (LAS bf16_t*)(lds + SCN_V_OFF);
    const float gC = __builtin_amdgcn_exp2f(128.0f * log2f(1.0f - __builtin_amdgcn_exp2f(-5.0f - (float)h)));
    f32x4 acc = (f32x4){0.f, 0.f, 0.f, 0.f};
    const bf16_t* ksrc = kts + (size_t)(h * 256 + 32 * dg + (tid >> 4)) * SEQ + (tid & 15) * 8;
    const bf16_t* vsrc = vt + (size_t)(h * 512 + 64 * eg + (tid >> 4)) * SEQ + (tid & 15) * 8;
    u32x4 pk = *(const u32x4*)ksrc, pv0 = *(const u32x4*)vsrc, pv1 = *(const u32x4*)(vsrc + (size_t)32 * SEQ);
    bf16_t* sdst = S + ((size_t)(h * 16) * 512 + 64 * eg + 16 * we + fr) * 256 + 32 * dg + 16 * wd + 4 * fq;
#pragma unroll 1
    for (int c = 0; c < 16; ++c) {
        *(u32x2*)(sdst + (size_t)c * 512 * 256) = pack4(acc);
        if (c == 15) break;
        __syncthreads();
        *(LAS u32x4*)(lk + (tid >> 4) * SCN_LD + (tid & 15) * 8) = pk;
        *(LAS u32x4*)(lv + (tid >> 4) * SCN_LD + (tid & 15) * 8) = pv0;
        *(LAS u32x4*)(lv + (32 + (tid >> 4)) * SCN_LD + (tid & 15) * 8) = pv1;
        __syncthreads();
        if (c < 14) { pk = *(const u32x4*)(ksrc + (c + 1) * 128); pv0 = *(const u32x4*)(vsrc + (c + 1) * 128); pv1 = *(const u32x4*)(vsrc + (size_t)32 * SEQ + (c + 1) * 128); }
        f32x4 tm = (f32x4){0.f, 0.f, 0.f, 0.f};
#pragma unroll
        for (int ks = 0; ks < 4; ++ks) {
            const bf16x8 a = *(const LAS bf16x8*)(lk + (16 * wd + fr) * SCN_LD + 32 * ks + 8 * fq);
            const bf16x8 b = *(const LAS bf16x8*)(lv + (16 * we + fr) * SCN_LD + 32 * ks + 8 * fq);
            tm = mfma16(a, b, tm);
        }
        acc = acc * gC + tm;
    }
    __syncthreads();
}
constexpr int RQ_LD = 264, SC_LD = 136, RO_SC_OFF = 128 * RQ_LD * 2, RO_PART_OFF = RO_SC_OFF + 128 * SC_LD * 2;
__device__ __forceinline__ void retout_unit(int h, int c, int eh, const bf16_t* q, const bf16_t* k, const bf16_t* vt, const bf16_t* S, bf16_t* ret  , float* rssq, LAS unsigned char* lds) {
    const int tid = opaque_tid(), lane = tid & 63, wave = __builtin_amdgcn_readfirstlane(tid >> 6);
    const int fr = lane & 15, fq = lane >> 4;
    LAS bf16_t* ql = (LAS bf16_t*)lds; LAS bf16_t* sc = (LAS bf16_t*)(lds + RO_SC_OFF); LAS float* part = (LAS float*)(lds + RO_PART_OFF);
    const float lg2 = log2f(1.0f - __builtin_amdgcn_exp2f(-5.0f - (float)h));
    const int tok0 = c * 128;
#pragma unroll
    for (int i = 0; i < 8; ++i) { const int p = tid + 512 * i, row = p >> 5, c16 = p & 31;
        *(LAS u32x4*)(ql + row * RQ_LD + c16 * 8) = *(const u32x4*)(q + (size_t)(tok0 + row) * 1024 + h * 256 + c16 * 8); }
    const bf16_t* sp = S + ((size_t)((h * 16 + c) * 512 + 256 * eh + 32 * wave + fr)) * 256 + 8 * fq;
    const bf16_t* vp = vt + (size_t)(h * 512 + 256 * eh + 32 * wave + fr) * SEQ + tok0 + 8 * fq;
    __syncthreads();
    {
        const int ti = wave; const int i = 16 * ti + fr;
        bf16x8 qf[8];
#pragma unroll
        for (int ks = 0; ks < 8; ++ks) qf[ks] = *(const LAS bf16x8*)(ql + (16 * ti + fr) * RQ_LD + 32 * ks + 8 * fq);
        const bf16_t* kp = k + (size_t)(tok0 + fr) * 1024 + h * 256 + 8 * fq;
#pragma unroll
        for (int tj = 0; tj < 8; ++tj) {
            if (tj <= (ti | 1)) {
                f32x4 v = (f32x4){0.f, 0.f, 0.f, 0.f};
                if (tj <= ti) {
                    f32x4 s2 = (f32x4){0.f, 0.f, 0.f, 0.f};
#pragma unroll
                    for (int ks = 0; ks < 8; ++ks) { const bf16x8 kf = *(const bf16x8*)(kp + (size_t)(16 * tj) * 1024 + 32 * ks); s2 = mfma16(kf, qf[ks], s2); }
#pragma unroll
                    for (int r = 0; r < 4; ++r) { const int j = 16 * tj + 4 * fq + r; v[r] = (i >= j) ? s2[r] * __builtin_amdgcn_exp2f(lg2 * (float)(i - j)) : 0.f; }
                }
                *(LAS u32x2*)(sc + (16 * ti + fr) * SC_LD + 16 * tj + 4 * fq) = pack4(v);
            }
        }
    }
    __syncthreads();
    f32x4 acc[8][2];
#pragma unroll
    for (int a = 0; a < 8; ++a)
#pragma unroll
        for (int b = 0; b < 2; ++b) acc[a][b] = (f32x4){0.f, 0.f, 0.f, 0.f};
#pragma unroll
    for (int ks = 0; ks < 8; ++ks) {
        bf16x8 sf[2], qf[8];
#pragma unroll
        for (int t = 0; t < 2; ++t) sf[t] = *(const bf16x8*)(sp + (size_t)(16 * t) * 256 + 32 * ks);
#pragma unroll
        for (int t = 0; t < 8; ++t) qf[t] = *(const LAS bf16x8*)(ql + (16 * t + fr) * RQ_LD + 32 * ks + 8 * fq);
#pragma unroll
        for (int a = 0; a < 8; ++a)
#pragma unroll
            for (int b = 0; b < 2; ++b) acc[a][b] = mfma16(sf[b], qf[a], acc[a][b]);
    }
#pragma unroll
    for (int a = 0; a < 8; ++a) { const float qd = __builtin_amdgcn_exp2f(lg2 * (float)(16 * a + fr + 1));
#pragma unroll
        for (int b = 0; b < 2; ++b) acc[a][b] = acc[a][b] * qd; }
#pragma unroll
    for (int ks = 0; ks < 4; ++ks) {
        bf16x8 vf[2];
#pragma unroll
        for (int t = 0; t < 2; ++t) vf[t] = *(const bf16x8*)(vp + (size_t)(16 * t) * SEQ + 32 * ks);
#pragma unroll
        for (int a = 0; a < 8; ++a) {
            if (a >= 2 * ks) {
                const bf16x8 pf = *(const LAS bf16x8*)(sc + (16 * a + fr) * SC_LD + 32 * ks + 8 * fq);
#pragma unroll
                for (int b = 0; b < 2; ++b) acc[a][b] = mfma16(vf[b], pf, acc[a][b]);
            }
        }
    }
#pragma unroll
    for (int a = 0; a < 8; ++a) {
        float ss = 0.f;
#pragma unroll
        for (int b = 0; b < 2; ++b) { const f32x4 t = acc[a][b]; ss += (t[0] * t[0] + t[1] * t[1]) + (t[2] * t[2] + t[3] * t[3]); }
        ss += __shfl_xor(ss, 16); ss += __shfl_xor(ss, 32);
        if (fq == 0) part[wave * 128 + 16 * a + fr] = ss;
    }
    __syncthreads();
    if (tid < 128) {
        float tot = 0.f;
#pragma unroll
        for (int w = 0; w < 8; ++w) tot += part[w * 128 + tid];
        rssq[(size_t)(tok0 + tid) * 8 + 2 * h + eh] = tot;
    }
#pragma unroll
    for (int a = 0; a < 8; ++a)
#pragma unroll
        for (int b = 0; b < 2; ++b)
            *(u32x2*)(ret + (size_t)(tok0 + 16 * a + fr) * 2048 + h * 512 + 256 * eh + 32 * wave + 16 * b + 4 * fq) = pack4(acc[a][b]);
    __syncthreads();
}
constexpr int PL_LD = 264, MA_KV_BYTES = 64 * 264 * 2, MA_P_OFF = MA_KV_BYTES;
__device__ __forceinline__ void memattn_unit(int b, int h, int rb, const bf16_t* mq, const bf16_t* mkn, const bf16_t* mvt, bf16_t* mo  , LAS unsigned char* lds) {
    const int tid = opaque_tid(), lane = tid & 63, wave = __builtin_amdgcn_readfirstlane(tid >> 6);
    const int fr = lane & 15, fq = lane >> 4;
    LAS bf16_t* kv = (LAS bf16_t*)lds; LAS bf16_t* pl = (LAS bf16_t*)(lds + MA_P_OFF) + wave * (16 * PL_LD);
    const int row = 128 * rb + 16 * wave + fr;
    const bf16_t* ksrc = mkn + (size_t)(b * 256) * 1024 + h * 256;
    const bf16_t* vsrc = mvt + (size_t)((b * 4 + h) * 256) * 256;
    u32x4 pre[4];
#pragma unroll
    for (int i = 0; i < 4; ++i) { const int p = tid + 512 * i; pre[i] = *(const u32x4*)(ksrc + (size_t)(p >> 5) * 1024 + (p & 31) * 8); }
    bf16x8 qf[8]; float qs = 0.f;
#pragma unroll
    for (int ks = 0; ks < 8; ++ks) { qf[ks] = *(const bf16x8*)(mq + (size_t)row * 1024 + h * 256 + 32 * ks + 8 * fq);
#pragma unroll
        for (int j = 0; j < 8; ++j) { const float f = bf2f((unsigned short)qf[ks][j]); qs += f * f; } }
    qs += __shfl_xor(qs, 16); qs += __shfl_xor(qs, 32);
    const float scl = __builtin_amdgcn_rsqf(qs * (1.0f / 256.0f) + EPS) * (0.0625f * LOG2E);
    f32x4 sa[16];
#pragma unroll
    for (int kc = 0; kc < 4; ++kc) {
        __syncthreads();
#pragma unroll
        for (int i = 0; i < 4; ++i) { const int p = tid + 512 * i; *(LAS u32x4*)(kv + (p >> 5) * PL_LD + (p & 31) * 8) = pre[i]; }
        __syncthreads();
#pragma unroll
        for (int i = 0; i < 4; ++i) { const int p = tid + 512 * i;
            pre[i] = (kc < 3) ? *(const u32x4*)(ksrc + (size_t)(64 * (kc + 1) + (p >> 5)) * 1024 + (p & 31) * 8) : *(const u32x4*)(vsrc + (size_t)(p >> 5) * 256 + (p & 31) * 8); }
#pragma unroll
        for (int tl = 0; tl < 4; ++tl) {
            f32x4 a = (f32x4){0.f, 0.f, 0.f, 0.f};
#pragma unroll
            for (int ks = 0; ks < 8; ++ks) { const bf16x8 kf = *(const LAS bf16x8*)(kv + (16 * tl + fr) * PL_LD + 32 * ks + 8 * fq); a = mfma16(kf, qf[ks], a); }
            sa[4 * kc + tl] = a * scl;
        }
    }
    float mx = -INFINITY;
#pragma unroll
    for (int t = 0; t < 16; ++t) mx = fmaxf(mx, fmaxf(fmaxf(sa[t][0], sa[t][1]), fmaxf(sa[t][2], sa[t][3])));
    mx = fmaxf(mx, __shfl_xor(mx, 16)); mx = fmaxf(mx, __shfl_xor(mx, 32));
    float l = 0.f;
#pragma unroll
    for (int t = 0; t < 16; ++t) {
        f32x4 p;
#pragma unroll
        for (int r = 0; r < 4; ++r) { p[r] = __builtin_amdgcn_exp2f(sa[t][r] - mx); l += p[r]; }
        *(LAS u32x2*)(pl + fr * PL_LD + 16 * t + 4 * fq) = pack4(p);
    }
    l += __shfl_xor(l, 16); l += __shfl_xor(l, 32);
    const float rl = __builtin_amdgcn_rcpf(l);
    LDS_WAIT(); asm volatile("" ::: "memory");
    bf16x8 pf[8];
#pragma unroll
    for (int ks = 0; ks < 8; ++ks) pf[ks] = *(const LAS bf16x8*)(pl + fr * PL_LD + 32 * ks + 8 * fq);
#pragma unroll
    for (int dc = 0; dc < 4; ++dc) {
        __syncthreads();
#pragma unroll
        for (int i = 0; i < 4; ++i) { const int p = tid + 512 * i; *(LAS u32x4*)(kv + (p >> 5) * PL_LD + (p & 31) * 8) = pre[i]; }
        __syncthreads();
        if (dc < 3) {
#pragma unroll
            for (int i = 0; i < 4; ++i) { const int p = tid + 512 * i; pre[i] = *(const u32x4*)(vsrc + (size_t)(64 * (dc + 1) + (p >> 5)) * 256 + (p & 31) * 8); }
        }
#pragma unroll
        for (int tl = 0; tl < 4; ++tl) {
            f32x4 a = (f32x4){0.f, 0.f, 0.f, 0.f};
#pragma unroll
            for (int ks = 0; ks < 8; ++ks) { const bf16x8 vf = *(const LAS bf16x8*)(kv + (16 * tl + fr) * PL_LD + 32 * ks + 8 * fq); a = mfma16(vf, pf[ks], a); }
            *(u32x2*)(mo + (size_t)row * 1024 + h * 256 + 64 * dc + 16 * tl + 4 * fq) = pack4(a * rl);
        }
    }
    __syncthreads();
}
__device__ __forceinline__ void dif_row(const bf16_t* o0, const bf16_t* o1, bf16_t* dif, const float* gout, float lam, int lane) {
    const u32x4* a = (const u32x4*)o0 + 2 * lane; const u32x4* b = (const u32x4*)o1 + 2 * lane;
    float d[16]; float ss = 0.f;
#pragma unroll
    for (int v = 0; v < 2; ++v) { const u32x4 x = a[v], y = b[v];
#pragma unroll
        for (int w = 0; w < 4; ++w) { const float x0 = __uint_as_float(x[w] << 16), x1 = __uint_as_float(x[w] & 0xffff0000u), y0 = __uint_as_float(y[w] << 16), y1 = __uint_as_float(y[w] & 0xffff0000u);
            const float d0 = x0 - lam * y0, d1 = x1 - lam * y1; d[v * 8 + w * 2] = d0; d[v * 8 + w * 2 + 1] = d1; ss += d0 * d0 + d1 * d1; } }
    ss += __shfl_xor(ss, 1); ss += __shfl_xor(ss, 2); ss += __shfl_xor(ss, 4);
    const float rn = __builtin_amdgcn_rsqf(ss * (1.0f / 128.0f) + EPS) * (1.0f - LAM_INIT);
    const float* gp = gout + (lane & 7) * 16;
    u32x4 o[2];
#pragma unroll
    for (int v = 0; v < 2; ++v)
#pragma unroll
        for (int w = 0; w < 4; ++w) o[v][w] = cvt_pk_bf16(d[v * 8 + w * 2] * rn * gp[v * 8 + w * 2], d[v * 8 + w * 2 + 1] * rn * gp[v * 8 + w * 2 + 1]);
    u32x4* op = (u32x4*)dif + 2 * lane; op[0] = o[0]; op[1] = o[1];
}

#ifndef PH_MASK
#define PH_MASK 0xffffffffu
#endif
#define PH(n) ((PH_MASK >> (n)) & 1u)
#ifndef DUP_MASK
#define DUP_MASK 0u
#endif
#define REP(n) _Pragma("unroll 1") for (int rep_ = 0; rep_ < 1 + (int)((DUP_MASK >> (n)) & 1u); ++rep_)
struct Args { const void* in[26]; float* out; unsigned char* ws; };
#define CAS __attribute__((address_space(4)))
__device__ __forceinline__ const void* karg(int i) { typedef const GAS void* gptr; const CAS gptr* p = (const CAS gptr*)__builtin_amdgcn_kernarg_segment_ptr(); asm volatile("" : "+s"(p)); return (const void*)p[i]; }
#define INP(i) ((const float*)karg(i))
#define WSP(T, off) ((T*)((unsigned char*)karg(27) + (off)))
#define OUTP ((float*)karg(26))
__global__ void __launch_bounds__(NWAVES * 64, 2) mk_fwd(Args args) {
    extern __shared__ __attribute__((aligned(16))) unsigned char lds_raw[];
    LAS unsigned char* lds = (LAS unsigned char*)lds_raw;
    volatile LAS unsigned* MISC = (volatile LAS unsigned*)(lds + MISC_OFF);
    const int G = gridDim.x, bx = blockIdx.x;
    for (int u = threadIdx.x; u < (LDS_BYTES - LDSCTL_OFF) / 4; u += NWAVES * 64) ((LAS unsigned*)(lds + LDSCTL_OFF))[u] = 0u;
    __syncthreads();
    (void)xcd_barrier_post((unsigned*)WSP(unsigned, WS_CTL) + CW_BAR, MISC + 8);
#define GRID_BAR() do { XcdBarrier b_; b_.bar = (unsigned*)WSP(unsigned, WS_CTL) + CW_BAR; b_.x = xb_xcc_id(); b_.st = (volatile LAS unsigned*)(lds + MISC_OFF) + 8; xcd_barrier(b_); } while (0)
    const int NGW = G * NWAVES, NGT = G * NWAVES * 64;
#define LANE_VARS() const int tid = opaque_tid(), lane = tid & 63, wave = __builtin_amdgcn_readfirstlane(tid >> 6); LAS float* scr = (LAS float*)(lds + wave * 16384); \
    const int gw = bx * NWAVES + wave, gt = bx * (NWAVES * 64) + tid; (void)scr; (void)gw; (void)gt; (void)lane

    REP(0) if (PH(0)) {
        LANE_VARS();
        transpose_all(INP(4), 1024, 2 * DFF, WSP(bf16_t, WS_WF1I), 2 * DFF, ColSwiglu{}, nullptr, scr, gw, NGW, lane);
        transpose_all(INP(5), DFF, 1024, WSP(bf16_t, WS_WF1O), 1024, ColIdent{0}, nullptr, scr, gw, NGW, lane);
        transpose_all(INP(18), 1024, 2048, WSP(bf16_t, WS_WMKV), 2048, ColIdent{0}, nullptr, scr, gw, NGW, lane);
        transpose_all(INP(7), 1024, 13312, WSP(bf16_t, WS_WMIX), NMIX, ColMix{}, INP(6), scr, gw, NGW, lane);
        transpose_all(INP(7), 1024, 13312, WSP(bf16_t, WS_WRG), 2048, ColIdent{4096}, INP(6), scr, gw, NGW, lane);
        { const float* x = INP(0); const float* g1 = INP(3); bf16_t* xb = WSP(bf16_t, WS_XB);
          for (int m = gw; m < TOK; m += NGW) rms_row_to_bf16(x + (size_t)m * DM, g1, xb + (size_t)m * DM, lane); }
        { const float* mem = INP(1); const float* gm = INP(17); bf16_t* memn = WSP(bf16_t, WS_MEMN);
          for (int m = gw; m < NB * MEML; m += NGW) rms_row_to_bf16(mem + (size_t)m * DM, gm, memn + (size_t)m * DM, lane); }
        rot_table((const int*)karg(2), WSP(float, WS_ROT), gt, NGT);
    }
    GRID_BAR();

    REP(1) if (PH(1)) {
        pg8::Gemm g{WSP(bf16_t, WS_XB), WSP(bf16_t, WS_WF1I), TOK, 2 * DFF, 1024}; pg8::StaticOrder S; S.init(TOK, 2 * DFF, G, bx);
        EpiSwiglu E{WSP(bf16_t, WS_ACT), nullptr};
        pg8::gemm_phase(lds, g, S, E);
    }
    if (PH(2)) {
        pg8::Gemm g{WSP(bf16_t, WS_MEMN), WSP(bf16_t, WS_WMKV), NB * MEML, 2048, 1024}; pg8::StaticOrder S; S.init(NB * MEML, 2048, G, (bx + G / 2) % G);
        EpiPlain E{WSP(bf16_t, WS_MKVRAW), 2048};
        pg8::gemm_phase(lds, g, S, E);
    }
    GRID_BAR();

    REP(3) if (PH(3)) {
        pg8::Gemm g{WSP(bf16_t, WS_ACT), WSP(bf16_t, WS_WF1O), TOK, 1024, DFF}; pg8::StaticOrder S; S.init(TOK, 1024, G, bx);
        EpiResid E{INP(0), OUTP, WSP(bf16_t, WS_XB), WSP(float, WS_SSQ1), 0.5f, (rep_ == 1 && ((DUP_MASK >> 23) & 1u)) ? 1 : 0};
        pg8::gemm_phase(lds, g, S, E);
    }
    if (PH(0)) {
        LANE_VARS();
        const bf16_t* mkvraw = WSP(bf16_t, WS_MKVRAW); bf16_t* mkn = WSP(bf16_t, WS_MKN); bf16_t* mvt = WSP(bf16_t, WS_MVT);
        const float* g_mem_k = INP(16); const float* g_mem_q = INP(15);
        for (int j = gw; j < NB * MEML * 4; j += NGW) {
            const int row = j >> 2, h = j & 3;
            const u32x2 w = *((const u32x2*)(mkvraw + (size_t)row * 2048 + h * 256) + lane);
            f32x4 v = (f32x4){__uint_as_float(w.x << 16), __uint_as_float(w.x & 0xffff0000u), __uint_as_float(w.y << 16), __uint_as_float(w.y & 0xffff0000u)};
            const float ss = wave_sum((v[0] * v[0] + v[1] * v[1]) + (v[2] * v[2] + v[3] * v[3]));
            const float rn = __builtin_amdgcn_rsqf(ss * (1.0f / 256.0f) + EPS);
            const f32x4 gk = *((const f32x4*)g_mem_k + lane), gq = *((const f32x4*)g_mem_q + lane);
            *((u32x2*)(mkn + (size_t)row * 1024 + h * 256) + lane) = pack4(v * rn * gk * gq);
        }
        for (int idx = gt; idx < NB * 4 * 256 * 256; idx += NGT) {
            const int key = idx & 255, d = (idx >> 8) & 255, bh = idx >> 16, b = bh >> 2, h = bh & 3;
            mvt[idx] = mkvraw[(size_t)(b * 256 + key) * 2048 + 1024 + h * 256 + d];
        }
    }
    GRID_BAR();

    for (int gb = 0; gb < NB; ++gb) {
        REP(4) if (PH(4)) {
            pg8::Gemm g{WSP(bf16_t, WS_XB) + (size_t)gb * SEQ * DM, WSP(bf16_t, WS_WMIX), SEQ, NMIX, 1024}; pg8::StaticOrder S; S.init(SEQ, NMIX, G, bx);
            prep_rs(WSP(float, WS_SSQ1), gb * SEQ, S, lds);
            EpiMix E{(const LAS float*)(lds + RTAB_OFF), WSP(float, WS_ROT), WSP(unsigned char, 0), INP(8), INP(9)};
            pg8::gemm_phase(lds, g, S, E);
        }
        GRID_BAR();
        REP(5) for (int u = bx; u < 256; u += G) {
            if (!(rep_ == 1 && ((DUP_MASK >> 21) & 1u))) { __syncthreads(); if (PH(5)) scan_unit(255 - u, WSP(bf16_t, WS_KTS), WSP(bf16_t, WS_VT), WSP(bf16_t, WS_S), lds); }
            if (u >= 192 && !(rep_ == 1 && ((DUP_MASK >> 19) & 1u))) {
                const int e = 255 - u;
                { const int m = e; __syncthreads();
                       if (PH(7) && !(rep_ == 1 && ((DUP_MASK >> 22) & 1u))) memattn_unit(gb, m >> 4, m & 15, WSP(bf16_t, WS_MQ), WSP(bf16_t, WS_MKN), WSP(bf16_t, WS_MVT), WSP(bf16_t, WS_MO) + (size_t)gb * SEQ * 1024, lds); }
            }
            if (!(rep_ == 1 && ((DUP_MASK >> 20) & 1u))) {
                const int qb = 7 - (u >> 5), rem = u & 31, hc = rem >> 1, vh = rem & 1, hh = hc >> 1, cc = hc & 1;
                __syncthreads();
                if (PH(6)) attn_body::attn_unit<8>(hc, 2 * hh + vh, qb, WSP(const attn_body::bf16, WS_DQ), WSP(const attn_body::bf16, WS_DK), WSP(const attn_body::bf16, WS_DV),
                                        WSP(attn_body::bf16, (cc ? WS_O1 : WS_O0)), (char*)lds_raw);
            }
        }
        GRID_BAR();
        REP(8) for (int idx = bx; idx < 128; idx += G) if (PH(8)) retout_unit(idx >> 5, (idx >> 1) & 15, idx & 1, WSP(bf16_t, WS_Q), WSP(bf16_t, WS_K), WSP(bf16_t, WS_VT), WSP(bf16_t, WS_S),
                                                                     WSP(bf16_t, WS_RET) + (size_t)gb * SEQ * 2048, WSP(float, WS_SSQ2) + (size_t)gb * SEQ * 8, lds);
        if (PH(0)) {
            LANE_VARS();
            const float s1 = wave_sum(INP(10)[lane] * INP(11)[lane]), s2 = wave_sum(INP(12)[lane] * INP(13)[lane]); const float lam = __expf(s1) - __expf(s2) + LAM_INIT;
            const bf16_t* bo0 = WSP(bf16_t, WS_O0); const bf16_t* bo1 = WSP(bf16_t, WS_O1); bf16_t* difb = WSP(bf16_t, WS_DIF); const float* gdo = INP(14);
            for (int r = gw; r < SEQ; r += NGW) dif_row(bo0 + (size_t)r * 1024, bo1 + (size_t)r * 1024, difb + ((size_t)gb * SEQ + r) * 1024, gdo, lam, lane);
            if (gb + 1 < NB) rot_table((const int*)karg(2) + (gb + 1) * SEQ, WSP(float, WS_ROT), gt, NGT);
        }
        GRID_BAR();
    }

    if (PH(9)) {
        pg8::Gemm g{WSP(bf16_t, WS_XB), WSP(bf16_t, WS_WRG), TOK, 2048, 1024}; pg8::StaticOrder S; S.init(TOK, 2048, G, bx);
        prep_rs(WSP(float, WS_SSQ1), 0, S, lds);
        EpiRg E{(const LAS float*)(lds + RTAB_OFF), WSP(bf16_t, WS_RET), WSP(float, WS_SSQ2)};
        pg8::gemm_phase(lds, g, S, E);
    }
    if (PH(0)) {
        LANE_VARS();
        transpose_all(INP(7), 1024, 13312, WSP(bf16_t, WS_WGATE), 3072, ColIdent{10240}, INP(6), scr, gw, NGW, lane);
        transpose_all(INP(19), 2048, 1024, WSP(bf16_t, WS_WBRR), 1024, ColIdent{0}, nullptr, scr, gw, NGW, lane);
        transpose_all(INP(20), 1024, 1024, WSP(bf16_t, WS_WBRD), 1024, ColIdent{0}, nullptr, scr, gw, NGW, lane);
        transpose_all(INP(21), 1024, 1024, WSP(bf16_t, WS_WBRM), 1024, ColIdent{0}, nullptr, scr, gw, NGW, lane);
        transpose_all(INP(22), 1024, 1024, WSP(bf16_t, WS_WO), 1024, ColIdent{0}, nullptr, scr, gw, NGW, lane);
    }
    GRID_BAR();

    REP(10) if (PH(10)) {
        pg8::StaticOrder S; S.init(TOK, 1024, G, bx);
        prep_rs(WSP(float, WS_SSQ1), 0, S, lds);
#pragma unroll 1
        for (int job = 0; job < 6; ++job) {
            const int kbr = job >> 1, isterm = job & 1;
            const bf16_t* A = isterm ? (kbr == 0 ? WSP(bf16_t, WS_RET) : kbr == 1 ? WSP(bf16_t, WS_DIF) : WSP(bf16_t, WS_MO)) : WSP(bf16_t, WS_XB);
            const bf16_t* Bt = isterm ? (kbr == 0 ? WSP(bf16_t, WS_WBRR) : kbr == 1 ? WSP(bf16_t, WS_WBRD) : WSP(bf16_t, WS_WBRM)) : WSP(bf16_t, WS_WGATE) + (size_t)kbr * 1024 * 1024;
            pg8::Gemm g{A, Bt, TOK, 1024, (isterm && kbr == 0) ? 2048 : 1024};
            EpiP5 E{isterm, (const LAS float*)(lds + RTAB_OFF), WSP(bf16_t, WS_STASH), WSP(bf16_t, WS_Y), kbr == 0};
            pg8::gemm_phase(lds, g, S, E);
        }
    }
    GRID_BAR();

    if (PH(11)) {
        pg8::Gemm g{WSP(bf16_t, WS_Y), WSP(bf16_t, WS_WO), TOK, 1024, 1024}; pg8::StaticOrder S; S.init(TOK, 1024, G, bx);
        EpiResid E{OUTP, OUTP, WSP(bf16_t, WS_XB), WSP(float, WS_SSQ2), 1.0f, 0};
        pg8::gemm_phase(lds, g, S, E);
    }
    if (PH(0)) {
        LANE_VARS();
        transpose_all(INP(24), 1024, 2 * DFF, WSP(bf16_t, WS_WF2I), 2 * DFF, ColSwiglu{}, INP(23), scr, gw, NGW, lane);
        transpose_all(INP(25), DFF, 1024, WSP(bf16_t, WS_WF2O), 1024, ColIdent{0}, nullptr, scr, gw, NGW, lane);
    }
    GRID_BAR();

    if (PH(12)) {
        pg8::Gemm g{WSP(bf16_t, WS_XB), WSP(bf16_t, WS_WF2I), TOK, 2 * DFF, 1024}; pg8::StaticOrder S; S.init(TOK, 2 * DFF, G, bx);
        prep_rs(WSP(float, WS_SSQ2), 0, S, lds);
        EpiSwiglu E{WSP(bf16_t, WS_ACT2), (const LAS float*)(lds + RTAB_OFF)};
        pg8::gemm_phase(lds, g, S, E);
    }
    GRID_BAR();

    if (PH(13)) {
        pg8::Gemm g{WSP(bf16_t, WS_ACT2), WSP(bf16_t, WS_WF2O), TOK, 1024, DFF}; pg8::StaticOrder S; S.init(TOK, 1024, G, bx);
        EpiResid E{OUTP, OUTP, nullptr, nullptr, 0.5f, 0};
        pg8::gemm_phase(lds, g, S, E);
    }
}

extern "C" void kernel_launch(void* const* d_in, const int* in_sizes, int n_in, void* d_out, int out_size, void* d_ws, size_t ws_size, hipStream_t stream) {
    static int grid = 0;
    if (grid == 0) {
        if (n_in != 26 || ws_size < WS_END) { fprintf(stderr, "kernel_launch: unexpected inputs (n_in %d, ws %zu)\n", n_in, ws_size); grid = -1; return; }
        int dev = 0, cus = 0;
        if (hipGetDevice(&dev) != hipSuccess || hipDeviceGetAttribute(&cus, hipDeviceAttributeMultiprocessorCount, dev) != hipSuccess) { grid = -1; return; }
        if (hipFuncSetAttribute((const void*)mk_fwd, hipFuncAttributeMaxDynamicSharedMemorySize, LDS_BYTES) != hipSuccess) { fprintf(stderr, "kernel_launch: hipFuncSetAttribute failed\n"); grid = -1; return; }
        grid = cus;
    }
    if (grid < 0) return;
    (void)hipMemsetAsync((char*)d_ws + WS_CTL, 0, CTL_ZERO_BYTES, stream);
    Args a{};
    for (int i = 0; i < 26; ++i) a.in[i] = d_in[i];
    a.out = (float*)d_out; a.ws = (unsigned char*)d_ws;
    hipLaunchKernelGGL(mk_fwd, dim3(grid), dim3(NWAVES * 64), LDS_BYTES, stream, a);
}
```

```cpp
#include <hip/hip_runtime.h>
#include <cstdio>
#include <cstdint>

#define LAS __attribute__((address_space(3)))
#define GAS __attribute__((address_space(1)))
typedef unsigned short bf16_t;
typedef short bf16x8 __attribute__((ext_vector_type(8)));
typedef float f32x4 __attribute__((ext_vector_type(4)));
typedef float f32x2 __attribute__((ext_vector_type(2)));
typedef unsigned u32x4 __attribute__((ext_vector_type(4)));
typedef unsigned u32x2 __attribute__((ext_vector_type(2)));

constexpr int NB = 8, SEQ = 2048, DM = 1024, TOK = NB * SEQ, MEML = 256, DFF = 2816;
constexpr int NMIX = 8192;
constexpr float EPS = 1e-6f;
constexpr float LOG2E = 1.4426950408889634f;
constexpr float C2Q = 0.125f * LOG2E;
constexpr float LAM_INIT = 0.2f;

constexpr size_t MiB = 1u << 20;
constexpr size_t WS_CTL = 0, CTL_ZERO_BYTES = 1 * MiB;
constexpr size_t WS_SSQ1 = 1 * MiB, WS_SSQ2 = 2 * MiB;
constexpr size_t WS_MKN = 3 * MiB, WS_MVT = 7 * MiB;
constexpr size_t WS_WMIX = 11 * MiB;
constexpr size_t WS_XB = 27 * MiB;
constexpr size_t WS_RET = 59 * MiB;
constexpr size_t WS_DIF = 123 * MiB;
constexpr size_t WS_MO = 155 * MiB;
constexpr size_t WS_Q = 187 * MiB, WS_K = 191 * MiB, WS_KTS = 195 * MiB, WS_VT = 199 * MiB, WS_DQ = 207 * MiB, WS_DK = 211 * MiB,
                 WS_DV = 215 * MiB, WS_MQ = 219 * MiB, WS_O0 = 223 * MiB, WS_O1 = 227 * MiB, WS_S = 231 * MiB;
constexpr size_t WS_ROT = 247 * MiB;
constexpr size_t WS_WRG = 249 * MiB;
constexpr size_t WS_ACT = 59 * MiB;
constexpr size_t WS_WF1I = 147 * MiB, WS_WF1O = 158 * MiB;
constexpr size_t WS_MEMN = 164 * MiB, WS_MKVRAW = 168 * MiB, WS_WMKV = 176 * MiB;
constexpr size_t WS_WGATE = 11 * MiB, WS_WBRR = 17 * MiB, WS_WBRD = 21 * MiB, WS_WBRM = 23 * MiB, WS_WO = 25 * MiB;
constexpr size_t WS_Y = 187 * MiB, WS_STASH = 219 * MiB;
constexpr size_t WS_WF2I = 59 * MiB, WS_WF2O = 70 * MiB, WS_ACT2 = 76 * MiB;
constexpr size_t WS_END = 256 * MiB;

constexpr int CW_BAR = 4096;
constexpr int CW_SCAN = 16384;

constexpr int RING_BYTES = 131072, LDSCTL_OFF = RING_BYTES, MISC_OFF = LDSCTL_OFF + 320, LDS_BYTES = 147456;
constexpr int NWAVES = 8;

__device__ __forceinline__ unsigned cvt_pk_bf16(float lo, float hi) { unsigned r; asm volatile("v_cvt_pk_bf16_f32 %0, %1, %2" : "=v"(r) : "v"(lo), "v"(hi)); return r; }
__device__ __forceinline__ u32x2 pack4(f32x4 v) { u32x2 w; w.x = cvt_pk_bf16(v[0], v[1]); w.y = cvt_pk_bf16(v[2], v[3]); return w; }
__device__ __forceinline__ unsigned short bf16_1(float v) { return (unsigned short)(cvt_pk_bf16(v, 0.f) & 0xffffu); }
__device__ __forceinline__ float bf2f(unsigned short b) { return __uint_as_float(((unsigned)b) << 16); }
__device__ __forceinline__ float siluf(float x) { return x * __builtin_amdgcn_rcpf(1.0f + __builtin_amdgcn_exp2f(-x * LOG2E)); }
__device__ __forceinline__ float sigmf(float x) { return __builtin_amdgcn_rcpf(1.0f + __builtin_amdgcn_exp2f(-x * LOG2E)); }
__device__ __forceinline__ float row_rs(const float* ssq, int row) {
    const f32x4 a = *(const f32x4*)(ssq + (size_t)row * 4);
    return __builtin_amdgcn_rsqf(((a[0] + a[1]) + (a[2] + a[3])) * (1.0f / 1024.0f) + EPS);
}
__device__ __forceinline__ int opaque_tid() { int t = threadIdx.x; asm volatile("" : "+v"(t)); return t; }
__device__ __forceinline__ f32x4 mfma16(bf16x8 a, bf16x8 b, f32x4 c) { return __builtin_amdgcn_mfma_f32_16x16x32_bf16(a, b, c, 0, 0, 0); }

namespace pg8 {
constexpr int BM = 256, BK = 64, HALF = 128, HTB = HALF * BK * 2, STAGE_BYTES = 8 * HTB, NXCD = 8, WGM = 8;
__host__ __device__ __forceinline__ int lds_byte(int r, int c) { const int st = (r >> 4) * 2 + (c >> 5), rr = r & 15, cc = c & 31, ob = rr * 64 + cc * 2; return st * 1024 + (ob ^ (((ob >> 9) & 1) << 5)); }
__host__ __device__ __forceinline__ void stage_rc(int b, int& R, int& C) { const int st = b / 1024, sb = b % 1024, swz = sb ^ (((sb >> 9) & 1) << 5); R = (st >> 1) * 16 + swz / 64; C = (st & 1) * 32 + (swz % 64) / 2; }
struct Unit { int pm, pn, ui; };
struct Gemm { const bf16_t* A; const bf16_t* Bt; int M, N, K; };
struct StaticOrder {
    int nM, nN, nwg, G, c;
    __host__ __device__ void init(int M, int N, int G_, int c_) { nM = M / BM; nN = N / BM; nwg = nM * nN; G = G_; c = c_; }
    __host__ __device__ bool next(int i, Unit& u) const {
        const long L = (long)i * G + c; if (L >= nwg) return false;
        int wgid = (int)L; { const int q = nwg / NXCD, r = nwg % NXCD, xcd = wgid % NXCD, off = wgid / NXCD; wgid = (xcd < r ? xcd * (q + 1) : r * (q + 1) + (xcd - r) * q) + off; }
        const int nig = WGM * nN, gid = wgid / nig, fm = gid * WGM, gsz = (nM - fm) < WGM ? (nM - fm) : WGM;
        u.pm = fm + ((wgid % nig) % gsz); u.pn = (wgid % nig) / gsz; u.ui = i; return true;
    }
};
template <class Epi>
__device__ __forceinline__ void gemm_phase(LAS unsigned char* lds, const Gemm g, const StaticOrder& S, const Epi& E) {
    const int tid = opaque_tid(), wid = __builtin_amdgcn_readfirstlane(tid >> 6), lane = tid & 63, wr = wid >> 2, wc = wid & 3, fr = lane & 15, fq = lane >> 4;
    const int K = g.K, nt = K / BK;
    unsigned voffA[2];
#pragma unroll
    for (int i = 0; i < 2; ++i) { int R, C; stage_rc(tid * 16 + i * 8192, R, C); voffA[i] = (unsigned)(R * K + C) * 2u; }
    const size_t kstep = (size_t)(BK * 2);
    const size_t hstep = (size_t)HALF * K * 2;
    const size_t tstep = 2 * hstep;
    const unsigned ldsw = (unsigned)wid * 1024u;
    const int aoff = lds_byte(wr * 64 + fr, fq * 8), boff = lds_byte(wc * 32 + fr, fq * 8);
#define PG8_SA(b, h) (((b) * 2 + (h)) * HTB)
#define PG8_SB(b, h) ((4 + (b) * 2 + (h)) * HTB)
#define PG8_STAGE(bufoff, gbase, voff) do { _Pragma("unroll") for (int _i = 0; _i < 2; ++_i) \
        __builtin_amdgcn_global_load_lds((const unsigned*)((const char*)(gbase) + (voff)[_i]), (LAS unsigned*)(lds + (bufoff) + ldsw + _i * 8192), 16, 0, 0); } while (0)
#define PG8_LDA(dst, b, h) do { _Pragma("unroll") for (int m = 0; m < 4; ++m) _Pragma("unroll") for (int k = 0; k < 2; ++k) dst[m][k] = *(const LAS bf16x8*)(lds + PG8_SA(b, h) + aoff + m * 2048 + k * 1024); } while (0)
#define PG8_LDB(dst, b, h) do { _Pragma("unroll") for (int n = 0; n < 2; ++n) _Pragma("unroll") for (int k = 0; k < 2; ++k) dst[n][k] = *(const LAS bf16x8*)(lds + PG8_SB(b, h) + boff + n * 2048 + k * 1024); } while (0)
#define PG8_MMA(ai, bj, At, Bt) do { __builtin_amdgcn_s_setprio(1); _Pragma("unroll") for (int m = 0; m < 4; ++m) _Pragma("unroll") for (int n = 0; n < 2; ++n) _Pragma("unroll") for (int k = 0; k < 2; ++k) \
        acc[ai][bj][m][n] = __builtin_amdgcn_mfma_f32_16x16x32_bf16(Bt[n][k], At[m][k], acc[ai][bj][m][n], 0, 0, 0); __builtin_amdgcn_s_setprio(0); } while (0)
#define PG8_WAIT_V(n) asm volatile("s_waitcnt vmcnt(" #n ")" ::: "memory")
#define PG8_WAIT_L(n) asm volatile("s_waitcnt lgkmcnt(" #n ")" ::: "memory")
#define PG8_BAR __builtin_amdgcn_s_barrier()
#define PG8_SCHED __builtin_amdgcn_sched_barrier(0)
    Unit cur, nxt; int ui = 0;
    if (!S.next(0, cur)) return;
    f32x4 acc[2][2][4][2];
#pragma unroll
    for (int a = 0; a < 2; ++a)
#pragma unroll
        for (int b = 0; b < 2; ++b)
#pragma unroll
            for (int m = 0; m < 4; ++m)
#pragma unroll
                for (int n = 0; n < 2; ++n) acc[a][b][m][n] = (f32x4){0.f, 0.f, 0.f, 0.f};
    bf16x8 At[4][2], B0[2][2], B1[2][2];
    const char* cA = (const char*)g.A + (size_t)cur.pm * tstep; const char* cB = (const char*)g.Bt + (size_t)cur.pn * tstep;
    PG8_STAGE(PG8_SB(0, 0), cB, voffA); PG8_STAGE(PG8_SB(0, 1), cB + hstep, voffA); PG8_STAGE(PG8_SA(0, 0), cA, voffA); PG8_STAGE(PG8_SA(0, 1), cA + hstep, voffA);
    if (wr == 1) PG8_BAR;
    PG8_WAIT_V(2); PG8_BAR;
    PG8_STAGE(PG8_SB(1, 0), cB + kstep, voffA); PG8_STAGE(PG8_SA(1, 0), cA + kstep, voffA); PG8_STAGE(PG8_SB(1, 1), cB + hstep + kstep, voffA);
    PG8_WAIT_V(6); PG8_BAR;
    for (;;) {
        const bool has_next = S.next(ui + 1, nxt);
        const char* nA = has_next ? (const char*)g.A + (size_t)nxt.pm * tstep : cA; const char* nB = has_next ? (const char*)g.Bt + (size_t)nxt.pn * tstep : cB;
        for (int t = 0; t < nt; t += 2) {
            const bool last = (t == nt - 2);
            const char* a1 = cA + (size_t)(t + 1) * kstep;
            const char* a2 = last ? nA : cA + (size_t)(t + 2) * kstep; const char* b2 = last ? nB : cB + (size_t)(t + 2) * kstep;
            const char* a3 = a2 + kstep; const char* b3 = b2 + kstep;
            PG8_LDB(B0, 0, 0); PG8_LDB(B1, 0, 1); PG8_SCHED; PG8_LDA(At, 0, 0); PG8_STAGE(PG8_SA(1, 1), a1 + hstep, voffA);
            PG8_WAIT_V(8); PG8_WAIT_L(0); PG8_BAR; PG8_MMA(0, 0, At, B0); PG8_MMA(0, 1, At, B1); PG8_BAR; PG8_SCHED;
            PG8_LDA(At, 0, 1); PG8_STAGE(PG8_SB(0, 0), b2, voffA); PG8_STAGE(PG8_SB(0, 1), b2 + hstep, voffA); PG8_STAGE(PG8_SA(0, 0), a2, voffA);
            PG8_WAIT_V(8); PG8_WAIT_L(0); PG8_BAR; PG8_MMA(1, 0, At, B0); PG8_MMA(1, 1, At, B1); PG8_BAR; PG8_SCHED;
            PG8_LDB(B0, 1, 0); PG8_LDB(B1, 1, 1); PG8_SCHED; PG8_LDA(At, 1, 0); PG8_STAGE(PG8_SA(0, 1), a2 + hstep, voffA);
            PG8_WAIT_V(8); PG8_WAIT_L(0); PG8_BAR; PG8_MMA(0, 0, At, B0); PG8_MMA(0, 1, At, B1); PG8_BAR; PG8_SCHED;
            PG8_LDA(At, 1, 1); PG8_STAGE(PG8_SB(1, 0), b3, voffA); PG8_STAGE(PG8_SB(1, 1), b3 + hstep, voffA); PG8_STAGE(PG8_SA(1, 0), a3, voffA);
            PG8_WAIT_V(8); PG8_WAIT_L(0); PG8_BAR; PG8_MMA(1, 0, At, B0); PG8_MMA(1, 1, At, B1); PG8_BAR; PG8_SCHED;
        }
        if (wr == 0) PG8_BAR;
        if (!Epi::AFTER_DRAIN || has_next) { int fr2 = fr, fq2 = fq; asm volatile("" : "+v"(fr2), "+v"(fq2)); E(acc, cur, wr, wc, fr2, fq2); }
        if (!has_next) break;
#pragma unroll
        for (int a = 0; a < 2; ++a)
#pragma unroll
            for (int b = 0; b < 2; ++b)
#pragma unroll
                for (int m = 0; m < 4; ++m)
#pragma unroll
                    for (int n = 0; n < 2; ++n) acc[a][b][m][n] = (f32x4){0.f, 0.f, 0.f, 0.f};
        cur = nxt; cA = nA; cB = nB; ++ui;
        if (wr == 1) PG8_BAR;
    }
    PG8_WAIT_V(0);
    PG8_BAR;
    if constexpr (Epi::AFTER_DRAIN) { int fr2 = fr, fq2 = fq; asm volatile("" : "+v"(fr2), "+v"(fq2)); E.fused(acc, cur, wr, wc, fr2, fq2, lds); }
#undef PG8_SA
#undef PG8_SB
#undef PG8_STAGE
#undef PG8_LDA
#undef PG8_LDB
#undef PG8_MMA
#undef PG8_WAIT_V
#undef PG8_WAIT_L
#undef PG8_BAR
#undef PG8_SCHED
}
}

__device__ __forceinline__ float wave_sum(float v);
#define ACC_ARG const f32x4 (&acc)[2][2][4][2]
#define EPI_FENCE() asm volatile("" ::: "memory")
constexpr int RTAB_OFF = RING_BYTES + 1024;
__device__ __forceinline__ void prep_rs(const float* ssq, int row_off, const pg8::StaticOrder& S, LAS unsigned char* lds) {
    const int tid = opaque_tid(); LAS float* rtab = (LAS float*)(lds + RTAB_OFF); pg8::Unit u;
    for (int i = 0; i < 6 && S.next(i, u); ++i) if (tid < 256) rtab[i * 256 + tid] = row_rs(ssq, row_off + u.pm * 256 + tid);
    __syncthreads();
}
struct EpiSwiglu {
    static constexpr bool AFTER_DRAIN = false;
    bf16_t* O; const LAS float* rtab;
    __device__ __forceinline__ void operator()(ACC_ARG, const pg8::Unit& u, int wr, int wc, int fr, int fq) const {
        const int lr0 = wr * 64 + fr, col0 = u.pn * 128 + wc * 32 + 4 * fq;
#pragma unroll
        for (int ai = 0; ai < 2; ++ai)
#pragma unroll
            for (int m = 0; m < 4; ++m) {
                const int lr = lr0 + ai * 128 + m * 16;
                const float rs = rtab ? rtab[u.ui * 256 + lr] : 1.0f;
#pragma unroll
                for (int n = 0; n < 2; ++n) {
                    const f32x4 gt = acc[ai][0][m][n] * rs, up = acc[ai][1][m][n] * rs; f32x4 v;
#pragma unroll
                    for (int j = 0; j < 4; ++j) v[j] = siluf(gt[j]) * up[j];
                    *(u32x2*)(O + (size_t)(u.pm * 256 + lr) * DFF + col0 + n * 16) = pack4(v);
                }
            }
    }
};
struct EpiResid {
    static constexpr bool AFTER_DRAIN = true;
    const float* base; float* out; bf16_t* xb; float* ssq; float scale; int skip;
    __device__ __forceinline__ void operator()(ACC_ARG, const pg8::Unit& u, int wr, int wc, int fr, int fq) const {
        if (skip) return;
        const int row0 = u.pm * 256 + wr * 64 + fr, col0 = u.pn * 256 + wc * 32 + 4 * fq;
#pragma unroll
        for (int ai = 0; ai < 2; ++ai)
#pragma unroll
            for (int m = 0; m < 4; ++m) {
                const int row = row0 + ai * 128 + m * 16; float ss = 0.f;
#pragma unroll
                for (int bj = 0; bj < 2; ++bj)
#pragma unroll
                    for (int n = 0; n < 2; ++n) {
                        const size_t off = (size_t)row * DM + col0 + bj * 128 + n * 16;
                        const f32x4 v = *(const f32x4*)(base + off) + acc[ai][bj][m][n] * scale;
                        *(f32x4*)(out + off) = v;
                        if (xb) *(u32x2*)(xb + off) = pack4(v);
                        ss += (v[0] * v[0] + v[1] * v[1]) + (v[2] * v[2] + v[3] * v[3]);
                    }
                if (ssq) { ss += __shfl_xor(ss, 16); ss += __shfl_xor(ss, 32); if (fq == 0) atomicAdd(ssq + (size_t)row * 4 + u.pn, ss); }
            }
    }
    __device__ __forceinline__ void fused(ACC_ARG, const pg8::Unit& u, int wr, int wc, int fr, int fq, LAS unsigned char* lds) const {
        if (skip) return;
        const int tid = opaque_tid(), lane = tid & 63, wave = __builtin_amdgcn_readfirstlane(tid >> 6);
        LAS float* tl = (LAS float*)lds;
#pragma unroll
        for (int ai = 0; ai < 2; ++ai)
#pragma unroll
            for (int wq = 0; wq < 2; ++wq) {
                if (wr == wq) {
#pragma unroll
                    for (int m = 0; m < 4; ++m)
#pragma unroll
                        for (int bj = 0; bj < 2; ++bj)
#pragma unroll
                            for (int n = 0; n < 2; ++n) *(LAS f32x4*)(tl + (16 * m + fr) * 260 + bj * 128 + wc * 32 + n * 16 + 4 * fq) = acc[ai][bj][m][n] * scale;
                }
                __syncthreads();
                const int rbase = u.pm * 256 + ai * 128 + wq * 64;
                f32x4 bv[8];
#pragma unroll
                for (int r = 0; r < 8; ++r) bv[r] = *(const f32x4*)(base + (size_t)(rbase + wave * 8 + r) * DM + u.pn * 256 + lane * 4);
#pragma unroll
                for (int r = 0; r < 8; ++r) {
                    const int row = rbase + wave * 8 + r; const size_t off = (size_t)row * DM + u.pn * 256 + lane * 4;
                    const f32x4 v = bv[r] + *(const LAS f32x4*)(tl + (wave * 8 + r) * 260 + lane * 4);
                    *(f32x4*)(out + off) = v;
                    if (xb) *(u32x2*)(xb + off) = pack4(v);
                    if (ssq) { const float ss = wave_sum((v[0] * v[0] + v[1] * v[1]) + (v[2] * v[2] + v[3] * v[3])); if (lane == 0) ssq[(size_t)row * 4 + u.pn] = ss; }
                }
                __syncthreads();
            }
    }
};
struct EpiPlain {
    static constexpr bool AFTER_DRAIN = false;
    bf16_t* O; int ldo;
    __device__ __forceinline__ void operator()(ACC_ARG, const pg8::Unit& u, int wr, int wc, int fr, int fq) const {
        const int row0 = u.pm * 256 + wr * 64 + fr, col0 = u.pn * 256 + wc * 32 + 4 * fq;
#pragma unroll
        for (int ai = 0; ai < 2; ++ai)
#pragma unroll
            for (int m = 0; m < 4; ++m)
#pragma unroll
                for (int bj = 0; bj < 2; ++bj)
#pragma unroll
                    for (int n = 0; n < 2; ++n) *(u32x2*)(O + (size_t)(row0 + ai * 128 + m * 16) * ldo + col0 + bj * 128 + n * 16) = pack4(acc[ai][bj][m][n]);
    }
};
struct EpiMix {
    static constexpr bool AFTER_DRAIN = false;
    const LAS float* rtab; const float* rot;
    unsigned char* ws; const float *gdq, *gdk;
    __device__ __forceinline__ void operator()(ACC_ARG, const pg8::Unit& u, int wr, int wc, int fr, int fq) const {
        const int pn = u.pn, lr0 = wr * 64 + fr, lrow0 = u.pm * 256 + lr0;
        if (pn < 8) {
            const bool isk = pn >= 4; const int h = pn & 3; bf16_t* dst = (bf16_t*)(ws + (isk ? WS_K : WS_Q)); bf16_t* kts = (bf16_t*)(ws + WS_KTS);
            const float lg2 = log2f(1.0f - __builtin_amdgcn_exp2f(-5.0f - (float)h));
#pragma unroll
            for (int ai = 0; ai < 2; ++ai) {
                f32x4 cs0[4][2], cs1[4][2];
#pragma unroll
                for (int m = 0; m < 4; ++m)
#pragma unroll
                    for (int n = 0; n < 2; ++n) { const f32x4* cs = (const f32x4*)(rot + ((size_t)(lrow0 + ai * 128 + m * 16) * 128 + wc * 32 + n * 16 + 4 * fq) * 2); cs0[m][n] = cs[0]; cs1[m][n] = cs[1]; }
                EPI_FENCE();
#pragma unroll
                for (int m = 0; m < 4; ++m) {
                    int lrow = lrow0 + ai * 128 + m * 16; asm volatile("" : "+v"(lrow));
                    const float rs = rtab[u.ui * 256 + lr0 + ai * 128 + m * 16] * (isk ? 0.0625f : 1.0f);
                    const float dec = __builtin_amdgcn_exp2f(lg2 * (float)(127 - (lrow & 127)));
#pragma unroll
                    for (int n = 0; n < 2; ++n) {
                        const int i0 = wc * 32 + n * 16 + 4 * fq;
                        const f32x4 c01 = cs0[m][n], c23 = cs1[m][n];
                        const f32x4 cv = (f32x4){c01[0], c01[2], c23[0], c23[2]}, sv = (f32x4){c01[1], c01[3], c23[1], c23[3]};
                        const f32x4 x1 = acc[ai][0][m][n] * rs, x2 = acc[ai][1][m][n] * rs;
                        const f32x4 o1 = x1 * cv - x2 * sv, o2 = x1 * sv + x2 * cv;
                        *(u32x2*)(dst + (size_t)lrow * 1024 + h * 256 + i0) = pack4(o1);
                        *(u32x2*)(dst + (size_t)lrow * 1024 + h * 256 + 128 + i0) = pack4(o2);
                        if (isk) {
#pragma unroll
                            for (int j = 0; j < 4; ++j) {
                                kts[(size_t)(h * 256 + i0 + j) * SEQ + lrow] = bf16_1(o1[j] * dec);
                                kts[(size_t)(h * 256 + 128 + i0 + j) * SEQ + lrow] = bf16_1(o2[j] * dec);
                            }
                        }
                    }
                }
                EPI_FENCE();
            }
        } else if (pn < 16) {
            const int h = (pn - 8) >> 1, e0 = ((pn - 8) & 1) * 256; bf16_t* vt = (bf16_t*)(ws + WS_VT);
#pragma unroll
            for (int ai = 0; ai < 2; ++ai)
#pragma unroll
                for (int m = 0; m < 4; ++m) {
                    int lrow = lrow0 + ai * 128 + m * 16; asm volatile("" : "+v"(lrow));
                    const float rs = rtab[u.ui * 256 + lr0 + ai * 128 + m * 16];
#pragma unroll
                    for (int bj = 0; bj < 2; ++bj)
#pragma unroll
                        for (int n = 0; n < 2; ++n) {
                            const int ec = e0 + bj * 128 + wc * 32 + n * 16 + 4 * fq; const f32x4 v = acc[ai][bj][m][n] * rs;
#pragma unroll
                            for (int j = 0; j < 4; ++j) vt[(size_t)(h * 512 + ec + j) * SEQ + lrow] = bf16_1(v[j]);
                        }
                    EPI_FENCE();
                }
        } else if (pn < 24) {
            const bool isk = pn >= 20; const int tile = (pn - 16) & 3; bf16_t* dst = (bf16_t*)(ws + (isk ? WS_DK : WS_DQ)); const float* gn = isk ? gdk : gdq; const float mul = isk ? 1.0f : C2Q;
            f32x4 gv[2][2];
#pragma unroll
            for (int bj = 0; bj < 2; ++bj)
#pragma unroll
                for (int n = 0; n < 2; ++n) gv[bj][n] = *(const f32x4*)(gn + 32 * bj + 16 * n + 4 * fq);
#pragma unroll
            for (int ai = 0; ai < 2; ++ai)
#pragma unroll
                for (int m = 0; m < 4; ++m) {
                    int lrow = lrow0 + ai * 128 + m * 16; asm volatile("" : "+v"(lrow));
                    const float rs = rtab[u.ui * 256 + lr0 + ai * 128 + m * 16];
                    f32x4 v[2][2]; float ss = 0.f;
#pragma unroll
                    for (int bj = 0; bj < 2; ++bj)
#pragma unroll
                        for (int n = 0; n < 2; ++n) { v[bj][n] = acc[ai][bj][m][n] * rs; const f32x4 t = v[bj][n]; ss += (t[0] * t[0] + t[1] * t[1]) + (t[2] * t[2] + t[3] * t[3]); }
                    ss += __shfl_xor(ss, 16); ss += __shfl_xor(ss, 32);
                    const float rn = __builtin_amdgcn_rsqf(ss * (1.0f / 64.0f) + EPS) * mul;
#pragma unroll
                    for (int bj = 0; bj < 2; ++bj)
#pragma unroll
                        for (int n = 0; n < 2; ++n)
                            *(u32x2*)(dst + (size_t)lrow * 1024 + tile * 256 + 64 * wc + 32 * bj + 16 * n + 4 * fq) = pack4(v[bj][n] * rn * gv[bj][n]);
                    EPI_FENCE();
                }
        } else {
            bf16_t* dst = (bf16_t*)(ws + (pn < 28 ? WS_DV : WS_MQ)); const int tile = (pn - 24) & 3;
#pragma unroll
            for (int ai = 0; ai < 2; ++ai)
#pragma unroll
                for (int m = 0; m < 4; ++m) {
                    int lrow = lrow0 + ai * 128 + m * 16; asm volatile("" : "+v"(lrow));
                    const float rs = rtab[u.ui * 256 + lr0 + ai * 128 + m * 16];
#pragma unroll
                    for (int bj = 0; bj < 2; ++bj)
#pragma unroll
                        for (int n = 0; n < 2; ++n)
                            *(u32x2*)(dst + (size_t)lrow * 1024 + tile * 256 + bj * 128 + wc * 32 + n * 16 + 4 * fq) = pack4(acc[ai][bj][m][n] * rs);
                    EPI_FENCE();
                }
        }
    }
};
struct EpiRg {
    static constexpr bool AFTER_DRAIN = false;
    const LAS float* rtab; bf16_t* ret; const float* rssq;
    __device__ __forceinline__ void operator()(ACC_ARG, const pg8::Unit& u, int wr, int wc, int fr, int fq) const {
        const int lr0 = wr * 64 + fr, col0 = u.pn * 256 + wc * 32 + 4 * fq;
#pragma unroll
        for (int ai = 0; ai < 2; ++ai) {
            u32x2 rv[4][2][2]; f32x2 rq2[4];
#pragma unroll
            for (int m = 0; m < 4; ++m) { const int lr = lr0 + ai * 128 + m * 16;
                rq2[m] = *(const f32x2*)(rssq + (size_t)(u.pm * 256 + lr) * 8 + 2 * (u.pn >> 1));
#pragma unroll
                for (int bj = 0; bj < 2; ++bj)
#pragma unroll
                    for (int n = 0; n < 2; ++n) rv[m][bj][n] = *(const u32x2*)(ret + (size_t)(u.pm * 256 + lr) * 2048 + col0 + bj * 128 + n * 16); }
            EPI_FENCE();
#pragma unroll
            for (int m = 0; m < 4; ++m) {
                const int lr = lr0 + ai * 128 + m * 16; const float rs = rtab[u.ui * 256 + lr];
                const float rr = __builtin_amdgcn_rsqf((rq2[m][0] + rq2[m][1]) * (1.0f / 512.0f) + EPS);
#pragma unroll
                for (int bj = 0; bj < 2; ++bj)
#pragma unroll
                    for (int n = 0; n < 2; ++n) {
                        const u32x2 w = rv[m][bj][n]; const f32x4 a = acc[ai][bj][m][n] * rs; f32x4 v;
                        v[0] = __uint_as_float(w.x << 16) * siluf(a[0]); v[1] = __uint_as_float(w.x & 0xffff0000u) * siluf(a[1]);
                        v[2] = __uint_as_float(w.y << 16) * siluf(a[2]); v[3] = __uint_as_float(w.y & 0xffff0000u) * siluf(a[3]);
                        *(u32x2*)(ret + (size_t)(u.pm * 256 + lr) * 2048 + col0 + bj * 128 + n * 16) = pack4(v * rr);
                    }
            }
            EPI_FENCE();
        }
    }
};
struct EpiP5 {
    static constexpr bool AFTER_DRAIN = false;
    int kind; const LAS float* rtab; bf16_t* gbuf; bf16_t* y; int first;
    __device__ __forceinline__ void operator()(ACC_ARG, const pg8::Unit& u, int wr, int wc, int fr, int fq) const {
        const int lr0 = wr * 64 + fr, col0 = u.pn * 256 + wc * 32 + 4 * fq;
#pragma unroll
        for (int ai = 0; ai < 2; ++ai) {
            u32x2 gv[4][2][2], yv[4][2][2];
            if (kind != 0) {
#pragma unroll
                for (int m = 0; m < 4; ++m)
#pragma unroll
                    for (int bj = 0; bj < 2; ++bj)
#pragma unroll
                        for (int n = 0; n < 2; ++n) { const size_t off = (size_t)(u.pm * 256 + lr0 + ai * 128 + m * 16) * DM + col0 + bj * 128 + n * 16;
                            gv[m][bj][n] = *(const u32x2*)(gbuf + off); yv[m][bj][n] = first ? (u32x2){0u, 0u} : *(const u32x2*)(y + off); }
            }
            EPI_FENCE();
#pragma unroll
            for (int m = 0; m < 4; ++m) {
                const int lr = lr0 + ai * 128 + m * 16; const float rs = rtab[u.ui * 256 + lr];
#pragma unroll
                for (int bj = 0; bj < 2; ++bj)
#pragma unroll
                    for (int n = 0; n < 2; ++n) {
                        const size_t off = (size_t)(u.pm * 256 + lr) * DM + col0 + bj * 128 + n * 16;
                        const f32x4 a = acc[ai][bj][m][n]; f32x4 v;
                        if (kind == 0) {
#pragma unroll
                            for (int j = 0; j < 4; ++j) v[j] = sigmf(a[j] * rs);
                            *(u32x2*)(gbuf + off) = pack4(v);
                        } else {
                            const u32x2 gw = gv[m][bj][n], w = yv[m][bj][n];
                            v[0] = __uint_as_float(gw.x << 16) * a[0] + __uint_as_float(w.x << 16); v[1] = __uint_as_float(gw.x & 0xffff0000u) * a[1] + __uint_as_float(w.x & 0xffff0000u);
                            v[2] = __uint_as_float(gw.y << 16) * a[2] + __uint_as_float(w.y << 16); v[3] = __uint_as_float(gw.y & 0xffff0000u) * a[3] + __uint_as_float(w.y & 0xffff0000u);
                            *(u32x2*)(y + off) = pack4(v);
                        }
                    }
            }
            EPI_FENCE();
        }
    }
};

#include <hip/hip_bf16.h>
namespace attn_body {
using bf16=__hip_bfloat16;
using bf16x8=__attribute__((ext_vector_type(8)))short;
using s16x4=__attribute__((ext_vector_type(4)))short;
using f32x16=__attribute__((ext_vector_type(16)))float;
using u32x4=__attribute__((ext_vector_type(4)))unsigned;
constexpr int D=64,DM=1024;
constexpr int NW=8,QBLK=32,QB=QBLK*NW,KVBLK=64;
__device__ __forceinline__ int crow(int r,int hi){return (r&3)+8*(r>>2)+4*hi;}
#define SBAR() __builtin_amdgcn_sched_barrier(0)
__device__ __forceinline__ void cmask(f32x16&p0,f32x16&p1,int jb,int qrel,int hi){
  const float NEG=-INFINITY; int kb=64*jb+4*hi;
  #pragma unroll
  for(int r=0;r<16;++r){int kv=kb+(r&3)+8*(r>>2); if(kv>qrel)p0[r]=NEG; if(kv+32>qrel)p1[r]=NEG;}
}
constexpr int NSLOT=3, SLOTB=8192;
constexpr int LDS_K=0, LDS_V=NSLOT*SLOTB, LDS_WS=2*NSLOT*SLOTB, LDS_OST=LDS_WS+NW*64*4, LDS_BYTES=LDS_OST+NW*4096;
__device__ __forceinline__ void glds16(const void*gsrc,unsigned lds_dst){unsigned keep;
  asm volatile("s_mov_b32 %0, m0\n\ts_mov_b32 m0, %2\n\ts_nop 0\n\tglobal_load_lds_dwordx4 %1, off\n\ts_mov_b32 m0, %0":"=&s"(keep):"v"(gsrc),"s"(lds_dst):"memory");}
__device__ __forceinline__ float max3f(float a,float b,float c){float r;asm("v_max3_f32 %0, %1, %2, %3":"=v"(r):"v"(a),"v"(b),"v"(c));return r;}
__device__ __forceinline__ float max2f(float a,float b){float r;asm("v_max_f32_e32 %0, %1, %2":"=v"(r):"v"(a),"v"(b));return r;}
__device__ __forceinline__ float fadd_s(float a,float b){float r;asm("v_add_f32_e32 %0, %1, %2":"=v"(r):"v"(a),"v"(b));return r;}
__device__ __forceinline__ float fsub_s(float a,float b){float r;asm("v_sub_f32_e32 %0, %1, %2":"=v"(r):"v"(a),"v"(b));return r;}
typedef float f32x2_t __attribute__((ext_vector_type(2))); typedef __bf16 bf16x2_t __attribute__((ext_vector_type(2)));
__device__ __forceinline__ unsigned cvtpk_s(float lo,float hi){f32x2_t v={lo,hi};bf16x2_t b=__builtin_convertvector(v,bf16x2_t);return __builtin_bit_cast(unsigned,b);}
#define WAIT_BAR(N) asm volatile("s_waitcnt vmcnt(" #N ") lgkmcnt(0)\n\ts_barrier":::"memory")
__device__ __forceinline__ void qkt(f32x16&p0,f32x16&p1,const char*Kslot,const bf16x8*qr,const f32x16&negm,int r32,int hi){
  const char*kb=Kslot+hi*1024+r32*16;
  #pragma unroll
  for(int d0=0;d0<4;++d0){
    const bf16x8 b0=*reinterpret_cast<const bf16x8*>(kb+d0*2048);
    const bf16x8 b1=*reinterpret_cast<const bf16x8*>(kb+d0*2048+512);
    if(d0==0){p0=__builtin_amdgcn_mfma_f32_32x32x16_bf16(b0,qr[0],negm,0,0,0);p1=__builtin_amdgcn_mfma_f32_32x32x16_bf16(b1,qr[0],negm,0,0,0);}
    else{p0=__builtin_amdgcn_mfma_f32_32x32x16_bf16(b0,qr[d0],p0,0,0,0);p1=__builtin_amdgcn_mfma_f32_32x32x16_bf16(b1,qr[d0],p1,0,0,0);}}
}
typedef __attribute__((address_space(3))) const char* lds_cptr;
typedef short v4i16_t __attribute__((ext_vector_type(4)));
__device__ __forceinline__ void kload8(bf16x8*kf,lds_cptr kp){
  kf[0]=*(const __attribute__((address_space(3))) bf16x8*)(kp);      kf[1]=*(const __attribute__((address_space(3))) bf16x8*)(kp+512);
  kf[2]=*(const __attribute__((address_space(3))) bf16x8*)(kp+2048); kf[3]=*(const __attribute__((address_space(3))) bf16x8*)(kp+2560);
  kf[4]=*(const __attribute__((address_space(3))) bf16x8*)(kp+4096); kf[5]=*(const __attribute__((address_space(3))) bf16x8*)(kp+4608);
  kf[6]=*(const __attribute__((address_space(3))) bf16x8*)(kp+6144); kf[7]=*(const __attribute__((address_space(3))) bf16x8*)(kp+6656);
}
__device__ __forceinline__ void kload2(bf16x8*kf,lds_cptr kp,int j){ kf[2*j]=*(const __attribute__((address_space(3))) bf16x8*)(kp+j*2048); kf[2*j+1]=*(const __attribute__((address_space(3))) bf16x8*)(kp+j*2048+512); }
__device__ __forceinline__ s16x4 vtr(lds_cptr p){ return __builtin_bit_cast(s16x4,__builtin_amdgcn_ds_read_tr16_b64_v4i16((__attribute__((address_space(3))) v4i16_t*)p)); }
__device__ __forceinline__ float rowmax(const f32x16&p0,const f32x16&p1){
  float a=max3f(p0[0],p0[1],p1[0]),b=max3f(p0[2],p0[3],p1[1]);a=max3f(a,p1[2],p1[3]);
  #pragma unroll
  for(int r=4;r<16;r+=4){a=max3f(a,p0[r],p0[r+1]);b=max3f(b,p0[r+2],p0[r+3]);a=max3f(a,p1[r],p1[r+1]);b=max3f(b,p1[r+2],p1[r+3]);}
  const float m=max2f(a,b);
  auto rr=__builtin_amdgcn_permlane32_swap(__float_as_uint(m),__float_as_uint(m),false,false);
  return max2f(__uint_as_float(rr[0]),__uint_as_float(rr[1]));
}
__device__ __forceinline__ void pv(f32x16*o,int vb,bf16x8 pa0,bf16x8 pa1,bf16x8 pa2,bf16x8 pa3){
  #pragma unroll
  for(int d0=0;d0<2;++d0){s16x4 lo[4],hi[4];
    #pragma unroll
    for(int ks=0;ks<4;++ks){
      asm volatile("ds_read_b64_tr_b16 %0,%1 offset:%c2":"=&v"(lo[ks]):"v"(vb),"i"(d0*4096+ks*1024):"memory");
      asm volatile("ds_read_b64_tr_b16 %0,%1 offset:%c2":"=&v"(hi[ks]):"v"(vb),"i"(d0*4096+ks*1024+512):"memory");}
    asm volatile("s_waitcnt lgkmcnt(0)":::"memory");SBAR();
    #define PK(k) (bf16x8){lo[k][0],lo[k][1],lo[k][2],lo[k][3],hi[k][0],hi[k][1],hi[k][2],hi[k][3]}
    o[d0]=__builtin_amdgcn_mfma_f32_32x32x16_bf16(pa0,PK(0),o[d0],0,0,0);
    o[d0]=__builtin_amdgcn_mfma_f32_32x32x16_bf16(pa1,PK(1),o[d0],0,0,0);
    o[d0]=__builtin_amdgcn_mfma_f32_32x32x16_bf16(pa2,PK(2),o[d0],0,0,0);
    o[d0]=__builtin_amdgcn_mfma_f32_32x32x16_bf16(pa3,PK(3),o[d0],0,0,0);
    #undef PK
  }
}
#define ATTN_STORE16(p,v) (*(u32x4*)(p)=(v))
template<int THRL> __device__ __forceinline__ void attn_unit(int hq,int hv,int qb,const bf16*Q,const bf16*__restrict__ K,const bf16*__restrict__ V,bf16*O,char*shm){
  const int tid=opaque_tid(),lane=tid&63,r32=lane&31,hi=lane>>5; const int wid=__builtin_amdgcn_readfirstlane(tid>>6);
  const int q0=qb*QB;
  const bf16*Qw=Q+(long)(q0+wid*QBLK)*DM+hq*D;
  const bf16*Kh=K+hq*D,*Vh=V+hv*D;
  const unsigned lds0=(unsigned)(uintptr_t)shm;
  float*wsf=(float*)(shm+LDS_WS)+wid*64;
  const bf16*ksrc=Kh+(long)lane*DM+wid*8;
  const bf16*vsrc=Vh+(long)(16*(wid&3)+(lane>>2))*DM+(wid>>2)*32+(lane&3)*8;
  const unsigned kdst=lds0+LDS_K+wid*1024, vdst=lds0+LDS_V+wid*1024;
  #define DMA_K(t,slot) glds16(ksrc+(long)(t)*KVBLK*DM,(unsigned)__builtin_amdgcn_readfirstlane(kdst+(slot)))
  #define DMA_V(t,slot) glds16(vsrc+(long)(t)*KVBLK*DM,(unsigned)__builtin_amdgcn_readfirstlane(vdst+(slot)))
  const int vb0=(int)(lds0+LDS_V)+((lane>>4)&1)*32+(lane&3)*8+(4*hi+((lane&15)>>2))*64;
  const char*Kbase=shm+LDS_K; bf16x8 kf[8];
  const lds_cptr shm3=(lds_cptr)shm; const lds_cptr kp0=shm3+LDS_K+hi*1024+r32*16; const lds_cptr vp0=shm3+LDS_V+((lane>>4)&1)*32+(lane&3)*8+(4*hi+((lane&15)>>2))*64;
  const int NT=(q0+QB)/KVBLK;
  DMA_K(0,0);DMA_V(0,0);DMA_K(1,SLOTB);
  bf16x8 qr[4];
  #pragma unroll
  for(int d0=0;d0<4;++d0)qr[d0]=*reinterpret_cast<const bf16x8*>(&Qw[(long)r32*DM+d0*16+hi*8]);
  float mhat=0.f,l_reg=0.f;f32x16 o[2];o[0]=f32x16{};o[1]=f32x16{};f32x16 negm=f32x16{};asm volatile("":"+v"(negm));
  const int qrel=wid*QBLK+r32;
  #define CMASK(P0,P1,t) do{int jb_=(t)-(NT-4); if(jb_>=0)cmask(P0,P1,jb_,qrel,hi);}while(0)
  bool resc=false;
  #define START(P0,P1) do{ const float rm=rowmax(P0,P1); resc=false; \
    { const float dl=rm; mhat=fadd_s(mhat,dl); \
      _Pragma("unroll") for(int r=0;r<16;++r){P0[r]=fsub_s(P0[r],dl);P1[r]=fsub_s(P1[r],dl);} \
      _Pragma("unroll") for(int r=0;r<16;++r)negm[r]=-mhat; asm volatile("":"+v"(negm)); } \
    _Pragma("unroll") for(int r=0;r<16;++r)P0[r]=__builtin_amdgcn_exp2f(P0[r]); }while(0)
  #define RESC() do{ if(resc){ asm volatile("s_waitcnt lgkmcnt(0)":::"memory"); \
      _Pragma("unroll") for(int d_=0;d_<2;++d_) _Pragma("unroll") for(int r=0;r<16;++r)o[d_][r]*=wsf[crow(r,hi)]; } }while(0)
  f32x16 pA0,pA1,pB0,pB1;
  int sl_prev=0,sl_cur=0,sl_next=SLOTB;
  #define ROT() do{sl_prev=sl_cur;sl_cur=sl_next;sl_next=(sl_next==(NSLOT-1)*SLOTB)?0:sl_next+SLOTB;}while(0)
  DMA_K(2,2*SLOTB);
  WAIT_BAR(3);
  qkt(pA0,pA1,Kbase,qr,negm,r32,hi);asm volatile("s_nop 15\n\ts_nop 7":"+v"(pA0),"+v"(pA1));CMASK(pA0,pA1,0);
  START(pA0,pA1);
  _Pragma("unroll") for(int r=0;r<16;++r)pA1[r]=__builtin_amdgcn_exp2f(pA1[r]);
  WAIT_BAR(0);
  DMA_K(3,0);DMA_V(1,SLOTB);
  ROT();
  kload8(kf,kp0+sl_cur);
  WAIT_BAR(2);
  s16x4 vlo[8],vhi[8]; u32x4 pw0,pw1,pw2,pw3;
  #define PKW(P,B) cvtpk_s(P[B],P[B+1])
  #define PAF(k) __builtin_bit_cast(bf16x8,pw##k)
  #define VFR(i) (bf16x8){vlo[i][0],vlo[i][1],vlo[i][2],vlo[i][3],vhi[i][0],vhi[i][1],vhi[i][2],vhi[i][3]}
  #define PIN(x) asm volatile("":"+v"(x))
  #define MX3(a,b,c) __builtin_fmaxf(__builtin_fmaxf((a),(b)),(c))
  #define GAPA(MF,A0,A1,A2,A3,W0,W1,PW) do{ MF; sacc+=A0; sacc+=A1; sacc+=A2; sacc+=A3; PIN(sacc); W0; W1; PIN(PW); SBAR(); }while(0)
  #define EX(v) __builtin_amdgcn_exp2f(v)
  #define GAPB(MF,X,B) do{ MF; X[B]=EX(X[B]); X[B+1]=EX(X[B+1]); X[B+2]=EX(X[B+2]); X[B+3]=EX(X[B+3]); PIN(X); SBAR(); }while(0)
  #define VRD(i) do{ vlo[i]=vtr(vp_+(((i)>>2)*4096+((i)&3)*1024)); vhi[i]=vtr(vp_+(((i)>>2)*4096+((i)&3)*1024+512)); }while(0)
  #define KRD(G,j) do{ if(G){ kload2(kf,kp0+sl_next,j); SBAR(); } }while(0)
  #define STEP(C0,C1,P0,P1,t,GK,GV,GL) do{ SBAR(); \
    const lds_cptr vp_=vp0+sl_prev; \
    VRD(0); SBAR(); float sacc=(P0[0]+P0[1]); \
    GAPA(C0=__builtin_amdgcn_mfma_f32_32x32x16_bf16(kf[0],qr[0],negm,0,0,0), P0[2],P0[3],P0[4],P0[5],     pw0[0]=PKW(P0,0), pw0[1]=PKW(P0,2), pw0); \
    VRD(4); SBAR(); GAPA(C1=__builtin_amdgcn_mfma_f32_32x32x16_bf16(kf[1],qr[0],negm,0,0,0), P0[6],P0[7],P0[8],P0[9],     pw0[2]=PKW(P0,4), pw0[3]=PKW(P0,6), pw0); \
    VRD(1); SBAR(); GAPA(C0=__builtin_amdgcn_mfma_f32_32x32x16_bf16(kf[2],qr[1],C0,0,0,0),   P0[10],P0[11],P0[12],P0[13], pw1[0]=PKW(P0,8), pw1[1]=PKW(P0,10), pw1); \
    VRD(5); SBAR(); GAPA(C1=__builtin_amdgcn_mfma_f32_32x32x16_bf16(kf[3],qr[1],C1,0,0,0),   P0[14],P0[15],P1[0],P1[1],   pw1[2]=PKW(P0,12),pw1[3]=PKW(P0,14), pw1); \
    VRD(2); SBAR(); GAPA(C0=__builtin_amdgcn_mfma_f32_32x32x16_bf16(kf[4],qr[2],C0,0,0,0),   P1[2],P1[3],P1[4],P1[5],     pw2[0]=PKW(P1,0), pw2[1]=PKW(P1,2), pw2); \
    VRD(6); SBAR(); GAPA(C1=__builtin_amdgcn_mfma_f32_32x32x16_bf16(kf[5],qr[2],C1,0,0,0),   P1[6],P1[7],P1[8],P1[9],     pw2[2]=PKW(P1,4), pw2[3]=PKW(P1,6), pw2); \
    VRD(3); SBAR(); GAPA(C0=__builtin_amdgcn_mfma_f32_32x32x16_bf16(kf[6],qr[3],C0,0,0,0),   P1[10],P1[11],P1[12],P1[13], pw3[0]=PKW(P1,8), pw3[1]=PKW(P1,10), pw3); \
    VRD(7); SBAR(); GAPA(C1=__builtin_amdgcn_mfma_f32_32x32x16_bf16(kf[7],qr[3],C1,0,0,0),   P1[14],P1[15],0.f,0.f,       pw3[2]=PKW(P1,12),pw3[3]=PKW(P1,14), pw3); \
    l_reg+=sacc; \
    if(GK){DMA_K((t)+3,sl_cur);} if(GV){DMA_V((t)+1,sl_next);} \
    CMASK(C0,C1,t); \
    { float a=MX3(C0[0],C0[1],C1[0]),b=MX3(C0[2],C0[3],C1[1]); a=MX3(a,C1[2],C1[3]); \
      _Pragma("unroll") for(int r=4;r<16;r+=4){a=MX3(a,C0[r],C0[r+1]);b=MX3(b,C0[r+2],C0[r+3]);a=MX3(a,C1[r],C1[r+1]);b=MX3(b,C1[r+2],C1[r+3]);} \
      float rm=__builtin_fmaxf(a,b); { auto rr=__builtin_amdgcn_permlane32_swap(__float_as_uint(rm),__float_as_uint(rm),false,false); rm=__builtin_fmaxf(__uint_as_float(rr[0]),__uint_as_float(rr[1])); } \
      resc=false; \
      if(__builtin_expect(__any(rm>(float)THRL),0)){ const float dl=__builtin_fmaxf(rm,0.f); mhat+=dl; \
        _Pragma("unroll") for(int r=0;r<16;++r){C0[r]-=dl;C1[r]-=dl;} \
        _Pragma("unroll") for(int r=0;r<16;++r)negm[r]=-mhat; asm volatile("":"+v"(negm)); \
        const float f=__builtin_amdgcn_exp2f(-dl); l_reg*=f; if(hi==0)wsf[r32]=f; resc=true; } } \
    SBAR(); \
    GAPB(o[0]=__builtin_amdgcn_mfma_f32_32x32x16_bf16(PAF(0),VFR(0),o[0],0,0,0), C0,0); \
    GAPB(o[1]=__builtin_amdgcn_mfma_f32_32x32x16_bf16(PAF(0),VFR(4),o[1],0,0,0), C0,4); \
    KRD(GL,0); GAPB(o[0]=__builtin_amdgcn_mfma_f32_32x32x16_bf16(PAF(1),VFR(1),o[0],0,0,0), C0,8); \
    KRD(GL,1); GAPB(o[1]=__builtin_amdgcn_mfma_f32_32x32x16_bf16(PAF(1),VFR(5),o[1],0,0,0), C0,12); \
    KRD(GL,2); GAPB(o[0]=__builtin_amdgcn_mfma_f32_32x32x16_bf16(PAF(2),VFR(2),o[0],0,0,0), C1,0); \
    KRD(GL,3); GAPB(o[1]=__builtin_amdgcn_mfma_f32_32x32x16_bf16(PAF(2),VFR(6),o[1],0,0,0), C1,4); \
    GAPB(o[0]=__builtin_amdgcn_mfma_f32_32x32x16_bf16(PAF(3),VFR(3),o[0],0,0,0), C1,8); \
    GAPB(o[1]=__builtin_amdgcn_mfma_f32_32x32x16_bf16(PAF(3),VFR(7),o[1],0,0,0), C1,12); \
    }while(0)
  int t=1;
  #undef CMASK
  #define CMASK(P0,P1,t) do{}while(0)
  for(;t+5<NT;t+=2){
    STEP(pB0,pB1,pA0,pA1,t,true,true,true);     WAIT_BAR(2); RESC(); ROT();
    STEP(pA0,pA1,pB0,pB1,t+1,true,true,true);   WAIT_BAR(2); RESC(); ROT();
  }
  #undef CMASK
  #define CMASK(P0,P1,t) do{int jb_=(t)-(NT-4); if(jb_>=0)cmask(P0,P1,jb_,qrel,hi);}while(0)
  #define ENDW(tt) do{ if((tt)+3<NT){WAIT_BAR(2);} else if((tt)+2<NT){WAIT_BAR(1);} else {WAIT_BAR(0);} }while(0)
  for(;t+1<NT;t+=2){
    STEP(pB0,pB1,pA0,pA1,t,(t+3<NT),(t+1<NT),(t+1<NT));       ENDW(t);   RESC(); ROT();
    STEP(pA0,pA1,pB0,pB1,t+1,(t+4<NT),(t+2<NT),(t+2<NT));     ENDW(t+1); RESC(); ROT();
  }
  STEP(pB0,pB1,pA0,pA1,NT-1,false,false,false); RESC();
  { float sacc=pB0[0]+pB0[1]; _Pragma("unroll") for(int r=2;r<16;++r)sacc+=pB0[r]; _Pragma("unroll") for(int r=0;r<16;++r)sacc+=pB1[r]; l_reg+=sacc;
    pw0=(u32x4){PKW(pB0,0),PKW(pB0,2),PKW(pB0,4),PKW(pB0,6)};pw1=(u32x4){PKW(pB0,8),PKW(pB0,10),PKW(pB0,12),PKW(pB0,14)};pw2=(u32x4){PKW(pB1,0),PKW(pB1,2),PKW(pB1,4),PKW(pB1,6)};pw3=(u32x4){PKW(pB1,8),PKW(pB1,10),PKW(pB1,12),PKW(pB1,14)};
    SBAR(); pv(o,vb0+sl_cur,PAF(0),PAF(1),PAF(2),PAF(3)); }
  #undef PKW
  #undef PAF
  #undef VFR
  #undef PIN
  #undef MX3
  #undef GAPA
  #undef GAPB
  #undef EX
  #undef VRD
  #undef KRD
  #undef STEP
  #undef ENDW
  {auto rr=__builtin_amdgcn_permlane32_swap(__float_as_uint(l_reg),__float_as_uint(l_reg),false,false);l_reg=__uint_as_float(rr[0])+__uint_as_float(rr[1]);}
  if(hi==0)wsf[32+r32]=l_reg;asm volatile("s_waitcnt lgkmcnt(0)":::"memory");
  float rli[16];
  #pragma unroll
  for(int r=0;r<16;++r)rli[r]=__builtin_amdgcn_rcpf(wsf[32+crow(r,hi)]);
  bf16*Ow=O+(long)(q0+wid*QBLK)*DM+hv*D;
  { bf16*stg=(bf16*)(shm+LDS_OST)+wid*2048;
    #pragma unroll
    for(int r=0;r<16;++r){const int orow=crow(r,hi);
      #pragma unroll
      for(int d0=0;d0<2;++d0)stg[orow*64+d0*32+r32]=__float2bfloat16(o[d0][r]*rli[r]);}
    asm volatile("s_waitcnt lgkmcnt(0)":::"memory");
    #pragma unroll
    for(int i=0;i<4;++i){const int row=i*8+(lane>>3),ch=lane&7; const u32x4 v=*(const u32x4*)(stg+row*64+ch*8); ATTN_STORE16(Ow+(long)row*DM+ch*8,v);} }
  asm volatile("s_waitcnt lgkmcnt(0)\n\ts_barrier":::"memory");
  #undef DMA_K
  #undef DMA_V
  #undef CMASK
  #undef START
  #undef RESC
  #undef ROT
}
constexpr int ATTN_LDS_BYTES=LDS_BYTES;
#undef SBAR
#undef WAIT_BAR
}

typedef GAS unsigned gu32;
#define RLX_AGENT __ATOMIC_RELAXED, __HIP_MEMORY_SCOPE_AGENT
#define LDS_WAIT() asm volatile("s_waitcnt lgkmcnt(0)" ::: "memory")
#define XB_TMO      128
#define XB_XCNT(j)  (256  + 64 * (j))
#define XB_XSUB(j)  (1280 + 64 * (j))
#define XB_XGEN(j)  (2304 + 64 * (j))
#define XB_TOP      3328
#define XB_TOPGEN   3392
#define XCD_BAR_WORDS 3456
#define XB_SPIN_CAP (1u << 18)
__device__ __forceinline__ unsigned xb_ld(unsigned* p)              { return __hip_atomic_load(p, __ATOMIC_RELAXED, __HIP_MEMORY_SCOPE_AGENT); }
__device__ __forceinline__ unsigned xb_add(unsigned* p, unsigned v) { return __hip_atomic_fetch_add(p, v, __ATOMIC_RELAXED, __HIP_MEMORY_SCOPE_AGENT); }
__device__ __forceinline__ unsigned xb_xcc_id() { return (unsigned)__builtin_amdgcn_s_getreg((3 << 11) | 20) & 0xFu; }
#define XB_SPIN(cond, bar) do { unsigned _sp = 0; while (cond) { __builtin_amdgcn_s_sleep(1); \
    if ((++_sp & 255u) == 0u) { if (xb_ld(&(bar)[XB_TMO])) break; if (_sp > XB_SPIN_CAP) { atomicAdd(&(bar)[XB_TMO], 1u); break; } } } } while (0)
struct XcdBarrier { unsigned* bar; unsigned x; volatile LAS unsigned* st; };
__device__ __forceinline__ XcdBarrier xcd_barrier_post(unsigned* bar, volatile LAS unsigned* st) {
    XcdBarrier b; b.bar = bar; b.x = xb_xcc_id(); b.st = st;
    if (threadIdx.x == 0) (void)xb_add(&bar[XB_XCNT(b.x)], 1u);
    return b;
}
__device__ __forceinline__ void xcd_barrier_complete(unsigned* bar, unsigned x, unsigned& nloc, unsigned& nx) {
    const unsigned G = gridDim.x * gridDim.y * gridDim.z;
    unsigned sum, cnt, mine, sp = 0u;
    for (;;) {
        sum = 0u; cnt = 0u; mine = 0u;
#pragma unroll
        for (unsigned j = 0; j < 16; ++j) { const unsigned c = xb_ld(&bar[XB_XCNT(j)]); sum += c; cnt += (c > 0u) ? 1u : 0u; mine = (j == x) ? c : mine; }
        if (sum == G) break;
        __builtin_amdgcn_s_sleep(1);
        if ((++sp & 255u) == 0u) { if (xb_ld(&bar[XB_TMO])) break; if (sp > XB_SPIN_CAP) { atomicAdd(&bar[XB_TMO], 1u); break; } }
    }
    nloc = mine > 0u ? mine : 1u; nx = cnt > 0u ? cnt : 1u;
}
__device__ __forceinline__ void xcd_barrier(const XcdBarrier& b) {
    asm volatile("s_waitcnt vmcnt(0)" ::: "memory");
    __syncthreads();
    if (threadIdx.x == 0) {
        unsigned* bar = b.bar; asm volatile("" : "+v"(bar));
        __builtin_amdgcn_s_waitcnt(0);
        unsigned nloc = b.st[0], nx = b.st[1];
        if (nloc == 0u) { xcd_barrier_complete(bar, b.x, nloc, nx); b.st[0] = nloc; b.st[1] = nx; }
        const unsigned old = xb_add(&bar[XB_XSUB(b.x)], 1u);
        const unsigned gen = old / nloc;
        if (old + 1u == (gen + 1u) * nloc) {
            __builtin_amdgcn_fence(__ATOMIC_RELEASE, "agent");
            asm volatile("s_waitcnt vmcnt(0)" ::: "memory");
            const unsigned og = xb_add(&bar[XB_TOP], 1u);
            const unsigned tg = og / nx;
            if (og + 1u == (tg + 1u) * nx) xb_add(&bar[XB_TOPGEN], 1u);
            else XB_SPIN(xb_ld(&bar[XB_TOPGEN]) == tg, bar);
            __builtin_amdgcn_fence(__ATOMIC_ACQUIRE, "agent");
            xb_add(&bar[XB_XGEN(b.x)], 1u);
            asm volatile("s_waitcnt vmcnt(0)" ::: "memory");
        } else {
            XB_SPIN(xb_ld(&bar[XB_XGEN(b.x)]) == gen, bar);
            __builtin_amdgcn_fence(__ATOMIC_ACQUIRE, "agent");
            asm volatile("s_waitcnt vmcnt(0)" ::: "memory");
        }
    }
    __syncthreads();
}

__device__ __forceinline__ float wave_sum(float v) {
#pragma unroll
    for (int o = 1; o < 64; o <<= 1) v += __shfl_xor(v, o);
    return v;
}
template <class F>
__device__ __forceinline__ void transpose_item(const float* W, int K, int ld, bf16_t* WT, int nrows, F srccol, const float* gk, LAS float* scr, int item, int lane) {
    const int nblk = nrows / 32, kb = item / nblk, nb = item % nblk, k0 = 64 * kb, n0 = 32 * nb, s0 = srccol(n0);
#pragma unroll 8
    for (int i = 0; i < 32; ++i) { const int kk = 2 * i + (lane >> 5); float v = W[(size_t)(k0 + kk) * ld + s0 + (lane & 31)]; if (gk) v *= gk[k0 + kk]; scr[kk * 33 + (lane & 31)] = v; }
    LDS_WAIT(); asm volatile("" ::: "memory");
    const int c = lane & 7;
#pragma unroll
    for (int j = 0; j < 4; ++j) { const int n = (lane >> 3) + 8 * j; const LAS float* s = scr + (8 * c) * 33 + n;
        u32x4 o; o.x = cvt_pk_bf16(s[0 * 33], s[1 * 33]); o.y = cvt_pk_bf16(s[2 * 33], s[3 * 33]); o.z = cvt_pk_bf16(s[4 * 33], s[5 * 33]); o.w = cvt_pk_bf16(s[6 * 33], s[7 * 33]);
        *(u32x4*)(WT + (size_t)(n0 + n) * K + k0 + 8 * c) = o; }
    LDS_WAIT(); asm volatile("" ::: "memory");
}
struct ColIdent { int off; __device__ __forceinline__ int operator()(int r) const { return off + r; } };
struct ColSwiglu { __device__ __forceinline__ int operator()(int r) const { return ((r >> 7) & 1) * DFF + (r >> 8) * 128 + (r & 127); } };
struct ColMix { __device__ __forceinline__ int operator()(int r) const {
    const int tile = r >> 8, p = r & 255, o = 64 * ((p >> 5) & 3) + 32 * (p >> 7) + (p & 31);
    if (tile < 16) return r;
    if (tile < 20) return 6144 + (tile - 16) * 256 + o;
    if (tile < 24) return 7168 + (tile - 20) * 256 + o;
    if (tile < 28) return 8192 + (tile - 24) * 256 + p;
    return 9216 + (tile - 28) * 256 + p; } };
template <class F>
__device__ __forceinline__ void transpose_all(const float* W, int K, int ld, bf16_t* WT, int nrows, F srccol, const float* gk, LAS float* scr, int gw, int ngw, int lane) {
    const int nitems = (K / 64) * (nrows / 32);
    for (int it = gw; it < nitems; it += ngw) transpose_item(W, K, ld, WT, nrows, srccol, gk, scr, it, lane);
}
__device__ __forceinline__ void rms_row_to_bf16(const float* xrow, const float* gain, bf16_t* orow, int lane) {
    const f32x4* xr = (const f32x4*)xrow + lane; const f32x4* gr = (const f32x4*)gain + lane;
    f32x4 v[4]; float s = 0.f;
#pragma unroll
    for (int j = 0; j < 4; ++j) { v[j] = xr[64 * j]; s += (v[j][0] * v[j][0] + v[j][1] * v[j][1]) + (v[j][2] * v[j][2] + v[j][3] * v[j][3]); }
    const float r = __builtin_amdgcn_rsqf(wave_sum(s) * (1.f / 1024.f) + EPS);
    u32x2* o8 = (u32x2*)orow + lane;
#pragma unroll
    for (int j = 0; j < 4; ++j) o8[64 * j] = pack4(v[j] * r * gr[64 * j]);
}
__device__ __forceinline__ void rot_table(const int* pos, float* rot, int gt, int ngt) {
    for (int idx = gt; idx < SEQ * 128; idx += ngt) {
        const int s = idx >> 7, i = idx & 127;
        const float inv = exp2f(-(float)i * (13.287712379549449f / 128.0f));
        const float ang = (float)pos[s] * inv;
        const float kq = rintf(ang * 0.6366197723675814f);
        float r = fmaf(-kq, 1.5703125f, ang); r = fmaf(-kq, 4.837512969970703125e-4f, r); r = fmaf(-kq, 7.54978995489188216e-8f, r);
        const float r2 = r * r;
        const float sn = r + r * r2 * (-1.6666667e-1f + r2 * (8.3333333e-3f + r2 * (-1.9841270e-4f + r2 * 2.7557319e-6f)));
        const float cn = 1.0f + r2 * (-0.5f + r2 * (4.1666668e-2f + r2 * (-1.3888889e-3f + r2 * (2.4801587e-5f + r2 * -2.7557319e-7f))));
        const int qd = ((int)kq) & 3;
        const float c = (qd == 0) ? cn : (qd == 1) ? -sn : (qd == 2) ? -cn : sn;
        const float sv = (qd == 0) ? sn : (qd == 1) ? cn : (qd == 2) ? -sn : -cn;
        *(f32x2*)(rot + (size_t)idx * 2) = (f32x2){c, sv};
    }
}

constexpr int SCN_LD = 136, SCN_V_OFF = 32 * SCN_LD * 2;
__device__ __forceinline__ void scan_unit(int u, const bf16_t* kts, const bf16_t* vt, bf16_t* S, LAS unsigned char* lds, unsigned* done  ) {
    const int tid = opaque_tid(), lane = tid & 63, wave = __builtin_amdgcn_readfirstlane(tid >> 6);
    const int fr = lane & 15, fq = lane >> 4, h = u >> 6, dg = (u >> 3) & 7, eg = u & 7, wd = wave & 1, we = wave >> 1;
    LAS bf16_t* lk = (LAS bf16_t*)lds; LAS bf16_t* lv = (LAS bf16_t*)(lds + SCN_V_OFF);
    const float gC = __builtin_amdgcn_exp2f(128.0f * log2f(1.0f - __builtin_amdgcn_exp2f(-5.0f - (float)h)));
    f32x4 acc = (f32x4){0.f, 0.f, 0.f, 0.f};
    const bf16_t* ksrc = kts + (size_t)(h * 256 + 32 * dg + (tid >> 4)) * SEQ + (tid & 15) * 8;
    const bf16_t* vsrc = vt + (size_t)(h * 512 + 64 * eg + (tid >> 4)) * SEQ + (tid & 15) * 8;
    u32x4 pk = *(const u32x4*)ksrc, pv0 = *(const u32x4*)vsrc, pv1 = *(const u32x4*)(vsrc + (size_t)32 * SEQ);
    bf16_t* sdst = S + ((size_t)(h * 16) * 512 + 64 * eg + 16 * we + fr) * 256 + 32 * dg + 16 * wd + 4 * fq;
#pragma unroll 1
    for (int c = 0; c < 16; ++c) {
        { const u32x2 w = pack4(acc);
          __hip_atomic_store((unsigned long long*)(sdst + (size_t)c * 512 * 256), ((unsigned long long)w.y << 32) | w.x, __ATOMIC_RELAXED, __HIP_MEMORY_SCOPE_AGENT); }
        if (c == 15) break;
        __syncthreads();
        *(LAS u32x4*)(lk + (tid >> 4) * SCN_LD + (tid & 15) * 8) = pk;
        *(LAS u32x4*)(lv + (tid >> 4) * SCN_LD + (tid & 15) * 8) = pv0;
        *(LAS u32x4*)(lv + (32 + (tid >> 4)) * SCN_LD + (tid & 15) * 8) = pv1;
        __syncthreads();
        if (c < 14) { pk = *(const u32x4*)(ksrc + (c + 1) * 128); pv0 = *(const u32x4*)(vsrc + (c + 1) * 128); pv1 = *(const u32x4*)(vsrc + (size_t)32 * SEQ + (c + 1) * 128); }
        f32x4 tm = (f32x4){0.f, 0.f, 0.f, 0.f};
#pragma unroll
        for (int ks = 0; ks < 4; ++ks) {
            const bf16x8 a = *(const LAS bf16x8*)(lk + (16 * wd + fr) * SCN_LD + 32 * ks + 8 * fq);
            const bf16x8 b = *(const LAS bf16x8*)(lv + (16 * we + fr) * SCN_LD + 32 * ks + 8 * fq);
            tm = mfma16(a, b, tm);
        }
        acc = acc * gC + tm;
    }
    asm volatile("s_waitcnt vmcnt(0)" ::: "memory");
    __syncthreads();
    if (tid == 0) __hip_atomic_fetch_add(done + ((h * 2 + (eg >> 2)) * 64), 1u, __ATOMIC_RELAXED, __HIP_MEMORY_SCOPE_AGENT);
}
constexpr int RQ_LD = 264, SC_LD = 136, RO_SC_OFF = 128 * RQ_LD * 2, RO_PART_OFF = RO_SC_OFF + 128 * SC_LD * 2;
__device__ __forceinline__ void retout_unit(int h, int c, int eh, const bf16_t* q, const bf16_t* k, const bf16_t* vt, const bf16_t* S, bf16_t* ret  , float* rssq, LAS unsigned char* lds, unsigned* done, unsigned* tmo) {
    const int tid = opaque_tid(), lane = tid & 63, wave = __builtin_amdgcn_readfirstlane(tid >> 6);
    const int fr = lane & 15, fq = lane >> 4;
    LAS bf16_t* ql = (LAS bf16_t*)lds; LAS bf16_t* sc = (LAS bf16_t*)(lds + RO_SC_OFF); LAS float* part = (LAS float*)(lds + RO_PART_OFF);
    const float lg2 = log2f(1.0f - __builtin_amdgcn_exp2f(-5.0f - (float)h));
    const int tok0 = c * 128;
#pragma unroll
    for (int i = 0; i < 8; ++i) { const int p = tid + 512 * i, row = p >> 5, c16 = p & 31;
        *(LAS u32x4*)(ql + row * RQ_LD + c16 * 8) = *(const u32x4*)(q + (size_t)(tok0 + row) * 1024 + h * 256 + c16 * 8); }
    const bf16_t* sp = S + ((size_t)((h * 16 + c) * 512 + 256 * eh + 32 * wave + fr)) * 256 + 8 * fq;
    const bf16_t* vp = vt + (size_t)(h * 512 + 256 * eh + 32 * wave + fr) * SEQ + tok0 + 8 * fq;
    __syncthreads();
    {
        const int ti = wave; const int i = 16 * ti + fr;
        bf16x8 qf[8];
#pragma unroll
        for (int ks = 0; ks < 8; ++ks) qf[ks] = *(const LAS bf16x8*)(ql + (16 * ti + fr) * RQ_LD + 32 * ks + 8 * fq);
        const bf16_t* kp = k + (size_t)(tok0 + fr) * 1024 + h * 256 + 8 * fq;
#pragma unroll
        for (int tj = 0; tj < 8; ++tj) {
            if (tj <= (ti | 1)) {
                f32x4 v = (f32x4){0.f, 0.f, 0.f, 0.f};
                if (tj <= ti) {
                    f32x4 s2 = (f32x4){0.f, 0.f, 0.f, 0.f};
#pragma unroll
                    for (int ks = 0; ks < 8; ++ks) { const bf16x8 kf = *(const bf16x8*)(kp + (size_t)(16 * tj) * 1024 + 32 * ks); s2 = mfma16(kf, qf[ks], s2); }
#pragma unroll
                    for (int r = 0; r < 4; ++r) { const int j = 16 * tj + 4 * fq + r; v[r] = (i >= j) ? s2[r] * __builtin_amdgcn_exp2f(lg2 * (float)(i - j)) : 0.f; }
                }
                *(LAS u32x2*)(sc + (16 * ti + fr) * SC_LD + 16 * tj + 4 * fq) = pack4(v);
            }
        }
    }
    if (tid < 64) {
        unsigned* f = done + ((h * 2 + eh) * 64); unsigned sp = 0;
        while ((unsigned)__builtin_amdgcn_readfirstlane(__hip_atomic_load(f, __ATOMIC_RELAXED, __HIP_MEMORY_SCOPE_AGENT)) < 32u) {
            __builtin_amdgcn_s_sleep(2);
            if (++sp > (1u << 20)) { if (tid == 0) __hip_atomic_store(tmo, 1u, __ATOMIC_RELAXED, __HIP_MEMORY_SCOPE_AGENT); break; }
        }
        __builtin_amdgcn_fence(__ATOMIC_ACQUIRE, "agent");
        asm volatile("s_waitcnt vmcnt(0)" ::: "memory");
    }
    __syncthreads();
    f32x4 acc[8][2];
#pragma unroll
    for (int a = 0; a < 8; ++a)
#pragma unroll
        for (int b = 0; b < 2; ++b) acc[a][b] = (f32x4){0.f, 0.f, 0.f, 0.f};
#pragma unroll
    for (int ks = 0; ks < 8; ++ks) {
        bf16x8 sf[2], qf[8];
#pragma unroll
        for (int t = 0; t < 2; ++t) sf[t] = *(const bf16x8*)(sp + (size_t)(16 * t) * 256 + 32 * ks);
#pragma unroll
        for (int t = 0; t < 8; ++t) qf[t] = *(const LAS bf16x8*)(ql + (16 * t + fr) * RQ_LD + 32 * ks + 8 * fq);
#pragma unroll
        for (int a = 0; a < 8; ++a)
#pragma unroll
            for (int b = 0; b < 2; ++b) acc[a][b] = mfma16(sf[b], qf[a], acc[a][b]);
    }
#pragma unroll
    for (int a = 0; a < 8; ++a) { const float qd = __builtin_amdgcn_exp2f(lg2 * (float)(16 * a + fr + 1));
#pragma unroll
        for (int b = 0; b < 2; ++b) acc[a][b] = acc[a][b] * qd; }
#pragma unroll
    for (int ks = 0; ks < 4; ++ks) {
        bf16x8 vf[2];
#pragma unroll
        for (int t = 0; t < 2; ++t) vf[t] = *(const bf16x8*)(vp + (size_t)(16 * t) * SEQ + 32 * ks);
#pragma unroll
        for (int a = 0; a < 8; ++a) {
            if (a >= 2 * ks) {
                const bf16x8 pf = *(const LAS bf16x8*)(sc + (16 * a + fr) * SC_LD + 32 * ks + 8 * fq);
#pragma unroll
                for (int b = 0; b < 2; ++b) acc[a][b] = mfma16(vf[b], pf, acc[a][b]);
            }
        }
    }
#pragma unroll
    for (int a = 0; a < 8; ++a) {
        float ss = 0.f;
#pragma unroll
        for (int b = 0; b < 2; ++b) { const f32x4 t = acc[a][b]; ss += (t[0] * t[0] + t[1] * t[1]) + (t[2] * t[2] + t[3] * t[3]); }
        ss += __shfl_xor(ss, 16); ss += __shfl_xor(ss, 32);
        if (fq == 0) part[wave * 128 + 16 * a + fr] = ss;
    }
    __syncthreads();
    if (tid < 128) {
        float tot = 0.f;
#pragma unroll
        for (int w = 0; w < 8; ++w) tot += part[w * 128 + tid];
        rssq[(size_t)(tok0 + tid) * 8 + 2 * h + eh] = tot;
    }
#pragma unroll
    for (int a = 0; a < 8; ++a)
#pragma unroll
        for (int b = 0; b < 2; ++b)
            *(u32x2*)(ret + (size_t)(tok0 + 16 * a + fr) * 2048 + h * 512 + 256 * eh + 32 * wave + 16 * b + 4 * fq) = pack4(acc[a][b]);
    __syncthreads();
}
constexpr int PL_LD = 264, MA_KV_BYTES = 64 * 264 * 2, MA_P_OFF = MA_KV_BYTES;
__device__ __forceinline__ void memattn_unit(int b, int h, int rb, const bf16_t* mq, const bf16_t* mkn, const bf16_t* mvt, bf16_t* mo  , LAS unsigned char* lds) {
    const int tid = opaque_tid(), lane = tid & 63, wave = __builtin_amdgcn_readfirstlane(tid >> 6);
    const int fr = lane & 15, fq = lane >> 4;
    LAS bf16_t* kv = (LAS bf16_t*)lds; LAS bf16_t* pl = (LAS bf16_t*)(lds + MA_P_OFF) + wave * (16 * PL_LD);
    const int row = 128 * rb + 16 * wave + fr;
    const bf16_t* ksrc = mkn + (size_t)(b * 256) * 1024 + h * 256;
    const bf16_t* vsrc = mvt + (size_t)((b * 4 + h) * 256) * 256;
    u32x4 pre[4];
#pragma unroll
    for (int i = 0; i < 4; ++i) { const int p = tid + 512 * i; pre[i] = *(const u32x4*)(ksrc + (size_t)(p >> 5) * 1024 + (p & 31) * 8); }
    bf16x8 qf[8]; float qs = 0.f;
#pragma unroll
    for (int ks = 0; ks < 8; ++ks) { qf[ks] = *(const bf16x8*)(mq + (size_t)row * 1024 + h * 256 + 32 * ks + 8 * fq);
#pragma unroll
        for (int j = 0; j < 8; ++j) { const float f = bf2f((unsigned short)qf[ks][j]); qs += f * f; } }
    qs += __shfl_xor(qs, 16); qs += __shfl_xor(qs, 32);
    const float scl = __builtin_amdgcn_rsqf(qs * (1.0f / 256.0f) + EPS) * (0.0625f * LOG2E);
    f32x4 sa[16];
#pragma unroll
    for (int kc = 0; kc < 4; ++kc) {
        __syncthreads();
#pragma unroll
        for (int i = 0; i < 4; ++i) { const int p = tid + 512 * i; *(LAS u32x4*)(kv + (p >> 5) * PL_LD + (p & 31) * 8) = pre[i]; }
        __syncthreads();
#pragma unroll
        for (int i = 0; i < 4; ++i) { const int p = tid + 512 * i;
            pre[i] = (kc < 3) ? *(const u32x4*)(ksrc + (size_t)(64 * (kc + 1) + (p >> 5)) * 1024 + (p & 31) * 8) : *(const u32x4*)(vsrc + (size_t)(p >> 5) * 256 + (p & 31) * 8); }
#pragma unroll
        for (int tl = 0; tl < 4; ++tl) {
            f32x4 a = (f32x4){0.f, 0.f, 0.f, 0.f};
#pragma unroll
            for (int ks = 0; ks < 8; ++ks) { const bf16x8 kf = *(const LAS bf16x8*)(kv + (16 * tl + fr) * PL_LD + 32 * ks + 8 * fq); a = mfma16(kf, qf[ks], a); }
            sa[4 * kc + tl] = a * scl;
        }
    }
    float mx = -INFINITY;
#pragma unroll
    for (int t = 0; t < 16; ++t) mx = fmaxf(mx, fmaxf(fmaxf(sa[t][0], sa[t][1]), fmaxf(sa[t][2], sa[t][3])));
    mx = fmaxf(mx, __shfl_xor(mx, 16)); mx = fmaxf(mx, __shfl_xor(mx, 32));
    float l = 0.f;
#pragma unroll
    for (int t = 0; t < 16; ++t) {
        f32x4 p;
#pragma unroll
        for (int r = 0; r < 4; ++r) { p[r] = __builtin_amdgcn_exp2f(sa[t][r] - mx); l += p[r]; }
        *(LAS u32x2*)(pl + fr * PL_LD + 16 * t + 4 * fq) = pack4(p);
    }
    l += __shfl_xor(l, 16); l += __shfl_xor(l, 32);
    const float rl = __builtin_amdgcn_rcpf(l);
    LDS_WAIT(); asm volatile("" ::: "memory");
    bf16x8 pf[8];
#pragma unroll
    for (int ks = 0; ks < 8; ++ks) pf[ks] = *(const LAS bf16x8*)(pl + fr * PL_LD + 32 * ks + 8 * fq);
#pragma unroll
    for (int dc = 0; dc < 4; ++dc) {
        __syncthreads();
#pragma unroll
        for (int i = 0; i < 4; ++i) { const int p = tid + 512 * i; *(LAS u32x4*)(kv + (p >> 5) * PL_LD + (p & 31) * 8) = pre[i]; }
        __syncthreads();
        if (dc < 3) {
#pragma unroll
            for (int i = 0; i < 4; ++i) { const int p = tid + 512 * i; pre[i] = *(const u32x4*)(vsrc + (size_t)(64 * (dc + 1) + (p >> 5)) * 256 + (p & 31) * 8); }
        }
#pragma unroll
        for (int tl = 0; tl < 4; ++tl) {
            f32x4 a = (f32x4){0.f, 0.f, 0.f, 0.f};
#pragma unroll
            for (int ks = 0; ks < 8; ++ks) { const bf16x8 vf = *(const LAS bf16x8*)(kv + (16 * tl + fr) * PL_LD + 32 * ks + 8 * fq); a = mfma16(vf, pf[ks], a); }
            *(u32x2*)(mo + (size_t)row * 1024 + h * 256 + 64 * dc + 16 * tl + 4 * fq) = pack4(a * rl);
        }
    }
    __syncthreads();
}
__device__ __forceinline__ void dif_row(const bf16_t* o0, const bf16_t* o1, bf16_t* dif, const float* gout, float lam, int lane) {
    const u32x4* a = (const u32x4*)o0 + 2 * lane; const u32x4* b = (const u32x4*)o1 + 2 * lane;
    float d[16]; float ss = 0.f;
#pragma unroll
    for (int v = 0; v < 2; ++v) { const u32x4 x = a[v], y = b[v];
#pragma unroll
        for (int w = 0; w < 4; ++w) { const float x0 = __uint_as_float(x[w] << 16), x1 = __uint_as_float(x[w] & 0xffff0000u), y0 = __uint_as_float(y[w] << 16), y1 = __uint_as_float(y[w] & 0xffff0000u);
            const float d0 = x0 - lam * y0, d1 = x1 - lam * y1; d[v * 8 + w * 2] = d0; d[v * 8 + w * 2 + 1] = d1; ss += d0 * d0 + d1 * d1; } }
    ss += __shfl_xor(ss, 1); ss += __shfl_xor(ss, 2); ss += __shfl_xor(ss, 4);
    const float rn = __builtin_amdgcn_rsqf(ss * (1.0f / 128.0f) + EPS) * (1.0f - LAM_INIT);
    const float* gp = gout + (lane & 7) * 16;
    u32x4 o[2];
#pragma unroll
    for (int v = 0; v < 2; ++v)
#pragma unroll
        for (int w = 0; w < 4; ++w) o[v][w] = cvt_pk_bf16(d[v * 8 + w * 2] * rn * gp[v * 8 + w * 2], d[v * 8 + w * 2 + 1] * rn * gp[v * 8 + w * 2 + 1]);
    u32x4* op = (u32x4*)dif + 2 * lane; op[0] = o[0]; op[1] = o[1];
}

#ifndef PH_MASK
#define PH_MASK 0xffffffffu
#endif
#define PH(n) ((PH_MASK >> (n)) & 1u)
#ifndef DUP_MASK
#define DUP_MASK 0u
#endif
#ifndef PROBE_K
#define PROBE_K (-1)
#endif
#define RUNP(k) (pass_ == 1 || (k) <= PROBE_K)
#define REP(n) _Pragma("unroll 1") for (int rep_ = 0; rep_ < 1 + (int)((DUP_MASK >> (n)) & 1u); ++rep_)
struct Args { const void* in[26]; float* out; unsigned char* ws; };
#define CAS __attribute__((address_space(4)))
__device__ __forceinline__ const void* karg(int i) { typedef const GAS void* gptr; const CAS gptr* p = (const CAS gptr*)__builtin_amdgcn_kernarg_segment_ptr(); asm volatile("" : "+s"(p)); return (const void*)p[i]; }
#define INP(i) ((const float*)karg(i))
#define WSP(T, off) ((T*)((unsigned char*)karg(27) + (off)))
#define OUTP ((float*)karg(26))
__global__ void __launch_bounds__(NWAVES * 64, 2) mk_fwd(Args args) {
    extern __shared__ __attribute__((aligned(16))) unsigned char lds_raw[];
    LAS unsigned char* lds = (LAS unsigned char*)lds_raw;
    volatile LAS unsigned* MISC = (volatile LAS unsigned*)(lds + MISC_OFF);
    const int G = gridDim.x, bx = blockIdx.x;
    for (int u = threadIdx.x; u < (LDS_BYTES - LDSCTL_OFF) / 4; u += NWAVES * 64) ((LAS unsigned*)(lds + LDSCTL_OFF))[u] = 0u;
    __syncthreads();
    (void)xcd_barrier_post((unsigned*)WSP(unsigned, WS_CTL) + CW_BAR, MISC + 8);
#define GRID_BAR() do { XcdBarrier b_; b_.bar = (unsigned*)WSP(unsigned, WS_CTL) + CW_BAR; b_.x = xb_xcc_id(); b_.st = (volatile LAS unsigned*)(lds + MISC_OFF) + 8; xcd_barrier(b_); } while (0)
    const int NGW = G * NWAVES, NGT = G * NWAVES * 64;
#define LANE_VARS() const int tid = opaque_tid(), lane = tid & 63, wave = __builtin_amdgcn_readfirstlane(tid >> 6); LAS float* scr = (LAS float*)(lds + wave * 16384); \
    const int gw = bx * NWAVES + wave, gt = bx * (NWAVES * 64) + tid; (void)scr; (void)gw; (void)gt; (void)lane

#pragma unroll 1
    for (int pass_ = (PROBE_K >= 0 ? 0 : 1); pass_ < 2; ++pass_) {
    if (RUNP(0)) {
    REP(0) if (PH(0)) {
        LANE_VARS();
        transpose_all(INP(4), 1024, 2 * DFF, WSP(bf16_t, WS_WF1I), 2 * DFF, ColSwiglu{}, nullptr, scr, gw, NGW, lane);
        transpose_all(INP(5), DFF, 1024, WSP(bf16_t, WS_WF1O), 1024, ColIdent{0}, nullptr, scr, gw, NGW, lane);
        transpose_all(INP(18), 1024, 2048, WSP(bf16_t, WS_WMKV), 2048, ColIdent{0}, nullptr, scr, gw, NGW, lane);
        transpose_all(INP(7), 1024, 13312, WSP(bf16_t, WS_WMIX), NMIX, ColMix{}, INP(6), scr, gw, NGW, lane);
        transpose_all(INP(7), 1024, 13312, WSP(bf16_t, WS_WRG), 2048, ColIdent{4096}, INP(6), scr, gw, NGW, lane);
        { const float* x = INP(0); const float* g1 = INP(3); bf16_t* xb = WSP(bf16_t, WS_XB);
          for (int m = gw; m < TOK; m += NGW) rms_row_to_bf16(x + (size_t)m * DM, g1, xb + (size_t)m * DM, lane); }
        { const float* mem = INP(1); const float* gm = INP(17); bf16_t* memn = WSP(bf16_t, WS_MEMN);
          for (int m = gw; m < NB * MEML; m += NGW) rms_row_to_bf16(mem + (size_t)m * DM, gm, memn + (size_t)m * DM, lane); }
        rot_table((const int*)karg(2), WSP(float, WS_ROT), gt, NGT);
    }
    GRID_BAR();
    }

    if (RUNP(1)) {
    REP(1) if (PH(1)) {
        pg8::Gemm g{WSP(bf16_t, WS_XB), WSP(bf16_t, WS_WF1I), TOK, 2 * DFF, 1024}; pg8::StaticOrder S; S.init(TOK, 2 * DFF, G, bx);
        EpiSwiglu E{WSP(bf16_t, WS_ACT), nullptr};
        pg8::gemm_phase(lds, g, S, E);
    }
    if (PH(2)) {
        pg8::Gemm g{WSP(bf16_t, WS_MEMN), WSP(bf16_t, WS_WMKV), NB * MEML, 2048, 1024}; pg8::StaticOrder S; S.init(NB * MEML, 2048, G, (bx + G / 2) % G);
        EpiPlain E{WSP(bf16_t, WS_MKVRAW), 2048};
        pg8::gemm_phase(lds, g, S, E);
    }
    GRID_BAR();
    }

    if (RUNP(2)) {
    REP(3) if (PH(3)) {
        pg8::Gemm g{WSP(bf16_t, WS_ACT), WSP(bf16_t, WS_WF1O), TOK, 1024, DFF}; pg8::StaticOrder S; S.init(TOK, 1024, G, bx);
        EpiResid E{INP(0), OUTP, WSP(bf16_t, WS_XB), WSP(float, WS_SSQ1), 0.5f, (rep_ == 1 && ((DUP_MASK >> 23) & 1u)) ? 1 : 0};
        pg8::gemm_phase(lds, g, S, E);
    }
    if (PH(0)) {
        LANE_VARS();
        const bf16_t* mkvraw = WSP(bf16_t, WS_MKVRAW); bf16_t* mkn = WSP(bf16_t, WS_MKN); bf16_t* mvt = WSP(bf16_t, WS_MVT);
        const float* g_mem_k = INP(16); const float* g_mem_q = INP(15);
        for (int j = gw; j < NB * MEML * 4; j += NGW) {
            const int row = j >> 2, h = j & 3;
            const u32x2 w = *((const u32x2*)(mkvraw + (size_t)row * 2048 + h * 256) + lane);
            f32x4 v = (f32x4){__uint_as_float(w.x << 16), __uint_as_float(w.x & 0xffff0000u), __uint_as_float(w.y << 16), __uint_as_float(w.y & 0xffff0000u)};
            const float ss = wave_sum((v[0] * v[0] + v[1] * v[1]) + (v[2] * v[2] + v[3] * v[3]));
            const float rn = __builtin_amdgcn_rsqf(ss * (1.0f / 256.0f) + EPS);
            const f32x4 gk = *((const f32x4*)g_mem_k + lane), gq = *((const f32x4*)g_mem_q + lane);
            *((u32x2*)(mkn + (size_t)row * 1024 + h * 256) + lane) = pack4(v * rn * gk * gq);
        }
        for (int idx = gt; idx < NB * 4 * 256 * 256; idx += NGT) {
            const int key = idx & 255, d = (idx >> 8) & 255, bh = idx >> 16, b = bh >> 2, h = bh & 3;
            mvt[idx] = mkvraw[(size_t)(b * 256 + key) * 2048 + 1024 + h * 256 + d];
        }
    }
    GRID_BAR();
    }

    if (RUNP(3))
    for (int gb = 0; gb < NB; ++gb) {
        REP(4) if (PH(4)) {
            pg8::Gemm g{WSP(bf16_t, WS_XB) + (size_t)gb * SEQ * DM, WSP(bf16_t, WS_WMIX), SEQ, NMIX, 1024}; pg8::StaticOrder S; S.init(SEQ, NMIX, G, bx);
            prep_rs(WSP(float, WS_SSQ1), gb * SEQ, S, lds);
            EpiMix E{(const LAS float*)(lds + RTAB_OFF), WSP(float, WS_ROT), WSP(unsigned char, 0), INP(8), INP(9)};
            pg8::gemm_phase(lds, g, S, E);
        }
        if (gb > 0) {
            LANE_VARS();
            const float s1 = wave_sum(INP(10)[lane] * INP(11)[lane]), s2 = wave_sum(INP(12)[lane] * INP(13)[lane]); const float lam = __expf(s1) - __expf(s2) + LAM_INIT;
            const bf16_t* bo0 = WSP(bf16_t, WS_O0); const bf16_t* bo1 = WSP(bf16_t, WS_O1); bf16_t* difb = WSP(bf16_t, WS_DIF); const float* gdo = INP(14);
            for (int r = gw; r < SEQ; r += NGW) dif_row(bo0 + (size_t)r * 1024, bo1 + (size_t)r * 1024, difb + ((size_t)(gb - 1) * SEQ + r) * 1024, gdo, lam, lane);
        }
        GRID_BAR();
        {
            unsigned* done = (unsigned*)WSP(unsigned, WS_CTL) + CW_SCAN + ((pass_ * NB + gb) * 8) * 64; unsigned* tmo = (unsigned*)WSP(unsigned, WS_CTL) + CW_BAR + XB_TMO;
            for (int u = bx; u < 256; u += G) { __syncthreads(); if (PH(5)) scan_unit(u, WSP(bf16_t, WS_KTS), WSP(bf16_t, WS_VT), WSP(bf16_t, WS_S), lds, done); }
            for (int slot = bx; slot < 256; slot += G) {
                const int grp = slot >> 5, j = slot & 31;
                if (grp >= 4) { const int ro = (grp - 4) * 32 + j; __syncthreads();
                    if (PH(8)) retout_unit(ro >> 5, (ro >> 1) & 15, ro & 1, WSP(bf16_t, WS_Q), WSP(bf16_t, WS_K), WSP(bf16_t, WS_VT), WSP(bf16_t, WS_S),
                                           WSP(bf16_t, WS_RET) + (size_t)gb * SEQ * 2048, WSP(float, WS_SSQ2) + (size_t)gb * SEQ * 8, lds, done, tmo); }
                {
                    const int qb = 7 - grp, hc = j >> 1, vh = j & 1, hh = hc >> 1, cc = hc & 1;
                    __syncthreads();
                    if (PH(6)) attn_body::attn_unit<8>(hc, 2 * hh + vh, qb, WSP(const attn_body::bf16, WS_DQ), WSP(const attn_body::bf16, WS_DK), WSP(const attn_body::bf16, WS_DV),
                                            WSP(attn_body::bf16, (cc ? WS_O1 : WS_O0)), (char*)lds_raw);
                }
                if (grp == 2 || grp == 3) { const int m = (grp - 2) * 32 + j; __syncthreads();
                    if (PH(7)) memattn_unit(gb, m >> 4, m & 15, WSP(bf16_t, WS_MQ), WSP(bf16_t, WS_MKN), WSP(bf16_t, WS_MVT), WSP(bf16_t, WS_MO) + (size_t)gb * SEQ * 1024, lds); }
            }
            if (gb + 1 < NB) { LANE_VARS(); rot_table((const int*)karg(2) + (gb + 1) * SEQ, WSP(float, WS_ROT), gt, NGT); }
        }
        GRID_BAR();
    }

    if (RUNP(4)) {
    if (PH(9)) {
        pg8::Gemm g{WSP(bf16_t, WS_XB), WSP(bf16_t, WS_WRG), TOK, 2048, 1024}; pg8::StaticOrder S; S.init(TOK, 2048, G, bx);
        prep_rs(WSP(float, WS_SSQ1), 0, S, lds);
        EpiRg E{(const LAS float*)(lds + RTAB_OFF), WSP(bf16_t, WS_RET), WSP(float, WS_SSQ2)};
        pg8::gemm_phase(lds, g, S, E);
    }
    if (PH(0)) {
        LANE_VARS();
        { const float s1 = wave_sum(INP(10)[lane] * INP(11)[lane]), s2 = wave_sum(INP(12)[lane] * INP(13)[lane]); const float lam = __expf(s1) - __expf(s2) + LAM_INIT;
          const bf16_t* bo0 = WSP(bf16_t, WS_O0); const bf16_t* bo1 = WSP(bf16_t, WS_O1); bf16_t* difb = WSP(bf16_t, WS_DIF); const float* gdo = INP(14);
          for (int r = gw; r < SEQ; r += NGW) dif_row(bo0 + (size_t)r * 1024, bo1 + (size_t)r * 1024, difb + ((size_t)(NB - 1) * SEQ + r) * 1024, gdo, lam, lane); }
        transpose_all(INP(7), 1024, 13312, WSP(bf16_t, WS_WGATE), 3072, ColIdent{10240}, INP(6), scr, gw, NGW, lane);
        transpose_all(INP(19), 2048, 1024, WSP(bf16_t, WS_WBRR), 1024, ColIdent{0}, nullptr, scr, gw, NGW, lane);
        transpose_all(INP(20), 1024, 1024, WSP(bf16_t, WS_WBRD), 1024, ColIdent{0}, nullptr, scr, gw, NGW, lane);
        transpose_all(INP(21), 1024, 1024, WSP(bf16_t, WS_WBRM), 1024, ColIdent{0}, nullptr, scr, gw, NGW, lane);
        transpose_all(INP(22), 1024, 1024, WSP(bf16_t, WS_WO), 1024, ColIdent{0}, nullptr, scr, gw, NGW, lane);
    }
    GRID_BAR();
    }

    if (RUNP(5)) {
    REP(10) if (PH(10)) {
        pg8::StaticOrder S; S.init(TOK, 1024, G, bx);
        prep_rs(WSP(float, WS_SSQ1), 0, S, lds);
#pragma unroll 1
        for (int job = 0; job < 6; ++job) {
            const int kbr = job >> 1, isterm = job & 1;
            const bf16_t* A = isterm ? (kbr == 0 ? WSP(bf16_t, WS_RET) : kbr == 1 ? WSP(bf16_t, WS_DIF) : WSP(bf16_t, WS_MO)) : WSP(bf16_t, WS_XB);
            const bf16_t* Bt = isterm ? (kbr == 0 ? WSP(bf16_t, WS_WBRR) : kbr == 1 ? WSP(bf16_t, WS_WBRD) : WSP(bf16_t, WS_WBRM)) : WSP(bf16_t, WS_WGATE) + (size_t)kbr * 1024 * 1024;
            pg8::Gemm g{A, Bt, TOK, 1024, (isterm && kbr == 0) ? 2048 : 1024};
            EpiP5 E{isterm, (const LAS float*)(lds + RTAB_OFF), WSP(bf16_t, WS_STASH), WSP(bf16_t, WS_Y), kbr == 0};
            pg8::gemm_phase(lds, g, S, E);
        }
    }
    GRID_BAR();
    }

    if (RUNP(6)) {
    if (PH(11)) {
        pg8::Gemm g{WSP(bf16_t, WS_Y), WSP(bf16_t, WS_WO), TOK, 1024, 1024}; pg8::StaticOrder S; S.init(TOK, 1024, G, bx);
        EpiResid E{OUTP, OUTP, WSP(bf16_t, WS_XB), WSP(float, WS_SSQ2), 1.0f, 0};
        pg8::gemm_phase(lds, g, S, E);
    }
    if (PH(0)) {
        LANE_VARS();
        transpose_all(INP(24), 1024, 2 * DFF, WSP(bf16_t, WS_WF2I), 2 * DFF, ColSwiglu{}, INP(23), scr, gw, NGW, lane);
        transpose_all(INP(25), DFF, 1024, WSP(bf16_t, WS_WF2O), 1024, ColIdent{0}, nullptr, scr, gw, NGW, lane);
    }
    GRID_BAR();
    }

    if (RUNP(7)) {
    if (PH(12)) {
        pg8::Gemm g{WSP(bf16_t, WS_XB), WSP(bf16_t, WS_WF2I), TOK, 2 * DFF, 1024}; pg8::StaticOrder S; S.init(TOK, 2 * DFF, G, bx);
        prep_rs(WSP(float, WS_SSQ2), 0, S, lds);
        EpiSwiglu E{WSP(bf16_t, WS_ACT2), (const LAS float*)(lds + RTAB_OFF)};
        pg8::gemm_phase(lds, g, S, E);
    }
    GRID_BAR();
    }

    if (RUNP(8))
    if (PH(13)) {
        pg8::Gemm g{WSP(bf16_t, WS_ACT2), WSP(bf16_t, WS_WF2O), TOK, 1024, DFF}; pg8::StaticOrder S; S.init(TOK, 1024, G, bx);
        EpiResid E{OUTP, OUTP, nullptr, nullptr, 0.5f, 0};
        pg8::gemm_phase(lds, g, S, E);
    }
    if (pass_ == 0) GRID_BAR();
    }
}

extern "C" void kernel_launch(void* const* d_in, const int* in_sizes, int n_in, void* d_out, int out_size, void* d_ws, size_t ws_size, hipStream_t stream) {
    static int grid = 0;
    if (grid == 0) {
        if (n_in != 26 || ws_size < WS_END) { fprintf(stderr, "kernel_launch: unexpected inputs (n_in %d, ws %zu)\n", n_in, ws_size); grid = -1; return; }
        int dev = 0, cus = 0;
        if (hipGetDevice(&dev) != hipSuccess || hipDeviceGetAttribute(&cus, hipDeviceAttributeMultiprocessorCount, dev) != hipSuccess) { grid = -1; return; }
        if (hipFuncSetAttribute((const void*)mk_fwd, hipFuncAttributeMaxDynamicSharedMemorySize, LDS_BYTES) != hipSuccess) { fprintf(stderr, "kernel_launch: hipFuncSetAttribute failed\n"); grid = -1; return; }
        grid = cus;
    }
    if (grid < 0) return;
    (void)hipMemsetAsync((char*)d_ws + WS_CTL, 0, CTL_ZERO_BYTES, stream);
    Args a{};
    for (int i = 0; i < 26; ++i) a.in[i] = d_in[i];
    a.out = (float*)d_out; a.ws = (unsigned char*)d_ws;
    hipLaunchKernelGGL(mk_fwd, dim3(grid), dim3(NWAVES * 64), LDS_BYTES, stream, a);
}
```

```cpp
#include <hip/hip_runtime.h>
#include <cstdio>
#include <cstdint>

#define LAS __attribute__((address_space(3)))
#define GAS __attribute__((address_space(1)))
typedef unsigned short bf16_t;
typedef short bf16x8 __attribute__((ext_vector_type(8)));
typedef float f32x4 __attribute__((ext_vector_type(4)));
typedef float f32x2 __attribute__((ext_vector_type(2)));
typedef unsigned u32x4 __attribute__((ext_vector_type(4)));
typedef unsigned u32x2 __attribute__((ext_vector_type(2)));

constexpr int NB = 8, SEQ = 2048, DM = 1024, TOK = NB * SEQ, MEML = 256, DFF = 2816;
constexpr int NMIX = 8192;
constexpr float EPS = 1e-6f;
constexpr float LOG2E = 1.4426950408889634f;
constexpr float C2Q = 0.125f * LOG2E;
constexpr float LAM_INIT = 0.2f;

constexpr size_t MiB = 1u << 20;
constexpr size_t KiB = 1u << 10;
constexpr size_t WS_CTL = 0, CTL_ZERO_BYTES = 256 * KiB;
constexpr size_t WS_SSQ1 = 256 * KiB, WS_SSQ2 = 512 * KiB;
constexpr size_t WS_ROT = 1 * MiB, WS_ROTB = 153 * MiB;
constexpr size_t WS_MKN = 3 * MiB, WS_MVT = 7 * MiB;
constexpr size_t WS_WMIX = 11 * MiB;
constexpr size_t WS_XB = 27 * MiB;
constexpr size_t WS_RET = 59 * MiB;
constexpr size_t WS_XBL = 91 * MiB;
constexpr size_t WS_DIF = 123 * MiB;
constexpr size_t WS_MO = 155 * MiB;
constexpr size_t WS_Q = 187 * MiB, WS_K = 191 * MiB, WS_KTS = 195 * MiB, WS_VT = 199 * MiB, WS_DQ = 207 * MiB, WS_DK = 211 * MiB,
                 WS_DV = 215 * MiB;
constexpr size_t SET_DELTA = 160 * MiB;
constexpr size_t WS_WRG = 219 * MiB;
constexpr size_t WS_O0 = 223 * MiB, WS_O1 = 227 * MiB, WS_S = 231 * MiB;
constexpr size_t WS_OB = 24 * MiB;
constexpr size_t WS_WF1I = 59 * MiB, WS_WF1O = 70 * MiB;
constexpr size_t WS_MEMN = 76 * MiB, WS_MKVRAW = 80 * MiB, WS_WMKV = 27 * MiB;
constexpr size_t WS_ACT = 155 * MiB;
constexpr size_t WS_WGATE = 11 * MiB, WS_WBRR = 17 * MiB, WS_WBRD = 21 * MiB, WS_WBRM = 23 * MiB, WS_WO = 25 * MiB;
constexpr size_t WS_G8A = 187 * MiB, WS_G8B = 203 * MiB, WS_G8C = 223 * MiB;
constexpr size_t WS_Y = 27 * MiB;
constexpr size_t WS_X2B = 187 * MiB;
constexpr size_t WS_WF2I = 59 * MiB, WS_WF2O = 70 * MiB, WS_ACT2 = 76 * MiB;
constexpr size_t WS_END = 256 * MiB;

constexpr int CW_BAR = 4096;
constexpr int CW_QUEUE = 32768;
constexpr int CW_SCAN = 16384;

constexpr int RING_BYTES = 131072, LDSCTL_OFF = RING_BYTES, MISC_OFF = LDSCTL_OFF + 320, LDS_BYTES = 147456;
constexpr int NWAVES = 8;

__device__ __forceinline__ unsigned cvt_pk_bf16(float lo, float hi) { unsigned r; asm volatile("v_cvt_pk_bf16_f32 %0, %1, %2" : "=v"(r) : "v"(lo), "v"(hi)); return r; }
__device__ __forceinline__ u32x2 pack4(f32x4 v) { u32x2 w; w.x = cvt_pk_bf16(v[0], v[1]); w.y = cvt_pk_bf16(v[2], v[3]); return w; }
__device__ __forceinline__ unsigned short bf16_1(float v) { return (unsigned short)(cvt_pk_bf16(v, 0.f) & 0xffffu); }
__device__ __forceinline__ float bf2f(unsigned short b) { return __uint_as_float(((unsigned)b) << 16); }
__device__ __forceinline__ float siluf(float x) { return x * __builtin_amdgcn_rcpf(1.0f + __builtin_amdgcn_exp2f(-x * LOG2E)); }
__device__ __forceinline__ float sigmf(float x) { return __builtin_amdgcn_rcpf(1.0f + __builtin_amdgcn_exp2f(-x * LOG2E)); }
__device__ __forceinline__ float row_rs(const float* ssq, int row) {
    const f32x4 a = *(const f32x4*)(ssq + (size_t)row * 4);
    return __builtin_amdgcn_rsqf(((a[0] + a[1]) + (a[2] + a[3])) * (1.0f / 1024.0f) + EPS);
}
__device__ __forceinline__ int opaque_tid() { int t = threadIdx.x; asm volatile("" : "+v"(t)); return t; }
__device__ __forceinline__ f32x4 mfma16(bf16x8 a, bf16x8 b, f32x4 c) { return __builtin_amdgcn_mfma_f32_16x16x32_bf16(a, b, c, 0, 0, 0); }

namespace pg8 {
constexpr int BM = 256, BK = 64, HALF = 128, HTB = HALF * BK * 2, STAGE_BYTES = 8 * HTB, NXCD = 8, WGM = 8;
__host__ __device__ __forceinline__ int lds_byte(int r, int c) { const int st = (r >> 4) * 2 + (c >> 5), rr = r & 15, cc = c & 31, ob = rr * 64 + cc * 2; return st * 1024 + (ob ^ (((ob >> 9) & 1) << 5)); }
__host__ __device__ __forceinline__ void stage_rc(int b, int& R, int& C) { const int st = b / 1024, sb = b % 1024, swz = sb ^ (((sb >> 9) & 1) << 5); R = (st >> 1) * 16 + swz / 64; C = (st & 1) * 32 + (swz % 64) / 2; }
struct Unit { int pm, pn, ui, ri, tag, K; const char* A; const char* Bt; };
struct Gemm { const bf16_t* A; const bf16_t* Bt; int M, N, K; };
struct StaticOrder {
    int nM, nN, nwg, G, c; Gemm g;
    __host__ __device__ void init(int M, int N, int G_, int c_) { nM = M / BM; nN = N / BM; nwg = nM * nN; G = G_; c = c_; g.A = nullptr; g.Bt = nullptr; g.M = M; g.N = N; g.K = 0; }
    __host__ __device__ void set(const Gemm& g_) { g = g_; }
    __host__ __device__ bool tile(int i, int& pm, int& pn) const {
        const long L = (long)i * G + c; if (L >= nwg) return false;
        int wgid = (int)L; { const int q = nwg / NXCD, r = nwg % NXCD, xcd = wgid % NXCD, off = wgid / NXCD; wgid = (xcd < r ? xcd * (q + 1) : r * (q + 1) + (xcd - r) * q) + off; }
        const int nig = WGM * nN, gid = wgid / nig, fm = gid * WGM, gsz = (nM - fm) < WGM ? (nM - fm) : WGM;
        pm = fm + ((wgid % nig) % gsz); pn = (wgid % nig) / gsz; return true;
    }
    __host__ __device__ bool next(int i, Unit& u) const {
        if (!tile(i, u.pm, u.pn)) return false;
        u.ui = i; u.ri = i; u.tag = 0; u.K = g.K;
        u.A = (const char*)g.A + (size_t)u.pm * 256 * g.K * 2; u.Bt = (const char*)g.Bt + (size_t)u.pn * 256 * g.K * 2; return true;
    }
};
template <class Epi, class Sched>
__device__ __forceinline__ void gemm_phase(LAS unsigned char* lds, const Sched& S, const Epi& E) {
    const int tid = opaque_tid(), wid = __builtin_amdgcn_readfirstlane(tid >> 6), lane = tid & 63, wr = wid >> 2, wc = wid & 3, fr = lane & 15, fq = lane >> 4;
    unsigned R2[2], C2[2];
#pragma unroll
    for (int i = 0; i < 2; ++i) { int R, C; stage_rc(tid * 16 + i * 8192, R, C); R2[i] = (unsigned)R * 2u; C2[i] = (unsigned)C * 2u; }
    const size_t kstep = (size_t)(BK * 2);
    const unsigned ldsw = (unsigned)wid * 1024u;
    const int aoff = lds_byte(wr * 64 + fr, fq * 8), boff = lds_byte(wc * 32 + fr, fq * 8);
#define PG8_SA(b, h) (((b) * 2 + (h)) * HTB)
#define PG8_SB(b, h) ((4 + (b) * 2 + (h)) * HTB)
#define PG8_STAGE(bufoff, gbase, voff) do { _Pragma("unroll") for (int _i = 0; _i < 2; ++_i) \
        __builtin_amdgcn_global_load_lds((const unsigned*)((const char*)(gbase) + (voff)[_i]), (LAS unsigned*)(lds + (bufoff) + ldsw + _i * 8192), 16, 0, 0); } while (0)
#define PG8_LDA(dst, b, h) do { _Pragma("unroll") for (int m = 0; m < 4; ++m) _Pragma("unroll") for (int k = 0; k < 2; ++k) dst[m][k] = *(const LAS bf16x8*)(lds + PG8_SA(b, h) + aoff + m * 2048 + k * 1024); } while (0)
#define PG8_LDB(dst, b, h) do { _Pragma("unroll") for (int n = 0; n < 2; ++n) _Pragma("unroll") for (int k = 0; k < 2; ++k) dst[n][k] = *(const LAS bf16x8*)(lds + PG8_SB(b, h) + boff + n * 2048 + k * 1024); } while (0)
#define PG8_MMA(ai, bj, At, Bt) do { __builtin_amdgcn_s_setprio(1); _Pragma("unroll") for (int m = 0; m < 4; ++m) _Pragma("unroll") for (int n = 0; n < 2; ++n) _Pragma("unroll") for (int k = 0; k < 2; ++k) \
        acc[ai][bj][m][n] = __builtin_amdgcn_mfma_f32_16x16x32_bf16(Bt[n][k], At[m][k], acc[ai][bj][m][n], 0, 0, 0); __builtin_amdgcn_s_setprio(0); } while (0)
#define PG8_WAIT_V(n) asm volatile("s_waitcnt vmcnt(" #n ")" ::: "memory")
#define PG8_WAIT_L(n) asm volatile("s_waitcnt lgkmcnt(" #n ")" ::: "memory")
#define PG8_BAR __builtin_amdgcn_s_barrier()
#define PG8_SCHED __builtin_amdgcn_sched_barrier(0)
    Unit cur, nxt; int ui = 0;
    if (!S.next(0, cur)) return;
    f32x4 acc[2][2][4][2];
#pragma unroll
    for (int a = 0; a < 2; ++a)
#pragma unroll
        for (int b = 0; b < 2; ++b)
#pragma unroll
            for (int m = 0; m < 4; ++m)
#pragma unroll
                for (int n = 0; n < 2; ++n) acc[a][b][m][n] = (f32x4){0.f, 0.f, 0.f, 0.f};
    bf16x8 At[4][2], B0[2][2], B1[2][2];
    const char* cA = cur.A; const char* cB = cur.Bt;
    unsigned vo[2] = {R2[0] * (unsigned)cur.K + C2[0], R2[1] * (unsigned)cur.K + C2[1]};
    size_t hstep = (size_t)HALF * cur.K * 2;
    PG8_STAGE(PG8_SB(0, 0), cB, vo); PG8_STAGE(PG8_SB(0, 1), cB + hstep, vo); PG8_STAGE(PG8_SA(0, 0), cA, vo); PG8_STAGE(PG8_SA(0, 1), cA + hstep, vo);
    if (wr == 1) PG8_BAR;
    PG8_WAIT_V(2); PG8_BAR;
    PG8_STAGE(PG8_SB(1, 0), cB + kstep, vo); PG8_STAGE(PG8_SA(1, 0), cA + kstep, vo); PG8_STAGE(PG8_SB(1, 1), cB + hstep + kstep, vo);
    PG8_WAIT_V(6); PG8_BAR;
    for (;;) {
        const bool has_next = S.next(ui + 1, nxt);
        if (!has_next) nxt = cur;
        const char* nA = nxt.A; const char* nB = nxt.Bt;
        const unsigned voN0 = R2[0] * (unsigned)nxt.K + C2[0], voN1 = R2[1] * (unsigned)nxt.K + C2[1]; const size_t hstepN = (size_t)HALF * nxt.K * 2;
        const int nt = cur.K / BK;
        for (int t = 0; t < nt; t += 2) {
            const bool last = (t == nt - 2);
            const char* a1 = cA + (size_t)(t + 1) * kstep;
            const char* a2 = last ? nA : cA + (size_t)(t + 2) * kstep; const char* b2 = last ? nB : cB + (size_t)(t + 2) * kstep;
            const char* a3 = a2 + kstep; const char* b3 = b2 + kstep;
            const unsigned v2[2] = {last ? voN0 : vo[0], last ? voN1 : vo[1]}; const size_t h2 = last ? hstepN : hstep;
            const bool tail = last && !has_next;
            PG8_LDB(B0, 0, 0); PG8_LDB(B1, 0, 1); PG8_SCHED; PG8_LDA(At, 0, 0); PG8_STAGE(PG8_SA(1, 1), a1 + hstep, vo);
            PG8_WAIT_V(8); PG8_WAIT_L(0); PG8_BAR; PG8_MMA(0, 0, At, B0); PG8_MMA(0, 1, At, B1); PG8_BAR; PG8_SCHED;
            PG8_LDA(At, 0, 1); if (!tail) { PG8_STAGE(PG8_SB(0, 0), b2, v2); PG8_STAGE(PG8_SB(0, 1), b2 + h2, v2); PG8_STAGE(PG8_SA(0, 0), a2, v2); }
            if (tail) PG8_WAIT_V(2); else PG8_WAIT_V(8);
            PG8_WAIT_L(0); PG8_BAR; PG8_MMA(1, 0, At, B0); PG8_MMA(1, 1, At, B1); PG8_BAR; PG8_SCHED;
            PG8_LDB(B0, 1, 0); PG8_LDB(B1, 1, 1); PG8_SCHED; PG8_LDA(At, 1, 0); if (!tail) { PG8_STAGE(PG8_SA(0, 1), a2 + h2, v2); }
            if (tail) PG8_WAIT_V(0); else PG8_WAIT_V(8);
            PG8_WAIT_L(0); PG8_BAR; PG8_MMA(0, 0, At, B0); PG8_MMA(0, 1, At, B1); PG8_BAR; PG8_SCHED;
            PG8_LDA(At, 1, 1); if (!tail) { PG8_STAGE(PG8_SB(1, 0), b3, v2); PG8_STAGE(PG8_SB(1, 1), b3 + h2, v2); PG8_STAGE(PG8_SA(1, 0), a3, v2); PG8_WAIT_V(8); }
            PG8_WAIT_L(0); PG8_BAR; PG8_MMA(1, 0, At, B0); PG8_MMA(1, 1, At, B1); PG8_BAR; PG8_SCHED;
        }
        if (wr == 0) PG8_BAR;
        if (!Epi::AFTER_DRAIN || has_next) { int fr2 = fr, fq2 = fq; asm volatile("" : "+v"(fr2), "+v"(fq2)); E(acc, cur, wr, wc, fr2, fq2); }
        if (!has_next) break;
#pragma unroll
        for (int a = 0; a < 2; ++a)
#pragma unroll
            for (int b = 0; b < 2; ++b)
#pragma unroll
                for (int m = 0; m < 4; ++m)
#pragma unroll
                    for (int n = 0; n < 2; ++n) acc[a][b][m][n] = (f32x4){0.f, 0.f, 0.f, 0.f};
        cur = nxt; cA = nA; cB = nB; vo[0] = voN0; vo[1] = voN1; hstep = hstepN; ++ui;
        if (wr == 1) PG8_BAR;
    }
    PG8_WAIT_V(0);
    PG8_BAR;
    if constexpr (Epi::AFTER_DRAIN) { int fr2 = fr, fq2 = fq; asm volatile("" : "+v"(fr2), "+v"(fq2)); E.fused(acc, cur, wr, wc, fr2, fq2, lds); }
#undef PG8_SA
#undef PG8_SB
#undef PG8_STAGE
#undef PG8_LDA
#undef PG8_LDB
#undef PG8_MMA
#undef PG8_WAIT_V
#undef PG8_WAIT_L
#undef PG8_BAR
#undef PG8_SCHED
}
}

__device__ __forceinline__ float wave_sum(float v);
#define ACC_ARG const f32x4 (&acc)[2][2][4][2]
#define EPI_FENCE() asm volatile("" ::: "memory")
constexpr int RTAB_OFF = RING_BYTES + 1024;
__device__ __forceinline__ void prep_rs(const float* ssq, int row_off, const pg8::StaticOrder& S, LAS unsigned char* lds) {
    const int tid = opaque_tid(); LAS float* rtab = (LAS float*)(lds + RTAB_OFF); pg8::Unit u;
    for (int i = 0; i < 6 && S.next(i, u); ++i) if (tid < 256) rtab[i * 256 + tid] = row_rs(ssq, row_off + u.pm * 256 + tid);
    __syncthreads();
}
struct EpiSwiglu {
    static constexpr bool AFTER_DRAIN = false;
    bf16_t* O; const LAS float* rtab;
    __device__ __forceinline__ void operator()(ACC_ARG, const pg8::Unit& u, int wr, int wc, int fr, int fq) const {
        const int lr0 = wr * 64 + fr, col0 = u.pn * 128 + wc * 32 + 8 * fq;
#pragma unroll
        for (int ai = 0; ai < 2; ++ai)
#pragma unroll
            for (int m = 0; m < 4; ++m) {
                const int lr = lr0 + ai * 128 + m * 16;
                const float rs = rtab ? rtab[u.ri * 256 + lr] : 1.0f;
                u32x4 w;
#pragma unroll
                for (int n = 0; n < 2; ++n) {
                    const f32x4 gt = acc[ai][0][m][n] * rs, up = acc[ai][1][m][n] * rs; f32x4 v;
#pragma unroll
                    for (int j = 0; j < 4; ++j) v[j] = siluf(gt[j]) * up[j];
                    const u32x2 p = pack4(v); if (n == 0) { w.x = p.x; w.y = p.y; } else { w.z = p.x; w.w = p.y; }
                }
                *(u32x4*)(O + (size_t)(u.pm * 256 + lr) * DFF + col0) = w;
            }
    }
};
struct EpiResid {
    static constexpr bool AFTER_DRAIN = true;
    const float* base; float* out; bf16_t* xb; float* ssq; float scale; int skip;
    __device__ __forceinline__ void operator()(ACC_ARG, const pg8::Unit& u, int wr, int wc, int fr, int fq) const {
        if (skip) return;
        const int row0 = u.pm * 256 + wr * 64 + fr, col0 = u.pn * 256 + wc * 32 + 4 * fq;
#pragma unroll
        for (int ai = 0; ai < 2; ++ai)
#pragma unroll
            for (int m = 0; m < 4; ++m) {
                const int row = row0 + ai * 128 + m * 16; float ss = 0.f;
#pragma unroll
                for (int bj = 0; bj < 2; ++bj)
#pragma unroll
                    for (int n = 0; n < 2; ++n) {
                        const size_t off = (size_t)row * DM + col0 + bj * 128 + n * 16;
                        const f32x4 v = *(const f32x4*)(base + off) + acc[ai][bj][m][n] * scale;
                        *(f32x4*)(out + off) = v;
                        if (xb) *(u32x2*)(xb + off) = pack4(v);
                        ss += (v[0] * v[0] + v[1] * v[1]) + (v[2] * v[2] + v[3] * v[3]);
                    }
                if (ssq) { ss += __shfl_xor(ss, 16); ss += __shfl_xor(ss, 32); if (fq == 0) atomicAdd(ssq + (size_t)row * 4 + u.pn, ss); }
            }
    }
    __device__ __forceinline__ void fused(ACC_ARG, const pg8::Unit& u, int wr, int wc, int fr, int fq, LAS unsigned char* lds) const {
        if (skip) return;
        const int tid = opaque_tid(), lane = tid & 63, wave = __builtin_amdgcn_readfirstlane(tid >> 6);
        LAS float* tl = (LAS float*)lds;
#pragma unroll
        for (int ai = 0; ai < 2; ++ai)
#pragma unroll
            for (int wq = 0; wq < 2; ++wq) {
                if (wr == wq) {
#pragma unroll
                    for (int m = 0; m < 4; ++m)
#pragma unroll
                        for (int bj = 0; bj < 2; ++bj)
#pragma unroll
                            for (int n = 0; n < 2; ++n) *(LAS f32x4*)(tl + (16 * m + fr) * 260 + bj * 128 + wc * 32 + n * 16 + 4 * fq) = acc[ai][bj][m][n] * scale;
                }
                __syncthreads();
                const int rbase = u.pm * 256 + ai * 128 + wq * 64;
                f32x4 bv[8];
#pragma unroll
                for (int r = 0; r < 8; ++r) bv[r] = *(const f32x4*)(base + (size_t)(rbase + wave * 8 + r) * DM + u.pn * 256 + lane * 4);
#pragma unroll
                for (int r = 0; r < 8; ++r) {
                    const int row = rbase + wave * 8 + r; const size_t off = (size_t)row * DM + u.pn * 256 + lane * 4;
                    const f32x4 v = bv[r] + *(const LAS f32x4*)(tl + (wave * 8 + r) * 260 + lane * 4);
                    *(f32x4*)(out + off) = v;
                    if (xb) *(u32x2*)(xb + off) = pack4(v);
                    if (ssq) { const float ss = wave_sum((v[0] * v[0] + v[1] * v[1]) + (v[2] * v[2] + v[3] * v[3])); if (lane == 0) ssq[(size_t)row * 4 + u.pn] = ss; }
                }
                __syncthreads();
            }
    }
};
struct EpiPlain {
    static constexpr bool AFTER_DRAIN = false;
    bf16_t* O; int ldo;
    __device__ __forceinline__ void operator()(ACC_ARG, const pg8::Unit& u, int wr, int wc, int fr, int fq) const {
        const int row0 = u.pm * 256 + wr * 64 + fr, col0 = u.pn * 256 + wc * 32 + 4 * fq;
#pragma unroll
        for (int ai = 0; ai < 2; ++ai)
#pragma unroll
            for (int m = 0; m < 4; ++m)
#pragma unroll
                for (int bj = 0; bj < 2; ++bj)
#pragma unroll
                    for (int n = 0; n < 2; ++n) *(u32x2*)(O + (size_t)(row0 + ai * 128 + m * 16) * ldo + col0 + bj * 128 + n * 16) = pack4(acc[ai][bj][m][n]);
    }
};
struct EpiMix {
    static constexpr bool AFTER_DRAIN = true;
    const LAS float* rtab; const float* rot;
    unsigned char* ws  ; bf16_t* mqb  ; const float *gdq, *gdk;
    static constexpr int TLD = 136;
    __device__ __forceinline__ void flushT(bf16_t* dst  , const LAS bf16_t* TS) const {
        const int tid = opaque_tid();
#pragma unroll
        for (int i = 0; i < 8; ++i) { const int p = tid + 512 * i, c = p >> 4, r8 = p & 15; *(u32x4*)(dst + (size_t)c * SEQ + r8 * 8) = *(const LAS u32x4*)(TS + c * TLD + r8 * 8); }
    }
    __device__ __forceinline__ void operator()(ACC_ARG, const pg8::Unit& u, int wr, int wc, int fr, int fq) const { body(acc, u, wr, wc, fr, fq, nullptr); }
    __device__ __forceinline__ void fused(ACC_ARG, const pg8::Unit& u, int wr, int wc, int fr, int fq, LAS unsigned char* lds) const {
        if (u.pn >= 4 && u.pn < 16) body(acc, u, wr, wc, fr, fq, (LAS bf16_t*)lds); else body(acc, u, wr, wc, fr, fq, nullptr);
    }
    __device__ __forceinline__ void body(ACC_ARG, const pg8::Unit& u, int wr, int wc, int fr, int fq, LAS bf16_t* TS) const {
        const int pn = u.pn, lr0 = wr * 64 + fr, lrow0 = u.pm * 256 + lr0;
        if (pn < 8) {
            const bool isk = pn >= 4; const int h = pn & 3; bf16_t* dst = (bf16_t*)(ws + (isk ? WS_K : WS_Q)); bf16_t* kts = (bf16_t*)(ws + WS_KTS);
            const float lg2 = log2f(1.0f - __builtin_amdgcn_exp2f(-5.0f - (float)h));
#pragma unroll
            for (int ai = 0; ai < 2; ++ai) {
                f32x4 cs0[4][2], cs1[4][2];
#pragma unroll
                for (int m = 0; m < 4; ++m)
#pragma unroll
                    for (int n = 0; n < 2; ++n) { const f32x4* cs = (const f32x4*)(rot + ((size_t)(lrow0 + ai * 128 + m * 16) * 128 + wc * 32 + 8 * fq + 4 * n) * 2); cs0[m][n] = cs[0]; cs1[m][n] = cs[1]; }
                EPI_FENCE();
#pragma unroll
                for (int m = 0; m < 4; ++m) {
                    int lrow = lrow0 + ai * 128 + m * 16; asm volatile("" : "+v"(lrow));
                    const float rs = rtab[u.ri * 256 + lr0 + ai * 128 + m * 16] * (isk ? 0.0625f : 1.0f);
                    const float dec = __builtin_amdgcn_exp2f(lg2 * (float)(127 - (lrow & 127)));
#pragma unroll
                    for (int n = 0; n < 2; ++n) {
                        const int i0 = wc * 32 + 8 * fq + 4 * n;
                        const f32x4 c01 = cs0[m][n], c23 = cs1[m][n];
                        const f32x4 cv = (f32x4){c01[0], c01[2], c23[0], c23[2]}, sv = (f32x4){c01[1], c01[3], c23[1], c23[3]};
                        const f32x4 x1 = acc[ai][0][m][n] * rs, x2 = acc[ai][1][m][n] * rs;
                        const f32x4 o1 = x1 * cv - x2 * sv, o2 = x1 * sv + x2 * cv;
                        *(u32x2*)(dst + (size_t)lrow * 1024 + h * 256 + i0) = pack4(o1);
                        *(u32x2*)(dst + (size_t)lrow * 1024 + h * 256 + 128 + i0) = pack4(o2);
                        if (isk) {
                            if (TS) {
                                const int rl = wr * 64 + m * 16 + fr;
#pragma unroll
                                for (int j = 0; j < 4; ++j) { TS[(i0 + j) * TLD + rl] = bf16_1(o1[j] * dec); TS[(128 + i0 + j) * TLD + rl] = bf16_1(o2[j] * dec); }
                            } else {
#pragma unroll
                                for (int j = 0; j < 4; ++j) {
                                    kts[(size_t)(h * 256 + i0 + j) * SEQ + lrow] = bf16_1(o1[j] * dec);
                                    kts[(size_t)(h * 256 + 128 + i0 + j) * SEQ + lrow] = bf16_1(o2[j] * dec);
                                }
                            }
                        }
                    }
                }
                EPI_FENCE();
                if (isk && TS) { __syncthreads(); flushT(kts + (size_t)(h * 256) * SEQ + u.pm * 256 + ai * 128, TS); __syncthreads(); }
            }
        } else if (pn < 16) {
            const int h = (pn - 8) >> 1, e0 = ((pn - 8) & 1) * 256; bf16_t* vt = (bf16_t*)(ws + WS_VT);
#pragma unroll
            for (int ai = 0; ai < 2; ++ai) {
#pragma unroll
                for (int m = 0; m < 4; ++m) {
                    int lrow = lrow0 + ai * 128 + m * 16; asm volatile("" : "+v"(lrow));
                    const float rs = rtab[u.ri * 256 + lr0 + ai * 128 + m * 16];
#pragma unroll
                    for (int bj = 0; bj < 2; ++bj)
#pragma unroll
                        for (int n = 0; n < 2; ++n) {
                            const int tc = bj * 128 + wc * 32 + 8 * fq + 4 * n, ec = e0 + tc; const f32x4 v = acc[ai][bj][m][n] * rs;
                            if (TS) {
                                const int rl = wr * 64 + m * 16 + fr;
#pragma unroll
                                for (int j = 0; j < 4; ++j) TS[(tc + j) * TLD + rl] = bf16_1(v[j]);
                            } else {
#pragma unroll
                                for (int j = 0; j < 4; ++j) vt[(size_t)(h * 512 + ec + j) * SEQ + lrow] = bf16_1(v[j]);
                            }
                        }
                    EPI_FENCE();
                }
                if (TS) { __syncthreads(); flushT(vt + (size_t)(h * 512 + e0) * SEQ + u.pm * 256 + ai * 128, TS); __syncthreads(); }
            }
        } else if (pn < 24) {
            const bool isk = pn >= 20; const int tile = (pn - 16) & 3; bf16_t* dst = (bf16_t*)(ws + (isk ? WS_DK : WS_DQ)); const float* gn = isk ? gdk : gdq; const float mul = isk ? 1.0f : C2Q;
            f32x4 gv[2][2];
#pragma unroll
            for (int bj = 0; bj < 2; ++bj)
#pragma unroll
                for (int n = 0; n < 2; ++n) gv[bj][n] = *(const f32x4*)(gn + 32 * bj + 8 * fq + 4 * n);
#pragma unroll
            for (int ai = 0; ai < 2; ++ai)
#pragma unroll
                for (int m = 0; m < 4; ++m) {
                    int lrow = lrow0 + ai * 128 + m * 16; asm volatile("" : "+v"(lrow));
                    const float rs = rtab[u.ri * 256 + lr0 + ai * 128 + m * 16];
                    f32x4 v[2][2]; float ss = 0.f;
#pragma unroll
                    for (int bj = 0; bj < 2; ++bj)
#pragma unroll
                        for (int n = 0; n < 2; ++n) { v[bj][n] = acc[ai][bj][m][n] * rs; const f32x4 t = v[bj][n]; ss += (t[0] * t[0] + t[1] * t[1]) + (t[2] * t[2] + t[3] * t[3]); }
                    ss += __shfl_xor(ss, 16); ss += __shfl_xor(ss, 32);
                    const float rn = __builtin_amdgcn_rsqf(ss * (1.0f / 64.0f) + EPS) * mul;
#pragma unroll
                    for (int bj = 0; bj < 2; ++bj) { const u32x2 p0 = pack4(v[bj][0] * rn * gv[bj][0]), p1 = pack4(v[bj][1] * rn * gv[bj][1]);
                        *(u32x4*)(dst + (size_t)lrow * 1024 + tile * 256 + 64 * wc + 32 * bj + 8 * fq) = (u32x4){p0.x, p0.y, p1.x, p1.y}; }
                    EPI_FENCE();
                }
        } else {
            bf16_t* dst = pn < 28 ? (bf16_t*)(ws + WS_DV) : mqb; const int tile = (pn - 24) & 3;
#pragma unroll
            for (int ai = 0; ai < 2; ++ai)
#pragma unroll
                for (int m = 0; m < 4; ++m) {
                    int lrow = lrow0 + ai * 128 + m * 16; asm volatile("" : "+v"(lrow));
                    const float rs = rtab[u.ri * 256 + lr0 + ai * 128 + m * 16];
#pragma unroll
                    for (int bj = 0; bj < 2; ++bj) { const u32x2 p0 = pack4(acc[ai][bj][m][0] * rs), p1 = pack4(acc[ai][bj][m][1] * rs);
                        *(u32x4*)(dst + (size_t)lrow * 1024 + tile * 256 + bj * 128 + wc * 32 + 8 * fq) = (u32x4){p0.x, p0.y, p1.x, p1.y}; }
                    EPI_FENCE();
                }
        }
    }
};
struct EpiRgG {
    static constexpr bool AFTER_DRAIN = false;
    const LAS float* rtab; bf16_t* ret; const float* rssq; unsigned char* ws;
    __device__ __forceinline__ void operator()(ACC_ARG, const pg8::Unit& u, int wr, int wc, int fr, int fq) const {
        const int lr0 = wr * 64 + fr;
        if (u.pn < 8) {
            const int col0 = u.pn * 256 + wc * 32 + 8 * fq;
#pragma unroll
            for (int ai = 0; ai < 2; ++ai) {
                u32x4 rv[4][2]; f32x2 rq2[4];
#pragma unroll
                for (int m = 0; m < 4; ++m) { const int lr = lr0 + ai * 128 + m * 16;
                    rq2[m] = *(const f32x2*)(rssq + (size_t)(u.pm * 256 + lr) * 8 + 2 * (u.pn >> 1));
#pragma unroll
                    for (int bj = 0; bj < 2; ++bj) rv[m][bj] = *(const u32x4*)(ret + (size_t)(u.pm * 256 + lr) * 2048 + col0 + bj * 128); }
                EPI_FENCE();
#pragma unroll
                for (int m = 0; m < 4; ++m) {
                    const int lr = lr0 + ai * 128 + m * 16; const float rs = rtab[u.ri * 256 + lr];
                    const float rr = __builtin_amdgcn_rsqf((rq2[m][0] + rq2[m][1]) * (1.0f / 512.0f) + EPS);
#pragma unroll
                    for (int bj = 0; bj < 2; ++bj) {
                        u32x4 o;
#pragma unroll
                        for (int n = 0; n < 2; ++n) {
                            const unsigned w0 = n == 0 ? rv[m][bj].x : rv[m][bj].z, w1 = n == 0 ? rv[m][bj].y : rv[m][bj].w; const f32x4 a = acc[ai][bj][m][n] * rs; f32x4 v;
                            v[0] = __uint_as_float(w0 << 16) * siluf(a[0]); v[1] = __uint_as_float(w0 & 0xffff0000u) * siluf(a[1]);
                            v[2] = __uint_as_float(w1 << 16) * siluf(a[2]); v[3] = __uint_as_float(w1 & 0xffff0000u) * siluf(a[3]);
                            const u32x2 p = pack4(v * rr); if (n == 0) { o.x = p.x; o.y = p.y; } else { o.z = p.x; o.w = p.y; }
                        }
                        *(u32x4*)(ret + (size_t)(u.pm * 256 + lr) * 2048 + col0 + bj * 128) = o;
                    }
                }
                EPI_FENCE();
            }
        } else {
            const int br = (u.pn - 8) >> 2, col0 = ((u.pn - 8) & 3) * 256 + wc * 32 + 8 * fq;
            unsigned char* g8 = ws + (br == 0 ? WS_G8A : br == 1 ? WS_G8B : WS_G8C);
#pragma unroll
            for (int ai = 0; ai < 2; ++ai)
#pragma unroll
                for (int m = 0; m < 4; ++m) {
                    const int lr = lr0 + ai * 128 + m * 16; const float rs = rtab[u.ri * 256 + lr];
#pragma unroll
                    for (int bj = 0; bj < 2; ++bj) {
                        u32x2 w2;
#pragma unroll
                        for (int n = 0; n < 2; ++n) {
                            const f32x4 a = acc[ai][bj][m][n] * rs; unsigned w = 0u;
#pragma unroll
                            for (int j = 0; j < 4; ++j) w |= (unsigned)__builtin_rintf(255.0f * sigmf(a[j])) << (8 * j);
                            if (n == 0) w2.x = w; else w2.y = w;
                        }
                        *(u32x2*)(g8 + (size_t)(u.pm * 256 + lr) * DM + col0 + bj * 128) = w2;
                    }
                }
        }
    }
};
struct EpiTerm3 {
    static constexpr bool AFTER_DRAIN = false;
    unsigned char* ws; bf16_t* y;
    __device__ __forceinline__ void operator()(ACC_ARG, const pg8::Unit& u, int wr, int wc, int fr, int fq) const {
        const int lr0 = wr * 64 + fr, col0 = u.pn * 256 + wc * 32 + 8 * fq, first = (u.tag == 0);
        const unsigned char* g8 = ws + (u.tag == 0 ? WS_G8A : u.tag == 1 ? WS_G8B : WS_G8C);
#pragma unroll
        for (int ai = 0; ai < 2; ++ai) {
            u32x2 gv[4][2]; u32x4 yv[4][2];
#pragma unroll
            for (int m = 0; m < 4; ++m)
#pragma unroll
                for (int bj = 0; bj < 2; ++bj) { const size_t off = (size_t)(u.pm * 256 + lr0 + ai * 128 + m * 16) * DM + col0 + bj * 128;
                    gv[m][bj] = *(const u32x2*)(g8 + off); yv[m][bj] = first ? (u32x4){0u, 0u, 0u, 0u} : *(const u32x4*)(y + off); }
            EPI_FENCE();
#pragma unroll
            for (int m = 0; m < 4; ++m)
#pragma unroll
                for (int bj = 0; bj < 2; ++bj) {
                    const size_t off = (size_t)(u.pm * 256 + lr0 + ai * 128 + m * 16) * DM + col0 + bj * 128;
                    u32x4 o;
#pragma unroll
                    for (int n = 0; n < 2; ++n) {
                        const f32x4 a = acc[ai][bj][m][n]; const unsigned gw = n == 0 ? gv[m][bj].x : gv[m][bj].y; const unsigned w0 = n == 0 ? yv[m][bj].x : yv[m][bj].z, w1 = n == 0 ? yv[m][bj].y : yv[m][bj].w; f32x4 v;
                        v[0] = (float)(gw & 255u) * (1.0f / 255.0f) * a[0] + __uint_as_float(w0 << 16); v[1] = (float)((gw >> 8) & 255u) * (1.0f / 255.0f) * a[1] + __uint_as_float(w0 & 0xffff0000u);
                        v[2] = (float)((gw >> 16) & 255u) * (1.0f / 255.0f) * a[2] + __uint_as_float(w1 << 16); v[3] = (float)(gw >> 24) * (1.0f / 255.0f) * a[3] + __uint_as_float(w1 & 0xffff0000u);
                        const u32x2 p = pack4(v); if (n == 0) { o.x = p.x; o.y = p.y; } else { o.z = p.x; o.w = p.y; }
                    }
                    *(u32x4*)(y + off) = o;
                }
            EPI_FENCE();
        }
    }
};

#include <hip/hip_bf16.h>
namespace attn_body {
using bf16=__hip_bfloat16;
using bf16x8=__attribute__((ext_vector_type(8)))short;
using s16x4=__attribute__((ext_vector_type(4)))short;
using f32x16=__attribute__((ext_vector_type(16)))float;
using u32x4=__attribute__((ext_vector_type(4)))unsigned;
constexpr int D=64,DM=1024;
constexpr int NW=8,QBLK=32,QB=QBLK*NW,KVBLK=64;
__device__ __forceinline__ int crow(int r,int hi){return (r&3)+8*(r>>2)+4*hi;}
#define SBAR() __builtin_amdgcn_sched_barrier(0)
__device__ __forceinline__ void cmask(f32x16&p0,f32x16&p1,int jb,int qrel,int hi){
  const float NEG=-INFINITY; int kb=64*jb+4*hi;
  #pragma unroll
  for(int r=0;r<16;++r){int kv=kb+(r&3)+8*(r>>2); if(kv>qrel)p0[r]=NEG; if(kv+32>qrel)p1[r]=NEG;}
}
constexpr int NSLOT=3, SLOTB=8192;
constexpr int LDS_K=0, LDS_V=NSLOT*SLOTB, LDS_WS=2*NSLOT*SLOTB, LDS_OST=LDS_WS+NW*64*4, LDS_BYTES=LDS_OST+NW*4096;
__device__ __forceinline__ void glds16(const void*gsrc,unsigned lds_dst){unsigned keep;
  asm volatile("s_mov_b32 %0, m0\n\ts_mov_b32 m0, %2\n\ts_nop 0\n\tglobal_load_lds_dwordx4 %1, off\n\ts_mov_b32 m0, %0":"=&s"(keep):"v"(gsrc),"s"(lds_dst):"memory");}
__device__ __forceinline__ float max3f(float a,float b,float c){float r;asm("v_max3_f32 %0, %1, %2, %3":"=v"(r):"v"(a),"v"(b),"v"(c));return r;}
__device__ __forceinline__ float max2f(float a,float b){float r;asm("v_max_f32_e32 %0, %1, %2":"=v"(r):"v"(a),"v"(b));return r;}
__device__ __forceinline__ float fadd_s(float a,float b){float r;asm("v_add_f32_e32 %0, %1, %2":"=v"(r):"v"(a),"v"(b));return r;}
__device__ __forceinline__ float fsub_s(float a,float b){float r;asm("v_sub_f32_e32 %0, %1, %2":"=v"(r):"v"(a),"v"(b));return r;}
typedef float f32x2_t __attribute__((ext_vector_type(2))); typedef __bf16 bf16x2_t __attribute__((ext_vector_type(2)));
__device__ __forceinline__ unsigned cvtpk_s(float lo,float hi){f32x2_t v={lo,hi};bf16x2_t b=__builtin_convertvector(v,bf16x2_t);return __builtin_bit_cast(unsigned,b);}
#define WAIT_BAR(N) asm volatile("s_waitcnt vmcnt(" #N ") lgkmcnt(0)\n\ts_barrier":::"memory")
__device__ __forceinline__ void qkt(f32x16&p0,f32x16&p1,const char*Kslot,const bf16x8*qr,const f32x16&negm,int r32,int hi){
  const char*kb=Kslot+hi*1024+r32*16;
  #pragma unroll
  for(int d0=0;d0<4;++d0){
    const bf16x8 b0=*reinterpret_cast<const bf16x8*>(kb+d0*2048);
    const bf16x8 b1=*reinterpret_cast<const bf16x8*>(kb+d0*2048+512);
    if(d0==0){p0=__builtin_amdgcn_mfma_f32_32x32x16_bf16(b0,qr[0],negm,0,0,0);p1=__builtin_amdgcn_mfma_f32_32x32x16_bf16(b1,qr[0],negm,0,0,0);}
    else{p0=__builtin_amdgcn_mfma_f32_32x32x16_bf16(b0,qr[d0],p0,0,0,0);p1=__builtin_amdgcn_mfma_f32_32x32x16_bf16(b1,qr[d0],p1,0,0,0);}}
}
typedef __attribute__((address_space(3))) const char* lds_cptr;
typedef short v4i16_t __attribute__((ext_vector_type(4)));
__device__ __forceinline__ void kload8(bf16x8*kf,lds_cptr kp){
  kf[0]=*(const __attribute__((address_space(3))) bf16x8*)(kp);      kf[1]=*(const __attribute__((address_space(3))) bf16x8*)(kp+512);
  kf[2]=*(const __attribute__((address_space(3))) bf16x8*)(kp+2048); kf[3]=*(const __attribute__((address_space(3))) bf16x8*)(kp+2560);
  kf[4]=*(const __attribute__((address_space(3))) bf16x8*)(kp+4096); kf[5]=*(const __attribute__((address_space(3))) bf16x8*)(kp+4608);
  kf[6]=*(const __attribute__((address_space(3))) bf16x8*)(kp+6144); kf[7]=*(const __attribute__((address_space(3))) bf16x8*)(kp+6656);
}
__device__ __forceinline__ void kload2(bf16x8*kf,lds_cptr kp,int j){ kf[2*j]=*(const __attribute__((address_space(3))) bf16x8*)(kp+j*2048); kf[2*j+1]=*(const __attribute__((address_space(3))) bf16x8*)(kp+j*2048+512); }
__device__ __forceinline__ s16x4 vtr(lds_cptr p){ return __builtin_bit_cast(s16x4,__builtin_amdgcn_ds_read_tr16_b64_v4i16((__attribute__((address_space(3))) v4i16_t*)p)); }
__device__ __forceinline__ float rowmax(const f32x16&p0,const f32x16&p1){
  float a=max3f(p0[0],p0[1],p1[0]),b=max3f(p0[2],p0[3],p1[1]);a=max3f(a,p1[2],p1[3]);
  #pragma unroll
  for(int r=4;r<16;r+=4){a=max3f(a,p0[r],p0[r+1]);b=max3f(b,p0[r+2],p0[r+3]);a=max3f(a,p1[r],p1[r+1]);b=max3f(b,p1[r+2],p1[r+3]);}
  const float m=max2f(a,b);
  auto rr=__builtin_amdgcn_permlane32_swap(__float_as_uint(m),__float_as_uint(m),false,false);
  return max2f(__uint_as_float(rr[0]),__uint_as_float(rr[1]));
}
__device__ __forceinline__ void pv(f32x16*o,int vb,bf16x8 pa0,bf16x8 pa1,bf16x8 pa2,bf16x8 pa3){
  #pragma unroll
  for(int d0=0;d0<2;++d0){s16x4 lo[4],hi[4];
    #pragma unroll
    for(int ks=0;ks<4;++ks){
      asm volatile("ds_read_b64_tr_b16 %0,%1 offset:%c2":"=&v"(lo[ks]):"v"(vb),"i"(d0*4096+ks*1024):"memory");
      asm volatile("ds_read_b64_tr_b16 %0,%1 offset:%c2":"=&v"(hi[ks]):"v"(vb),"i"(d0*4096+ks*1024+512):"memory");}
    asm volatile("s_waitcnt lgkmcnt(0)":::"memory");SBAR();
    #define PK(k) (bf16x8){lo[k][0],lo[k][1],lo[k][2],lo[k][3],hi[k][0],hi[k][1],hi[k][2],hi[k][3]}
    o[d0]=__builtin_amdgcn_mfma_f32_32x32x16_bf16(pa0,PK(0),o[d0],0,0,0);
    o[d0]=__builtin_amdgcn_mfma_f32_32x32x16_bf16(pa1,PK(1),o[d0],0,0,0);
    o[d0]=__builtin_amdgcn_mfma_f32_32x32x16_bf16(pa2,PK(2),o[d0],0,0,0);
    o[d0]=__builtin_amdgcn_mfma_f32_32x32x16_bf16(pa3,PK(3),o[d0],0,0,0);
    #undef PK
  }
}
#define ATTN_STORE16(p,v) (*(u32x4*)(p)=(v))
template<int THRL> __device__ __forceinline__ void attn_unit(int hq,int hv,int qb,const bf16*Q,const bf16*__restrict__ K,const bf16*__restrict__ V,bf16*O,char*shm){
  const int tid=opaque_tid(),lane=tid&63,r32=lane&31,hi=lane>>5; const int wid=__builtin_amdgcn_readfirstlane(tid>>6);
  const int q0=qb*QB;
  const bf16*Qw=Q+(long)(q0+wid*QBLK)*DM+hq*D;
  const bf16*Kh=K+hq*D,*Vh=V+hv*D;
  const unsigned lds0=(unsigned)(uintptr_t)shm;
  float*wsf=(float*)(shm+LDS_WS)+wid*64;
  const bf16*ksrc=Kh+(long)lane*DM+wid*8;
  const bf16*vsrc=Vh+(long)(16*(wid&3)+(lane>>2))*DM+(wid>>2)*32+(lane&3)*8;
  const unsigned kdst=lds0+LDS_K+wid*1024, vdst=lds0+LDS_V+wid*1024;
  #define DMA_K(t,slot) glds16(ksrc+(long)(t)*KVBLK*DM,(unsigned)__builtin_amdgcn_readfirstlane(kdst+(slot)))
  #define DMA_V(t,slot) glds16(vsrc+(long)(t)*KVBLK*DM,(unsigned)__builtin_amdgcn_readfirstlane(vdst+(slot)))
  const int vb0=(int)(lds0+LDS_V)+((lane>>4)&1)*32+(lane&3)*8+(4*hi+((lane&15)>>2))*64;
  const char*Kbase=shm+LDS_K; bf16x8 kf[8];
  const lds_cptr shm3=(lds_cptr)shm; const lds_cptr kp0=shm3+LDS_K+hi*1024+r32*16; const lds_cptr vp0=shm3+LDS_V+((lane>>4)&1)*32+(lane&3)*8+(4*hi+((lane&15)>>2))*64;
  const int NT=(q0+QB)/KVBLK;
  DMA_K(0,0);DMA_V(0,0);DMA_K(1,SLOTB);
  bf16x8 qr[4];
  #pragma unroll
  for(int d0=0;d0<4;++d0)qr[d0]=*reinterpret_cast<const bf16x8*>(&Qw[(long)r32*DM+d0*16+hi*8]);
  float mhat=0.f,l_reg=0.f;f32x16 o[2];o[0]=f32x16{};o[1]=f32x16{};f32x16 negm=f32x16{};asm volatile("":"+v"(negm));
  const int qrel=wid*QBLK+r32;
  #define CMASK(P0,P1,t) do{int jb_=(t)-(NT-4); if(jb_>=0)cmask(P0,P1,jb_,qrel,hi);}while(0)
  bool resc=false;
  #define START(P0,P1) do{ const float rm=rowmax(P0,P1); resc=false; \
    { const float dl=rm; mhat=fadd_s(mhat,dl); \
      _Pragma("unroll") for(int r=0;r<16;++r){P0[r]=fsub_s(P0[r],dl);P1[r]=fsub_s(P1[r],dl);} \
      _Pragma("unroll") for(int r=0;r<16;++r)negm[r]=-mhat; asm volatile("":"+v"(negm)); } \
    _Pragma("unroll") for(int r=0;r<16;++r)P0[r]=__builtin_amdgcn_exp2f(P0[r]); }while(0)
  #define RESC() do{ if(resc){ asm volatile("s_waitcnt lgkmcnt(0)":::"memory"); \
      _Pragma("unroll") for(int d_=0;d_<2;++d_) _Pragma("unroll") for(int r=0;r<16;++r)o[d_][r]*=wsf[crow(r,hi)]; } }while(0)
  f32x16 pA0,pA1,pB0,pB1;
  int sl_prev=0,sl_cur=0,sl_next=SLOTB;
  #define ROT() do{sl_prev=sl_cur;sl_cur=sl_next;sl_next=(sl_next==(NSLOT-1)*SLOTB)?0:sl_next+SLOTB;}while(0)
  DMA_K(2,2*SLOTB);
  WAIT_BAR(3);
  qkt(pA0,pA1,Kbase,qr,negm,r32,hi);asm volatile("s_nop 15\n\ts_nop 7":"+v"(pA0),"+v"(pA1));CMASK(pA0,pA1,0);
  START(pA0,pA1);
  _Pragma("unroll") for(int r=0;r<16;++r)pA1[r]=__builtin_amdgcn_exp2f(pA1[r]);
  WAIT_BAR(0);
  DMA_K(3,0);DMA_V(1,SLOTB);
  ROT();
  kload8(kf,kp0+sl_cur);
  WAIT_BAR(2);
  s16x4 vlo[8],vhi[8]; u32x4 pw0,pw1,pw2,pw3;
  #define PKW(P,B) cvtpk_s(P[B],P[B+1])
  #define PAF(k) __builtin_bit_cast(bf16x8,pw##k)
  #define VFR(i) (bf16x8){vlo[i][0],vlo[i][1],vlo[i][2],vlo[i][3],vhi[i][0],vhi[i][1],vhi[i][2],vhi[i][3]}
  #define PIN(x) asm volatile("":"+v"(x))
  #define MX3(a,b,c) __builtin_fmaxf(__builtin_fmaxf((a),(b)),(c))
  #define GAPA(MF,A0,A1,A2,A3,W0,W1,PW) do{ MF; sacc+=A0; sacc+=A1; sacc+=A2; sacc+=A3; PIN(sacc); W0; W1; PIN(PW); SBAR(); }while(0)
  #define EX(v) __builtin_amdgcn_exp2f(v)
  #define GAPB(MF,X,B) do{ MF; X[B]=EX(X[B]); X[B+1]=EX(X[B+1]); X[B+2]=EX(X[B+2]); X[B+3]=EX(X[B+3]); PIN(X); SBAR(); }while(0)
  #define VRD(i) do{ vlo[i]=vtr(vp_+(((i)>>2)*4096+((i)&3)*1024)); vhi[i]=vtr(vp_+(((i)>>2)*4096+((i)&3)*1024+512)); }while(0)
  #define KRD(G,j) do{ if(G){ kload2(kf,kp0+sl_next,j); SBAR(); } }while(0)
  #define STEP(C0,C1,P0,P1,t,GK,GV,GL) do{ SBAR(); \
    const lds_cptr vp_=vp0+sl_prev; \
    VRD(0); SBAR(); float sacc=(P0[0]+P0[1]); \
    GAPA(C0=__builtin_amdgcn_mfma_f32_32x32x16_bf16(kf[0],qr[0],negm,0,0,0), P0[2],P0[3],P0[4],P0[5],     pw0[0]=PKW(P0,0), pw0[1]=PKW(P0,2), pw0); \
    VRD(4); SBAR(); GAPA(C1=__builtin_amdgcn_mfma_f32_32x32x16_bf16(kf[1],qr[0],negm,0,0,0), P0[6],P0[7],P0[8],P0[9],     pw0[2]=PKW(P0,4), pw0[3]=PKW(P0,6), pw0); \
    VRD(1); SBAR(); GAPA(C0=__builtin_amdgcn_mfma_f32_32x32x16_bf16(kf[2],qr[1],C0,0,0,0),   P0[10],P0[11],P0[12],P0[13], pw1[0]=PKW(P0,8), pw1[1]=PKW(P0,10), pw1); \
    VRD(5); SBAR(); GAPA(C1=__builtin_amdgcn_mfma_f32_32x32x16_bf16(kf[3],qr[1],C1,0,0,0),   P0[14],P0[15],P1[0],P1[1],   pw1[2]=PKW(P0,12),pw1[3]=PKW(P0,14), pw1); \
    VRD(2); SBAR(); GAPA(C0=__builtin_amdgcn_mfma_f32_32x32x16_bf16(kf[4],qr[2],C0,0,0,0),   P1[2],P1[3],P1[4],P1[5],     pw2[0]=PKW(P1,0), pw2[1]=PKW(P1,2), pw2); \
    VRD(6); SBAR(); GAPA(C1=__builtin_amdgcn_mfma_f32_32x32x16_bf16(kf[5],qr[2],C1,0,0,0),   P1[6],P1[7],P1[8],P1[9],     pw2[2]=PKW(P1,4), pw2[3]=PKW(P1,6), pw2); \
    VRD(3); SBAR(); GAPA(C0=__builtin_amdgcn_mfma_f32_32x32x16_bf16(kf[6],qr[3],C0,0,0,0),   P1[10],P1[11],P1[12],P1[13], pw3[0]=PKW(P1,8), pw3[1]=PKW(P1,10), pw3); \
    VRD(7); SBAR(); GAPA(C1=__builtin_amdgcn_mfma_f32_32x32x16_bf16(kf[7],qr[3],C1,0,0,0),   P1[14],P1[15],0.f,0.f,       pw3[2]=PKW(P1,12),pw3[3]=PKW(P1,14), pw3); \
    l_reg+=sacc; \
    if(GK){DMA_K((t)+3,sl_cur);} if(GV){DMA_V((t)+1,sl_next);} \
    CMASK(C0,C1,t); \
    { float a=MX3(C0[0],C0[1],C1[0]),b=MX3(C0[2],C0[3],C1[1]); a=MX3(a,C1[2],C1[3]); \
      _Pragma("unroll") for(int r=4;r<16;r+=4){a=MX3(a,C0[r],C0[r+1]);b=MX3(b,C0[r+2],C0[r+3]);a=MX3(a,C1[r],C1[r+1]);b=MX3(b,C1[r+2],C1[r+3]);} \
      float rm=__builtin_fmaxf(a,b); { auto rr=__builtin_amdgcn_permlane32_swap(__float_as_uint(rm),__float_as_uint(rm),false,false); rm=__builtin_fmaxf(__uint_as_float(rr[0]),__uint_as_float(rr[1])); } \
      resc=false; \
      if(__builtin_expect(__any(rm>(float)THRL),0)){ const float dl=__builtin_fmaxf(rm,0.f); mhat+=dl; \
        _Pragma("unroll") for(int r=0;r<16;++r){C0[r]-=dl;C1[r]-=dl;} \
        _Pragma("unroll") for(int r=0;r<16;++r)negm[r]=-mhat; asm volatile("":"+v"(negm)); \
        const float f=__builtin_amdgcn_exp2f(-dl); l_reg*=f; if(hi==0)wsf[r32]=f; resc=true; } } \
    SBAR(); \
    GAPB(o[0]=__builtin_amdgcn_mfma_f32_32x32x16_bf16(PAF(0),VFR(0),o[0],0,0,0), C0,0); \
    GAPB(o[1]=__builtin_amdgcn_mfma_f32_32x32x16_bf16(PAF(0),VFR(4),o[1],0,0,0), C0,4); \
    KRD(GL,0); GAPB(o[0]=__builtin_amdgcn_mfma_f32_32x32x16_bf16(PAF(1),VFR(1),o[0],0,0,0), C0,8); \
    KRD(GL,1); GAPB(o[1]=__builtin_amdgcn_mfma_f32_32x32x16_bf16(PAF(1),VFR(5),o[1],0,0,0), C0,12); \
    KRD(GL,2); GAPB(o[0]=__builtin_amdgcn_mfma_f32_32x32x16_bf16(PAF(2),VFR(2),o[0],0,0,0), C1,0); \
    KRD(GL,3); GAPB(o[1]=__builtin_amdgcn_mfma_f32_32x32x16_bf16(PAF(2),VFR(6),o[1],0,0,0), C1,4); \
    GAPB(o[0]=__builtin_amdgcn_mfma_f32_32x32x16_bf16(PAF(3),VFR(3),o[0],0,0,0), C1,8); \
    GAPB(o[1]=__builtin_amdgcn_mfma_f32_32x32x16_bf16(PAF(3),VFR(7),o[1],0,0,0), C1,12); \
    }while(0)
  int t=1;
  #undef CMASK
  #define CMASK(P0,P1,t) do{}while(0)
  for(;t+5<NT;t+=2){
    STEP(pB0,pB1,pA0,pA1,t,true,true,true);     WAIT_BAR(2); RESC(); ROT();
    STEP(pA0,pA1,pB0,pB1,t+1,true,true,true);   WAIT_BAR(2); RESC(); ROT();
  }
  #undef CMASK
  #define CMASK(P0,P1,t) do{int jb_=(t)-(NT-4); if(jb_>=0)cmask(P0,P1,jb_,qrel,hi);}while(0)
  #define ENDW(tt) do{ if((tt)+3<NT){WAIT_BAR(2);} else if((tt)+2<NT){WAIT_BAR(1);} else {WAIT_BAR(0);} }while(0)
  for(;t+1<NT;t+=2){
    STEP(pB0,pB1,pA0,pA1,t,(t+3<NT),(t+1<NT),(t+1<NT));       ENDW(t);   RESC(); ROT();
    STEP(pA0,pA1,pB0,pB1,t+1,(t+4<NT),(t+2<NT),(t+2<NT));     ENDW(t+1); RESC(); ROT();
  }
  STEP(pB0,pB1,pA0,pA1,NT-1,false,false,false); RESC();
  { float sacc=pB0[0]+pB0[1]; _Pragma("unroll") for(int r=2;r<16;++r)sacc+=pB0[r]; _Pragma("unroll") for(int r=0;r<16;++r)sacc+=pB1[r]; l_reg+=sacc;
    pw0=(u32x4){PKW(pB0,0),PKW(pB0,2),PKW(pB0,4),PKW(pB0,6)};pw1=(u32x4){PKW(pB0,8),PKW(pB0,10),PKW(pB0,12),PKW(pB0,14)};pw2=(u32x4){PKW(pB1,0),PKW(pB1,2),PKW(pB1,4),PKW(pB1,6)};pw3=(u32x4){PKW(pB1,8),PKW(pB1,10),PKW(pB1,12),PKW(pB1,14)};
    SBAR(); pv(o,vb0+sl_cur,PAF(0),PAF(1),PAF(2),PAF(3)); }
  #undef PKW
  #undef PAF
  #undef VFR
  #undef PIN
  #undef MX3
  #undef GAPA
  #undef GAPB
  #undef EX
  #undef VRD
  #undef KRD
  #undef STEP
  #undef ENDW
  {auto rr=__builtin_amdgcn_permlane32_swap(__float_as_uint(l_reg),__float_as_uint(l_reg),false,false);l_reg=__uint_as_float(rr[0])+__uint_as_float(rr[1]);}
  if(hi==0)wsf[32+r32]=l_reg;asm volatile("s_waitcnt lgkmcnt(0)":::"memory");
  float rli[16];
  #pragma unroll
  for(int r=0;r<16;++r)rli[r]=__builtin_amdgcn_rcpf(wsf[32+crow(r,hi)]);
  bf16*Ow=O+(long)(q0+wid*QBLK)*DM+hv*D;
  { bf16*stg=(bf16*)(shm+LDS_OST)+wid*2048;
    #pragma unroll
    for(int r=0;r<16;++r){const int orow=crow(r,hi);
      #pragma unroll
      for(int d0=0;d0<2;++d0)stg[orow*64+d0*32+r32]=__float2bfloat16(o[d0][r]*rli[r]);}
    asm volatile("s_waitcnt lgkmcnt(0)":::"memory");
    #pragma unroll
    for(int i=0;i<4;++i){const int row=i*8+(lane>>3),ch=lane&7; const u32x4 v=*(const u32x4*)(stg+row*64+ch*8); ATTN_STORE16(Ow+(long)row*DM+ch*8,v);} }
  asm volatile("s_waitcnt lgkmcnt(0)\n\ts_barrier":::"memory");
  #undef DMA_K
  #undef DMA_V
  #undef CMASK
  #undef START
  #undef RESC
  #undef ROT
}
constexpr int ATTN_LDS_BYTES=LDS_BYTES;
#undef SBAR
#undef WAIT_BAR
}

typedef GAS unsigned gu32;
#define RLX_AGENT __ATOMIC_RELAXED, __HIP_MEMORY_SCOPE_AGENT
#define LDS_WAIT() asm volatile("s_waitcnt lgkmcnt(0)" ::: "memory")
#define XB_TMO      128
#define XB_XCNT(j)  (256  + 64 * (j))
#define XB_XSUB(j)  (1280 + 64 * (j))
#define XB_XGEN(j)  (2304 + 64 * (j))
#define XB_TOP      3328
#define XB_TOPGEN   3392
#define XCD_BAR_WORDS 3456
#define XB_SPIN_CAP (1u << 18)
__device__ __forceinline__ unsigned xb_ld(unsigned* p)              { return __hip_atomic_load(p, __ATOMIC_RELAXED, __HIP_MEMORY_SCOPE_AGENT); }
__device__ __forceinline__ unsigned xb_add(unsigned* p, unsigned v) { return __hip_atomic_fetch_add(p, v, __ATOMIC_RELAXED, __HIP_MEMORY_SCOPE_AGENT); }
__device__ __forceinline__ unsigned xb_xcc_id() { return (unsigned)__builtin_amdgcn_s_getreg((3 << 11) | 20) & 0xFu; }
#define XB_SPIN(cond, bar) do { unsigned _sp = 0; while (cond) { __builtin_amdgcn_s_sleep(1); \
    if ((++_sp & 255u) == 0u) { if (xb_ld(&(bar)[XB_TMO])) break; if (_sp > XB_SPIN_CAP) { atomicAdd(&(bar)[XB_TMO], 1u); break; } } } } while (0)
struct XcdBarrier { unsigned* bar; unsigned x; volatile LAS unsigned* st; };
__device__ __forceinline__ XcdBarrier xcd_barrier_post(unsigned* bar, volatile LAS unsigned* st) {
    XcdBarrier b; b.bar = bar; b.x = xb_xcc_id(); b.st = st;
    if (threadIdx.x == 0) (void)xb_add(&bar[XB_XCNT(b.x)], 1u);
    return b;
}
__device__ __forceinline__ void xcd_barrier_complete(unsigned* bar, unsigned x, unsigned& nloc, unsigned& nx) {
    const unsigned G = gridDim.x * gridDim.y * gridDim.z;
    unsigned sum, cnt, mine, sp = 0u;
    for (;;) {
        sum = 0u; cnt = 0u; mine = 0u;
#pragma unroll
        for (unsigned j = 0; j < 16; ++j) { const unsigned c = xb_ld(&bar[XB_XCNT(j)]); sum += c; cnt += (c > 0u) ? 1u : 0u; mine = (j == x) ? c : mine; }
        if (sum == G) break;
        __builtin_amdgcn_s_sleep(1);
        if ((++sp & 255u) == 0u) { if (xb_ld(&bar[XB_TMO])) break; if (sp > XB_SPIN_CAP) { atomicAdd(&bar[XB_TMO], 1u); break; } }
    }
    nloc = mine > 0u ? mine : 1u; nx = cnt > 0u ? cnt : 1u;
}
__device__ __forceinline__ void xcd_barrier(const XcdBarrier& b) {
    asm volatile("s_waitcnt vmcnt(0)" ::: "memory");
    __syncthreads();
    if (threadIdx.x == 0) {
        unsigned* bar = b.bar; asm volatile("" : "+v"(bar));
        __builtin_amdgcn_s_waitcnt(0);
        unsigned nloc = b.st[0], nx = b.st[1];
        if (nloc == 0u) { xcd_barrier_complete(bar, b.x, nloc, nx); b.st[0] = nloc; b.st[1] = nx; }
        const unsigned old = xb_add(&bar[XB_XSUB(b.x)], 1u);
        const unsigned gen = old / nloc;
        if (old + 1u == (gen + 1u) * nloc) {
            __builtin_amdgcn_fence(__ATOMIC_RELEASE, "agent");
            asm volatile("s_waitcnt vmcnt(0)" ::: "memory");
            const unsigned og = xb_add(&bar[XB_TOP], 1u);
            const unsigned tg = og / nx;
            if (og + 1u == (tg + 1u) * nx) xb_add(&bar[XB_TOPGEN], 1u);
            else XB_SPIN(xb_ld(&bar[XB_TOPGEN]) == tg, bar);
            __builtin_amdgcn_fence(__ATOMIC_ACQUIRE, "agent");
            xb_add(&bar[XB_XGEN(b.x)], 1u);
            asm volatile("s_waitcnt vmcnt(0)" ::: "memory");
        } else {
            XB_SPIN(xb_ld(&bar[XB_XGEN(b.x)]) == gen, bar);
            __builtin_amdgcn_fence(__ATOMIC_ACQUIRE, "agent");
            asm volatile("s_waitcnt vmcnt(0)" ::: "memory");
        }
    }
    __syncthreads();
}

__device__ __forceinline__ float wave_sum(float v) {
#pragma unroll
    for (int o = 1; o < 64; o <<= 1) v += __shfl_xor(v, o);
    return v;
}
template <class F>
__device__ __forceinline__ void transpose_load(const float* W, int ld, int nrows, F srccol, int item, int lane, f32x4 (&v)[8]) {
    const int nblk = nrows / 32, kb = item / nblk, nb = item % nblk, k0 = 64 * kb, s0 = srccol(32 * nb);
#pragma unroll
    for (int i = 0; i < 8; ++i) v[i] = *(const f32x4*)(W + (size_t)(k0 + 8 * i + (lane >> 3)) * ld + s0 + 4 * (lane & 7));
}
__host__ __device__ __forceinline__ int perm32(int rho) { const int n = rho >> 4, i = rho & 15; return 8 * (i >> 2) + 4 * n + (i & 3); }
template <bool PERM>
__device__ __forceinline__ void transpose_store(int K, bf16_t* WT, int nrows, const float* gk, LAS float* scr, int item, int lane, const f32x4 (&v)[8]) {
    const int nblk = nrows / 32, kb = item / nblk, nb = item % nblk, k0 = 64 * kb, n0 = 32 * nb;
#pragma unroll
    for (int i = 0; i < 8; ++i) { const int kk = 8 * i + (lane >> 3); const float g = gk ? gk[k0 + kk] : 1.0f;
#pragma unroll
        for (int e = 0; e < 4; ++e) scr[kk * 33 + 4 * (lane & 7) + e] = v[i][e] * g; }
    LDS_WAIT(); asm volatile("" ::: "memory");
    const int c = lane & 7;
#pragma unroll
    for (int j = 0; j < 4; ++j) { const int n = (lane >> 3) + 8 * j; const LAS float* s = scr + (8 * c) * 33 + (PERM ? perm32(n) : n);
        u32x4 o; o.x = cvt_pk_bf16(s[0 * 33], s[1 * 33]); o.y = cvt_pk_bf16(s[2 * 33], s[3 * 33]); o.z = cvt_pk_bf16(s[4 * 33], s[5 * 33]); o.w = cvt_pk_bf16(s[6 * 33], s[7 * 33]);
        *(u32x4*)(WT + (size_t)(n0 + n) * K + k0 + 8 * c) = o; }
    LDS_WAIT(); asm volatile("" ::: "memory");
}
struct ColIdent { int off; __device__ __forceinline__ int operator()(int r) const { return off + r; } };
struct ColSwiglu { __device__ __forceinline__ int operator()(int r) const { return ((r >> 7) & 1) * DFF + (r >> 8) * 128 + (r & 127); } };
struct ColMix { __device__ __forceinline__ int operator()(int r) const {
    const int tile = r >> 8, p = r & 255, o = 64 * ((p >> 5) & 3) + 32 * (p >> 7) + (p & 31);
    if (tile < 16) return r;
    if (tile < 20) return 6144 + (tile - 16) * 256 + o;
    if (tile < 24) return 7168 + (tile - 20) * 256 + o;
    if (tile < 28) return 8192 + (tile - 24) * 256 + p;
    return 9216 + (tile - 28) * 256 + p; } };
template <bool PERM = false, class F>
__device__ __forceinline__ void transpose_all(const float* W, int K, int ld, bf16_t* WT, int nrows, F srccol, const float* gk, LAS float* scr, int gw, int ngw, int lane) {
    const int nitems = (K / 64) * (nrows / 32);
    for (int it = gw; it < nitems; it += 2 * ngw) {
        f32x4 va[8], vb[8]; const int it2 = it + ngw;
        transpose_load(W, ld, nrows, srccol, it, lane, va);
        if (it2 < nitems) transpose_load(W, ld, nrows, srccol, it2, lane, vb);
        transpose_store<PERM>(K, WT, nrows, gk, scr, it, lane, va);
        if (it2 < nitems) transpose_store<PERM>(K, WT, nrows, gk, scr, it2, lane, vb);
    }
}
__device__ __forceinline__ void rms_rows_to_bf16(const float* x, const float* gain, bf16_t* o, int m0, int step, int nrows, int lane) {
    const f32x4* gr = (const f32x4*)gain + lane;
    for (int m = m0; m < nrows; m += 2 * step) {
        const int m2 = (m + step < nrows) ? m + step : m;
        const f32x4* xa = (const f32x4*)(x + (size_t)m * DM) + lane; const f32x4* xb2 = (const f32x4*)(x + (size_t)m2 * DM) + lane;
        f32x4 va[4], vb[4]; float sa = 0.f, sb = 0.f;
#pragma unroll
        for (int j = 0; j < 4; ++j) { va[j] = xa[64 * j]; vb[j] = xb2[64 * j]; }
#pragma unroll
        for (int j = 0; j < 4; ++j) { sa += (va[j][0] * va[j][0] + va[j][1] * va[j][1]) + (va[j][2] * va[j][2] + va[j][3] * va[j][3]); sb += (vb[j][0] * vb[j][0] + vb[j][1] * vb[j][1]) + (vb[j][2] * vb[j][2] + vb[j][3] * vb[j][3]); }
        const float ra = __builtin_amdgcn_rsqf(wave_sum(sa) * (1.f / 1024.f) + EPS), rb = __builtin_amdgcn_rsqf(wave_sum(sb) * (1.f / 1024.f) + EPS);
        u32x2* oa = (u32x2*)(o + (size_t)m * DM) + lane; u32x2* ob = (u32x2*)(o + (size_t)m2 * DM) + lane;
#pragma unroll
        for (int j = 0; j < 4; ++j) { const f32x4 g = gr[64 * j]; oa[64 * j] = pack4(va[j] * ra * g); if (m2 != m) ob[64 * j] = pack4(vb[j] * rb * g); }
    }
}
__device__ __forceinline__ void rot_table(const int* pos, float* rot, int gt, int ngt) {
    for (int idx = gt; idx < SEQ * 128; idx += ngt) {
        const int s = idx >> 7, i = idx & 127;
        const float inv = exp2f(-(float)i * (13.287712379549449f / 128.0f));
        const float ang = (float)pos[s] * inv;
        const float kq = rintf(ang * 0.6366197723675814f);
        float r = fmaf(-kq, 1.5703125f, ang); r = fmaf(-kq, 4.837512969970703125e-4f, r); r = fmaf(-kq, 7.54978995489188216e-8f, r);
        const float r2 = r * r;
        const float sn = r + r * r2 * (-1.6666667e-1f + r2 * (8.3333333e-3f + r2 * (-1.9841270e-4f + r2 * 2.7557319e-6f)));
        const float cn = 1.0f + r2 * (-0.5f + r2 * (4.1666668e-2f + r2 * (-1.3888889e-3f + r2 * (2.4801587e-5f + r2 * -2.7557319e-7f))));
        const int qd = ((int)kq) & 3;
        const float c = (qd == 0) ? cn : (qd == 1) ? -sn : (qd == 2) ? -cn : sn;
        const float sv = (qd == 0) ? sn : (qd == 1) ? cn : (qd == 2) ? -sn : -cn;
        *(f32x2*)(rot + (size_t)idx * 2) = (f32x2){c, sv};
    }
}

constexpr int SCN_LD = 136, SCN_V_OFF = 64 * SCN_LD * 2, SCN_CH = 192 * SCN_LD * 2;
constexpr unsigned SCAN_UNITS_PER_FLAG = 8;
__device__ __forceinline__ void scan_unit(int u, const bf16_t* kts, const bf16_t* vt, bf16_t* S, LAS unsigned char* lds, unsigned* done  ) {
    const int tid = opaque_tid(), lane = tid & 63, wave = __builtin_amdgcn_readfirstlane(tid >> 6);
    const int fr = lane & 15, fq = lane >> 4, h = u >> 4, dg = (u >> 2) & 3, eg = u & 3, wd = wave & 1, we = wave >> 1;
    const float gC = __builtin_amdgcn_exp2f(128.0f * log2f(1.0f - __builtin_amdgcn_exp2f(-5.0f - (float)h)));
    f32x4 acc[2][2];
#pragma unroll
    for (int a = 0; a < 2; ++a)
#pragma unroll
        for (int b = 0; b < 2; ++b) acc[a][b] = (f32x4){0.f, 0.f, 0.f, 0.f};
    const bf16_t* ksrc = kts + (size_t)(h * 256 + 64 * dg + (tid >> 4)) * SEQ + (tid & 15) * 8;
    const bf16_t* vsrc = vt + (size_t)(h * 512 + 128 * eg + (tid >> 4)) * SEQ + (tid & 15) * 8;
    u32x4 pk[2][2], pv[2][4];
#pragma unroll
    for (int i = 0; i < 2; ++i) {
#pragma unroll
        for (int j = 0; j < 2; ++j) pk[i][j] = *(const u32x4*)(ksrc + (size_t)(32 * j) * SEQ + i * 128);
#pragma unroll
        for (int j = 0; j < 4; ++j) pv[i][j] = *(const u32x4*)(vsrc + (size_t)(32 * j) * SEQ + i * 128);
    }
    bf16_t* sdst = S + ((size_t)(h * 16) * 512 + 128 * eg + 32 * we + fr) * 256 + 64 * dg + 32 * wd + 4 * fq;
#pragma unroll
    for (int r = 0; r < 8; ++r) {
        __syncthreads();
#pragma unroll
        for (int i = 0; i < 2; ++i) {
            if (2 * r + i < 15) {
                LAS bf16_t* lk = (LAS bf16_t*)(lds + i * SCN_CH); LAS bf16_t* lv = (LAS bf16_t*)(lds + i * SCN_CH + SCN_V_OFF);
#pragma unroll
                for (int j = 0; j < 2; ++j) *(LAS u32x4*)(lk + (32 * j + (tid >> 4)) * SCN_LD + (tid & 15) * 8) = pk[i][j];
#pragma unroll
                for (int j = 0; j < 4; ++j) *(LAS u32x4*)(lv + (32 * j + (tid >> 4)) * SCN_LD + (tid & 15) * 8) = pv[i][j];
            }
        }
        __syncthreads();
        if (r < 7) {
#pragma unroll
            for (int i = 0; i < 2; ++i) { const int c = 2 * (r + 1) + i;
                if (c < 15) {
#pragma unroll
                    for (int j = 0; j < 2; ++j) pk[i][j] = *(const u32x4*)(ksrc + (size_t)(32 * j) * SEQ + c * 128);
#pragma unroll
                    for (int j = 0; j < 4; ++j) pv[i][j] = *(const u32x4*)(vsrc + (size_t)(32 * j) * SEQ + c * 128);
                } }
        }
#pragma unroll
        for (int i = 0; i < 2; ++i) {
            const int c = 2 * r + i;
#pragma unroll
            for (int td = 0; td < 2; ++td)
#pragma unroll
                for (int te = 0; te < 2; ++te) { const u32x2 w = pack4(acc[td][te]);
                    __hip_atomic_store((unsigned long long*)(sdst + (size_t)c * 512 * 256 + (size_t)(16 * te) * 256 + 16 * td), ((unsigned long long)w.y << 32) | w.x, __ATOMIC_RELAXED, __HIP_MEMORY_SCOPE_AGENT); }
            if (c < 15) {
                const LAS bf16_t* lk = (const LAS bf16_t*)(lds + i * SCN_CH); const LAS bf16_t* lv = (const LAS bf16_t*)(lds + i * SCN_CH + SCN_V_OFF);
                f32x4 tm[2][2];
#pragma unroll
                for (int td = 0; td < 2; ++td)
#pragma unroll
                    for (int te = 0; te < 2; ++te) tm[td][te] = (f32x4){0.f, 0.f, 0.f, 0.f};
#pragma unroll
                for (int ks = 0; ks < 4; ++ks) {
                    bf16x8 a[2], b[2];
#pragma unroll
                    for (int t = 0; t < 2; ++t) { a[t] = *(const LAS bf16x8*)(lk + (32 * wd + 16 * t + fr) * SCN_LD + 32 * ks + 8 * fq); b[t] = *(const LAS bf16x8*)(lv + (32 * we + 16 * t + fr) * SCN_LD + 32 * ks + 8 * fq); }
#pragma unroll
                    for (int td = 0; td < 2; ++td)
#pragma unroll
                        for (int te = 0; te < 2; ++te) tm[td][te] = mfma16(a[td], b[te], tm[td][te]);
                }
#pragma unroll
                for (int td = 0; td < 2; ++td)
#pragma unroll
                    for (int te = 0; te < 2; ++te) acc[td][te] = acc[td][te] * gC + tm[td][te];
            }
        }
    }
    asm volatile("s_waitcnt vmcnt(0)" ::: "memory");
    __syncthreads();
    if (tid == 0) __hip_atomic_fetch_add(done + ((h * 2 + (eg >> 1)) * 64), 1u, __ATOMIC_RELAXED, __HIP_MEMORY_SCOPE_AGENT);
}
constexpr int RQ_LD = 264, SC_LD = 136, RO_SC_OFF = 128 * RQ_LD * 2, RO_PART_OFF = RO_SC_OFF + 128 * SC_LD * 2;
__device__ __forceinline__ void retout_unit(int h, int c, int eh, const bf16_t* q, const bf16_t* k, const bf16_t* vt, const bf16_t* S, bf16_t* ret  , float* rssq, LAS unsigned char* lds, unsigned* done, unsigned* tmo) {
    const int tid = opaque_tid(), lane = tid & 63, wave = __builtin_amdgcn_readfirstlane(tid >> 6);
    const int fr = lane & 15, fq = lane >> 4;
    LAS bf16_t* ql = (LAS bf16_t*)lds; LAS bf16_t* sc = (LAS bf16_t*)(lds + RO_SC_OFF); LAS float* part = (LAS float*)(lds + RO_PART_OFF);
    const float lg2 = log2f(1.0f - __builtin_amdgcn_exp2f(-5.0f - (float)h));
    const int tok0 = c * 128;
#pragma unroll
    for (int i = 0; i < 8; ++i) { const int p = tid + 512 * i, row = p >> 5, c16 = p & 31;
        *(LAS u32x4*)(ql + row * RQ_LD + c16 * 8) = *(const u32x4*)(q + (size_t)(tok0 + row) * 1024 + h * 256 + c16 * 8); }
    const bf16_t* sp = S + ((size_t)((h * 16 + c) * 512 + 256 * eh + 32 * wave + fr)) * 256 + 8 * fq;
    const bf16_t* vp = vt + (size_t)(h * 512 + 256 * eh + 32 * wave + fr) * SEQ + tok0 + 8 * fq;
    __syncthreads();
    {
        const int tj = wave;
        bf16x8 kf[8];
        const bf16_t* kp = k + (size_t)(tok0 + 16 * tj + fr) * 1024 + h * 256 + 8 * fq;
#pragma unroll
        for (int ks = 0; ks < 8; ++ks) kf[ks] = *(const bf16x8*)(kp + 32 * ks);
#pragma unroll
        for (int ti = 0; ti < 8; ++ti) {
            if (ti >= tj) {
                f32x4 s2 = (f32x4){0.f, 0.f, 0.f, 0.f};
#pragma unroll
                for (int ks = 0; ks < 8; ++ks) { const bf16x8 qf = *(const LAS bf16x8*)(ql + (16 * ti + fr) * RQ_LD + 32 * ks + 8 * fq); s2 = mfma16(kf[ks], qf, s2); }
                const int i = 16 * ti + fr; f32x4 v;
#pragma unroll
                for (int r = 0; r < 4; ++r) { const int j = 16 * tj + 4 * fq + r; v[r] = (i >= j) ? s2[r] * __builtin_amdgcn_exp2f(lg2 * (float)(i - j)) : 0.f; }
                *(LAS u32x2*)(sc + (16 * ti + fr) * SC_LD + 16 * tj + 4 * fq) = pack4(v);
            } else if (ti == tj - 1 && (tj & 1)) {
                *(LAS u32x2*)(sc + (16 * ti + fr) * SC_LD + 16 * tj + 4 * fq) = (u32x2){0u, 0u};
            }
        }
    }
    if (tid < 64) {
        unsigned* f = done + ((h * 2 + eh) * 64); unsigned sp = 0;
        while ((unsigned)__builtin_amdgcn_readfirstlane(__hip_atomic_load(f, __ATOMIC_RELAXED, __HIP_MEMORY_SCOPE_AGENT)) < SCAN_UNITS_PER_FLAG) {
            __builtin_amdgcn_s_sleep(2);
            if (++sp > (1u << 20)) { if (tid == 0) __hip_atomic_store(tmo, 1u, __ATOMIC_RELAXED, __HIP_MEMORY_SCOPE_AGENT); break; }
        }
        __builtin_amdgcn_fence(__ATOMIC_ACQUIRE, "agent");
        asm volatile("s_waitcnt vmcnt(0)" ::: "memory");
    }
    __syncthreads();
    f32x4 acc[8][2];
#pragma unroll
    for (int a = 0; a < 8; ++a)
#pragma unroll
        for (int b = 0; b < 2; ++b) acc[a][b] = (f32x4){0.f, 0.f, 0.f, 0.f};
#pragma unroll
    for (int ks = 0; ks < 8; ++ks) {
        bf16x8 sf[2], qf[8];
#pragma unroll
        for (int t = 0; t < 2; ++t) sf[t] = *(const bf16x8*)(sp + (size_t)(16 * t) * 256 + 32 * ks);
#pragma unroll
        for (int t = 0; t < 8; ++t) qf[t] = *(const LAS bf16x8*)(ql + (16 * t + fr) * RQ_LD + 32 * ks + 8 * fq);
#pragma unroll
        for (int a = 0; a < 8; ++a)
#pragma unroll
            for (int b = 0; b < 2; ++b) acc[a][b] = mfma16(sf[b], qf[a], acc[a][b]);
    }
#pragma unroll
    for (int a = 0; a < 8; ++a) { const float qd = __builtin_amdgcn_exp2f(lg2 * (float)(16 * a + fr + 1));
#pragma unroll
        for (int b = 0; b < 2; ++b) acc[a][b] = acc[a][b] * qd; }
#pragma unroll
    for (int ks = 0; ks < 4; ++ks) {
        bf16x8 vf[2];
#pragma unroll
        for (int t = 0; t < 2; ++t) vf[t] = *(const bf16x8*)(vp + (size_t)(16 * t) * SEQ + 32 * ks);
#pragma unroll
        for (int a = 0; a < 8; ++a) {
            if (a >= 2 * ks) {
                const bf16x8 pf = *(const LAS bf16x8*)(sc + (16 * a + fr) * SC_LD + 32 * ks + 8 * fq);
#pragma unroll
                for (int b = 0; b < 2; ++b) acc[a][b] = mfma16(vf[b], pf, acc[a][b]);
            }
        }
    }
#pragma unroll
    for (int a = 0; a < 8; ++a) {
        float ss = 0.f;
#pragma unroll
        for (int b = 0; b < 2; ++b) { const f32x4 t = acc[a][b]; ss += (t[0] * t[0] + t[1] * t[1]) + (t[2] * t[2] + t[3] * t[3]); }
        ss += __shfl_xor(ss, 16); ss += __shfl_xor(ss, 32);
        if (fq == 0) part[wave * 128 + 16 * a + fr] = ss;
    }
    __syncthreads();
    if (tid < 128) {
        float tot = 0.f;
#pragma unroll
        for (int w = 0; w < 8; ++w) tot += part[w * 128 + tid];
        rssq[(size_t)(tok0 + tid) * 8 + 2 * h + eh] = tot;
    }
#pragma unroll
    for (int a = 0; a < 8; ++a)
#pragma unroll
        for (int b = 0; b < 2; ++b)
            *(u32x2*)(ret + (size_t)(tok0 + 16 * a + fr) * 2048 + h * 512 + 256 * eh + 32 * wave + 16 * b + 4 * fq) = pack4(acc[a][b]);
    __syncthreads();
}
constexpr int PL_LD = 264, MA_KV_BYTES = 64 * 264 * 2, MA_P_OFF = MA_KV_BYTES;
__device__ __forceinline__ void memattn_unit(int b, int h, int rb, const bf16_t* mkn, const bf16_t* mvt, bf16_t* mo  , LAS unsigned char* lds) {
    const bf16_t* mq = mo;
    const int tid = opaque_tid(), lane = tid & 63, wave = __builtin_amdgcn_readfirstlane(tid >> 6);
    const int fr = lane & 15, fq = lane >> 4;
    LAS bf16_t* kv = (LAS bf16_t*)lds; LAS bf16_t* pl = (LAS bf16_t*)(lds + MA_P_OFF) + wave * (16 * PL_LD);
    const int row = 128 * rb + 16 * wave + fr;
    const bf16_t* ksrc = mkn + (size_t)(b * 256) * 1024 + h * 256;
    const bf16_t* vsrc = mvt + (size_t)((b * 4 + h) * 256) * 256;
    u32x4 pre[4];
#pragma unroll
    for (int i = 0; i < 4; ++i) { const int p = tid + 512 * i; pre[i] = *(const u32x4*)(ksrc + (size_t)(p >> 5) * 1024 + (p & 31) * 8); }
    bf16x8 qf[8]; float qs = 0.f;
#pragma unroll
    for (int ks = 0; ks < 8; ++ks) { qf[ks] = *(const bf16x8*)(mq + (size_t)row * 1024 + h * 256 + 32 * ks + 8 * fq);
#pragma unroll
        for (int j = 0; j < 8; ++j) { const float f = bf2f((unsigned short)qf[ks][j]); qs += f * f; } }
    qs += __shfl_xor(qs, 16); qs += __shfl_xor(qs, 32);
    const float scl = __builtin_amdgcn_rsqf(qs * (1.0f / 256.0f) + EPS) * (0.0625f * LOG2E);
    f32x4 sa[16];
#pragma unroll
    for (int kc = 0; kc < 4; ++kc) {
        __syncthreads();
#pragma unroll
        for (int i = 0; i < 4; ++i) { const int p = tid + 512 * i; *(LAS u32x4*)(kv + (p >> 5) * PL_LD + (p & 31) * 8) = pre[i]; }
        __syncthreads();
#pragma unroll
        for (int i = 0; i < 4; ++i) { const int p = tid + 512 * i;
            pre[i] = (kc < 3) ? *(const u32x4*)(ksrc + (size_t)(64 * (kc + 1) + (p >> 5)) * 1024 + (p & 31) * 8) : *(const u32x4*)(vsrc + (size_t)(p >> 5) * 256 + (p & 31) * 8); }
#pragma unroll
        for (int tl = 0; tl < 4; ++tl) {
            f32x4 a = (f32x4){0.f, 0.f, 0.f, 0.f};
#pragma unroll
            for (int ks = 0; ks < 8; ++ks) { const bf16x8 kf = *(const LAS bf16x8*)(kv + (16 * tl + fr) * PL_LD + 32 * ks + 8 * fq); a = mfma16(kf, qf[ks], a); }
            sa[4 * kc + tl] = a * scl;
        }
    }
    float mx = -INFINITY;
#pragma unroll
    for (int t = 0; t < 16; ++t) mx = fmaxf(mx, fmaxf(fmaxf(sa[t][0], sa[t][1]), fmaxf(sa[t][2], sa[t][3])));
    mx = fmaxf(mx, __shfl_xor(mx, 16)); mx = fmaxf(mx, __shfl_xor(mx, 32));
    float l = 0.f;
#pragma unroll
    for (int t = 0; t < 16; ++t) {
        f32x4 p;
#pragma unroll
        for (int r = 0; r < 4; ++r) { p[r] = __builtin_amdgcn_exp2f(sa[t][r] - mx); l += p[r]; }
        *(LAS u32x2*)(pl + fr * PL_LD + 16 * t + 4 * fq) = pack4(p);
    }
    l += __shfl_xor(l, 16); l += __shfl_xor(l, 32);
    const float rl = __builtin_amdgcn_rcpf(l);
    LDS_WAIT(); asm volatile("" ::: "memory");
    bf16x8 pf[8];
#pragma unroll
    for (int ks = 0; ks < 8; ++ks) pf[ks] = *(const LAS bf16x8*)(pl + fr * PL_LD + 32 * ks + 8 * fq);
#pragma unroll
    for (int dc = 0; dc < 4; ++dc) {
        __syncthreads();
#pragma unroll
        for (int i = 0; i < 4; ++i) { const int p = tid + 512 * i; *(LAS u32x4*)(kv + (p >> 5) * PL_LD + (p & 31) * 8) = pre[i]; }
        __syncthreads();
        if (dc < 3) {
#pragma unroll
            for (int i = 0; i < 4; ++i) { const int p = tid + 512 * i; pre[i] = *(const u32x4*)(vsrc + (size_t)(64 * (dc + 1) + (p >> 5)) * 256 + (p & 31) * 8); }
        }
#pragma unroll
        for (int tl = 0; tl < 4; ++tl) {
            f32x4 a = (f32x4){0.f, 0.f, 0.f, 0.f};
#pragma unroll
            for (int ks = 0; ks < 8; ++ks) { const bf16x8 vf = *(const LAS bf16x8*)(kv + (16 * tl + fr) * PL_LD + 32 * ks + 8 * fq); a = mfma16(vf, pf[ks], a); }
            *(u32x2*)(mo + (size_t)row * 1024 + h * 256 + 64 * dc + 16 * tl + 4 * fq) = pack4(a * rl);
        }
    }
    __syncthreads();
}
__device__ __forceinline__ void dif_row(const bf16_t* o0, const bf16_t* o1, bf16_t* dif, const float* gout, float lam, int lane) {
    const u32x4* a = (const u32x4*)o0 + 2 * lane; const u32x4* b = (const u32x4*)o1 + 2 * lane;
    float d[16]; float ss = 0.f;
#pragma unroll
    for (int v = 0; v < 2; ++v) { const u32x4 x = a[v], y = b[v];
#pragma unroll
        for (int w = 0; w < 4; ++w) { const float x0 = __uint_as_float(x[w] << 16), x1 = __uint_as_float(x[w] & 0xffff0000u), y0 = __uint_as_float(y[w] << 16), y1 = __uint_as_float(y[w] & 0xffff0000u);
            const float d0 = x0 - lam * y0, d1 = x1 - lam * y1; d[v * 8 + w * 2] = d0; d[v * 8 + w * 2 + 1] = d1; ss += d0 * d0 + d1 * d1; } }
    ss += __shfl_xor(ss, 1); ss += __shfl_xor(ss, 2); ss += __shfl_xor(ss, 4);
    const float rn = __builtin_amdgcn_rsqf(ss * (1.0f / 128.0f) + EPS) * (1.0f - LAM_INIT);
    const float* gp = gout + (lane & 7) * 16;
    u32x4 o[2];
#pragma unroll
    for (int v = 0; v < 2; ++v)
#pragma unroll
        for (int w = 0; w < 4; ++w) o[v][w] = cvt_pk_bf16(d[v * 8 + w * 2] * rn * gp[v * 8 + w * 2], d[v * 8 + w * 2 + 1] * rn * gp[v * 8 + w * 2 + 1]);
    u32x4* op = (u32x4*)dif + 2 * lane; op[0] = o[0]; op[1] = o[1];
}

struct P4bOrder {
    pg8::StaticOrder T; unsigned char* ws;
    __device__ __forceinline__ bool next(int i, pg8::Unit& u) const {
        int pm, pn; if (!T.tile(i, pm, pn)) return false;
        u.pm = pm; u.pn = pn; u.ui = i; u.ri = i; u.tag = 0; u.K = 1024;
        u.A = (const char*)ws + WS_XB + (size_t)pm * 256 * 1024 * 2;
        u.Bt = (const char*)ws + (pn < 8 ? WS_WRG + (size_t)pn * 256 * 1024 * 2 : WS_WGATE + (size_t)(pn - 8) * 256 * 1024 * 2); return true;
    }
};
struct P5Order {
    pg8::StaticOrder T; unsigned char* ws;
    __device__ __forceinline__ bool next(int i, pg8::Unit& u) const {
        const int ti = i / 3, kbr = i - 3 * ti; int pm, pn; if (!T.tile(ti, pm, pn)) return false;
        const size_t offA = kbr == 0 ? WS_RET : kbr == 1 ? WS_DIF : WS_MO;
        const size_t offB = kbr == 0 ? WS_WBRR : kbr == 1 ? WS_WBRD : WS_WBRM;
        const int K = kbr == 0 ? 2048 : 1024;
        u.pm = pm; u.pn = pn; u.ui = i; u.ri = ti; u.tag = kbr; u.K = K;
        u.A = (const char*)ws + offA + (size_t)pm * 256 * K * 2; u.Bt = (const char*)ws + offB + (size_t)pn * 256 * K * 2; return true;
    }
};
#ifndef PH_MASK
#define PH_MASK 0xffffffffu
#endif
#define PH(n) ((PH_MASK >> (n)) & 1u)
#ifndef DUP_MASK
#define DUP_MASK 0u
#endif
#ifndef PROBE_K
#define PROBE_K (-1)
#endif
#define RUNP(k) (pass_ == 1 || (k) <= PROBE_K)
#define REP(n) _Pragma("unroll 1") for (int rep_ = 0; rep_ < 1 + (int)((DUP_MASK >> (n)) & 1u); ++rep_)
struct Args { const void* in[26]; float* out; unsigned char* ws; };
#define CAS __attribute__((address_space(4)))
__device__ __forceinline__ const void* karg(int i) { typedef const GAS void* gptr; const CAS gptr* p = (const CAS gptr*)__builtin_amdgcn_kernarg_segment_ptr(); asm volatile("" : "+s"(p)); return (const void*)p[i]; }
#define INP(i) ((const float*)karg(i))
#define WSP(T, off) ((T*)((unsigned char*)karg(27) + (off)))
#define OUTP ((float*)karg(26))
__global__ void __launch_bounds__(NWAVES * 64, 2) mk_fwd(Args args) {
    extern __shared__ __attribute__((aligned(16))) unsigned char lds_raw[];
    LAS unsigned char* lds = (LAS unsigned char*)lds_raw;
    volatile LAS unsigned* MISC = (volatile LAS unsigned*)(lds + MISC_OFF);
    const int G = gridDim.x, bx = blockIdx.x;
    for (int u = threadIdx.x; u < (LDS_BYTES - LDSCTL_OFF) / 4; u += NWAVES * 64) ((LAS unsigned*)(lds + LDSCTL_OFF))[u] = 0u;
    __syncthreads();
    (void)xcd_barrier_post((unsigned*)WSP(unsigned, WS_CTL) + CW_BAR, MISC + 8);
#define GRID_BAR() do { XcdBarrier b_; b_.bar = (unsigned*)WSP(unsigned, WS_CTL) + CW_BAR; b_.x = xb_xcc_id(); b_.st = (volatile LAS unsigned*)(lds + MISC_OFF) + 8; xcd_barrier(b_); } while (0)
    const int NGW = G * NWAVES, NGT = G * NWAVES * 64;
#define LANE_VARS() const int tid = opaque_tid(), lane = tid & 63, wave = __builtin_amdgcn_readfirstlane(tid >> 6); LAS float* scr = (LAS float*)(lds + wave * 16384); \
    const int gw = bx * NWAVES + wave, gt = bx * (NWAVES * 64) + tid; (void)scr; (void)gw; (void)gt; (void)lane

#pragma unroll 1
    for (int pass_ = (PROBE_K >= 0 ? 0 : 1); pass_ < 2; ++pass_) {
    if (RUNP(0)) {
    REP(0) if (PH(0)) {
        LANE_VARS();
        transpose_all<true>(INP(4), 1024, 2 * DFF, WSP(bf16_t, WS_WF1I), 2 * DFF, ColSwiglu{}, nullptr, scr, gw, NGW, lane);
        transpose_all(INP(18), 1024, 2048, WSP(bf16_t, WS_WMKV), 2048, ColIdent{0}, nullptr, scr, gw, NGW, lane);
        { const float* x = INP(0); const float* g1 = INP(3); bf16_t* xb = WSP(bf16_t, WS_XBL);
          rms_rows_to_bf16(x, g1, xb, gw, NGW, TOK, lane); }
        { const float* mem = INP(1); const float* gm = INP(17); bf16_t* memn = WSP(bf16_t, WS_MEMN);
          rms_rows_to_bf16(mem, gm, memn, gw, NGW, NB * MEML, lane); }
        rot_table((const int*)karg(2), WSP(float, WS_ROT), gt, NGT);
    }
    GRID_BAR();
    }

    if (RUNP(1)) {
    REP(1) if (PH(1)) {
        pg8::Gemm g{WSP(bf16_t, WS_XBL), WSP(bf16_t, WS_WF1I), TOK, 2 * DFF, 1024}; pg8::StaticOrder S; S.init(TOK, 2 * DFF, G, bx);
        EpiSwiglu E{WSP(bf16_t, WS_ACT), nullptr};
        S.set(g); pg8::gemm_phase(lds, S, E);
    }
    if (PH(2)) {
        pg8::Gemm g{WSP(bf16_t, WS_MEMN), WSP(bf16_t, WS_WMKV), NB * MEML, 2048, 1024}; pg8::StaticOrder S; S.init(NB * MEML, 2048, G, (bx + G / 2) % G);
        EpiPlain E{WSP(bf16_t, WS_MKVRAW), 2048};
        S.set(g); pg8::gemm_phase(lds, S, E);
    }
    if (PH(0)) {
        const int q0 = (3 * G) / 4, nq = G - q0;
        if (bx >= q0) {
            LANE_VARS();
            const int gw2 = (bx - q0) * NWAVES + wave, ngw2 = nq * NWAVES;
            transpose_all(INP(5), DFF, 1024, WSP(bf16_t, WS_WF1O), 1024, ColIdent{0}, nullptr, scr, gw2, ngw2, lane);
            transpose_all<true>(INP(7), 1024, 13312, WSP(bf16_t, WS_WMIX), NMIX, ColMix{}, INP(6), scr, gw2, ngw2, lane);
        }
    }
    GRID_BAR();
    }

    if (RUNP(2)) {
    REP(3) if (PH(3)) {
        pg8::Gemm g{WSP(bf16_t, WS_ACT), WSP(bf16_t, WS_WF1O), TOK, 1024, DFF}; pg8::StaticOrder S; S.init(TOK, 1024, G, bx);
        EpiResid E{INP(0), OUTP, WSP(bf16_t, WS_XBL), WSP(float, WS_SSQ1), 0.5f, (rep_ == 1 && ((DUP_MASK >> 23) & 1u)) ? 1 : 0};
        S.set(g); pg8::gemm_phase(lds, S, E);
    }
    if (PH(0)) {
        LANE_VARS();
        const bf16_t* mkvraw = WSP(bf16_t, WS_MKVRAW); bf16_t* mkn = WSP(bf16_t, WS_MKN); bf16_t* mvt = WSP(bf16_t, WS_MVT);
        const float* g_mem_k = INP(16); const float* g_mem_q = INP(15);
        for (int j = gw; j < NB * MEML * 4; j += NGW) {
            const int row = j >> 2, h = j & 3;
            const u32x2 w = *((const u32x2*)(mkvraw + (size_t)row * 2048 + h * 256) + lane);
            f32x4 v = (f32x4){__uint_as_float(w.x << 16), __uint_as_float(w.x & 0xffff0000u), __uint_as_float(w.y << 16), __uint_as_float(w.y & 0xffff0000u)};
            const float ss = wave_sum((v[0] * v[0] + v[1] * v[1]) + (v[2] * v[2] + v[3] * v[3]));
            const float rn = __builtin_amdgcn_rsqf(ss * (1.0f / 256.0f) + EPS);
            const f32x4 gk = *((const f32x4*)g_mem_k + lane), gq = *((const f32x4*)g_mem_q + lane);
            *((u32x2*)(mkn + (size_t)row * 1024 + h * 256) + lane) = pack4(v * rn * gk * gq);
        }
        for (int idx = gt; idx < NB * 4 * 256 * 256; idx += NGT) {
            const int key = idx & 255, d = (idx >> 8) & 255, bh = idx >> 16, b = bh >> 2, h = bh & 3;
            mvt[idx] = mkvraw[(size_t)(b * 256 + key) * 2048 + 1024 + h * 256 + d];
        }
    }
    GRID_BAR();
    }

    if (RUNP(3))
    for (int ph = 0; ph <= NB; ++ph) {
        const int gp = ph, gm = ph - 1;
        unsigned char* const wsP = WSP(unsigned char, 0) - (((gp + 1) & 1) ? SET_DELTA : 0);
        unsigned char* const wsB = WSP(unsigned char, 0) - (((gm + 1) & 1) ? SET_DELTA : 0);
        unsigned* done = (unsigned*)WSP(unsigned, WS_CTL) + CW_SCAN + ((pass_ * NB + (gm < 0 ? 0 : gm)) * 8) * 64; unsigned* tmo = (unsigned*)WSP(unsigned, WS_CTL) + CW_BAR + XB_TMO;
        if (gm >= 0)
            for (int u = bx; u < 64; u += G) { __syncthreads(); if (PH(5)) scan_unit(u, (const bf16_t*)(wsB + WS_KTS), (const bf16_t*)(wsB + WS_VT), WSP(bf16_t, WS_S), lds, done); }
        if (gp < NB) {
            REP(4) if (PH(4)) {
                pg8::Gemm g{WSP(bf16_t, WS_XBL) + (size_t)gp * SEQ * DM, WSP(bf16_t, WS_WMIX), SEQ, NMIX, 1024}; pg8::StaticOrder S; S.init(SEQ, NMIX, G, bx);
                prep_rs(WSP(float, WS_SSQ1), gp * SEQ, S, lds);
                EpiMix E{(const LAS float*)(lds + RTAB_OFF), WSP(float, (gp & 1) ? WS_ROTB : WS_ROT), wsP, WSP(bf16_t, WS_MO) + (size_t)gp * SEQ * 1024, INP(8), INP(9)};
                S.set(g); pg8::gemm_phase(lds, S, E);
            }
        }
        if (gm >= 0) {
            const size_t oOff = (gm & 1) ? WS_OB : 0;
            unsigned* qctr = (unsigned*)WSP(unsigned, WS_CTL) + CW_QUEUE + (pass_ * NB + gm) * 64;
            volatile LAS unsigned* qslot = (volatile LAS unsigned*)(lds + MISC_OFF) + 16;
            for (;;) {
                __syncthreads();
                if (threadIdx.x == 0) qslot[0] = __hip_atomic_fetch_add(qctr, 1u, __ATOMIC_RELAXED, __HIP_MEMORY_SCOPE_AGENT);
                __syncthreads();
                const int id = __builtin_amdgcn_readfirstlane((int)qslot[0]);
                if (id >= 448) break;
                int aq = -1, aj = 0;
                if (id < 64) { aq = 7 - (id >> 5); aj = id & 31; }
                else if (id < 192) { const int ro = id - 64;
                    if (PH(8)) retout_unit(ro >> 5, (ro >> 1) & 15, ro & 1, (const bf16_t*)(wsB + WS_Q), (const bf16_t*)(wsB + WS_K), (const bf16_t*)(wsB + WS_VT), WSP(bf16_t, WS_S),
                                           WSP(bf16_t, WS_RET) + (size_t)gm * SEQ * 2048, WSP(float, WS_SSQ2) + (size_t)gm * SEQ * 8, lds, done, tmo); }
                else if (id < 224) { aq = 5; aj = id - 192; }
                else if (id < 288) { const int m = id - 224;
                    if (PH(7)) memattn_unit(gm, m >> 4, m & 15, WSP(bf16_t, WS_MKN), WSP(bf16_t, WS_MVT), WSP(bf16_t, WS_MO) + (size_t)gm * SEQ * 1024, lds); }
                else { aq = 4 - ((id - 288) >> 5); aj = (id - 288) & 31; }
                if (aq >= 0) {
                    const int hc = aj >> 1, vh = aj & 1, hh = hc >> 1, cc = hc & 1;
                    if (PH(6)) attn_body::attn_unit<8>(hc, 2 * hh + vh, aq, (const attn_body::bf16*)(wsB + WS_DQ), (const attn_body::bf16*)(wsB + WS_DK), (const attn_body::bf16*)(wsB + WS_DV),
                                            WSP(attn_body::bf16, (cc ? WS_O1 : WS_O0) + oOff), (char*)lds_raw);
                }
            }
        }
        {
            LANE_VARS();
            if (ph >= 2) {
                const int gd = ph - 2; const size_t oD = (gd & 1) ? WS_OB : 0;
                const float s1 = wave_sum(INP(10)[lane] * INP(11)[lane]), s2 = wave_sum(INP(12)[lane] * INP(13)[lane]); const float lam = __expf(s1) - __expf(s2) + LAM_INIT;
                const bf16_t* bo0 = WSP(bf16_t, WS_O0 + oD); const bf16_t* bo1 = WSP(bf16_t, WS_O1 + oD); bf16_t* difb = WSP(bf16_t, WS_DIF); const float* gdo = INP(14);
                for (int r = gw; r < SEQ; r += NGW) dif_row(bo0 + (size_t)r * 1024, bo1 + (size_t)r * 1024, difb + ((size_t)gd * SEQ + r) * 1024, gdo, lam, lane);
            }
            if (ph + 1 < NB) rot_table((const int*)karg(2) + (ph + 1) * SEQ, WSP(float, ((ph + 1) & 1) ? WS_ROTB : WS_ROT), gt, NGT);
            if (ph == 0) transpose_all<true>(INP(7), 1024, 13312, WSP(bf16_t, WS_WRG), 2048, ColIdent{4096}, INP(6), scr, gw, NGW, lane);
            if (ph == NB) {
                transpose_all<true>(INP(7), 1024, 13312, WSP(bf16_t, WS_WGATE), 3072, ColIdent{10240}, INP(6), scr, gw, NGW, lane);
                const float* x1 = OUTP; bf16_t* xb = WSP(bf16_t, WS_XB);
                for (int r = gw; r < TOK; r += NGW) {
                    const f32x4* xr = (const f32x4*)(x1 + (size_t)r * DM) + lane; u32x2* o8 = (u32x2*)(xb + (size_t)r * DM) + lane; f32x4 v[4];
#pragma unroll
                    for (int jj = 0; jj < 4; ++jj) v[jj] = xr[64 * jj];
#pragma unroll
                    for (int jj = 0; jj < 4; ++jj) o8[64 * jj] = pack4(v[jj]);
                }
            }
        }
        GRID_BAR();
    }

    if (RUNP(4)) {
    if (PH(9)) {
        pg8::StaticOrder T; T.init(TOK, 5120, G, bx);
        prep_rs(WSP(float, WS_SSQ1), 0, T, lds);
        P4bOrder S{T, WSP(unsigned char, 0)};
        EpiRgG E{(const LAS float*)(lds + RTAB_OFF), WSP(bf16_t, WS_RET), WSP(float, WS_SSQ2), WSP(unsigned char, 0)};
        pg8::gemm_phase(lds, S, E);
    }
    if (PH(0)) {
        LANE_VARS();
        { const float s1 = wave_sum(INP(10)[lane] * INP(11)[lane]), s2 = wave_sum(INP(12)[lane] * INP(13)[lane]); const float lam = __expf(s1) - __expf(s2) + LAM_INIT;
          const bf16_t* bo0 = WSP(bf16_t, WS_O0 + (((NB - 1) & 1) ? WS_OB : 0)); const bf16_t* bo1 = WSP(bf16_t, WS_O1 + (((NB - 1) & 1) ? WS_OB : 0)); bf16_t* difb = WSP(bf16_t, WS_DIF); const float* gdo = INP(14);
          for (int r = gw; r < SEQ; r += NGW) dif_row(bo0 + (size_t)r * 1024, bo1 + (size_t)r * 1024, difb + ((size_t)(NB - 1) * SEQ + r) * 1024, gdo, lam, lane); }
        transpose_all<true>(INP(19), 2048, 1024, WSP(bf16_t, WS_WBRR), 1024, ColIdent{0}, nullptr, scr, gw, NGW, lane);
        transpose_all<true>(INP(20), 1024, 1024, WSP(bf16_t, WS_WBRD), 1024, ColIdent{0}, nullptr, scr, gw, NGW, lane);
        transpose_all<true>(INP(21), 1024, 1024, WSP(bf16_t, WS_WBRM), 1024, ColIdent{0}, nullptr, scr, gw, NGW, lane);
        transpose_all(INP(22), 1024, 1024, WSP(bf16_t, WS_WO), 1024, ColIdent{0}, nullptr, scr, gw, NGW, lane);
    }
    GRID_BAR();
    }

    if (RUNP(5)) {
    REP(10) if (PH(10)) {
        pg8::StaticOrder T; T.init(TOK, 1024, G, bx);
        P5Order S{T, WSP(unsigned char, 0)};
        EpiTerm3 E{WSP(unsigned char, 0), WSP(bf16_t, WS_Y)};
        pg8::gemm_phase(lds, S, E);
    }
    GRID_BAR();
    }

    if (RUNP(6)) {
    if (PH(11)) {
        pg8::Gemm g{WSP(bf16_t, WS_Y), WSP(bf16_t, WS_WO), TOK, 1024, 1024}; pg8::StaticOrder S; S.init(TOK, 1024, G, bx);
        EpiResid E{OUTP, OUTP, WSP(bf16_t, WS_X2B), WSP(float, WS_SSQ2), 1.0f, 0};
        S.set(g); pg8::gemm_phase(lds, S, E);
    }
    if (PH(0)) {
        LANE_VARS();
        transpose_all<true>(INP(24), 1024, 2 * DFF, WSP(bf16_t, WS_WF2I), 2 * DFF, ColSwiglu{}, INP(23), scr, gw, NGW, lane);
        transpose_all(INP(25), DFF, 1024, WSP(bf16_t, WS_WF2O), 1024, ColIdent{0}, nullptr, scr, gw, NGW, lane);
    }
    GRID_BAR();
    }

    if (RUNP(7)) {
    if (PH(12)) {
        pg8::Gemm g{WSP(bf16_t, WS_X2B), WSP(bf16_t, WS_WF2I), TOK, 2 * DFF, 1024}; pg8::StaticOrder S; S.init(TOK, 2 * DFF, G, bx);
        prep_rs(WSP(float, WS_SSQ2), 0, S, lds);
        EpiSwiglu E{WSP(bf16_t, WS_ACT2), (const LAS float*)(lds + RTAB_OFF)};
        S.set(g); pg8::gemm_phase(lds, S, E);
    }
    GRID_BAR();
    }

    if (RUNP(8))
    if (PH(13)) {
        pg8::Gemm g{WSP(bf16_t, WS_ACT2), WSP(bf16_t, WS_WF2O), TOK, 1024, DFF}; pg8::StaticOrder S; S.init(TOK, 1024, G, bx);
        EpiResid E{OUTP, OUTP, nullptr, nullptr, 0.5f, 0};
        S.set(g); pg8::gemm_phase(lds, S, E);
    }
    if (pass_ == 0) GRID_BAR();
    }
}

extern "C" void kernel_launch(void* const* d_in, const int* in_sizes, int n_in, void* d_out, int out_size, void* d_ws, size_t ws_size, hipStream_t stream) {
    static int grid = 0;
    if (grid == 0) {
        if (n_in != 26 || ws_size < WS_END) { fprintf(stderr, "kernel_launch: unexpected inputs (n_in %d, ws %zu)\n", n_in, ws_size); grid = -1; return; }
        int dev = 0, cus = 0;
        if (hipGetDevice(&dev) != hipSuccess || hipDeviceGetAttribute(&cus, hipDeviceAttributeMultiprocessorCount, dev) != hipSuccess) { grid = -1; return; }
        if (hipFuncSetAttribute((const void*)mk_fwd, hipFuncAttributeMaxDynamicSharedMemorySize, LDS_BYTES) != hipSuccess) { fprintf(stderr, "kernel_launch: hipFuncSetAttribute failed\n"); grid = -1; return; }
        grid = cus;
    }
    if (grid < 0) return;
    (void)hipMemsetAsync((char*)d_ws + WS_CTL, 0, CTL_ZERO_BYTES, stream);
    Args a{};
    for (int i = 0; i < 26; ++i) a.in[i] = d_in[i];
    a.out = (float*)d_out; a.ws = (unsigned char*)d_ws;
    hipLaunchKernelGGL(mk_fwd, dim3(grid), dim3(NWAVES * 64), LDS_BYTES, stream, a);
}
```

```cpp
#include <hip/hip_runtime.h>
#include <cstdio>
#include <cstdint>

#define LAS __attribute__((address_space(3)))
#define GAS __attribute__((address_space(1)))
typedef unsigned short bf16_t;
typedef short bf16x8 __attribute__((ext_vector_type(8)));
typedef float f32x4 __attribute__((ext_vector_type(4)));
typedef float f32x2 __attribute__((ext_vector_type(2)));
typedef unsigned u32x4 __attribute__((ext_vector_type(4)));
typedef unsigned u32x2 __attribute__((ext_vector_type(2)));

constexpr int NB = 8, SEQ = 2048, DM = 1024, TOK = NB * SEQ, MEML = 256, DFF = 2816;
constexpr int NMIX = 8192;
constexpr float EPS = 1e-6f;
constexpr float LOG2E = 1.4426950408889634f;
constexpr float C2Q = 0.125f * LOG2E;
constexpr float LAM_INIT = 0.2f;

constexpr size_t MiB = 1u << 20;
constexpr size_t KiB = 1u << 10;
constexpr size_t WS_CTL = 0, CTL_ZERO_BYTES = 256 * KiB;
constexpr size_t WS_SSQ1 = 256 * KiB, WS_SSQ2 = 512 * KiB;
constexpr size_t WS_ROT = 1 * MiB, WS_ROTB = 153 * MiB;
constexpr size_t WS_MKN = 3 * MiB, WS_MVT = 7 * MiB;
constexpr size_t WS_WMIX = 11 * MiB;
constexpr size_t WS_XB = 27 * MiB;
constexpr size_t WS_RET = 59 * MiB;
constexpr size_t WS_XBL = 91 * MiB;
constexpr size_t WS_DIF = 123 * MiB;
constexpr size_t WS_MO = 155 * MiB;
constexpr size_t WS_Q = 187 * MiB, WS_K = 191 * MiB, WS_KTS = 195 * MiB, WS_VT = 199 * MiB, WS_DQ = 207 * MiB, WS_DK = 211 * MiB,
                 WS_DV = 215 * MiB;
constexpr size_t SET_DELTA = 160 * MiB;
constexpr size_t WS_WRG = 219 * MiB;
constexpr size_t WS_O0 = 223 * MiB, WS_O1 = 227 * MiB, WS_S = 231 * MiB;
constexpr size_t WS_OB = 24 * MiB;
constexpr size_t WS_WF1I = 59 * MiB, WS_WF1O = 70 * MiB;
constexpr size_t WS_MEMN = 76 * MiB, WS_MKVRAW = 80 * MiB, WS_WMKV = 27 * MiB;
constexpr size_t WS_ACT = 155 * MiB;
constexpr size_t WS_WGATE = 11 * MiB, WS_WBRR = 17 * MiB, WS_WBRD = 21 * MiB, WS_WBRM = 23 * MiB, WS_WO = 25 * MiB;
constexpr size_t WS_G8A = 187 * MiB, WS_G8B = 203 * MiB, WS_G8C = 223 * MiB;
constexpr size_t WS_Y = 27 * MiB;
constexpr size_t WS_X2B = 187 * MiB;
constexpr size_t WS_WF2I = 59 * MiB, WS_WF2O = 70 * MiB, WS_ACT2 = 76 * MiB;
constexpr size_t WS_END = 256 * MiB;

constexpr int CW_BAR = 4096;
constexpr int CW_QUEUE = 32768;
constexpr int CW_SCAN = 16384;

constexpr int RING_BYTES = 131072, LDSCTL_OFF = RING_BYTES, MISC_OFF = LDSCTL_OFF + 320, LDS_BYTES = 147456;
constexpr int NWAVES = 8;

__device__ __forceinline__ unsigned cvt_pk_bf16(float lo, float hi) { unsigned r; asm volatile("v_cvt_pk_bf16_f32 %0, %1, %2" : "=v"(r) : "v"(lo), "v"(hi)); return r; }
__device__ __forceinline__ u32x2 pack4(f32x4 v) { u32x2 w; w.x = cvt_pk_bf16(v[0], v[1]); w.y = cvt_pk_bf16(v[2], v[3]); return w; }
__device__ __forceinline__ unsigned short bf16_1(float v) { return (unsigned short)(cvt_pk_bf16(v, 0.f) & 0xffffu); }
__device__ __forceinline__ float bf2f(unsigned short b) { return __uint_as_float(((unsigned)b) << 16); }
__device__ __forceinline__ float siluf(float x) { return x * __builtin_amdgcn_rcpf(1.0f + __builtin_amdgcn_exp2f(-x * LOG2E)); }
__device__ __forceinline__ float sigmf(float x) { return __builtin_amdgcn_rcpf(1.0f + __builtin_amdgcn_exp2f(-x * LOG2E)); }
__device__ __forceinline__ float row_rs(const float* ssq, int row) {
    const f32x4 a = *(const f32x4*)(ssq + (size_t)row * 4);
    return __builtin_amdgcn_rsqf(((a[0] + a[1]) + (a[2] + a[3])) * (1.0f / 1024.0f) + EPS);
}
__device__ __forceinline__ int opaque_tid() { int t = threadIdx.x; asm volatile("" : "+v"(t)); return t; }
__device__ __forceinline__ f32x4 mfma16(bf16x8 a, bf16x8 b, f32x4 c) { return __builtin_amdgcn_mfma_f32_16x16x32_bf16(a, b, c, 0, 0, 0); }

namespace pg8 {
constexpr int BM = 256, BK = 64, HALF = 128, HTB = HALF * BK * 2, STAGE_BYTES = 8 * HTB, NXCD = 8, WGM = 8;
__host__ __device__ __forceinline__ int lds_byte(int r, int c) { const int st = (r >> 4) * 2 + (c >> 5), rr = r & 15, cc = c & 31, ob = rr * 64 + cc * 2; return st * 1024 + (ob ^ (((ob >> 9) & 1) << 5)); }
__host__ __device__ __forceinline__ void stage_rc(int b, int& R, int& C) { const int st = b / 1024, sb = b % 1024, swz = sb ^ (((sb >> 9) & 1) << 5); R = (st >> 1) * 16 + swz / 64; C = (st & 1) * 32 + (swz % 64) / 2; }
struct Unit { int pm, pn, ui, ri, tag, K; const char* A; const char* Bt; };
struct Gemm { const bf16_t* A; const bf16_t* Bt; int M, N, K; };
struct StaticOrder {
    int nM, nN, nwg, G, c; Gemm g;
    __host__ __device__ void init(int M, int N, int G_, int c_) { nM = M / BM; nN = N / BM; nwg = nM * nN; G = G_; c = c_; g.A = nullptr; g.Bt = nullptr; g.M = M; g.N = N; g.K = 0; }
    __host__ __device__ void set(const Gemm& g_) { g = g_; }
    __host__ __device__ bool tile(int i, int& pm, int& pn) const {
        const long L = (long)i * G + c; if (L >= nwg) return false;
        int wgid = (int)L; { const int q = nwg / NXCD, r = nwg % NXCD, xcd = wgid % NXCD, off = wgid / NXCD; wgid = (xcd < r ? xcd * (q + 1) : r * (q + 1) + (xcd - r) * q) + off; }
        const int nig = WGM * nN, gid = wgid / nig, fm = gid * WGM, gsz = (nM - fm) < WGM ? (nM - fm) : WGM;
        pm = fm + ((wgid % nig) % gsz); pn = (wgid % nig) / gsz; return true;
    }
    __host__ __device__ bool next(int i, Unit& u) const {
        if (!tile(i, u.pm, u.pn)) return false;
        u.ui = i; u.ri = i; u.tag = 0; u.K = g.K;
        u.A = (const char*)g.A + (size_t)u.pm * 256 * g.K * 2; u.Bt = (const char*)g.Bt + (size_t)u.pn * 256 * g.K * 2; return true;
    }
};
template <class Epi, class Sched>
__device__ __forceinline__ void gemm_phase(LAS unsigned char* lds, const Sched& S, const Epi& E) {
    const int tid = opaque_tid(), wid = __builtin_amdgcn_readfirstlane(tid >> 6), lane = tid & 63, wr = wid >> 2, wc = wid & 3, fr = lane & 15, fq = lane >> 4;
    unsigned R2[2], C2[2];
#pragma unroll
    for (int i = 0; i < 2; ++i) { int R, C; stage_rc(tid * 16 + i * 8192, R, C); R2[i] = (unsigned)R * 2u; C2[i] = (unsigned)C * 2u; }
    const size_t kstep = (size_t)(BK * 2);
    const unsigned ldsw = (unsigned)wid * 1024u;
    const int aoff = lds_byte(wr * 64 + fr, fq * 8), boff = lds_byte(wc * 32 + fr, fq * 8);
#define PG8_SA(b, h) (((b) * 2 + (h)) * HTB)
#define PG8_SB(b, h) ((4 + (b) * 2 + (h)) * HTB)
#define PG8_STAGE(bufoff, gbase, voff) do { _Pragma("unroll") for (int _i = 0; _i < 2; ++_i) \
        __builtin_amdgcn_global_load_lds((const unsigned*)((const char*)(gbase) + (voff)[_i]), (LAS unsigned*)(lds + (bufoff) + ldsw + _i * 8192), 16, 0, 0); } while (0)
#define PG8_LDA(dst, b, h) do { _Pragma("unroll") for (int m = 0; m < 4; ++m) _Pragma("unroll") for (int k = 0; k < 2; ++k) dst[m][k] = *(const LAS bf16x8*)(lds + PG8_SA(b, h) + aoff + m * 2048 + k * 1024); } while (0)
#define PG8_LDB(dst, b, h) do { _Pragma("unroll") for (int n = 0; n < 2; ++n) _Pragma("unroll") for (int k = 0; k < 2; ++k) dst[n][k] = *(const LAS bf16x8*)(lds + PG8_SB(b, h) + boff + n * 2048 + k * 1024); } while (0)
#define PG8_MMA(ai, bj, At, Bt) do { __builtin_amdgcn_s_setprio(1); _Pragma("unroll") for (int m = 0; m < 4; ++m) _Pragma("unroll") for (int n = 0; n < 2; ++n) _Pragma("unroll") for (int k = 0; k < 2; ++k) \
        acc[ai][bj][m][n] = __builtin_amdgcn_mfma_f32_16x16x32_bf16(Bt[n][k], At[m][k], acc[ai][bj][m][n], 0, 0, 0); __builtin_amdgcn_s_setprio(0); } while (0)
#define PG8_WAIT_V(n) asm volatile("s_waitcnt vmcnt(" #n ")" ::: "memory")
#define PG8_WAIT_L(n) asm volatile("s_waitcnt lgkmcnt(" #n ")" ::: "memory")
#define PG8_BAR __builtin_amdgcn_s_barrier()
#define PG8_SCHED __builtin_amdgcn_sched_barrier(0)
    Unit cur, nxt; int ui = 0;
    if (!S.next(0, cur)) return;
    f32x4 acc[2][2][4][2];
#pragma unroll
    for (int a = 0; a < 2; ++a)
#pragma unroll
        for (int b = 0; b < 2; ++b)
#pragma unroll
            for (int m = 0; m < 4; ++m)
#pragma unroll
                for (int n = 0; n < 2; ++n) acc[a][b][m][n] = (f32x4){0.f, 0.f, 0.f, 0.f};
    bf16x8 At[4][2], B0[2][2], B1[2][2];
    const char* cA = cur.A; const char* cB = cur.Bt;
    unsigned vo[2] = {R2[0] * (unsigned)cur.K + C2[0], R2[1] * (unsigned)cur.K + C2[1]};
    size_t hstep = (size_t)HALF * cur.K * 2;
    PG8_STAGE(PG8_SB(0, 0), cB, vo); PG8_STAGE(PG8_SB(0, 1), cB + hstep, vo); PG8_STAGE(PG8_SA(0, 0), cA, vo); PG8_STAGE(PG8_SA(0, 1), cA + hstep, vo);
    if (wr == 1) PG8_BAR;
    PG8_WAIT_V(2); PG8_BAR;
    PG8_STAGE(PG8_SB(1, 0), cB + kstep, vo); PG8_STAGE(PG8_SA(1, 0), cA + kstep, vo); PG8_STAGE(PG8_SB(1, 1), cB + hstep + kstep, vo);
    PG8_WAIT_V(6); PG8_BAR;
    for (;;) {
        const bool has_next = S.next(ui + 1, nxt);
        if (!has_next) nxt = cur;
        const char* nA = nxt.A; const char* nB = nxt.Bt;
        const unsigned voN0 = R2[0] * (unsigned)nxt.K + C2[0], voN1 = R2[1] * (unsigned)nxt.K + C2[1]; const size_t hstepN = (size_t)HALF * nxt.K * 2;
        const int nt = cur.K / BK;
        for (int t = 0; t < nt; t += 2) {
            const bool last = (t == nt - 2);
            const char* a1 = cA + (size_t)(t + 1) * kstep;
            const char* a2 = last ? nA : cA + (size_t)(t + 2) * kstep; const char* b2 = last ? nB : cB + (size_t)(t + 2) * kstep;
            const char* a3 = a2 + kstep; const char* b3 = b2 + kstep;
            const unsigned v2[2] = {last ? voN0 : vo[0], last ? voN1 : vo[1]}; const size_t h2 = last ? hstepN : hstep;
            PG8_LDB(B0, 0, 0); PG8_LDB(B1, 0, 1); PG8_SCHED; PG8_LDA(At, 0, 0); PG8_STAGE(PG8_SA(1, 1), a1 + hstep, vo);
            PG8_WAIT_V(8); PG8_WAIT_L(0); PG8_BAR; PG8_MMA(0, 0, At, B0); PG8_MMA(0, 1, At, B1); PG8_BAR; PG8_SCHED;
            PG8_LDA(At, 0, 1); PG8_STAGE(PG8_SB(0, 0), b2, v2); PG8_STAGE(PG8_SB(0, 1), b2 + h2, v2); PG8_STAGE(PG8_SA(0, 0), a2, v2);
            PG8_WAIT_V(8); PG8_WAIT_L(0); PG8_BAR; PG8_MMA(1, 0, At, B0); PG8_MMA(1, 1, At, B1); PG8_BAR; PG8_SCHED;
            PG8_LDB(B0, 1, 0); PG8_LDB(B1, 1, 1); PG8_SCHED; PG8_LDA(At, 1, 0); PG8_STAGE(PG8_SA(0, 1), a2 + h2, v2);
            PG8_WAIT_V(8); PG8_WAIT_L(0); PG8_BAR; PG8_MMA(0, 0, At, B0); PG8_MMA(0, 1, At, B1); PG8_BAR; PG8_SCHED;
            PG8_LDA(At, 1, 1); PG8_STAGE(PG8_SB(1, 0), b3, v2); PG8_STAGE(PG8_SB(1, 1), b3 + h2, v2); PG8_STAGE(PG8_SA(1, 0), a3, v2);
            PG8_WAIT_V(8); PG8_WAIT_L(0); PG8_BAR; PG8_MMA(1, 0, At, B0); PG8_MMA(1, 1, At, B1); PG8_BAR; PG8_SCHED;
        }
        if (wr == 0) PG8_BAR;
        if (!Epi::AFTER_DRAIN || has_next) { int fr2 = fr, fq2 = fq; asm volatile("" : "+v"(fr2), "+v"(fq2)); E(acc, cur, wr, wc, fr2, fq2); }
        if (!has_next) break;
#pragma unroll
        for (int a = 0; a < 2; ++a)
#pragma unroll
            for (int b = 0; b < 2; ++b)
#pragma unroll
                for (int m = 0; m < 4; ++m)
#pragma unroll
                    for (int n = 0; n < 2; ++n) acc[a][b][m][n] = (f32x4){0.f, 0.f, 0.f, 0.f};
        cur = nxt; cA = nA; cB = nB; vo[0] = voN0; vo[1] = voN1; hstep = hstepN; ++ui;
        if (wr == 1) PG8_BAR;
    }
    PG8_WAIT_V(0);
    PG8_BAR;
    if constexpr (Epi::AFTER_DRAIN) { int fr2 = fr, fq2 = fq; asm volatile("" : "+v"(fr2), "+v"(fq2)); E.fused(acc, cur, wr, wc, fr2, fq2, lds); }
#undef PG8_SA
#undef PG8_SB
#undef PG8_STAGE
#undef PG8_LDA
#undef PG8_LDB
#undef PG8_MMA
#undef PG8_WAIT_V
#undef PG8_WAIT_L
#undef PG8_BAR
#undef PG8_SCHED
}
}

__device__ __forceinline__ float wave_sum(float v);
#define ACC_ARG const f32x4 (&acc)[2][2][4][2]
#define EPI_FENCE() asm volatile("" ::: "memory")
constexpr int RTAB_OFF = RING_BYTES + 1024;
__device__ __forceinline__ void prep_rs(const float* ssq, int row_off, const pg8::StaticOrder& S, LAS unsigned char* lds) {
    const int tid = opaque_tid(); LAS float* rtab = (LAS float*)(lds + RTAB_OFF); pg8::Unit u;
    for (int i = 0; i < 6 && S.next(i, u); ++i) if (tid < 256) rtab[i * 256 + tid] = row_rs(ssq, row_off + u.pm * 256 + tid);
    __syncthreads();
}
struct EpiSwiglu {
    static constexpr bool AFTER_DRAIN = false;
    bf16_t* O; const LAS float* rtab;
    __device__ __forceinline__ void operator()(ACC_ARG, const pg8::Unit& u, int wr, int wc, int fr, int fq) const {
        const int lr0 = wr * 64 + fr, col0 = u.pn * 128 + wc * 32 + 8 * fq;
#pragma unroll
        for (int ai = 0; ai < 2; ++ai)
#pragma unroll
            for (int m = 0; m < 4; ++m) {
                const int lr = lr0 + ai * 128 + m * 16;
                const float rs = rtab ? rtab[u.ri * 256 + lr] : 1.0f;
                u32x4 w;
#pragma unroll
                for (int n = 0; n < 2; ++n) {
                    const f32x4 gt = acc[ai][0][m][n] * rs, up = acc[ai][1][m][n] * rs; f32x4 v;
#pragma unroll
                    for (int j = 0; j < 4; ++j) v[j] = siluf(gt[j]) * up[j];
                    const u32x2 p = pack4(v); if (n == 0) { w.x = p.x; w.y = p.y; } else { w.z = p.x; w.w = p.y; }
                }
                *(u32x4*)(O + (size_t)(u.pm * 256 + lr) * DFF + col0) = w;
            }
    }
};
struct EpiResid {
    static constexpr bool AFTER_DRAIN = true;
    const float* base; float* out; bf16_t* xb; float* ssq; float scale; int skip;
    __device__ __forceinline__ void operator()(ACC_ARG, const pg8::Unit& u, int wr, int wc, int fr, int fq) const {
        if (skip) return;
        const int row0 = u.pm * 256 + wr * 64 + fr, col0 = u.pn * 256 + wc * 32 + 4 * fq;
#pragma unroll
        for (int ai = 0; ai < 2; ++ai)
#pragma unroll
            for (int m = 0; m < 4; ++m) {
                const int row = row0 + ai * 128 + m * 16; float ss = 0.f;
#pragma unroll
                for (int bj = 0; bj < 2; ++bj)
#pragma unroll
                    for (int n = 0; n < 2; ++n) {
                        const size_t off = (size_t)row * DM + col0 + bj * 128 + n * 16;
                        const f32x4 v = *(const f32x4*)(base + off) + acc[ai][bj][m][n] * scale;
                        *(f32x4*)(out + off) = v;
                        if (xb) *(u32x2*)(xb + off) = pack4(v);
                        ss += (v[0] * v[0] + v[1] * v[1]) + (v[2] * v[2] + v[3] * v[3]);
                    }
                if (ssq) { ss += __shfl_xor(ss, 16); ss += __shfl_xor(ss, 32); if (fq == 0) atomicAdd(ssq + (size_t)row * 4 + u.pn, ss); }
            }
    }
    __device__ __forceinline__ void fused(ACC_ARG, const pg8::Unit& u, int wr, int wc, int fr, int fq, LAS unsigned char* lds) const {
        if (skip) return;
        const int tid = opaque_tid(), lane = tid & 63, wave = __builtin_amdgcn_readfirstlane(tid >> 6);
        LAS float* tl = (LAS float*)lds;
#pragma unroll
        for (int ai = 0; ai < 2; ++ai)
#pragma unroll
            for (int wq = 0; wq < 2; ++wq) {
                if (wr == wq) {
#pragma unroll
                    for (int m = 0; m < 4; ++m)
#pragma unroll
                        for (int bj = 0; bj < 2; ++bj)
#pragma unroll
                            for (int n = 0; n < 2; ++n) *(LAS f32x4*)(tl + (16 * m + fr) * 260 + bj * 128 + wc * 32 + n * 16 + 4 * fq) = acc[ai][bj][m][n] * scale;
                }
                __syncthreads();
                const int rbase = u.pm * 256 + ai * 128 + wq * 64;
                f32x4 bv[8];
#pragma unroll
                for (int r = 0; r < 8; ++r) bv[r] = __builtin_nontemporal_load((const f32x4*)(base + (size_t)(rbase + wave * 8 + r) * DM + u.pn * 256 + lane * 4));
#pragma unroll
                for (int r = 0; r < 8; ++r) {
                    const int row = rbase + wave * 8 + r; const size_t off = (size_t)row * DM + u.pn * 256 + lane * 4;
                    const f32x4 v = bv[r] + *(const LAS f32x4*)(tl + (wave * 8 + r) * 260 + lane * 4);
                    if (xb) { *(f32x4*)(out + off) = v; *(u32x2*)(xb + off) = pack4(v); } else __builtin_nontemporal_store(v, (f32x4*)(out + off));
                    if (ssq) { const float ss = wave_sum((v[0] * v[0] + v[1] * v[1]) + (v[2] * v[2] + v[3] * v[3])); if (lane == 0) ssq[(size_t)row * 4 + u.pn] = ss; }
                }
                __syncthreads();
            }
    }
};
struct EpiPlain {
    static constexpr bool AFTER_DRAIN = false;
    bf16_t* O; int ldo;
    __device__ __forceinline__ void operator()(ACC_ARG, const pg8::Unit& u, int wr, int wc, int fr, int fq) const {
        const int row0 = u.pm * 256 + wr * 64 + fr, col0 = u.pn * 256 + wc * 32 + 4 * fq;
#pragma unroll
        for (int ai = 0; ai < 2; ++ai)
#pragma unroll
            for (int m = 0; m < 4; ++m)
#pragma unroll
                for (int bj = 0; bj < 2; ++bj)
#pragma unroll
                    for (int n = 0; n < 2; ++n) *(u32x2*)(O + (size_t)(row0 + ai * 128 + m * 16) * ldo + col0 + bj * 128 + n * 16) = pack4(acc[ai][bj][m][n]);
    }
};
struct EpiMix {
    static constexpr bool AFTER_DRAIN = true;
    const LAS float* rtab; const float* rot;
    unsigned char* ws  ; bf16_t* mqb  ; const float *gdq, *gdk;
    static constexpr int TLD = 136;
    __device__ __forceinline__ void flushT(bf16_t* dst  , const LAS bf16_t* TS) const {
        const int tid = opaque_tid();
#pragma unroll
        for (int i = 0; i < 8; ++i) { const int p = tid + 512 * i, c = p >> 4, r8 = p & 15; *(u32x4*)(dst + (size_t)c * SEQ + r8 * 8) = *(const LAS u32x4*)(TS + c * TLD + r8 * 8); }
    }
    __device__ __forceinline__ void operator()(ACC_ARG, const pg8::Unit& u, int wr, int wc, int fr, int fq) const { body(acc, u, wr, wc, fr, fq, nullptr); }
    __device__ __forceinline__ void fused(ACC_ARG, const pg8::Unit& u, int wr, int wc, int fr, int fq, LAS unsigned char* lds) const {
        if (u.pn >= 4 && u.pn < 16) body(acc, u, wr, wc, fr, fq, (LAS bf16_t*)lds); else body(acc, u, wr, wc, fr, fq, nullptr);
    }
    __device__ __forceinline__ void body(ACC_ARG, const pg8::Unit& u, int wr, int wc, int fr, int fq, LAS bf16_t* TS) const {
        const int pn = u.pn, lr0 = wr * 64 + fr, lrow0 = u.pm * 256 + lr0;
        if (pn < 8) {
            const bool isk = pn >= 4; const int h = pn & 3; bf16_t* dst = (bf16_t*)(ws + (isk ? WS_K : WS_Q)); bf16_t* kts = (bf16_t*)(ws + WS_KTS);
            const float lg2 = log2f(1.0f - __builtin_amdgcn_exp2f(-5.0f - (float)h));
#pragma unroll
            for (int ai = 0; ai < 2; ++ai) {
                f32x4 cs0[4][2], cs1[4][2];
#pragma unroll
                for (int m = 0; m < 4; ++m)
#pragma unroll
                    for (int n = 0; n < 2; ++n) { const f32x4* cs = (const f32x4*)(rot + ((size_t)(lrow0 + ai * 128 + m * 16) * 128 + wc * 32 + 8 * fq + 4 * n) * 2); cs0[m][n] = cs[0]; cs1[m][n] = cs[1]; }
                EPI_FENCE();
#pragma unroll
                for (int m = 0; m < 4; ++m) {
                    int lrow = lrow0 + ai * 128 + m * 16; asm volatile("" : "+v"(lrow));
                    const float rs = rtab[u.ri * 256 + lr0 + ai * 128 + m * 16] * (isk ? 0.0625f : 1.0f);
                    const float dec = __builtin_amdgcn_exp2f(lg2 * (float)(127 - (lrow & 127)));
#pragma unroll
                    for (int n = 0; n < 2; ++n) {
                        const int i0 = wc * 32 + 8 * fq + 4 * n;
                        const f32x4 c01 = cs0[m][n], c23 = cs1[m][n];
                        const f32x4 cv = (f32x4){c01[0], c01[2], c23[0], c23[2]}, sv = (f32x4){c01[1], c01[3], c23[1], c23[3]};
                        const f32x4 x1 = acc[ai][0][m][n] * rs, x2 = acc[ai][1][m][n] * rs;
                        const f32x4 o1 = x1 * cv - x2 * sv, o2 = x1 * sv + x2 * cv;
                        *(u32x2*)(dst + (size_t)lrow * 1024 + h * 256 + i0) = pack4(o1);
                        *(u32x2*)(dst + (size_t)lrow * 1024 + h * 256 + 128 + i0) = pack4(o2);
                        if (isk) {
                            if (TS) {
                                const int rl = wr * 64 + m * 16 + fr;
#pragma unroll
                                for (int j = 0; j < 4; ++j) { TS[(i0 + j) * TLD + rl] = bf16_1(o1[j] * dec); TS[(128 + i0 + j) * TLD + rl] = bf16_1(o2[j] * dec); }
                            } else {
#pragma unroll
                                for (int j = 0; j < 4; ++j) {
                                    kts[(size_t)(h * 256 + i0 + j) * SEQ + lrow] = bf16_1(o1[j] * dec);
                                    kts[(size_t)(h * 256 + 128 + i0 + j) * SEQ + lrow] = bf16_1(o2[j] * dec);
                                }
                            }
                        }
                    }
                }
                EPI_FENCE();
                if (isk && TS) { __syncthreads(); flushT(kts + (size_t)(h * 256) * SEQ + u.pm * 256 + ai * 128, TS); __syncthreads(); }
            }
        } else if (pn < 16) {
            const int h = (pn - 8) >> 1, e0 = ((pn - 8) & 1) * 256; bf16_t* vt = (bf16_t*)(ws + WS_VT);
#pragma unroll
            for (int ai = 0; ai < 2; ++ai) {
#pragma unroll
                for (int m = 0; m < 4; ++m) {
                    int lrow = lrow0 + ai * 128 + m * 16; asm volatile("" : "+v"(lrow));
                    const float rs = rtab[u.ri * 256 + lr0 + ai * 128 + m * 16];
#pragma unroll
                    for (int bj = 0; bj < 2; ++bj)
#pragma unroll
                        for (int n = 0; n < 2; ++n) {
                            const int tc = bj * 128 + wc * 32 + 8 * fq + 4 * n, ec = e0 + tc; const f32x4 v = acc[ai][bj][m][n] * rs;
                            if (TS) {
                                const int rl = wr * 64 + m * 16 + fr;
#pragma unroll
                                for (int j = 0; j < 4; ++j) TS[(tc + j) * TLD + rl] = bf16_1(v[j]);
                            } else {
#pragma unroll
                                for (int j = 0; j < 4; ++j) vt[(size_t)(h * 512 + ec + j) * SEQ + lrow] = bf16_1(v[j]);
                            }
                        }
                    EPI_FENCE();
                }
                if (TS) { __syncthreads(); flushT(vt + (size_t)(h * 512 + e0) * SEQ + u.pm * 256 + ai * 128, TS); __syncthreads(); }
            }
        } else if (pn < 24) {
            const bool isk = pn >= 20; const int tile = (pn - 16) & 3; bf16_t* dst = (bf16_t*)(ws + (isk ? WS_DK : WS_DQ)); const float* gn = isk ? gdk : gdq; const float mul = isk ? 1.0f : C2Q;
            f32x4 gv[2][2];
#pragma unroll
            for (int bj = 0; bj < 2; ++bj)
#pragma unroll
                for (int n = 0; n < 2; ++n) gv[bj][n] = *(const f32x4*)(gn + 32 * bj + 8 * fq + 4 * n);
#pragma unroll
            for (int ai = 0; ai < 2; ++ai)
#pragma unroll
                for (int m = 0; m < 4; ++m) {
                    int lrow = lrow0 + ai * 128 + m * 16; asm volatile("" : "+v"(lrow));
                    const float rs = rtab[u.ri * 256 + lr0 + ai * 128 + m * 16];
                    f32x4 v[2][2]; float ss = 0.f;
#pragma unroll
                    for (int bj = 0; bj < 2; ++bj)
#pragma unroll
                        for (int n = 0; n < 2; ++n) { v[bj][n] = acc[ai][bj][m][n] * rs; const f32x4 t = v[bj][n]; ss += (t[0] * t[0] + t[1] * t[1]) + (t[2] * t[2] + t[3] * t[3]); }
                    ss += __shfl_xor(ss, 16); ss += __shfl_xor(ss, 32);
                    const float rn = __builtin_amdgcn_rsqf(ss * (1.0f / 64.0f) + EPS) * mul;
#pragma unroll
                    for (int bj = 0; bj < 2; ++bj) { const u32x2 p0 = pack4(v[bj][0] * rn * gv[bj][0]), p1 = pack4(v[bj][1] * rn * gv[bj][1]);
                        *(u32x4*)(dst + (size_t)lrow * 1024 + tile * 256 + 64 * wc + 32 * bj + 8 * fq) = (u32x4){p0.x, p0.y, p1.x, p1.y}; }
                    EPI_FENCE();
                }
        } else {
            bf16_t* dst = pn < 28 ? (bf16_t*)(ws + WS_DV) : mqb; const int tile = (pn - 24) & 3;
#pragma unroll
            for (int ai = 0; ai < 2; ++ai)
#pragma unroll
                for (int m = 0; m < 4; ++m) {
                    int lrow = lrow0 + ai * 128 + m * 16; asm volatile("" : "+v"(lrow));
                    const float rs = rtab[u.ri * 256 + lr0 + ai * 128 + m * 16];
#pragma unroll
                    for (int bj = 0; bj < 2; ++bj) { const u32x2 p0 = pack4(acc[ai][bj][m][0] * rs), p1 = pack4(acc[ai][bj][m][1] * rs);
                        *(u32x4*)(dst + (size_t)lrow * 1024 + tile * 256 + bj * 128 + wc * 32 + 8 * fq) = (u32x4){p0.x, p0.y, p1.x, p1.y}; }
                    EPI_FENCE();
                }
        }
    }
};
struct EpiRgG {
    static constexpr bool AFTER_DRAIN = false;
    const LAS float* rtab; bf16_t* ret; const float* rssq; unsigned char* ws;
    __device__ __forceinline__ void operator()(ACC_ARG, const pg8::Unit& u, int wr, int wc, int fr, int fq) const {
        const int lr0 = wr * 64 + fr;
        if (u.pn < 8) {
            const int col0 = u.pn * 256 + wc * 32 + 8 * fq;
#pragma unroll
            for (int ai = 0; ai < 2; ++ai) {
                u32x4 rv[4][2]; f32x2 rq2[4];
#pragma unroll
                for (int m = 0; m < 4; ++m) { const int lr = lr0 + ai * 128 + m * 16;
                    rq2[m] = *(const f32x2*)(rssq + (size_t)(u.pm * 256 + lr) * 8 + 2 * (u.pn >> 1));
#pragma unroll
                    for (int bj = 0; bj < 2; ++bj) rv[m][bj] = *(const u32x4*)(ret + (size_t)(u.pm * 256 + lr) * 2048 + col0 + bj * 128); }
                EPI_FENCE();
#pragma unroll
                for (int m = 0; m < 4; ++m) {
                    const int lr = lr0 + ai * 128 + m * 16; const float rs = rtab[u.ri * 256 + lr];
                    const float rr = __builtin_amdgcn_rsqf((rq2[m][0] + rq2[m][1]) * (1.0f / 512.0f) + EPS);
#pragma unroll
                    for (int bj = 0; bj < 2; ++bj) {
                        u32x4 o;
#pragma unroll
                        for (int n = 0; n < 2; ++n) {
                            const unsigned w0 = n == 0 ? rv[m][bj].x : rv[m][bj].z, w1 = n == 0 ? rv[m][bj].y : rv[m][bj].w; const f32x4 a = acc[ai][bj][m][n] * rs; f32x4 v;
                            v[0] = __uint_as_float(w0 << 16) * siluf(a[0]); v[1] = __uint_as_float(w0 & 0xffff0000u) * siluf(a[1]);
                            v[2] = __uint_as_float(w1 << 16) * siluf(a[2]); v[3] = __uint_as_float(w1 & 0xffff0000u) * siluf(a[3]);
                            const u32x2 p = pack4(v * rr); if (n == 0) { o.x = p.x; o.y = p.y; } else { o.z = p.x; o.w = p.y; }
                        }
                        *(u32x4*)(ret + (size_t)(u.pm * 256 + lr) * 2048 + col0 + bj * 128) = o;
                    }
                }
                EPI_FENCE();
            }
        } else {
            const int br = (u.pn - 8) >> 2, col0 = ((u.pn - 8) & 3) * 256 + wc * 32 + 8 * fq;
            unsigned char* g8 = ws + (br == 0 ? WS_G8A : br == 1 ? WS_G8B : WS_G8C);
#pragma unroll
            for (int ai = 0; ai < 2; ++ai)
#pragma unroll
                for (int m = 0; m < 4; ++m) {
                    const int lr = lr0 + ai * 128 + m * 16; const float rs = rtab[u.ri * 256 + lr];
#pragma unroll
                    for (int bj = 0; bj < 2; ++bj) {
                        u32x2 w2;
#pragma unroll
                        for (int n = 0; n < 2; ++n) {
                            const f32x4 a = acc[ai][bj][m][n] * rs; unsigned w = 0u;
#pragma unroll
                            for (int j = 0; j < 4; ++j) w |= (unsigned)__builtin_rintf(255.0f * sigmf(a[j])) << (8 * j);
                            if (n == 0) w2.x = w; else w2.y = w;
                        }
                        *(u32x2*)(g8 + (size_t)(u.pm * 256 + lr) * DM + col0 + bj * 128) = w2;
                    }
                }
        }
    }
};
struct EpiTerm3 {
    static constexpr bool AFTER_DRAIN = false;
    unsigned char* ws; bf16_t* y;
    __device__ __forceinline__ void operator()(ACC_ARG, const pg8::Unit& u, int wr, int wc, int fr, int fq) const {
        const int lr0 = wr * 64 + fr, col0 = u.pn * 256 + wc * 32 + 8 * fq, first = (u.tag == 0);
        const unsigned char* g8 = ws + (u.tag == 0 ? WS_G8A : u.tag == 1 ? WS_G8B : WS_G8C);
#pragma unroll
        for (int ai = 0; ai < 2; ++ai) {
            u32x2 gv[4][2]; u32x4 yv[4][2];
#pragma unroll
            for (int m = 0; m < 4; ++m)
#pragma unroll
                for (int bj = 0; bj < 2; ++bj) { const size_t off = (size_t)(u.pm * 256 + lr0 + ai * 128 + m * 16) * DM + col0 + bj * 128;
                    gv[m][bj] = *(const u32x2*)(g8 + off); yv[m][bj] = first ? (u32x4){0u, 0u, 0u, 0u} : *(const u32x4*)(y + off); }
            EPI_FENCE();
#pragma unroll
            for (int m = 0; m < 4; ++m)
#pragma unroll
                for (int bj = 0; bj < 2; ++bj) {
                    const size_t off = (size_t)(u.pm * 256 + lr0 + ai * 128 + m * 16) * DM + col0 + bj * 128;
                    u32x4 o;
#pragma unroll
                    for (int n = 0; n < 2; ++n) {
                        const f32x4 a = acc[ai][bj][m][n]; const unsigned gw = n == 0 ? gv[m][bj].x : gv[m][bj].y; const unsigned w0 = n == 0 ? yv[m][bj].x : yv[m][bj].z, w1 = n == 0 ? yv[m][bj].y : yv[m][bj].w; f32x4 v;
                        v[0] = (float)(gw & 255u) * (1.0f / 255.0f) * a[0] + __uint_as_float(w0 << 16); v[1] = (float)((gw >> 8) & 255u) * (1.0f / 255.0f) * a[1] + __uint_as_float(w0 & 0xffff0000u);
                        v[2] = (float)((gw >> 16) & 255u) * (1.0f / 255.0f) * a[2] + __uint_as_float(w1 << 16); v[3] = (float)(gw >> 24) * (1.0f / 255.0f) * a[3] + __uint_as_float(w1 & 0xffff0000u);
                        const u32x2 p = pack4(v); if (n == 0) { o.x = p.x; o.y = p.y; } else { o.z = p.x; o.w = p.y; }
                    }
                    *(u32x4*)(y + off) = o;
                }
            EPI_FENCE();
        }
    }
};

#include <hip/hip_bf16.h>
namespace attn_body {
using bf16=__hip_bfloat16;
using bf16x8=__attribute__((ext_vector_type(8)))short;
using s16x4=__attribute__((ext_vector_type(4)))short;
using f32x16=__attribute__((ext_vector_type(16)))float;
using u32x4=__attribute__((ext_vector_type(4)))unsigned;
constexpr int D=64,DM=1024;
constexpr int NW=8,QBLK=32,QB=QBLK*NW,KVBLK=64;
__device__ __forceinline__ int crow(int r,int hi){return (r&3)+8*(r>>2)+4*hi;}
#define SBAR() __builtin_amdgcn_sched_barrier(0)
__device__ __forceinline__ void cmask(f32x16&p0,f32x16&p1,int jb,int qrel,int hi){
  const float NEG=-INFINITY; int kb=64*jb+4*hi;
  #pragma unroll
  for(int r=0;r<16;++r){int kv=kb+(r&3)+8*(r>>2); if(kv>qrel)p0[r]=NEG; if(kv+32>qrel)p1[r]=NEG;}
}
constexpr int NSLOT=3, SLOTB=8192;
constexpr int LDS_K=0, LDS_V=NSLOT*SLOTB, LDS_WS=2*NSLOT*SLOTB, LDS_OST=LDS_WS+NW*64*4, LDS_BYTES=LDS_OST+NW*4096;
__device__ __forceinline__ void glds16(const void*gsrc,unsigned lds_dst){unsigned keep;
  asm volatile("s_mov_b32 %0, m0\n\ts_mov_b32 m0, %2\n\ts_nop 0\n\tglobal_load_lds_dwordx4 %1, off\n\ts_mov_b32 m0, %0":"=&s"(keep):"v"(gsrc),"s"(lds_dst):"memory");}
__device__ __forceinline__ float max3f(float a,float b,float c){float r;asm("v_max3_f32 %0, %1, %2, %3":"=v"(r):"v"(a),"v"(b),"v"(c));return r;}
__device__ __forceinline__ float max2f(float a,float b){float r;asm("v_max_f32_e32 %0, %1, %2":"=v"(r):"v"(a),"v"(b));return r;}
__device__ __forceinline__ float fadd_s(float a,float b){float r;asm("v_add_f32_e32 %0, %1, %2":"=v"(r):"v"(a),"v"(b));return r;}
__device__ __forceinline__ float fsub_s(float a,float b){float r;asm("v_sub_f32_e32 %0, %1, %2":"=v"(r):"v"(a),"v"(b));return r;}
typedef float f32x2_t __attribute__((ext_vector_type(2))); typedef __bf16 bf16x2_t __attribute__((ext_vector_type(2)));
__device__ __forceinline__ unsigned cvtpk_s(float lo,float hi){f32x2_t v={lo,hi};bf16x2_t b=__builtin_convertvector(v,bf16x2_t);return __builtin_bit_cast(unsigned,b);}
#define WAIT_BAR(N) asm volatile("s_waitcnt vmcnt(" #N ") lgkmcnt(0)\n\ts_barrier":::"memory")
__device__ __forceinline__ void qkt(f32x16&p0,f32x16&p1,const char*Kslot,const bf16x8*qr,const f32x16&negm,int r32,int hi){
  const char*kb=Kslot+hi*1024+r32*16;
  #pragma unroll
  for(int d0=0;d0<4;++d0){
    const bf16x8 b0=*reinterpret_cast<const bf16x8*>(kb+d0*2048);
    const bf16x8 b1=*reinterpret_cast<const bf16x8*>(kb+d0*2048+512);
    if(d0==0){p0=__builtin_amdgcn_mfma_f32_32x32x16_bf16(b0,qr[0],negm,0,0,0);p1=__builtin_amdgcn_mfma_f32_32x32x16_bf16(b1,qr[0],negm,0,0,0);}
    else{p0=__builtin_amdgcn_mfma_f32_32x32x16_bf16(b0,qr[d0],p0,0,0,0);p1=__builtin_amdgcn_mfma_f32_32x32x16_bf16(b1,qr[d0],p1,0,0,0);}}
}
typedef __attribute__((address_space(3))) const char* lds_cptr;
typedef short v4i16_t __attribute__((ext_vector_type(4)));
__device__ __forceinline__ void kload8(bf16x8*kf,lds_cptr kp){
  kf[0]=*(const __attribute__((address_space(3))) bf16x8*)(kp);      kf[1]=*(const __attribute__((address_space(3))) bf16x8*)(kp+512);
  kf[2]=*(const __attribute__((address_space(3))) bf16x8*)(kp+2048); kf[3]=*(const __attribute__((address_space(3))) bf16x8*)(kp+2560);
  kf[4]=*(const __attribute__((address_space(3))) bf16x8*)(kp+4096); kf[5]=*(const __attribute__((address_space(3))) bf16x8*)(kp+4608);
  kf[6]=*(const __attribute__((address_space(3))) bf16x8*)(kp+6144); kf[7]=*(const __attribute__((address_space(3))) bf16x8*)(kp+6656);
}
__device__ __forceinline__ void kload2(bf16x8*kf,lds_cptr kp,int j){ kf[2*j]=*(const __attribute__((address_space(3))) bf16x8*)(kp+j*2048); kf[2*j+1]=*(const __attribute__((address_space(3))) bf16x8*)(kp+j*2048+512); }
__device__ __forceinline__ s16x4 vtr(lds_cptr p){ return __builtin_bit_cast(s16x4,__builtin_amdgcn_ds_read_tr16_b64_v4i16((__attribute__((address_space(3))) v4i16_t*)p)); }
__device__ __forceinline__ float rowmax(const f32x16&p0,const f32x16&p1){
  float a=max3f(p0[0],p0[1],p1[0]),b=max3f(p0[2],p0[3],p1[1]);a=max3f(a,p1[2],p1[3]);
  #pragma unroll
  for(int r=4;r<16;r+=4){a=max3f(a,p0[r],p0[r+1]);b=max3f(b,p0[r+2],p0[r+3]);a=max3f(a,p1[r],p1[r+1]);b=max3f(b,p1[r+2],p1[r+3]);}
  const float m=max2f(a,b);
  auto rr=__builtin_amdgcn_permlane32_swap(__float_as_uint(m),__float_as_uint(m),false,false);
  return max2f(__uint_as_float(rr[0]),__uint_as_float(rr[1]));
}
__device__ __forceinline__ void pv(f32x16*o,int vb,bf16x8 pa0,bf16x8 pa1,bf16x8 pa2,bf16x8 pa3){
  #pragma unroll
  for(int d0=0;d0<2;++d0){s16x4 lo[4],hi[4];
    #pragma unroll
    for(int ks=0;ks<4;++ks){
      asm volatile("ds_read_b64_tr_b16 %0,%1 offset:%c2":"=&v"(lo[ks]):"v"(vb),"i"(d0*4096+ks*1024):"memory");
      asm volatile("ds_read_b64_tr_b16 %0,%1 offset:%c2":"=&v"(hi[ks]):"v"(vb),"i"(d0*4096+ks*1024+512):"memory");}
    asm volatile("s_waitcnt lgkmcnt(0)":::"memory");SBAR();
    #define PK(k) (bf16x8){lo[k][0],lo[k][1],lo[k][2],lo[k][3],hi[k][0],hi[k][1],hi[k][2],hi[k][3]}
    o[d0]=__builtin_amdgcn_mfma_f32_32x32x16_bf16(pa0,PK(0),o[d0],0,0,0);
    o[d0]=__builtin_amdgcn_mfma_f32_32x32x16_bf16(pa1,PK(1),o[d0],0,0,0);
    o[d0]=__builtin_amdgcn_mfma_f32_32x32x16_bf16(pa2,PK(2),o[d0],0,0,0);
    o[d0]=__builtin_amdgcn_mfma_f32_32x32x16_bf16(pa3,PK(3),o[d0],0,0,0);
    #undef PK
  }
}
#define ATTN_STORE16(p,v) (*(u32x4*)(p)=(v))
template<int THRL> __device__ __forceinline__ void attn_unit(int hq,int hv,int qb,const bf16*Q,const bf16*__restrict__ K,const bf16*__restrict__ V,bf16*O,char*shm){
  const int tid=opaque_tid(),lane=tid&63,r32=lane&31,hi=lane>>5; const int wid=__builtin_amdgcn_readfirstlane(tid>>6);
  const int q0=qb*QB;
  const bf16*Qw=Q+(long)(q0+wid*QBLK)*DM+hq*D;
  const bf16*Kh=K+hq*D,*Vh=V+hv*D;
  const unsigned lds0=(unsigned)(uintptr_t)shm;
  float*wsf=(float*)(shm+LDS_WS)+wid*64;
  const bf16*ksrc=Kh+(long)lane*DM+wid*8;
  const bf16*vsrc=Vh+(long)(16*(wid&3)+(lane>>2))*DM+(wid>>2)*32+(lane&3)*8;
  const unsigned kdst=lds0+LDS_K+wid*1024, vdst=lds0+LDS_V+wid*1024;
  #define DMA_K(t,slot) glds16(ksrc+(long)(t)*KVBLK*DM,(unsigned)__builtin_amdgcn_readfirstlane(kdst+(slot)))
  #define DMA_V(t,slot) glds16(vsrc+(long)(t)*KVBLK*DM,(unsigned)__builtin_amdgcn_readfirstlane(vdst+(slot)))
  const int vb0=(int)(lds0+LDS_V)+((lane>>4)&1)*32+(lane&3)*8+(4*hi+((lane&15)>>2))*64;
  const char*Kbase=shm+LDS_K; bf16x8 kf[8];
  const lds_cptr shm3=(lds_cptr)shm; const lds_cptr kp0=shm3+LDS_K+hi*1024+r32*16; const lds_cptr vp0=shm3+LDS_V+((lane>>4)&1)*32+(lane&3)*8+(4*hi+((lane&15)>>2))*64;
  const int NT=(q0+QB)/KVBLK;
  DMA_K(0,0);DMA_V(0,0);DMA_K(1,SLOTB);
  bf16x8 qr[4];
  #pragma unroll
  for(int d0=0;d0<4;++d0)qr[d0]=*reinterpret_cast<const bf16x8*>(&Qw[(long)r32*DM+d0*16+hi*8]);
  float mhat=0.f,l_reg=0.f;f32x16 o[2];o[0]=f32x16{};o[1]=f32x16{};f32x16 negm=f32x16{};asm volatile("":"+v"(negm));
  const int qrel=wid*QBLK+r32;
  #define CMASK(P0,P1,t) do{int jb_=(t)-(NT-4); if(jb_>=0)cmask(P0,P1,jb_,qrel,hi);}while(0)
  bool resc=false;
  #define START(P0,P1) do{ const float rm=rowmax(P0,P1); resc=false; \
    { const float dl=rm; mhat=fadd_s(mhat,dl); \
      _Pragma("unroll") for(int r=0;r<16;++r){P0[r]=fsub_s(P0[r],dl);P1[r]=fsub_s(P1[r],dl);} \
      _Pragma("unroll") for(int r=0;r<16;++r)negm[r]=-mhat; asm volatile("":"+v"(negm)); } \
    _Pragma("unroll") for(int r=0;r<16;++r)P0[r]=__builtin_amdgcn_exp2f(P0[r]); }while(0)
  #define RESC() do{ if(resc){ asm volatile("s_waitcnt lgkmcnt(0)":::"memory"); \
      _Pragma("unroll") for(int d_=0;d_<2;++d_) _Pragma("unroll") for(int r=0;r<16;++r)o[d_][r]*=wsf[crow(r,hi)]; } }while(0)
  f32x16 pA0,pA1,pB0,pB1;
  int sl_prev=0,sl_cur=0,sl_next=SLOTB;
  #define ROT() do{sl_prev=sl_cur;sl_cur=sl_next;sl_next=(sl_next==(NSLOT-1)*SLOTB)?0:sl_next+SLOTB;}while(0)
  DMA_K(2,2*SLOTB);
  WAIT_BAR(3);
  qkt(pA0,pA1,Kbase,qr,negm,r32,hi);asm volatile("s_nop 15\n\ts_nop 7":"+v"(pA0),"+v"(pA1));CMASK(pA0,pA1,0);
  START(pA0,pA1);
  _Pragma("unroll") for(int r=0;r<16;++r)pA1[r]=__builtin_amdgcn_exp2f(pA1[r]);
  WAIT_BAR(0);
  DMA_K(3,0);DMA_V(1,SLOTB);
  ROT();
  kload8(kf,kp0+sl_cur);
  WAIT_BAR(2);
  s16x4 vlo[8],vhi[8]; u32x4 pw0,pw1,pw2,pw3;
  #define PKW(P,B) cvtpk_s(P[B],P[B+1])
  #define PAF(k) __builtin_bit_cast(bf16x8,pw##k)
  #define VFR(i) (bf16x8){vlo[i][0],vlo[i][1],vlo[i][2],vlo[i][3],vhi[i][0],vhi[i][1],vhi[i][2],vhi[i][3]}
  #define PIN(x) asm volatile("":"+v"(x))
  #define MX3(a,b,c) __builtin_fmaxf(__builtin_fmaxf((a),(b)),(c))
  #define GAPA(MF,A0,A1,A2,A3,W0,W1,PW) do{ MF; sacc+=A0; sacc+=A1; sacc+=A2; sacc+=A3; PIN(sacc); W0; W1; PIN(PW); SBAR(); }while(0)
  #define EX(v) __builtin_amdgcn_exp2f(v)
  #define GAPB(MF,X,B) do{ MF; X[B]=EX(X[B]); X[B+1]=EX(X[B+1]); X[B+2]=EX(X[B+2]); X[B+3]=EX(X[B+3]); PIN(X); SBAR(); }while(0)
  #define VRD(i) do{ vlo[i]=vtr(vp_+(((i)>>2)*4096+((i)&3)*1024)); vhi[i]=vtr(vp_+(((i)>>2)*4096+((i)&3)*1024+512)); }while(0)
  #define KRD(G,j) do{ if(G){ kload2(kf,kp0+sl_next,j); SBAR(); } }while(0)
  #define STEP(C0,C1,P0,P1,t,GK,GV,GL) do{ SBAR(); \
    const lds_cptr vp_=vp0+sl_prev; \
    VRD(0); SBAR(); float sacc=(P0[0]+P0[1]); \
    GAPA(C0=__builtin_amdgcn_mfma_f32_32x32x16_bf16(kf[0],qr[0],negm,0,0,0), P0[2],P0[3],P0[4],P0[5],     pw0[0]=PKW(P0,0), pw0[1]=PKW(P0,2), pw0); \
    VRD(4); SBAR(); GAPA(C1=__builtin_amdgcn_mfma_f32_32x32x16_bf16(kf[1],qr[0],negm,0,0,0), P0[6],P0[7],P0[8],P0[9],     pw0[2]=PKW(P0,4), pw0[3]=PKW(P0,6), pw0); \
    VRD(1); SBAR(); GAPA(C0=__builtin_amdgcn_mfma_f32_32x32x16_bf16(kf[2],qr[1],C0,0,0,0),   P0[10],P0[11],P0[12],P0[13], pw1[0]=PKW(P0,8), pw1[1]=PKW(P0,10), pw1); \
    VRD(5); SBAR(); GAPA(C1=__builtin_amdgcn_mfma_f32_32x32x16_bf16(kf[3],qr[1],C1,0,0,0),   P0[14],P0[15],P1[0],P1[1],   pw1[2]=PKW(P0,12),pw1[3]=PKW(P0,14), pw1); \
    VRD(2); SBAR(); GAPA(C0=__builtin_amdgcn_mfma_f32_32x32x16_bf16(kf[4],qr[2],C0,0,0,0),   P1[2],P1[3],P1[4],P1[5],     pw2[0]=PKW(P1,0), pw2[1]=PKW(P1,2), pw2); \
    VRD(6); SBAR(); GAPA(C1=__builtin_amdgcn_mfma_f32_32x32x16_bf16(kf[5],qr[2],C1,0,0,0),   P1[6],P1[7],P1[8],P1[9],     pw2[2]=PKW(P1,4), pw2[3]=PKW(P1,6), pw2); \
    VRD(3); SBAR(); GAPA(C0=__builtin_amdgcn_mfma_f32_32x32x16_bf16(kf[6],qr[3],C0,0,0,0),   P1[10],P1[11],P1[12],P1[13], pw3[0]=PKW(P1,8), pw3[1]=PKW(P1,10), pw3); \
    VRD(7); SBAR(); GAPA(C1=__builtin_amdgcn_mfma_f32_32x32x16_bf16(kf[7],qr[3],C1,0,0,0),   P1[14],P1[15],0.f,0.f,       pw3[2]=PKW(P1,12),pw3[3]=PKW(P1,14), pw3); \
    l_reg+=sacc; \
    if(GK){DMA_K((t)+3,sl_cur);} if(GV){DMA_V((t)+1,sl_next);} \
    CMASK(C0,C1,t); \
    { float a=MX3(C0[0],C0[1],C1[0]),b=MX3(C0[2],C0[3],C1[1]); a=MX3(a,C1[2],C1[3]); \
      _Pragma("unroll") for(int r=4;r<16;r+=4){a=MX3(a,C0[r],C0[r+1]);b=MX3(b,C0[r+2],C0[r+3]);a=MX3(a,C1[r],C1[r+1]);b=MX3(b,C1[r+2],C1[r+3]);} \
      float rm=__builtin_fmaxf(a,b); { auto rr=__builtin_amdgcn_permlane32_swap(__float_as_uint(rm),__float_as_uint(rm),false,false); rm=__builtin_fmaxf(__uint_as_float(rr[0]),__uint_as_float(rr[1])); } \
      resc=false; \
      if(__builtin_expect(__any(rm>(float)THRL),0)){ const float dl=__builtin_fmaxf(rm,0.f); mhat+=dl; \
        _Pragma("unroll") for(int r=0;r<16;++r){C0[r]-=dl;C1[r]-=dl;} \
        _Pragma("unroll") for(int r=0;r<16;++r)negm[r]=-mhat; asm volatile("":"+v"(negm)); \
        const float f=__builtin_amdgcn_exp2f(-dl); l_reg*=f; if(hi==0)wsf[r32]=f; resc=true; } } \
    SBAR(); \
    GAPB(o[0]=__builtin_amdgcn_mfma_f32_32x32x16_bf16(PAF(0),VFR(0),o[0],0,0,0), C0,0); \
    GAPB(o[1]=__builtin_amdgcn_mfma_f32_32x32x16_bf16(PAF(0),VFR(4),o[1],0,0,0), C0,4); \
    KRD(GL,0); GAPB(o[0]=__builtin_amdgcn_mfma_f32_32x32x16_bf16(PAF(1),VFR(1),o[0],0,0,0), C0,8); \
    KRD(GL,1); GAPB(o[1]=__builtin_amdgcn_mfma_f32_32x32x16_bf16(PAF(1),VFR(5),o[1],0,0,0), C0,12); \
    KRD(GL,2); GAPB(o[0]=__builtin_amdgcn_mfma_f32_32x32x16_bf16(PAF(2),VFR(2),o[0],0,0,0), C1,0); \
    KRD(GL,3); GAPB(o[1]=__builtin_amdgcn_mfma_f32_32x32x16_bf16(PAF(2),VFR(6),o[1],0,0,0), C1,4); \
    GAPB(o[0]=__builtin_amdgcn_mfma_f32_32x32x16_bf16(PAF(3),VFR(3),o[0],0,0,0), C1,8); \
    GAPB(o[1]=__builtin_amdgcn_mfma_f32_32x32x16_bf16(PAF(3),VFR(7),o[1],0,0,0), C1,12); \
    }while(0)
  int t=1;
  #undef CMASK
  #define CMASK(P0,P1,t) do{}while(0)
  for(;t+5<NT;t+=2){
    STEP(pB0,pB1,pA0,pA1,t,true,true,true);     WAIT_BAR(2); RESC(); ROT();
    STEP(pA0,pA1,pB0,pB1,t+1,true,true,true);   WAIT_BAR(2); RESC(); ROT();
  }
  #undef CMASK
  #define CMASK(P0,P1,t) do{int jb_=(t)-(NT-4); if(jb_>=0)cmask(P0,P1,jb_,qrel,hi);}while(0)
  #define ENDW(tt) do{ if((tt)+3<NT){WAIT_BAR(2);} else if((tt)+2<NT){WAIT_BAR(1);} else {WAIT_BAR(0);} }while(0)
  for(;t+1<NT;t+=2){
    STEP(pB0,pB1,pA0,pA1,t,(t+3<NT),(t+1<NT),(t+1<NT));       ENDW(t);   RESC(); ROT();
    STEP(pA0,pA1,pB0,pB1,t+1,(t+4<NT),(t+2<NT),(t+2<NT));     ENDW(t+1); RESC(); ROT();
  }
  STEP(pB0,pB1,pA0,pA1,NT-1,false,false,false); RESC();
  { float sacc=pB0[0]+pB0[1]; _Pragma("unroll") for(int r=2;r<16;++r)sacc+=pB0[r]; _Pragma("unroll") for(int r=0;r<16;++r)sacc+=pB1[r]; l_reg+=sacc;
    pw0=(u32x4){PKW(pB0,0),PKW(pB0,2),PKW(pB0,4),PKW(pB0,6)};pw1=(u32x4){PKW(pB0,8),PKW(pB0,10),PKW(pB0,12),PKW(pB0,14)};pw2=(u32x4){PKW(pB1,0),PKW(pB1,2),PKW(pB1,4),PKW(pB1,6)};pw3=(u32x4){PKW(pB1,8),PKW(pB1,10),PKW(pB1,12),PKW(pB1,14)};
    SBAR(); pv(o,vb0+sl_cur,PAF(0),PAF(1),PAF(2),PAF(3)); }
  #undef PKW
  #undef PAF
  #undef VFR
  #undef PIN
  #undef MX3
  #undef GAPA
  #undef GAPB
  #undef EX
  #undef VRD
  #undef KRD
  #undef STEP
  #undef ENDW
  {auto rr=__builtin_amdgcn_permlane32_swap(__float_as_uint(l_reg),__float_as_uint(l_reg),false,false);l_reg=__uint_as_float(rr[0])+__uint_as_float(rr[1]);}
  if(hi==0)wsf[32+r32]=l_reg;asm volatile("s_waitcnt lgkmcnt(0)":::"memory");
  float rli[16];
  #pragma unroll
  for(int r=0;r<16;++r)rli[r]=__builtin_amdgcn_rcpf(wsf[32+crow(r,hi)]);
  bf16*Ow=O+(long)(q0+wid*QBLK)*DM+hv*D;
  { bf16*stg=(bf16*)(shm+LDS_OST)+wid*2048;
    #pragma unroll
    for(int r=0;r<16;++r){const int orow=crow(r,hi);
      #pragma unroll
      for(int d0=0;d0<2;++d0)stg[orow*64+d0*32+r32]=__float2bfloat16(o[d0][r]*rli[r]);}
    asm volatile("s_waitcnt lgkmcnt(0)":::"memory");
    #pragma unroll
    for(int i=0;i<4;++i){const int row=i*8+(lane>>3),ch=lane&7; const u32x4 v=*(const u32x4*)(stg+row*64+ch*8); ATTN_STORE16(Ow+(long)row*DM+ch*8,v);} }
  asm volatile("s_waitcnt lgkmcnt(0)\n\ts_barrier":::"memory");
  #undef DMA_K
  #undef DMA_V
  #undef CMASK
  #undef START
  #undef RESC
  #undef ROT
}
constexpr int ATTN_LDS_BYTES=LDS_BYTES;
#undef SBAR
#undef WAIT_BAR
}

typedef GAS unsigned gu32;
#define RLX_AGENT __ATOMIC_RELAXED, __HIP_MEMORY_SCOPE_AGENT
#define LDS_WAIT() asm volatile("s_waitcnt lgkmcnt(0)" ::: "memory")
#define XB_TMO      128
#define XB_XCNT(j)  (256  + 64 * (j))
#define XB_XSUB(j)  (1280 + 64 * (j))
#define XB_XGEN(j)  (2304 + 64 * (j))
#define XB_TOP      3328
#define XB_TOPGEN   3392
#define XCD_BAR_WORDS 3456
#define XB_SPIN_CAP (1u << 18)
__device__ __forceinline__ unsigned xb_ld(unsigned* p)              { return __hip_atomic_load(p, __ATOMIC_RELAXED, __HIP_MEMORY_SCOPE_AGENT); }
__device__ __forceinline__ unsigned xb_add(unsigned* p, unsigned v) { return __hip_atomic_fetch_add(p, v, __ATOMIC_RELAXED, __HIP_MEMORY_SCOPE_AGENT); }
__device__ __forceinline__ unsigned xb_xcc_id() { return (unsigned)__builtin_amdgcn_s_getreg((3 << 11) | 20) & 0xFu; }
#define XB_SPIN(cond, bar) do { unsigned _sp = 0; while (cond) { __builtin_amdgcn_s_sleep(1); \
    if ((++_sp & 255u) == 0u) { if (xb_ld(&(bar)[XB_TMO])) break; if (_sp > XB_SPIN_CAP) { atomicAdd(&(bar)[XB_TMO], 1u); break; } } } } while (0)
struct XcdBarrier { unsigned* bar; unsigned x; volatile LAS unsigned* st; };
__device__ __forceinline__ XcdBarrier xcd_barrier_post(unsigned* bar, volatile LAS unsigned* st) {
    XcdBarrier b; b.bar = bar; b.x = xb_xcc_id(); b.st = st;
    if (threadIdx.x == 0) (void)xb_add(&bar[XB_XCNT(b.x)], 1u);
    return b;
}
__device__ __forceinline__ void xcd_barrier_complete(unsigned* bar, unsigned x, unsigned& nloc, unsigned& nx) {
    const unsigned G = gridDim.x * gridDim.y * gridDim.z;
    unsigned sum, cnt, mine, sp = 0u;
    for (;;) {
        sum = 0u; cnt = 0u; mine = 0u;
#pragma unroll
        for (unsigned j = 0; j < 16; ++j) { const unsigned c = xb_ld(&bar[XB_XCNT(j)]); sum += c; cnt += (c > 0u) ? 1u : 0u; mine = (j == x) ? c : mine; }
        if (sum == G) break;
        __builtin_amdgcn_s_sleep(1);
        if ((++sp & 255u) == 0u) { if (xb_ld(&bar[XB_TMO])) break; if (sp > XB_SPIN_CAP) { atomicAdd(&bar[XB_TMO], 1u); break; } }
    }
    nloc = mine > 0u ? mine : 1u; nx = cnt > 0u ? cnt : 1u;
}
__device__ __forceinline__ void xcd_barrier(const XcdBarrier& b) {
    asm volatile("s_waitcnt vmcnt(0)" ::: "memory");
    __syncthreads();
    if (threadIdx.x == 0) {
        unsigned* bar = b.bar; asm volatile("" : "+v"(bar));
        __builtin_amdgcn_s_waitcnt(0);
        unsigned nloc = b.st[0], nx = b.st[1];
        if (nloc == 0u) { xcd_barrier_complete(bar, b.x, nloc, nx); b.st[0] = nloc; b.st[1] = nx; }
        const unsigned old = xb_add(&bar[XB_XSUB(b.x)], 1u);
        const unsigned gen = old / nloc;
        if (old + 1u == (gen + 1u) * nloc) {
            __builtin_amdgcn_fence(__ATOMIC_RELEASE, "agent");
            asm volatile("s_waitcnt vmcnt(0)" ::: "memory");
            const unsigned og = xb_add(&bar[XB_TOP], 1u);
            const unsigned tg = og / nx;
            if (og + 1u == (tg + 1u) * nx) xb_add(&bar[XB_TOPGEN], 1u);
            else XB_SPIN(xb_ld(&bar[XB_TOPGEN]) == tg, bar);
            __builtin_amdgcn_fence(__ATOMIC_ACQUIRE, "agent");
            xb_add(&bar[XB_XGEN(b.x)], 1u);
            asm volatile("s_waitcnt vmcnt(0)" ::: "memory");
        } else {
            XB_SPIN(xb_ld(&bar[XB_XGEN(b.x)]) == gen, bar);
            __builtin_amdgcn_fence(__ATOMIC_ACQUIRE, "agent");
            asm volatile("s_waitcnt vmcnt(0)" ::: "memory");
        }
    }
    __syncthreads();
}

__device__ __forceinline__ float wave_sum(float v) {
#pragma unroll
    for (int o = 1; o < 64; o <<= 1) v += __shfl_xor(v, o);
    return v;
}
template <class F>
__device__ __forceinline__ void transpose_load(const float* W, int ld, int nrows, F srccol, int item, int lane, f32x4 (&v)[8]) {
    const int nblk = nrows / 32, kb = item / nblk, nb = item % nblk, k0 = 64 * kb, s0 = srccol(32 * nb);
#pragma unroll
    for (int i = 0; i < 8; ++i) v[i] = __builtin_nontemporal_load((const f32x4*)(W + (size_t)(k0 + 8 * i + (lane >> 3)) * ld + s0 + 4 * (lane & 7)));
}
__host__ __device__ __forceinline__ int perm32(int rho) { const int n = rho >> 4, i = rho & 15; return 8 * (i >> 2) + 4 * n + (i & 3); }
template <bool PERM>
__device__ __forceinline__ void transpose_store(int K, bf16_t* WT, int nrows, const float* gk, LAS float* scr, int item, int lane, const f32x4 (&v)[8]) {
    const int nblk = nrows / 32, kb = item / nblk, nb = item % nblk, k0 = 64 * kb, n0 = 32 * nb;
#pragma unroll
    for (int i = 0; i < 8; ++i) { const int kk = 8 * i + (lane >> 3); const float g = gk ? gk[k0 + kk] : 1.0f;
#pragma unroll
        for (int e = 0; e < 4; ++e) scr[kk * 33 + 4 * (lane & 7) + e] = v[i][e] * g; }
    LDS_WAIT(); asm volatile("" ::: "memory");
    const int c = lane & 7;
#pragma unroll
    for (int j = 0; j < 4; ++j) { const int n = (lane >> 3) + 8 * j; const LAS float* s = scr + (8 * c) * 33 + (PERM ? perm32(n) : n);
        u32x4 o; o.x = cvt_pk_bf16(s[0 * 33], s[1 * 33]); o.y = cvt_pk_bf16(s[2 * 33], s[3 * 33]); o.z = cvt_pk_bf16(s[4 * 33], s[5 * 33]); o.w = cvt_pk_bf16(s[6 * 33], s[7 * 33]);
        *(u32x4*)(WT + (size_t)(n0 + n) * K + k0 + 8 * c) = o; }
    LDS_WAIT(); asm volatile("" ::: "memory");
}
struct ColIdent { int off; __device__ __forceinline__ int operator()(int r) const { return off + r; } };
struct ColSwiglu { __device__ __forceinline__ int operator()(int r) const { return ((r >> 7) & 1) * DFF + (r >> 8) * 128 + (r & 127); } };
struct ColMix { __device__ __forceinline__ int operator()(int r) const {
    const int tile = r >> 8, p = r & 255, o = 64 * ((p >> 5) & 3) + 32 * (p >> 7) + (p & 31);
    if (tile < 16) return r;
    if (tile < 20) return 6144 + (tile - 16) * 256 + o;
    if (tile < 24) return 7168 + (tile - 20) * 256 + o;
    if (tile < 28) return 8192 + (tile - 24) * 256 + p;
    return 9216 + (tile - 28) * 256 + p; } };
template <bool PERM = false, class F>
__device__ __forceinline__ void transpose_all(const float* W, int K, int ld, bf16_t* WT, int nrows, F srccol, const float* gk, LAS float* scr, int gw, int ngw, int lane) {
    const int nitems = (K / 64) * (nrows / 32);
    for (int it = gw; it < nitems; it += 2 * ngw) {
        f32x4 va[8], vb[8]; const int it2 = it + ngw;
        transpose_load(W, ld, nrows, srccol, it, lane, va);
        if (it2 < nitems) transpose_load(W, ld, nrows, srccol, it2, lane, vb);
        transpose_store<PERM>(K, WT, nrows, gk, scr, it, lane, va);
        if (it2 < nitems) transpose_store<PERM>(K, WT, nrows, gk, scr, it2, lane, vb);
    }
}
__device__ __forceinline__ void rms_rows_to_bf16(const float* x, const float* gain, bf16_t* o, int m0, int step, int nrows, int lane) {
    const f32x4* gr = (const f32x4*)gain + lane;
    for (int m = m0; m < nrows; m += 2 * step) {
        const int m2 = (m + step < nrows) ? m + step : m;
        const f32x4* xa = (const f32x4*)(x + (size_t)m * DM) + lane; const f32x4* xb2 = (const f32x4*)(x + (size_t)m2 * DM) + lane;
        f32x4 va[4], vb[4]; float sa = 0.f, sb = 0.f;
#pragma unroll
        for (int j = 0; j < 4; ++j) { va[j] = __builtin_nontemporal_load(xa + 64 * j); vb[j] = __builtin_nontemporal_load(xb2 + 64 * j); }
#pragma unroll
        for (int j = 0; j < 4; ++j) { sa += (va[j][0] * va[j][0] + va[j][1] * va[j][1]) + (va[j][2] * va[j][2] + va[j][3] * va[j][3]); sb += (vb[j][0] * vb[j][0] + vb[j][1] * vb[j][1]) + (vb[j][2] * vb[j][2] + vb[j][3] * vb[j][3]); }
        const float ra = __builtin_amdgcn_rsqf(wave_sum(sa) * (1.f / 1024.f) + EPS), rb = __builtin_amdgcn_rsqf(wave_sum(sb) * (1.f / 1024.f) + EPS);
        u32x2* oa = (u32x2*)(o + (size_t)m * DM) + lane; u32x2* ob = (u32x2*)(o + (size_t)m2 * DM) + lane;
#pragma unroll
        for (int j = 0; j < 4; ++j) { const f32x4 g = gr[64 * j]; oa[64 * j] = pack4(va[j] * ra * g); if (m2 != m) ob[64 * j] = pack4(vb[j] * rb * g); }
    }
}
__device__ __forceinline__ void rot_table(const int* pos, float* rot, int gt, int ngt) {
    for (int idx = gt; idx < SEQ * 128; idx += ngt) {
        const int s = idx >> 7, i = idx & 127;
        const float inv = exp2f(-(float)i * (13.287712379549449f / 128.0f));
        const float ang = (float)pos[s] * inv;
        const float kq = rintf(ang * 0.6366197723675814f);
        float r = fmaf(-kq, 1.5703125f, ang); r = fmaf(-kq, 4.837512969970703125e-4f, r); r = fmaf(-kq, 7.54978995489188216e-8f, r);
        const float r2 = r * r;
        const float sn = r + r * r2 * (-1.6666667e-1f + r2 * (8.3333333e-3f + r2 * (-1.9841270e-4f + r2 * 2.7557319e-6f)));
        const float cn = 1.0f + r2 * (-0.5f + r2 * (4.1666668e-2f + r2 * (-1.3888889e-3f + r2 * (2.4801587e-5f + r2 * -2.7557319e-7f))));
        const int qd = ((int)kq) & 3;
        const float c = (qd == 0) ? cn : (qd == 1) ? -sn : (qd == 2) ? -cn : sn;
        const float sv = (qd == 0) ? sn : (qd == 1) ? cn : (qd == 2) ? -sn : -cn;
        *(f32x2*)(rot + (size_t)idx * 2) = (f32x2){c, sv};
    }
}

constexpr int SCN_LD = 136, SCN_V_OFF = 64 * SCN_LD * 2, SCN_CH = 192 * SCN_LD * 2;
constexpr unsigned SCAN_UNITS_PER_FLAG = 8;
__device__ __forceinline__ void scan_unit(int u, const bf16_t* kts, const bf16_t* vt, bf16_t* S, LAS unsigned char* lds, unsigned* done  ) {
    const int tid = opaque_tid(), lane = tid & 63, wave = __builtin_amdgcn_readfirstlane(tid >> 6);
    const int fr = lane & 15, fq = lane >> 4, h = u >> 4, dg = (u >> 2) & 3, eg = u & 3, wd = wave & 1, we = wave >> 1;
    const float gC = __builtin_amdgcn_exp2f(128.0f * log2f(1.0f - __builtin_amdgcn_exp2f(-5.0f - (float)h)));
    f32x4 acc[2][2];
#pragma unroll
    for (int a = 0; a < 2; ++a)
#pragma unroll
        for (int b = 0; b < 2; ++b) acc[a][b] = (f32x4){0.f, 0.f, 0.f, 0.f};
    const bf16_t* ksrc = kts + (size_t)(h * 256 + 64 * dg + (tid >> 4)) * SEQ + (tid & 15) * 8;
    const bf16_t* vsrc = vt + (size_t)(h * 512 + 128 * eg + (tid >> 4)) * SEQ + (tid & 15) * 8;
    u32x4 pk[2][2], pv[2][4];
#pragma unroll
    for (int i = 0; i < 2; ++i) {
#pragma unroll
        for (int j = 0; j < 2; ++j) pk[i][j] = *(const u32x4*)(ksrc + (size_t)(32 * j) * SEQ + i * 128);
#pragma unroll
        for (int j = 0; j < 4; ++j) pv[i][j] = *(const u32x4*)(vsrc + (size_t)(32 * j) * SEQ + i * 128);
    }
    bf16_t* sdst = S + ((size_t)(h * 16) * 512 + 128 * eg + 32 * we + fr) * 256 + 64 * dg + 32 * wd + 4 * fq;
#pragma unroll
    for (int r = 0; r < 8; ++r) {
        __syncthreads();
#pragma unroll
        for (int i = 0; i < 2; ++i) {
            if (2 * r + i < 15) {
                LAS bf16_t* lk = (LAS bf16_t*)(lds + i * SCN_CH); LAS bf16_t* lv = (LAS bf16_t*)(lds + i * SCN_CH + SCN_V_OFF);
#pragma unroll
                for (int j = 0; j < 2; ++j) *(LAS u32x4*)(lk + (32 * j + (tid >> 4)) * SCN_LD + (tid & 15) * 8) = pk[i][j];
#pragma unroll
                for (int j = 0; j < 4; ++j) *(LAS u32x4*)(lv + (32 * j + (tid >> 4)) * SCN_LD + (tid & 15) * 8) = pv[i][j];
            }
        }
        __syncthreads();
        if (r < 7) {
#pragma unroll
            for (int i = 0; i < 2; ++i) { const int c = 2 * (r + 1) + i;
                if (c < 15) {
#pragma unroll
                    for (int j = 0; j < 2; ++j) pk[i][j] = *(const u32x4*)(ksrc + (size_t)(32 * j) * SEQ + c * 128);
#pragma unroll
                    for (int j = 0; j < 4; ++j) pv[i][j] = *(const u32x4*)(vsrc + (size_t)(32 * j) * SEQ + c * 128);
                } }
        }
#pragma unroll
        for (int i = 0; i < 2; ++i) {
            const int c = 2 * r + i;
#pragma unroll
            for (int td = 0; td < 2; ++td)
#pragma unroll
                for (int te = 0; te < 2; ++te) { const u32x2 w = pack4(acc[td][te]);
                    __hip_atomic_store((unsigned long long*)(sdst + (size_t)c * 512 * 256 + (size_t)(16 * te) * 256 + 16 * td), ((unsigned long long)w.y << 32) | w.x, __ATOMIC_RELAXED, __HIP_MEMORY_SCOPE_AGENT); }
            if (c < 15) {
                const LAS bf16_t* lk = (const LAS bf16_t*)(lds + i * SCN_CH); const LAS bf16_t* lv = (const LAS bf16_t*)(lds + i * SCN_CH + SCN_V_OFF);
                f32x4 tm[2][2];
#pragma unroll
                for (int td = 0; td < 2; ++td)
#pragma unroll
                    for (int te = 0; te < 2; ++te) tm[td][te] = (f32x4){0.f, 0.f, 0.f, 0.f};
#pragma unroll
                for (int ks = 0; ks < 4; ++ks) {
                    bf16x8 a[2], b[2];
#pragma unroll
                    for (int t = 0; t < 2; ++t) { a[t] = *(const LAS bf16x8*)(lk + (32 * wd + 16 * t + fr) * SCN_LD + 32 * ks + 8 * fq); b[t] = *(const LAS bf16x8*)(lv + (32 * we + 16 * t + fr) * SCN_LD + 32 * ks + 8 * fq); }
#pragma unroll
                    for (int td = 0; td < 2; ++td)
#pragma unroll
                        for (int te = 0; te < 2; ++te) tm[td][te] = mfma16(a[td], b[te], tm[td][te]);
                }
#pragma unroll
                for (int td = 0; td < 2; ++td)
#pragma unroll
                    for (int te = 0; te < 2; ++te) acc[td][te] = acc[td][te] * gC + tm[td][te];
            }
        }
    }
    asm volatile("s_waitcnt vmcnt(0)" ::: "memory");
    __syncthreads();
    if (tid == 0) __hip_atomic_fetch_add(done + ((h * 2 + (eg >> 1)) * 64), 1u, __ATOMIC_RELAXED, __HIP_MEMORY_SCOPE_AGENT);
}
constexpr int RQ_LD = 264, SC_LD = 136, RO_SC_OFF = 128 * RQ_LD * 2, RO_PART_OFF = RO_SC_OFF + 128 * SC_LD * 2;
__device__ __forceinline__ void retout_unit(int h, int c, int eh, const bf16_t* q, const bf16_t* k, const bf16_t* vt, const bf16_t* S, bf16_t* ret  , float* rssq, LAS unsigned char* lds, unsigned* done, unsigned* tmo) {
    const int tid = opaque_tid(), lane = tid & 63, wave = __builtin_amdgcn_readfirstlane(tid >> 6);
    const int fr = lane & 15, fq = lane >> 4;
    LAS bf16_t* ql = (LAS bf16_t*)lds; LAS bf16_t* sc = (LAS bf16_t*)(lds + RO_SC_OFF); LAS float* part = (LAS float*)(lds + RO_PART_OFF);
    const float lg2 = log2f(1.0f - __builtin_amdgcn_exp2f(-5.0f - (float)h));
    const int tok0 = c * 128;
#pragma unroll
    for (int i = 0; i < 8; ++i) { const int p = tid + 512 * i, row = p >> 5, c16 = p & 31;
        *(LAS u32x4*)(ql + row * RQ_LD + c16 * 8) = *(const u32x4*)(q + (size_t)(tok0 + row) * 1024 + h * 256 + c16 * 8); }
    const bf16_t* sp = S + ((size_t)((h * 16 + c) * 512 + 256 * eh + 32 * wave + fr)) * 256 + 8 * fq;
    const bf16_t* vp = vt + (size_t)(h * 512 + 256 * eh + 32 * wave + fr) * SEQ + tok0 + 8 * fq;
    __syncthreads();
    {
        const int tj = wave;
        bf16x8 kf[8];
        const bf16_t* kp = k + (size_t)(tok0 + 16 * tj + fr) * 1024 + h * 256 + 8 * fq;
#pragma unroll
        for (int ks = 0; ks < 8; ++ks) kf[ks] = *(const bf16x8*)(kp + 32 * ks);
#pragma unroll
        for (int ti = 0; ti < 8; ++ti) {
            if (ti >= tj) {
                f32x4 s2 = (f32x4){0.f, 0.f, 0.f, 0.f};
#pragma unroll
                for (int ks = 0; ks < 8; ++ks) { const bf16x8 qf = *(const LAS bf16x8*)(ql + (16 * ti + fr) * RQ_LD + 32 * ks + 8 * fq); s2 = mfma16(kf[ks], qf, s2); }
                const int i = 16 * ti + fr; f32x4 v;
#pragma unroll
                for (int r = 0; r < 4; ++r) { const int j = 16 * tj + 4 * fq + r; v[r] = (i >= j) ? s2[r] * __builtin_amdgcn_exp2f(lg2 * (float)(i - j)) : 0.f; }
                *(LAS u32x2*)(sc + (16 * ti + fr) * SC_LD + 16 * tj + 4 * fq) = pack4(v);
            } else if (ti == tj - 1 && (tj & 1)) {
                *(LAS u32x2*)(sc + (16 * ti + fr) * SC_LD + 16 * tj + 4 * fq) = (u32x2){0u, 0u};
            }
        }
    }
    if (tid < 64) {
        unsigned* f = done + ((h * 2 + eh) * 64); unsigned sp = 0;
        while ((unsigned)__builtin_amdgcn_readfirstlane(__hip_atomic_load(f, __ATOMIC_RELAXED, __HIP_MEMORY_SCOPE_AGENT)) < SCAN_UNITS_PER_FLAG) {
            __builtin_amdgcn_s_sleep(2);
            if (++sp > (1u << 20)) { if (tid == 0) __hip_atomic_store(tmo, 1u, __ATOMIC_RELAXED, __HIP_MEMORY_SCOPE_AGENT); break; }
        }
        __builtin_amdgcn_fence(__ATOMIC_ACQUIRE, "agent");
        asm volatile("s_waitcnt vmcnt(0)" ::: "memory");
    }
    __syncthreads();
    f32x4 acc[8][2];
#pragma unroll
    for (int a = 0; a < 8; ++a)
#pragma unroll
        for (int b = 0; b < 2; ++b) acc[a][b] = (f32x4){0.f, 0.f, 0.f, 0.f};
#pragma unroll
    for (int ks = 0; ks < 8; ++ks) {
        bf16x8 sf[2], qf[8];
#pragma unroll
        for (int t = 0; t < 2; ++t) sf[t] = *(const bf16x8*)(sp + (size_t)(16 * t) * 256 + 32 * ks);
#pragma unroll
        for (int t = 0; t < 8; ++t) qf[t] = *(const LAS bf16x8*)(ql + (16 * t + fr) * RQ_LD + 32 * ks + 8 * fq);
#pragma unroll
        for (int a = 0; a < 8; ++a)
#pragma unroll
            for (int b = 0; b < 2; ++b) acc[a][b] = mfma16(sf[b], qf[a], acc[a][b]);
    }
#pragma unroll
    for (int a = 0; a < 8; ++a) { const float qd = __builtin_amdgcn_exp2f(lg2 * (float)(16 * a + fr + 1));
#pragma unroll
        for (int b = 0; b < 2; ++b) acc[a][b] = acc[a][b] * qd; }
#pragma unroll
    for (int ks = 0; ks < 4; ++ks) {
        bf16x8 vf[2];
#pragma unroll
        for (int t = 0; t < 2; ++t) vf[t] = *(const bf16x8*)(vp + (size_t)(16 * t) * SEQ + 32 * ks);
#pragma unroll
        for (int a = 0; a < 8; ++a) {
            if (a >= 2 * ks) {
                const bf16x8 pf = *(const LAS bf16x8*)(sc + (16 * a + fr) * SC_LD + 32 * ks + 8 * fq);
#pragma unroll
                for (int b = 0; b < 2; ++b) acc[a][b] = mfma16(vf[b], pf, acc[a][b]);
            }
        }
    }
#pragma unroll
    for (int a = 0; a < 8; ++a) {
        float ss = 0.f;
#pragma unroll
        for (int b = 0; b < 2; ++b) { const f32x4 t = acc[a][b]; ss += (t[0] * t[0] + t[1] * t[1]) + (t[2] * t[2] + t[3] * t[3]); }
        ss += __shfl_xor(ss, 16); ss += __shfl_xor(ss, 32);
        if (fq == 0) part[wave * 128 + 16 * a + fr] = ss;
    }
    __syncthreads();
    if (tid < 128) {
        float tot = 0.f;
#pragma unroll
        for (int w = 0; w < 8; ++w) tot += part[w * 128 + tid];
        rssq[(size_t)(tok0 + tid) * 8 + 2 * h + eh] = tot;
    }
#pragma unroll
    for (int a = 0; a < 8; ++a)
#pragma unroll
        for (int b = 0; b < 2; ++b)
            *(u32x2*)(ret + (size_t)(tok0 + 16 * a + fr) * 2048 + h * 512 + 256 * eh + 32 * wave + 16 * b + 4 * fq) = pack4(acc[a][b]);
    __syncthreads();
}
constexpr int PL_LD = 264, MA_KV_BYTES = 64 * 264 * 2, MA_P_OFF = MA_KV_BYTES;
__device__ __forceinline__ void memattn_unit(int b, int h, int rb, const bf16_t* mkn, const bf16_t* mvt, bf16_t* mo  , LAS unsigned char* lds) {
    const bf16_t* mq = mo;
    const int tid = opaque_tid(), lane = tid & 63, wave = __builtin_amdgcn_readfirstlane(tid >> 6);
    const int fr = lane & 15, fq = lane >> 4;
    LAS bf16_t* kv = (LAS bf16_t*)lds; LAS bf16_t* pl = (LAS bf16_t*)(lds + MA_P_OFF) + wave * (16 * PL_LD);
    const int row = 128 * rb + 16 * wave + fr;
    const bf16_t* ksrc = mkn + (size_t)(b * 256) * 1024 + h * 256;
    const bf16_t* vsrc = mvt + (size_t)((b * 4 + h) * 256) * 256;
    u32x4 pre[4];
#pragma unroll
    for (int i = 0; i < 4; ++i) { const int p = tid + 512 * i; pre[i] = *(const u32x4*)(ksrc + (size_t)(p >> 5) * 1024 + (p & 31) * 8); }
    bf16x8 qf[8]; float qs = 0.f;
#pragma unroll
    for (int ks = 0; ks < 8; ++ks) { qf[ks] = *(const bf16x8*)(mq + (size_t)row * 1024 + h * 256 + 32 * ks + 8 * fq);
#pragma unroll
        for (int j = 0; j < 8; ++j) { const float f = bf2f((unsigned short)qf[ks][j]); qs += f * f; } }
    qs += __shfl_xor(qs, 16); qs += __shfl_xor(qs, 32);
    const float scl = __builtin_amdgcn_rsqf(qs * (1.0f / 256.0f) + EPS) * (0.0625f * LOG2E);
    f32x4 sa[16];
#pragma unroll
    for (int kc = 0; kc < 4; ++kc) {
        __syncthreads();
#pragma unroll
        for (int i = 0; i < 4; ++i) { const int p = tid + 512 * i; *(LAS u32x4*)(kv + (p >> 5) * PL_LD + (p & 31) * 8) = pre[i]; }
        __syncthreads();
#pragma unroll
        for (int i = 0; i < 4; ++i) { const int p = tid + 512 * i;
            pre[i] = (kc < 3) ? *(const u32x4*)(ksrc + (size_t)(64 * (kc + 1) + (p >> 5)) * 1024 + (p & 31) * 8) : *(const u32x4*)(vsrc + (size_t)(p >> 5) * 256 + (p & 31) * 8); }
#pragma unroll
        for (int tl = 0; tl < 4; ++tl) {
            f32x4 a = (f32x4){0.f, 0.f, 0.f, 0.f};
#pragma unroll
            for (int ks = 0; ks < 8; ++ks) { const bf16x8 kf = *(const LAS bf16x8*)(kv + (16 * tl + fr) * PL_LD + 32 * ks + 8 * fq); a = mfma16(kf, qf[ks], a); }
            sa[4 * kc + tl] = a * scl;
        }
    }
    float mx = -INFINITY;
#pragma unroll
    for (int t = 0; t < 16; ++t) mx = fmaxf(mx, fmaxf(fmaxf(sa[t][0], sa[t][1]), fmaxf(sa[t][2], sa[t][3])));
    mx = fmaxf(mx, __shfl_xor(mx, 16)); mx = fmaxf(mx, __shfl_xor(mx, 32));
    float l = 0.f;
#pragma unroll
    for (int t = 0; t < 16; ++t) {
        f32x4 p;
#pragma unroll
        for (int r = 0; r < 4; ++r) { p[r] = __builtin_amdgcn_exp2f(sa[t][r] - mx); l += p[r]; }
        *(LAS u32x2*)(pl + fr * PL_LD + 16 * t + 4 * fq) = pack4(p);
    }
    l += __shfl_xor(l, 16); l += __shfl_xor(l, 32);
    const float rl = __builtin_amdgcn_rcpf(l);
    LDS_WAIT(); asm volatile("" ::: "memory");
    bf16x8 pf[8];
#pragma unroll
    for (int ks = 0; ks < 8; ++ks) pf[ks] = *(const LAS bf16x8*)(pl + fr * PL_LD + 32 * ks + 8 * fq);
#pragma unroll
    for (int dc = 0; dc < 4; ++dc) {
        __syncthreads();
#pragma unroll
        for (int i = 0; i < 4; ++i) { const int p = tid + 512 * i; *(LAS u32x4*)(kv + (p >> 5) * PL_LD + (p & 31) * 8) = pre[i]; }
        __syncthreads();
        if (dc < 3) {
#pragma unroll
            for (int i = 0; i < 4; ++i) { const int p = tid + 512 * i; pre[i] = *(const u32x4*)(vsrc + (size_t)(64 * (dc + 1) + (p >> 5)) * 256 + (p & 31) * 8); }
        }
#pragma unroll
        for (int tl = 0; tl < 4; ++tl) {
            f32x4 a = (f32x4){0.f, 0.f, 0.f, 0.f};
#pragma unroll
            for (int ks = 0; ks < 8; ++ks) { const bf16x8 vf = *(const LAS bf16x8*)(kv + (16 * tl + fr) * PL_LD + 32 * ks + 8 * fq); a = mfma16(vf, pf[ks], a); }
            *(u32x2*)(mo + (size_t)row * 1024 + h * 256 + 64 * dc + 16 * tl + 4 * fq) = pack4(a * rl);
        }
    }
    __syncthreads();
}
__device__ __forceinline__ void dif_row(const bf16_t* o0, const bf16_t* o1, bf16_t* dif, const float* gout, float lam, int lane) {
    const u32x4* a = (const u32x4*)o0 + 2 * lane; const u32x4* b = (const u32x4*)o1 + 2 * lane;
    float d[16]; float ss = 0.f;
#pragma unroll
    for (int v = 0; v < 2; ++v) { const u32x4 x = __builtin_nontemporal_load(a + v), y = __builtin_nontemporal_load(b + v);
#pragma unroll
        for (int w = 0; w < 4; ++w) { const float x0 = __uint_as_float(x[w] << 16), x1 = __uint_as_float(x[w] & 0xffff0000u), y0 = __uint_as_float(y[w] << 16), y1 = __uint_as_float(y[w] & 0xffff0000u);
            const float d0 = x0 - lam * y0, d1 = x1 - lam * y1; d[v * 8 + w * 2] = d0; d[v * 8 + w * 2 + 1] = d1; ss += d0 * d0 + d1 * d1; } }
    ss += __shfl_xor(ss, 1); ss += __shfl_xor(ss, 2); ss += __shfl_xor(ss, 4);
    const float rn = __builtin_amdgcn_rsqf(ss * (1.0f / 128.0f) + EPS) * (1.0f - LAM_INIT);
    const float* gp = gout + (lane & 7) * 16;
    u32x4 o[2];
#pragma unroll
    for (int v = 0; v < 2; ++v)
#pragma unroll
        for (int w = 0; w < 4; ++w) o[v][w] = cvt_pk_bf16(d[v * 8 + w * 2] * rn * gp[v * 8 + w * 2], d[v * 8 + w * 2 + 1] * rn * gp[v * 8 + w * 2 + 1]);
    u32x4* op = (u32x4*)dif + 2 * lane; op[0] = o[0]; op[1] = o[1];
}

struct P4bOrder {
    pg8::StaticOrder T; unsigned char* ws;
    __device__ __forceinline__ bool next(int i, pg8::Unit& u) const {
        int pm, pn; if (!T.tile(i, pm, pn)) return false;
        u.pm = pm; u.pn = pn; u.ui = i; u.ri = i; u.tag = 0; u.K = 1024;
        u.A = (const char*)ws + WS_XB + (size_t)pm * 256 * 1024 * 2;
        u.Bt = (const char*)ws + (pn < 8 ? WS_WRG + (size_t)pn * 256 * 1024 * 2 : WS_WGATE + (size_t)(pn - 8) * 256 * 1024 * 2); return true;
    }
};
struct P5Order {
    pg8::StaticOrder T; unsigned char* ws;
    __device__ __forceinline__ bool next(int i, pg8::Unit& u) const {
        const int ti = i / 3, kbr = i - 3 * ti; int pm, pn; if (!T.tile(ti, pm, pn)) return false;
        const size_t offA = kbr == 0 ? WS_RET : kbr == 1 ? WS_DIF : WS_MO;
        const size_t offB = kbr == 0 ? WS_WBRR : kbr == 1 ? WS_WBRD : WS_WBRM;
        const int K = kbr == 0 ? 2048 : 1024;
        u.pm = pm; u.pn = pn; u.ui = i; u.ri = ti; u.tag = kbr; u.K = K;
        u.A = (const char*)ws + offA + (size_t)pm * 256 * K * 2; u.Bt = (const char*)ws + offB + (size_t)pn * 256 * K * 2; return true;
    }
};
#ifndef PH_MASK
#define PH_MASK 0xffffffffu
#endif
#define PH(n) ((PH_MASK >> (n)) & 1u)
#ifndef DUP_MASK
#define DUP_MASK 0u
#endif
#ifndef PROBE_K
#define PROBE_K (-1)
#endif
#define RUNP(k) (pass_ == 1 || (k) <= PROBE_K)
#define REP(n) _Pragma("unroll 1") for (int rep_ = 0; rep_ < 1 + (int)((DUP_MASK >> (n)) & 1u); ++rep_)
struct Args { const void* in[26]; float* out; unsigned char* ws; };
#define CAS __attribute__((address_space(4)))
__device__ __forceinline__ const void* karg(int i) { typedef const GAS void* gptr; const CAS gptr* p = (const CAS gptr*)__builtin_amdgcn_kernarg_segment_ptr(); asm volatile("" : "+s"(p)); return (const void*)p[i]; }
#define INP(i) ((const float*)karg(i))
#define WSP(T, off) ((T*)((unsigned char*)karg(27) + (off)))
#define OUTP ((float*)karg(26))
__global__ void __launch_bounds__(NWAVES * 64, 2) mk_fwd(Args args) {
    extern __shared__ __attribute__((aligned(16))) unsigned char lds_raw[];
    LAS unsigned char* lds = (LAS unsigned char*)lds_raw;
    volatile LAS unsigned* MISC = (volatile LAS unsigned*)(lds + MISC_OFF);
    const int G = gridDim.x, bx = blockIdx.x;
    for (int u = threadIdx.x; u < (LDS_BYTES - LDSCTL_OFF) / 4; u += NWAVES * 64) ((LAS unsigned*)(lds + LDSCTL_OFF))[u] = 0u;
    __syncthreads();
    (void)xcd_barrier_post((unsigned*)WSP(unsigned, WS_CTL) + CW_BAR, MISC + 8);
#define GRID_BAR() do { XcdBarrier b_; b_.bar = (unsigned*)WSP(unsigned, WS_CTL) + CW_BAR; b_.x = xb_xcc_id(); b_.st = (volatile LAS unsigned*)(lds + MISC_OFF) + 8; xcd_barrier(b_); } while (0)
    const int NGW = G * NWAVES, NGT = G * NWAVES * 64;
#define LANE_VARS() const int tid = opaque_tid(), lane = tid & 63, wave = __builtin_amdgcn_readfirstlane(tid >> 6); LAS float* scr = (LAS float*)(lds + wave * 16384); \
    const int gw = bx * NWAVES + wave, gt = bx * (NWAVES * 64) + tid; (void)scr; (void)gw; (void)gt; (void)lane

#pragma unroll 1
    for (int pass_ = (PROBE_K >= 0 ? 0 : 1); pass_ < 2; ++pass_) {
    if (RUNP(0)) {
    REP(0) if (PH(0)) {
        LANE_VARS();
        transpose_all<true>(INP(4), 1024, 2 * DFF, WSP(bf16_t, WS_WF1I), 2 * DFF, ColSwiglu{}, nullptr, scr, gw, NGW, lane);
        transpose_all(INP(18), 1024, 2048, WSP(bf16_t, WS_WMKV), 2048, ColIdent{0}, nullptr, scr, gw, NGW, lane);
        { const float* x = INP(0); const float* g1 = INP(3); bf16_t* xb = WSP(bf16_t, WS_XBL);
          rms_rows_to_bf16(x, g1, xb, gw, NGW, TOK, lane); }
        { const float* mem = INP(1); const float* gm = INP(17); bf16_t* memn = WSP(bf16_t, WS_MEMN);
          rms_rows_to_bf16(mem, gm, memn, gw, NGW, NB * MEML, lane); }
        rot_table((const int*)karg(2), WSP(float, WS_ROT), gt, NGT);
    }
    GRID_BAR();
    }

    if (RUNP(1)) {
    REP(1) if (PH(1)) {
        pg8::Gemm g{WSP(bf16_t, WS_XBL), WSP(bf16_t, WS_WF1I), TOK, 2 * DFF, 1024}; pg8::StaticOrder S; S.init(TOK, 2 * DFF, G, bx);
        EpiSwiglu E{WSP(bf16_t, WS_ACT), nullptr};
        S.set(g); pg8::gemm_phase(lds, S, E);
    }
    if (PH(2)) {
        pg8::Gemm g{WSP(bf16_t, WS_MEMN), WSP(bf16_t, WS_WMKV), NB * MEML, 2048, 1024}; pg8::StaticOrder S; S.init(NB * MEML, 2048, G, (bx + G / 2) % G);
        EpiPlain E{WSP(bf16_t, WS_MKVRAW), 2048};
        S.set(g); pg8::gemm_phase(lds, S, E);
    }
    if (PH(0)) {
        const int q0 = (3 * G) / 4, nq = G - q0;
        if (bx >= q0) {
            LANE_VARS();
            const int gw2 = (bx - q0) * NWAVES + wave, ngw2 = nq * NWAVES;
            transpose_all(INP(5), DFF, 1024, WSP(bf16_t, WS_WF1O), 1024, ColIdent{0}, nullptr, scr, gw2, ngw2, lane);
            transpose_all<true>(INP(7), 1024, 13312, WSP(bf16_t, WS_WMIX), NMIX, ColMix{}, INP(6), scr, gw2, ngw2, lane);
        }
    }
    GRID_BAR();
    }

    if (RUNP(2)) {
    REP(3) if (PH(3)) {
        pg8::Gemm g{WSP(bf16_t, WS_ACT), WSP(bf16_t, WS_WF1O), TOK, 1024, DFF}; pg8::StaticOrder S; S.init(TOK, 1024, G, bx);
        EpiResid E{INP(0), OUTP, WSP(bf16_t, WS_XBL), WSP(float, WS_SSQ1), 0.5f, (rep_ == 1 && ((DUP_MASK >> 23) & 1u)) ? 1 : 0};
        S.set(g); pg8::gemm_phase(lds, S, E);
    }
    if (PH(0)) {
        LANE_VARS();
        const bf16_t* mkvraw = WSP(bf16_t, WS_MKVRAW); bf16_t* mkn = WSP(bf16_t, WS_MKN); bf16_t* mvt = WSP(bf16_t, WS_MVT);
        const float* g_mem_k = INP(16); const float* g_mem_q = INP(15);
        for (int j = gw; j < NB * MEML * 4; j += NGW) {
            const int row = j >> 2, h = j & 3;
            const u32x2 w = *((const u32x2*)(mkvraw + (size_t)row * 2048 + h * 256) + lane);
            f32x4 v = (f32x4){__uint_as_float(w.x << 16), __uint_as_float(w.x & 0xffff0000u), __uint_as_float(w.y << 16), __uint_as_float(w.y & 0xffff0000u)};
            const float ss = wave_sum((v[0] * v[0] + v[1] * v[1]) + (v[2] * v[2] + v[3] * v[3]));
            const float rn = __builtin_amdgcn_rsqf(ss * (1.0f / 256.0f) + EPS);
            const f32x4 gk = *((const f32x4*)g_mem_k + lane), gq = *((const f32x4*)g_mem_q + lane);
            *((u32x2*)(mkn + (size_t)row * 1024 + h * 256) + lane) = pack4(v * rn * gk * gq);
        }
        for (int idx = gt; idx < NB * 4 * 256 * 256; idx += NGT) {
            const int key = idx & 255, d = (idx >> 8) & 255, bh = idx >> 16, b = bh >> 2, h = bh & 3;
            mvt[idx] = mkvraw[(size_t)(b * 256 + key) * 2048 + 1024 + h * 256 + d];
        }
    }
    GRID_BAR();
    }

    if (RUNP(3))
    for (int ph = 0; ph <= NB; ++ph) {
        const int gp = ph, gm = ph - 1;
        unsigned char* const wsP = WSP(unsigned char, 0) - (((gp + 1) & 1) ? SET_DELTA : 0);
        unsigned char* const wsB = WSP(unsigned char, 0) - (((gm + 1) & 1) ? SET_DELTA : 0);
        unsigned* done = (unsigned*)WSP(unsigned, WS_CTL) + CW_SCAN + ((pass_ * NB + (gm < 0 ? 0 : gm)) * 8) * 64; unsigned* tmo = (unsigned*)WSP(unsigned, WS_CTL) + CW_BAR + XB_TMO;
        if (gm >= 0)
            for (int u = bx; u < 64; u += G) { __syncthreads(); if (PH(5)) scan_unit(u, (const bf16_t*)(wsB + WS_KTS), (const bf16_t*)(wsB + WS_VT), WSP(bf16_t, WS_S), lds, done); }
        if (gp < NB) {
            REP(4) if (PH(4)) {
                pg8::Gemm g{WSP(bf16_t, WS_XBL) + (size_t)gp * SEQ * DM, WSP(bf16_t, WS_WMIX), SEQ, NMIX, 1024}; pg8::StaticOrder S; S.init(SEQ, NMIX, G, bx);
                prep_rs(WSP(float, WS_SSQ1), gp * SEQ, S, lds);
                EpiMix E{(const LAS float*)(lds + RTAB_OFF), WSP(float, (gp & 1) ? WS_ROTB : WS_ROT), wsP, WSP(bf16_t, WS_MO) + (size_t)gp * SEQ * 1024, INP(8), INP(9)};
                S.set(g); pg8::gemm_phase(lds, S, E);
            }
        }
        if (gm >= 0) {
            const size_t oOff = (gm & 1) ? WS_OB : 0;
            unsigned* qctr = (unsigned*)WSP(unsigned, WS_CTL) + CW_QUEUE + (pass_ * NB + gm) * 64;
            volatile LAS unsigned* qslot = (volatile LAS unsigned*)(lds + MISC_OFF) + 16;
            for (;;) {
                __syncthreads();
                if (threadIdx.x == 0) qslot[0] = __hip_atomic_fetch_add(qctr, 1u, __ATOMIC_RELAXED, __HIP_MEMORY_SCOPE_AGENT);
                __syncthreads();
                const int id = __builtin_amdgcn_readfirstlane((int)qslot[0]);
                if (id >= 448) break;
                int aq = -1, aj = 0;
                if (id < 64) { aq = 7 - (id >> 5); aj = id & 31; }
                else if (id < 192) { const int ro = id - 64;
                    if (PH(8)) retout_unit(ro >> 5, (ro >> 1) & 15, ro & 1, (const bf16_t*)(wsB + WS_Q), (const bf16_t*)(wsB + WS_K), (const bf16_t*)(wsB + WS_VT), WSP(bf16_t, WS_S),
                                           WSP(bf16_t, WS_RET) + (size_t)gm * SEQ * 2048, WSP(float, WS_SSQ2) + (size_t)gm * SEQ * 8, lds, done, tmo); }
                else if (id < 224) { aq = 5; aj = id - 192; }
                else if (id < 288) { const int m = id - 224;
                    if (PH(7)) memattn_unit(gm, m >> 4, m & 15, WSP(bf16_t, WS_MKN), WSP(bf16_t, WS_MVT), WSP(bf16_t, WS_MO) + (size_t)gm * SEQ * 1024, lds); }
                else { aq = 4 - ((id - 288) >> 5); aj = (id - 288) & 31; }
                if (aq >= 0) {
                    const int hc = aj >> 1, vh = aj & 1, hh = hc >> 1, cc = hc & 1;
                    if (PH(6)) attn_body::attn_unit<8>(hc, 2 * hh + vh, aq, (const attn_body::bf16*)(wsB + WS_DQ), (const attn_body::bf16*)(wsB + WS_DK), (const attn_body::bf16*)(wsB + WS_DV),
                                            WSP(attn_body::bf16, (cc ? WS_O1 : WS_O0) + oOff), (char*)lds_raw);
                }
            }
        }
        {
            LANE_VARS();
            if (ph >= 2) {
                const int gd = ph - 2; const size_t oD = (gd & 1) ? WS_OB : 0;
                const float s1 = wave_sum(INP(10)[lane] * INP(11)[lane]), s2 = wave_sum(INP(12)[lane] * INP(13)[lane]); const float lam = __expf(s1) - __expf(s2) + LAM_INIT;
                const bf16_t* bo0 = WSP(bf16_t, WS_O0 + oD); const bf16_t* bo1 = WSP(bf16_t, WS_O1 + oD); bf16_t* difb = WSP(bf16_t, WS_DIF); const float* gdo = INP(14);
                for (int r = gw; r < SEQ; r += NGW) dif_row(bo0 + (size_t)r * 1024, bo1 + (size_t)r * 1024, difb + ((size_t)gd * SEQ + r) * 1024, gdo, lam, lane);
            }
            if (ph + 1 < NB) rot_table((const int*)karg(2) + (ph + 1) * SEQ, WSP(float, ((ph + 1) & 1) ? WS_ROTB : WS_ROT), gt, NGT);
            if (ph == 0) transpose_all<true>(INP(7), 1024, 13312, WSP(bf16_t, WS_WRG), 2048, ColIdent{4096}, INP(6), scr, gw, NGW, lane);
            if (ph == NB) {
                transpose_all<true>(INP(7), 1024, 13312, WSP(bf16_t, WS_WGATE), 3072, ColIdent{10240}, INP(6), scr, gw, NGW, lane);
                const float* x1 = OUTP; bf16_t* xb = WSP(bf16_t, WS_XB);
                for (int r = gw; r < TOK; r += NGW) {
                    const f32x4* xr = (const f32x4*)(x1 + (size_t)r * DM) + lane; u32x2* o8 = (u32x2*)(xb + (size_t)r * DM) + lane; f32x4 v[4];
#pragma unroll
                    for (int jj = 0; jj < 4; ++jj) v[jj] = __builtin_nontemporal_load(xr + 64 * jj);
#pragma unroll
                    for (int jj = 0; jj < 4; ++jj) o8[64 * jj] = pack4(v[jj]);
                }
            }
        }
        GRID_BAR();
    }

    if (RUNP(4)) {
    if (PH(9)) {
        pg8::StaticOrder T; T.init(TOK, 5120, G, bx);
        prep_rs(WSP(float, WS_SSQ1), 0, T, lds);
        P4bOrder S{T, WSP(unsigned char, 0)};
        EpiRgG E{(const LAS float*)(lds + RTAB_OFF), WSP(bf16_t, WS_RET), WSP(float, WS_SSQ2), WSP(unsigned char, 0)};
        pg8::gemm_phase(lds, S, E);
    }
    if (PH(0)) {
        LANE_VARS();
        { const float s1 = wave_sum(INP(10)[lane] * INP(11)[lane]), s2 = wave_sum(INP(12)[lane] * INP(13)[lane]); const float lam = __expf(s1) - __expf(s2) + LAM_INIT;
          const bf16_t* bo0 = WSP(bf16_t, WS_O0 + (((NB - 1) & 1) ? WS_OB : 0)); const bf16_t* bo1 = WSP(bf16_t, WS_O1 + (((NB - 1) & 1) ? WS_OB : 0)); bf16_t* difb = WSP(bf16_t, WS_DIF); const float* gdo = INP(14);
          for (int r = gw; r < SEQ; r += NGW) dif_row(bo0 + (size_t)r * 1024, bo1 + (size_t)r * 1024, difb + ((size_t)(NB - 1) * SEQ + r) * 1024, gdo, lam, lane); }
        transpose_all<true>(INP(19), 2048, 1024, WSP(bf16_t, WS_WBRR), 1024, ColIdent{0}, nullptr, scr, gw, NGW, lane);
        transpose_all<true>(INP(20), 1024, 1024, WSP(bf16_t, WS_WBRD), 1024, ColIdent{0}, nullptr, scr, gw, NGW, lane);
        transpose_all<true>(INP(21), 1024, 1024, WSP(bf16_t, WS_WBRM), 1024, ColIdent{0}, nullptr, scr, gw, NGW, lane);
        transpose_all(INP(22), 1024, 1024, WSP(bf16_t, WS_WO), 1024, ColIdent{0}, nullptr, scr, gw, NGW, lane);
    }
    GRID_BAR();
    }

    if (RUNP(5)) {
    REP(10) if (PH(10)) {
        pg8::StaticOrder T; T.init(TOK, 1024, G, bx);
        P5Order S{T, WSP(unsigned char, 0)};
        EpiTerm3 E{WSP(unsigned char, 0), WSP(bf16_t, WS_Y)};
        pg8::gemm_phase(lds, S, E);
    }
    GRID_BAR();
    }

    if (RUNP(6)) {
    if (PH(11)) {
        pg8::Gemm g{WSP(bf16_t, WS_Y), WSP(bf16_t, WS_WO), TOK, 1024, 1024}; pg8::StaticOrder S; S.init(TOK, 1024, G, bx);
        EpiResid E{OUTP, OUTP, WSP(bf16_t, WS_X2B), WSP(float, WS_SSQ2), 1.0f, 0};
        S.set(g); pg8::gemm_phase(lds, S, E);
    }
    if (PH(0)) {
        LANE_VARS();
        transpose_all<true>(INP(24), 1024, 2 * DFF, WSP(bf16_t, WS_WF2I), 2 * DFF, ColSwiglu{}, INP(23), scr, gw, NGW, lane);
        transpose_all(INP(25), DFF, 1024, WSP(bf16_t, WS_WF2O), 1024, ColIdent{0}, nullptr, scr, gw, NGW, lane);
    }
    GRID_BAR();
    }

    if (RUNP(7)) {
    if (PH(12)) {
        pg8::Gemm g{WSP(bf16_t, WS_X2B), WSP(bf16_t, WS_WF2I), TOK, 2 * DFF, 1024}; pg8::StaticOrder S; S.init(TOK, 2 * DFF, G, bx);
        prep_rs(WSP(float, WS_SSQ2), 0, S, lds);
        EpiSwiglu E{WSP(bf16_t, WS_ACT2), (const LAS float*)(lds + RTAB_OFF)};
        S.set(g); pg8::gemm_phase(lds, S, E);
    }
    GRID_BAR();
    }

    if (RUNP(8))
    if (PH(13)) {
        pg8::Gemm g{WSP(bf16_t, WS_ACT2), WSP(bf16_t, WS_WF2O), TOK, 1024, DFF}; pg8::StaticOrder S; S.init(TOK, 1024, G, bx);
        EpiResid E{OUTP, OUTP, nullptr, nullptr, 0.5f, 0};
        S.set(g); pg8::gemm_phase(lds, S, E);
    }
    if (pass_ == 0) GRID_BAR();
    }
}

extern "C" void kernel_launch(void* const* d_in, const int* in_sizes, int n_in, void* d_out, int out_size, void* d_ws, size_t ws_size, hipStream_t stream) {
    static int grid = 0;
    if (grid == 0) {
        if (n_in != 26 || ws_size < WS_END) { fprintf(stderr, "kernel_launch: unexpected inputs (n_in %d, ws %zu)\n", n_in, ws_size); grid = -1; return; }
        int dev = 0, cus = 0;
        if (hipGetDevice(&dev) != hipSuccess || hipDeviceGetAttribute(&cus, hipDeviceAttributeMultiprocessorCount, dev) != hipSuccess) { grid = -1; return; }
        if (hipFuncSetAttribute((const void*)mk_fwd, hipFuncAttributeMaxDynamicSharedMemorySize, LDS_BYTES) != hipSuccess) { fprintf(stderr, "kernel_launch: hipFuncSetAttribute failed\n"); grid = -1; return; }
        grid = cus;
    }
    if (grid < 0) return;
    (void)hipMemsetAsync((char*)d_ws + WS_CTL, 0, CTL_ZERO_BYTES, stream);
    Args a{};
    for (int i = 0; i < 26; ++i) a.in[i] = d_in[i];
    a.out = (float*)d_out; a.ws = (unsigned char*)d_ws;
    hipLaunchKernelGGL(mk_fwd, dim3(grid), dim3(NWAVES * 64), LDS_BYTES, stream, a);
}
```

```cpp
#include <hip/hip_runtime.h>
#include <cstdio>
#include <cstdint>

#define LAS __attribute__((address_space(3)))
#define GAS __attribute__((address_space(1)))
typedef unsigned short bf16_t;
typedef short bf16x8 __attribute__((ext_vector_type(8)));
typedef float f32x4 __attribute__((ext_vector_type(4)));
typedef float f32x2 __attribute__((ext_vector_type(2)));
typedef unsigned u32x4 __attribute__((ext_vector_type(4)));
typedef unsigned u32x2 __attribute__((ext_vector_type(2)));

constexpr int NB = 8, SEQ = 2048, DM = 1024, TOK = NB * SEQ, MEML = 256, DFF = 2816;
constexpr int NMIX = 8192;
constexpr float EPS = 1e-6f;
constexpr float LOG2E = 1.4426950408889634f;
constexpr float C2Q = 0.125f * LOG2E;
constexpr float LAM_INIT = 0.2f;

constexpr size_t MiB = 1u << 20;
constexpr size_t KiB = 1u << 10;
constexpr size_t WS_CTL = 0, CTL_ZERO_BYTES = 256 * KiB;
constexpr size_t WS_SSQ1 = 256 * KiB, WS_SSQ2 = 512 * KiB;
constexpr size_t WS_ROT = 1 * MiB, WS_ROTB = 153 * MiB;
constexpr size_t WS_MKN = 3 * MiB, WS_MVT = 7 * MiB;
constexpr size_t WS_WMIX = 11 * MiB;
constexpr size_t WS_XB = 27 * MiB;
constexpr size_t WS_RET = 59 * MiB;
constexpr size_t WS_XBL = 91 * MiB;
constexpr size_t WS_DIF = 123 * MiB;
constexpr size_t WS_MO = 155 * MiB;
constexpr size_t WS_Q = 187 * MiB, WS_K = 191 * MiB, WS_KTS = 195 * MiB, WS_VT = 199 * MiB, WS_DQ = 207 * MiB, WS_DK = 211 * MiB,
                 WS_DV = 215 * MiB;
constexpr size_t SET_DELTA = 160 * MiB;
constexpr size_t WS_WRG = 219 * MiB;
constexpr size_t WS_O0 = 223 * MiB, WS_O1 = 227 * MiB, WS_S = 231 * MiB;
constexpr size_t WS_OB = 24 * MiB;
constexpr size_t WS_WF1I = 59 * MiB, WS_WF1O = 70 * MiB;
constexpr size_t WS_MEMN = 76 * MiB, WS_MKVRAW = 80 * MiB, WS_WMKV = 27 * MiB;
constexpr size_t WS_ACT = 155 * MiB;
constexpr size_t WS_WGATE = 11 * MiB, WS_WBRR = 17 * MiB, WS_WBRD = 21 * MiB, WS_WBRM = 23 * MiB, WS_WO = 25 * MiB;
constexpr size_t WS_G8A = 187 * MiB, WS_G8B = 203 * MiB, WS_G8C = 223 * MiB;
constexpr size_t WS_Y = 27 * MiB;
constexpr size_t WS_X2B = 187 * MiB;
constexpr size_t WS_WF2I = 59 * MiB, WS_WF2O = 70 * MiB, WS_ACT2 = 76 * MiB;
constexpr size_t WS_END = 256 * MiB;

constexpr int CW_BAR = 4096, CW_BAR2 = 8192;
constexpr int CW_QUEUE = 32768;
constexpr int CW_SCAN = 16384;

constexpr int RING_BYTES = 131072, LDSCTL_OFF = RING_BYTES, MISC_OFF = LDSCTL_OFF + 320, LDS_BYTES = 147456;
constexpr int NWAVES = 8;

__device__ __forceinline__ unsigned cvt_pk_bf16(float lo, float hi) { unsigned r; asm volatile("v_cvt_pk_bf16_f32 %0, %1, %2" : "=v"(r) : "v"(lo), "v"(hi)); return r; }
__device__ __forceinline__ u32x2 pack4(f32x4 v) { u32x2 w; w.x = cvt_pk_bf16(v[0], v[1]); w.y = cvt_pk_bf16(v[2], v[3]); return w; }
__device__ __forceinline__ unsigned short bf16_1(float v) { return (unsigned short)(cvt_pk_bf16(v, 0.f) & 0xffffu); }
__device__ __forceinline__ float bf2f(unsigned short b) { return __uint_as_float(((unsigned)b) << 16); }
__device__ __forceinline__ float siluf(float x) { return x * __builtin_amdgcn_rcpf(1.0f + __builtin_amdgcn_exp2f(-x * LOG2E)); }
__device__ __forceinline__ float sigmf(float x) { return __builtin_amdgcn_rcpf(1.0f + __builtin_amdgcn_exp2f(-x * LOG2E)); }
__device__ __forceinline__ float row_rs(const float* ssq, int row) {
    const f32x4 a = *(const f32x4*)(ssq + (size_t)row * 4);
    return __builtin_amdgcn_rsqf(((a[0] + a[1]) + (a[2] + a[3])) * (1.0f / 1024.0f) + EPS);
}
__device__ __forceinline__ int opaque_tid() { int t = threadIdx.x; asm volatile("" : "+v"(t)); return t; }
__device__ __forceinline__ f32x4 mfma16(bf16x8 a, bf16x8 b, f32x4 c) { return __builtin_amdgcn_mfma_f32_16x16x32_bf16(a, b, c, 0, 0, 0); }

namespace pg8 {
constexpr int BM = 256, BK = 64, HALF = 128, HTB = HALF * BK * 2, STAGE_BYTES = 8 * HTB, NXCD = 8, WGM = 8;
__host__ __device__ __forceinline__ int lds_byte(int r, int c) { const int st = (r >> 4) * 2 + (c >> 5), rr = r & 15, cc = c & 31, ob = rr * 64 + cc * 2; return st * 1024 + (ob ^ (((ob >> 9) & 1) << 5)); }
__host__ __device__ __forceinline__ void stage_rc(int b, int& R, int& C) { const int st = b / 1024, sb = b % 1024, swz = sb ^ (((sb >> 9) & 1) << 5); R = (st >> 1) * 16 + swz / 64; C = (st & 1) * 32 + (swz % 64) / 2; }
struct Unit { int pm, pn, ui, ri, tag, K; const char* A; const char* Bt; };
struct Gemm { const bf16_t* A; const bf16_t* Bt; int M, N, K; };
struct StaticOrder {
    int nM, nN, nwg, G, c; Gemm g;
    __host__ __device__ void init(int M, int N, int G_, int c_) { nM = M / BM; nN = N / BM; nwg = nM * nN; G = G_; c = c_; g.A = nullptr; g.Bt = nullptr; g.M = M; g.N = N; g.K = 0; }
    __host__ __device__ void set(const Gemm& g_) { g = g_; }
    __host__ __device__ bool tile(int i, int& pm, int& pn) const {
        const long L = (long)i * G + c; if (L >= nwg) return false;
        int wgid = (int)L; { const int q = nwg / NXCD, r = nwg % NXCD, xcd = wgid % NXCD, off = wgid / NXCD; wgid = (xcd < r ? xcd * (q + 1) : r * (q + 1) + (xcd - r) * q) + off; }
        const int nig = WGM * nN, gid = wgid / nig, fm = gid * WGM, gsz = (nM - fm) < WGM ? (nM - fm) : WGM;
        pm = fm + ((wgid % nig) % gsz); pn = (wgid % nig) / gsz; return true;
    }
    __host__ __device__ bool next(int i, Unit& u) const {
        if (!tile(i, u.pm, u.pn)) return false;
        u.ui = i; u.ri = i; u.tag = 0; u.K = g.K;
        u.A = (const char*)g.A + (size_t)u.pm * 256 * g.K * 2; u.Bt = (const char*)g.Bt + (size_t)u.pn * 256 * g.K * 2; return true;
    }
};
struct NoHook { __device__ __forceinline__ void wait() const {} };
template <class Epi, class Sched, class Hook = NoHook>
__device__ __forceinline__ void gemm_phase(LAS unsigned char* lds, const Sched& S, const Epi& E, const Hook& H = Hook{}) {
    const int tid = opaque_tid(), wid = __builtin_amdgcn_readfirstlane(tid >> 6), lane = tid & 63, wr = wid >> 2, wc = wid & 3, fr = lane & 15, fq = lane >> 4;
    unsigned R2[2], C2[2];
#pragma unroll
    for (int i = 0; i < 2; ++i) { int R, C; stage_rc(tid * 16 + i * 8192, R, C); R2[i] = (unsigned)R * 2u; C2[i] = (unsigned)C * 2u; }
    const size_t kstep = (size_t)(BK * 2);
    const unsigned ldsw = (unsigned)wid * 1024u;
    const int aoff = lds_byte(wr * 64 + fr, fq * 8), boff = lds_byte(wc * 32 + fr, fq * 8);
#define PG8_SA(b, h) (((b) * 2 + (h)) * HTB)
#define PG8_SB(b, h) ((4 + (b) * 2 + (h)) * HTB)
#define PG8_STAGE(bufoff, gbase, voff) do { _Pragma("unroll") for (int _i = 0; _i < 2; ++_i) \
        __builtin_amdgcn_global_load_lds((const unsigned*)((const char*)(gbase) + (voff)[_i]), (LAS unsigned*)(lds + (bufoff) + ldsw + _i * 8192), 16, 0, 0); } while (0)
#define PG8_LDA(dst, b, h) do { _Pragma("unroll") for (int m = 0; m < 4; ++m) _Pragma("unroll") for (int k = 0; k < 2; ++k) dst[m][k] = *(const LAS bf16x8*)(lds + PG8_SA(b, h) + aoff + m * 2048 + k * 1024); } while (0)
#define PG8_LDB(dst, b, h) do { _Pragma("unroll") for (int n = 0; n < 2; ++n) _Pragma("unroll") for (int k = 0; k < 2; ++k) dst[n][k] = *(const LAS bf16x8*)(lds + PG8_SB(b, h) + boff + n * 2048 + k * 1024); } while (0)
#define PG8_MMA(ai, bj, At, Bt) do { __builtin_amdgcn_s_setprio(1); _Pragma("unroll") for (int m = 0; m < 4; ++m) _Pragma("unroll") for (int n = 0; n < 2; ++n) _Pragma("unroll") for (int k = 0; k < 2; ++k) \
        acc[ai][bj][m][n] = __builtin_amdgcn_mfma_f32_16x16x32_bf16(Bt[n][k], At[m][k], acc[ai][bj][m][n], 0, 0, 0); __builtin_amdgcn_s_setprio(0); } while (0)
#define PG8_WAIT_V(n) asm volatile("s_waitcnt vmcnt(" #n ")" ::: "memory")
#define PG8_WAIT_L(n) asm volatile("s_waitcnt lgkmcnt(" #n ")" ::: "memory")
#define PG8_BAR __builtin_amdgcn_s_barrier()
#define PG8_SCHED __builtin_amdgcn_sched_barrier(0)
    Unit cur, nxt; int ui = 0;
    if (!S.next(0, cur)) return;
    f32x4 acc[2][2][4][2];
#pragma unroll
    for (int a = 0; a < 2; ++a)
#pragma unroll
        for (int b = 0; b < 2; ++b)
#pragma unroll
            for (int m = 0; m < 4; ++m)
#pragma unroll
                for (int n = 0; n < 2; ++n) acc[a][b][m][n] = (f32x4){0.f, 0.f, 0.f, 0.f};
    bf16x8 At[4][2], B0[2][2], B1[2][2];
    const char* cA = cur.A; const char* cB = cur.Bt;
    unsigned vo[2] = {R2[0] * (unsigned)cur.K + C2[0], R2[1] * (unsigned)cur.K + C2[1]};
    size_t hstep = (size_t)HALF * cur.K * 2;
    PG8_STAGE(PG8_SB(0, 0), cB, vo); PG8_STAGE(PG8_SB(0, 1), cB + hstep, vo); PG8_STAGE(PG8_SA(0, 0), cA, vo); PG8_STAGE(PG8_SA(0, 1), cA + hstep, vo);
    if (wr == 1) PG8_BAR;
    PG8_WAIT_V(2); PG8_BAR;
    PG8_STAGE(PG8_SB(1, 0), cB + kstep, vo); PG8_STAGE(PG8_SA(1, 0), cA + kstep, vo); PG8_STAGE(PG8_SB(1, 1), cB + hstep + kstep, vo);
    PG8_WAIT_V(6); PG8_BAR;
    for (;;) {
        const bool has_next = S.next(ui + 1, nxt);
        if (!has_next) nxt = cur;
        const char* nA = nxt.A; const char* nB = nxt.Bt;
        const unsigned voN0 = R2[0] * (unsigned)nxt.K + C2[0], voN1 = R2[1] * (unsigned)nxt.K + C2[1]; const size_t hstepN = (size_t)HALF * nxt.K * 2;
        const int nt = cur.K / BK;
        for (int t = 0; t < nt; t += 2) {
            const bool last = (t == nt - 2);
            const char* a1 = cA + (size_t)(t + 1) * kstep;
            const char* a2 = last ? nA : cA + (size_t)(t + 2) * kstep; const char* b2 = last ? nB : cB + (size_t)(t + 2) * kstep;
            const char* a3 = a2 + kstep; const char* b3 = b2 + kstep;
            const unsigned v2[2] = {last ? voN0 : vo[0], last ? voN1 : vo[1]}; const size_t h2 = last ? hstepN : hstep;
            PG8_LDB(B0, 0, 0); PG8_LDB(B1, 0, 1); PG8_SCHED; PG8_LDA(At, 0, 0); PG8_STAGE(PG8_SA(1, 1), a1 + hstep, vo);
            PG8_WAIT_V(8); PG8_WAIT_L(0); PG8_BAR; PG8_MMA(0, 0, At, B0); PG8_MMA(0, 1, At, B1); PG8_BAR; PG8_SCHED;
            PG8_LDA(At, 0, 1); PG8_STAGE(PG8_SB(0, 0), b2, v2); PG8_STAGE(PG8_SB(0, 1), b2 + h2, v2); PG8_STAGE(PG8_SA(0, 0), a2, v2);
            PG8_WAIT_V(8); PG8_WAIT_L(0); PG8_BAR; PG8_MMA(1, 0, At, B0); PG8_MMA(1, 1, At, B1); PG8_BAR; PG8_SCHED;
            PG8_LDB(B0, 1, 0); PG8_LDB(B1, 1, 1); PG8_SCHED; PG8_LDA(At, 1, 0); PG8_STAGE(PG8_SA(0, 1), a2 + h2, v2);
            PG8_WAIT_V(8); PG8_WAIT_L(0); PG8_BAR; PG8_MMA(0, 0, At, B0); PG8_MMA(0, 1, At, B1); PG8_BAR; PG8_SCHED;
            PG8_LDA(At, 1, 1); PG8_STAGE(PG8_SB(1, 0), b3, v2); PG8_STAGE(PG8_SB(1, 1), b3 + h2, v2); PG8_STAGE(PG8_SA(1, 0), a3, v2);
            PG8_WAIT_V(8); PG8_WAIT_L(0); PG8_BAR; PG8_MMA(1, 0, At, B0); PG8_MMA(1, 1, At, B1); PG8_BAR; PG8_SCHED;
        }
        if (wr == 0) PG8_BAR;
        if (ui == 0 && (!Epi::AFTER_DRAIN || has_next)) H.wait();
        if (!Epi::AFTER_DRAIN || has_next) { int fr2 = fr, fq2 = fq; asm volatile("" : "+v"(fr2), "+v"(fq2)); E(acc, cur, wr, wc, fr2, fq2); }
        if (!has_next) break;
#pragma unroll
        for (int a = 0; a < 2; ++a)
#pragma unroll
            for (int b = 0; b < 2; ++b)
#pragma unroll
                for (int m = 0; m < 4; ++m)
#pragma unroll
                    for (int n = 0; n < 2; ++n) acc[a][b][m][n] = (f32x4){0.f, 0.f, 0.f, 0.f};
        cur = nxt; cA = nA; cB = nB; vo[0] = voN0; vo[1] = voN1; hstep = hstepN; ++ui;
        if (wr == 1) PG8_BAR;
    }
    PG8_WAIT_V(0);
    PG8_BAR;
    if constexpr (Epi::AFTER_DRAIN) { if (ui == 0) H.wait(); }
    if constexpr (Epi::AFTER_DRAIN) { int fr2 = fr, fq2 = fq; asm volatile("" : "+v"(fr2), "+v"(fq2)); E.fused(acc, cur, wr, wc, fr2, fq2, lds); }
#undef PG8_SA
#undef PG8_SB
#undef PG8_STAGE
#undef PG8_LDA
#undef PG8_LDB
#undef PG8_MMA
#undef PG8_WAIT_V
#undef PG8_WAIT_L
#undef PG8_BAR
#undef PG8_SCHED
}
}

__device__ __forceinline__ float wave_sum(float v);
#define ACC_ARG const f32x4 (&acc)[2][2][4][2]
#define EPI_FENCE() asm volatile("" ::: "memory")
constexpr int RTAB_OFF = RING_BYTES + 1024;
__device__ __forceinline__ void prep_rs(const float* ssq, int row_off, const pg8::StaticOrder& S, LAS unsigned char* lds) {
    const int tid = opaque_tid(); LAS float* rtab = (LAS float*)(lds + RTAB_OFF); pg8::Unit u;
    for (int i = 0; i < 6 && S.next(i, u); ++i) if (tid < 256) rtab[i * 256 + tid] = row_rs(ssq, row_off + u.pm * 256 + tid);
    __syncthreads();
}
struct EpiSwiglu {
    static constexpr bool AFTER_DRAIN = false;
    bf16_t* O; const LAS float* rtab;
    __device__ __forceinline__ void operator()(ACC_ARG, const pg8::Unit& u, int wr, int wc, int fr, int fq) const {
        const int lr0 = wr * 64 + fr, col0 = u.pn * 128 + wc * 32 + 8 * fq;
#pragma unroll
        for (int ai = 0; ai < 2; ++ai)
#pragma unroll
            for (int m = 0; m < 4; ++m) {
                const int lr = lr0 + ai * 128 + m * 16;
                const float rs = rtab ? rtab[u.ri * 256 + lr] : 1.0f;
                u32x4 w;
#pragma unroll
                for (int n = 0; n < 2; ++n) {
                    const f32x4 gt = acc[ai][0][m][n] * rs, up = acc[ai][1][m][n] * rs; f32x4 v;
#pragma unroll
                    for (int j = 0; j < 4; ++j) v[j] = siluf(gt[j]) * up[j];
                    const u32x2 p = pack4(v); if (n == 0) { w.x = p.x; w.y = p.y; } else { w.z = p.x; w.w = p.y; }
                }
                *(u32x4*)(O + (size_t)(u.pm * 256 + lr) * DFF + col0) = w;
            }
    }
};
template <bool BB, bool OF>
struct EpiResid {
    static constexpr bool AFTER_DRAIN = true;
    const void* base; float* out; bf16_t* xb; float* ssq; float scale; int skip;
    __device__ __forceinline__ f32x4 ldb(size_t off) const {
        if (BB) { const u32x2 w = __builtin_nontemporal_load((const u32x2*)((const bf16_t*)base + off));
                  return (f32x4){__uint_as_float(w.x << 16), __uint_as_float(w.x & 0xffff0000u), __uint_as_float(w.y << 16), __uint_as_float(w.y & 0xffff0000u)}; }
        return __builtin_nontemporal_load((const f32x4*)((const float*)base + off));
    }
    __device__ __forceinline__ void operator()(ACC_ARG, const pg8::Unit& u, int wr, int wc, int fr, int fq) const {
        if (skip) return;
        const int row0 = u.pm * 256 + wr * 64 + fr, col0 = u.pn * 256 + wc * 32 + 4 * fq;
#pragma unroll
        for (int ai = 0; ai < 2; ++ai)
#pragma unroll
            for (int m = 0; m < 4; ++m) {
                const int row = row0 + ai * 128 + m * 16; float ss = 0.f;
#pragma unroll
                for (int bj = 0; bj < 2; ++bj)
#pragma unroll
                    for (int n = 0; n < 2; ++n) {
                        const size_t off = (size_t)row * DM + col0 + bj * 128 + n * 16;
                        const f32x4 v = ldb(off) + acc[ai][bj][m][n] * scale;
                        if (OF) *(f32x4*)(out + off) = v; else *(u32x2*)(xb + off) = pack4(v);
                        ss += (v[0] * v[0] + v[1] * v[1]) + (v[2] * v[2] + v[3] * v[3]);
                    }
                if (!OF) { ss += __shfl_xor(ss, 16); ss += __shfl_xor(ss, 32); if (fq == 0) atomicAdd(ssq + (size_t)row * 4 + u.pn, ss); }
            }
    }
    __device__ __forceinline__ void fused(ACC_ARG, const pg8::Unit& u, int wr, int wc, int fr, int fq, LAS unsigned char* lds) const {
        if (skip) return;
        const int tid = opaque_tid(), lane = tid & 63, wave = __builtin_amdgcn_readfirstlane(tid >> 6);
        LAS float* tl = (LAS float*)lds;
#pragma unroll
        for (int ai = 0; ai < 2; ++ai)
#pragma unroll
            for (int wq = 0; wq < 2; ++wq) {
                if (wr == wq) {
#pragma unroll
                    for (int m = 0; m < 4; ++m)
#pragma unroll
                        for (int bj = 0; bj < 2; ++bj)
#pragma unroll
                            for (int n = 0; n < 2; ++n) *(LAS f32x4*)(tl + (16 * m + fr) * 260 + bj * 128 + wc * 32 + n * 16 + 4 * fq) = acc[ai][bj][m][n] * scale;
                }
                __syncthreads();
                const int rbase = u.pm * 256 + ai * 128 + wq * 64;
                f32x4 bv[8];
#pragma unroll
                for (int r = 0; r < 8; ++r) bv[r] = ldb((size_t)(rbase + wave * 8 + r) * DM + u.pn * 256 + lane * 4);
#pragma unroll
                for (int r = 0; r < 8; ++r) {
                    const int row = rbase + wave * 8 + r; const size_t off = (size_t)row * DM + u.pn * 256 + lane * 4;
                    const f32x4 v = bv[r] + *(const LAS f32x4*)(tl + (wave * 8 + r) * 260 + lane * 4);
                    if (OF) __builtin_nontemporal_store(v, (f32x4*)(out + off));
                    else {
                        *(u32x2*)(xb + off) = pack4(v);
                        const float ss = wave_sum((v[0] * v[0] + v[1] * v[1]) + (v[2] * v[2] + v[3] * v[3])); if (lane == 0) ssq[(size_t)row * 4 + u.pn] = ss;
                    }
                }
                __syncthreads();
            }
    }
};
struct EpiPlain {
    static constexpr bool AFTER_DRAIN = false;
    bf16_t* O; int ldo;
    __device__ __forceinline__ void operator()(ACC_ARG, const pg8::Unit& u, int wr, int wc, int fr, int fq) const {
        const int row0 = u.pm * 256 + wr * 64 + fr, col0 = u.pn * 256 + wc * 32 + 4 * fq;
#pragma unroll
        for (int ai = 0; ai < 2; ++ai)
#pragma unroll
            for (int m = 0; m < 4; ++m)
#pragma unroll
                for (int bj = 0; bj < 2; ++bj)
#pragma unroll
                    for (int n = 0; n < 2; ++n) *(u32x2*)(O + (size_t)(row0 + ai * 128 + m * 16) * ldo + col0 + bj * 128 + n * 16) = pack4(acc[ai][bj][m][n]);
    }
};
struct EpiMix {
    static constexpr bool AFTER_DRAIN = true;
    const LAS float* rtab; const float* rot;
    unsigned char* ws  ; bf16_t* mqb  ; const float *gdq, *gdk;
    static constexpr int TLD = 136;
    __device__ __forceinline__ void flushT(bf16_t* dst  , const LAS bf16_t* TS) const {
        const int tid = opaque_tid();
#pragma unroll
        for (int i = 0; i < 8; ++i) { const int p = tid + 512 * i, c = p >> 4, r8 = p & 15; *(u32x4*)(dst + (size_t)c * SEQ + r8 * 8) = *(const LAS u32x4*)(TS + c * TLD + r8 * 8); }
    }
    __device__ __forceinline__ void operator()(ACC_ARG, const pg8::Unit& u, int wr, int wc, int fr, int fq) const { body(acc, u, wr, wc, fr, fq, nullptr); }
    __device__ __forceinline__ void fused(ACC_ARG, const pg8::Unit& u, int wr, int wc, int fr, int fq, LAS unsigned char* lds) const {
        if (u.pn >= 4 && u.pn < 16) body(acc, u, wr, wc, fr, fq, (LAS bf16_t*)lds); else body(acc, u, wr, wc, fr, fq, nullptr);
    }
    __device__ __forceinline__ void body(ACC_ARG, const pg8::Unit& u, int wr, int wc, int fr, int fq, LAS bf16_t* TS) const {
        const int pn = u.pn, lr0 = wr * 64 + fr, lrow0 = u.pm * 256 + lr0;
        if (pn < 8) {
            const bool isk = pn >= 4; const int h = pn & 3; bf16_t* dst = (bf16_t*)(ws + (isk ? WS_K : WS_Q)); bf16_t* kts = (bf16_t*)(ws + WS_KTS);
            const float lg2 = log2f(1.0f - __builtin_amdgcn_exp2f(-5.0f - (float)h));
#pragma unroll
            for (int ai = 0; ai < 2; ++ai) {
                f32x4 cs0[4][2], cs1[4][2];
#pragma unroll
                for (int m = 0; m < 4; ++m)
#pragma unroll
                    for (int n = 0; n < 2; ++n) { const f32x4* cs = (const f32x4*)(rot + ((size_t)(lrow0 + ai * 128 + m * 16) * 128 + wc * 32 + 8 * fq + 4 * n) * 2); cs0[m][n] = cs[0]; cs1[m][n] = cs[1]; }
                EPI_FENCE();
#pragma unroll
                for (int m = 0; m < 4; ++m) {
                    int lrow = lrow0 + ai * 128 + m * 16; asm volatile("" : "+v"(lrow));
                    const float rs = rtab[u.ri * 256 + lr0 + ai * 128 + m * 16] * (isk ? 0.0625f : 1.0f);
                    const float dec = __builtin_amdgcn_exp2f(lg2 * (float)(127 - (lrow & 127)));
#pragma unroll
                    for (int n = 0; n < 2; ++n) {
                        const int i0 = wc * 32 + 8 * fq + 4 * n;
                        const f32x4 c01 = cs0[m][n], c23 = cs1[m][n];
                        const f32x4 cv = (f32x4){c01[0], c01[2], c23[0], c23[2]}, sv = (f32x4){c01[1], c01[3], c23[1], c23[3]};
                        const f32x4 x1 = acc[ai][0][m][n] * rs, x2 = acc[ai][1][m][n] * rs;
                        const f32x4 o1 = x1 * cv - x2 * sv, o2 = x1 * sv + x2 * cv;
                        *(u32x2*)(dst + (size_t)lrow * 1024 + h * 256 + i0) = pack4(o1);
                        *(u32x2*)(dst + (size_t)lrow * 1024 + h * 256 + 128 + i0) = pack4(o2);
                        if (isk) {
                            if (TS) {
                                const int rl = wr * 64 + m * 16 + fr;
#pragma unroll
                                for (int j = 0; j < 4; ++j) { TS[(i0 + j) * TLD + rl] = bf16_1(o1[j] * dec); TS[(128 + i0 + j) * TLD + rl] = bf16_1(o2[j] * dec); }
                            } else {
#pragma unroll
                                for (int j = 0; j < 4; ++j) {
                                    kts[(size_t)(h * 256 + i0 + j) * SEQ + lrow] = bf16_1(o1[j] * dec);
                                    kts[(size_t)(h * 256 + 128 + i0 + j) * SEQ + lrow] = bf16_1(o2[j] * dec);
                                }
                            }
                        }
                    }
                }
                EPI_FENCE();
                if (isk && TS) { __syncthreads(); flushT(kts + (size_t)(h * 256) * SEQ + u.pm * 256 + ai * 128, TS); __syncthreads(); }
            }
        } else if (pn < 16) {
            const int h = (pn - 8) >> 1, e0 = ((pn - 8) & 1) * 256; bf16_t* vt = (bf16_t*)(ws + WS_VT);
#pragma unroll
            for (int ai = 0; ai < 2; ++ai) {
#pragma unroll
                for (int m = 0; m < 4; ++m) {
                    int lrow = lrow0 + ai * 128 + m * 16; asm volatile("" : "+v"(lrow));
                    const float rs = rtab[u.ri * 256 + lr0 + ai * 128 + m * 16];
#pragma unroll
                    for (int bj = 0; bj < 2; ++bj)
#pragma unroll
                        for (int n = 0; n < 2; ++n) {
                            const int tc = bj * 128 + wc * 32 + 8 * fq + 4 * n, ec = e0 + tc; const f32x4 v = acc[ai][bj][m][n] * rs;
                            if (TS) {
                                const int rl = wr * 64 + m * 16 + fr;
#pragma unroll
                                for (int j = 0; j < 4; ++j) TS[(tc + j) * TLD + rl] = bf16_1(v[j]);
                            } else {
#pragma unroll
                                for (int j = 0; j < 4; ++j) vt[(size_t)(h * 512 + ec + j) * SEQ + lrow] = bf16_1(v[j]);
                            }
                        }
                    EPI_FENCE();
                }
                if (TS) { __syncthreads(); flushT(vt + (size_t)(h * 512 + e0) * SEQ + u.pm * 256 + ai * 128, TS); __syncthreads(); }
            }
        } else if (pn < 24) {
            const bool isk = pn >= 20; const int tile = (pn - 16) & 3; bf16_t* dst = (bf16_t*)(ws + (isk ? WS_DK : WS_DQ)); const float* gn = isk ? gdk : gdq; const float mul = isk ? 1.0f : C2Q;
            f32x4 gv[2][2];
#pragma unroll
            for (int bj = 0; bj < 2; ++bj)
#pragma unroll
                for (int n = 0; n < 2; ++n) gv[bj][n] = *(const f32x4*)(gn + 32 * bj + 8 * fq + 4 * n);
#pragma unroll
            for (int ai = 0; ai < 2; ++ai)
#pragma unroll
                for (int m = 0; m < 4; ++m) {
                    int lrow = lrow0 + ai * 128 + m * 16; asm volatile("" : "+v"(lrow));
                    const float rs = rtab[u.ri * 256 + lr0 + ai * 128 + m * 16];
                    f32x4 v[2][2]; float ss = 0.f;
#pragma unroll
                    for (int bj = 0; bj < 2; ++bj)
#pragma unroll
                        for (int n = 0; n < 2; ++n) { v[bj][n] = acc[ai][bj][m][n] * rs; const f32x4 t = v[bj][n]; ss += (t[0] * t[0] + t[1] * t[1]) + (t[2] * t[2] + t[3] * t[3]); }
                    ss += __shfl_xor(ss, 16); ss += __shfl_xor(ss, 32);
                    const float rn = __builtin_amdgcn_rsqf(ss * (1.0f / 64.0f) + EPS) * mul;
#pragma unroll
                    for (int bj = 0; bj < 2; ++bj) { const u32x2 p0 = pack4(v[bj][0] * rn * gv[bj][0]), p1 = pack4(v[bj][1] * rn * gv[bj][1]);
                        *(u32x4*)(dst + (size_t)lrow * 1024 + tile * 256 + 64 * wc + 32 * bj + 8 * fq) = (u32x4){p0.x, p0.y, p1.x, p1.y}; }
                    EPI_FENCE();
                }
        } else {
            bf16_t* dst = pn < 28 ? (bf16_t*)(ws + WS_DV) : mqb; const int tile = (pn - 24) & 3;
#pragma unroll
            for (int ai = 0; ai < 2; ++ai)
#pragma unroll
                for (int m = 0; m < 4; ++m) {
                    int lrow = lrow0 + ai * 128 + m * 16; asm volatile("" : "+v"(lrow));
                    const float rs = rtab[u.ri * 256 + lr0 + ai * 128 + m * 16];
#pragma unroll
                    for (int bj = 0; bj < 2; ++bj) { const u32x2 p0 = pack4(acc[ai][bj][m][0] * rs), p1 = pack4(acc[ai][bj][m][1] * rs);
                        *(u32x4*)(dst + (size_t)lrow * 1024 + tile * 256 + bj * 128 + wc * 32 + 8 * fq) = (u32x4){p0.x, p0.y, p1.x, p1.y}; }
                    EPI_FENCE();
                }
        }
    }
};
struct EpiRgG {
    static constexpr bool AFTER_DRAIN = false;
    const LAS float* rtab; bf16_t* ret; const float* rssq; unsigned char* ws;
    __device__ __forceinline__ void operator()(ACC_ARG, const pg8::Unit& u, int wr, int wc, int fr, int fq) const {
        const int lr0 = wr * 64 + fr;
        if (u.pn < 8) {
            const int col0 = u.pn * 256 + wc * 32 + 8 * fq;
#pragma unroll
            for (int ai = 0; ai < 2; ++ai) {
                u32x4 rv[4][2]; f32x2 rq2[4];
#pragma unroll
                for (int m = 0; m < 4; ++m) { const int lr = lr0 + ai * 128 + m * 16;
                    rq2[m] = *(const f32x2*)(rssq + (size_t)(u.pm * 256 + lr) * 8 + 2 * (u.pn >> 1));
#pragma unroll
                    for (int bj = 0; bj < 2; ++bj) rv[m][bj] = *(const u32x4*)(ret + (size_t)(u.pm * 256 + lr) * 2048 + col0 + bj * 128); }
                EPI_FENCE();
#pragma unroll
                for (int m = 0; m < 4; ++m) {
                    const int lr = lr0 + ai * 128 + m * 16; const float rs = rtab[u.ri * 256 + lr];
                    const float rr = __builtin_amdgcn_rsqf((rq2[m][0] + rq2[m][1]) * (1.0f / 512.0f) + EPS);
#pragma unroll
                    for (int bj = 0; bj < 2; ++bj) {
                        u32x4 o;
#pragma unroll
                        for (int n = 0; n < 2; ++n) {
                            const unsigned w0 = n == 0 ? rv[m][bj].x : rv[m][bj].z, w1 = n == 0 ? rv[m][bj].y : rv[m][bj].w; const f32x4 a = acc[ai][bj][m][n] * rs; f32x4 v;
                            v[0] = __uint_as_float(w0 << 16) * siluf(a[0]); v[1] = __uint_as_float(w0 & 0xffff0000u) * siluf(a[1]);
                            v[2] = __uint_as_float(w1 << 16) * siluf(a[2]); v[3] = __uint_as_float(w1 & 0xffff0000u) * siluf(a[3]);
                            const u32x2 p = pack4(v * rr); if (n == 0) { o.x = p.x; o.y = p.y; } else { o.z = p.x; o.w = p.y; }
                        }
                        *(u32x4*)(ret + (size_t)(u.pm * 256 + lr) * 2048 + col0 + bj * 128) = o;
                    }
                }
                EPI_FENCE();
            }
        } else {
            const int br = (u.pn - 8) >> 2, col0 = ((u.pn - 8) & 3) * 256 + wc * 32 + 8 * fq;
            unsigned char* g8 = ws + (br == 0 ? WS_G8A : br == 1 ? WS_G8B : WS_G8C);
#pragma unroll
            for (int ai = 0; ai < 2; ++ai)
#pragma unroll
                for (int m = 0; m < 4; ++m) {
                    const int lr = lr0 + ai * 128 + m * 16; const float rs = rtab[u.ri * 256 + lr];
#pragma unroll
                    for (int bj = 0; bj < 2; ++bj) {
                        u32x2 w2;
#pragma unroll
                        for (int n = 0; n < 2; ++n) {
                            const f32x4 a = acc[ai][bj][m][n] * rs; unsigned w = 0u;
#pragma unroll
                            for (int j = 0; j < 4; ++j) w |= (unsigned)__builtin_rintf(255.0f * sigmf(a[j])) << (8 * j);
                            if (n == 0) w2.x = w; else w2.y = w;
                        }
                        *(u32x2*)(g8 + (size_t)(u.pm * 256 + lr) * DM + col0 + bj * 128) = w2;
                    }
                }
        }
    }
};
struct EpiTerm3 {
    static constexpr bool AFTER_DRAIN = false;
    unsigned char* ws; bf16_t* y;
    __device__ __forceinline__ void operator()(ACC_ARG, const pg8::Unit& u, int wr, int wc, int fr, int fq) const {
        const int lr0 = wr * 64 + fr, col0 = u.pn * 256 + wc * 32 + 8 * fq, first = (u.tag == 0);
        const unsigned char* g8 = ws + (u.tag == 0 ? WS_G8A : u.tag == 1 ? WS_G8B : WS_G8C);
#pragma unroll
        for (int ai = 0; ai < 2; ++ai) {
            u32x2 gv[4][2]; u32x4 yv[4][2];
#pragma unroll
            for (int m = 0; m < 4; ++m)
#pragma unroll
                for (int bj = 0; bj < 2; ++bj) { const size_t off = (size_t)(u.pm * 256 + lr0 + ai * 128 + m * 16) * DM + col0 + bj * 128;
                    gv[m][bj] = *(const u32x2*)(g8 + off); yv[m][bj] = first ? (u32x4){0u, 0u, 0u, 0u} : *(const u32x4*)(y + off); }
            EPI_FENCE();
#pragma unroll
            for (int m = 0; m < 4; ++m)
#pragma unroll
                for (int bj = 0; bj < 2; ++bj) {
                    const size_t off = (size_t)(u.pm * 256 + lr0 + ai * 128 + m * 16) * DM + col0 + bj * 128;
                    u32x4 o;
#pragma unroll
                    for (int n = 0; n < 2; ++n) {
                        const f32x4 a = acc[ai][bj][m][n]; const unsigned gw = n == 0 ? gv[m][bj].x : gv[m][bj].y; const unsigned w0 = n == 0 ? yv[m][bj].x : yv[m][bj].z, w1 = n == 0 ? yv[m][bj].y : yv[m][bj].w; f32x4 v;
                        v[0] = (float)(gw & 255u) * (1.0f / 255.0f) * a[0] + __uint_as_float(w0 << 16); v[1] = (float)((gw >> 8) & 255u) * (1.0f / 255.0f) * a[1] + __uint_as_float(w0 & 0xffff0000u);
                        v[2] = (float)((gw >> 16) & 255u) * (1.0f / 255.0f) * a[2] + __uint_as_float(w1 << 16); v[3] = (float)(gw >> 24) * (1.0f / 255.0f) * a[3] + __uint_as_float(w1 & 0xffff0000u);
                        const u32x2 p = pack4(v); if (n == 0) { o.x = p.x; o.y = p.y; } else { o.z = p.x; o.w = p.y; }
                    }
                    *(u32x4*)(y + off) = o;
                }
            EPI_FENCE();
        }
    }
};

#include <hip/hip_bf16.h>
namespace attn_body {
using bf16=__hip_bfloat16;
using bf16x8=__attribute__((ext_vector_type(8)))short;
using s16x4=__attribute__((ext_vector_type(4)))short;
using f32x16=__attribute__((ext_vector_type(16)))float;
using u32x4=__attribute__((ext_vector_type(4)))unsigned;
constexpr int D=64,DM=1024;
constexpr int NW=8,QBLK=32,QB=QBLK*NW,KVBLK=64;
__device__ __forceinline__ int crow(int r,int hi){return (r&3)+8*(r>>2)+4*hi;}
#define SBAR() __builtin_amdgcn_sched_barrier(0)
__device__ __forceinline__ void cmask(f32x16&p0,f32x16&p1,int jb,int qrel,int hi){
  const float NEG=-INFINITY; int kb=64*jb+4*hi;
  #pragma unroll
  for(int r=0;r<16;++r){int kv=kb+(r&3)+8*(r>>2); if(kv>qrel)p0[r]=NEG; if(kv+32>qrel)p1[r]=NEG;}
}
constexpr int NSLOT=3, SLOTB=8192;
constexpr int LDS_K=0, LDS_V=NSLOT*SLOTB, LDS_WS=2*NSLOT*SLOTB, LDS_OST=LDS_WS+NW*64*4, LDS_BYTES=LDS_OST+NW*4096;
__device__ __forceinline__ void glds16(const void*gsrc,unsigned lds_dst){unsigned keep;
  asm volatile("s_mov_b32 %0, m0\n\ts_mov_b32 m0, %2\n\ts_nop 0\n\tglobal_load_lds_dwordx4 %1, off\n\ts_mov_b32 m0, %0":"=&s"(keep):"v"(gsrc),"s"(lds_dst):"memory");}
__device__ __forceinline__ float max3f(float a,float b,float c){float r;asm("v_max3_f32 %0, %1, %2, %3":"=v"(r):"v"(a),"v"(b),"v"(c));return r;}
__device__ __forceinline__ float max2f(float a,float b){float r;asm("v_max_f32_e32 %0, %1, %2":"=v"(r):"v"(a),"v"(b));return r;}
__device__ __forceinline__ float fadd_s(float a,float b){float r;asm("v_add_f32_e32 %0, %1, %2":"=v"(r):"v"(a),"v"(b));return r;}
__device__ __forceinline__ float fsub_s(float a,float b){float r;asm("v_sub_f32_e32 %0, %1, %2":"=v"(r):"v"(a),"v"(b));return r;}
typedef float f32x2_t __attribute__((ext_vector_type(2))); typedef __bf16 bf16x2_t __attribute__((ext_vector_type(2)));
__device__ __forceinline__ unsigned cvtpk_s(float lo,float hi){f32x2_t v={lo,hi};bf16x2_t b=__builtin_convertvector(v,bf16x2_t);return __builtin_bit_cast(unsigned,b);}
#define WAIT_BAR(N) asm volatile("s_waitcnt vmcnt(" #N ") lgkmcnt(0)\n\ts_barrier":::"memory")
__device__ __forceinline__ void qkt(f32x16&p0,f32x16&p1,const char*Kslot,const bf16x8*qr,const f32x16&negm,int r32,int hi){
  const char*kb=Kslot+hi*1024+r32*16;
  #pragma unroll
  for(int d0=0;d0<4;++d0){
    const bf16x8 b0=*reinterpret_cast<const bf16x8*>(kb+d0*2048);
    const bf16x8 b1=*reinterpret_cast<const bf16x8*>(kb+d0*2048+512);
    if(d0==0){p0=__builtin_amdgcn_mfma_f32_32x32x16_bf16(b0,qr[0],negm,0,0,0);p1=__builtin_amdgcn_mfma_f32_32x32x16_bf16(b1,qr[0],negm,0,0,0);}
    else{p0=__builtin_amdgcn_mfma_f32_32x32x16_bf16(b0,qr[d0],p0,0,0,0);p1=__builtin_amdgcn_mfma_f32_32x32x16_bf16(b1,qr[d0],p1,0,0,0);}}
}
typedef __attribute__((address_space(3))) const char* lds_cptr;
typedef short v4i16_t __attribute__((ext_vector_type(4)));
__device__ __forceinline__ void kload8(bf16x8*kf,lds_cptr kp){
  kf[0]=*(const __attribute__((address_space(3))) bf16x8*)(kp);      kf[1]=*(const __attribute__((address_space(3))) bf16x8*)(kp+512);
  kf[2]=*(const __attribute__((address_space(3))) bf16x8*)(kp+2048); kf[3]=*(const __attribute__((address_space(3))) bf16x8*)(kp+2560);
  kf[4]=*(const __attribute__((address_space(3))) bf16x8*)(kp+4096); kf[5]=*(const __attribute__((address_space(3))) bf16x8*)(kp+4608);
  kf[6]=*(const __attribute__((address_space(3))) bf16x8*)(kp+6144); kf[7]=*(const __attribute__((address_space(3))) bf16x8*)(kp+6656);
}
__device__ __forceinline__ void kload2(bf16x8*kf,lds_cptr kp,int j){ kf[2*j]=*(const __attribute__((address_space(3))) bf16x8*)(kp+j*2048); kf[2*j+1]=*(const __attribute__((address_space(3))) bf16x8*)(kp+j*2048+512); }
__device__ __forceinline__ s16x4 vtr(lds_cptr p){ return __builtin_bit_cast(s16x4,__builtin_amdgcn_ds_read_tr16_b64_v4i16((__attribute__((address_space(3))) v4i16_t*)p)); }
__device__ __forceinline__ float rowmax(const f32x16&p0,const f32x16&p1){
  float a=max3f(p0[0],p0[1],p1[0]),b=max3f(p0[2],p0[3],p1[1]);a=max3f(a,p1[2],p1[3]);
  #pragma unroll
  for(int r=4;r<16;r+=4){a=max3f(a,p0[r],p0[r+1]);b=max3f(b,p0[r+2],p0[r+3]);a=max3f(a,p1[r],p1[r+1]);b=max3f(b,p1[r+2],p1[r+3]);}
  const float m=max2f(a,b);
  auto rr=__builtin_amdgcn_permlane32_swap(__float_as_uint(m),__float_as_uint(m),false,false);
  return max2f(__uint_as_float(rr[0]),__uint_as_float(rr[1]));
}
__device__ __forceinline__ void pv(f32x16*o,int vb,bf16x8 pa0,bf16x8 pa1,bf16x8 pa2,bf16x8 pa3){
  #pragma unroll
  for(int d0=0;d0<2;++d0){s16x4 lo[4],hi[4];
    #pragma unroll
    for(int ks=0;ks<4;++ks){
      asm volatile("ds_read_b64_tr_b16 %0,%1 offset:%c2":"=&v"(lo[ks]):"v"(vb),"i"(d0*4096+ks*1024):"memory");
      asm volatile("ds_read_b64_tr_b16 %0,%1 offset:%c2":"=&v"(hi[ks]):"v"(vb),"i"(d0*4096+ks*1024+512):"memory");}
    asm volatile("s_waitcnt lgkmcnt(0)":::"memory");SBAR();
    #define PK(k) (bf16x8){lo[k][0],lo[k][1],lo[k][2],lo[k][3],hi[k][0],hi[k][1],hi[k][2],hi[k][3]}
    o[d0]=__builtin_amdgcn_mfma_f32_32x32x16_bf16(pa0,PK(0),o[d0],0,0,0);
    o[d0]=__builtin_amdgcn_mfma_f32_32x32x16_bf16(pa1,PK(1),o[d0],0,0,0);
    o[d0]=__builtin_amdgcn_mfma_f32_32x32x16_bf16(pa2,PK(2),o[d0],0,0,0);
    o[d0]=__builtin_amdgcn_mfma_f32_32x32x16_bf16(pa3,PK(3),o[d0],0,0,0);
    #undef PK
  }
}
#define ATTN_STORE16(p,v) (*(u32x4*)(p)=(v))
template<int THRL> __device__ __forceinline__ void attn_unit(int hq,int hv,int qb,const bf16*Q,const bf16*__restrict__ K,const bf16*__restrict__ V,bf16*O,char*shm){
  const int tid=opaque_tid(),lane=tid&63,r32=lane&31,hi=lane>>5; const int wid=__builtin_amdgcn_readfirstlane(tid>>6);
  const int q0=qb*QB;
  const bf16*Qw=Q+(long)(q0+wid*QBLK)*DM+hq*D;
  const bf16*Kh=K+hq*D,*Vh=V+hv*D;
  const unsigned lds0=(unsigned)(uintptr_t)shm;
  float*wsf=(float*)(shm+LDS_WS)+wid*64;
  const bf16*ksrc=Kh+(long)lane*DM+wid*8;
  const bf16*vsrc=Vh+(long)(16*(wid&3)+(lane>>2))*DM+(wid>>2)*32+(lane&3)*8;
  const unsigned kdst=lds0+LDS_K+wid*1024, vdst=lds0+LDS_V+wid*1024;
  #define DMA_K(t,slot) glds16(ksrc+(long)(t)*KVBLK*DM,(unsigned)__builtin_amdgcn_readfirstlane(kdst+(slot)))
  #define DMA_V(t,slot) glds16(vsrc+(long)(t)*KVBLK*DM,(unsigned)__builtin_amdgcn_readfirstlane(vdst+(slot)))
  const int vb0=(int)(lds0+LDS_V)+((lane>>4)&1)*32+(lane&3)*8+(4*hi+((lane&15)>>2))*64;
  const char*Kbase=shm+LDS_K; bf16x8 kf[8];
  const lds_cptr shm3=(lds_cptr)shm; const lds_cptr kp0=shm3+LDS_K+hi*1024+r32*16; const lds_cptr vp0=shm3+LDS_V+((lane>>4)&1)*32+(lane&3)*8+(4*hi+((lane&15)>>2))*64;
  const int NT=(q0+QB)/KVBLK;
  DMA_K(0,0);DMA_V(0,0);DMA_K(1,SLOTB);
  bf16x8 qr[4];
  #pragma unroll
  for(int d0=0;d0<4;++d0)qr[d0]=*reinterpret_cast<const bf16x8*>(&Qw[(long)r32*DM+d0*16+hi*8]);
  float mhat=0.f,l_reg=0.f;f32x16 o[2];o[0]=f32x16{};o[1]=f32x16{};f32x16 negm=f32x16{};asm volatile("":"+v"(negm));
  const int qrel=wid*QBLK+r32;
  #define CMASK(P0,P1,t) do{int jb_=(t)-(NT-4); if(jb_>=0)cmask(P0,P1,jb_,qrel,hi);}while(0)
  bool resc=false;
  #define START(P0,P1) do{ const float rm=rowmax(P0,P1); resc=false; \
    { const float dl=rm; mhat=fadd_s(mhat,dl); \
      _Pragma("unroll") for(int r=0;r<16;++r){P0[r]=fsub_s(P0[r],dl);P1[r]=fsub_s(P1[r],dl);} \
      _Pragma("unroll") for(int r=0;r<16;++r)negm[r]=-mhat; asm volatile("":"+v"(negm)); } \
    _Pragma("unroll") for(int r=0;r<16;++r)P0[r]=__builtin_amdgcn_exp2f(P0[r]); }while(0)
  #define RESC() do{ if(resc){ asm volatile("s_waitcnt lgkmcnt(0)":::"memory"); \
      _Pragma("unroll") for(int d_=0;d_<2;++d_) _Pragma("unroll") for(int r=0;r<16;++r)o[d_][r]*=wsf[crow(r,hi)]; } }while(0)
  f32x16 pA0,pA1,pB0,pB1;
  int sl_prev=0,sl_cur=0,sl_next=SLOTB;
  #define ROT() do{sl_prev=sl_cur;sl_cur=sl_next;sl_next=(sl_next==(NSLOT-1)*SLOTB)?0:sl_next+SLOTB;}while(0)
  DMA_K(2,2*SLOTB);
  WAIT_BAR(3);
  qkt(pA0,pA1,Kbase,qr,negm,r32,hi);asm volatile("s_nop 15\n\ts_nop 7":"+v"(pA0),"+v"(pA1));CMASK(pA0,pA1,0);
  START(pA0,pA1);
  _Pragma("unroll") for(int r=0;r<16;++r)pA1[r]=__builtin_amdgcn_exp2f(pA1[r]);
  WAIT_BAR(0);
  DMA_K(3,0);DMA_V(1,SLOTB);
  ROT();
  kload8(kf,kp0+sl_cur);
  WAIT_BAR(2);
  s16x4 vlo[8],vhi[8]; u32x4 pw0,pw1,pw2,pw3;
  #define PKW(P,B) cvtpk_s(P[B],P[B+1])
  #define PAF(k) __builtin_bit_cast(bf16x8,pw##k)
  #define VFR(i) (bf16x8){vlo[i][0],vlo[i][1],vlo[i][2],vlo[i][3],vhi[i][0],vhi[i][1],vhi[i][2],vhi[i][3]}
  #define PIN(x) asm volatile("":"+v"(x))
  #define MX3(a,b,c) __builtin_fmaxf(__builtin_fmaxf((a),(b)),(c))
  #define GAPA(MF,A0,A1,A2,A3,W0,W1,PW) do{ MF; sacc+=A0; sacc+=A1; sacc+=A2; sacc+=A3; PIN(sacc); W0; W1; PIN(PW); SBAR(); }while(0)
  #define EX(v) __builtin_amdgcn_exp2f(v)
  #define GAPB(MF,X,B) do{ MF; X[B]=EX(X[B]); X[B+1]=EX(X[B+1]); X[B+2]=EX(X[B+2]); X[B+3]=EX(X[B+3]); PIN(X); SBAR(); }while(0)
  #define VRD(i) do{ vlo[i]=vtr(vp_+(((i)>>2)*4096+((i)&3)*1024)); vhi[i]=vtr(vp_+(((i)>>2)*4096+((i)&3)*1024+512)); }while(0)
  #define KRD(G,j) do{ if(G){ kload2(kf,kp0+sl_next,j); SBAR(); } }while(0)
  #define STEP(C0,C1,P0,P1,t,GK,GV,GL) do{ SBAR(); \
    const lds_cptr vp_=vp0+sl_prev; \
    VRD(0); SBAR(); float sacc=(P0[0]+P0[1]); \
    GAPA(C0=__builtin_amdgcn_mfma_f32_32x32x16_bf16(kf[0],qr[0],negm,0,0,0), P0[2],P0[3],P0[4],P0[5],     pw0[0]=PKW(P0,0), pw0[1]=PKW(P0,2), pw0); \
    VRD(4); SBAR(); GAPA(C1=__builtin_amdgcn_mfma_f32_32x32x16_bf16(kf[1],qr[0],negm,0,0,0), P0[6],P0[7],P0[8],P0[9],     pw0[2]=PKW(P0,4), pw0[3]=PKW(P0,6), pw0); \
    VRD(1); SBAR(); GAPA(C0=__builtin_amdgcn_mfma_f32_32x32x16_bf16(kf[2],qr[1],C0,0,0,0),   P0[10],P0[11],P0[12],P0[13], pw1[0]=PKW(P0,8), pw1[1]=PKW(P0,10), pw1); \
    VRD(5); SBAR(); GAPA(C1=__builtin_amdgcn_mfma_f32_32x32x16_bf16(kf[3],qr[1],C1,0,0,0),   P0[14],P0[15],P1[0],P1[1],   pw1[2]=PKW(P0,12),pw1[3]=PKW(P0,14), pw1); \
    VRD(2); SBAR(); GAPA(C0=__builtin_amdgcn_mfma_f32_32x32x16_bf16(kf[4],qr[2],C0,0,0,0),   P1[2],P1[3],P1[4],P1[5],     pw2[0]=PKW(P1,0), pw2[1]=PKW(P1,2), pw2); \
    VRD(6); SBAR(); GAPA(C1=__builtin_amdgcn_mfma_f32_32x32x16_bf16(kf[5],qr[2],C1,0,0,0),   P1[6],P1[7],P1[8],P1[9],     pw2[2]=PKW(P1,4), pw2[3]=PKW(P1,6), pw2); \
    VRD(3); SBAR(); GAPA(C0=__builtin_amdgcn_mfma_f32_32x32x16_bf16(kf[6],qr[3],C0,0,0,0),   P1[10],P1[11],P1[12],P1[13], pw3[0]=PKW(P1,8), pw3[1]=PKW(P1,10), pw3); \
    VRD(7); SBAR(); GAPA(C1=__builtin_amdgcn_mfma_f32_32x32x16_bf16(kf[7],qr[3],C1,0,0,0),   P1[14],P1[15],0.f,0.f,       pw3[2]=PKW(P1,12),pw3[3]=PKW(P1,14), pw3); \
    l_reg+=sacc; \
    if(GK){DMA_K((t)+3,sl_cur);} if(GV){DMA_V((t)+1,sl_next);} \
    CMASK(C0,C1,t); \
    { float a=MX3(C0[0],C0[1],C1[0]),b=MX3(C0[2],C0[3],C1[1]); a=MX3(a,C1[2],C1[3]); \
      _Pragma("unroll") for(int r=4;r<16;r+=4){a=MX3(a,C0[r],C0[r+1]);b=MX3(b,C0[r+2],C0[r+3]);a=MX3(a,C1[r],C1[r+1]);b=MX3(b,C1[r+2],C1[r+3]);} \
      float rm=__builtin_fmaxf(a,b); { auto rr=__builtin_amdgcn_permlane32_swap(__float_as_uint(rm),__float_as_uint(rm),false,false); rm=__builtin_fmaxf(__uint_as_float(rr[0]),__uint_as_float(rr[1])); } \
      resc=false; \
      if(__builtin_expect(__any(rm>(float)THRL),0)){ const float dl=__builtin_fmaxf(rm,0.f); mhat+=dl; \
        _Pragma("unroll") for(int r=0;r<16;++r){C0[r]-=dl;C1[r]-=dl;} \
        _Pragma("unroll") for(int r=0;r<16;++r)negm[r]=-mhat; asm volatile("":"+v"(negm)); \
        const float f=__builtin_amdgcn_exp2f(-dl); l_reg*=f; if(hi==0)wsf[r32]=f; resc=true; } } \
    SBAR(); \
    GAPB(o[0]=__builtin_amdgcn_mfma_f32_32x32x16_bf16(PAF(0),VFR(0),o[0],0,0,0), C0,0); \
    GAPB(o[1]=__builtin_amdgcn_mfma_f32_32x32x16_bf16(PAF(0),VFR(4),o[1],0,0,0), C0,4); \
    KRD(GL,0); GAPB(o[0]=__builtin_amdgcn_mfma_f32_32x32x16_bf16(PAF(1),VFR(1),o[0],0,0,0), C0,8); \
    KRD(GL,1); GAPB(o[1]=__builtin_amdgcn_mfma_f32_32x32x16_bf16(PAF(1),VFR(5),o[1],0,0,0), C0,12); \
    KRD(GL,2); GAPB(o[0]=__builtin_amdgcn_mfma_f32_32x32x16_bf16(PAF(2),VFR(2),o[0],0,0,0), C1,0); \
    KRD(GL,3); GAPB(o[1]=__builtin_amdgcn_mfma_f32_32x32x16_bf16(PAF(2),VFR(6),o[1],0,0,0), C1,4); \
    GAPB(o[0]=__builtin_amdgcn_mfma_f32_32x32x16_bf16(PAF(3),VFR(3),o[0],0,0,0), C1,8); \
    GAPB(o[1]=__builtin_amdgcn_mfma_f32_32x32x16_bf16(PAF(3),VFR(7),o[1],0,0,0), C1,12); \
    }while(0)
  int t=1;
  #undef CMASK
  #define CMASK(P0,P1,t) do{}while(0)
  for(;t+5<NT;t+=2){
    STEP(pB0,pB1,pA0,pA1,t,true,true,true);     WAIT_BAR(2); RESC(); ROT();
    STEP(pA0,pA1,pB0,pB1,t+1,true,true,true);   WAIT_BAR(2); RESC(); ROT();
  }
  #undef CMASK
  #define CMASK(P0,P1,t) do{int jb_=(t)-(NT-4); if(jb_>=0)cmask(P0,P1,jb_,qrel,hi);}while(0)
  #define ENDW(tt) do{ if((tt)+3<NT){WAIT_BAR(2);} else if((tt)+2<NT){WAIT_BAR(1);} else {WAIT_BAR(0);} }while(0)
  for(;t+1<NT;t+=2){
    STEP(pB0,pB1,pA0,pA1,t,(t+3<NT),(t+1<NT),(t+1<NT));       ENDW(t);   RESC(); ROT();
    STEP(pA0,pA1,pB0,pB1,t+1,(t+4<NT),(t+2<NT),(t+2<NT));     ENDW(t+1); RESC(); ROT();
  }
  STEP(pB0,pB1,pA0,pA1,NT-1,false,false,false); RESC();
  { float sacc=pB0[0]+pB0[1]; _Pragma("unroll") for(int r=2;r<16;++r)sacc+=pB0[r]; _Pragma("unroll") for(int r=0;r<16;++r)sacc+=pB1[r]; l_reg+=sacc;
    pw0=(u32x4){PKW(pB0,0),PKW(pB0,2),PKW(pB0,4),PKW(pB0,6)};pw1=(u32x4){PKW(pB0,8),PKW(pB0,10),PKW(pB0,12),PKW(pB0,14)};pw2=(u32x4){PKW(pB1,0),PKW(pB1,2),PKW(pB1,4),PKW(pB1,6)};pw3=(u32x4){PKW(pB1,8),PKW(pB1,10),PKW(pB1,12),PKW(pB1,14)};
    SBAR(); pv(o,vb0+sl_cur,PAF(0),PAF(1),PAF(2),PAF(3)); }
  #undef PKW
  #undef PAF
  #undef VFR
  #undef PIN
  #undef MX3
  #undef GAPA
  #undef GAPB
  #undef EX
  #undef VRD
  #undef KRD
  #undef STEP
  #undef ENDW
  {auto rr=__builtin_amdgcn_permlane32_swap(__float_as_uint(l_reg),__float_as_uint(l_reg),false,false);l_reg=__uint_as_float(rr[0])+__uint_as_float(rr[1]);}
  if(hi==0)wsf[32+r32]=l_reg;asm volatile("s_waitcnt lgkmcnt(0)":::"memory");
  float rli[16];
  #pragma unroll
  for(int r=0;r<16;++r)rli[r]=__builtin_amdgcn_rcpf(wsf[32+crow(r,hi)]);
  bf16*Ow=O+(long)(q0+wid*QBLK)*DM+hv*D;
  { bf16*stg=(bf16*)(shm+LDS_OST)+wid*2048;
    #pragma unroll
    for(int r=0;r<16;++r){const int orow=crow(r,hi);
      #pragma unroll
      for(int d0=0;d0<2;++d0)stg[orow*64+d0*32+r32]=__float2bfloat16(o[d0][r]*rli[r]);}
    asm volatile("s_waitcnt lgkmcnt(0)":::"memory");
    #pragma unroll
    for(int i=0;i<4;++i){const int row=i*8+(lane>>3),ch=lane&7; const u32x4 v=*(const u32x4*)(stg+row*64+ch*8); ATTN_STORE16(Ow+(long)row*DM+ch*8,v);} }
  asm volatile("s_waitcnt lgkmcnt(0)\n\ts_barrier":::"memory");
  #undef DMA_K
  #undef DMA_V
  #undef CMASK
  #undef START
  #undef RESC
  #undef ROT
}
constexpr int ATTN_LDS_BYTES=LDS_BYTES;
#undef SBAR
#undef WAIT_BAR
}

typedef GAS unsigned gu32;
#define RLX_AGENT __ATOMIC_RELAXED, __HIP_MEMORY_SCOPE_AGENT
#define LDS_WAIT() asm volatile("s_waitcnt lgkmcnt(0)" ::: "memory")
#define XB_TMO      128
#define XB_XCNT(j)  (256  + 64 * (j))
#define XB_XSUB(j)  (1280 + 64 * (j))
#define XB_XGEN(j)  (2304 + 64 * (j))
#define XB_TOP      3328
#define XB_TOPGEN   3392
#define XCD_BAR_WORDS 3456
#define XB_SPIN_CAP (1u << 18)
__device__ __forceinline__ unsigned xb_ld(unsigned* p)              { return __hip_atomic_load(p, __ATOMIC_RELAXED, __HIP_MEMORY_SCOPE_AGENT); }
__device__ __forceinline__ unsigned xb_add(unsigned* p, unsigned v) { return __hip_atomic_fetch_add(p, v, __ATOMIC_RELAXED, __HIP_MEMORY_SCOPE_AGENT); }
__device__ __forceinline__ unsigned xb_xcc_id() { return (unsigned)__builtin_amdgcn_s_getreg((3 << 11) | 20) & 0xFu; }
#define XB_SPIN(cond, bar) do { unsigned _sp = 0; while (cond) { __builtin_amdgcn_s_sleep(1); \
    if ((++_sp & 255u) == 0u) { if (xb_ld(&(bar)[XB_TMO])) break; if (_sp > XB_SPIN_CAP) { atomicAdd(&(bar)[XB_TMO], 1u); break; } } } } while (0)
struct XcdBarrier { unsigned* bar; unsigned x; volatile LAS unsigned* st; };
__device__ __forceinline__ XcdBarrier xcd_barrier_post(unsigned* bar, volatile LAS unsigned* st) {
    XcdBarrier b; b.bar = bar; b.x = xb_xcc_id(); b.st = st;
    if (threadIdx.x == 0) (void)xb_add(&bar[XB_XCNT(b.x)], 1u);
    return b;
}
__device__ __forceinline__ void xcd_barrier_complete(unsigned* bar, unsigned x, unsigned& nloc, unsigned& nx) {
    const unsigned G = gridDim.x * gridDim.y * gridDim.z;
    unsigned sum, cnt, mine, sp = 0u;
    for (;;) {
        sum = 0u; cnt = 0u; mine = 0u;
#pragma unroll
        for (unsigned j = 0; j < 16; ++j) { const unsigned c = xb_ld(&bar[XB_XCNT(j)]); sum += c; cnt += (c > 0u) ? 1u : 0u; mine = (j == x) ? c : mine; }
        if (sum == G) break;
        __builtin_amdgcn_s_sleep(1);
        if ((++sp & 255u) == 0u) { if (xb_ld(&bar[XB_TMO])) break; if (sp > XB_SPIN_CAP) { atomicAdd(&bar[XB_TMO], 1u); break; } }
    }
    nloc = mine > 0u ? mine : 1u; nx = cnt > 0u ? cnt : 1u;
}
__device__ __forceinline__ void xcd_barrier(const XcdBarrier& b) {
    asm volatile("s_waitcnt vmcnt(0)" ::: "memory");
    __syncthreads();
    if (threadIdx.x == 0) {
        unsigned* bar = b.bar; asm volatile("" : "+v"(bar));
        __builtin_amdgcn_s_waitcnt(0);
        unsigned nloc = b.st[0], nx = b.st[1];
        if (nloc == 0u) { xcd_barrier_complete(bar, b.x, nloc, nx); b.st[0] = nloc; b.st[1] = nx; }
        const unsigned old = xb_add(&bar[XB_XSUB(b.x)], 1u);
        const unsigned gen = old / nloc;
        if (old + 1u == (gen + 1u) * nloc) {
            __builtin_amdgcn_fence(__ATOMIC_RELEASE, "agent");
            asm volatile("s_waitcnt vmcnt(0)" ::: "memory");
            const unsigned og = xb_add(&bar[XB_TOP], 1u);
            const unsigned tg = og / nx;
            if (og + 1u == (tg + 1u) * nx) xb_add(&bar[XB_TOPGEN], 1u);
            else XB_SPIN(xb_ld(&bar[XB_TOPGEN]) == tg, bar);
            __builtin_amdgcn_fence(__ATOMIC_ACQUIRE, "agent");
            xb_add(&bar[XB_XGEN(b.x)], 1u);
            asm volatile("s_waitcnt vmcnt(0)" ::: "memory");
        } else {
            XB_SPIN(xb_ld(&bar[XB_XGEN(b.x)]) == gen, bar);
            __builtin_amdgcn_fence(__ATOMIC_ACQUIRE, "agent");
            asm volatile("s_waitcnt vmcnt(0)" ::: "memory");
        }
    }
    __syncthreads();
}

#define XB2_XSUB(j) (64 * (j))
#define XB2_TOP     1024
#define XB2_TOPGEN  1088
__device__ __forceinline__ void xcd_split_arrive(unsigned* bar2, unsigned* bar, volatile LAS unsigned* st) {
    asm volatile("s_waitcnt vmcnt(0)" ::: "memory");
    __syncthreads();
    if (threadIdx.x == 0) {
        asm volatile("" : "+v"(bar2));
        __builtin_amdgcn_s_waitcnt(0);
        unsigned nloc = st[0], nx = st[1]; const unsigned x = xb_xcc_id();
        if (nloc == 0u) { xcd_barrier_complete(bar, x, nloc, nx); st[0] = nloc; st[1] = nx; }
        const unsigned old = xb_add(&bar2[XB2_XSUB(x)], 1u);
        if ((old + 1u) % nloc == 0u) {
            __builtin_amdgcn_fence(__ATOMIC_RELEASE, "agent");
            asm volatile("s_waitcnt vmcnt(0)" ::: "memory");
            const unsigned og = xb_add(&bar2[XB2_TOP], 1u);
            if ((og + 1u) % nx == 0u) xb_add(&bar2[XB2_TOPGEN], 1u);
            asm volatile("s_waitcnt vmcnt(0)" ::: "memory");
        }
    }
}
__device__ __forceinline__ void xcd_split_wait(unsigned* bar2, unsigned* bar, unsigned target) {
    if (threadIdx.x == 0) {
        asm volatile("" : "+v"(bar2));
        XB_SPIN(xb_ld(&bar2[XB2_TOPGEN]) < target, bar);
        __builtin_amdgcn_fence(__ATOMIC_ACQUIRE, "agent");
        asm volatile("s_waitcnt vmcnt(0)" ::: "memory");
    }
    __syncthreads();
}

__device__ __forceinline__ float wave_sum(float v) {
#pragma unroll
    for (int o = 1; o < 64; o <<= 1) v += __shfl_xor(v, o);
    return v;
}
template <class F>
__device__ __forceinline__ void transpose_load(const float* W, int ld, int nrows, F srccol, int item, int lane, f32x4 (&v)[8]) {
    const int nblk = nrows / 32, kb = item / nblk, nb = item % nblk, k0 = 64 * kb, s0 = srccol(32 * nb);
#pragma unroll
    for (int i = 0; i < 8; ++i) v[i] = __builtin_nontemporal_load((const f32x4*)(W + (size_t)(k0 + 8 * i + (lane >> 3)) * ld + s0 + 4 * (lane & 7)));
}
__host__ __device__ __forceinline__ int perm32(int rho) { const int n = rho >> 4, i = rho & 15; return 8 * (i >> 2) + 4 * n + (i & 3); }
template <bool PERM>
__device__ __forceinline__ void transpose_store(int K, bf16_t* WT, int nrows, const float* gk, LAS float* scr, int item, int lane, const f32x4 (&v)[8]) {
    const int nblk = nrows / 32, kb = item / nblk, nb = item % nblk, k0 = 64 * kb, n0 = 32 * nb;
#pragma unroll
    for (int i = 0; i < 8; ++i) { const int kk = 8 * i + (lane >> 3); const float g = gk ? gk[k0 + kk] : 1.0f;
#pragma unroll
        for (int e = 0; e < 4; ++e) scr[kk * 33 + 4 * (lane & 7) + e] = v[i][e] * g; }
    LDS_WAIT(); asm volatile("" ::: "memory");
    const int c = lane & 7;
#pragma unroll
    for (int j = 0; j < 4; ++j) { const int n = (lane >> 3) + 8 * j; const LAS float* s = scr + (8 * c) * 33 + (PERM ? perm32(n) : n);
        u32x4 o; o.x = cvt_pk_bf16(s[0 * 33], s[1 * 33]); o.y = cvt_pk_bf16(s[2 * 33], s[3 * 33]); o.z = cvt_pk_bf16(s[4 * 33], s[5 * 33]); o.w = cvt_pk_bf16(s[6 * 33], s[7 * 33]);
        *(u32x4*)(WT + (size_t)(n0 + n) * K + k0 + 8 * c) = o; }
    LDS_WAIT(); asm volatile("" ::: "memory");
}
struct ColIdent { int off; __device__ __forceinline__ int operator()(int r) const { return off + r; } };
struct ColSwiglu { __device__ __forceinline__ int operator()(int r) const { return ((r >> 7) & 1) * DFF + (r >> 8) * 128 + (r & 127); } };
struct ColMix { __device__ __forceinline__ int operator()(int r) const {
    const int tile = r >> 8, p = r & 255, o = 64 * ((p >> 5) & 3) + 32 * (p >> 7) + (p & 31);
    if (tile < 16) return r;
    if (tile < 20) return 6144 + (tile - 16) * 256 + o;
    if (tile < 24) return 7168 + (tile - 20) * 256 + o;
    if (tile < 28) return 8192 + (tile - 24) * 256 + p;
    return 9216 + (tile - 28) * 256 + p; } };
template <bool PERM = false, class F>
__device__ __forceinline__ void transpose_all(const float* W, int K, int ld, bf16_t* WT, int nrows, F srccol, const float* gk, LAS float* scr, int gw, int ngw, int lane) {
    const int nitems = (K / 64) * (nrows / 32);
    for (int it = gw; it < nitems; it += 2 * ngw) {
        f32x4 va[8], vb[8]; const int it2 = it + ngw;
        transpose_load(W, ld, nrows, srccol, it, lane, va);
        if (it2 < nitems) transpose_load(W, ld, nrows, srccol, it2, lane, vb);
        transpose_store<PERM>(K, WT, nrows, gk, scr, it, lane, va);
        if (it2 < nitems) transpose_store<PERM>(K, WT, nrows, gk, scr, it2, lane, vb);
    }
}
__device__ __forceinline__ void rms_rows_to_bf16(const float* x, const float* gain, bf16_t* o, int m0, int step, int nrows, int lane) {
    const f32x4* gr = (const f32x4*)gain + lane;
    for (int m = m0; m < nrows; m += 2 * step) {
        const int m2 = (m + step < nrows) ? m + step : m;
        const f32x4* xa = (const f32x4*)(x + (size_t)m * DM) + lane; const f32x4* xb2 = (const f32x4*)(x + (size_t)m2 * DM) + lane;
        f32x4 va[4], vb[4]; float sa = 0.f, sb = 0.f;
#pragma unroll
        for (int j = 0; j < 4; ++j) { va[j] = __builtin_nontemporal_load(xa + 64 * j); vb[j] = __builtin_nontemporal_load(xb2 + 64 * j); }
#pragma unroll
        for (int j = 0; j < 4; ++j) { sa += (va[j][0] * va[j][0] + va[j][1] * va[j][1]) + (va[j][2] * va[j][2] + va[j][3] * va[j][3]); sb += (vb[j][0] * vb[j][0] + vb[j][1] * vb[j][1]) + (vb[j][2] * vb[j][2] + vb[j][3] * vb[j][3]); }
        const float ra = __builtin_amdgcn_rsqf(wave_sum(sa) * (1.f / 1024.f) + EPS), rb = __builtin_amdgcn_rsqf(wave_sum(sb) * (1.f / 1024.f) + EPS);
        u32x2* oa = (u32x2*)(o + (size_t)m * DM) + lane; u32x2* ob = (u32x2*)(o + (size_t)m2 * DM) + lane;
#pragma unroll
        for (int j = 0; j < 4; ++j) { const f32x4 g = gr[64 * j]; oa[64 * j] = pack4(va[j] * ra * g); if (m2 != m) ob[64 * j] = pack4(vb[j] * rb * g); }
    }
}
__device__ __forceinline__ void rot_table(const int* pos, float* rot, int gt, int ngt) {
    for (int idx = gt; idx < SEQ * 128; idx += ngt) {
        const int s = idx >> 7, i = idx & 127;
        const float inv = exp2f(-(float)i * (13.287712379549449f / 128.0f));
        const float ang = (float)pos[s] * inv;
        const float kq = rintf(ang * 0.6366197723675814f);
        float r = fmaf(-kq, 1.5703125f, ang); r = fmaf(-kq, 4.837512969970703125e-4f, r); r = fmaf(-kq, 7.54978995489188216e-8f, r);
        const float r2 = r * r;
        const float sn = r + r * r2 * (-1.6666667e-1f + r2 * (8.3333333e-3f + r2 * (-1.9841270e-4f + r2 * 2.7557319e-6f)));
        const float cn = 1.0f + r2 * (-0.5f + r2 * (4.1666668e-2f + r2 * (-1.3888889e-3f + r2 * (2.4801587e-5f + r2 * -2.7557319e-7f))));
        const int qd = ((int)kq) & 3;
        const float c = (qd == 0) ? cn : (qd == 1) ? -sn : (qd == 2) ? -cn : sn;
        const float sv = (qd == 0) ? sn : (qd == 1) ? cn : (qd == 2) ? -sn : -cn;
        *(f32x2*)(rot + (size_t)idx * 2) = (f32x2){c, sv};
    }
}

constexpr int SCN_LD = 136, SCN_V_OFF = 64 * SCN_LD * 2, SCN_CH = 192 * SCN_LD * 2;
constexpr unsigned SCAN_UNITS_PER_FLAG = 8;
__device__ __forceinline__ void scan_unit(int u, const bf16_t* kts, const bf16_t* vt, bf16_t* S, LAS unsigned char* lds, unsigned* done  ) {
    const int tid = opaque_tid(), lane = tid & 63, wave = __builtin_amdgcn_readfirstlane(tid >> 6);
    const int fr = lane & 15, fq = lane >> 4, h = u >> 4, dg = (u >> 2) & 3, eg = u & 3, wd = wave & 1, we = wave >> 1;
    const float gC = __builtin_amdgcn_exp2f(128.0f * log2f(1.0f - __builtin_amdgcn_exp2f(-5.0f - (float)h)));
    f32x4 acc[2][2];
#pragma unroll
    for (int a = 0; a < 2; ++a)
#pragma unroll
        for (int b = 0; b < 2; ++b) acc[a][b] = (f32x4){0.f, 0.f, 0.f, 0.f};
    const bf16_t* ksrc = kts + (size_t)(h * 256 + 64 * dg + (tid >> 4)) * SEQ + (tid & 15) * 8;
    const bf16_t* vsrc = vt + (size_t)(h * 512 + 128 * eg + (tid >> 4)) * SEQ + (tid & 15) * 8;
    u32x4 pk[2][2], pv[2][4];
#pragma unroll
    for (int i = 0; i < 2; ++i) {
#pragma unroll
        for (int j = 0; j < 2; ++j) pk[i][j] = *(const u32x4*)(ksrc + (size_t)(32 * j) * SEQ + i * 128);
#pragma unroll
        for (int j = 0; j < 4; ++j) pv[i][j] = *(const u32x4*)(vsrc + (size_t)(32 * j) * SEQ + i * 128);
    }
    bf16_t* sdst = S + ((size_t)(h * 16) * 512 + 128 * eg + 32 * we + fr) * 256 + 64 * dg + 32 * wd + 4 * fq;
#pragma unroll
    for (int r = 0; r < 8; ++r) {
        __syncthreads();
#pragma unroll
        for (int i = 0; i < 2; ++i) {
            if (2 * r + i < 15) {
                LAS bf16_t* lk = (LAS bf16_t*)(lds + i * SCN_CH); LAS bf16_t* lv = (LAS bf16_t*)(lds + i * SCN_CH + SCN_V_OFF);
#pragma unroll
                for (int j = 0; j < 2; ++j) *(LAS u32x4*)(lk + (32 * j + (tid >> 4)) * SCN_LD + (tid & 15) * 8) = pk[i][j];
#pragma unroll
                for (int j = 0; j < 4; ++j) *(LAS u32x4*)(lv + (32 * j + (tid >> 4)) * SCN_LD + (tid & 15) * 8) = pv[i][j];
            }
        }
        __syncthreads();
        if (r < 7) {
#pragma unroll
            for (int i = 0; i < 2; ++i) { const int c = 2 * (r + 1) + i;
                if (c < 15) {
#pragma unroll
                    for (int j = 0; j < 2; ++j) pk[i][j] = *(const u32x4*)(ksrc + (size_t)(32 * j) * SEQ + c * 128);
#pragma unroll
                    for (int j = 0; j < 4; ++j) pv[i][j] = *(const u32x4*)(vsrc + (size_t)(32 * j) * SEQ + c * 128);
                } }
        }
#pragma unroll
        for (int i = 0; i < 2; ++i) {
            const int c = 2 * r + i;
#pragma unroll
            for (int td = 0; td < 2; ++td)
#pragma unroll
                for (int te = 0; te < 2; ++te) { const u32x2 w = pack4(acc[td][te]);
                    __hip_atomic_store((unsigned long long*)(sdst + (size_t)c * 512 * 256 + (size_t)(16 * te) * 256 + 16 * td), ((unsigned long long)w.y << 32) | w.x, __ATOMIC_RELAXED, __HIP_MEMORY_SCOPE_AGENT); }
            if (c < 15) {
                const LAS bf16_t* lk = (const LAS bf16_t*)(lds + i * SCN_CH); const LAS bf16_t* lv = (const LAS bf16_t*)(lds + i * SCN_CH + SCN_V_OFF);
                f32x4 tm[2][2];
#pragma unroll
                for (int td = 0; td < 2; ++td)
#pragma unroll
                    for (int te = 0; te < 2; ++te) tm[td][te] = (f32x4){0.f, 0.f, 0.f, 0.f};
#pragma unroll
                for (int ks = 0; ks < 4; ++ks) {
                    bf16x8 a[2], b[2];
#pragma unroll
                    for (int t = 0; t < 2; ++t) { a[t] = *(const LAS bf16x8*)(lk + (32 * wd + 16 * t + fr) * SCN_LD + 32 * ks + 8 * fq); b[t] = *(const LAS bf16x8*)(lv + (32 * we + 16 * t + fr) * SCN_LD + 32 * ks + 8 * fq); }
#pragma unroll
                    for (int td = 0; td < 2; ++td)
#pragma unroll
                        for (int te = 0; te < 2; ++te) tm[td][te] = mfma16(a[td], b[te], tm[td][te]);
                }
#pragma unroll
                for (int td = 0; td < 2; ++td)
#pragma unroll
                    for (int te = 0; te < 2; ++te) acc[td][te] = acc[td][te] * gC + tm[td][te];
            }
        }
    }
    asm volatile("s_waitcnt vmcnt(0)" ::: "memory");
    __syncthreads();
    if (tid == 0) __hip_atomic_fetch_add(done + ((h * 2 + (eg >> 1)) * 64), 1u, __ATOMIC_RELAXED, __HIP_MEMORY_SCOPE_AGENT);
}
constexpr int RQ_LD = 264, SC_LD = 136, RO_SC_OFF = 128 * RQ_LD * 2, RO_PART_OFF = RO_SC_OFF + 128 * SC_LD * 2;
__device__ __forceinline__ void retout_unit(int h, int c, int eh, const bf16_t* q, const bf16_t* k, const bf16_t* vt, const bf16_t* S, bf16_t* ret  , float* rssq, LAS unsigned char* lds, unsigned* done, unsigned* tmo) {
    const int tid = opaque_tid(), lane = tid & 63, wave = __builtin_amdgcn_readfirstlane(tid >> 6);
    const int fr = lane & 15, fq = lane >> 4;
    LAS bf16_t* ql = (LAS bf16_t*)lds; LAS bf16_t* sc = (LAS bf16_t*)(lds + RO_SC_OFF); LAS float* part = (LAS float*)(lds + RO_PART_OFF);
    const float lg2 = log2f(1.0f - __builtin_amdgcn_exp2f(-5.0f - (float)h));
    const int tok0 = c * 128;
#pragma unroll
    for (int i = 0; i < 8; ++i) { const int p = tid + 512 * i, row = p >> 5, c16 = p & 31;
        *(LAS u32x4*)(ql + row * RQ_LD + c16 * 8) = *(const u32x4*)(q + (size_t)(tok0 + row) * 1024 + h * 256 + c16 * 8); }
    const bf16_t* sp = S + ((size_t)((h * 16 + c) * 512 + 256 * eh + 32 * wave + fr)) * 256 + 8 * fq;
    const bf16_t* vp = vt + (size_t)(h * 512 + 256 * eh + 32 * wave + fr) * SEQ + tok0 + 8 * fq;
    __syncthreads();
    {
        const int tj = wave;
        bf16x8 kf[8];
        const bf16_t* kp = k + (size_t)(tok0 + 16 * tj + fr) * 1024 + h * 256 + 8 * fq;
#pragma unroll
        for (int ks = 0; ks < 8; ++ks) kf[ks] = *(const bf16x8*)(kp + 32 * ks);
#pragma unroll
        for (int ti = 0; ti < 8; ++ti) {
            if (ti >= tj) {
                f32x4 s2 = (f32x4){0.f, 0.f, 0.f, 0.f};
#pragma unroll
                for (int ks = 0; ks < 8; ++ks) { const bf16x8 qf = *(const LAS bf16x8*)(ql + (16 * ti + fr) * RQ_LD + 32 * ks + 8 * fq); s2 = mfma16(kf[ks], qf, s2); }
                const int i = 16 * ti + fr; f32x4 v;
#pragma unroll
                for (int r = 0; r < 4; ++r) { const int j = 16 * tj + 4 * fq + r; v[r] = (i >= j) ? s2[r] * __builtin_amdgcn_exp2f(lg2 * (float)(i - j)) : 0.f; }
                *(LAS u32x2*)(sc + (16 * ti + fr) * SC_LD + 16 * tj + 4 * fq) = pack4(v);
            } else if (ti == tj - 1 && (tj & 1)) {
                *(LAS u32x2*)(sc + (16 * ti + fr) * SC_LD + 16 * tj + 4 * fq) = (u32x2){0u, 0u};
            }
        }
    }
    if (tid < 64) {
        unsigned* f = done + ((h * 2 + eh) * 64); unsigned sp = 0;
        while ((unsigned)__builtin_amdgcn_readfirstlane(__hip_atomic_load(f, __ATOMIC_RELAXED, __HIP_MEMORY_SCOPE_AGENT)) < SCAN_UNITS_PER_FLAG) {
            __builtin_amdgcn_s_sleep(2);
            if (++sp > (1u << 20)) { if (tid == 0) __hip_atomic_store(tmo, 1u, __ATOMIC_RELAXED, __HIP_MEMORY_SCOPE_AGENT); break; }
        }
        __builtin_amdgcn_fence(__ATOMIC_ACQUIRE, "agent");
        asm volatile("s_waitcnt vmcnt(0)" ::: "memory");
    }
    __syncthreads();
    f32x4 acc[8][2];
#pragma unroll
    for (int a = 0; a < 8; ++a)
#pragma unroll
        for (int b = 0; b < 2; ++b) acc[a][b] = (f32x4){0.f, 0.f, 0.f, 0.f};
#pragma unroll
    for (int ks = 0; ks < 8; ++ks) {
        bf16x8 sf[2], qf[8];
#pragma unroll
        for (int t = 0; t < 2; ++t) sf[t] = *(const bf16x8*)(sp + (size_t)(16 * t) * 256 + 32 * ks);
#pragma unroll
        for (int t = 0; t < 8; ++t) qf[t] = *(const LAS bf16x8*)(ql + (16 * t + fr) * RQ_LD + 32 * ks + 8 * fq);
#pragma unroll
        for (int a = 0; a < 8; ++a)
#pragma unroll
            for (int b = 0; b < 2; ++b) acc[a][b] = mfma16(sf[b], qf[a], acc[a][b]);
    }
#pragma unroll
    for (int a = 0; a < 8; ++a) { const float qd = __builtin_amdgcn_exp2f(lg2 * (float)(16 * a + fr + 1));
#pragma unroll
        for (int b = 0; b < 2; ++b) acc[a][b] = acc[a][b] * qd; }
#pragma unroll
    for (int ks = 0; ks < 4; ++ks) {
        bf16x8 vf[2];
#pragma unroll
        for (int t = 0; t < 2; ++t) vf[t] = *(const bf16x8*)(vp + (size_t)(16 * t) * SEQ + 32 * ks);
#pragma unroll
        for (int a = 0; a < 8; ++a) {
            if (a >= 2 * ks) {
                const bf16x8 pf = *(const LAS bf16x8*)(sc + (16 * a + fr) * SC_LD + 32 * ks + 8 * fq);
#pragma unroll
                for (int b = 0; b < 2; ++b) acc[a][b] = mfma16(vf[b], pf, acc[a][b]);
            }
        }
    }
#pragma unroll
    for (int a = 0; a < 8; ++a) {
        float ss = 0.f;
#pragma unroll
        for (int b = 0; b < 2; ++b) { const f32x4 t = acc[a][b]; ss += (t[0] * t[0] + t[1] * t[1]) + (t[2] * t[2] + t[3] * t[3]); }
        ss += __shfl_xor(ss, 16); ss += __shfl_xor(ss, 32);
        if (fq == 0) part[wave * 128 + 16 * a + fr] = ss;
    }
    __syncthreads();
    if (tid < 128) {
        float tot = 0.f;
#pragma unroll
        for (int w = 0; w < 8; ++w) tot += part[w * 128 + tid];
        rssq[(size_t)(tok0 + tid) * 8 + 2 * h + eh] = tot;
    }
#pragma unroll
    for (int a = 0; a < 8; ++a)
#pragma unroll
        for (int b = 0; b < 2; ++b)
            *(u32x2*)(ret + (size_t)(tok0 + 16 * a + fr) * 2048 + h * 512 + 256 * eh + 32 * wave + 16 * b + 4 * fq) = pack4(acc[a][b]);
    __syncthreads();
}
constexpr int PL_LD = 264, MA_KV_BYTES = 64 * 264 * 2, MA_P_OFF = MA_KV_BYTES;
__device__ __forceinline__ void memattn_unit(int b, int h, int rb, const bf16_t* mkn, const bf16_t* mvt, bf16_t* mo  , LAS unsigned char* lds) {
    const bf16_t* mq = mo;
    const int tid = opaque_tid(), lane = tid & 63, wave = __builtin_amdgcn_readfirstlane(tid >> 6);
    const int fr = lane & 15, fq = lane >> 4;
    LAS bf16_t* kv = (LAS bf16_t*)lds; LAS bf16_t* pl = (LAS bf16_t*)(lds + MA_P_OFF) + wave * (16 * PL_LD);
    const int row = 128 * rb + 16 * wave + fr;
    const bf16_t* ksrc = mkn + (size_t)(b * 256) * 1024 + h * 256;
    const bf16_t* vsrc = mvt + (size_t)((b * 4 + h) * 256) * 256;
    u32x4 pre[4];
#pragma unroll
    for (int i = 0; i < 4; ++i) { const int p = tid + 512 * i; pre[i] = *(const u32x4*)(ksrc + (size_t)(p >> 5) * 1024 + (p & 31) * 8); }
    bf16x8 qf[8]; float qs = 0.f;
#pragma unroll
    for (int ks = 0; ks < 8; ++ks) { qf[ks] = *(const bf16x8*)(mq + (size_t)row * 1024 + h * 256 + 32 * ks + 8 * fq);
#pragma unroll
        for (int j = 0; j < 8; ++j) { const float f = bf2f((unsigned short)qf[ks][j]); qs += f * f; } }
    qs += __shfl_xor(qs, 16); qs += __shfl_xor(qs, 32);
    const float scl = __builtin_amdgcn_rsqf(qs * (1.0f / 256.0f) + EPS) * (0.0625f * LOG2E);
    f32x4 sa[16];
#pragma unroll
    for (int kc = 0; kc < 4; ++kc) {
        __syncthreads();
#pragma unroll
        for (int i = 0; i < 4; ++i) { const int p = tid + 512 * i; *(LAS u32x4*)(kv + (p >> 5) * PL_LD + (p & 31) * 8) = pre[i]; }
        __syncthreads();
#pragma unroll
        for (int i = 0; i < 4; ++i) { const int p = tid + 512 * i;
            pre[i] = (kc < 3) ? *(const u32x4*)(ksrc + (size_t)(64 * (kc + 1) + (p >> 5)) * 1024 + (p & 31) * 8) : *(const u32x4*)(vsrc + (size_t)(p >> 5) * 256 + (p & 31) * 8); }
#pragma unroll
        for (int tl = 0; tl < 4; ++tl) {
            f32x4 a = (f32x4){0.f, 0.f, 0.f, 0.f};
#pragma unroll
            for (int ks = 0; ks < 8; ++ks) { const bf16x8 kf = *(const LAS bf16x8*)(kv + (16 * tl + fr) * PL_LD + 32 * ks + 8 * fq); a = mfma16(kf, qf[ks], a); }
            sa[4 * kc + tl] = a * scl;
        }
    }
    float mx = -INFINITY;
#pragma unroll
    for (int t = 0; t < 16; ++t) mx = fmaxf(mx, fmaxf(fmaxf(sa[t][0], sa[t][1]), fmaxf(sa[t][2], sa[t][3])));
    mx = fmaxf(mx, __shfl_xor(mx, 16)); mx = fmaxf(mx, __shfl_xor(mx, 32));
    float l = 0.f;
#pragma unroll
    for (int t = 0; t < 16; ++t) {
        f32x4 p;
#pragma unroll
        for (int r = 0; r < 4; ++r) { p[r] = __builtin_amdgcn_exp2f(sa[t][r] - mx); l += p[r]; }
        *(LAS u32x2*)(pl + fr * PL_LD + 16 * t + 4 * fq) = pack4(p);
    }
    l += __shfl_xor(l, 16); l += __shfl_xor(l, 32);
    const float rl = __builtin_amdgcn_rcpf(l);
    LDS_WAIT(); asm volatile("" ::: "memory");
    bf16x8 pf[8];
#pragma unroll
    for (int ks = 0; ks < 8; ++ks) pf[ks] = *(const LAS bf16x8*)(pl + fr * PL_LD + 32 * ks + 8 * fq);
#pragma unroll
    for (int dc = 0; dc < 4; ++dc) {
        __syncthreads();
#pragma unroll
        for (int i = 0; i < 4; ++i) { const int p = tid + 512 * i; *(LAS u32x4*)(kv + (p >> 5) * PL_LD + (p & 31) * 8) = pre[i]; }
        __syncthreads();
        if (dc < 3) {
#pragma unroll
            for (int i = 0; i < 4; ++i) { const int p = tid + 512 * i; pre[i] = *(const u32x4*)(vsrc + (size_t)(64 * (dc + 1) + (p >> 5)) * 256 + (p & 31) * 8); }
        }
#pragma unroll
        for (int tl = 0; tl < 4; ++tl) {
            f32x4 a = (f32x4){0.f, 0.f, 0.f, 0.f};
#pragma unroll
            for (int ks = 0; ks < 8; ++ks) { const bf16x8 vf = *(const LAS bf16x8*)(kv + (16 * tl + fr) * PL_LD + 32 * ks + 8 * fq); a = mfma16(vf, pf[ks], a); }
            *(u32x2*)(mo + (size_t)row * 1024 + h * 256 + 64 * dc + 16 * tl + 4 * fq) = pack4(a * rl);
        }
    }
    __syncthreads();
}
__device__ __forceinline__ void dif_row(const bf16_t* o0, const bf16_t* o1, bf16_t* dif, const float* gout, float lam, int lane) {
    const u32x4* a = (const u32x4*)o0 + 2 * lane; const u32x4* b = (const u32x4*)o1 + 2 * lane;
    float d[16]; float ss = 0.f;
#pragma unroll
    for (int v = 0; v < 2; ++v) { const u32x4 x = __builtin_nontemporal_load(a + v), y = __builtin_nontemporal_load(b + v);
#pragma unroll
        for (int w = 0; w < 4; ++w) { const float x0 = __uint_as_float(x[w] << 16), x1 = __uint_as_float(x[w] & 0xffff0000u), y0 = __uint_as_float(y[w] << 16), y1 = __uint_as_float(y[w] & 0xffff0000u);
            const float d0 = x0 - lam * y0, d1 = x1 - lam * y1; d[v * 8 + w * 2] = d0; d[v * 8 + w * 2 + 1] = d1; ss += d0 * d0 + d1 * d1; } }
    ss += __shfl_xor(ss, 1); ss += __shfl_xor(ss, 2); ss += __shfl_xor(ss, 4);
    const float rn = __builtin_amdgcn_rsqf(ss * (1.0f / 128.0f) + EPS) * (1.0f - LAM_INIT);
    const float* gp = gout + (lane & 7) * 16;
    u32x4 o[2];
#pragma unroll
    for (int v = 0; v < 2; ++v)
#pragma unroll
        for (int w = 0; w < 4; ++w) o[v][w] = cvt_pk_bf16(d[v * 8 + w * 2] * rn * gp[v * 8 + w * 2], d[v * 8 + w * 2 + 1] * rn * gp[v * 8 + w * 2 + 1]);
    u32x4* op = (u32x4*)dif + 2 * lane; op[0] = o[0]; op[1] = o[1];
}

struct P4bOrder {
    pg8::StaticOrder T; unsigned char* ws; const char* xa;
    __device__ __forceinline__ bool next(int i, pg8::Unit& u) const {
        int pm, pn; if (!T.tile(i, pm, pn)) return false;
        u.pm = pm; u.pn = pn; u.ui = i; u.ri = i; u.tag = 0; u.K = 1024;
        u.A = xa + (size_t)pm * 256 * 1024 * 2;
        u.Bt = (const char*)ws + (pn < 8 ? WS_WRG + (size_t)pn * 256 * 1024 * 2 : WS_WGATE + (size_t)(pn - 8) * 256 * 1024 * 2); return true;
    }
};
struct P5Order {
    pg8::StaticOrder T; unsigned char* ws;
    __device__ __forceinline__ bool next(int i, pg8::Unit& u) const {
        const int ti = i / 3, kbr = i - 3 * ti; int pm, pn; if (!T.tile(ti, pm, pn)) return false;
        const size_t offA = kbr == 0 ? WS_RET : kbr == 1 ? WS_DIF : WS_MO;
        const size_t offB = kbr == 0 ? WS_WBRR : kbr == 1 ? WS_WBRD : WS_WBRM;
        const int K = kbr == 0 ? 2048 : 1024;
        u.pm = pm; u.pn = pn; u.ui = i; u.ri = ti; u.tag = kbr; u.K = K;
        u.A = (const char*)ws + offA + (size_t)pm * 256 * K * 2; u.Bt = (const char*)ws + offB + (size_t)pn * 256 * K * 2; return true;
    }
};
#ifndef PH_MASK
#define PH_MASK 0xffffffffu
#endif
#define PH(n) ((PH_MASK >> (n)) & 1u)
#ifndef DUP_MASK
#define DUP_MASK 0u
#endif
#ifndef PROBE_K
#define PROBE_K (-1)
#endif
#define RUNP(k) (pass_ == 1 || (k) <= PROBE_K)
#define REP(n) _Pragma("unroll 1") for (int rep_ = 0; rep_ < 1 + (int)((DUP_MASK >> (n)) & 1u); ++rep_)
struct Args { const void* in[26]; float* out; unsigned char* ws; };
#define CAS __attribute__((address_space(4)))
__device__ __forceinline__ const void* karg(int i) { typedef const GAS void* gptr; const CAS gptr* p = (const CAS gptr*)__builtin_amdgcn_kernarg_segment_ptr(); asm volatile("" : "+s"(p)); return (const void*)p[i]; }
#define INP(i) ((const float*)karg(i))
#define WSP(T, off) ((T*)((unsigned char*)karg(27) + (off)))
#define OUTP ((float*)karg(26))
struct SplitWait {
    unsigned target;
    __device__ __forceinline__ void wait() const { if (target) xcd_split_wait((unsigned*)WSP(unsigned, WS_CTL) + CW_BAR2, (unsigned*)WSP(unsigned, WS_CTL) + CW_BAR, target); }
};
__global__ void __launch_bounds__(NWAVES * 64, 2) mk_fwd(Args args) {
    extern __shared__ __attribute__((aligned(16))) unsigned char lds_raw[];
    LAS unsigned char* lds = (LAS unsigned char*)lds_raw;
    volatile LAS unsigned* MISC = (volatile LAS unsigned*)(lds + MISC_OFF);
    const int G = gridDim.x, bx = blockIdx.x;
    for (int u = threadIdx.x; u < (LDS_BYTES - LDSCTL_OFF) / 4; u += NWAVES * 64) ((LAS unsigned*)(lds + LDSCTL_OFF))[u] = 0u;
    __syncthreads();
    (void)xcd_barrier_post((unsigned*)WSP(unsigned, WS_CTL) + CW_BAR, MISC + 8);
#define GRID_BAR() do { XcdBarrier b_; b_.bar = (unsigned*)WSP(unsigned, WS_CTL) + CW_BAR; b_.x = xb_xcc_id(); b_.st = (volatile LAS unsigned*)(lds + MISC_OFF) + 8; xcd_barrier(b_); } while (0)
#define SPLIT_ARRIVE() do { xcd_split_arrive((unsigned*)WSP(unsigned, WS_CTL) + CW_BAR2, (unsigned*)WSP(unsigned, WS_CTL) + CW_BAR, (volatile LAS unsigned*)(lds + MISC_OFF) + 8); ++sgen; } while (0)
    unsigned sgen = 0;
    const int NGW = G * NWAVES, NGT = G * NWAVES * 64;
#define LANE_VARS() const int tid = opaque_tid(), lane = tid & 63, wave = __builtin_amdgcn_readfirstlane(tid >> 6); LAS float* scr = (LAS float*)(lds + wave * 16384); \
    const int gw = bx * NWAVES + wave, gt = bx * (NWAVES * 64) + tid; (void)scr; (void)gw; (void)gt; (void)lane

#pragma unroll 1
    for (int pass_ = (PROBE_K >= 0 ? 0 : 1); pass_ < 2; ++pass_) {
    if (RUNP(0)) {
    REP(0) if (PH(0)) {
        LANE_VARS();
        transpose_all<true>(INP(4), 1024, 2 * DFF, WSP(bf16_t, WS_WF1I), 2 * DFF, ColSwiglu{}, nullptr, scr, gw, NGW, lane);
        transpose_all(INP(18), 1024, 2048, WSP(bf16_t, WS_WMKV), 2048, ColIdent{0}, nullptr, scr, gw, NGW, lane);
        { const float* x = INP(0); const float* g1 = INP(3); bf16_t* xb = WSP(bf16_t, WS_XBL);
          rms_rows_to_bf16(x, g1, xb, gw, NGW, TOK, lane); }
        { const float* mem = INP(1); const float* gm = INP(17); bf16_t* memn = WSP(bf16_t, WS_MEMN);
          rms_rows_to_bf16(mem, gm, memn, gw, NGW, NB * MEML, lane); }
        rot_table((const int*)karg(2), WSP(float, WS_ROT), gt, NGT);
    }
    GRID_BAR();
    }

    if (RUNP(1)) {
    REP(1) if (PH(1)) {
        pg8::Gemm g{WSP(bf16_t, WS_XBL), WSP(bf16_t, WS_WF1I), TOK, 2 * DFF, 1024}; pg8::StaticOrder S; S.init(TOK, 2 * DFF, G, bx);
        EpiSwiglu E{WSP(bf16_t, WS_ACT), nullptr};
        S.set(g); pg8::gemm_phase(lds, S, E);
    }
    if (PH(2)) {
        pg8::Gemm g{WSP(bf16_t, WS_MEMN), WSP(bf16_t, WS_WMKV), NB * MEML, 2048, 1024}; pg8::StaticOrder S; S.init(NB * MEML, 2048, G, (bx + G / 2) % G);
        EpiPlain E{WSP(bf16_t, WS_MKVRAW), 2048};
        S.set(g); pg8::gemm_phase(lds, S, E);
    }
    if (PH(0)) {
        const int q0 = (3 * G) / 4, nq = G - q0;
        if (bx >= q0) {
            LANE_VARS();
            const int gw2 = (bx - q0) * NWAVES + wave, ngw2 = nq * NWAVES;
            transpose_all(INP(5), DFF, 1024, WSP(bf16_t, WS_WF1O), 1024, ColIdent{0}, nullptr, scr, gw2, ngw2, lane);
            transpose_all<true>(INP(7), 1024, 13312, WSP(bf16_t, WS_WMIX), NMIX, ColMix{}, INP(6), scr, gw2, ngw2, lane);
        }
    }
    GRID_BAR();
    }

    if (RUNP(2)) {
    REP(3) if (PH(3)) {
        pg8::Gemm g{WSP(bf16_t, WS_ACT), WSP(bf16_t, WS_WF1O), TOK, 1024, DFF}; pg8::StaticOrder S; S.init(TOK, 1024, G, bx);
        EpiResid<false, false> E{INP(0), nullptr, (bf16_t*)OUTP, WSP(float, WS_SSQ1), 0.5f, (rep_ == 1 && ((DUP_MASK >> 23) & 1u)) ? 1 : 0};
        S.set(g); pg8::gemm_phase(lds, S, E);
    }
    if (PH(0)) {
        LANE_VARS();
        const bf16_t* mkvraw = WSP(bf16_t, WS_MKVRAW); bf16_t* mkn = WSP(bf16_t, WS_MKN); bf16_t* mvt = WSP(bf16_t, WS_MVT);
        const float* g_mem_k = INP(16); const float* g_mem_q = INP(15);
        for (int j = gw; j < NB * MEML * 4; j += NGW) {
            const int row = j >> 2, h = j & 3;
            const u32x2 w = *((const u32x2*)(mkvraw + (size_t)row * 2048 + h * 256) + lane);
            f32x4 v = (f32x4){__uint_as_float(w.x << 16), __uint_as_float(w.x & 0xffff0000u), __uint_as_float(w.y << 16), __uint_as_float(w.y & 0xffff0000u)};
            const float ss = wave_sum((v[0] * v[0] + v[1] * v[1]) + (v[2] * v[2] + v[3] * v[3]));
            const float rn = __builtin_amdgcn_rsqf(ss * (1.0f / 256.0f) + EPS);
            const f32x4 gk = *((const f32x4*)g_mem_k + lane), gq = *((const f32x4*)g_mem_q + lane);
            *((u32x2*)(mkn + (size_t)row * 1024 + h * 256) + lane) = pack4(v * rn * gk * gq);
        }
        for (int idx = gt; idx < NB * 4 * 256 * 256; idx += NGT) {
            const int key = idx & 255, d = (idx >> 8) & 255, bh = idx >> 16, b = bh >> 2, h = bh & 3;
            mvt[idx] = mkvraw[(size_t)(b * 256 + key) * 2048 + 1024 + h * 256 + d];
        }
    }
    GRID_BAR();
    }

    if (RUNP(3))
    for (int ph = 0; ph <= NB; ++ph) {
        const int gp = ph, gm = ph - 1;
        unsigned char* const wsP = WSP(unsigned char, 0) - (((gp + 1) & 1) ? SET_DELTA : 0);
        unsigned char* const wsB = WSP(unsigned char, 0) - (((gm + 1) & 1) ? SET_DELTA : 0);
        unsigned* done = (unsigned*)WSP(unsigned, WS_CTL) + CW_SCAN + ((pass_ * NB + (gm < 0 ? 0 : gm)) * 8) * 64; unsigned* tmo = (unsigned*)WSP(unsigned, WS_CTL) + CW_BAR + XB_TMO;
        const bool early = (gm >= 0 && bx < 64) || gp >= NB;
        if (early) { SplitWait H{sgen}; H.wait(); }
        if (gm >= 0)
            for (int u = bx; u < 64; u += G) { __syncthreads(); if (PH(5)) scan_unit(u, (const bf16_t*)(wsB + WS_KTS), (const bf16_t*)(wsB + WS_VT), WSP(bf16_t, WS_S), lds, done); }
        if (gp < NB) {
            REP(4) if (PH(4)) {
                pg8::Gemm g{(const bf16_t*)OUTP + (size_t)gp * SEQ * DM, WSP(bf16_t, WS_WMIX), SEQ, NMIX, 1024}; pg8::StaticOrder S; S.init(SEQ, NMIX, G, bx);
                prep_rs(WSP(float, WS_SSQ1), gp * SEQ, S, lds);
                EpiMix E{(const LAS float*)(lds + RTAB_OFF), WSP(float, (gp & 1) ? WS_ROTB : WS_ROT), wsP, WSP(bf16_t, WS_MO) + (size_t)gp * SEQ * 1024, INP(8), INP(9)};
                SplitWait H{early ? 0u : sgen};
                S.set(g); pg8::gemm_phase(lds, S, E, H);
                if (bx >= (SEQ / 256) * (NMIX / 256)) H.wait();
            }
        }
        if (gm >= 0) {
            const size_t oOff = (gm & 1) ? WS_OB : 0;
            unsigned* qctr = (unsigned*)WSP(unsigned, WS_CTL) + CW_QUEUE + (pass_ * NB + gm) * 64;
            volatile LAS unsigned* qslot = (volatile LAS unsigned*)(lds + MISC_OFF) + 16;
            for (;;) {
                __syncthreads();
                if (threadIdx.x == 0) qslot[0] = __hip_atomic_fetch_add(qctr, 1u, __ATOMIC_RELAXED, __HIP_MEMORY_SCOPE_AGENT);
                __syncthreads();
                const int id = __builtin_amdgcn_readfirstlane((int)qslot[0]);
                if (id >= 448) break;
                int aq = -1, aj = 0;
                if (id < 64) { aq = 7 - (id >> 5); aj = id & 31; }
                else if (id < 192) { const int ro = id - 64;
                    if (PH(8)) retout_unit(ro >> 5, (ro >> 1) & 15, ro & 1, (const bf16_t*)(wsB + WS_Q), (const bf16_t*)(wsB + WS_K), (const bf16_t*)(wsB + WS_VT), WSP(bf16_t, WS_S),
                                           WSP(bf16_t, WS_RET) + (size_t)gm * SEQ * 2048, WSP(float, WS_SSQ2) + (size_t)gm * SEQ * 8, lds, done, tmo); }
                else if (id < 224) { aq = 5; aj = id - 192; }
                else if (id < 288) { const int m = id - 224;
                    if (PH(7)) memattn_unit(gm, m >> 4, m & 15, WSP(bf16_t, WS_MKN), WSP(bf16_t, WS_MVT), WSP(bf16_t, WS_MO) + (size_t)gm * SEQ * 1024, lds); }
                else { aq = 4 - ((id - 288) >> 5); aj = (id - 288) & 31; }
                if (aq >= 0) {
                    const int hc = aj >> 1, vh = aj & 1, hh = hc >> 1, cc = hc & 1;
                    if (PH(6)) attn_body::attn_unit<8>(hc, 2 * hh + vh, aq, (const attn_body::bf16*)(wsB + WS_DQ), (const attn_body::bf16*)(wsB + WS_DK), (const attn_body::bf16*)(wsB + WS_DV),
                                            WSP(attn_body::bf16, (cc ? WS_O1 : WS_O0) + oOff), (char*)lds_raw);
                }
            }
        }
        {
            LANE_VARS();
            if (ph >= 2) {
                const int gd = ph - 2; const size_t oD = (gd & 1) ? WS_OB : 0;
                const float s1 = wave_sum(INP(10)[lane] * INP(11)[lane]), s2 = wave_sum(INP(12)[lane] * INP(13)[lane]); const float lam = __expf(s1) - __expf(s2) + LAM_INIT;
                const bf16_t* bo0 = WSP(bf16_t, WS_O0 + oD); const bf16_t* bo1 = WSP(bf16_t, WS_O1 + oD); bf16_t* difb = WSP(bf16_t, WS_DIF); const float* gdo = INP(14);
                for (int r = gw; r < SEQ; r += NGW) dif_row(bo0 + (size_t)r * 1024, bo1 + (size_t)r * 1024, difb + ((size_t)gd * SEQ + r) * 1024, gdo, lam, lane);
            }
            if (ph + 1 < NB) rot_table((const int*)karg(2) + (ph + 1) * SEQ, WSP(float, ((ph + 1) & 1) ? WS_ROTB : WS_ROT), gt, NGT);
            if (ph == 0) transpose_all<true>(INP(7), 1024, 13312, WSP(bf16_t, WS_WRG), 2048, ColIdent{4096}, INP(6), scr, gw, NGW, lane);
            if (ph == NB) {
                transpose_all<true>(INP(7), 1024, 13312, WSP(bf16_t, WS_WGATE), 3072, ColIdent{10240}, INP(6), scr, gw, NGW, lane);
            }
        }
        SPLIT_ARRIVE();
    }

    if (RUNP(4)) {
    if (PH(9)) {
        pg8::StaticOrder T; T.init(TOK, 5120, G, bx);
        prep_rs(WSP(float, WS_SSQ1), 0, T, lds);
        P4bOrder S{T, WSP(unsigned char, 0), (const char*)OUTP};
        EpiRgG E{(const LAS float*)(lds + RTAB_OFF), WSP(bf16_t, WS_RET), WSP(float, WS_SSQ2), WSP(unsigned char, 0)};
        SplitWait H{sgen};
        pg8::gemm_phase(lds, S, E, H);
        if (bx >= (TOK / 256) * (5120 / 256)) H.wait();
    }
    if (PH(0)) {
        LANE_VARS();
        { const float s1 = wave_sum(INP(10)[lane] * INP(11)[lane]), s2 = wave_sum(INP(12)[lane] * INP(13)[lane]); const float lam = __expf(s1) - __expf(s2) + LAM_INIT;
          const bf16_t* bo0 = WSP(bf16_t, WS_O0 + (((NB - 1) & 1) ? WS_OB : 0)); const bf16_t* bo1 = WSP(bf16_t, WS_O1 + (((NB - 1) & 1) ? WS_OB : 0)); bf16_t* difb = WSP(bf16_t, WS_DIF); const float* gdo = INP(14);
          for (int r = gw; r < SEQ; r += NGW) dif_row(bo0 + (size_t)r * 1024, bo1 + (size_t)r * 1024, difb + ((size_t)(NB - 1) * SEQ + r) * 1024, gdo, lam, lane); }
        transpose_all<true>(INP(19), 2048, 1024, WSP(bf16_t, WS_WBRR), 1024, ColIdent{0}, nullptr, scr, gw, NGW, lane);
        transpose_all<true>(INP(20), 1024, 1024, WSP(bf16_t, WS_WBRD), 1024, ColIdent{0}, nullptr, scr, gw, NGW, lane);
        transpose_all<true>(INP(21), 1024, 1024, WSP(bf16_t, WS_WBRM), 1024, ColIdent{0}, nullptr, scr, gw, NGW, lane);
        transpose_all(INP(22), 1024, 1024, WSP(bf16_t, WS_WO), 1024, ColIdent{0}, nullptr, scr, gw, NGW, lane);
    }
    GRID_BAR();
    }

    if (RUNP(5)) {
    REP(10) if (PH(10)) {
        pg8::StaticOrder T; T.init(TOK, 1024, G, bx);
        P5Order S{T, WSP(unsigned char, 0)};
        EpiTerm3 E{WSP(unsigned char, 0), WSP(bf16_t, WS_Y)};
        pg8::gemm_phase(lds, S, E);
    }
    GRID_BAR();
    }

    if (RUNP(6)) {
    if (PH(11)) {
        pg8::Gemm g{WSP(bf16_t, WS_Y), WSP(bf16_t, WS_WO), TOK, 1024, 1024}; pg8::StaticOrder S; S.init(TOK, 1024, G, bx);
        EpiResid<true, false> E{OUTP, nullptr, WSP(bf16_t, WS_X2B), WSP(float, WS_SSQ2), 1.0f, 0};
        S.set(g); pg8::gemm_phase(lds, S, E);
    }
    if (PH(0)) {
        LANE_VARS();
        transpose_all<true>(INP(24), 1024, 2 * DFF, WSP(bf16_t, WS_WF2I), 2 * DFF, ColSwiglu{}, INP(23), scr, gw, NGW, lane);
        transpose_all(INP(25), DFF, 1024, WSP(bf16_t, WS_WF2O), 1024, ColIdent{0}, nullptr, scr, gw, NGW, lane);
    }
    GRID_BAR();
    }

    if (RUNP(7)) {
    if (PH(12)) {
        pg8::Gemm g{WSP(bf16_t, WS_X2B), WSP(bf16_t, WS_WF2I), TOK, 2 * DFF, 1024}; pg8::StaticOrder S; S.init(TOK, 2 * DFF, G, bx);
        prep_rs(WSP(float, WS_SSQ2), 0, S, lds);
        EpiSwiglu E{WSP(bf16_t, WS_ACT2), (const LAS float*)(lds + RTAB_OFF)};
        S.set(g); pg8::gemm_phase(lds, S, E);
    }
    GRID_BAR();
    }

    if (RUNP(8))
    if (PH(13)) {
        pg8::Gemm g{WSP(bf16_t, WS_ACT2), WSP(bf16_t, WS_WF2O), TOK, 1024, DFF}; pg8::StaticOrder S; S.init(TOK, 1024, G, bx);
        EpiResid<true, true> E{WSP(bf16_t, WS_X2B), OUTP, nullptr, nullptr, 0.5f, 0};
        S.set(g); pg8::gemm_phase(lds, S, E);
    }
    if (pass_ == 0) GRID_BAR();
    }
}

extern "C" void kernel_launch(void* const* d_in, const int* in_sizes, int n_in, void* d_out, int out_size, void* d_ws, size_t ws_size, hipStream_t stream) {
    static int grid = 0;
    if (grid == 0) {
        if (n_in != 26 || ws_size < WS_END) { fprintf(stderr, "kernel_launch: unexpected inputs (n_in %d, ws %zu)\n", n_in, ws_size); grid = -1; return; }
        int dev = 0, cus = 0;
        if (hipGetDevice(&dev) != hipSuccess || hipDeviceGetAttribute(&cus, hipDeviceAttributeMultiprocessorCount, dev) != hipSuccess) { grid = -1; return; }
        if (hipFuncSetAttribute((const void*)mk_fwd, hipFuncAttributeMaxDynamicSharedMemorySize, LDS_BYTES) != hipSuccess) { fprintf(stderr, "kernel_launch: hipFuncSetAttribute failed\n"); grid = -1; return; }
        grid = cus;
    }
    if (grid < 0) return;
    (void)hipMemsetAsync((char*)d_ws + WS_CTL, 0, CTL_ZERO_BYTES, stream);
    Args a{};
    for (int i = 0; i < 26; ++i) a.in[i] = d_in[i];
    a.out = (float*)d_out; a.ws = (unsigned char*)d_ws;
    hipLaunchKernelGGL(mk_fwd, dim3(grid), dim3(NWAVES * 64), LDS_BYTES, stream, a);
}
```

```cpp
#include <hip/hip_runtime.h>
#include <cstdio>
#include <cstdint>

#define LAS __attribute__((address_space(3)))
#define GAS __attribute__((address_space(1)))
typedef unsigned short bf16_t;
typedef short bf16x8 __attribute__((ext_vector_type(8)));
typedef float f32x4 __attribute__((ext_vector_type(4)));
typedef float f32x2 __attribute__((ext_vector_type(2)));
typedef unsigned u32x4 __attribute__((ext_vector_type(4)));
typedef unsigned u32x2 __attribute__((ext_vector_type(2)));

constexpr int NB = 8, SEQ = 2048, DM = 1024, TOK = NB * SEQ, MEML = 256, DFF = 2816;
constexpr int NMIX = 8192;
constexpr float EPS = 1e-6f;
constexpr float LOG2E = 1.4426950408889634f;
constexpr float C2Q = 0.125f * LOG2E;
constexpr float LAM_INIT = 0.2f;

constexpr size_t MiB = 1u << 20;
constexpr size_t KiB = 1u << 10;
constexpr size_t WS_CTL = 0, CTL_ZERO_BYTES = 256 * KiB;
constexpr size_t WS_SSQ1 = 256 * KiB, WS_SSQ2 = 512 * KiB;
constexpr size_t WS_ROT = 1 * MiB, WS_ROTB = 153 * MiB;
constexpr size_t WS_MKN = 3 * MiB, WS_MVT = 7 * MiB;
constexpr size_t WS_WMIX = 11 * MiB;
constexpr size_t WS_XB = 27 * MiB;
constexpr size_t WS_RET = 59 * MiB;
constexpr size_t WS_XBL = 91 * MiB;
constexpr size_t WS_DIF = 123 * MiB;
constexpr size_t WS_MO = 155 * MiB;
constexpr size_t WS_Q = 187 * MiB, WS_K = 191 * MiB, WS_KTS = 195 * MiB, WS_VT = 199 * MiB, WS_DQ = 207 * MiB, WS_DK = 211 * MiB,
                 WS_DV = 215 * MiB;
constexpr size_t SET_DELTA = 160 * MiB;
constexpr size_t WS_WRG = 219 * MiB;
constexpr size_t WS_O0 = 223 * MiB, WS_O1 = 227 * MiB, WS_S = 231 * MiB;
constexpr size_t WS_OB = 24 * MiB;
constexpr size_t WS_WF1I = 59 * MiB, WS_WF1O = 70 * MiB;
constexpr size_t WS_MEMN = 76 * MiB, WS_MKVRAW = 80 * MiB, WS_WMKV = 27 * MiB;
constexpr size_t WS_ACT = 155 * MiB;
constexpr size_t WS_WGATE = 11 * MiB, WS_WBRR = 17 * MiB, WS_WBRD = 21 * MiB, WS_WBRM = 23 * MiB, WS_WO = 25 * MiB;
constexpr size_t WS_G8A = 187 * MiB, WS_G8B = 203 * MiB, WS_G8C = 223 * MiB;
constexpr size_t WS_Y = 27 * MiB;
constexpr size_t WS_X2B = 187 * MiB;
constexpr size_t WS_WF2I = 239 * MiB, WS_WF2O = 1 * MiB, WS_ACT2 = 76 * MiB;
constexpr size_t WS_END = 256 * MiB;

constexpr int CW_BAR = 4096, CW_BAR2 = 8192;
constexpr int CW_QUEUE = 32768;
constexpr int CW_SCAN = 16384;

constexpr int RING_BYTES = 131072, LDSCTL_OFF = RING_BYTES, MISC_OFF = LDSCTL_OFF + 320, LDS_BYTES = 147456;
constexpr int NWAVES = 8;

__device__ __forceinline__ unsigned cvt_pk_bf16(float lo, float hi) { unsigned r; asm volatile("v_cvt_pk_bf16_f32 %0, %1, %2" : "=v"(r) : "v"(lo), "v"(hi)); return r; }
__device__ __forceinline__ u32x2 pack4(f32x4 v) { u32x2 w; w.x = cvt_pk_bf16(v[0], v[1]); w.y = cvt_pk_bf16(v[2], v[3]); return w; }
__device__ __forceinline__ unsigned short bf16_1(float v) { return (unsigned short)(cvt_pk_bf16(v, 0.f) & 0xffffu); }
__device__ __forceinline__ float bf2f(unsigned short b) { return __uint_as_float(((unsigned)b) << 16); }
__device__ __forceinline__ float siluf(float x) { return x * __builtin_amdgcn_rcpf(1.0f + __builtin_amdgcn_exp2f(-x * LOG2E)); }
__device__ __forceinline__ float sigmf(float x) { return __builtin_amdgcn_rcpf(1.0f + __builtin_amdgcn_exp2f(-x * LOG2E)); }
__device__ __forceinline__ float row_rs(const float* ssq, int row) {
    const f32x4 a = *(const f32x4*)(ssq + (size_t)row * 4);
    return __builtin_amdgcn_rsqf(((a[0] + a[1]) + (a[2] + a[3])) * (1.0f / 1024.0f) + EPS);
}
__device__ __forceinline__ int opaque_tid() { int t = threadIdx.x; asm volatile("" : "+v"(t)); return t; }
__device__ __forceinline__ f32x4 mfma16(bf16x8 a, bf16x8 b, f32x4 c) { return __builtin_amdgcn_mfma_f32_16x16x32_bf16(a, b, c, 0, 0, 0); }

namespace pg8 {
constexpr int BM = 256, BK = 64, HALF = 128, HTB = HALF * BK * 2, STAGE_BYTES = 8 * HTB, NXCD = 8, WGM = 8;
__host__ __device__ __forceinline__ int lds_byte(int r, int c) { const int st = (r >> 4) * 2 + (c >> 5), rr = r & 15, cc = c & 31, ob = rr * 64 + cc * 2; return st * 1024 + (ob ^ (((ob >> 9) & 1) << 5)); }
__host__ __device__ __forceinline__ void stage_rc(int b, int& R, int& C) { const int st = b / 1024, sb = b % 1024, swz = sb ^ (((sb >> 9) & 1) << 5); R = (st >> 1) * 16 + swz / 64; C = (st & 1) * 32 + (swz % 64) / 2; }
struct Unit { int pm, pn, ui, ri, tag, K; const char* A; const char* Bt; };
struct Gemm { const bf16_t* A; const bf16_t* Bt; int M, N, K; };
struct StaticOrder {
    int nM, nN, nwg, G, c; Gemm g;
    __host__ __device__ void init(int M, int N, int G_, int c_) { nM = M / BM; nN = N / BM; nwg = nM * nN; G = G_; c = c_; g.A = nullptr; g.Bt = nullptr; g.M = M; g.N = N; g.K = 0; }
    __host__ __device__ void set(const Gemm& g_) { g = g_; }
    __host__ __device__ bool tile(int i, int& pm, int& pn) const {
        const long L = (long)i * G + c; if (L >= nwg) return false;
        int wgid = (int)L; { const int q = nwg / NXCD, r = nwg % NXCD, xcd = wgid % NXCD, off = wgid / NXCD; wgid = (xcd < r ? xcd * (q + 1) : r * (q + 1) + (xcd - r) * q) + off; }
        const int nig = WGM * nN, gid = wgid / nig, fm = gid * WGM, gsz = (nM - fm) < WGM ? (nM - fm) : WGM;
        pm = fm + ((wgid % nig) % gsz); pn = (wgid % nig) / gsz; return true;
    }
    __host__ __device__ bool next(int i, Unit& u) const {
        if (!tile(i, u.pm, u.pn)) return false;
        u.ui = i; u.ri = i; u.tag = 0; u.K = g.K;
        u.A = (const char*)g.A + (size_t)u.pm * 256 * g.K * 2; u.Bt = (const char*)g.Bt + (size_t)u.pn * 256 * g.K * 2; return true;
    }
};
struct NoHook { __device__ __forceinline__ void wait() const {} };
template <class Epi, class Sched, class Hook = NoHook>
__device__ __forceinline__ void gemm_phase(LAS unsigned char* lds, const Sched& S, const Epi& E, const Hook& H = Hook{}) {
    const int tid = opaque_tid(), wid = __builtin_amdgcn_readfirstlane(tid >> 6), lane = tid & 63, wr = wid >> 2, wc = wid & 3, fr = lane & 15, fq = lane >> 4;
    unsigned R2[2], C2[2];
#pragma unroll
    for (int i = 0; i < 2; ++i) { int R, C; stage_rc(tid * 16 + i * 8192, R, C); R2[i] = (unsigned)R * 2u; C2[i] = (unsigned)C * 2u; }
    const size_t kstep = (size_t)(BK * 2);
    const unsigned ldsw = (unsigned)wid * 1024u;
    const int aoff = lds_byte(wr * 64 + fr, fq * 8), boff = lds_byte(wc * 32 + fr, fq * 8);
#define PG8_SA(b, h) (((b) * 2 + (h)) * HTB)
#define PG8_SB(b, h) ((4 + (b) * 2 + (h)) * HTB)
#define PG8_STAGE(bufoff, gbase, voff) do { _Pragma("unroll") for (int _i = 0; _i < 2; ++_i) \
        __builtin_amdgcn_global_load_lds((const unsigned*)((const char*)(gbase) + (voff)[_i]), (LAS unsigned*)(lds + (bufoff) + ldsw + _i * 8192), 16, 0, 0); } while (0)
#define PG8_LDA(dst, b, h) do { _Pragma("unroll") for (int m = 0; m < 4; ++m) _Pragma("unroll") for (int k = 0; k < 2; ++k) dst[m][k] = *(const LAS bf16x8*)(lds + PG8_SA(b, h) + aoff + m * 2048 + k * 1024); } while (0)
#define PG8_LDB(dst, b, h) do { _Pragma("unroll") for (int n = 0; n < 2; ++n) _Pragma("unroll") for (int k = 0; k < 2; ++k) dst[n][k] = *(const LAS bf16x8*)(lds + PG8_SB(b, h) + boff + n * 2048 + k * 1024); } while (0)
#define PG8_MMA(ai, bj, At, Bt) do { __builtin_amdgcn_s_setprio(1); _Pragma("unroll") for (int m = 0; m < 4; ++m) _Pragma("unroll") for (int n = 0; n < 2; ++n) _Pragma("unroll") for (int k = 0; k < 2; ++k) \
        acc[ai][bj][m][n] = __builtin_amdgcn_mfma_f32_16x16x32_bf16(Bt[n][k], At[m][k], acc[ai][bj][m][n], 0, 0, 0); __builtin_amdgcn_s_setprio(0); } while (0)
#define PG8_WAIT_V(n) asm volatile("s_waitcnt vmcnt(" #n ")" ::: "memory")
#define PG8_WAIT_L(n) asm volatile("s_waitcnt lgkmcnt(" #n ")" ::: "memory")
#define PG8_BAR __builtin_amdgcn_s_barrier()
#define PG8_SCHED __builtin_amdgcn_sched_barrier(0)
    Unit cur, nxt; int ui = 0;
    if (!S.next(0, cur)) return;
    f32x4 acc[2][2][4][2];
#pragma unroll
    for (int a = 0; a < 2; ++a)
#pragma unroll
        for (int b = 0; b < 2; ++b)
#pragma unroll
            for (int m = 0; m < 4; ++m)
#pragma unroll
                for (int n = 0; n < 2; ++n) acc[a][b][m][n] = (f32x4){0.f, 0.f, 0.f, 0.f};
    bf16x8 At[4][2], B0[2][2], B1[2][2];
    const char* cA = cur.A; const char* cB = cur.Bt;
    unsigned vo[2] = {R2[0] * (unsigned)cur.K + C2[0], R2[1] * (unsigned)cur.K + C2[1]};
    size_t hstep = (size_t)HALF * cur.K * 2;
    PG8_STAGE(PG8_SB(0, 0), cB, vo); PG8_STAGE(PG8_SB(0, 1), cB + hstep, vo); PG8_STAGE(PG8_SA(0, 0), cA, vo); PG8_STAGE(PG8_SA(0, 1), cA + hstep, vo);
    if (wr == 1) PG8_BAR;
    PG8_WAIT_V(2); PG8_BAR;
    PG8_STAGE(PG8_SB(1, 0), cB + kstep, vo); PG8_STAGE(PG8_SA(1, 0), cA + kstep, vo); PG8_STAGE(PG8_SB(1, 1), cB + hstep + kstep, vo);
    PG8_WAIT_V(6); PG8_BAR;
    for (;;) {
        const bool has_next = S.next(ui + 1, nxt);
        if (!has_next) nxt = cur;
        const char* nA = nxt.A; const char* nB = nxt.Bt;
        const unsigned voN0 = R2[0] * (unsigned)nxt.K + C2[0], voN1 = R2[1] * (unsigned)nxt.K + C2[1]; const size_t hstepN = (size_t)HALF * nxt.K * 2;
        const int nt = cur.K / BK;
        for (int t = 0; t < nt; t += 2) {
            const bool last = (t == nt - 2);
            const char* a1 = cA + (size_t)(t + 1) * kstep;
            const char* a2 = last ? nA : cA + (size_t)(t + 2) * kstep; const char* b2 = last ? nB : cB + (size_t)(t + 2) * kstep;
            const char* a3 = a2 + kstep; const char* b3 = b2 + kstep;
            const unsigned v2[2] = {last ? voN0 : vo[0], last ? voN1 : vo[1]}; const size_t h2 = last ? hstepN : hstep;
            PG8_LDB(B0, 0, 0); PG8_LDB(B1, 0, 1); PG8_SCHED; PG8_LDA(At, 0, 0); PG8_STAGE(PG8_SA(1, 1), a1 + hstep, vo);
            PG8_WAIT_V(8); PG8_WAIT_L(0); PG8_BAR; PG8_MMA(0, 0, At, B0); PG8_MMA(0, 1, At, B1); PG8_BAR; PG8_SCHED;
            PG8_LDA(At, 0, 1); PG8_STAGE(PG8_SB(0, 0), b2, v2); PG8_STAGE(PG8_SB(0, 1), b2 + h2, v2); PG8_STAGE(PG8_SA(0, 0), a2, v2);
            PG8_WAIT_V(8); PG8_WAIT_L(0); PG8_BAR; PG8_MMA(1, 0, At, B0); PG8_MMA(1, 1, At, B1); PG8_BAR; PG8_SCHED;
            PG8_LDB(B0, 1, 0); PG8_LDB(B1, 1, 1); PG8_SCHED; PG8_LDA(At, 1, 0); PG8_STAGE(PG8_SA(0, 1), a2 + h2, v2);
            PG8_WAIT_V(8); PG8_WAIT_L(0); PG8_BAR; PG8_MMA(0, 0, At, B0); PG8_MMA(0, 1, At, B1); PG8_BAR; PG8_SCHED;
            PG8_LDA(At, 1, 1); PG8_STAGE(PG8_SB(1, 0), b3, v2); PG8_STAGE(PG8_SB(1, 1), b3 + h2, v2); PG8_STAGE(PG8_SA(1, 0), a3, v2);
            PG8_WAIT_V(8); PG8_WAIT_L(0); PG8_BAR; PG8_MMA(1, 0, At, B0); PG8_MMA(1, 1, At, B1); PG8_BAR; PG8_SCHED;
        }
        if (wr == 0) PG8_BAR;
        if (ui == 0 && (!Epi::AFTER_DRAIN || has_next)) H.wait();
        if (!Epi::AFTER_DRAIN || has_next) { int fr2 = fr, fq2 = fq; asm volatile("" : "+v"(fr2), "+v"(fq2)); E(acc, cur, wr, wc, fr2, fq2); }
        if (!has_next) break;
#pragma unroll
        for (int a = 0; a < 2; ++a)
#pragma unroll
            for (int b = 0; b < 2; ++b)
#pragma unroll
                for (int m = 0; m < 4; ++m)
#pragma unroll
                    for (int n = 0; n < 2; ++n) acc[a][b][m][n] = (f32x4){0.f, 0.f, 0.f, 0.f};
        cur = nxt; cA = nA; cB = nB; vo[0] = voN0; vo[1] = voN1; hstep = hstepN; ++ui;
        if (wr == 1) PG8_BAR;
    }
    PG8_WAIT_V(0);
    PG8_BAR;
    if constexpr (Epi::AFTER_DRAIN) { if (ui == 0) H.wait(); }
    if constexpr (Epi::AFTER_DRAIN) { int fr2 = fr, fq2 = fq; asm volatile("" : "+v"(fr2), "+v"(fq2)); E.fused(acc, cur, wr, wc, fr2, fq2, lds); }
#undef PG8_SA
#undef PG8_SB
#undef PG8_STAGE
#undef PG8_LDA
#undef PG8_LDB
#undef PG8_MMA
#undef PG8_WAIT_V
#undef PG8_WAIT_L
#undef PG8_BAR
#undef PG8_SCHED
}
}

__device__ __forceinline__ float wave_sum(float v);
#define ACC_ARG const f32x4 (&acc)[2][2][4][2]
#define EPI_FENCE() asm volatile("" ::: "memory")
constexpr int RTAB_OFF = RING_BYTES + 1024;
__device__ __forceinline__ void prep_rs(const float* ssq, int row_off, const pg8::StaticOrder& S, LAS unsigned char* lds) {
    const int tid = opaque_tid(); LAS float* rtab = (LAS float*)(lds + RTAB_OFF); pg8::Unit u;
    for (int i = 0; i < 6 && S.next(i, u); ++i) if (tid < 256) rtab[i * 256 + tid] = row_rs(ssq, row_off + u.pm * 256 + tid);
    __syncthreads();
}
struct EpiSwiglu {
    static constexpr bool AFTER_DRAIN = false;
    bf16_t* O; const LAS float* rtab;
    __device__ __forceinline__ void operator()(ACC_ARG, const pg8::Unit& u, int wr, int wc, int fr, int fq) const {
        const int lr0 = wr * 64 + fr, col0 = u.pn * 128 + wc * 32 + 8 * fq;
#pragma unroll
        for (int ai = 0; ai < 2; ++ai)
#pragma unroll
            for (int m = 0; m < 4; ++m) {
                const int lr = lr0 + ai * 128 + m * 16;
                const float rs = rtab ? rtab[u.ri * 256 + lr] : 1.0f;
                u32x4 w;
#pragma unroll
                for (int n = 0; n < 2; ++n) {
                    const f32x4 gt = acc[ai][0][m][n] * rs, up = acc[ai][1][m][n] * rs; f32x4 v;
#pragma unroll
                    for (int j = 0; j < 4; ++j) v[j] = siluf(gt[j]) * up[j];
                    const u32x2 p = pack4(v); if (n == 0) { w.x = p.x; w.y = p.y; } else { w.z = p.x; w.w = p.y; }
                }
                *(u32x4*)(O + (size_t)(u.pm * 256 + lr) * DFF + col0) = w;
            }
    }
};
template <bool BB, bool OF>
struct EpiResid {
    static constexpr bool AFTER_DRAIN = true;
    const void* base; float* out; bf16_t* xb; float* ssq; float scale; int skip;
    __device__ __forceinline__ f32x4 ldb(size_t off) const {
        if (BB) { const u32x2 w = __builtin_nontemporal_load((const u32x2*)((const bf16_t*)base + off));
                  return (f32x4){__uint_as_float(w.x << 16), __uint_as_float(w.x & 0xffff0000u), __uint_as_float(w.y << 16), __uint_as_float(w.y & 0xffff0000u)}; }
        return __builtin_nontemporal_load((const f32x4*)((const float*)base + off));
    }
    __device__ __forceinline__ void operator()(ACC_ARG, const pg8::Unit& u, int wr, int wc, int fr, int fq) const {
        if (skip) return;
        const int row0 = u.pm * 256 + wr * 64 + fr, col0 = u.pn * 256 + wc * 32 + 4 * fq;
#pragma unroll
        for (int ai = 0; ai < 2; ++ai)
#pragma unroll
            for (int m = 0; m < 4; ++m) {
                const int row = row0 + ai * 128 + m * 16; float ss = 0.f;
#pragma unroll
                for (int bj = 0; bj < 2; ++bj)
#pragma unroll
                    for (int n = 0; n < 2; ++n) {
                        const size_t off = (size_t)row * DM + col0 + bj * 128 + n * 16;
                        const f32x4 v = ldb(off) + acc[ai][bj][m][n] * scale;
                        if (OF) *(f32x4*)(out + off) = v; else *(u32x2*)(xb + off) = pack4(v);
                        ss += (v[0] * v[0] + v[1] * v[1]) + (v[2] * v[2] + v[3] * v[3]);
                    }
                if (!OF) { ss += __shfl_xor(ss, 16); ss += __shfl_xor(ss, 32); if (fq == 0) atomicAdd(ssq + (size_t)row * 4 + u.pn, ss); }
            }
    }
    __device__ __forceinline__ void fused(ACC_ARG, const pg8::Unit& u, int wr, int wc, int fr, int fq, LAS unsigned char* lds) const {
        if (skip) return;
        const int tid = opaque_tid(), lane = tid & 63, wave = __builtin_amdgcn_readfirstlane(tid >> 6);
        LAS float* tl = (LAS float*)lds;
#pragma unroll
        for (int ai = 0; ai < 2; ++ai)
#pragma unroll
            for (int wq = 0; wq < 2; ++wq) {
                if (wr == wq) {
#pragma unroll
                    for (int m = 0; m < 4; ++m)
#pragma unroll
                        for (int bj = 0; bj < 2; ++bj)
#pragma unroll
                            for (int n = 0; n < 2; ++n) *(LAS f32x4*)(tl + (16 * m + fr) * 260 + bj * 128 + wc * 32 + n * 16 + 4 * fq) = acc[ai][bj][m][n] * scale;
                }
                __syncthreads();
                const int rbase = u.pm * 256 + ai * 128 + wq * 64;
                f32x4 bv[8];
#pragma unroll
                for (int r = 0; r < 8; ++r) bv[r] = ldb((size_t)(rbase + wave * 8 + r) * DM + u.pn * 256 + lane * 4);
#pragma unroll
                for (int r = 0; r < 8; ++r) {
                    const int row = rbase + wave * 8 + r; const size_t off = (size_t)row * DM + u.pn * 256 + lane * 4;
                    const f32x4 v = bv[r] + *(const LAS f32x4*)(tl + (wave * 8 + r) * 260 + lane * 4);
                    if (OF) __builtin_nontemporal_store(v, (f32x4*)(out + off));
                    else {
                        *(u32x2*)(xb + off) = pack4(v);
                        const float ss = wave_sum((v[0] * v[0] + v[1] * v[1]) + (v[2] * v[2] + v[3] * v[3])); if (lane == 0) ssq[(size_t)row * 4 + u.pn] = ss;
                    }
                }
                __syncthreads();
            }
    }
};
struct EpiPlain {
    static constexpr bool AFTER_DRAIN = false;
    bf16_t* O; int ldo;
    __device__ __forceinline__ void operator()(ACC_ARG, const pg8::Unit& u, int wr, int wc, int fr, int fq) const {
        const int row0 = u.pm * 256 + wr * 64 + fr, col0 = u.pn * 256 + wc * 32 + 4 * fq;
#pragma unroll
        for (int ai = 0; ai < 2; ++ai)
#pragma unroll
            for (int m = 0; m < 4; ++m)
#pragma unroll
                for (int bj = 0; bj < 2; ++bj)
#pragma unroll
                    for (int n = 0; n < 2; ++n) *(u32x2*)(O + (size_t)(row0 + ai * 128 + m * 16) * ldo + col0 + bj * 128 + n * 16) = pack4(acc[ai][bj][m][n]);
    }
};
struct EpiMix {
    static constexpr bool AFTER_DRAIN = true;
    const LAS float* rtab; const float* rot;
    unsigned char* ws  ; bf16_t* mqb  ; const float *gdq, *gdk;
    static constexpr int TLD = 136;
    __device__ __forceinline__ void flushT(bf16_t* dst  , const LAS bf16_t* TS) const {
        const int tid = opaque_tid();
#pragma unroll
        for (int i = 0; i < 8; ++i) { const int p = tid + 512 * i, c = p >> 4, r8 = p & 15; *(u32x4*)(dst + (size_t)c * SEQ + r8 * 8) = *(const LAS u32x4*)(TS + c * TLD + r8 * 8); }
    }
    __device__ __forceinline__ void operator()(ACC_ARG, const pg8::Unit& u, int wr, int wc, int fr, int fq) const { body(acc, u, wr, wc, fr, fq, nullptr); }
    __device__ __forceinline__ void fused(ACC_ARG, const pg8::Unit& u, int wr, int wc, int fr, int fq, LAS unsigned char* lds) const {
        if (u.pn >= 4 && u.pn < 16) body(acc, u, wr, wc, fr, fq, (LAS bf16_t*)lds); else body(acc, u, wr, wc, fr, fq, nullptr);
    }
    __device__ __forceinline__ void body(ACC_ARG, const pg8::Unit& u, int wr, int wc, int fr, int fq, LAS bf16_t* TS) const {
        const int pn = u.pn, lr0 = wr * 64 + fr, lrow0 = u.pm * 256 + lr0;
        if (pn < 8) {
            const bool isk = pn >= 4; const int h = pn & 3; bf16_t* dst = (bf16_t*)(ws + (isk ? WS_K : WS_Q)); bf16_t* kts = (bf16_t*)(ws + WS_KTS);
            const float lg2 = log2f(1.0f - __builtin_amdgcn_exp2f(-5.0f - (float)h));
#pragma unroll
            for (int ai = 0; ai < 2; ++ai) {
                f32x4 cs0[4][2], cs1[4][2];
#pragma unroll
                for (int m = 0; m < 4; ++m)
#pragma unroll
                    for (int n = 0; n < 2; ++n) { const f32x4* cs = (const f32x4*)(rot + ((size_t)(lrow0 + ai * 128 + m * 16) * 128 + wc * 32 + 8 * fq + 4 * n) * 2); cs0[m][n] = cs[0]; cs1[m][n] = cs[1]; }
                EPI_FENCE();
#pragma unroll
                for (int m = 0; m < 4; ++m) {
                    int lrow = lrow0 + ai * 128 + m * 16; asm volatile("" : "+v"(lrow));
                    const float rs = rtab[u.ri * 256 + lr0 + ai * 128 + m * 16] * (isk ? 0.0625f : 1.0f);
                    const float dec = __builtin_amdgcn_exp2f(lg2 * (float)(127 - (lrow & 127)));
#pragma unroll
                    for (int n = 0; n < 2; ++n) {
                        const int i0 = wc * 32 + 8 * fq + 4 * n;
                        const f32x4 c01 = cs0[m][n], c23 = cs1[m][n];
                        const f32x4 cv = (f32x4){c01[0], c01[2], c23[0], c23[2]}, sv = (f32x4){c01[1], c01[3], c23[1], c23[3]};
                        const f32x4 x1 = acc[ai][0][m][n] * rs, x2 = acc[ai][1][m][n] * rs;
                        const f32x4 o1 = x1 * cv - x2 * sv, o2 = x1 * sv + x2 * cv;
                        *(u32x2*)(dst + (size_t)lrow * 1024 + h * 256 + i0) = pack4(o1);
                        *(u32x2*)(dst + (size_t)lrow * 1024 + h * 256 + 128 + i0) = pack4(o2);
                        if (isk) {
                            if (TS) {
                                const int rl = wr * 64 + m * 16 + fr;
#pragma unroll
                                for (int j = 0; j < 4; ++j) { TS[(i0 + j) * TLD + rl] = bf16_1(o1[j] * dec); TS[(128 + i0 + j) * TLD + rl] = bf16_1(o2[j] * dec); }
                            } else {
#pragma unroll
                                for (int j = 0; j < 4; ++j) {
                                    kts[(size_t)(h * 256 + i0 + j) * SEQ + lrow] = bf16_1(o1[j] * dec);
                                    kts[(size_t)(h * 256 + 128 + i0 + j) * SEQ + lrow] = bf16_1(o2[j] * dec);
                                }
                            }
                        }
                    }
                }
                EPI_FENCE();
                if (isk && TS) { __syncthreads(); flushT(kts + (size_t)(h * 256) * SEQ + u.pm * 256 + ai * 128, TS); __syncthreads(); }
            }
        } else if (pn < 16) {
            const int h = (pn - 8) >> 1, e0 = ((pn - 8) & 1) * 256; bf16_t* vt = (bf16_t*)(ws + WS_VT);
#pragma unroll
            for (int ai = 0; ai < 2; ++ai) {
#pragma unroll
                for (int m = 0; m < 4; ++m) {
                    int lrow = lrow0 + ai * 128 + m * 16; asm volatile("" : "+v"(lrow));
                    const float rs = rtab[u.ri * 256 + lr0 + ai * 128 + m * 16];
#pragma unroll
                    for (int bj = 0; bj < 2; ++bj)
#pragma unroll
                        for (int n = 0; n < 2; ++n) {
                            const int tc = bj * 128 + wc * 32 + 8 * fq + 4 * n, ec = e0 + tc; const f32x4 v = acc[ai][bj][m][n] * rs;
                            if (TS) {
                                const int rl = wr * 64 + m * 16 + fr;
#pragma unroll
                                for (int j = 0; j < 4; ++j) TS[(tc + j) * TLD + rl] = bf16_1(v[j]);
                            } else {
#pragma unroll
                                for (int j = 0; j < 4; ++j) vt[(size_t)(h * 512 + ec + j) * SEQ + lrow] = bf16_1(v[j]);
                            }
                        }
                    EPI_FENCE();
                }
                if (TS) { __syncthreads(); flushT(vt + (size_t)(h * 512 + e0) * SEQ + u.pm * 256 + ai * 128, TS); __syncthreads(); }
            }
        } else if (pn < 24) {
            const bool isk = pn >= 20; const int tile = (pn - 16) & 3; bf16_t* dst = (bf16_t*)(ws + (isk ? WS_DK : WS_DQ)); const float* gn = isk ? gdk : gdq; const float mul = isk ? 1.0f : C2Q;
            f32x4 gv[2][2];
#pragma unroll
            for (int bj = 0; bj < 2; ++bj)
#pragma unroll
                for (int n = 0; n < 2; ++n) gv[bj][n] = *(const f32x4*)(gn + 32 * bj + 8 * fq + 4 * n);
#pragma unroll
            for (int ai = 0; ai < 2; ++ai)
#pragma unroll
                for (int m = 0; m < 4; ++m) {
                    int lrow = lrow0 + ai * 128 + m * 16; asm volatile("" : "+v"(lrow));
                    const float rs = rtab[u.ri * 256 + lr0 + ai * 128 + m * 16];
                    f32x4 v[2][2]; float ss = 0.f;
#pragma unroll
                    for (int bj = 0; bj < 2; ++bj)
#pragma unroll
                        for (int n = 0; n < 2; ++n) { v[bj][n] = acc[ai][bj][m][n] * rs; const f32x4 t = v[bj][n]; ss += (t[0] * t[0] + t[1] * t[1]) + (t[2] * t[2] + t[3] * t[3]); }
                    ss += __shfl_xor(ss, 16); ss += __shfl_xor(ss, 32);
                    const float rn = __builtin_amdgcn_rsqf(ss * (1.0f / 64.0f) + EPS) * mul;
#pragma unroll
                    for (int bj = 0; bj < 2; ++bj) { const u32x2 p0 = pack4(v[bj][0] * rn * gv[bj][0]), p1 = pack4(v[bj][1] * rn * gv[bj][1]);
                        *(u32x4*)(dst + (size_t)lrow * 1024 + tile * 256 + 64 * wc + 32 * bj + 8 * fq) = (u32x4){p0.x, p0.y, p1.x, p1.y}; }
                    EPI_FENCE();
                }
        } else {
            bf16_t* dst = pn < 28 ? (bf16_t*)(ws + WS_DV) : mqb; const int tile = (pn - 24) & 3;
#pragma unroll
            for (int ai = 0; ai < 2; ++ai)
#pragma unroll
                for (int m = 0; m < 4; ++m) {
                    int lrow = lrow0 + ai * 128 + m * 16; asm volatile("" : "+v"(lrow));
                    const float rs = rtab[u.ri * 256 + lr0 + ai * 128 + m * 16];
#pragma unroll
                    for (int bj = 0; bj < 2; ++bj) { const u32x2 p0 = pack4(acc[ai][bj][m][0] * rs), p1 = pack4(acc[ai][bj][m][1] * rs);
                        *(u32x4*)(dst + (size_t)lrow * 1024 + tile * 256 + bj * 128 + wc * 32 + 8 * fq) = (u32x4){p0.x, p0.y, p1.x, p1.y}; }
                    EPI_FENCE();
                }
        }
    }
};
struct EpiRgG {
    static constexpr bool AFTER_DRAIN = false;
    const LAS float* rtab; bf16_t* ret; const float* rssq; unsigned char* ws;
    __device__ __forceinline__ void operator()(ACC_ARG, const pg8::Unit& u, int wr, int wc, int fr, int fq) const {
        const int lr0 = wr * 64 + fr;
        if (u.pn < 8) {
            const int col0 = u.pn * 256 + wc * 32 + 8 * fq;
#pragma unroll
            for (int ai = 0; ai < 2; ++ai) {
                u32x4 rv[4][2]; f32x2 rq2[4];
#pragma unroll
                for (int m = 0; m < 4; ++m) { const int lr = lr0 + ai * 128 + m * 16;
                    rq2[m] = *(const f32x2*)(rssq + (size_t)(u.pm * 256 + lr) * 8 + 2 * (u.pn >> 1));
#pragma unroll
                    for (int bj = 0; bj < 2; ++bj) rv[m][bj] = *(const u32x4*)(ret + (size_t)(u.pm * 256 + lr) * 2048 + col0 + bj * 128); }
                EPI_FENCE();
#pragma unroll
                for (int m = 0; m < 4; ++m) {
                    const int lr = lr0 + ai * 128 + m * 16; const float rs = rtab[u.ri * 256 + lr];
                    const float rr = __builtin_amdgcn_rsqf((rq2[m][0] + rq2[m][1]) * (1.0f / 512.0f) + EPS);
#pragma unroll
                    for (int bj = 0; bj < 2; ++bj) {
                        u32x4 o;
#pragma unroll
                        for (int n = 0; n < 2; ++n) {
                            const unsigned w0 = n == 0 ? rv[m][bj].x : rv[m][bj].z, w1 = n == 0 ? rv[m][bj].y : rv[m][bj].w; const f32x4 a = acc[ai][bj][m][n] * rs; f32x4 v;
                            v[0] = __uint_as_float(w0 << 16) * siluf(a[0]); v[1] = __uint_as_float(w0 & 0xffff0000u) * siluf(a[1]);
                            v[2] = __uint_as_float(w1 << 16) * siluf(a[2]); v[3] = __uint_as_float(w1 & 0xffff0000u) * siluf(a[3]);
                            const u32x2 p = pack4(v * rr); if (n == 0) { o.x = p.x; o.y = p.y; } else { o.z = p.x; o.w = p.y; }
                        }
                        *(u32x4*)(ret + (size_t)(u.pm * 256 + lr) * 2048 + col0 + bj * 128) = o;
                    }
                }
                EPI_FENCE();
            }
        } else {
            const int br = (u.pn - 8) >> 2, col0 = ((u.pn - 8) & 3) * 256 + wc * 32 + 8 * fq;
            unsigned char* g8 = ws + (br == 0 ? WS_G8A : br == 1 ? WS_G8B : WS_G8C);
#pragma unroll
            for (int ai = 0; ai < 2; ++ai)
#pragma unroll
                for (int m = 0; m < 4; ++m) {
                    const int lr = lr0 + ai * 128 + m * 16; const float rs = rtab[u.ri * 256 + lr];
#pragma unroll
                    for (int bj = 0; bj < 2; ++bj) {
                        u32x2 w2;
#pragma unroll
                        for (int n = 0; n < 2; ++n) {
                            const f32x4 a = acc[ai][bj][m][n] * rs; unsigned w = 0u;
#pragma unroll
                            for (int j = 0; j < 4; ++j) w |= (unsigned)__builtin_rintf(255.0f * sigmf(a[j])) << (8 * j);
                            if (n == 0) w2.x = w; else w2.y = w;
                        }
                        *(u32x2*)(g8 + (size_t)(u.pm * 256 + lr) * DM + col0 + bj * 128) = w2;
                    }
                }
        }
    }
};
struct EpiTerm3 {
    static constexpr bool AFTER_DRAIN = false;
    unsigned char* ws; bf16_t* y;
    __device__ __forceinline__ void operator()(ACC_ARG, const pg8::Unit& u, int wr, int wc, int fr, int fq) const {
        const int lr0 = wr * 64 + fr, col0 = u.pn * 256 + wc * 32 + 8 * fq, first = (u.tag == 0);
        const unsigned char* g8 = ws + (u.tag == 0 ? WS_G8A : u.tag == 1 ? WS_G8B : WS_G8C);
#pragma unroll
        for (int ai = 0; ai < 2; ++ai) {
            u32x2 gv[4][2]; u32x4 yv[4][2];
#pragma unroll
            for (int m = 0; m < 4; ++m)
#pragma unroll
                for (int bj = 0; bj < 2; ++bj) { const size_t off = (size_t)(u.pm * 256 + lr0 + ai * 128 + m * 16) * DM + col0 + bj * 128;
                    gv[m][bj] = *(const u32x2*)(g8 + off); yv[m][bj] = first ? (u32x4){0u, 0u, 0u, 0u} : *(const u32x4*)(y + off); }
            EPI_FENCE();
#pragma unroll
            for (int m = 0; m < 4; ++m)
#pragma unroll
                for (int bj = 0; bj < 2; ++bj) {
                    const size_t off = (size_t)(u.pm * 256 + lr0 + ai * 128 + m * 16) * DM + col0 + bj * 128;
                    u32x4 o;
#pragma unroll
                    for (int n = 0; n < 2; ++n) {
                        const f32x4 a = acc[ai][bj][m][n]; const unsigned gw = n == 0 ? gv[m][bj].x : gv[m][bj].y; const unsigned w0 = n == 0 ? yv[m][bj].x : yv[m][bj].z, w1 = n == 0 ? yv[m][bj].y : yv[m][bj].w; f32x4 v;
                        v[0] = (float)(gw & 255u) * (1.0f / 255.0f) * a[0] + __uint_as_float(w0 << 16); v[1] = (float)((gw >> 8) & 255u) * (1.0f / 255.0f) * a[1] + __uint_as_float(w0 & 0xffff0000u);
                        v[2] = (float)((gw >> 16) & 255u) * (1.0f / 255.0f) * a[2] + __uint_as_float(w1 << 16); v[3] = (float)(gw >> 24) * (1.0f / 255.0f) * a[3] + __uint_as_float(w1 & 0xffff0000u);
                        const u32x2 p = pack4(v); if (n == 0) { o.x = p.x; o.y = p.y; } else { o.z = p.x; o.w = p.y; }
                    }
                    *(u32x4*)(y + off) = o;
                }
            EPI_FENCE();
        }
    }
};

#include <hip/hip_bf16.h>
namespace attn_body {
using bf16=__hip_bfloat16;
using bf16x8=__attribute__((ext_vector_type(8)))short;
using s16x4=__attribute__((ext_vector_type(4)))short;
using f32x16=__attribute__((ext_vector_type(16)))float;
using u32x4=__attribute__((ext_vector_type(4)))unsigned;
constexpr int D=64,DM=1024;
constexpr int NW=8,QBLK=32,QB=QBLK*NW,KVBLK=64;
__device__ __forceinline__ int crow(int r,int hi){return (r&3)+8*(r>>2)+4*hi;}
#define SBAR() __builtin_amdgcn_sched_barrier(0)
__device__ __forceinline__ void cmask(f32x16&p0,f32x16&p1,int jb,int qrel,int hi){
  const float NEG=-INFINITY; int kb=64*jb+4*hi;
  #pragma unroll
  for(int r=0;r<16;++r){int kv=kb+(r&3)+8*(r>>2); if(kv>qrel)p0[r]=NEG; if(kv+32>qrel)p1[r]=NEG;}
}
constexpr int NSLOT=3, SLOTB=8192;
constexpr int LDS_K=0, LDS_V=NSLOT*SLOTB, LDS_WS=2*NSLOT*SLOTB, LDS_OST=LDS_WS+NW*64*4, LDS_BYTES=LDS_OST+NW*4096;
__device__ __forceinline__ void glds16(const void*gsrc,unsigned lds_dst){unsigned keep;
  asm volatile("s_mov_b32 %0, m0\n\ts_mov_b32 m0, %2\n\ts_nop 0\n\tglobal_load_lds_dwordx4 %1, off\n\ts_mov_b32 m0, %0":"=&s"(keep):"v"(gsrc),"s"(lds_dst):"memory");}
__device__ __forceinline__ float max3f(float a,float b,float c){float r;asm("v_max3_f32 %0, %1, %2, %3":"=v"(r):"v"(a),"v"(b),"v"(c));return r;}
__device__ __forceinline__ float max2f(float a,float b){float r;asm("v_max_f32_e32 %0, %1, %2":"=v"(r):"v"(a),"v"(b));return r;}
__device__ __forceinline__ float fadd_s(float a,float b){float r;asm("v_add_f32_e32 %0, %1, %2":"=v"(r):"v"(a),"v"(b));return r;}
__device__ __forceinline__ float fsub_s(float a,float b){float r;asm("v_sub_f32_e32 %0, %1, %2":"=v"(r):"v"(a),"v"(b));return r;}
typedef float f32x2_t __attribute__((ext_vector_type(2))); typedef __bf16 bf16x2_t __attribute__((ext_vector_type(2)));
__device__ __forceinline__ unsigned cvtpk_s(float lo,float hi){f32x2_t v={lo,hi};bf16x2_t b=__builtin_convertvector(v,bf16x2_t);return __builtin_bit_cast(unsigned,b);}
#define WAIT_BAR(N) asm volatile("s_waitcnt vmcnt(" #N ") lgkmcnt(0)\n\ts_barrier":::"memory")
__device__ __forceinline__ void qkt(f32x16&p0,f32x16&p1,const char*Kslot,const bf16x8*qr,const f32x16&negm,int r32,int hi){
  const char*kb=Kslot+hi*1024+r32*16;
  #pragma unroll
  for(int d0=0;d0<4;++d0){
    const bf16x8 b0=*reinterpret_cast<const bf16x8*>(kb+d0*2048);
    const bf16x8 b1=*reinterpret_cast<const bf16x8*>(kb+d0*2048+512);
    if(d0==0){p0=__builtin_amdgcn_mfma_f32_32x32x16_bf16(b0,qr[0],negm,0,0,0);p1=__builtin_amdgcn_mfma_f32_32x32x16_bf16(b1,qr[0],negm,0,0,0);}
    else{p0=__builtin_amdgcn_mfma_f32_32x32x16_bf16(b0,qr[d0],p0,0,0,0);p1=__builtin_amdgcn_mfma_f32_32x32x16_bf16(b1,qr[d0],p1,0,0,0);}}
}
typedef __attribute__((address_space(3))) const char* lds_cptr;
typedef short v4i16_t __attribute__((ext_vector_type(4)));
__device__ __forceinline__ void kload8(bf16x8*kf,lds_cptr kp){
  kf[0]=*(const __attribute__((address_space(3))) bf16x8*)(kp);      kf[1]=*(const __attribute__((address_space(3))) bf16x8*)(kp+512);
  kf[2]=*(const __attribute__((address_space(3))) bf16x8*)(kp+2048); kf[3]=*(const __attribute__((address_space(3))) bf16x8*)(kp+2560);
  kf[4]=*(const __attribute__((address_space(3))) bf16x8*)(kp+4096); kf[5]=*(const __attribute__((address_space(3))) bf16x8*)(kp+4608);
  kf[6]=*(const __attribute__((address_space(3))) bf16x8*)(kp+6144); kf[7]=*(const __attribute__((address_space(3))) bf16x8*)(kp+6656);
}
__device__ __forceinline__ void kload2(bf16x8*kf,lds_cptr kp,int j){ kf[2*j]=*(const __attribute__((address_space(3))) bf16x8*)(kp+j*2048); kf[2*j+1]=*(const __attribute__((address_space(3))) bf16x8*)(kp+j*2048+512); }
__device__ __forceinline__ s16x4 vtr(lds_cptr p){ return __builtin_bit_cast(s16x4,__builtin_amdgcn_ds_read_tr16_b64_v4i16((__attribute__((address_space(3))) v4i16_t*)p)); }
__device__ __forceinline__ float rowmax(const f32x16&p0,const f32x16&p1){
  float a=max3f(p0[0],p0[1],p1[0]),b=max3f(p0[2],p0[3],p1[1]);a=max3f(a,p1[2],p1[3]);
  #pragma unroll
  for(int r=4;r<16;r+=4){a=max3f(a,p0[r],p0[r+1]);b=max3f(b,p0[r+2],p0[r+3]);a=max3f(a,p1[r],p1[r+1]);b=max3f(b,p1[r+2],p1[r+3]);}
  const float m=max2f(a,b);
  auto rr=__builtin_amdgcn_permlane32_swap(__float_as_uint(m),__float_as_uint(m),false,false);
  return max2f(__uint_as_float(rr[0]),__uint_as_float(rr[1]));
}
__device__ __forceinline__ void pv(f32x16*o,int vb,bf16x8 pa0,bf16x8 pa1,bf16x8 pa2,bf16x8 pa3){
  #pragma unroll
  for(int d0=0;d0<2;++d0){s16x4 lo[4],hi[4];
    #pragma unroll
    for(int ks=0;ks<4;++ks){
      asm volatile("ds_read_b64_tr_b16 %0,%1 offset:%c2":"=&v"(lo[ks]):"v"(vb),"i"(d0*4096+ks*1024):"memory");
      asm volatile("ds_read_b64_tr_b16 %0,%1 offset:%c2":"=&v"(hi[ks]):"v"(vb),"i"(d0*4096+ks*1024+512):"memory");}
    asm volatile("s_waitcnt lgkmcnt(0)":::"memory");SBAR();
    #define PK(k) (bf16x8){lo[k][0],lo[k][1],lo[k][2],lo[k][3],hi[k][0],hi[k][1],hi[k][2],hi[k][3]}
    o[d0]=__builtin_amdgcn_mfma_f32_32x32x16_bf16(pa0,PK(0),o[d0],0,0,0);
    o[d0]=__builtin_amdgcn_mfma_f32_32x32x16_bf16(pa1,PK(1),o[d0],0,0,0);
    o[d0]=__builtin_amdgcn_mfma_f32_32x32x16_bf16(pa2,PK(2),o[d0],0,0,0);
    o[d0]=__builtin_amdgcn_mfma_f32_32x32x16_bf16(pa3,PK(3),o[d0],0,0,0);
    #undef PK
  }
}
#define ATTN_STORE16(p,v) (*(u32x4*)(p)=(v))
template<int THRL> __device__ __forceinline__ void attn_unit(int hq,int hv,int qb,const bf16*Q,const bf16*__restrict__ K,const bf16*__restrict__ V,bf16*O,char*shm){
  const int tid=opaque_tid(),lane=tid&63,r32=lane&31,hi=lane>>5; const int wid=__builtin_amdgcn_readfirstlane(tid>>6);
  const int q0=qb*QB;
  const bf16*Qw=Q+(long)(q0+wid*QBLK)*DM+hq*D;
  const bf16*Kh=K+hq*D,*Vh=V+hv*D;
  const unsigned lds0=(unsigned)(uintptr_t)shm;
  float*wsf=(float*)(shm+LDS_WS)+wid*64;
  const bf16*ksrc=Kh+(long)lane*DM+wid*8;
  const bf16*vsrc=Vh+(long)(16*(wid&3)+(lane>>2))*DM+(wid>>2)*32+(lane&3)*8;
  const unsigned kdst=lds0+LDS_K+wid*1024, vdst=lds0+LDS_V+wid*1024;
  #define DMA_K(t,slot) glds16(ksrc+(long)(t)*KVBLK*DM,(unsigned)__builtin_amdgcn_readfirstlane(kdst+(slot)))
  #define DMA_V(t,slot) glds16(vsrc+(long)(t)*KVBLK*DM,(unsigned)__builtin_amdgcn_readfirstlane(vdst+(slot)))
  const int vb0=(int)(lds0+LDS_V)+((lane>>4)&1)*32+(lane&3)*8+(4*hi+((lane&15)>>2))*64;
  const char*Kbase=shm+LDS_K; bf16x8 kf[8];
  const lds_cptr shm3=(lds_cptr)shm; const lds_cptr kp0=shm3+LDS_K+hi*1024+r32*16; const lds_cptr vp0=shm3+LDS_V+((lane>>4)&1)*32+(lane&3)*8+(4*hi+((lane&15)>>2))*64;
  const int NT=(q0+QB)/KVBLK;
  DMA_K(0,0);DMA_V(0,0);DMA_K(1,SLOTB);
  bf16x8 qr[4];
  #pragma unroll
  for(int d0=0;d0<4;++d0)qr[d0]=*reinterpret_cast<const bf16x8*>(&Qw[(long)r32*DM+d0*16+hi*8]);
  float mhat=0.f,l_reg=0.f;f32x16 o[2];o[0]=f32x16{};o[1]=f32x16{};f32x16 negm=f32x16{};asm volatile("":"+v"(negm));
  const int qrel=wid*QBLK+r32;
  #define CMASK(P0,P1,t) do{int jb_=(t)-(NT-4); if(jb_>=0)cmask(P0,P1,jb_,qrel,hi);}while(0)
  bool resc=false;
  #define START(P0,P1) do{ const float rm=rowmax(P0,P1); resc=false; \
    { const float dl=rm; mhat=fadd_s(mhat,dl); \
      _Pragma("unroll") for(int r=0;r<16;++r){P0[r]=fsub_s(P0[r],dl);P1[r]=fsub_s(P1[r],dl);} \
      _Pragma("unroll") for(int r=0;r<16;++r)negm[r]=-mhat; asm volatile("":"+v"(negm)); } \
    _Pragma("unroll") for(int r=0;r<16;++r)P0[r]=__builtin_amdgcn_exp2f(P0[r]); }while(0)
  #define RESC() do{ if(resc){ asm volatile("s_waitcnt lgkmcnt(0)":::"memory"); \
      _Pragma("unroll") for(int d_=0;d_<2;++d_) _Pragma("unroll") for(int r=0;r<16;++r)o[d_][r]*=wsf[crow(r,hi)]; } }while(0)
  f32x16 pA0,pA1,pB0,pB1;
  int sl_prev=0,sl_cur=0,sl_next=SLOTB;
  #define ROT() do{sl_prev=sl_cur;sl_cur=sl_next;sl_next=(sl_next==(NSLOT-1)*SLOTB)?0:sl_next+SLOTB;}while(0)
  DMA_K(2,2*SLOTB);
  WAIT_BAR(3);
  qkt(pA0,pA1,Kbase,qr,negm,r32,hi);asm volatile("s_nop 15\n\ts_nop 7":"+v"(pA0),"+v"(pA1));CMASK(pA0,pA1,0);
  START(pA0,pA1);
  _Pragma("unroll") for(int r=0;r<16;++r)pA1[r]=__builtin_amdgcn_exp2f(pA1[r]);
  WAIT_BAR(0);
  DMA_K(3,0);DMA_V(1,SLOTB);
  ROT();
  kload8(kf,kp0+sl_cur);
  WAIT_BAR(2);
  s16x4 vlo[8],vhi[8]; u32x4 pw0,pw1,pw2,pw3;
  #define PKW(P,B) cvtpk_s(P[B],P[B+1])
  #define PAF(k) __builtin_bit_cast(bf16x8,pw##k)
  #define VFR(i) (bf16x8){vlo[i][0],vlo[i][1],vlo[i][2],vlo[i][3],vhi[i][0],vhi[i][1],vhi[i][2],vhi[i][3]}
  #define PIN(x) asm volatile("":"+v"(x))
  #define MX3(a,b,c) __builtin_fmaxf(__builtin_fmaxf((a),(b)),(c))
  #define GAPA(MF,A0,A1,A2,A3,W0,W1,PW) do{ MF; sacc+=A0; sacc+=A1; sacc+=A2; sacc+=A3; PIN(sacc); W0; W1; PIN(PW); SBAR(); }while(0)
  #define EX(v) __builtin_amdgcn_exp2f(v)
  #define GAPB(MF,X,B) do{ MF; X[B]=EX(X[B]); X[B+1]=EX(X[B+1]); X[B+2]=EX(X[B+2]); X[B+3]=EX(X[B+3]); PIN(X); SBAR(); }while(0)
  #define VRD(i) do{ vlo[i]=vtr(vp_+(((i)>>2)*4096+((i)&3)*1024)); vhi[i]=vtr(vp_+(((i)>>2)*4096+((i)&3)*1024+512)); }while(0)
  #define KRD(G,j) do{ if(G){ kload2(kf,kp0+sl_next,j); SBAR(); } }while(0)
  #define STEP(C0,C1,P0,P1,t,GK,GV,GL) do{ SBAR(); \
    const lds_cptr vp_=vp0+sl_prev; \
    VRD(0); SBAR(); float sacc=(P0[0]+P0[1]); \
    GAPA(C0=__builtin_amdgcn_mfma_f32_32x32x16_bf16(kf[0],qr[0],negm,0,0,0), P0[2],P0[3],P0[4],P0[5],     pw0[0]=PKW(P0,0), pw0[1]=PKW(P0,2), pw0); \
    VRD(4); SBAR(); GAPA(C1=__builtin_amdgcn_mfma_f32_32x32x16_bf16(kf[1],qr[0],negm,0,0,0), P0[6],P0[7],P0[8],P0[9],     pw0[2]=PKW(P0,4), pw0[3]=PKW(P0,6), pw0); \
    VRD(1); SBAR(); GAPA(C0=__builtin_amdgcn_mfma_f32_32x32x16_bf16(kf[2],qr[1],C0,0,0,0),   P0[10],P0[11],P0[12],P0[13], pw1[0]=PKW(P0,8), pw1[1]=PKW(P0,10), pw1); \
    VRD(5); SBAR(); GAPA(C1=__builtin_amdgcn_mfma_f32_32x32x16_bf16(kf[3],qr[1],C1,0,0,0),   P0[14],P0[15],P1[0],P1[1],   pw1[2]=PKW(P0,12),pw1[3]=PKW(P0,14), pw1); \
    VRD(2); SBAR(); GAPA(C0=__builtin_amdgcn_mfma_f32_32x32x16_bf16(kf[4],qr[2],C0,0,0,0),   P1[2],P1[3],P1[4],P1[5],     pw2[0]=PKW(P1,0), pw2[1]=PKW(P1,2), pw2); \
    VRD(6); SBAR(); GAPA(C1=__builtin_amdgcn_mfma_f32_32x32x16_bf16(kf[5],qr[2],C1,0,0,0),   P1[6],P1[7],P1[8],P1[9],     pw2[2]=PKW(P1,4), pw2[3]=PKW(P1,6), pw2); \
    VRD(3); SBAR(); GAPA(C0=__builtin_amdgcn_mfma_f32_32x32x16_bf16(kf[6],qr[3],C0,0,0,0),   P1[10],P1[11],P1[12],P1[13], pw3[0]=PKW(P1,8), pw3[1]=PKW(P1,10), pw3); \
    VRD(7); SBAR(); GAPA(C1=__builtin_amdgcn_mfma_f32_32x32x16_bf16(kf[7],qr[3],C1,0,0,0),   P1[14],P1[15],0.f,0.f,       pw3[2]=PKW(P1,12),pw3[3]=PKW(P1,14), pw3); \
    l_reg+=sacc; \
    if(GK){DMA_K((t)+3,sl_cur);} if(GV){DMA_V((t)+1,sl_next);} \
    CMASK(C0,C1,t); \
    { float a=MX3(C0[0],C0[1],C1[0]),b=MX3(C0[2],C0[3],C1[1]); a=MX3(a,C1[2],C1[3]); \
      _Pragma("unroll") for(int r=4;r<16;r+=4){a=MX3(a,C0[r],C0[r+1]);b=MX3(b,C0[r+2],C0[r+3]);a=MX3(a,C1[r],C1[r+1]);b=MX3(b,C1[r+2],C1[r+3]);} \
      float rm=__builtin_fmaxf(a,b); { auto rr=__builtin_amdgcn_permlane32_swap(__float_as_uint(rm),__float_as_uint(rm),false,false); rm=__builtin_fmaxf(__uint_as_float(rr[0]),__uint_as_float(rr[1])); } \
      resc=false; \
      if(__builtin_expect(__any(rm>(float)THRL),0)){ const float dl=__builtin_fmaxf(rm,0.f); mhat+=dl; \
        _Pragma("unroll") for(int r=0;r<16;++r){C0[r]-=dl;C1[r]-=dl;} \
        _Pragma("unroll") for(int r=0;r<16;++r)negm[r]=-mhat; asm volatile("":"+v"(negm)); \
        const float f=__builtin_amdgcn_exp2f(-dl); l_reg*=f; if(hi==0)wsf[r32]=f; resc=true; } } \
    SBAR(); \
    GAPB(o[0]=__builtin_amdgcn_mfma_f32_32x32x16_bf16(PAF(0),VFR(0),o[0],0,0,0), C0,0); \
    GAPB(o[1]=__builtin_amdgcn_mfma_f32_32x32x16_bf16(PAF(0),VFR(4),o[1],0,0,0), C0,4); \
    KRD(GL,0); GAPB(o[0]=__builtin_amdgcn_mfma_f32_32x32x16_bf16(PAF(1),VFR(1),o[0],0,0,0), C0,8); \
    KRD(GL,1); GAPB(o[1]=__builtin_amdgcn_mfma_f32_32x32x16_bf16(PAF(1),VFR(5),o[1],0,0,0), C0,12); \
    KRD(GL,2); GAPB(o[0]=__builtin_amdgcn_mfma_f32_32x32x16_bf16(PAF(2),VFR(2),o[0],0,0,0), C1,0); \
    KRD(GL,3); GAPB(o[1]=__builtin_amdgcn_mfma_f32_32x32x16_bf16(PAF(2),VFR(6),o[1],0,0,0), C1,4); \
    GAPB(o[0]=__builtin_amdgcn_mfma_f32_32x32x16_bf16(PAF(3),VFR(3),o[0],0,0,0), C1,8); \
    GAPB(o[1]=__builtin_amdgcn_mfma_f32_32x32x16_bf16(PAF(3),VFR(7),o[1],0,0,0), C1,12); \
    }while(0)
  int t=1;
  #undef CMASK
  #define CMASK(P0,P1,t) do{}while(0)
  for(;t+5<NT;t+=2){
    STEP(pB0,pB1,pA0,pA1,t,true,true,true);     WAIT_BAR(2); RESC(); ROT();
    STEP(pA0,pA1,pB0,pB1,t+1,true,true,true);   WAIT_BAR(2); RESC(); ROT();
  }
  #undef CMASK
  #define CMASK(P0,P1,t) do{int jb_=(t)-(NT-4); if(jb_>=0)cmask(P0,P1,jb_,qrel,hi);}while(0)
  #define ENDW(tt) do{ if((tt)+3<NT){WAIT_BAR(2);} else if((tt)+2<NT){WAIT_BAR(1);} else {WAIT_BAR(0);} }while(0)
  for(;t+1<NT;t+=2){
    STEP(pB0,pB1,pA0,pA1,t,(t+3<NT),(t+1<NT),(t+1<NT));       ENDW(t);   RESC(); ROT();
    STEP(pA0,pA1,pB0,pB1,t+1,(t+4<NT),(t+2<NT),(t+2<NT));     ENDW(t+1); RESC(); ROT();
  }
  STEP(pB0,pB1,pA0,pA1,NT-1,false,false,false); RESC();
  { float sacc=pB0[0]+pB0[1]; _Pragma("unroll") for(int r=2;r<16;++r)sacc+=pB0[r]; _Pragma("unroll") for(int r=0;r<16;++r)sacc+=pB1[r]; l_reg+=sacc;
    pw0=(u32x4){PKW(pB0,0),PKW(pB0,2),PKW(pB0,4),PKW(pB0,6)};pw1=(u32x4){PKW(pB0,8),PKW(pB0,10),PKW(pB0,12),PKW(pB0,14)};pw2=(u32x4){PKW(pB1,0),PKW(pB1,2),PKW(pB1,4),PKW(pB1,6)};pw3=(u32x4){PKW(pB1,8),PKW(pB1,10),PKW(pB1,12),PKW(pB1,14)};
    SBAR(); pv(o,vb0+sl_cur,PAF(0),PAF(1),PAF(2),PAF(3)); }
  #undef PKW
  #undef PAF
  #undef VFR
  #undef PIN
  #undef MX3
  #undef GAPA
  #undef GAPB
  #undef EX
  #undef VRD
  #undef KRD
  #undef STEP
  #undef ENDW
  {auto rr=__builtin_amdgcn_permlane32_swap(__float_as_uint(l_reg),__float_as_uint(l_reg),false,false);l_reg=__uint_as_float(rr[0])+__uint_as_float(rr[1]);}
  if(hi==0)wsf[32+r32]=l_reg;asm volatile("s_waitcnt lgkmcnt(0)":::"memory");
  float rli[16];
  #pragma unroll
  for(int r=0;r<16;++r)rli[r]=__builtin_amdgcn_rcpf(wsf[32+crow(r,hi)]);
  bf16*Ow=O+(long)(q0+wid*QBLK)*DM+hv*D;
  { bf16*stg=(bf16*)(shm+LDS_OST)+wid*2048;
    #pragma unroll
    for(int r=0;r<16;++r){const int orow=crow(r,hi);
      #pragma unroll
      for(int d0=0;d0<2;++d0)stg[orow*64+d0*32+r32]=__float2bfloat16(o[d0][r]*rli[r]);}
    asm volatile("s_waitcnt lgkmcnt(0)":::"memory");
    #pragma unroll
    for(int i=0;i<4;++i){const int row=i*8+(lane>>3),ch=lane&7; const u32x4 v=*(const u32x4*)(stg+row*64+ch*8); ATTN_STORE16(Ow+(long)row*DM+ch*8,v);} }
  asm volatile("s_waitcnt lgkmcnt(0)\n\ts_barrier":::"memory");
  #undef DMA_K
  #undef DMA_V
  #undef CMASK
  #undef START
  #undef RESC
  #undef ROT
}
constexpr int ATTN_LDS_BYTES=LDS_BYTES;
#undef SBAR
#undef WAIT_BAR
}

typedef GAS unsigned gu32;
#define RLX_AGENT __ATOMIC_RELAXED, __HIP_MEMORY_SCOPE_AGENT
#define LDS_WAIT() asm volatile("s_waitcnt lgkmcnt(0)" ::: "memory")
#define XB_TMO      128
#define XB_XCNT(j)  (256  + 64 * (j))
#define XB_XSUB(j)  (1280 + 64 * (j))
#define XB_XGEN(j)  (2304 + 64 * (j))
#define XB_TOP      3328
#define XB_TOPGEN   3392
#define XCD_BAR_WORDS 3456
#define XB_SPIN_CAP (1u << 18)
__device__ __forceinline__ unsigned xb_ld(unsigned* p)              { return __hip_atomic_load(p, __ATOMIC_RELAXED, __HIP_MEMORY_SCOPE_AGENT); }
__device__ __forceinline__ unsigned xb_add(unsigned* p, unsigned v) { return __hip_atomic_fetch_add(p, v, __ATOMIC_RELAXED, __HIP_MEMORY_SCOPE_AGENT); }
__device__ __forceinline__ unsigned xb_xcc_id() { return (unsigned)__builtin_amdgcn_s_getreg((3 << 11) | 20) & 0xFu; }
#define XB_SPIN(cond, bar) do { unsigned _sp = 0; while (cond) { __builtin_amdgcn_s_sleep(1); \
    if ((++_sp & 255u) == 0u) { if (xb_ld(&(bar)[XB_TMO])) break; if (_sp > XB_SPIN_CAP) { atomicAdd(&(bar)[XB_TMO], 1u); break; } } } } while (0)
struct XcdBarrier { unsigned* bar; unsigned x; volatile LAS unsigned* st; };
__device__ __forceinline__ XcdBarrier xcd_barrier_post(unsigned* bar, volatile LAS unsigned* st) {
    XcdBarrier b; b.bar = bar; b.x = xb_xcc_id(); b.st = st;
    if (threadIdx.x == 0) (void)xb_add(&bar[XB_XCNT(b.x)], 1u);
    return b;
}
__device__ __forceinline__ void xcd_barrier_complete(unsigned* bar, unsigned x, unsigned& nloc, unsigned& nx) {
    const unsigned G = gridDim.x * gridDim.y * gridDim.z;
    unsigned sum, cnt, mine, sp = 0u;
    for (;;) {
        sum = 0u; cnt = 0u; mine = 0u;
#pragma unroll
        for (unsigned j = 0; j < 16; ++j) { const unsigned c = xb_ld(&bar[XB_XCNT(j)]); sum += c; cnt += (c > 0u) ? 1u : 0u; mine = (j == x) ? c : mine; }
        if (sum == G) break;
        __builtin_amdgcn_s_sleep(1);
        if ((++sp & 255u) == 0u) { if (xb_ld(&bar[XB_TMO])) break; if (sp > XB_SPIN_CAP) { atomicAdd(&bar[XB_TMO], 1u); break; } }
    }
    nloc = mine > 0u ? mine : 1u; nx = cnt > 0u ? cnt : 1u;
}
__device__ __forceinline__ void xcd_barrier(const XcdBarrier& b) {
    asm volatile("s_waitcnt vmcnt(0)" ::: "memory");
    __syncthreads();
    if (threadIdx.x == 0) {
        unsigned* bar = b.bar; asm volatile("" : "+v"(bar));
        __builtin_amdgcn_s_waitcnt(0);
        unsigned nloc = b.st[0], nx = b.st[1];
        if (nloc == 0u) { xcd_barrier_complete(bar, b.x, nloc, nx); b.st[0] = nloc; b.st[1] = nx; }
        const unsigned old = xb_add(&bar[XB_XSUB(b.x)], 1u);
        const unsigned gen = old / nloc;
        if (old + 1u == (gen + 1u) * nloc) {
            __builtin_amdgcn_fence(__ATOMIC_RELEASE, "agent");
            asm volatile("s_waitcnt vmcnt(0)" ::: "memory");
            const unsigned og = xb_add(&bar[XB_TOP], 1u);
            const unsigned tg = og / nx;
            if (og + 1u == (tg + 1u) * nx) xb_add(&bar[XB_TOPGEN], 1u);
            else XB_SPIN(xb_ld(&bar[XB_TOPGEN]) == tg, bar);
            __builtin_amdgcn_fence(__ATOMIC_ACQUIRE, "agent");
            xb_add(&bar[XB_XGEN(b.x)], 1u);
            asm volatile("s_waitcnt vmcnt(0)" ::: "memory");
        } else {
            XB_SPIN(xb_ld(&bar[XB_XGEN(b.x)]) == gen, bar);
            __builtin_amdgcn_fence(__ATOMIC_ACQUIRE, "agent");
            asm volatile("s_waitcnt vmcnt(0)" ::: "memory");
        }
    }
    __syncthreads();
}

#define XB2_XSUB(j) (64 * (j))
#define XB2_TOP     1024
#define XB2_TOPGEN  1088
__device__ __forceinline__ void xcd_split_arrive(unsigned* bar2, unsigned* bar, volatile LAS unsigned* st) {
    asm volatile("s_waitcnt vmcnt(0)" ::: "memory");
    __syncthreads();
    if (threadIdx.x == 0) {
        asm volatile("" : "+v"(bar2));
        __builtin_amdgcn_s_waitcnt(0);
        unsigned nloc = st[0], nx = st[1]; const unsigned x = xb_xcc_id();
        if (nloc == 0u) { xcd_barrier_complete(bar, x, nloc, nx); st[0] = nloc; st[1] = nx; }
        const unsigned old = xb_add(&bar2[XB2_XSUB(x)], 1u);
        if ((old + 1u) % nloc == 0u) {
            __builtin_amdgcn_fence(__ATOMIC_RELEASE, "agent");
            asm volatile("s_waitcnt vmcnt(0)" ::: "memory");
            const unsigned og = xb_add(&bar2[XB2_TOP], 1u);
            if ((og + 1u) % nx == 0u) xb_add(&bar2[XB2_TOPGEN], 1u);
            asm volatile("s_waitcnt vmcnt(0)" ::: "memory");
        }
    }
}
__device__ __forceinline__ void xcd_split_wait(unsigned* bar2, unsigned* bar, unsigned target) {
    if (threadIdx.x == 0) {
        asm volatile("" : "+v"(bar2));
        XB_SPIN(xb_ld(&bar2[XB2_TOPGEN]) < target, bar);
        __builtin_amdgcn_fence(__ATOMIC_ACQUIRE, "agent");
        asm volatile("s_waitcnt vmcnt(0)" ::: "memory");
    }
    __syncthreads();
}

__device__ __forceinline__ float wave_sum(float v) {
#pragma unroll
    for (int o = 1; o < 64; o <<= 1) v += __shfl_xor(v, o);
    return v;
}
template <class F>
__device__ __forceinline__ void transpose_load(const float* W, int ld, int nrows, F srccol, int item, int lane, f32x4 (&v)[8]) {
    const int nblk = nrows / 32, kb = item / nblk, nb = item % nblk, k0 = 64 * kb, s0 = srccol(32 * nb);
#pragma unroll
    for (int i = 0; i < 8; ++i) v[i] = __builtin_nontemporal_load((const f32x4*)(W + (size_t)(k0 + 8 * i + (lane >> 3)) * ld + s0 + 4 * (lane & 7)));
}
__host__ __device__ __forceinline__ int perm32(int rho) { const int n = rho >> 4, i = rho & 15; return 8 * (i >> 2) + 4 * n + (i & 3); }
template <bool PERM>
__device__ __forceinline__ void transpose_store(int K, bf16_t* WT, int nrows, const float* gk, LAS float* scr, int item, int lane, const f32x4 (&v)[8]) {
    const int nblk = nrows / 32, kb = item / nblk, nb = item % nblk, k0 = 64 * kb, n0 = 32 * nb;
#pragma unroll
    for (int i = 0; i < 8; ++i) { const int kk = 8 * i + (lane >> 3); const float g = gk ? gk[k0 + kk] : 1.0f;
#pragma unroll
        for (int e = 0; e < 4; ++e) scr[kk * 33 + 4 * (lane & 7) + e] = v[i][e] * g; }
    LDS_WAIT(); asm volatile("" ::: "memory");
    const int c = lane & 7;
#pragma unroll
    for (int j = 0; j < 4; ++j) { const int n = (lane >> 3) + 8 * j; const LAS float* s = scr + (8 * c) * 33 + (PERM ? perm32(n) : n);
        u32x4 o; o.x = cvt_pk_bf16(s[0 * 33], s[1 * 33]); o.y = cvt_pk_bf16(s[2 * 33], s[3 * 33]); o.z = cvt_pk_bf16(s[4 * 33], s[5 * 33]); o.w = cvt_pk_bf16(s[6 * 33], s[7 * 33]);
        *(u32x4*)(WT + (size_t)(n0 + n) * K + k0 + 8 * c) = o; }
    LDS_WAIT(); asm volatile("" ::: "memory");
}
struct ColIdent { int off; __device__ __forceinline__ int operator()(int r) const { return off + r; } };
struct ColSwiglu { __device__ __forceinline__ int operator()(int r) const { return ((r >> 7) & 1) * DFF + (r >> 8) * 128 + (r & 127); } };
struct ColMix { __device__ __forceinline__ int operator()(int r) const {
    const int tile = r >> 8, p = r & 255, o = 64 * ((p >> 5) & 3) + 32 * (p >> 7) + (p & 31);
    if (tile < 16) return r;
    if (tile < 20) return 6144 + (tile - 16) * 256 + o;
    if (tile < 24) return 7168 + (tile - 20) * 256 + o;
    if (tile < 28) return 8192 + (tile - 24) * 256 + p;
    return 9216 + (tile - 28) * 256 + p; } };
template <bool PERM = false, class F>
__device__ __forceinline__ void transpose_all(const float* W, int K, int ld, bf16_t* WT, int nrows, F srccol, const float* gk, LAS float* scr, int gw, int ngw, int lane) {
    const int nitems = (K / 64) * (nrows / 32);
    for (int it = gw; it < nitems; it += 2 * ngw) {
        f32x4 va[8], vb[8]; const int it2 = it + ngw;
        transpose_load(W, ld, nrows, srccol, it, lane, va);
        if (it2 < nitems) transpose_load(W, ld, nrows, srccol, it2, lane, vb);
        transpose_store<PERM>(K, WT, nrows, gk, scr, it, lane, va);
        if (it2 < nitems) transpose_store<PERM>(K, WT, nrows, gk, scr, it2, lane, vb);
    }
}
__device__ __forceinline__ void rms_rows_to_bf16(const float* x, const float* gain, bf16_t* o, int m0, int step, int nrows, int lane) {
    const f32x4* gr = (const f32x4*)gain + lane;
    for (int m = m0; m < nrows; m += 2 * step) {
        const int m2 = (m + step < nrows) ? m + step : m;
        const f32x4* xa = (const f32x4*)(x + (size_t)m * DM) + lane; const f32x4* xb2 = (const f32x4*)(x + (size_t)m2 * DM) + lane;
        f32x4 va[4], vb[4]; float sa = 0.f, sb = 0.f;
#pragma unroll
        for (int j = 0; j < 4; ++j) { va[j] = __builtin_nontemporal_load(xa + 64 * j); vb[j] = __builtin_nontemporal_load(xb2 + 64 * j); }
#pragma unroll
        for (int j = 0; j < 4; ++j) { sa += (va[j][0] * va[j][0] + va[j][1] * va[j][1]) + (va[j][2] * va[j][2] + va[j][3] * va[j][3]); sb += (vb[j][0] * vb[j][0] + vb[j][1] * vb[j][1]) + (vb[j][2] * vb[j][2] + vb[j][3] * vb[j][3]); }
        const float ra = __builtin_amdgcn_rsqf(wave_sum(sa) * (1.f / 1024.f) + EPS), rb = __builtin_amdgcn_rsqf(wave_sum(sb) * (1.f / 1024.f) + EPS);
        u32x2* oa = (u32x2*)(o + (size_t)m * DM) + lane; u32x2* ob = (u32x2*)(o + (size_t)m2 * DM) + lane;
#pragma unroll
        for (int j = 0; j < 4; ++j) { const f32x4 g = gr[64 * j]; oa[64 * j] = pack4(va[j] * ra * g); if (m2 != m) ob[64 * j] = pack4(vb[j] * rb * g); }
    }
}
__device__ __forceinline__ void rot_table(const int* pos, float* rot, int gt, int ngt) {
    for (int idx = gt; idx < SEQ * 128; idx += ngt) {
        const int s = idx >> 7, i = idx & 127;
        const float inv = exp2f(-(float)i * (13.287712379549449f / 128.0f));
        const float ang = (float)pos[s] * inv;
        const float kq = rintf(ang * 0.6366197723675814f);
        float r = fmaf(-kq, 1.5703125f, ang); r = fmaf(-kq, 4.837512969970703125e-4f, r); r = fmaf(-kq, 7.54978995489188216e-8f, r);
        const float r2 = r * r;
        const float sn = r + r * r2 * (-1.6666667e-1f + r2 * (8.3333333e-3f + r2 * (-1.9841270e-4f + r2 * 2.7557319e-6f)));
        const float cn = 1.0f + r2 * (-0.5f + r2 * (4.1666668e-2f + r2 * (-1.3888889e-3f + r2 * (2.4801587e-5f + r2 * -2.7557319e-7f))));
        const int qd = ((int)kq) & 3;
        const float c = (qd == 0) ? cn : (qd == 1) ? -sn : (qd == 2) ? -cn : sn;
        const float sv = (qd == 0) ? sn : (qd == 1) ? cn : (qd == 2) ? -sn : -cn;
        *(f32x2*)(rot + (size_t)idx * 2) = (f32x2){c, sv};
    }
}

constexpr int SCN_LD = 136, SCN_V_OFF = 64 * SCN_LD * 2, SCN_CH = 192 * SCN_LD * 2;
constexpr unsigned SCAN_UNITS_PER_FLAG = 8;
__device__ __forceinline__ void scan_unit(int u, const bf16_t* kts, const bf16_t* vt, bf16_t* S, LAS unsigned char* lds, unsigned* done  ) {
    const int tid = opaque_tid(), lane = tid & 63, wave = __builtin_amdgcn_readfirstlane(tid >> 6);
    const int fr = lane & 15, fq = lane >> 4, h = u >> 4, dg = (u >> 2) & 3, eg = u & 3, wd = wave & 1, we = wave >> 1;
    const float gC = __builtin_amdgcn_exp2f(128.0f * log2f(1.0f - __builtin_amdgcn_exp2f(-5.0f - (float)h)));
    f32x4 acc[2][2];
#pragma unroll
    for (int a = 0; a < 2; ++a)
#pragma unroll
        for (int b = 0; b < 2; ++b) acc[a][b] = (f32x4){0.f, 0.f, 0.f, 0.f};
    const bf16_t* ksrc = kts + (size_t)(h * 256 + 64 * dg + (tid >> 4)) * SEQ + (tid & 15) * 8;
    const bf16_t* vsrc = vt + (size_t)(h * 512 + 128 * eg + (tid >> 4)) * SEQ + (tid & 15) * 8;
    u32x4 pk[2][2], pv[2][4];
#pragma unroll
    for (int i = 0; i < 2; ++i) {
#pragma unroll
        for (int j = 0; j < 2; ++j) pk[i][j] = *(const u32x4*)(ksrc + (size_t)(32 * j) * SEQ + i * 128);
#pragma unroll
        for (int j = 0; j < 4; ++j) pv[i][j] = *(const u32x4*)(vsrc + (size_t)(32 * j) * SEQ + i * 128);
    }
    bf16_t* sdst = S + ((size_t)(h * 16) * 512 + 128 * eg + 32 * we + fr) * 256 + 64 * dg + 32 * wd + 4 * fq;
#pragma unroll
    for (int r = 0; r < 8; ++r) {
        __syncthreads();
#pragma unroll
        for (int i = 0; i < 2; ++i) {
            if (2 * r + i < 15) {
                LAS bf16_t* lk = (LAS bf16_t*)(lds + i * SCN_CH); LAS bf16_t* lv = (LAS bf16_t*)(lds + i * SCN_CH + SCN_V_OFF);
#pragma unroll
                for (int j = 0; j < 2; ++j) *(LAS u32x4*)(lk + (32 * j + (tid >> 4)) * SCN_LD + (tid & 15) * 8) = pk[i][j];
#pragma unroll
                for (int j = 0; j < 4; ++j) *(LAS u32x4*)(lv + (32 * j + (tid >> 4)) * SCN_LD + (tid & 15) * 8) = pv[i][j];
            }
        }
        __syncthreads();
        if (r < 7) {
#pragma unroll
            for (int i = 0; i < 2; ++i) { const int c = 2 * (r + 1) + i;
                if (c < 15) {
#pragma unroll
                    for (int j = 0; j < 2; ++j) pk[i][j] = *(const u32x4*)(ksrc + (size_t)(32 * j) * SEQ + c * 128);
#pragma unroll
                    for (int j = 0; j < 4; ++j) pv[i][j] = *(const u32x4*)(vsrc + (size_t)(32 * j) * SEQ + c * 128);
                } }
        }
#pragma unroll
        for (int i = 0; i < 2; ++i) {
            const int c = 2 * r + i;
#pragma unroll
            for (int td = 0; td < 2; ++td)
#pragma unroll
                for (int te = 0; te < 2; ++te) { const u32x2 w = pack4(acc[td][te]);
                    __hip_atomic_store((unsigned long long*)(sdst + (size_t)c * 512 * 256 + (size_t)(16 * te) * 256 + 16 * td), ((unsigned long long)w.y << 32) | w.x, __ATOMIC_RELAXED, __HIP_MEMORY_SCOPE_AGENT); }
            if (c < 15) {
                const LAS bf16_t* lk = (const LAS bf16_t*)(lds + i * SCN_CH); const LAS bf16_t* lv = (const LAS bf16_t*)(lds + i * SCN_CH + SCN_V_OFF);
                f32x4 tm[2][2];
#pragma unroll
                for (int td = 0; td < 2; ++td)
#pragma unroll
                    for (int te = 0; te < 2; ++te) tm[td][te] = (f32x4){0.f, 0.f, 0.f, 0.f};
#pragma unroll
                for (int ks = 0; ks < 4; ++ks) {
                    bf16x8 a[2], b[2];
#pragma unroll
                    for (int t = 0; t < 2; ++t) { a[t] = *(const LAS bf16x8*)(lk + (32 * wd + 16 * t + fr) * SCN_LD + 32 * ks + 8 * fq); b[t] = *(const LAS bf16x8*)(lv + (32 * we + 16 * t + fr) * SCN_LD + 32 * ks + 8 * fq); }
#pragma unroll
                    for (int td = 0; td < 2; ++td)
#pragma unroll
                        for (int te = 0; te < 2; ++te) tm[td][te] = mfma16(a[td], b[te], tm[td][te]);
                }
#pragma unroll
                for (int td = 0; td < 2; ++td)
#pragma unroll
                    for (int te = 0; te < 2; ++te) acc[td][te] = acc[td][te] * gC + tm[td][te];
            }
        }
    }
    asm volatile("s_waitcnt vmcnt(0)" ::: "memory");
    __syncthreads();
    if (tid == 0) __hip_atomic_fetch_add(done + ((h * 2 + (eg >> 1)) * 64), 1u, __ATOMIC_RELAXED, __HIP_MEMORY_SCOPE_AGENT);
}
constexpr int RQ_LD = 264, SC_LD = 136, RO_SC_OFF = 128 * RQ_LD * 2, RO_PART_OFF = RO_SC_OFF + 128 * SC_LD * 2;
__device__ __forceinline__ void retout_unit(int h, int c, int eh, const bf16_t* q, const bf16_t* k, const bf16_t* vt, const bf16_t* S, bf16_t* ret  , float* rssq, LAS unsigned char* lds, unsigned* done, unsigned* tmo) {
    const int tid = opaque_tid(), lane = tid & 63, wave = __builtin_amdgcn_readfirstlane(tid >> 6);
    const int fr = lane & 15, fq = lane >> 4;
    LAS bf16_t* ql = (LAS bf16_t*)lds; LAS bf16_t* sc = (LAS bf16_t*)(lds + RO_SC_OFF); LAS float* part = (LAS float*)(lds + RO_PART_OFF);
    const float lg2 = log2f(1.0f - __builtin_amdgcn_exp2f(-5.0f - (float)h));
    const int tok0 = c * 128;
    if (tid < 64) {
        unsigned* f = done + ((h * 2 + eh) * 64); unsigned sp = 0;
        while ((unsigned)__builtin_amdgcn_readfirstlane(__hip_atomic_load(f, __ATOMIC_RELAXED, __HIP_MEMORY_SCOPE_AGENT)) < SCAN_UNITS_PER_FLAG) {
            __builtin_amdgcn_s_sleep(2);
            if (++sp > (1u << 20)) { if (tid == 0) __hip_atomic_store(tmo, 1u, __ATOMIC_RELAXED, __HIP_MEMORY_SCOPE_AGENT); break; }
        }
        __builtin_amdgcn_fence(__ATOMIC_ACQUIRE, "agent");
        asm volatile("s_waitcnt vmcnt(0)" ::: "memory");
    }
    __syncthreads();
    const bf16_t* sp = S + ((size_t)((h * 16 + c) * 512 + 256 * eh + 32 * wave + fr)) * 256 + 8 * fq;
    const bf16_t* vp = vt + (size_t)(h * 512 + 256 * eh + 32 * wave + fr) * SEQ + tok0 + 8 * fq;
    const bf16_t* kp = k + (size_t)(tok0 + 16 * wave + fr) * 1024 + h * 256 + 8 * fq;
    u32x4 qv[8]; bf16x8 kf[8], sfa[8][2], vfa[4][2];
#pragma unroll
    for (int i = 0; i < 8; ++i) { const int p = tid + 512 * i, row = p >> 5, c16 = p & 31; qv[i] = *(const u32x4*)(q + (size_t)(tok0 + row) * 1024 + h * 256 + c16 * 8); }
#pragma unroll
    for (int ks = 0; ks < 8; ++ks) kf[ks] = *(const bf16x8*)(kp + 32 * ks);
#pragma unroll
    for (int ks = 0; ks < 8; ++ks)
#pragma unroll
        for (int t = 0; t < 2; ++t) sfa[ks][t] = *(const bf16x8*)(sp + (size_t)(16 * t) * 256 + 32 * ks);
#pragma unroll
    for (int ks = 0; ks < 4; ++ks)
#pragma unroll
        for (int t = 0; t < 2; ++t) vfa[ks][t] = *(const bf16x8*)(vp + (size_t)(16 * t) * SEQ + 32 * ks);
#pragma unroll
    for (int i = 0; i < 8; ++i) { const int p = tid + 512 * i, row = p >> 5, c16 = p & 31; *(LAS u32x4*)(ql + row * RQ_LD + c16 * 8) = qv[i]; }
    __syncthreads();
    {
        const int tj = wave;
#pragma unroll
        for (int ti = 0; ti < 8; ++ti) {
            if (ti >= tj) {
                f32x4 s2 = (f32x4){0.f, 0.f, 0.f, 0.f};
#pragma unroll
                for (int ks = 0; ks < 8; ++ks) { const bf16x8 qf = *(const LAS bf16x8*)(ql + (16 * ti + fr) * RQ_LD + 32 * ks + 8 * fq); s2 = mfma16(kf[ks], qf, s2); }
                const int i = 16 * ti + fr; f32x4 v;
#pragma unroll
                for (int r = 0; r < 4; ++r) { const int j = 16 * tj + 4 * fq + r; v[r] = (i >= j) ? s2[r] * __builtin_amdgcn_exp2f(lg2 * (float)(i - j)) : 0.f; }
                *(LAS u32x2*)(sc + (16 * ti + fr) * SC_LD + 16 * tj + 4 * fq) = pack4(v);
            } else if (ti == tj - 1 && (tj & 1)) {
                *(LAS u32x2*)(sc + (16 * ti + fr) * SC_LD + 16 * tj + 4 * fq) = (u32x2){0u, 0u};
            }
        }
    }
    __syncthreads();
    f32x4 acc[8][2];
#pragma unroll
    for (int a = 0; a < 8; ++a)
#pragma unroll
        for (int b = 0; b < 2; ++b) acc[a][b] = (f32x4){0.f, 0.f, 0.f, 0.f};
#pragma unroll
    for (int ks = 0; ks < 8; ++ks) {
        bf16x8 qf[8];
#pragma unroll
        for (int t = 0; t < 8; ++t) qf[t] = *(const LAS bf16x8*)(ql + (16 * t + fr) * RQ_LD + 32 * ks + 8 * fq);
#pragma unroll
        for (int a = 0; a < 8; ++a)
#pragma unroll
            for (int b = 0; b < 2; ++b) acc[a][b] = mfma16(sfa[ks][b], qf[a], acc[a][b]);
    }
#pragma unroll
    for (int a = 0; a < 8; ++a) { const float qd = __builtin_amdgcn_exp2f(lg2 * (float)(16 * a + fr + 1));
#pragma unroll
        for (int b = 0; b < 2; ++b) acc[a][b] = acc[a][b] * qd; }
#pragma unroll
    for (int ks = 0; ks < 4; ++ks) {
#pragma unroll
        for (int a = 0; a < 8; ++a) {
            if (a >= 2 * ks) {
                const bf16x8 pf = *(const LAS bf16x8*)(sc + (16 * a + fr) * SC_LD + 32 * ks + 8 * fq);
#pragma unroll
                for (int b = 0; b < 2; ++b) acc[a][b] = mfma16(vfa[ks][b], pf, acc[a][b]);
            }
        }
    }
#pragma unroll
    for (int a = 0; a < 8; ++a) {
        float ss = 0.f;
#pragma unroll
        for (int b = 0; b < 2; ++b) { const f32x4 t = acc[a][b]; ss += (t[0] * t[0] + t[1] * t[1]) + (t[2] * t[2] + t[3] * t[3]); }
        ss += __shfl_xor(ss, 16); ss += __shfl_xor(ss, 32);
        if (fq == 0) part[wave * 128 + 16 * a + fr] = ss;
    }
    __syncthreads();
    if (tid < 128) {
        float tot = 0.f;
#pragma unroll
        for (int w = 0; w < 8; ++w) tot += part[w * 128 + tid];
        rssq[(size_t)(tok0 + tid) * 8 + 2 * h + eh] = tot;
    }
#pragma unroll
    for (int a = 0; a < 8; ++a)
#pragma unroll
        for (int b = 0; b < 2; ++b)
            *(u32x2*)(ret + (size_t)(tok0 + 16 * a + fr) * 2048 + h * 512 + 256 * eh + 32 * wave + 16 * b + 4 * fq) = pack4(acc[a][b]);
    __syncthreads();
}
constexpr int PL_LD = 264, MA_KV_BYTES = 64 * 264 * 2, MA_P_OFF = MA_KV_BYTES;
__device__ __forceinline__ void memattn_unit(int b, int h, int rb, const bf16_t* mkn, const bf16_t* mvt, bf16_t* mo  , LAS unsigned char* lds) {
    const bf16_t* mq = mo;
    const int tid = opaque_tid(), lane = tid & 63, wave = __builtin_amdgcn_readfirstlane(tid >> 6);
    const int fr = lane & 15, fq = lane >> 4;
    LAS bf16_t* kv = (LAS bf16_t*)lds; LAS bf16_t* pl = (LAS bf16_t*)(lds + MA_P_OFF) + wave * (16 * PL_LD);
    const int row = 128 * rb + 16 * wave + fr;
    const bf16_t* ksrc = mkn + (size_t)(b * 256) * 1024 + h * 256;
    const bf16_t* vsrc = mvt + (size_t)((b * 4 + h) * 256) * 256;
    u32x4 pre[4];
#pragma unroll
    for (int i = 0; i < 4; ++i) { const int p = tid + 512 * i; pre[i] = *(const u32x4*)(ksrc + (size_t)(p >> 5) * 1024 + (p & 31) * 8); }
    bf16x8 qf[8]; float qs = 0.f;
#pragma unroll
    for (int ks = 0; ks < 8; ++ks) { qf[ks] = *(const bf16x8*)(mq + (size_t)row * 1024 + h * 256 + 32 * ks + 8 * fq);
#pragma unroll
        for (int j = 0; j < 8; ++j) { const float f = bf2f((unsigned short)qf[ks][j]); qs += f * f; } }
    qs += __shfl_xor(qs, 16); qs += __shfl_xor(qs, 32);
    const float scl = __builtin_amdgcn_rsqf(qs * (1.0f / 256.0f) + EPS) * (0.0625f * LOG2E);
    f32x4 sa[16];
#pragma unroll
    for (int kc = 0; kc < 4; ++kc) {
        __syncthreads();
#pragma unroll
        for (int i = 0; i < 4; ++i) { const int p = tid + 512 * i; *(LAS u32x4*)(kv + (p >> 5) * PL_LD + (p & 31) * 8) = pre[i]; }
        __syncthreads();
#pragma unroll
        for (int i = 0; i < 4; ++i) { const int p = tid + 512 * i;
            pre[i] = (kc < 3) ? *(const u32x4*)(ksrc + (size_t)(64 * (kc + 1) + (p >> 5)) * 1024 + (p & 31) * 8) : *(const u32x4*)(vsrc + (size_t)(p >> 5) * 256 + (p & 31) * 8); }
#pragma unroll
        for (int tl = 0; tl < 4; ++tl) {
            f32x4 a = (f32x4){0.f, 0.f, 0.f, 0.f};
#pragma unroll
            for (int ks = 0; ks < 8; ++ks) { const bf16x8 kf = *(const LAS bf16x8*)(kv + (16 * tl + fr) * PL_LD + 32 * ks + 8 * fq); a = mfma16(kf, qf[ks], a); }
            sa[4 * kc + tl] = a * scl;
        }
    }
    float mx = -INFINITY;
#pragma unroll
    for (int t = 0; t < 16; ++t) mx = fmaxf(mx, fmaxf(fmaxf(sa[t][0], sa[t][1]), fmaxf(sa[t][2], sa[t][3])));
    mx = fmaxf(mx, __shfl_xor(mx, 16)); mx = fmaxf(mx, __shfl_xor(mx, 32));
    float l = 0.f;
#pragma unroll
    for (int t = 0; t < 16; ++t) {
        f32x4 p;
#pragma unroll
        for (int r = 0; r < 4; ++r) { p[r] = __builtin_amdgcn_exp2f(sa[t][r] - mx); l += p[r]; }
        *(LAS u32x2*)(pl + fr * PL_LD + 16 * t + 4 * fq) = pack4(p);
    }
    l += __shfl_xor(l, 16); l += __shfl_xor(l, 32);
    const float rl = __builtin_amdgcn_rcpf(l);
    LDS_WAIT(); asm volatile("" ::: "memory");
    bf16x8 pf[8];
#pragma unroll
    for (int ks = 0; ks < 8; ++ks) pf[ks] = *(const LAS bf16x8*)(pl + fr * PL_LD + 32 * ks + 8 * fq);
#pragma unroll
    for (int dc = 0; dc < 4; ++dc) {
        __syncthreads();
#pragma unroll
        for (int i = 0; i < 4; ++i) { const int p = tid + 512 * i; *(LAS u32x4*)(kv + (p >> 5) * PL_LD + (p & 31) * 8) = pre[i]; }
        __syncthreads();
        if (dc < 3) {
#pragma unroll
            for (int i = 0; i < 4; ++i) { const int p = tid + 512 * i; pre[i] = *(const u32x4*)(vsrc + (size_t)(64 * (dc + 1) + (p >> 5)) * 256 + (p & 31) * 8); }
        }
#pragma unroll
        for (int tl = 0; tl < 4; ++tl) {
            f32x4 a = (f32x4){0.f, 0.f, 0.f, 0.f};
#pragma unroll
            for (int ks = 0; ks < 8; ++ks) { const bf16x8 vf = *(const LAS bf16x8*)(kv + (16 * tl + fr) * PL_LD + 32 * ks + 8 * fq); a = mfma16(vf, pf[ks], a); }
            *(u32x2*)(mo + (size_t)row * 1024 + h * 256 + 64 * dc + 16 * tl + 4 * fq) = pack4(a * rl);
        }
    }
    __syncthreads();
}
__device__ __forceinline__ void dif_row(const bf16_t* o0, const bf16_t* o1, bf16_t* dif, const float* gout, float lam, int lane) {
    const u32x4* a = (const u32x4*)o0 + 2 * lane; const u32x4* b = (const u32x4*)o1 + 2 * lane;
    float d[16]; float ss = 0.f;
#pragma unroll
    for (int v = 0; v < 2; ++v) { const u32x4 x = __builtin_nontemporal_load(a + v), y = __builtin_nontemporal_load(b + v);
#pragma unroll
        for (int w = 0; w < 4; ++w) { const float x0 = __uint_as_float(x[w] << 16), x1 = __uint_as_float(x[w] & 0xffff0000u), y0 = __uint_as_float(y[w] << 16), y1 = __uint_as_float(y[w] & 0xffff0000u);
            const float d0 = x0 - lam * y0, d1 = x1 - lam * y1; d[v * 8 + w * 2] = d0; d[v * 8 + w * 2 + 1] = d1; ss += d0 * d0 + d1 * d1; } }
    ss += __shfl_xor(ss, 1); ss += __shfl_xor(ss, 2); ss += __shfl_xor(ss, 4);
    const float rn = __builtin_amdgcn_rsqf(ss * (1.0f / 128.0f) + EPS) * (1.0f - LAM_INIT);
    const float* gp = gout + (lane & 7) * 16;
    u32x4 o[2];
#pragma unroll
    for (int v = 0; v < 2; ++v)
#pragma unroll
        for (int w = 0; w < 4; ++w) o[v][w] = cvt_pk_bf16(d[v * 8 + w * 2] * rn * gp[v * 8 + w * 2], d[v * 8 + w * 2 + 1] * rn * gp[v * 8 + w * 2 + 1]);
    u32x4* op = (u32x4*)dif + 2 * lane; op[0] = o[0]; op[1] = o[1];
}

struct P4bOrder {
    pg8::StaticOrder T; unsigned char* ws; const char* xa;
    __device__ __forceinline__ bool next(int i, pg8::Unit& u) const {
        int pm, pn; if (!T.tile(i, pm, pn)) return false;
        u.pm = pm; u.pn = pn; u.ui = i; u.ri = i; u.tag = 0; u.K = 1024;
        u.A = xa + (size_t)pm * 256 * 1024 * 2;
        u.Bt = (const char*)ws + (pn < 8 ? WS_WRG + (size_t)pn * 256 * 1024 * 2 : WS_WGATE + (size_t)(pn - 8) * 256 * 1024 * 2); return true;
    }
};
struct P5Order {
    pg8::StaticOrder T; unsigned char* ws;
    __device__ __forceinline__ bool next(int i, pg8::Unit& u) const {
        const int ti = i / 3, kbr = i - 3 * ti; int pm, pn; if (!T.tile(ti, pm, pn)) return false;
        const size_t offA = kbr == 0 ? WS_RET : kbr == 1 ? WS_DIF : WS_MO;
        const size_t offB = kbr == 0 ? WS_WBRR : kbr == 1 ? WS_WBRD : WS_WBRM;
        const int K = kbr == 0 ? 2048 : 1024;
        u.pm = pm; u.pn = pn; u.ui = i; u.ri = ti; u.tag = kbr; u.K = K;
        u.A = (const char*)ws + offA + (size_t)pm * 256 * K * 2; u.Bt = (const char*)ws + offB + (size_t)pn * 256 * K * 2; return true;
    }
};
#ifndef PH_MASK
#define PH_MASK 0xffffffffu
#endif
#define PH(n) ((PH_MASK >> (n)) & 1u)
#ifndef DUP_MASK
#define DUP_MASK 0u
#endif
#ifndef PROBE_K
#define PROBE_K (-1)
#endif
#define RUNP(k) (pass_ == 1 || (k) <= PROBE_K)
#define REPQ(n) _Pragma("unroll 1") for (int rq_ = 0; rq_ < 1 + (int)((DUP_MASK >> (n)) & 1u); ++rq_)
#define REP(n) _Pragma("unroll 1") for (int rep_ = 0; rep_ < 1 + (int)((DUP_MASK >> (n)) & 1u); ++rep_)
struct Args { const void* in[26]; float* out; unsigned char* ws; };
#define CAS __attribute__((address_space(4)))
__device__ __forceinline__ const void* karg(int i) { typedef const GAS void* gptr; const CAS gptr* p = (const CAS gptr*)__builtin_amdgcn_kernarg_segment_ptr(); asm volatile("" : "+s"(p)); return (const void*)p[i]; }
#define INP(i) ((const float*)karg(i))
#define WSP(T, off) ((T*)((unsigned char*)karg(27) + (off)))
#define OUTP ((float*)karg(26))
struct SplitWait {
    unsigned target;
    __device__ __forceinline__ void wait() const { if (target) xcd_split_wait((unsigned*)WSP(unsigned, WS_CTL) + CW_BAR2, (unsigned*)WSP(unsigned, WS_CTL) + CW_BAR, target); }
};
__global__ void __launch_bounds__(NWAVES * 64, 2) mk_fwd(Args args) {
    extern __shared__ __attribute__((aligned(16))) unsigned char lds_raw[];
    LAS unsigned char* lds = (LAS unsigned char*)lds_raw;
    volatile LAS unsigned* MISC = (volatile LAS unsigned*)(lds + MISC_OFF);
    const int G = gridDim.x, bx = blockIdx.x;
    for (int u = threadIdx.x; u < (LDS_BYTES - LDSCTL_OFF) / 4; u += NWAVES * 64) ((LAS unsigned*)(lds + LDSCTL_OFF))[u] = 0u;
    __syncthreads();
    (void)xcd_barrier_post((unsigned*)WSP(unsigned, WS_CTL) + CW_BAR, MISC + 8);
#define GRID_BAR() do { XcdBarrier b_; b_.bar = (unsigned*)WSP(unsigned, WS_CTL) + CW_BAR; b_.x = xb_xcc_id(); b_.st = (volatile LAS unsigned*)(lds + MISC_OFF) + 8; xcd_barrier(b_); } while (0)
#define SPLIT_ARRIVE() do { xcd_split_arrive((unsigned*)WSP(unsigned, WS_CTL) + CW_BAR2, (unsigned*)WSP(unsigned, WS_CTL) + CW_BAR, (volatile LAS unsigned*)(lds + MISC_OFF) + 8); ++sgen; } while (0)
    unsigned sgen = 0;
    const int NGW = G * NWAVES, NGT = G * NWAVES * 64;
#define LANE_VARS() const int tid = opaque_tid(), lane = tid & 63, wave = __builtin_amdgcn_readfirstlane(tid >> 6); LAS float* scr = (LAS float*)(lds + wave * 16384); \
    const int gw = bx * NWAVES + wave, gt = bx * (NWAVES * 64) + tid; (void)scr; (void)gw; (void)gt; (void)lane

#pragma unroll 1
    for (int pass_ = (PROBE_K >= 0 ? 0 : 1); pass_ < 2; ++pass_) {
    if (RUNP(0)) {
    REP(0) if (PH(0)) {
        LANE_VARS();
        transpose_all<true>(INP(4), 1024, 2 * DFF, WSP(bf16_t, WS_WF1I), 2 * DFF, ColSwiglu{}, nullptr, scr, gw, NGW, lane);
        transpose_all(INP(18), 1024, 2048, WSP(bf16_t, WS_WMKV), 2048, ColIdent{0}, nullptr, scr, gw, NGW, lane);
        { const float* x = INP(0); const float* g1 = INP(3); bf16_t* xb = WSP(bf16_t, WS_XBL);
          rms_rows_to_bf16(x, g1, xb, gw, NGW, TOK, lane); }
        { const float* mem = INP(1); const float* gm = INP(17); bf16_t* memn = WSP(bf16_t, WS_MEMN);
          rms_rows_to_bf16(mem, gm, memn, gw, NGW, NB * MEML, lane); }
        rot_table((const int*)karg(2), WSP(float, WS_ROT), gt, NGT);
    }
    GRID_BAR();
    }

    if (RUNP(1)) {
    REP(1) if (PH(1)) {
        pg8::Gemm g{WSP(bf16_t, WS_XBL), WSP(bf16_t, WS_WF1I), TOK, 2 * DFF, 1024}; pg8::StaticOrder S; S.init(TOK, 2 * DFF, G, bx);
        EpiSwiglu E{WSP(bf16_t, WS_ACT), nullptr};
        S.set(g); pg8::gemm_phase(lds, S, E);
    }
    if (PH(2)) {
        pg8::Gemm g{WSP(bf16_t, WS_MEMN), WSP(bf16_t, WS_WMKV), NB * MEML, 2048, 1024}; pg8::StaticOrder S; S.init(NB * MEML, 2048, G, (bx + G / 2) % G);
        EpiPlain E{WSP(bf16_t, WS_MKVRAW), 2048};
        S.set(g); pg8::gemm_phase(lds, S, E);
    }
    if (PH(0)) {
        const int q0 = (3 * G) / 4, nq = G - q0;
        if (bx >= q0) {
            LANE_VARS();
            const int gw2 = (bx - q0) * NWAVES + wave, ngw2 = nq * NWAVES;
            transpose_all(INP(5), DFF, 1024, WSP(bf16_t, WS_WF1O), 1024, ColIdent{0}, nullptr, scr, gw2, ngw2, lane);
            transpose_all<true>(INP(7), 1024, 13312, WSP(bf16_t, WS_WMIX), NMIX, ColMix{}, INP(6), scr, gw2, ngw2, lane);
        }
    }
    GRID_BAR();
    }

    if (RUNP(2)) {
    REP(3) if (PH(3)) {
        pg8::Gemm g{WSP(bf16_t, WS_ACT), WSP(bf16_t, WS_WF1O), TOK, 1024, DFF}; pg8::StaticOrder S; S.init(TOK, 1024, G, bx);
        EpiResid<false, false> E{INP(0), nullptr, (bf16_t*)OUTP, WSP(float, WS_SSQ1), 0.5f, (rep_ == 1 && ((DUP_MASK >> 23) & 1u)) ? 1 : 0};
        S.set(g); pg8::gemm_phase(lds, S, E);
    }
    SPLIT_ARRIVE();
    if (PH(0)) {
        LANE_VARS();
        const bf16_t* mkvraw = WSP(bf16_t, WS_MKVRAW); bf16_t* mkn = WSP(bf16_t, WS_MKN); bf16_t* mvt = WSP(bf16_t, WS_MVT);
        const float* g_mem_k = INP(16); const float* g_mem_q = INP(15);
        for (int j = gw; j < NB * MEML * 4; j += NGW) {
            const int row = j >> 2, h = j & 3;
            const u32x2 w = *((const u32x2*)(mkvraw + (size_t)row * 2048 + h * 256) + lane);
            f32x4 v = (f32x4){__uint_as_float(w.x << 16), __uint_as_float(w.x & 0xffff0000u), __uint_as_float(w.y << 16), __uint_as_float(w.y & 0xffff0000u)};
            const float ss = wave_sum((v[0] * v[0] + v[1] * v[1]) + (v[2] * v[2] + v[3] * v[3]));
            const float rn = __builtin_amdgcn_rsqf(ss * (1.0f / 256.0f) + EPS);
            const f32x4 gk = *((const f32x4*)g_mem_k + lane), gq = *((const f32x4*)g_mem_q + lane);
            *((u32x2*)(mkn + (size_t)row * 1024 + h * 256) + lane) = pack4(v * rn * gk * gq);
        }
        for (int idx = gt; idx < NB * 4 * 256 * 256; idx += NGT) {
            const int key = idx & 255, d = (idx >> 8) & 255, bh = idx >> 16, b = bh >> 2, h = bh & 3;
            mvt[idx] = mkvraw[(size_t)(b * 256 + key) * 2048 + 1024 + h * 256 + d];
        }
    }
    { SplitWait H{sgen}; H.wait(); }
    }

    if (RUNP(3))
    for (int ph = 0; ph <= NB; ++ph) {
        const int gp = ph, gm = ph - 1;
        unsigned char* const wsP = WSP(unsigned char, 0) - (((gp + 1) & 1) ? SET_DELTA : 0);
        unsigned char* const wsB = WSP(unsigned char, 0) - (((gm + 1) & 1) ? SET_DELTA : 0);
        unsigned* done = (unsigned*)WSP(unsigned, WS_CTL) + CW_SCAN + ((pass_ * NB + (gm < 0 ? 0 : gm)) * 8) * 64; unsigned* tmo = (unsigned*)WSP(unsigned, WS_CTL) + CW_BAR + XB_TMO;
        const bool early = (gm >= 0 && bx < 64) || gp >= NB;
        if (early) { SplitWait H{sgen}; H.wait(); }
        if (gm >= 0)
            for (int u = bx; u < 64; u += G) REPQ(26) { __syncthreads(); if (PH(5)) scan_unit(u, (const bf16_t*)(wsB + WS_KTS), (const bf16_t*)(wsB + WS_VT), WSP(bf16_t, WS_S), lds, done); }
        if (gp < NB) {
            REP(4) if (PH(4)) {
                pg8::Gemm g{(const bf16_t*)OUTP + (size_t)gp * SEQ * DM, WSP(bf16_t, WS_WMIX), SEQ, NMIX, 1024}; pg8::StaticOrder S; S.init(SEQ, NMIX, G, bx);
                prep_rs(WSP(float, WS_SSQ1), gp * SEQ, S, lds);
                EpiMix E{(const LAS float*)(lds + RTAB_OFF), WSP(float, (gp & 1) ? WS_ROTB : WS_ROT), wsP, WSP(bf16_t, WS_MO) + (size_t)gp * SEQ * 1024, INP(8), INP(9)};
                SplitWait H{early ? 0u : sgen};
                S.set(g); pg8::gemm_phase(lds, S, E, H);
                if (bx >= (SEQ / 256) * (NMIX / 256)) H.wait();
            }
        }
        if (gm >= 0) {
            const size_t oOff = (gm & 1) ? WS_OB : 0;
            unsigned* qctr = (unsigned*)WSP(unsigned, WS_CTL) + CW_QUEUE + (pass_ * NB + gm) * 64;
            volatile LAS unsigned* qslot = (volatile LAS unsigned*)(lds + MISC_OFF) + 16;
            for (;;) {
                __syncthreads();
                if (threadIdx.x == 0) qslot[0] = __hip_atomic_fetch_add(qctr, 1u, __ATOMIC_RELAXED, __HIP_MEMORY_SCOPE_AGENT);
                __syncthreads();
                const int id = __builtin_amdgcn_readfirstlane((int)qslot[0]);
                if (id >= 448) break;
                int aq = -1, aj = 0;
                if (id < 192) { aq = 7 - (id >> 5); aj = id & 31; }
                else if (id < 320) { const int ro = id - 192;
                    if (PH(8)) REPQ(24) { __syncthreads(); retout_unit(ro >> 5, (ro >> 1) & 15, ro & 1, (const bf16_t*)(wsB + WS_Q), (const bf16_t*)(wsB + WS_K), (const bf16_t*)(wsB + WS_VT), WSP(bf16_t, WS_S),
                                           WSP(bf16_t, WS_RET) + (size_t)gm * SEQ * 2048, WSP(float, WS_SSQ2) + (size_t)gm * SEQ * 8, lds, done, tmo); } }
                else if (id < 384) { const int m = id - 320;
                    if (PH(7)) memattn_unit(gm, m >> 4, m & 15, WSP(bf16_t, WS_MKN), WSP(bf16_t, WS_MVT), WSP(bf16_t, WS_MO) + (size_t)gm * SEQ * 1024, lds); }
                else { aq = 1 - ((id - 384) >> 5); aj = (id - 384) & 31; }
                if (aq >= 0) {
                    const int hc = aj >> 1, vh = aj & 1, hh = hc >> 1, cc = hc & 1;
                    if (PH(6)) REPQ(25) attn_body::attn_unit<8>(hc, 2 * hh + vh, aq, (const attn_body::bf16*)(wsB + WS_DQ), (const attn_body::bf16*)(wsB + WS_DK), (const attn_body::bf16*)(wsB + WS_DV),
                                            WSP(attn_body::bf16, (cc ? WS_O1 : WS_O0) + oOff), (char*)lds_raw);
                }
            }
        }
        {
            LANE_VARS();
            if (ph >= 2) {
                const int gd = ph - 2; const size_t oD = (gd & 1) ? WS_OB : 0;
                const float s1 = wave_sum(INP(10)[lane] * INP(11)[lane]), s2 = wave_sum(INP(12)[lane] * INP(13)[lane]); const float lam = __expf(s1) - __expf(s2) + LAM_INIT;
                const bf16_t* bo0 = WSP(bf16_t, WS_O0 + oD); const bf16_t* bo1 = WSP(bf16_t, WS_O1 + oD); bf16_t* difb = WSP(bf16_t, WS_DIF); const float* gdo = INP(14);
                for (int r = gw; r < SEQ; r += NGW) dif_row(bo0 + (size_t)r * 1024, bo1 + (size_t)r * 1024, difb + ((size_t)gd * SEQ + r) * 1024, gdo, lam, lane);
            }
            if (ph + 1 < NB) rot_table((const int*)karg(2) + (ph + 1) * SEQ, WSP(float, ((ph + 1) & 1) ? WS_ROTB : WS_ROT), gt, NGT);
            if (ph == 0) transpose_all<true>(INP(7), 1024, 13312, WSP(bf16_t, WS_WRG), 2048, ColIdent{4096}, INP(6), scr, gw, NGW, lane);
            if (ph == NB) {
                transpose_all<true>(INP(7), 1024, 13312, WSP(bf16_t, WS_WGATE), 3072, ColIdent{10240}, INP(6), scr, gw, NGW, lane);
            }
        }
        SPLIT_ARRIVE();
    }

    if (RUNP(4)) {
    if (PH(9)) {
        pg8::StaticOrder T; T.init(TOK, 5120, G, bx);
        prep_rs(WSP(float, WS_SSQ1), 0, T, lds);
        P4bOrder S{T, WSP(unsigned char, 0), (const char*)OUTP};
        EpiRgG E{(const LAS float*)(lds + RTAB_OFF), WSP(bf16_t, WS_RET), WSP(float, WS_SSQ2), WSP(unsigned char, 0)};
        SplitWait H{sgen};
        pg8::gemm_phase(lds, S, E, H);
        if (bx >= (TOK / 256) * (5120 / 256)) H.wait();
    }
    if (PH(0)) {
        LANE_VARS();
        { const float s1 = wave_sum(INP(10)[lane] * INP(11)[lane]), s2 = wave_sum(INP(12)[lane] * INP(13)[lane]); const float lam = __expf(s1) - __expf(s2) + LAM_INIT;
          const bf16_t* bo0 = WSP(bf16_t, WS_O0 + (((NB - 1) & 1) ? WS_OB : 0)); const bf16_t* bo1 = WSP(bf16_t, WS_O1 + (((NB - 1) & 1) ? WS_OB : 0)); bf16_t* difb = WSP(bf16_t, WS_DIF); const float* gdo = INP(14);
          for (int r = gw; r < SEQ; r += NGW) dif_row(bo0 + (size_t)r * 1024, bo1 + (size_t)r * 1024, difb + ((size_t)(NB - 1) * SEQ + r) * 1024, gdo, lam, lane); }
        transpose_all<true>(INP(19), 2048, 1024, WSP(bf16_t, WS_WBRR), 1024, ColIdent{0}, nullptr, scr, gw, NGW, lane);
        transpose_all<true>(INP(20), 1024, 1024, WSP(bf16_t, WS_WBRD), 1024, ColIdent{0}, nullptr, scr, gw, NGW, lane);
        transpose_all<true>(INP(21), 1024, 1024, WSP(bf16_t, WS_WBRM), 1024, ColIdent{0}, nullptr, scr, gw, NGW, lane);
    }
    SPLIT_ARRIVE();
    if (PH(0)) {
        LANE_VARS();
        transpose_all(INP(22), 1024, 1024, WSP(bf16_t, WS_WO), 1024, ColIdent{0}, nullptr, scr, gw, NGW, lane);
        transpose_all(INP(25), DFF, 1024, WSP(bf16_t, WS_WF2O), 1024, ColIdent{0}, nullptr, scr, gw, NGW, lane);
    }
    { SplitWait H{sgen}; H.wait(); }
    }

    if (RUNP(5)) {
    REP(10) if (PH(10)) {
        pg8::StaticOrder T; T.init(TOK, 1024, G, bx);
        P5Order S{T, WSP(unsigned char, 0)};
        EpiTerm3 E{WSP(unsigned char, 0), WSP(bf16_t, WS_Y)};
        pg8::gemm_phase(lds, S, E);
    }
    SPLIT_ARRIVE();
    if (PH(0)) {
        LANE_VARS();
        transpose_all<true>(INP(24), 1024, 2 * DFF, WSP(bf16_t, WS_WF2I), 2 * DFF, ColSwiglu{}, INP(23), scr, gw, NGW, lane);
    }
    { SplitWait H{sgen}; H.wait(); }
    }

    if (RUNP(6)) {
    if (PH(11)) {
        pg8::Gemm g{WSP(bf16_t, WS_Y), WSP(bf16_t, WS_WO), TOK, 1024, 1024}; pg8::StaticOrder S; S.init(TOK, 1024, G, bx);
        EpiResid<true, false> E{OUTP, nullptr, WSP(bf16_t, WS_X2B), WSP(float, WS_SSQ2), 1.0f, 0};
        S.set(g); pg8::gemm_phase(lds, S, E);
    }
    GRID_BAR();
    }

    if (RUNP(7)) {
    if (PH(12)) {
        pg8::Gemm g{WSP(bf16_t, WS_X2B), WSP(bf16_t, WS_WF2I), TOK, 2 * DFF, 1024}; pg8::StaticOrder S; S.init(TOK, 2 * DFF, G, bx);
        prep_rs(WSP(float, WS_SSQ2), 0, S, lds);
        EpiSwiglu E{WSP(bf16_t, WS_ACT2), (const LAS float*)(lds + RTAB_OFF)};
        S.set(g); pg8::gemm_phase(lds, S, E);
    }
    GRID_BAR();
    }

    if (RUNP(8))
    if (PH(13)) {
        pg8::Gemm g{WSP(bf16_t, WS_ACT2), WSP(bf16_t, WS_WF2O), TOK, 1024, DFF}; pg8::StaticOrder S; S.init(TOK, 1024, G, bx);
        EpiResid<true, true> E{WSP(bf16_t, WS_X2B), OUTP, nullptr, nullptr, 0.5f, 0};
        S.set(g); pg8::gemm_phase(lds, S, E);
    }
    if (pass_ == 0) GRID_BAR();
    }
}

extern "C" void kernel_launch(void* const* d_in, const int* in_sizes, int n_in, void* d_out, int out_size, void* d_ws, size_t ws_size, hipStream_t stream) {
    static int grid = 0;
    if (grid == 0) {
        if (n_in != 26 || ws_size < WS_END) { fprintf(stderr, "kernel_launch: unexpected inputs (n_in %d, ws %zu)\n", n_in, ws_size); grid = -1; return; }
        int dev = 0, cus = 0;
        if (hipGetDevice(&dev) != hipSuccess || hipDeviceGetAttribute(&cus, hipDeviceAttributeMultiprocessorCount, dev) != hipSuccess) { grid = -1; return; }
        if (hipFuncSetAttribute((const void*)mk_fwd, hipFuncAttributeMaxDynamicSharedMemorySize, LDS_BYTES) != hipSuccess) { fprintf(stderr, "kernel_launch: hipFuncSetAttribute failed\n"); grid = -1; return; }
        grid = cus;
    }
    if (grid < 0) return;
    (void)hipMemsetAsync((char*)d_ws + WS_CTL, 0, CTL_ZERO_BYTES, stream);
    Args a{};
    for (int i = 0; i < 26; ++i) a.in[i] = d_in[i];
    a.out = (float*)d_out; a.ws = (unsigned char*)d_ws;
    hipLaunchKernelGGL(mk_fwd, dim3(grid), dim3(NWAVES * 64), LDS_BYTES, stream, a);
}
```

```cpp
#include <hip/hip_runtime.h>
#include <cstdio>
#include <cstdint>

#define LAS __attribute__((address_space(3)))
#define GAS __attribute__((address_space(1)))
typedef unsigned short bf16_t;
typedef short bf16x8 __attribute__((ext_vector_type(8)));
typedef float f32x4 __attribute__((ext_vector_type(4)));
typedef float f32x2 __attribute__((ext_vector_type(2)));
typedef unsigned u32x4 __attribute__((ext_vector_type(4)));
typedef unsigned u32x2 __attribute__((ext_vector_type(2)));

constexpr int NB = 8, SEQ = 2048, DM = 1024, TOK = NB * SEQ, MEML = 256, DFF = 2816;
constexpr int NMIX = 8192;
constexpr float EPS = 1e-6f;
constexpr float LOG2E = 1.4426950408889634f;
constexpr float C2Q = 0.125f * LOG2E;
constexpr float LAM_INIT = 0.2f;

constexpr size_t MiB = 1u << 20;
constexpr size_t KiB = 1u << 10;
constexpr size_t WS_CTL = 0, CTL_ZERO_BYTES = 256 * KiB;
constexpr size_t WS_SSQ1 = 256 * KiB, WS_SSQ2 = 512 * KiB;
constexpr size_t WS_ROT = 1 * MiB, WS_ROTB = 153 * MiB;
constexpr size_t WS_MKN = 3 * MiB, WS_MVT = 7 * MiB;
constexpr size_t WS_WMIX = 11 * MiB;
constexpr size_t WS_XB = 27 * MiB;
constexpr size_t WS_RET = 59 * MiB;
constexpr size_t WS_XBL = 91 * MiB;
constexpr size_t WS_DIF = 123 * MiB;
constexpr size_t WS_MO = 155 * MiB;
constexpr size_t WS_Q = 187 * MiB, WS_K = 191 * MiB, WS_KTS = 195 * MiB, WS_VT = 199 * MiB, WS_DQ = 207 * MiB, WS_DK = 211 * MiB,
                 WS_DV = 215 * MiB;
constexpr size_t SET_DELTA = 160 * MiB;
constexpr size_t WS_WRG = 219 * MiB;
constexpr size_t WS_O0 = 223 * MiB, WS_O1 = 227 * MiB, WS_S = 231 * MiB;
constexpr size_t WS_OB = 24 * MiB;
constexpr size_t WS_WF1I = 59 * MiB, WS_WF1O = 70 * MiB;
constexpr size_t WS_MEMN = 76 * MiB, WS_MKVRAW = 80 * MiB, WS_WMKV = 27 * MiB;
constexpr size_t WS_ACT = 155 * MiB;
constexpr size_t WS_WGATE = 11 * MiB, WS_WBRR = 17 * MiB, WS_WBRD = 21 * MiB, WS_WBRM = 23 * MiB, WS_WO = 25 * MiB;
constexpr size_t WS_G8A = 187 * MiB, WS_G8B = 203 * MiB, WS_G8C = 223 * MiB;
constexpr size_t WS_Y = 27 * MiB;
constexpr size_t WS_X2B = 187 * MiB;
constexpr size_t WS_WF2I = 239 * MiB, WS_WF2O = 1 * MiB, WS_ACT2 = 76 * MiB;
constexpr size_t WS_END = 256 * MiB;

constexpr int CW_BAR = 4096, CW_BAR2 = 8192;
constexpr int CW_QUEUE = 32768;
constexpr int CW_SCAN = 16384;

constexpr int RING_BYTES = 131072, LDSCTL_OFF = RING_BYTES, MISC_OFF = LDSCTL_OFF + 320, LDS_BYTES = 147456;
constexpr int NWAVES = 8;

__device__ __forceinline__ unsigned cvt_pk_bf16(float lo, float hi) { unsigned r; asm volatile("v_cvt_pk_bf16_f32 %0, %1, %2" : "=v"(r) : "v"(lo), "v"(hi)); return r; }
__device__ __forceinline__ u32x2 pack4(f32x4 v) { u32x2 w; w.x = cvt_pk_bf16(v[0], v[1]); w.y = cvt_pk_bf16(v[2], v[3]); return w; }
__device__ __forceinline__ unsigned short bf16_1(float v) { return (unsigned short)(cvt_pk_bf16(v, 0.f) & 0xffffu); }
__device__ __forceinline__ float bf2f(unsigned short b) { return __uint_as_float(((unsigned)b) << 16); }
__device__ __forceinline__ float siluf(float x) { return x * __builtin_amdgcn_rcpf(1.0f + __builtin_amdgcn_exp2f(-x * LOG2E)); }
__device__ __forceinline__ float sigmf(float x) { return __builtin_amdgcn_rcpf(1.0f + __builtin_amdgcn_exp2f(-x * LOG2E)); }
__device__ __forceinline__ float row_rs(const float* ssq, int row) {
    const f32x4 a = *(const f32x4*)(ssq + (size_t)row * 4);
    return __builtin_amdgcn_rsqf(((a[0] + a[1]) + (a[2] + a[3])) * (1.0f / 1024.0f) + EPS);
}
__device__ __forceinline__ int opaque_tid() { int t = threadIdx.x; asm volatile("" : "+v"(t)); return t; }
__device__ __forceinline__ f32x4 mfma16(bf16x8 a, bf16x8 b, f32x4 c) { return __builtin_amdgcn_mfma_f32_16x16x32_bf16(a, b, c, 0, 0, 0); }

namespace pg8 {
constexpr int BM = 256, BK = 64, HALF = 128, HTB = HALF * BK * 2, STAGE_BYTES = 8 * HTB, NXCD = 8, WGM = 8;
__host__ __device__ __forceinline__ int lds_byte(int r, int c) { const int st = (r >> 4) * 2 + (c >> 5), rr = r & 15, cc = c & 31, ob = rr * 64 + cc * 2; return st * 1024 + (ob ^ (((ob >> 9) & 1) << 5)); }
__host__ __device__ __forceinline__ void stage_rc(int b, int& R, int& C) { const int st = b / 1024, sb = b % 1024, swz = sb ^ (((sb >> 9) & 1) << 5); R = (st >> 1) * 16 + swz / 64; C = (st & 1) * 32 + (swz % 64) / 2; }
struct Unit { int pm, pn, ui, ri, tag, K; const char* A; const char* Bt; };
struct Gemm { const bf16_t* A; const bf16_t* Bt; int M, N, K; };
struct StaticOrder {
    int nM, nN, nwg, G, c; Gemm g;
    __host__ __device__ void init(int M, int N, int G_, int c_) { nM = M / BM; nN = N / BM; nwg = nM * nN; G = G_; c = c_; g.A = nullptr; g.Bt = nullptr; g.M = M; g.N = N; g.K = 0; }
    __host__ __device__ void set(const Gemm& g_) { g = g_; }
    __host__ __device__ bool tile(int i, int& pm, int& pn) const {
        const long L = (long)i * G + c; if (L >= nwg) return false;
        int wgid = (int)L; { const int q = nwg / NXCD, r = nwg % NXCD, xcd = wgid % NXCD, off = wgid / NXCD; wgid = (xcd < r ? xcd * (q + 1) : r * (q + 1) + (xcd - r) * q) + off; }
        const int nig = WGM * nN, gid = wgid / nig, fm = gid * WGM, gsz = (nM - fm) < WGM ? (nM - fm) : WGM;
        pm = fm + ((wgid % nig) % gsz); pn = (wgid % nig) / gsz; return true;
    }
    __host__ __device__ bool next(int i, Unit& u) const {
        if (!tile(i, u.pm, u.pn)) return false;
        u.ui = i; u.ri = i; u.tag = 0; u.K = g.K;
        u.A = (const char*)g.A + (size_t)u.pm * 256 * g.K * 2; u.Bt = (const char*)g.Bt + (size_t)u.pn * 256 * g.K * 2; return true;
    }
};
struct NoHook { __device__ __forceinline__ void wait() const {} };
template <class Epi, class Sched, class Hook = NoHook>
__device__ __forceinline__ void gemm_phase(LAS unsigned char* lds, const Sched& S, const Epi& E, const Hook& H = Hook{}) {
    const int tid = opaque_tid(), wid = __builtin_amdgcn_readfirstlane(tid >> 6), lane = tid & 63, wr = wid >> 2, wc = wid & 3, fr = lane & 15, fq = lane >> 4;
    unsigned R2[2], C2[2];
#pragma unroll
    for (int i = 0; i < 2; ++i) { int R, C; stage_rc(tid * 16 + i * 8192, R, C); R2[i] = (unsigned)R * 2u; C2[i] = (unsigned)C * 2u; }
    const size_t kstep = (size_t)(BK * 2);
    const unsigned ldsw = (unsigned)wid * 1024u;
    const int aoff = lds_byte(wr * 64 + fr, fq * 8), boff = lds_byte(wc * 32 + fr, fq * 8);
#define PG8_SA(b, h) (((b) * 2 + (h)) * HTB)
#define PG8_SB(b, h) ((4 + (b) * 2 + (h)) * HTB)
#define PG8_STAGE(bufoff, gbase, voff) do { _Pragma("unroll") for (int _i = 0; _i < 2; ++_i) \
        __builtin_amdgcn_global_load_lds((const unsigned*)((const char*)(gbase) + (voff)[_i]), (LAS unsigned*)(lds + (bufoff) + ldsw + _i * 8192), 16, 0, 0); } while (0)
#define PG8_LDA(dst, b, h) do { _Pragma("unroll") for (int m = 0; m < 4; ++m) _Pragma("unroll") for (int k = 0; k < 2; ++k) dst[m][k] = *(const LAS bf16x8*)(lds + PG8_SA(b, h) + aoff + m * 2048 + k * 1024); } while (0)
#define PG8_LDB(dst, b, h) do { _Pragma("unroll") for (int n = 0; n < 2; ++n) _Pragma("unroll") for (int k = 0; k < 2; ++k) dst[n][k] = *(const LAS bf16x8*)(lds + PG8_SB(b, h) + boff + n * 2048 + k * 1024); } while (0)
#define PG8_MMA(ai, bj, At, Bt) do { __builtin_amdgcn_s_setprio(1); _Pragma("unroll") for (int m = 0; m < 4; ++m) _Pragma("unroll") for (int n = 0; n < 2; ++n) _Pragma("unroll") for (int k = 0; k < 2; ++k) \
        acc[ai][bj][m][n] = __builtin_amdgcn_mfma_f32_16x16x32_bf16(Bt[n][k], At[m][k], acc[ai][bj][m][n], 0, 0, 0); __builtin_amdgcn_s_setprio(0); } while (0)
#define PG8_WAIT_V(n) asm volatile("s_waitcnt vmcnt(" #n ")" ::: "memory")
#define PG8_WAIT_L(n) asm volatile("s_waitcnt lgkmcnt(" #n ")" ::: "memory")
#define PG8_BAR __builtin_amdgcn_s_barrier()
#define PG8_SCHED __builtin_amdgcn_sched_barrier(0)
    Unit cur, nxt; int ui = 0;
    if (!S.next(0, cur)) return;
    f32x4 acc[2][2][4][2];
#pragma unroll
    for (int a = 0; a < 2; ++a)
#pragma unroll
        for (int b = 0; b < 2; ++b)
#pragma unroll
            for (int m = 0; m < 4; ++m)
#pragma unroll
                for (int n = 0; n < 2; ++n) acc[a][b][m][n] = (f32x4){0.f, 0.f, 0.f, 0.f};
    bf16x8 At[4][2], B0[2][2], B1[2][2];
    const char* cA = cur.A; const char* cB = cur.Bt;
    unsigned vo[2] = {R2[0] * (unsigned)cur.K + C2[0], R2[1] * (unsigned)cur.K + C2[1]};
    size_t hstep = (size_t)HALF * cur.K * 2;
    PG8_STAGE(PG8_SB(0, 0), cB, vo); PG8_STAGE(PG8_SB(0, 1), cB + hstep, vo); PG8_STAGE(PG8_SA(0, 0), cA, vo); PG8_STAGE(PG8_SA(0, 1), cA + hstep, vo);
    if (wr == 1) PG8_BAR;
    PG8_WAIT_V(2); PG8_BAR;
    PG8_STAGE(PG8_SB(1, 0), cB + kstep, vo); PG8_STAGE(PG8_SA(1, 0), cA + kstep, vo); PG8_STAGE(PG8_SB(1, 1), cB + hstep + kstep, vo);
    PG8_WAIT_V(6); PG8_BAR;
    for (;;) {
        const bool has_next = S.next(ui + 1, nxt);
        if (!has_next) nxt = cur;
        const char* nA = nxt.A; const char* nB = nxt.Bt;
        const unsigned voN0 = R2[0] * (unsigned)nxt.K + C2[0], voN1 = R2[1] * (unsigned)nxt.K + C2[1]; const size_t hstepN = (size_t)HALF * nxt.K * 2;
        const int nt = cur.K / BK;
        for (int t = 0; t < nt; t += 2) {
            const bool last = (t == nt - 2);
            const char* a1 = cA + (size_t)(t + 1) * kstep;
            const char* a2 = last ? nA : cA + (size_t)(t + 2) * kstep; const char* b2 = last ? nB : cB + (size_t)(t + 2) * kstep;
            const char* a3 = a2 + kstep; const char* b3 = b2 + kstep;
            const unsigned v2[2] = {last ? voN0 : vo[0], last ? voN1 : vo[1]}; const size_t h2 = last ? hstepN : hstep;
            PG8_LDB(B0, 0, 0); PG8_LDB(B1, 0, 1); PG8_SCHED; PG8_LDA(At, 0, 0); PG8_STAGE(PG8_SA(1, 1), a1 + hstep, vo);
            PG8_WAIT_V(8); PG8_WAIT_L(0); PG8_BAR; PG8_MMA(0, 0, At, B0); PG8_MMA(0, 1, At, B1); PG8_BAR; PG8_SCHED;
            PG8_LDA(At, 0, 1); PG8_STAGE(PG8_SB(0, 0), b2, v2); PG8_STAGE(PG8_SB(0, 1), b2 + h2, v2); PG8_STAGE(PG8_SA(0, 0), a2, v2);
            PG8_WAIT_V(8); PG8_WAIT_L(0); PG8_BAR; PG8_MMA(1, 0, At, B0); PG8_MMA(1, 1, At, B1); PG8_BAR; PG8_SCHED;
            PG8_LDB(B0, 1, 0); PG8_LDB(B1, 1, 1); PG8_SCHED; PG8_LDA(At, 1, 0); PG8_STAGE(PG8_SA(0, 1), a2 + h2, v2);
            PG8_WAIT_V(8); PG8_WAIT_L(0); PG8_BAR; PG8_MMA(0, 0, At, B0); PG8_MMA(0, 1, At, B1); PG8_BAR; PG8_SCHED;
            PG8_LDA(At, 1, 1); PG8_STAGE(PG8_SB(1, 0), b3, v2); PG8_STAGE(PG8_SB(1, 1), b3 + h2, v2); PG8_STAGE(PG8_SA(1, 0), a3, v2);
            PG8_WAIT_V(8); PG8_WAIT_L(0); PG8_BAR; PG8_MMA(1, 0, At, B0); PG8_MMA(1, 1, At, B1); PG8_BAR; PG8_SCHED;
        }
        if (wr == 0) PG8_BAR;
        if (ui == 0 && (!Epi::AFTER_DRAIN || has_next)) H.wait();
        if (!Epi::AFTER_DRAIN || has_next) { int fr2 = fr, fq2 = fq; asm volatile("" : "+v"(fr2), "+v"(fq2)); E(acc, cur, wr, wc, fr2, fq2); }
        if (!has_next) break;
#pragma unroll
        for (int a = 0; a < 2; ++a)
#pragma unroll
            for (int b = 0; b < 2; ++b)
#pragma unroll
                for (int m = 0; m < 4; ++m)
#pragma unroll
                    for (int n = 0; n < 2; ++n) acc[a][b][m][n] = (f32x4){0.f, 0.f, 0.f, 0.f};
        cur = nxt; cA = nA; cB = nB; vo[0] = voN0; vo[1] = voN1; hstep = hstepN; ++ui;
        if (wr == 1) PG8_BAR;
    }
    PG8_WAIT_V(0);
    PG8_BAR;
    if constexpr (Epi::AFTER_DRAIN) { if (ui == 0) H.wait(); }
    if constexpr (Epi::AFTER_DRAIN) { int fr2 = fr, fq2 = fq; asm volatile("" : "+v"(fr2), "+v"(fq2)); E.fused(acc, cur, wr, wc, fr2, fq2, lds); }
#undef PG8_SA
#undef PG8_SB
#undef PG8_STAGE
#undef PG8_LDA
#undef PG8_LDB
#undef PG8_MMA
#undef PG8_WAIT_V
#undef PG8_WAIT_L
#undef PG8_BAR
#undef PG8_SCHED
}
}

__device__ __forceinline__ float wave_sum(float v);
#define ACC_ARG const f32x4 (&acc)[2][2][4][2]
#define EPI_FENCE() asm volatile("" ::: "memory")
constexpr int RTAB_OFF = RING_BYTES + 1024;
__device__ __forceinline__ void prep_rs(const float* ssq, int row_off, const pg8::StaticOrder& S, LAS unsigned char* lds) {
    const int tid = opaque_tid(); LAS float* rtab = (LAS float*)(lds + RTAB_OFF); pg8::Unit u;
    for (int i = 0; i < 6 && S.next(i, u); ++i) if (tid < 256) rtab[i * 256 + tid] = row_rs(ssq, row_off + u.pm * 256 + tid);
    __syncthreads();
}
struct EpiSwiglu {
    static constexpr bool AFTER_DRAIN = false;
    bf16_t* O; const LAS float* rtab;
    __device__ __forceinline__ void operator()(ACC_ARG, const pg8::Unit& u, int wr, int wc, int fr, int fq) const {
        const int lr0 = wr * 64 + fr, col0 = u.pn * 128 + wc * 32 + 8 * fq;
#pragma unroll
        for (int ai = 0; ai < 2; ++ai)
#pragma unroll
            for (int m = 0; m < 4; ++m) {
                const int lr = lr0 + ai * 128 + m * 16;
                const float rs = rtab ? rtab[u.ri * 256 + lr] : 1.0f;
                u32x4 w;
#pragma unroll
                for (int n = 0; n < 2; ++n) {
                    const f32x4 gt = acc[ai][0][m][n] * rs, up = acc[ai][1][m][n] * rs; f32x4 v;
#pragma unroll
                    for (int j = 0; j < 4; ++j) v[j] = siluf(gt[j]) * up[j];
                    const u32x2 p = pack4(v); if (n == 0) { w.x = p.x; w.y = p.y; } else { w.z = p.x; w.w = p.y; }
                }
                *(u32x4*)(O + (size_t)(u.pm * 256 + lr) * DFF + col0) = w;
            }
    }
};
template <bool BB, bool OF>
struct EpiResid {
    static constexpr bool AFTER_DRAIN = true;
    const void* base; float* out; bf16_t* xb; float* ssq; float scale; int skip;
    __device__ __forceinline__ f32x4 ldb(size_t off) const {
        if (BB) { const u32x2 w = __builtin_nontemporal_load((const u32x2*)((const bf16_t*)base + off));
                  return (f32x4){__uint_as_float(w.x << 16), __uint_as_float(w.x & 0xffff0000u), __uint_as_float(w.y << 16), __uint_as_float(w.y & 0xffff0000u)}; }
        return __builtin_nontemporal_load((const f32x4*)((const float*)base + off));
    }
    __device__ __forceinline__ void operator()(ACC_ARG, const pg8::Unit& u, int wr, int wc, int fr, int fq) const {
        if (skip) return;
        const int row0 = u.pm * 256 + wr * 64 + fr, col0 = u.pn * 256 + wc * 32 + 4 * fq;
#pragma unroll
        for (int ai = 0; ai < 2; ++ai)
#pragma unroll
            for (int m = 0; m < 4; ++m) {
                const int row = row0 + ai * 128 + m * 16; float ss = 0.f;
#pragma unroll
                for (int bj = 0; bj < 2; ++bj)
#pragma unroll
                    for (int n = 0; n < 2; ++n) {
                        const size_t off = (size_t)row * DM + col0 + bj * 128 + n * 16;
                        const f32x4 v = ldb(off) + acc[ai][bj][m][n] * scale;
                        if (OF) *(f32x4*)(out + off) = v; else *(u32x2*)(xb + off) = pack4(v);
                        ss += (v[0] * v[0] + v[1] * v[1]) + (v[2] * v[2] + v[3] * v[3]);
                    }
                if (!OF) { ss += __shfl_xor(ss, 16); ss += __shfl_xor(ss, 32); if (fq == 0) atomicAdd(ssq + (size_t)row * 4 + u.pn, ss); }
            }
    }
    __device__ __forceinline__ void fused(ACC_ARG, const pg8::Unit& u, int wr, int wc, int fr, int fq, LAS unsigned char* lds) const {
        if (skip) return;
        const int tid = opaque_tid(), lane = tid & 63, wave = __builtin_amdgcn_readfirstlane(tid >> 6);
        LAS float* tl = (LAS float*)lds;
#pragma unroll
        for (int ai = 0; ai < 2; ++ai)
#pragma unroll
            for (int wq = 0; wq < 2; ++wq) {
                if (wr == wq) {
#pragma unroll
                    for (int m = 0; m < 4; ++m)
#pragma unroll
                        for (int bj = 0; bj < 2; ++bj)
#pragma unroll
                            for (int n = 0; n < 2; ++n) *(LAS f32x4*)(tl + (16 * m + fr) * 260 + bj * 128 + wc * 32 + n * 16 + 4 * fq) = acc[ai][bj][m][n] * scale;
                }
                __syncthreads();
                const int rbase = u.pm * 256 + ai * 128 + wq * 64;
                f32x4 bv[8];
#pragma unroll
                for (int r = 0; r < 8; ++r) bv[r] = ldb((size_t)(rbase + wave * 8 + r) * DM + u.pn * 256 + lane * 4);
#pragma unroll
                for (int r = 0; r < 8; ++r) {
                    const int row = rbase + wave * 8 + r; const size_t off = (size_t)row * DM + u.pn * 256 + lane * 4;
                    const f32x4 v = bv[r] + *(const LAS f32x4*)(tl + (wave * 8 + r) * 260 + lane * 4);
                    if (OF) __builtin_nontemporal_store(v, (f32x4*)(out + off));
                    else {
                        *(u32x2*)(xb + off) = pack4(v);
                        const float ss = wave_sum((v[0] * v[0] + v[1] * v[1]) + (v[2] * v[2] + v[3] * v[3])); if (lane == 0) ssq[(size_t)row * 4 + u.pn] = ss;
                    }
                }
                __syncthreads();
            }
    }
};
struct EpiPlain {
    static constexpr bool AFTER_DRAIN = false;
    bf16_t* O; int ldo;
    __device__ __forceinline__ void operator()(ACC_ARG, const pg8::Unit& u, int wr, int wc, int fr, int fq) const {
        const int row0 = u.pm * 256 + wr * 64 + fr, col0 = u.pn * 256 + wc * 32 + 4 * fq;
#pragma unroll
        for (int ai = 0; ai < 2; ++ai)
#pragma unroll
            for (int m = 0; m < 4; ++m)
#pragma unroll
                for (int bj = 0; bj < 2; ++bj)
#pragma unroll
                    for (int n = 0; n < 2; ++n) *(u32x2*)(O + (size_t)(row0 + ai * 128 + m * 16) * ldo + col0 + bj * 128 + n * 16) = pack4(acc[ai][bj][m][n]);
    }
};
struct EpiMix {
    static constexpr bool AFTER_DRAIN = true;
    const LAS float* rtab; const float* rot;
    unsigned char* ws  ; bf16_t* mqb  ; const float *gdq, *gdk;
    static constexpr int TLD = 136;
    __device__ __forceinline__ void flushT(bf16_t* dst  , const LAS bf16_t* TS) const {
        const int tid = opaque_tid();
#pragma unroll
        for (int i = 0; i < 8; ++i) { const int p = tid + 512 * i, c = p >> 4, r8 = p & 15; *(u32x4*)(dst + (size_t)c * SEQ + r8 * 8) = *(const LAS u32x4*)(TS + c * TLD + r8 * 8); }
    }
    __device__ __forceinline__ void operator()(ACC_ARG, const pg8::Unit& u, int wr, int wc, int fr, int fq) const { body(acc, u, wr, wc, fr, fq, nullptr); }
    __device__ __forceinline__ void fused(ACC_ARG, const pg8::Unit& u, int wr, int wc, int fr, int fq, LAS unsigned char* lds) const {
        if (u.pn >= 4 && u.pn < 16) body(acc, u, wr, wc, fr, fq, (LAS bf16_t*)lds); else body(acc, u, wr, wc, fr, fq, nullptr);
    }
    __device__ __forceinline__ void body(ACC_ARG, const pg8::Unit& u, int wr, int wc, int fr, int fq, LAS bf16_t* TS) const {
        const int pn = u.pn, lr0 = wr * 64 + fr, lrow0 = u.pm * 256 + lr0;
        if (pn < 8) {
            const bool isk = pn >= 4; const int h = pn & 3; bf16_t* dst = (bf16_t*)(ws + (isk ? WS_K : WS_Q)); bf16_t* kts = (bf16_t*)(ws + WS_KTS);
            const float lg2 = log2f(1.0f - __builtin_amdgcn_exp2f(-5.0f - (float)h));
#pragma unroll
            for (int ai = 0; ai < 2; ++ai) {
                f32x4 cs0[4][2], cs1[4][2];
#pragma unroll
                for (int m = 0; m < 4; ++m)
#pragma unroll
                    for (int n = 0; n < 2; ++n) { const f32x4* cs = (const f32x4*)(rot + ((size_t)(lrow0 + ai * 128 + m * 16) * 128 + wc * 32 + 8 * fq + 4 * n) * 2); cs0[m][n] = cs[0]; cs1[m][n] = cs[1]; }
                EPI_FENCE();
#pragma unroll
                for (int m = 0; m < 4; ++m) {
                    int lrow = lrow0 + ai * 128 + m * 16; asm volatile("" : "+v"(lrow));
                    const float rs = rtab[u.ri * 256 + lr0 + ai * 128 + m * 16] * (isk ? 0.0625f : 1.0f);
                    const float dec = __builtin_amdgcn_exp2f(lg2 * (float)(127 - (lrow & 127)));
#pragma unroll
                    for (int n = 0; n < 2; ++n) {
                        const int i0 = wc * 32 + 8 * fq + 4 * n;
                        const f32x4 c01 = cs0[m][n], c23 = cs1[m][n];
                        const f32x4 cv = (f32x4){c01[0], c01[2], c23[0], c23[2]}, sv = (f32x4){c01[1], c01[3], c23[1], c23[3]};
                        const f32x4 x1 = acc[ai][0][m][n] * rs, x2 = acc[ai][1][m][n] * rs;
                        const f32x4 o1 = x1 * cv - x2 * sv, o2 = x1 * sv + x2 * cv;
                        *(u32x2*)(dst + (size_t)lrow * 1024 + h * 256 + i0) = pack4(o1);
                        *(u32x2*)(dst + (size_t)lrow * 1024 + h * 256 + 128 + i0) = pack4(o2);
                        if (isk) {
                            if (TS) {
                                const int rl = wr * 64 + m * 16 + fr;
#pragma unroll
                                for (int j = 0; j < 4; ++j) { TS[(i0 + j) * TLD + rl] = bf16_1(o1[j] * dec); TS[(128 + i0 + j) * TLD + rl] = bf16_1(o2[j] * dec); }
                            } else {
#pragma unroll
                                for (int j = 0; j < 4; ++j) {
                                    kts[(size_t)(h * 256 + i0 + j) * SEQ + lrow] = bf16_1(o1[j] * dec);
                                    kts[(size_t)(h * 256 + 128 + i0 + j) * SEQ + lrow] = bf16_1(o2[j] * dec);
                                }
                            }
                        }
                    }
                }
                EPI_FENCE();
                if (isk && TS) { __syncthreads(); flushT(kts + (size_t)(h * 256) * SEQ + u.pm * 256 + ai * 128, TS); __syncthreads(); }
            }
        } else if (pn < 16) {
            const int h = (pn - 8) >> 1, e0 = ((pn - 8) & 1) * 256; bf16_t* vt = (bf16_t*)(ws + WS_VT);
#pragma unroll
            for (int ai = 0; ai < 2; ++ai) {
#pragma unroll
                for (int m = 0; m < 4; ++m) {
                    int lrow = lrow0 + ai * 128 + m * 16; asm volatile("" : "+v"(lrow));
                    const float rs = rtab[u.ri * 256 + lr0 + ai * 128 + m * 16];
#pragma unroll
                    for (int bj = 0; bj < 2; ++bj)
#pragma unroll
                        for (int n = 0; n < 2; ++n) {
                            const int tc = bj * 128 + wc * 32 + 8 * fq + 4 * n, ec = e0 + tc; const f32x4 v = acc[ai][bj][m][n] * rs;
                            if (TS) {
                                const int rl = wr * 64 + m * 16 + fr;
#pragma unroll
                                for (int j = 0; j < 4; ++j) TS[(tc + j) * TLD + rl] = bf16_1(v[j]);
                            } else {
#pragma unroll
                                for (int j = 0; j < 4; ++j) vt[(size_t)(h * 512 + ec + j) * SEQ + lrow] = bf16_1(v[j]);
                            }
                        }
                    EPI_FENCE();
                }
                if (TS) { __syncthreads(); flushT(vt + (size_t)(h * 512 + e0) * SEQ + u.pm * 256 + ai * 128, TS); __syncthreads(); }
            }
        } else if (pn < 24) {
            const bool isk = pn >= 20; const int tile = (pn - 16) & 3; bf16_t* dst = (bf16_t*)(ws + (isk ? WS_DK : WS_DQ)); const float* gn = isk ? gdk : gdq; const float mul = isk ? 1.0f : C2Q;
            f32x4 gv[2][2];
#pragma unroll
            for (int bj = 0; bj < 2; ++bj)
#pragma unroll
                for (int n = 0; n < 2; ++n) gv[bj][n] = *(const f32x4*)(gn + 32 * bj + 8 * fq + 4 * n);
#pragma unroll
            for (int ai = 0; ai < 2; ++ai)
#pragma unroll
                for (int m = 0; m < 4; ++m) {
                    int lrow = lrow0 + ai * 128 + m * 16; asm volatile("" : "+v"(lrow));
                    const float rs = rtab[u.ri * 256 + lr0 + ai * 128 + m * 16];
                    f32x4 v[2][2]; float ss = 0.f;
#pragma unroll
                    for (int bj = 0; bj < 2; ++bj)
#pragma unroll
                        for (int n = 0; n < 2; ++n) { v[bj][n] = acc[ai][bj][m][n] * rs; const f32x4 t = v[bj][n]; ss += (t[0] * t[0] + t[1] * t[1]) + (t[2] * t[2] + t[3] * t[3]); }
                    ss += __shfl_xor(ss, 16); ss += __shfl_xor(ss, 32);
                    const float rn = __builtin_amdgcn_rsqf(ss * (1.0f / 64.0f) + EPS) * mul;
#pragma unroll
                    for (int bj = 0; bj < 2; ++bj) { const u32x2 p0 = pack4(v[bj][0] * rn * gv[bj][0]), p1 = pack4(v[bj][1] * rn * gv[bj][1]);
                        *(u32x4*)(dst + (size_t)lrow * 1024 + tile * 256 + 64 * wc + 32 * bj + 8 * fq) = (u32x4){p0.x, p0.y, p1.x, p1.y}; }
                    EPI_FENCE();
                }
        } else {
            bf16_t* dst = pn < 28 ? (bf16_t*)(ws + WS_DV) : mqb; const int tile = (pn - 24) & 3;
#pragma unroll
            for (int ai = 0; ai < 2; ++ai)
#pragma unroll
                for (int m = 0; m < 4; ++m) {
                    int lrow = lrow0 + ai * 128 + m * 16; asm volatile("" : "+v"(lrow));
                    const float rs = rtab[u.ri * 256 + lr0 + ai * 128 + m * 16];
#pragma unroll
                    for (int bj = 0; bj < 2; ++bj) { const u32x2 p0 = pack4(acc[ai][bj][m][0] * rs), p1 = pack4(acc[ai][bj][m][1] * rs);
                        *(u32x4*)(dst + (size_t)lrow * 1024 + tile * 256 + bj * 128 + wc * 32 + 8 * fq) = (u32x4){p0.x, p0.y, p1.x, p1.y}; }
                    EPI_FENCE();
                }
        }
    }
};
struct EpiRgG {
    static constexpr bool AFTER_DRAIN = false;
    const LAS float* rtab; bf16_t* ret; const float* rssq; unsigned char* ws;
    __device__ __forceinline__ void operator()(ACC_ARG, const pg8::Unit& u, int wr, int wc, int fr, int fq) const {
        const int lr0 = wr * 64 + fr;
        if (u.pn < 8) {
            const int col0 = u.pn * 256 + wc * 32 + 8 * fq;
#pragma unroll
            for (int ai = 0; ai < 2; ++ai) {
                u32x4 rv[4][2]; f32x2 rq2[4];
#pragma unroll
                for (int m = 0; m < 4; ++m) { const int lr = lr0 + ai * 128 + m * 16;
                    rq2[m] = *(const f32x2*)(rssq + (size_t)(u.pm * 256 + lr) * 8 + 2 * (u.pn >> 1));
#pragma unroll
                    for (int bj = 0; bj < 2; ++bj) rv[m][bj] = *(const u32x4*)(ret + (size_t)(u.pm * 256 + lr) * 2048 + col0 + bj * 128); }
                EPI_FENCE();
#pragma unroll
                for (int m = 0; m < 4; ++m) {
                    const int lr = lr0 + ai * 128 + m * 16; const float rs = rtab[u.ri * 256 + lr];
                    const float rr = __builtin_amdgcn_rsqf((rq2[m][0] + rq2[m][1]) * (1.0f / 512.0f) + EPS);
#pragma unroll
                    for (int bj = 0; bj < 2; ++bj) {
                        u32x4 o;
#pragma unroll
                        for (int n = 0; n < 2; ++n) {
                            const unsigned w0 = n == 0 ? rv[m][bj].x : rv[m][bj].z, w1 = n == 0 ? rv[m][bj].y : rv[m][bj].w; const f32x4 a = acc[ai][bj][m][n] * rs; f32x4 v;
                            v[0] = __uint_as_float(w0 << 16) * siluf(a[0]); v[1] = __uint_as_float(w0 & 0xffff0000u) * siluf(a[1]);
                            v[2] = __uint_as_float(w1 << 16) * siluf(a[2]); v[3] = __uint_as_float(w1 & 0xffff0000u) * siluf(a[3]);
                            const u32x2 p = pack4(v * rr); if (n == 0) { o.x = p.x; o.y = p.y; } else { o.z = p.x; o.w = p.y; }
                        }
                        *(u32x4*)(ret + (size_t)(u.pm * 256 + lr) * 2048 + col0 + bj * 128) = o;
                    }
                }
                EPI_FENCE();
            }
        } else {
            const int br = (u.pn - 8) >> 2, col0 = ((u.pn - 8) & 3) * 256 + wc * 32 + 8 * fq;
            unsigned char* g8 = ws + (br == 0 ? WS_G8A : br == 1 ? WS_G8B : WS_G8C);
#pragma unroll
            for (int ai = 0; ai < 2; ++ai)
#pragma unroll
                for (int m = 0; m < 4; ++m) {
                    const int lr = lr0 + ai * 128 + m * 16; const float rs = rtab[u.ri * 256 + lr];
#pragma unroll
                    for (int bj = 0; bj < 2; ++bj) {
                        u32x2 w2;
#pragma unroll
                        for (int n = 0; n < 2; ++n) {
                            const f32x4 a = acc[ai][bj][m][n] * rs; unsigned w = 0u;
#pragma unroll
                            for (int j = 0; j < 4; ++j) w |= (unsigned)__builtin_rintf(255.0f * sigmf(a[j])) << (8 * j);
                            if (n == 0) w2.x = w; else w2.y = w;
                        }
                        *(u32x2*)(g8 + (size_t)(u.pm * 256 + lr) * DM + col0 + bj * 128) = w2;
                    }
                }
        }
    }
};
struct EpiTerm3 {
    static constexpr bool AFTER_DRAIN = false;
    unsigned char* ws; bf16_t* y;
    __device__ __forceinline__ void operator()(ACC_ARG, const pg8::Unit& u, int wr, int wc, int fr, int fq) const {
        const int lr0 = wr * 64 + fr, col0 = u.pn * 256 + wc * 32 + 8 * fq, first = (u.tag == 0);
        const unsigned char* g8 = ws + (u.tag == 0 ? WS_G8A : u.tag == 1 ? WS_G8B : WS_G8C);
#pragma unroll
        for (int ai = 0; ai < 2; ++ai) {
            u32x2 gv[4][2]; u32x4 yv[4][2];
#pragma unroll
            for (int m = 0; m < 4; ++m)
#pragma unroll
                for (int bj = 0; bj < 2; ++bj) { const size_t off = (size_t)(u.pm * 256 + lr0 + ai * 128 + m * 16) * DM + col0 + bj * 128;
                    gv[m][bj] = *(const u32x2*)(g8 + off); yv[m][bj] = first ? (u32x4){0u, 0u, 0u, 0u} : *(const u32x4*)(y + off); }
            EPI_FENCE();
#pragma unroll
            for (int m = 0; m < 4; ++m)
#pragma unroll
                for (int bj = 0; bj < 2; ++bj) {
                    const size_t off = (size_t)(u.pm * 256 + lr0 + ai * 128 + m * 16) * DM + col0 + bj * 128;
                    u32x4 o;
#pragma unroll
                    for (int n = 0; n < 2; ++n) {
                        const f32x4 a = acc[ai][bj][m][n]; const unsigned gw = n == 0 ? gv[m][bj].x : gv[m][bj].y; const unsigned w0 = n == 0 ? yv[m][bj].x : yv[m][bj].z, w1 = n == 0 ? yv[m][bj].y : yv[m][bj].w; f32x4 v;
                        v[0] = (float)(gw & 255u) * (1.0f / 255.0f) * a[0] + __uint_as_float(w0 << 16); v[1] = (float)((gw >> 8) & 255u) * (1.0f / 255.0f) * a[1] + __uint_as_float(w0 & 0xffff0000u);
                        v[2] = (float)((gw >> 16) & 255u) * (1.0f / 255.0f) * a[2] + __uint_as_float(w1 << 16); v[3] = (float)(gw >> 24) * (1.0f / 255.0f) * a[3] + __uint_as_float(w1 & 0xffff0000u);
                        const u32x2 p = pack4(v); if (n == 0) { o.x = p.x; o.y = p.y; } else { o.z = p.x; o.w = p.y; }
                    }
                    *(u32x4*)(y + off) = o;
                }
            EPI_FENCE();
        }
    }
};

#include <hip/hip_bf16.h>
namespace attn_body {
using bf16=__hip_bfloat16;
using bf16x8=__attribute__((ext_vector_type(8)))short;
using s16x4=__attribute__((ext_vector_type(4)))short;
using f32x16=__attribute__((ext_vector_type(16)))float;
using u32x4=__attribute__((ext_vector_type(4)))unsigned;
constexpr int D=64,DM=1024;
constexpr int NW=8,QBLK=32,QB=QBLK*NW,KVBLK=64;
__device__ __forceinline__ int crow(int r,int hi){return (r&3)+8*(r>>2)+4*hi;}
#define SBAR() __builtin_amdgcn_sched_barrier(0)
__device__ __forceinline__ void cmask(f32x16&p0,f32x16&p1,int jb,int qrel,int hi){
  const float NEG=-INFINITY; int kb=64*jb+4*hi;
  #pragma unroll
  for(int r=0;r<16;++r){int kv=kb+(r&3)+8*(r>>2); if(kv>qrel)p0[r]=NEG; if(kv+32>qrel)p1[r]=NEG;}
}
constexpr int NSLOT=3, SLOTB=8192;
constexpr int LDS_K=0, LDS_V=NSLOT*SLOTB, LDS_WS=2*NSLOT*SLOTB, LDS_OST=LDS_WS+NW*64*4, LDS_BYTES=LDS_OST+NW*4096;
__device__ __forceinline__ void glds16(const void*gsrc,unsigned lds_dst){unsigned keep;
  asm volatile("s_mov_b32 %0, m0\n\ts_mov_b32 m0, %2\n\ts_nop 0\n\tglobal_load_lds_dwordx4 %1, off\n\ts_mov_b32 m0, %0":"=&s"(keep):"v"(gsrc),"s"(lds_dst):"memory");}
__device__ __forceinline__ float max3f(float a,float b,float c){float r;asm("v_max3_f32 %0, %1, %2, %3":"=v"(r):"v"(a),"v"(b),"v"(c));return r;}
__device__ __forceinline__ float max2f(float a,float b){float r;asm("v_max_f32_e32 %0, %1, %2":"=v"(r):"v"(a),"v"(b));return r;}
__device__ __forceinline__ float fadd_s(float a,float b){float r;asm("v_add_f32_e32 %0, %1, %2":"=v"(r):"v"(a),"v"(b));return r;}
__device__ __forceinline__ float fsub_s(float a,float b){float r;asm("v_sub_f32_e32 %0, %1, %2":"=v"(r):"v"(a),"v"(b));return r;}
typedef float f32x2_t __attribute__((ext_vector_type(2))); typedef __bf16 bf16x2_t __attribute__((ext_vector_type(2)));
__device__ __forceinline__ unsigned cvtpk_s(float lo,float hi){f32x2_t v={lo,hi};bf16x2_t b=__builtin_convertvector(v,bf16x2_t);return __builtin_bit_cast(unsigned,b);}
#define WAIT_BAR(N) asm volatile("s_waitcnt vmcnt(" #N ") lgkmcnt(0)\n\ts_barrier":::"memory")
__device__ __forceinline__ void qkt(f32x16&p0,f32x16&p1,const char*Kslot,const bf16x8*qr,const f32x16&negm,int r32,int hi){
  const char*kb=Kslot+hi*1024+r32*16;
  #pragma unroll
  for(int d0=0;d0<4;++d0){
    const bf16x8 b0=*reinterpret_cast<const bf16x8*>(kb+d0*2048);
    const bf16x8 b1=*reinterpret_cast<const bf16x8*>(kb+d0*2048+512);
    if(d0==0){p0=__builtin_amdgcn_mfma_f32_32x32x16_bf16(b0,qr[0],negm,0,0,0);p1=__builtin_amdgcn_mfma_f32_32x32x16_bf16(b1,qr[0],negm,0,0,0);}
    else{p0=__builtin_amdgcn_mfma_f32_32x32x16_bf16(b0,qr[d0],p0,0,0,0);p1=__builtin_amdgcn_mfma_f32_32x32x16_bf16(b1,qr[d0],p1,0,0,0);}}
}
typedef __attribute__((address_space(3))) const char* lds_cptr;
typedef short v4i16_t __attribute__((ext_vector_type(4)));
__device__ __forceinline__ void kload8(bf16x8*kf,lds_cptr kp){
  kf[0]=*(const __attribute__((address_space(3))) bf16x8*)(kp);      kf[1]=*(const __attribute__((address_space(3))) bf16x8*)(kp+512);
  kf[2]=*(const __attribute__((address_space(3))) bf16x8*)(kp+2048); kf[3]=*(const __attribute__((address_space(3))) bf16x8*)(kp+2560);
  kf[4]=*(const __attribute__((address_space(3))) bf16x8*)(kp+4096); kf[5]=*(const __attribute__((address_space(3))) bf16x8*)(kp+4608);
  kf[6]=*(const __attribute__((address_space(3))) bf16x8*)(kp+6144); kf[7]=*(const __attribute__((address_space(3))) bf16x8*)(kp+6656);
}
__device__ __forceinline__ void kload2(bf16x8*kf,lds_cptr kp,int j){ kf[2*j]=*(const __attribute__((address_space(3))) bf16x8*)(kp+j*2048); kf[2*j+1]=*(const __attribute__((address_space(3))) bf16x8*)(kp+j*2048+512); }
__device__ __forceinline__ s16x4 vtr(lds_cptr p){ return __builtin_bit_cast(s16x4,__builtin_amdgcn_ds_read_tr16_b64_v4i16((__attribute__((address_space(3))) v4i16_t*)p)); }
__device__ __forceinline__ float rowmax(const f32x16&p0,const f32x16&p1){
  float a=max3f(p0[0],p0[1],p1[0]),b=max3f(p0[2],p0[3],p1[1]);a=max3f(a,p1[2],p1[3]);
  #pragma unroll
  for(int r=4;r<16;r+=4){a=max3f(a,p0[r],p0[r+1]);b=max3f(b,p0[r+2],p0[r+3]);a=max3f(a,p1[r],p1[r+1]);b=max3f(b,p1[r+2],p1[r+3]);}
  const float m=max2f(a,b);
  auto rr=__builtin_amdgcn_permlane32_swap(__float_as_uint(m),__float_as_uint(m),false,false);
  return max2f(__uint_as_float(rr[0]),__uint_as_float(rr[1]));
}
__device__ __forceinline__ void pv(f32x16*o,int vb,bf16x8 pa0,bf16x8 pa1,bf16x8 pa2,bf16x8 pa3){
  #pragma unroll
  for(int d0=0;d0<2;++d0){s16x4 lo[4],hi[4];
    #pragma unroll
    for(int ks=0;ks<4;++ks){
      asm volatile("ds_read_b64_tr_b16 %0,%1 offset:%c2":"=&v"(lo[ks]):"v"(vb),"i"(d0*4096+ks*1024):"memory");
      asm volatile("ds_read_b64_tr_b16 %0,%1 offset:%c2":"=&v"(hi[ks]):"v"(vb),"i"(d0*4096+ks*1024+512):"memory");}
    asm volatile("s_waitcnt lgkmcnt(0)":::"memory");SBAR();
    #define PK(k) (bf16x8){lo[k][0],lo[k][1],lo[k][2],lo[k][3],hi[k][0],hi[k][1],hi[k][2],hi[k][3]}
    o[d0]=__builtin_amdgcn_mfma_f32_32x32x16_bf16(pa0,PK(0),o[d0],0,0,0);
    o[d0]=__builtin_amdgcn_mfma_f32_32x32x16_bf16(pa1,PK(1),o[d0],0,0,0);
    o[d0]=__builtin_amdgcn_mfma_f32_32x32x16_bf16(pa2,PK(2),o[d0],0,0,0);
    o[d0]=__builtin_amdgcn_mfma_f32_32x32x16_bf16(pa3,PK(3),o[d0],0,0,0);
    #undef PK
  }
}
#define ATTN_STORE16(p,v) (*(u32x4*)(p)=(v))
template<int THRL> __device__ __forceinline__ void attn_unit(int hq,int hv,int qb,const bf16*Q,const bf16*__restrict__ K,const bf16*__restrict__ V,bf16*O,char*shm){
  const int tid=opaque_tid(),lane=tid&63,r32=lane&31,hi=lane>>5; const int wid=__builtin_amdgcn_readfirstlane(tid>>6);
  const int q0=qb*QB;
  const bf16*Qw=Q+(long)(q0+wid*QBLK)*DM+hq*D;
  const bf16*Kh=K+hq*D,*Vh=V+hv*D;
  const unsigned lds0=(unsigned)(uintptr_t)shm;
  float*wsf=(float*)(shm+LDS_WS)+wid*64;
  const bf16*ksrc=Kh+(long)lane*DM+wid*8;
  const bf16*vsrc=Vh+(long)(16*(wid&3)+(lane>>2))*DM+(wid>>2)*32+(lane&3)*8;
  const unsigned kdst=lds0+LDS_K+wid*1024, vdst=lds0+LDS_V+wid*1024;
  #define DMA_K(t,slot) glds16(ksrc+(long)(t)*KVBLK*DM,(unsigned)__builtin_amdgcn_readfirstlane(kdst+(slot)))
  #define DMA_V(t,slot) glds16(vsrc+(long)(t)*KVBLK*DM,(unsigned)__builtin_amdgcn_readfirstlane(vdst+(slot)))
  const int vb0=(int)(lds0+LDS_V)+((lane>>4)&1)*32+(lane&3)*8+(4*hi+((lane&15)>>2))*64;
  const char*Kbase=shm+LDS_K; bf16x8 kf[8];
  const lds_cptr shm3=(lds_cptr)shm; const lds_cptr kp0=shm3+LDS_K+hi*1024+r32*16; const lds_cptr vp0=shm3+LDS_V+((lane>>4)&1)*32+(lane&3)*8+(4*hi+((lane&15)>>2))*64;
  const int NT=(q0+QB)/KVBLK;
  DMA_K(0,0);DMA_V(0,0);DMA_K(1,SLOTB);
  bf16x8 qr[4];
  #pragma unroll
  for(int d0=0;d0<4;++d0)qr[d0]=*reinterpret_cast<const bf16x8*>(&Qw[(long)r32*DM+d0*16+hi*8]);
  float mhat=0.f,l_reg=0.f;f32x16 o[2];o[0]=f32x16{};o[1]=f32x16{};f32x16 negm=f32x16{};asm volatile("":"+v"(negm));
  const int qrel=wid*QBLK+r32;
  #define CMASK(P0,P1,t) do{int jb_=(t)-(NT-4); if(jb_>=0)cmask(P0,P1,jb_,qrel,hi);}while(0)
  bool resc=false;
  #define START(P0,P1) do{ const float rm=rowmax(P0,P1); resc=false; \
    { const float dl=rm; mhat=fadd_s(mhat,dl); \
      _Pragma("unroll") for(int r=0;r<16;++r){P0[r]=fsub_s(P0[r],dl);P1[r]=fsub_s(P1[r],dl);} \
      _Pragma("unroll") for(int r=0;r<16;++r)negm[r]=-mhat; asm volatile("":"+v"(negm)); } \
    _Pragma("unroll") for(int r=0;r<16;++r)P0[r]=__builtin_amdgcn_exp2f(P0[r]); }while(0)
  #define RESC() do{ if(resc){ asm volatile("s_waitcnt lgkmcnt(0)":::"memory"); \
      _Pragma("unroll") for(int d_=0;d_<2;++d_) _Pragma("unroll") for(int r=0;r<16;++r)o[d_][r]*=wsf[crow(r,hi)]; } }while(0)
  f32x16 pA0,pA1,pB0,pB1;
  int sl_prev=0,sl_cur=0,sl_next=SLOTB;
  #define ROT() do{sl_prev=sl_cur;sl_cur=sl_next;sl_next=(sl_next==(NSLOT-1)*SLOTB)?0:sl_next+SLOTB;}while(0)
  DMA_K(2,2*SLOTB);
  WAIT_BAR(3);
  qkt(pA0,pA1,Kbase,qr,negm,r32,hi);asm volatile("s_nop 15\n\ts_nop 7":"+v"(pA0),"+v"(pA1));CMASK(pA0,pA1,0);
  START(pA0,pA1);
  _Pragma("unroll") for(int r=0;r<16;++r)pA1[r]=__builtin_amdgcn_exp2f(pA1[r]);
  WAIT_BAR(0);
  DMA_K(3,0);DMA_V(1,SLOTB);
  ROT();
  kload8(kf,kp0+sl_cur);
  WAIT_BAR(2);
  s16x4 vlo[8],vhi[8]; u32x4 pw0,pw1,pw2,pw3;
  #define PKW(P,B) cvtpk_s(P[B],P[B+1])
  #define PAF(k) __builtin_bit_cast(bf16x8,pw##k)
  #define VFR(i) (bf16x8){vlo[i][0],vlo[i][1],vlo[i][2],vlo[i][3],vhi[i][0],vhi[i][1],vhi[i][2],vhi[i][3]}
  #define PIN(x) asm volatile("":"+v"(x))
  #define MX3(a,b,c) __builtin_fmaxf(__builtin_fmaxf((a),(b)),(c))
  #define GAPA(MF,A0,A1,A2,A3,W0,W1,PW) do{ MF; sacc+=A0; sacc+=A1; sacc+=A2; sacc+=A3; PIN(sacc); W0; W1; PIN(PW); SBAR(); }while(0)
  #define EX(v) __builtin_amdgcn_exp2f(v)
  #define GAPB(MF,X,B) do{ MF; X[B]=EX(X[B]); X[B+1]=EX(X[B+1]); X[B+2]=EX(X[B+2]); X[B+3]=EX(X[B+3]); PIN(X); SBAR(); }while(0)
  #define VRD(i) do{ vlo[i]=vtr(vp_+(((i)>>2)*4096+((i)&3)*1024)); vhi[i]=vtr(vp_+(((i)>>2)*4096+((i)&3)*1024+512)); }while(0)
  #define KRD(G,j) do{ if(G){ kload2(kf,kp0+sl_next,j); SBAR(); } }while(0)
  #define STEP(C0,C1,P0,P1,t,GK,GV,GL) do{ SBAR(); \
    const lds_cptr vp_=vp0+sl_prev; \
    VRD(0); SBAR(); float sacc=(P0[0]+P0[1]); \
    GAPA(C0=__builtin_amdgcn_mfma_f32_32x32x16_bf16(kf[0],qr[0],negm,0,0,0), P0[2],P0[3],P0[4],P0[5],     pw0[0]=PKW(P0,0), pw0[1]=PKW(P0,2), pw0); \
    VRD(4); SBAR(); GAPA(C1=__builtin_amdgcn_mfma_f32_32x32x16_bf16(kf[1],qr[0],negm,0,0,0), P0[6],P0[7],P0[8],P0[9],     pw0[2]=PKW(P0,4), pw0[3]=PKW(P0,6), pw0); \
    VRD(1); SBAR(); GAPA(C0=__builtin_amdgcn_mfma_f32_32x32x16_bf16(kf[2],qr[1],C0,0,0,0),   P0[10],P0[11],P0[12],P0[13], pw1[0]=PKW(P0,8), pw1[1]=PKW(P0,10), pw1); \
    VRD(5); SBAR(); GAPA(C1=__builtin_amdgcn_mfma_f32_32x32x16_bf16(kf[3],qr[1],C1,0,0,0),   P0[14],P0[15],P1[0],P1[1],   pw1[2]=PKW(P0,12),pw1[3]=PKW(P0,14), pw1); \
    VRD(2); SBAR(); GAPA(C0=__builtin_amdgcn_mfma_f32_32x32x16_bf16(kf[4],qr[2],C0,0,0,0),   P1[2],P1[3],P1[4],P1[5],     pw2[0]=PKW(P1,0), pw2[1]=PKW(P1,2), pw2); \
    VRD(6); SBAR(); GAPA(C1=__builtin_amdgcn_mfma_f32_32x32x16_bf16(kf[5],qr[2],C1,0,0,0),   P1[6],P1[7],P1[8],P1[9],     pw2[2]=PKW(P1,4), pw2[3]=PKW(P1,6), pw2); \
    VRD(3); SBAR(); GAPA(C0=__builtin_amdgcn_mfma_f32_32x32x16_bf16(kf[6],qr[3],C0,0,0,0),   P1[10],P1[11],P1[12],P1[13], pw3[0]=PKW(P1,8), pw3[1]=PKW(P1,10), pw3); \
    VRD(7); SBAR(); GAPA(C1=__builtin_amdgcn_mfma_f32_32x32x16_bf16(kf[7],qr[3],C1,0,0,0),   P1[14],P1[15],0.f,0.f,       pw3[2]=PKW(P1,12),pw3[3]=PKW(P1,14), pw3); \
    l_reg+=sacc; \
    if(GK){DMA_K((t)+3,sl_cur);} if(GV){DMA_V((t)+1,sl_next);} \
    CMASK(C0,C1,t); \
    { float a=MX3(C0[0],C0[1],C1[0]),b=MX3(C0[2],C0[3],C1[1]); a=MX3(a,C1[2],C1[3]); \
      _Pragma("unroll") for(int r=4;r<16;r+=4){a=MX3(a,C0[r],C0[r+1]);b=MX3(b,C0[r+2],C0[r+3]);a=MX3(a,C1[r],C1[r+1]);b=MX3(b,C1[r+2],C1[r+3]);} \
      float rm=__builtin_fmaxf(a,b); { auto rr=__builtin_amdgcn_permlane32_swap(__float_as_uint(rm),__float_as_uint(rm),false,false); rm=__builtin_fmaxf(__uint_as_float(rr[0]),__uint_as_float(rr[1])); } \
      resc=false; \
      if(__builtin_expect(__any(rm>(float)THRL),0)){ const float dl=__builtin_fmaxf(rm,0.f); mhat+=dl; \
        _Pragma("unroll") for(int r=0;r<16;++r){C0[r]-=dl;C1[r]-=dl;} \
        _Pragma("unroll") for(int r=0;r<16;++r)negm[r]=-mhat; asm volatile("":"+v"(negm)); \
        const float f=__builtin_amdgcn_exp2f(-dl); l_reg*=f; if(hi==0)wsf[r32]=f; resc=true; } } \
    SBAR(); \
    GAPB(o[0]=__builtin_amdgcn_mfma_f32_32x32x16_bf16(PAF(0),VFR(0),o[0],0,0,0), C0,0); \
    GAPB(o[1]=__builtin_amdgcn_mfma_f32_32x32x16_bf16(PAF(0),VFR(4),o[1],0,0,0), C0,4); \
    KRD(GL,0); GAPB(o[0]=__builtin_amdgcn_mfma_f32_32x32x16_bf16(PAF(1),VFR(1),o[0],0,0,0), C0,8); \
    KRD(GL,1); GAPB(o[1]=__builtin_amdgcn_mfma_f32_32x32x16_bf16(PAF(1),VFR(5),o[1],0,0,0), C0,12); \
    KRD(GL,2); GAPB(o[0]=__builtin_amdgcn_mfma_f32_32x32x16_bf16(PAF(2),VFR(2),o[0],0,0,0), C1,0); \
    KRD(GL,3); GAPB(o[1]=__builtin_amdgcn_mfma_f32_32x32x16_bf16(PAF(2),VFR(6),o[1],0,0,0), C1,4); \
    GAPB(o[0]=__builtin_amdgcn_mfma_f32_32x32x16_bf16(PAF(3),VFR(3),o[0],0,0,0), C1,8); \
    GAPB(o[1]=__builtin_amdgcn_mfma_f32_32x32x16_bf16(PAF(3),VFR(7),o[1],0,0,0), C1,12); \
    }while(0)
  int t=1;
  #undef CMASK
  #define CMASK(P0,P1,t) do{}while(0)
  for(;t+5<NT;t+=2){
    STEP(pB0,pB1,pA0,pA1,t,true,true,true);     WAIT_BAR(2); RESC(); ROT();
    STEP(pA0,pA1,pB0,pB1,t+1,true,true,true);   WAIT_BAR(2); RESC(); ROT();
  }
  #undef CMASK
  #define CMASK(P0,P1,t) do{int jb_=(t)-(NT-4); if(jb_>=0)cmask(P0,P1,jb_,qrel,hi);}while(0)
  #define ENDW(tt) do{ if((tt)+3<NT){WAIT_BAR(2);} else if((tt)+2<NT){WAIT_BAR(1);} else {WAIT_BAR(0);} }while(0)
  for(;t+1<NT;t+=2){
    STEP(pB0,pB1,pA0,pA1,t,(t+3<NT),(t+1<NT),(t+1<NT));       ENDW(t);   RESC(); ROT();
    STEP(pA0,pA1,pB0,pB1,t+1,(t+4<NT),(t+2<NT),(t+2<NT));     ENDW(t+1); RESC(); ROT();
  }
  STEP(pB0,pB1,pA0,pA1,NT-1,false,false,false); RESC();
  { float sacc=pB0[0]+pB0[1]; _Pragma("unroll") for(int r=2;r<16;++r)sacc+=pB0[r]; _Pragma("unroll") for(int r=0;r<16;++r)sacc+=pB1[r]; l_reg+=sacc;
    pw0=(u32x4){PKW(pB0,0),PKW(pB0,2),PKW(pB0,4),PKW(pB0,6)};pw1=(u32x4){PKW(pB0,8),PKW(pB0,10),PKW(pB0,12),PKW(pB0,14)};pw2=(u32x4){PKW(pB1,0),PKW(pB1,2),PKW(pB1,4),PKW(pB1,6)};pw3=(u32x4){PKW(pB1,8),PKW(pB1,10),PKW(pB1,12),PKW(pB1,14)};
    SBAR(); pv(o,vb0+sl_cur,PAF(0),PAF(1),PAF(2),PAF(3)); }
  #undef PKW
  #undef PAF
  #undef VFR
  #undef PIN
  #undef MX3
  #undef GAPA
  #undef GAPB
  #undef EX
  #undef VRD
  #undef KRD
  #undef STEP
  #undef ENDW
  {auto rr=__builtin_amdgcn_permlane32_swap(__float_as_uint(l_reg),__float_as_uint(l_reg),false,false);l_reg=__uint_as_float(rr[0])+__uint_as_float(rr[1]);}
  if(hi==0)wsf[32+r32]=l_reg;asm volatile("s_waitcnt lgkmcnt(0)":::"memory");
  float rli[16];
  #pragma unroll
  for(int r=0;r<16;++r)rli[r]=__builtin_amdgcn_rcpf(wsf[32+crow(r,hi)]);
  bf16*Ow=O+(long)(q0+wid*QBLK)*DM+hv*D;
  { bf16*stg=(bf16*)(shm+LDS_OST)+wid*2048;
    #pragma unroll
    for(int r=0;r<16;++r){const int orow=crow(r,hi);
      #pragma unroll
      for(int d0=0;d0<2;++d0)stg[orow*64+d0*32+r32]=__float2bfloat16(o[d0][r]*rli[r]);}
    asm volatile("s_waitcnt lgkmcnt(0)":::"memory");
    #pragma unroll
    for(int i=0;i<4;++i){const int row=i*8+(lane>>3),ch=lane&7; const u32x4 v=*(const u32x4*)(stg+row*64+ch*8); ATTN_STORE16(Ow+(long)row*DM+ch*8,v);} }
  asm volatile("s_waitcnt lgkmcnt(0)\n\ts_barrier":::"memory");
  #undef DMA_K
  #undef DMA_V
  #undef CMASK
  #undef START
  #undef RESC
  #undef ROT
}
constexpr int ATTN_LDS_BYTES=LDS_BYTES;
#undef SBAR
#undef WAIT_BAR
}

typedef GAS unsigned gu32;
#define RLX_AGENT __ATOMIC_RELAXED, __HIP_MEMORY_SCOPE_AGENT
#define LDS_WAIT() asm volatile("s_waitcnt lgkmcnt(0)" ::: "memory")
#define XB_TMO      128
#define XB_XCNT(j)  (256  + 64 * (j))
#define XB_XSUB(j)  (1280 + 64 * (j))
#define XB_XGEN(j)  (2304 + 64 * (j))
#define XB_TOP      3328
#define XB_TOPGEN   3392
#define XCD_BAR_WORDS 3456
#define XB_SPIN_CAP (1u << 18)
__device__ __forceinline__ unsigned xb_ld(unsigned* p)              { return __hip_atomic_load(p, __ATOMIC_RELAXED, __HIP_MEMORY_SCOPE_AGENT); }
__device__ __forceinline__ unsigned xb_add(unsigned* p, unsigned v) { return __hip_atomic_fetch_add(p, v, __ATOMIC_RELAXED, __HIP_MEMORY_SCOPE_AGENT); }
__device__ __forceinline__ unsigned xb_xcc_id() { return (unsigned)__builtin_amdgcn_s_getreg((3 << 11) | 20) & 0xFu; }
#define XB_SPIN(cond, bar) do { unsigned _sp = 0; while (cond) { __builtin_amdgcn_s_sleep(1); \
    if ((++_sp & 255u) == 0u) { if (xb_ld(&(bar)[XB_TMO])) break; if (_sp > XB_SPIN_CAP) { atomicAdd(&(bar)[XB_TMO], 1u); break; } } } } while (0)
struct XcdBarrier { unsigned* bar; unsigned x; volatile LAS unsigned* st; };
__device__ __forceinline__ XcdBarrier xcd_barrier_post(unsigned* bar, volatile LAS unsigned* st) {
    XcdBarrier b; b.bar = bar; b.x = xb_xcc_id(); b.st = st;
    if (threadIdx.x == 0) (void)xb_add(&bar[XB_XCNT(b.x)], 1u);
    return b;
}
__device__ __forceinline__ void xcd_barrier_complete(unsigned* bar, unsigned x, unsigned& nloc, unsigned& nx) {
    const unsigned G = gridDim.x * gridDim.y * gridDim.z;
    unsigned sum, cnt, mine, sp = 0u;
    for (;;) {
        sum = 0u; cnt = 0u; mine = 0u;
#pragma unroll
        for (unsigned j = 0; j < 16; ++j) { const unsigned c = xb_ld(&bar[XB_XCNT(j)]); sum += c; cnt += (c > 0u) ? 1u : 0u; mine = (j == x) ? c : mine; }
        if (sum == G) break;
        __builtin_amdgcn_s_sleep(1);
        if ((++sp & 255u) == 0u) { if (xb_ld(&bar[XB_TMO])) break; if (sp > XB_SPIN_CAP) { atomicAdd(&bar[XB_TMO], 1u); break; } }
    }
    nloc = mine > 0u ? mine : 1u; nx = cnt > 0u ? cnt : 1u;
}
__device__ __forceinline__ void xcd_barrier(const XcdBarrier& b) {
    asm volatile("s_waitcnt vmcnt(0)" ::: "memory");
    __syncthreads();
    if (threadIdx.x == 0) {
        unsigned* bar = b.bar; asm volatile("" : "+v"(bar));
        __builtin_amdgcn_s_waitcnt(0);
        unsigned nloc = b.st[0], nx = b.st[1];
        if (nloc == 0u) { xcd_barrier_complete(bar, b.x, nloc, nx); b.st[0] = nloc; b.st[1] = nx; }
        const unsigned old = xb_add(&bar[XB_XSUB(b.x)], 1u);
        const unsigned gen = old / nloc;
        if (old + 1u == (gen + 1u) * nloc) {
            __builtin_amdgcn_fence(__ATOMIC_RELEASE, "agent");
            asm volatile("s_waitcnt vmcnt(0)" ::: "memory");
            const unsigned og = xb_add(&bar[XB_TOP], 1u);
            const unsigned tg = og / nx;
            if (og + 1u == (tg + 1u) * nx) xb_add(&bar[XB_TOPGEN], 1u);
            else XB_SPIN(xb_ld(&bar[XB_TOPGEN]) == tg, bar);
            __builtin_amdgcn_fence(__ATOMIC_ACQUIRE, "agent");
            xb_add(&bar[XB_XGEN(b.x)], 1u);
            asm volatile("s_waitcnt vmcnt(0)" ::: "memory");
        } else {
            XB_SPIN(xb_ld(&bar[XB_XGEN(b.x)]) == gen, bar);
            __builtin_amdgcn_fence(__ATOMIC_ACQUIRE, "agent");
            asm volatile("s_waitcnt vmcnt(0)" ::: "memory");
        }
    }
    __syncthreads();
}

#define XB2_XSUB(j) (64 * (j))
#define XB2_TOP     1024
#define XB2_TOPGEN  1088
__device__ __forceinline__ void xcd_split_arrive(unsigned* bar2, unsigned* bar, volatile LAS unsigned* st) {
    asm volatile("s_waitcnt vmcnt(0)" ::: "memory");
    __syncthreads();
    if (threadIdx.x == 0) {
        asm volatile("" : "+v"(bar2));
        __builtin_amdgcn_s_waitcnt(0);
        unsigned nloc = st[0], nx = st[1]; const unsigned x = xb_xcc_id();
        if (nloc == 0u) { xcd_barrier_complete(bar, x, nloc, nx); st[0] = nloc; st[1] = nx; }
        const unsigned old = xb_add(&bar2[XB2_XSUB(x)], 1u);
        if ((old + 1u) % nloc == 0u) {
            __builtin_amdgcn_fence(__ATOMIC_RELEASE, "agent");
            asm volatile("s_waitcnt vmcnt(0)" ::: "memory");
            const unsigned og = xb_add(&bar2[XB2_TOP], 1u);
            if ((og + 1u) % nx == 0u) xb_add(&bar2[XB2_TOPGEN], 1u);
            asm volatile("s_waitcnt vmcnt(0)" ::: "memory");
        }
    }
}
__device__ __forceinline__ void xcd_split_wait(unsigned* bar2, unsigned* bar, unsigned target) {
    if (threadIdx.x == 0) {
        asm volatile("" : "+v"(bar2));
        XB_SPIN(xb_ld(&bar2[XB2_TOPGEN]) < target, bar);
        __builtin_amdgcn_fence(__ATOMIC_ACQUIRE, "agent");
        asm volatile("s_waitcnt vmcnt(0)" ::: "memory");
    }
    __syncthreads();
}

__device__ __forceinline__ float wave_sum(float v) {
#pragma unroll
    for (int o = 1; o < 64; o <<= 1) v += __shfl_xor(v, o);
    return v;
}
template <class F>
__device__ __forceinline__ void transpose_load(const float* W, int ld, int nrows, F srccol, int item, int lane, f32x4 (&v)[8]) {
    const int nblk = nrows / 32, kb = item / nblk, nb = item % nblk, k0 = 64 * kb, s0 = srccol(32 * nb);
#pragma unroll
    for (int i = 0; i < 8; ++i) v[i] = __builtin_nontemporal_load((const f32x4*)(W + (size_t)(k0 + 8 * i + (lane >> 3)) * ld + s0 + 4 * (lane & 7)));
}
__host__ __device__ __forceinline__ int perm32(int rho) { const int n = rho >> 4, i = rho & 15; return 8 * (i >> 2) + 4 * n + (i & 3); }
template <bool PERM>
__device__ __forceinline__ void transpose_store(int K, bf16_t* WT, int nrows, const float* gk, LAS float* scr, int item, int lane, const f32x4 (&v)[8]) {
    const int nblk = nrows / 32, kb = item / nblk, nb = item % nblk, k0 = 64 * kb, n0 = 32 * nb;
#pragma unroll
    for (int i = 0; i < 8; ++i) { const int kk = 8 * i + (lane >> 3); const float g = gk ? gk[k0 + kk] : 1.0f;
#pragma unroll
        for (int e = 0; e < 4; ++e) scr[kk * 33 + 4 * (lane & 7) + e] = v[i][e] * g; }
    LDS_WAIT(); asm volatile("" ::: "memory");
    const int c = lane & 7;
#pragma unroll
    for (int j = 0; j < 4; ++j) { const int n = (lane >> 3) + 8 * j; const LAS float* s = scr + (8 * c) * 33 + (PERM ? perm32(n) : n);
        u32x4 o; o.x = cvt_pk_bf16(s[0 * 33], s[1 * 33]); o.y = cvt_pk_bf16(s[2 * 33], s[3 * 33]); o.z = cvt_pk_bf16(s[4 * 33], s[5 * 33]); o.w = cvt_pk_bf16(s[6 * 33], s[7 * 33]);
        *(u32x4*)(WT + (size_t)(n0 + n) * K + k0 + 8 * c) = o; }
    LDS_WAIT(); asm volatile("" ::: "memory");
}
struct ColIdent { int off; __device__ __forceinline__ int operator()(int r) const { return off + r; } };
struct ColSwiglu { __device__ __forceinline__ int operator()(int r) const { return ((r >> 7) & 1) * DFF + (r >> 8) * 128 + (r & 127); } };
struct ColMix { __device__ __forceinline__ int operator()(int r) const {
    const int tile = r >> 8, p = r & 255, o = 64 * ((p >> 5) & 3) + 32 * (p >> 7) + (p & 31);
    if (tile < 16) return r;
    if (tile < 20) return 6144 + (tile - 16) * 256 + o;
    if (tile < 24) return 7168 + (tile - 20) * 256 + o;
    if (tile < 28) return 8192 + (tile - 24) * 256 + p;
    return 9216 + (tile - 28) * 256 + p; } };
template <bool PERM = false, class F>
__device__ __forceinline__ void transpose_all(const float* W, int K, int ld, bf16_t* WT, int nrows, F srccol, const float* gk, LAS float* scr, int gw, int ngw, int lane) {
    const int nitems = (K / 64) * (nrows / 32);
    for (int it = gw; it < nitems; it += 2 * ngw) {
        f32x4 va[8], vb[8]; const int it2 = it + ngw;
        transpose_load(W, ld, nrows, srccol, it, lane, va);
        if (it2 < nitems) transpose_load(W, ld, nrows, srccol, it2, lane, vb);
        transpose_store<PERM>(K, WT, nrows, gk, scr, it, lane, va);
        if (it2 < nitems) transpose_store<PERM>(K, WT, nrows, gk, scr, it2, lane, vb);
    }
}
__device__ __forceinline__ void rms_rows_to_bf16(const float* x, const float* gain, bf16_t* o, int m0, int step, int nrows, int lane) {
    const f32x4* gr = (const f32x4*)gain + lane;
    for (int m = m0; m < nrows; m += 2 * step) {
        const int m2 = (m + step < nrows) ? m + step : m;
        const f32x4* xa = (const f32x4*)(x + (size_t)m * DM) + lane; const f32x4* xb2 = (const f32x4*)(x + (size_t)m2 * DM) + lane;
        f32x4 va[4], vb[4]; float sa = 0.f, sb = 0.f;
#pragma unroll
        for (int j = 0; j < 4; ++j) { va[j] = __builtin_nontemporal_load(xa + 64 * j); vb[j] = __builtin_nontemporal_load(xb2 + 64 * j); }
#pragma unroll
        for (int j = 0; j < 4; ++j) { sa += (va[j][0] * va[j][0] + va[j][1] * va[j][1]) + (va[j][2] * va[j][2] + va[j][3] * va[j][3]); sb += (vb[j][0] * vb[j][0] + vb[j][1] * vb[j][1]) + (vb[j][2] * vb[j][2] + vb[j][3] * vb[j][3]); }
        const float ra = __builtin_amdgcn_rsqf(wave_sum(sa) * (1.f / 1024.f) + EPS), rb = __builtin_amdgcn_rsqf(wave_sum(sb) * (1.f / 1024.f) + EPS);
        u32x2* oa = (u32x2*)(o + (size_t)m * DM) + lane; u32x2* ob = (u32x2*)(o + (size_t)m2 * DM) + lane;
#pragma unroll
        for (int j = 0; j < 4; ++j) { const f32x4 g = gr[64 * j]; oa[64 * j] = pack4(va[j] * ra * g); if (m2 != m) ob[64 * j] = pack4(vb[j] * rb * g); }
    }
}
__device__ __forceinline__ void rot_table(const int* pos, float* rot, int gt, int ngt) {
    for (int idx = gt; idx < SEQ * 128; idx += ngt) {
        const int s = idx >> 7, i = idx & 127;
        const float inv = exp2f(-(float)i * (13.287712379549449f / 128.0f));
        const float ang = (float)pos[s] * inv;
        const float kq = rintf(ang * 0.6366197723675814f);
        float r = fmaf(-kq, 1.5703125f, ang); r = fmaf(-kq, 4.837512969970703125e-4f, r); r = fmaf(-kq, 7.54978995489188216e-8f, r);
        const float r2 = r * r;
        const float sn = r + r * r2 * (-1.6666667e-1f + r2 * (8.3333333e-3f + r2 * (-1.9841270e-4f + r2 * 2.7557319e-6f)));
        const float cn = 1.0f + r2 * (-0.5f + r2 * (4.1666668e-2f + r2 * (-1.3888889e-3f + r2 * (2.4801587e-5f + r2 * -2.7557319e-7f))));
        const int qd = ((int)kq) & 3;
        const float c = (qd == 0) ? cn : (qd == 1) ? -sn : (qd == 2) ? -cn : sn;
        const float sv = (qd == 0) ? sn : (qd == 1) ? cn : (qd == 2) ? -sn : -cn;
        *(f32x2*)(rot + (size_t)idx * 2) = (f32x2){c, sv};
    }
}

constexpr int SCN_LD = 136, SCN_V_OFF = 64 * SCN_LD * 2, SCN_CH = 192 * SCN_LD * 2;
constexpr unsigned SCAN_UNITS_PER_FLAG = 8;
__device__ __forceinline__ void scan_unit(int u, const bf16_t* kts, const bf16_t* vt, bf16_t* S, LAS unsigned char* lds, unsigned* done  ) {
    const int tid = opaque_tid(), lane = tid & 63, wave = __builtin_amdgcn_readfirstlane(tid >> 6);
    const int fr = lane & 15, fq = lane >> 4, h = u >> 4, dg = (u >> 2) & 3, eg = u & 3, wd = wave & 1, we = wave >> 1;
    const float gC = __builtin_amdgcn_exp2f(128.0f * log2f(1.0f - __builtin_amdgcn_exp2f(-5.0f - (float)h)));
    f32x4 acc[2][2];
#pragma unroll
    for (int a = 0; a < 2; ++a)
#pragma unroll
        for (int b = 0; b < 2; ++b) acc[a][b] = (f32x4){0.f, 0.f, 0.f, 0.f};
    const bf16_t* ksrc = kts + (size_t)(h * 256 + 64 * dg + (tid >> 4)) * SEQ + (tid & 15) * 8;
    const bf16_t* vsrc = vt + (size_t)(h * 512 + 128 * eg + (tid >> 4)) * SEQ + (tid & 15) * 8;
    u32x4 pk[3][2][2], pv[3][2][4];
#pragma unroll
    for (int sb = 0; sb < 3; ++sb)
#pragma unroll
        for (int i = 0; i < 2; ++i) {
#pragma unroll
            for (int j = 0; j < 2; ++j) pk[sb][i][j] = *(const u32x4*)(ksrc + (size_t)(32 * j) * SEQ + (2 * sb + i) * 128);
#pragma unroll
            for (int j = 0; j < 4; ++j) pv[sb][i][j] = *(const u32x4*)(vsrc + (size_t)(32 * j) * SEQ + (2 * sb + i) * 128);
        }
    bf16_t* sdst = S + ((size_t)(h * 16) * 512 + 128 * eg + 32 * we + fr) * 256 + 64 * dg + 32 * wd + 4 * fq;
#pragma unroll
    for (int r = 0; r < 8; ++r) {
        __syncthreads();
#pragma unroll
        for (int i = 0; i < 2; ++i) {
            if (2 * r + i < 15) {
                LAS bf16_t* lk = (LAS bf16_t*)(lds + i * SCN_CH); LAS bf16_t* lv = (LAS bf16_t*)(lds + i * SCN_CH + SCN_V_OFF);
#pragma unroll
                for (int j = 0; j < 2; ++j) *(LAS u32x4*)(lk + (32 * j + (tid >> 4)) * SCN_LD + (tid & 15) * 8) = pk[r % 3][i][j];
#pragma unroll
                for (int j = 0; j < 4; ++j) *(LAS u32x4*)(lv + (32 * j + (tid >> 4)) * SCN_LD + (tid & 15) * 8) = pv[r % 3][i][j];
            }
        }
        __syncthreads();
        if (r < 5) {
#pragma unroll
            for (int i = 0; i < 2; ++i) { const int c = 2 * (r + 3) + i;
                if (c < 15) {
#pragma unroll
                    for (int j = 0; j < 2; ++j) pk[r % 3][i][j] = *(const u32x4*)(ksrc + (size_t)(32 * j) * SEQ + c * 128);
#pragma unroll
                    for (int j = 0; j < 4; ++j) pv[r % 3][i][j] = *(const u32x4*)(vsrc + (size_t)(32 * j) * SEQ + c * 128);
                } }
        }
#pragma unroll
        for (int i = 0; i < 2; ++i) {
            const int c = 2 * r + i;
#pragma unroll
            for (int td = 0; td < 2; ++td)
#pragma unroll
                for (int te = 0; te < 2; ++te) { const u32x2 w = pack4(acc[td][te]);
                    __hip_atomic_store((unsigned long long*)(sdst + (size_t)c * 512 * 256 + (size_t)(16 * te) * 256 + 16 * td), ((unsigned long long)w.y << 32) | w.x, __ATOMIC_RELAXED, __HIP_MEMORY_SCOPE_AGENT); }
            if (c < 15) {
                const LAS bf16_t* lk = (const LAS bf16_t*)(lds + i * SCN_CH); const LAS bf16_t* lv = (const LAS bf16_t*)(lds + i * SCN_CH + SCN_V_OFF);
                f32x4 tm[2][2];
#pragma unroll
                for (int td = 0; td < 2; ++td)
#pragma unroll
                    for (int te = 0; te < 2; ++te) tm[td][te] = (f32x4){0.f, 0.f, 0.f, 0.f};
#pragma unroll
                for (int ks = 0; ks < 4; ++ks) {
                    bf16x8 a[2], b[2];
#pragma unroll
                    for (int t = 0; t < 2; ++t) { a[t] = *(const LAS bf16x8*)(lk + (32 * wd + 16 * t + fr) * SCN_LD + 32 * ks + 8 * fq); b[t] = *(const LAS bf16x8*)(lv + (32 * we + 16 * t + fr) * SCN_LD + 32 * ks + 8 * fq); }
#pragma unroll
                    for (int td = 0; td < 2; ++td)
#pragma unroll
                        for (int te = 0; te < 2; ++te) tm[td][te] = mfma16(a[td], b[te], tm[td][te]);
                }
#pragma unroll
                for (int td = 0; td < 2; ++td)
#pragma unroll
                    for (int te = 0; te < 2; ++te) acc[td][te] = acc[td][te] * gC + tm[td][te];
            }
        }
    }
    asm volatile("s_waitcnt vmcnt(0)" ::: "memory");
    __syncthreads();
    if (tid == 0) __hip_atomic_fetch_add(done + ((h * 2 + (eg >> 1)) * 64), 1u, __ATOMIC_RELAXED, __HIP_MEMORY_SCOPE_AGENT);
}
constexpr int RQ_LD = 264, SC_LD = 136, RO_SC_OFF = 128 * RQ_LD * 2, RO_PART_OFF = RO_SC_OFF + 128 * SC_LD * 2;
__device__ __forceinline__ void retout_unit(int h, int c, int eh, const bf16_t* q, const bf16_t* k, const bf16_t* vt, const bf16_t* S, bf16_t* ret  , float* rssq, LAS unsigned char* lds, unsigned* done, unsigned* tmo) {
    const int tid = opaque_tid(), lane = tid & 63, wave = __builtin_amdgcn_readfirstlane(tid >> 6);
    const int fr = lane & 15, fq = lane >> 4;
    LAS bf16_t* ql = (LAS bf16_t*)lds; LAS bf16_t* sc = (LAS bf16_t*)(lds + RO_SC_OFF); LAS float* part = (LAS float*)(lds + RO_PART_OFF);
    const float lg2 = log2f(1.0f - __builtin_amdgcn_exp2f(-5.0f - (float)h));
    const int tok0 = c * 128;
    if (tid < 64) {
        unsigned* f = done + ((h * 2 + eh) * 64); unsigned sp = 0;
        while ((unsigned)__builtin_amdgcn_readfirstlane(__hip_atomic_load(f, __ATOMIC_RELAXED, __HIP_MEMORY_SCOPE_AGENT)) < SCAN_UNITS_PER_FLAG) {
            __builtin_amdgcn_s_sleep(2);
            if (++sp > (1u << 20)) { if (tid == 0) __hip_atomic_store(tmo, 1u, __ATOMIC_RELAXED, __HIP_MEMORY_SCOPE_AGENT); break; }
        }
        __builtin_amdgcn_fence(__ATOMIC_ACQUIRE, "agent");
        asm volatile("s_waitcnt vmcnt(0)" ::: "memory");
    }
    __syncthreads();
    const bf16_t* sp = S + ((size_t)((h * 16 + c) * 512 + 256 * eh + 32 * wave + fr)) * 256 + 8 * fq;
    const bf16_t* vp = vt + (size_t)(h * 512 + 256 * eh + 32 * wave + fr) * SEQ + tok0 + 8 * fq;
    const bf16_t* kp = k + (size_t)(tok0 + 16 * wave + fr) * 1024 + h * 256 + 8 * fq;
    u32x4 qv[8]; bf16x8 kf[8], sfa[8][2], vfa[4][2];
#pragma unroll
    for (int i = 0; i < 8; ++i) { const int p = tid + 512 * i, row = p >> 5, c16 = p & 31; qv[i] = *(const u32x4*)(q + (size_t)(tok0 + row) * 1024 + h * 256 + c16 * 8); }
#pragma unroll
    for (int ks = 0; ks < 8; ++ks) kf[ks] = *(const bf16x8*)(kp + 32 * ks);
#pragma unroll
    for (int ks = 0; ks < 8; ++ks)
#pragma unroll
        for (int t = 0; t < 2; ++t) sfa[ks][t] = *(const bf16x8*)(sp + (size_t)(16 * t) * 256 + 32 * ks);
#pragma unroll
    for (int i = 0; i < 8; ++i) { const int p = tid + 512 * i, row = p >> 5, c16 = p & 31; *(LAS u32x4*)(ql + row * RQ_LD + c16 * 8) = qv[i]; }
    __syncthreads();
    {
        const int tj = wave;
#pragma unroll
        for (int ti = 0; ti < 8; ++ti) {
            if (ti >= tj) {
                f32x4 s2 = (f32x4){0.f, 0.f, 0.f, 0.f};
#pragma unroll
                for (int ks = 0; ks < 8; ++ks) { const bf16x8 qf = *(const LAS bf16x8*)(ql + (16 * ti + fr) * RQ_LD + 32 * ks + 8 * fq); s2 = mfma16(kf[ks], qf, s2); }
                const int i = 16 * ti + fr; f32x4 v;
#pragma unroll
                for (int r = 0; r < 4; ++r) { const int j = 16 * tj + 4 * fq + r; v[r] = (i >= j) ? s2[r] * __builtin_amdgcn_exp2f(lg2 * (float)(i - j)) : 0.f; }
                *(LAS u32x2*)(sc + (16 * ti + fr) * SC_LD + 16 * tj + 4 * fq) = pack4(v);
            } else if (ti == tj - 1 && (tj & 1)) {
                u32x2 z = (u32x2){0u, 0u}; asm volatile("" : "+v"(z));
                *(LAS u32x2*)(sc + (16 * ti + fr) * SC_LD + 16 * tj + 4 * fq) = z;
            }
        }
    }
    __syncthreads();
    f32x4 acc[8][2];
#pragma unroll
    for (int a = 0; a < 8; ++a)
#pragma unroll
        for (int b = 0; b < 2; ++b) acc[a][b] = (f32x4){0.f, 0.f, 0.f, 0.f};
    {
        bf16x8 qf[2][8];
#pragma unroll
        for (int t = 0; t < 8; ++t) qf[0][t] = *(const LAS bf16x8*)(ql + (16 * t + fr) * RQ_LD + 8 * fq);
#pragma unroll
        for (int ks = 0; ks < 8; ++ks) {
            if (ks == 4) {
#pragma unroll
                for (int k2 = 0; k2 < 4; ++k2)
#pragma unroll
                    for (int t = 0; t < 2; ++t) vfa[k2][t] = *(const bf16x8*)(vp + (size_t)(16 * t) * SEQ + 32 * k2);
            }
            if (ks < 7) {
#pragma unroll
                for (int t = 0; t < 8; ++t) qf[(ks + 1) & 1][t] = *(const LAS bf16x8*)(ql + (16 * t + fr) * RQ_LD + 32 * (ks + 1) + 8 * fq);
            }
            __builtin_amdgcn_sched_barrier(0);
#pragma unroll
            for (int a = 0; a < 8; ++a)
#pragma unroll
                for (int b = 0; b < 2; ++b) acc[a][b] = mfma16(sfa[ks][b], qf[ks & 1][a], acc[a][b]);
            __builtin_amdgcn_sched_barrier(0);
        }
    }
#pragma unroll
    for (int a = 0; a < 8; ++a) { const float qd = __builtin_amdgcn_exp2f(lg2 * (float)(16 * a + fr + 1));
#pragma unroll
        for (int b = 0; b < 2; ++b) acc[a][b] = acc[a][b] * qd; }
#pragma unroll
    for (int ks = 0; ks < 4; ++ks) {
        bf16x8 pf[8];
#pragma unroll
        for (int a = 0; a < 8; ++a) if (a >= 2 * ks) pf[a] = *(const LAS bf16x8*)(sc + (16 * a + fr) * SC_LD + 32 * ks + 8 * fq);
        __builtin_amdgcn_sched_barrier(0);
#pragma unroll
        for (int a = 0; a < 8; ++a) {
            if (a >= 2 * ks) {
#pragma unroll
                for (int b = 0; b < 2; ++b) acc[a][b] = mfma16(vfa[ks][b], pf[a], acc[a][b]);
            }
        }
        __builtin_amdgcn_sched_barrier(0);
    }
#pragma unroll
    for (int a = 0; a < 8; ++a) {
        float ss = 0.f;
#pragma unroll
        for (int b = 0; b < 2; ++b) { const f32x4 t = acc[a][b]; ss += (t[0] * t[0] + t[1] * t[1]) + (t[2] * t[2] + t[3] * t[3]); }
        ss += __shfl_xor(ss, 16); ss += __shfl_xor(ss, 32);
        if (fq == 0) part[wave * 128 + 16 * a + fr] = ss;
    }
    __syncthreads();
    if (tid < 128) {
        float tot = 0.f;
#pragma unroll
        for (int w = 0; w < 8; ++w) tot += part[w * 128 + tid];
        rssq[(size_t)(tok0 + tid) * 8 + 2 * h + eh] = tot;
    }
#pragma unroll
    for (int a = 0; a < 8; ++a)
#pragma unroll
        for (int b = 0; b < 2; ++b)
            *(u32x2*)(ret + (size_t)(tok0 + 16 * a + fr) * 2048 + h * 512 + 256 * eh + 32 * wave + 16 * b + 4 * fq) = pack4(acc[a][b]);
    __syncthreads();
}
constexpr int PL_LD = 264, MA_KV_BYTES = 64 * 264 * 2, MA_P_OFF = MA_KV_BYTES;
__device__ __forceinline__ void memattn_unit(int b, int h, int rb, const bf16_t* mkn, const bf16_t* mvt, bf16_t* mo  , LAS unsigned char* lds) {
    const bf16_t* mq = mo;
    const int tid = opaque_tid(), lane = tid & 63, wave = __builtin_amdgcn_readfirstlane(tid >> 6);
    const int fr = lane & 15, fq = lane >> 4;
    LAS bf16_t* kv = (LAS bf16_t*)lds; LAS bf16_t* pl = (LAS bf16_t*)(lds + MA_P_OFF) + wave * (16 * PL_LD);
    const int row = 128 * rb + 16 * wave + fr;
    const bf16_t* ksrc = mkn + (size_t)(b * 256) * 1024 + h * 256;
    const bf16_t* vsrc = mvt + (size_t)((b * 4 + h) * 256) * 256;
    u32x4 pre[4];
#pragma unroll
    for (int i = 0; i < 4; ++i) { const int p = tid + 512 * i; pre[i] = *(const u32x4*)(ksrc + (size_t)(p >> 5) * 1024 + (p & 31) * 8); }
    bf16x8 qf[8]; float qs = 0.f;
#pragma unroll
    for (int ks = 0; ks < 8; ++ks) { qf[ks] = *(const bf16x8*)(mq + (size_t)row * 1024 + h * 256 + 32 * ks + 8 * fq);
#pragma unroll
        for (int j = 0; j < 8; ++j) { const float f = bf2f((unsigned short)qf[ks][j]); qs += f * f; } }
    qs += __shfl_xor(qs, 16); qs += __shfl_xor(qs, 32);
    const float scl = __builtin_amdgcn_rsqf(qs * (1.0f / 256.0f) + EPS) * (0.0625f * LOG2E);
    f32x4 sa[16];
#pragma unroll
    for (int kc = 0; kc < 4; ++kc) {
        __syncthreads();
#pragma unroll
        for (int i = 0; i < 4; ++i) { const int p = tid + 512 * i; *(LAS u32x4*)(kv + (p >> 5) * PL_LD + (p & 31) * 8) = pre[i]; }
        __syncthreads();
#pragma unroll
        for (int i = 0; i < 4; ++i) { const int p = tid + 512 * i;
            pre[i] = (kc < 3) ? *(const u32x4*)(ksrc + (size_t)(64 * (kc + 1) + (p >> 5)) * 1024 + (p & 31) * 8) : *(const u32x4*)(vsrc + (size_t)(p >> 5) * 256 + (p & 31) * 8); }
#pragma unroll
        for (int tl = 0; tl < 4; ++tl) {
            f32x4 a = (f32x4){0.f, 0.f, 0.f, 0.f};
#pragma unroll
            for (int ks = 0; ks < 8; ++ks) { const bf16x8 kf = *(const LAS bf16x8*)(kv + (16 * tl + fr) * PL_LD + 32 * ks + 8 * fq); a = mfma16(kf, qf[ks], a); }
            sa[4 * kc + tl] = a * scl;
        }
    }
    float mx = -INFINITY;
#pragma unroll
    for (int t = 0; t < 16; ++t) mx = fmaxf(mx, fmaxf(fmaxf(sa[t][0], sa[t][1]), fmaxf(sa[t][2], sa[t][3])));
    mx = fmaxf(mx, __shfl_xor(mx, 16)); mx = fmaxf(mx, __shfl_xor(mx, 32));
    float l = 0.f;
#pragma unroll
    for (int t = 0; t < 16; ++t) {
        f32x4 p;
#pragma unroll
        for (int r = 0; r < 4; ++r) { p[r] = __builtin_amdgcn_exp2f(sa[t][r] - mx); l += p[r]; }
        *(LAS u32x2*)(pl + fr * PL_LD + 16 * t + 4 * fq) = pack4(p);
    }
    l += __shfl_xor(l, 16); l += __shfl_xor(l, 32);
    const float rl = __builtin_amdgcn_rcpf(l);
    LDS_WAIT(); asm volatile("" ::: "memory");
    bf16x8 pf[8];
#pragma unroll
    for (int ks = 0; ks < 8; ++ks) pf[ks] = *(const LAS bf16x8*)(pl + fr * PL_LD + 32 * ks + 8 * fq);
#pragma unroll
    for (int dc = 0; dc < 4; ++dc) {
        __syncthreads();
#pragma unroll
        for (int i = 0; i < 4; ++i) { const int p = tid + 512 * i; *(LAS u32x4*)(kv + (p >> 5) * PL_LD + (p & 31) * 8) = pre[i]; }
        __syncthreads();
        if (dc < 3) {
#pragma unroll
            for (int i = 0; i < 4; ++i) { const int p = tid + 512 * i; pre[i] = *(const u32x4*)(vsrc + (size_t)(64 * (dc + 1) + (p >> 5)) * 256 + (p & 31) * 8); }
        }
#pragma unroll
        for (int tl = 0; tl < 4; ++tl) {
            f32x4 a = (f32x4){0.f, 0.f, 0.f, 0.f};
#pragma unroll
            for (int ks = 0; ks < 8; ++ks) { const bf16x8 vf = *(const LAS bf16x8*)(kv + (16 * tl + fr) * PL_LD + 32 * ks + 8 * fq); a = mfma16(vf, pf[ks], a); }
            *(u32x2*)(mo + (size_t)row * 1024 + h * 256 + 64 * dc + 16 * tl + 4 * fq) = pack4(a * rl);
        }
    }
    __syncthreads();
}
__device__ __forceinline__ void dif_row(const bf16_t* o0, const bf16_t* o1, bf16_t* dif, const float* gout, float lam, int lane) {
    const u32x4* a = (const u32x4*)o0 + 2 * lane; const u32x4* b = (const u32x4*)o1 + 2 * lane;
    float d[16]; float ss = 0.f;
#pragma unroll
    for (int v = 0; v < 2; ++v) { const u32x4 x = __builtin_nontemporal_load(a + v), y = __builtin_nontemporal_load(b + v);
#pragma unroll
        for (int w = 0; w < 4; ++w) { const float x0 = __uint_as_float(x[w] << 16), x1 = __uint_as_float(x[w] & 0xffff0000u), y0 = __uint_as_float(y[w] << 16), y1 = __uint_as_float(y[w] & 0xffff0000u);
            const float d0 = x0 - lam * y0, d1 = x1 - lam * y1; d[v * 8 + w * 2] = d0; d[v * 8 + w * 2 + 1] = d1; ss += d0 * d0 + d1 * d1; } }
    ss += __shfl_xor(ss, 1); ss += __shfl_xor(ss, 2); ss += __shfl_xor(ss, 4);
    const float rn = __builtin_amdgcn_rsqf(ss * (1.0f / 128.0f) + EPS) * (1.0f - LAM_INIT);
    const float* gp = gout + (lane & 7) * 16;
    u32x4 o[2];
#pragma unroll
    for (int v = 0; v < 2; ++v)
#pragma unroll
        for (int w = 0; w < 4; ++w) o[v][w] = cvt_pk_bf16(d[v * 8 + w * 2] * rn * gp[v * 8 + w * 2], d[v * 8 + w * 2 + 1] * rn * gp[v * 8 + w * 2 + 1]);
    u32x4* op = (u32x4*)dif + 2 * lane; op[0] = o[0]; op[1] = o[1];
}

struct P4bOrder {
    pg8::StaticOrder T; unsigned char* ws; const char* xa;
    __device__ __forceinline__ bool next(int i, pg8::Unit& u) const {
        int pm, pn; if (!T.tile(i, pm, pn)) return false;
        u.pm = pm; u.pn = pn; u.ui = i; u.ri = i; u.tag = 0; u.K = 1024;
        u.A = xa + (size_t)pm * 256 * 1024 * 2;
        u.Bt = (const char*)ws + (pn < 8 ? WS_WRG + (size_t)pn * 256 * 1024 * 2 : WS_WGATE + (size_t)(pn - 8) * 256 * 1024 * 2); return true;
    }
};
struct P5Order {
    pg8::StaticOrder T; unsigned char* ws;
    __device__ __forceinline__ bool next(int i, pg8::Unit& u) const {
        const int ti = i / 3, kbr = i - 3 * ti; int pm, pn; if (!T.tile(ti, pm, pn)) return false;
        const size_t offA = kbr == 0 ? WS_RET : kbr == 1 ? WS_DIF : WS_MO;
        const size_t offB = kbr == 0 ? WS_WBRR : kbr == 1 ? WS_WBRD : WS_WBRM;
        const int K = kbr == 0 ? 2048 : 1024;
        u.pm = pm; u.pn = pn; u.ui = i; u.ri = ti; u.tag = kbr; u.K = K;
        u.A = (const char*)ws + offA + (size_t)pm * 256 * K * 2; u.Bt = (const char*)ws + offB + (size_t)pn * 256 * K * 2; return true;
    }
};
#ifndef PH_MASK
#define PH_MASK 0xffffffffu
#endif
#define PH(n) ((PH_MASK >> (n)) & 1u)
#ifndef DUP_MASK
#define DUP_MASK 0u
#endif
#ifndef PROBE_K
#define PROBE_K (-1)
#endif
#define RUNP(k) (pass_ == 1 || (k) <= PROBE_K)
#define REPQ(n) _Pragma("unroll 1") for (int rq_ = 0; rq_ < 1 + (int)((DUP_MASK >> (n)) & 1u); ++rq_)
#define REP(n) _Pragma("unroll 1") for (int rep_ = 0; rep_ < 1 + (int)((DUP_MASK >> (n)) & 1u); ++rep_)
struct Args { const void* in[26]; float* out; unsigned char* ws; };
#define CAS __attribute__((address_space(4)))
__device__ __forceinline__ const void* karg(int i) { typedef const GAS void* gptr; const CAS gptr* p = (const CAS gptr*)__builtin_amdgcn_kernarg_segment_ptr(); asm volatile("" : "+s"(p)); return (const void*)p[i]; }
#define INP(i) ((const float*)karg(i))
#define WSP(T, off) ((T*)((unsigned char*)karg(27) + (off)))
#define OUTP ((float*)karg(26))
struct SplitWait {
    unsigned target;
    __device__ __forceinline__ void wait() const { if (target) xcd_split_wait((unsigned*)WSP(unsigned, WS_CTL) + CW_BAR2, (unsigned*)WSP(unsigned, WS_CTL) + CW_BAR, target); }
};
__global__ void __launch_bounds__(NWAVES * 64, 2) mk_fwd(Args args) {
    extern __shared__ __attribute__((aligned(16))) unsigned char lds_raw[];
    LAS unsigned char* lds = (LAS unsigned char*)lds_raw;
    volatile LAS unsigned* MISC = (volatile LAS unsigned*)(lds + MISC_OFF);
    const int G = gridDim.x, bx = blockIdx.x;
    for (int u = threadIdx.x; u < (LDS_BYTES - LDSCTL_OFF) / 4; u += NWAVES * 64) ((LAS unsigned*)(lds + LDSCTL_OFF))[u] = 0u;
    __syncthreads();
    (void)xcd_barrier_post((unsigned*)WSP(unsigned, WS_CTL) + CW_BAR, MISC + 8);
#define GRID_BAR() do { XcdBarrier b_; b_.bar = (unsigned*)WSP(unsigned, WS_CTL) + CW_BAR; b_.x = xb_xcc_id(); b_.st = (volatile LAS unsigned*)(lds + MISC_OFF) + 8; xcd_barrier(b_); } while (0)
#define SPLIT_ARRIVE() do { xcd_split_arrive((unsigned*)WSP(unsigned, WS_CTL) + CW_BAR2, (unsigned*)WSP(unsigned, WS_CTL) + CW_BAR, (volatile LAS unsigned*)(lds + MISC_OFF) + 8); ++sgen; } while (0)
    unsigned sgen = 0;
    const int NGW = G * NWAVES, NGT = G * NWAVES * 64;
#define LANE_VARS() const int tid = opaque_tid(), lane = tid & 63, wave = __builtin_amdgcn_readfirstlane(tid >> 6); LAS float* scr = (LAS float*)(lds + wave * 16384); \
    const int gw = bx * NWAVES + wave, gt = bx * (NWAVES * 64) + tid; (void)scr; (void)gw; (void)gt; (void)lane

#pragma unroll 1
    for (int pass_ = (PROBE_K >= 0 ? 0 : 1); pass_ < 2; ++pass_) {
    if (RUNP(0)) {
    REP(0) if (PH(0)) {
        LANE_VARS();
        transpose_all<true>(INP(4), 1024, 2 * DFF, WSP(bf16_t, WS_WF1I), 2 * DFF, ColSwiglu{}, nullptr, scr, gw, NGW, lane);
        transpose_all(INP(18), 1024, 2048, WSP(bf16_t, WS_WMKV), 2048, ColIdent{0}, nullptr, scr, gw, NGW, lane);
        { const float* x = INP(0); const float* g1 = INP(3); bf16_t* xb = WSP(bf16_t, WS_XBL);
          rms_rows_to_bf16(x, g1, xb, gw, NGW, TOK, lane); }
        { const float* mem = INP(1); const float* gm = INP(17); bf16_t* memn = WSP(bf16_t, WS_MEMN);
          rms_rows_to_bf16(mem, gm, memn, gw, NGW, NB * MEML, lane); }
        rot_table((const int*)karg(2), WSP(float, WS_ROT), gt, NGT);
    }
    GRID_BAR();
    }

    if (RUNP(1)) {
    REP(1) if (PH(1)) {
        pg8::Gemm g{WSP(bf16_t, WS_XBL), WSP(bf16_t, WS_WF1I), TOK, 2 * DFF, 1024}; pg8::StaticOrder S; S.init(TOK, 2 * DFF, G, bx);
        EpiSwiglu E{WSP(bf16_t, WS_ACT), nullptr};
        S.set(g); pg8::gemm_phase(lds, S, E);
    }
    if (PH(2)) {
        pg8::Gemm g{WSP(bf16_t, WS_MEMN), WSP(bf16_t, WS_WMKV), NB * MEML, 2048, 1024}; pg8::StaticOrder S; S.init(NB * MEML, 2048, G, (bx + G / 2) % G);
        EpiPlain E{WSP(bf16_t, WS_MKVRAW), 2048};
        S.set(g); pg8::gemm_phase(lds, S, E);
    }
    if (PH(0)) {
        const int q0 = (3 * G) / 4, nq = G - q0;
        if (bx >= q0) {
            LANE_VARS();
            const int gw2 = (bx - q0) * NWAVES + wave, ngw2 = nq * NWAVES;
            transpose_all(INP(5), DFF, 1024, WSP(bf16_t, WS_WF1O), 1024, ColIdent{0}, nullptr, scr, gw2, ngw2, lane);
            transpose_all<true>(INP(7), 1024, 13312, WSP(bf16_t, WS_WMIX), NMIX, ColMix{}, INP(6), scr, gw2, ngw2, lane);
        }
    }
    GRID_BAR();
    }

    if (RUNP(2)) {
    REP(3) if (PH(3)) {
        pg8::Gemm g{WSP(bf16_t, WS_ACT), WSP(bf16_t, WS_WF1O), TOK, 1024, DFF}; pg8::StaticOrder S; S.init(TOK, 1024, G, bx);
        EpiResid<false, false> E{INP(0), nullptr, (bf16_t*)OUTP, WSP(float, WS_SSQ1), 0.5f, (rep_ == 1 && ((DUP_MASK >> 23) & 1u)) ? 1 : 0};
        S.set(g); pg8::gemm_phase(lds, S, E);
    }
    SPLIT_ARRIVE();
    if (PH(0)) {
        LANE_VARS();
        const bf16_t* mkvraw = WSP(bf16_t, WS_MKVRAW); bf16_t* mkn = WSP(bf16_t, WS_MKN); bf16_t* mvt = WSP(bf16_t, WS_MVT);
        const float* g_mem_k = INP(16); const float* g_mem_q = INP(15);
        for (int j = gw; j < NB * MEML * 4; j += NGW) {
            const int row = j >> 2, h = j & 3;
            const u32x2 w = *((const u32x2*)(mkvraw + (size_t)row * 2048 + h * 256) + lane);
            f32x4 v = (f32x4){__uint_as_float(w.x << 16), __uint_as_float(w.x & 0xffff0000u), __uint_as_float(w.y << 16), __uint_as_float(w.y & 0xffff0000u)};
            const float ss = wave_sum((v[0] * v[0] + v[1] * v[1]) + (v[2] * v[2] + v[3] * v[3]));
            const float rn = __builtin_amdgcn_rsqf(ss * (1.0f / 256.0f) + EPS);
            const f32x4 gk = *((const f32x4*)g_mem_k + lane), gq = *((const f32x4*)g_mem_q + lane);
            *((u32x2*)(mkn + (size_t)row * 1024 + h * 256) + lane) = pack4(v * rn * gk * gq);
        }
        for (int idx = gt; idx < NB * 4 * 256 * 256; idx += NGT) {
            const int key = idx & 255, d = (idx >> 8) & 255, bh = idx >> 16, b = bh >> 2, h = bh & 3;
            mvt[idx] = mkvraw[(size_t)(b * 256 + key) * 2048 + 1024 + h * 256 + d];
        }
    }
    { SplitWait H{sgen}; H.wait(); }
    }

    if (RUNP(3))
    for (int ph = 0; ph <= NB; ++ph) {
        const int gp = ph, gm = ph - 1;
        unsigned char* const wsP = WSP(unsigned char, 0) - (((gp + 1) & 1) ? SET_DELTA : 0);
        unsigned char* const wsB = WSP(unsigned char, 0) - (((gm + 1) & 1) ? SET_DELTA : 0);
        unsigned* done = (unsigned*)WSP(unsigned, WS_CTL) + CW_SCAN + ((pass_ * NB + (gm < 0 ? 0 : gm)) * 8) * 64; unsigned* tmo = (unsigned*)WSP(unsigned, WS_CTL) + CW_BAR + XB_TMO;
        const bool early = (gm >= 0 && bx < 64) || gp >= NB;
        if (early) { SplitWait H{sgen}; H.wait(); }
        if (gm >= 0)
            for (int u = bx; u < 64; u += G) REPQ(26) { __syncthreads(); if (PH(5)) scan_unit(u, (const bf16_t*)(wsB + WS_KTS), (const bf16_t*)(wsB + WS_VT), WSP(bf16_t, WS_S), lds, done); }
        if (gp < NB) {
            REP(4) if (PH(4)) {
                pg8::Gemm g{(const bf16_t*)OUTP + (size_t)gp * SEQ * DM, WSP(bf16_t, WS_WMIX), SEQ, NMIX, 1024}; pg8::StaticOrder S; S.init(SEQ, NMIX, G, bx);
                prep_rs(WSP(float, WS_SSQ1), gp * SEQ, S, lds);
                EpiMix E{(const LAS float*)(lds + RTAB_OFF), WSP(float, (gp & 1) ? WS_ROTB : WS_ROT), wsP, WSP(bf16_t, WS_MO) + (size_t)gp * SEQ * 1024, INP(8), INP(9)};
                SplitWait H{early ? 0u : sgen};
                S.set(g); pg8::gemm_phase(lds, S, E, H);
                if (bx >= (SEQ / 256) * (NMIX / 256)) H.wait();
            }
        }
        if (gm >= 0) {
            const size_t oOff = (gm & 1) ? WS_OB : 0;
            unsigned* qctr = (unsigned*)WSP(unsigned, WS_CTL) + CW_QUEUE + (pass_ * NB + gm) * 64;
            volatile LAS unsigned* qslot = (volatile LAS unsigned*)(lds + MISC_OFF) + 16;
            for (;;) {
                __syncthreads();
                if (threadIdx.x == 0) qslot[0] = __hip_atomic_fetch_add(qctr, 1u, __ATOMIC_RELAXED, __HIP_MEMORY_SCOPE_AGENT);
                __syncthreads();
                const int id = __builtin_amdgcn_readfirstlane((int)qslot[0]);
                if (id >= 448) break;
                int aq = -1, aj = 0;
                if (id < 192) { aq = 7 - (id >> 5); aj = id & 31; }
                else if (id < 320) { const int ro = id - 192;
                    if (PH(8)) REPQ(24) { __syncthreads(); retout_unit(ro >> 5, (ro >> 1) & 15, ro & 1, (const bf16_t*)(wsB + WS_Q), (const bf16_t*)(wsB + WS_K), (const bf16_t*)(wsB + WS_VT), WSP(bf16_t, WS_S),
                                           WSP(bf16_t, WS_RET) + (size_t)gm * SEQ * 2048, WSP(float, WS_SSQ2) + (size_t)gm * SEQ * 8, lds, done, tmo); } }
                else if (id < 384) { const int m = id - 320;
                    if (PH(7)) memattn_unit(gm, m >> 4, m & 15, WSP(bf16_t, WS_MKN), WSP(bf16_t, WS_MVT), WSP(bf16_t, WS_MO) + (size_t)gm * SEQ * 1024, lds); }
                else { aq = 1 - ((id - 384) >> 5); aj = (id - 384) & 31; }
                if (aq >= 0) {
                    const int hc = aj >> 1, vh = aj & 1, hh = hc >> 1, cc = hc & 1;
                    if (PH(6)) REPQ(25) attn_body::attn_unit<8>(hc, 2 * hh + vh, aq, (const attn_body::bf16*)(wsB + WS_DQ), (const attn_body::bf16*)(wsB + WS_DK), (const attn_body::bf16*)(wsB + WS_DV),
                                            WSP(attn_body::bf16, (cc ? WS_O1 : WS_O0) + oOff), (char*)lds_raw);
                }
            }
        }
        {
            LANE_VARS();
            if (ph >= 2) {
                const int gd = ph - 2; const size_t oD = (gd & 1) ? WS_OB : 0;
                const float s1 = wave_sum(INP(10)[lane] * INP(11)[lane]), s2 = wave_sum(INP(12)[lane] * INP(13)[lane]); const float lam = __expf(s1) - __expf(s2) + LAM_INIT;
                const bf16_t* bo0 = WSP(bf16_t, WS_O0 + oD); const bf16_t* bo1 = WSP(bf16_t, WS_O1 + oD); bf16_t* difb = WSP(bf16_t, WS_DIF); const float* gdo = INP(14);
                for (int r = gw; r < SEQ; r += NGW) dif_row(bo0 + (size_t)r * 1024, bo1 + (size_t)r * 1024, difb + ((size_t)gd * SEQ + r) * 1024, gdo, lam, lane);
            }
            if (ph + 1 < NB) rot_table((const int*)karg(2) + (ph + 1) * SEQ, WSP(float, ((ph + 1) & 1) ? WS_ROTB : WS_ROT), gt, NGT);
            if (ph == 0) transpose_all<true>(INP(7), 1024, 13312, WSP(bf16_t, WS_WRG), 2048, ColIdent{4096}, INP(6), scr, gw, NGW, lane);
            if (ph == NB) {
                transpose_all<true>(INP(7), 1024, 13312, WSP(bf16_t, WS_WGATE), 3072, ColIdent{10240}, INP(6), scr, gw, NGW, lane);
            }
        }
        SPLIT_ARRIVE();
    }

    if (RUNP(4)) {
    if (PH(9)) {
        pg8::StaticOrder T; T.init(TOK, 5120, G, bx);
        prep_rs(WSP(float, WS_SSQ1), 0, T, lds);
        P4bOrder S{T, WSP(unsigned char, 0), (const char*)OUTP};
        EpiRgG E{(const LAS float*)(lds + RTAB_OFF), WSP(bf16_t, WS_RET), WSP(float, WS_SSQ2), WSP(unsigned char, 0)};
        SplitWait H{sgen};
        pg8::gemm_phase(lds, S, E, H);
        if (bx >= (TOK / 256) * (5120 / 256)) H.wait();
    }
    if (PH(0)) {
        LANE_VARS();
        { const float s1 = wave_sum(INP(10)[lane] * INP(11)[lane]), s2 = wave_sum(INP(12)[lane] * INP(13)[lane]); const float lam = __expf(s1) - __expf(s2) + LAM_INIT;
          const bf16_t* bo0 = WSP(bf16_t, WS_O0 + (((NB - 1) & 1) ? WS_OB : 0)); const bf16_t* bo1 = WSP(bf16_t, WS_O1 + (((NB - 1) & 1) ? WS_OB : 0)); bf16_t* difb = WSP(bf16_t, WS_DIF); const float* gdo = INP(14);
          for (int r = gw; r < SEQ; r += NGW) dif_row(bo0 + (size_t)r * 1024, bo1 + (size_t)r * 1024, difb + ((size_t)(NB - 1) * SEQ + r) * 1024, gdo, lam, lane); }
        transpose_all<true>(INP(19), 2048, 1024, WSP(bf16_t, WS_WBRR), 1024, ColIdent{0}, nullptr, scr, gw, NGW, lane);
        transpose_all<true>(INP(20), 1024, 1024, WSP(bf16_t, WS_WBRD), 1024, ColIdent{0}, nullptr, scr, gw, NGW, lane);
        transpose_all<true>(INP(21), 1024, 1024, WSP(bf16_t, WS_WBRM), 1024, ColIdent{0}, nullptr, scr, gw, NGW, lane);
    }
    SPLIT_ARRIVE();
    if (PH(0)) {
        LANE_VARS();
        transpose_all(INP(22), 1024, 1024, WSP(bf16_t, WS_WO), 1024, ColIdent{0}, nullptr, scr, gw, NGW, lane);
        transpose_all(INP(25), DFF, 1024, WSP(bf16_t, WS_WF2O), 1024, ColIdent{0}, nullptr, scr, gw, NGW, lane);
    }
    { SplitWait H{sgen}; H.wait(); }
    }

    if (RUNP(5)) {
    REP(10) if (PH(10)) {
        pg8::StaticOrder T; T.init(TOK, 1024, G, bx);
        P5Order S{T, WSP(unsigned char, 0)};
        EpiTerm3 E{WSP(unsigned char, 0), WSP(bf16_t, WS_Y)};
        pg8::gemm_phase(lds, S, E);
    }
    SPLIT_ARRIVE();
    if (PH(0)) {
        LANE_VARS();
        transpose_all<true>(INP(24), 1024, 2 * DFF, WSP(bf16_t, WS_WF2I), 2 * DFF, ColSwiglu{}, INP(23), scr, gw, NGW, lane);
    }
    { SplitWait H{sgen}; H.wait(); }
    }

    if (RUNP(6)) {
    if (PH(11)) {
        pg8::Gemm g{WSP(bf16_t, WS_Y), WSP(bf16_t, WS_WO), TOK, 1024, 1024}; pg8::StaticOrder S; S.init(TOK, 1024, G, bx);
        EpiResid<true, false> E{OUTP, nullptr, WSP(bf16_t, WS_X2B), WSP(float, WS_SSQ2), 1.0f, 0};
        S.set(g); pg8::gemm_phase(lds, S, E);
    }
    GRID_BAR();
    }

    if (RUNP(7)) {
    if (PH(12)) {
        pg8::Gemm g{WSP(bf16_t, WS_X2B), WSP(bf16_t, WS_WF2I), TOK, 2 * DFF, 1024}; pg8::StaticOrder S; S.init(TOK, 2 * DFF, G, bx);
        prep_rs(WSP(float, WS_SSQ2), 0, S, lds);
        EpiSwiglu E{WSP(bf16_t, WS_ACT2), (const LAS float*)(lds + RTAB_OFF)};
        S.set(g); pg8::gemm_phase(lds, S, E);
    }
    GRID_BAR();
    }

    if (RUNP(8))
    if (PH(13)) {
        pg8::Gemm g{WSP(bf16_t, WS_ACT2), WSP(bf16_t, WS_WF2O), TOK, 1024, DFF}; pg8::StaticOrder S; S.init(TOK, 1024, G, bx);
        EpiResid<true, true> E{WSP(bf16_t, WS_X2B), OUTP, nullptr, nullptr, 0.5f, 0};
        S.set(g); pg8::gemm_phase(lds, S, E);
    }
    if (pass_ == 0) GRID_BAR();
    }
}

extern "C" void kernel_launch(void* const* d_in, const int* in_sizes, int n_in, void* d_out, int out_size, void* d_ws, size_t ws_size, hipStream_t stream) {
    static int grid = 0;
    if (grid == 0) {
        if (n_in != 26 || ws_size < WS_END) { fprintf(stderr, "kernel_launch: unexpected inputs (n_in %d, ws %zu)\n", n_in, ws_size); grid = -1; return; }
        int dev = 0, cus = 0;
        if (hipGetDevice(&dev) != hipSuccess || hipDeviceGetAttribute(&cus, hipDeviceAttributeMultiprocessorCount, dev) != hipSuccess) { grid = -1; return; }
        if (hipFuncSetAttribute((const void*)mk_fwd, hipFuncAttributeMaxDynamicSharedMemorySize, LDS_BYTES) != hipSuccess) { fprintf(stderr, "kernel_launch: hipFuncSetAttribute failed\n"); grid = -1; return; }
        grid = cus;
    }
    if (grid < 0) return;
    (void)hipMemsetAsync((char*)d_ws + WS_CTL, 0, CTL_ZERO_BYTES, stream);
    Args a{};
    for (int i = 0; i < 26; ++i) a.in[i] = d_in[i];
    a.out = (float*)d_out; a.ws = (unsigned char*)d_ws;
    hipLaunchKernelGGL(mk_fwd, dim3(grid), dim3(NWAVES * 64), LDS_BYTES, stream, a);
}
```

```cpp
#include <hip/hip_runtime.h>
#include <cstdio>
#include <cstdint>

#define LAS __attribute__((address_space(3)))
#define GAS __attribute__((address_space(1)))
typedef unsigned short bf16_t;
typedef short bf16x8 __attribute__((ext_vector_type(8)));
typedef float f32x4 __attribute__((ext_vector_type(4)));
typedef float f32x2 __attribute__((ext_vector_type(2)));
typedef unsigned u32x4 __attribute__((ext_vector_type(4)));
typedef unsigned u32x2 __attribute__((ext_vector_type(2)));

constexpr int NB = 8, SEQ = 2048, DM = 1024, TOK = NB * SEQ, MEML = 256, DFF = 2816;
constexpr int NMIX = 8192;
constexpr float EPS = 1e-6f;
constexpr float LOG2E = 1.4426950408889634f;
constexpr float C2Q = 0.125f * LOG2E;
constexpr float LAM_INIT = 0.2f;

constexpr size_t MiB = 1u << 20;
constexpr size_t KiB = 1u << 10;
constexpr size_t WS_CTL = 0, CTL_ZERO_BYTES = 256 * KiB;
constexpr size_t WS_SSQ1 = 256 * KiB, WS_SSQ2 = 512 * KiB;
constexpr size_t WS_ROT = 1 * MiB, WS_ROTB = 153 * MiB;
constexpr size_t WS_MKN = 3 * MiB, WS_MVT = 7 * MiB;
constexpr size_t WS_WMIX = 11 * MiB;
constexpr size_t WS_XB = 27 * MiB;
constexpr size_t WS_RET = 59 * MiB;
constexpr size_t WS_XBL = 91 * MiB;
constexpr size_t WS_DIF = 123 * MiB;
constexpr size_t WS_MO = 155 * MiB;
constexpr size_t WS_Q = 187 * MiB, WS_K = 191 * MiB, WS_KTS = 195 * MiB, WS_VT = 199 * MiB, WS_DQ = 207 * MiB, WS_DK = 211 * MiB,
                 WS_DV = 215 * MiB;
constexpr size_t SET_DELTA = 160 * MiB;
constexpr size_t WS_WRG = 219 * MiB;
constexpr size_t WS_O0 = 223 * MiB, WS_O1 = 227 * MiB, WS_S = 231 * MiB;
constexpr size_t WS_OB = 24 * MiB;
constexpr size_t WS_WF1I = 59 * MiB, WS_WF1O = 70 * MiB;
constexpr size_t WS_MEMN = 76 * MiB, WS_MKVRAW = 80 * MiB, WS_WMKV = 27 * MiB;
constexpr size_t WS_ACT = 155 * MiB;
constexpr size_t WS_WGATE = 11 * MiB, WS_WBRR = 17 * MiB, WS_WBRD = 21 * MiB, WS_WBRM = 23 * MiB, WS_WO = 25 * MiB;
constexpr size_t WS_G8A = 187 * MiB, WS_G8B = 203 * MiB, WS_G8C = 223 * MiB;
constexpr size_t WS_Y = 27 * MiB;
constexpr size_t WS_X2B = 187 * MiB;
constexpr size_t WS_WF2I = 239 * MiB, WS_WF2O = 1 * MiB, WS_ACT2 = 76 * MiB;
constexpr size_t WS_END = 256 * MiB;

constexpr int CW_BAR = 4096, CW_BAR2 = 8192;
constexpr int CW_QUEUE = 32768;
constexpr int CW_SCAN = 16384;

constexpr int RING_BYTES = 131072, LDSCTL_OFF = RING_BYTES, MISC_OFF = LDSCTL_OFF + 320, LDS_BYTES = 147456;
constexpr int NWAVES = 8;

__device__ __forceinline__ unsigned cvt_pk_bf16(float lo, float hi) { unsigned r; asm volatile("v_cvt_pk_bf16_f32 %0, %1, %2" : "=v"(r) : "v"(lo), "v"(hi)); return r; }
__device__ __forceinline__ u32x2 pack4(f32x4 v) { u32x2 w; w.x = cvt_pk_bf16(v[0], v[1]); w.y = cvt_pk_bf16(v[2], v[3]); return w; }
__device__ __forceinline__ unsigned short bf16_1(float v) { return (unsigned short)(cvt_pk_bf16(v, 0.f) & 0xffffu); }
__device__ __forceinline__ float bf2f(unsigned short b) { return __uint_as_float(((unsigned)b) << 16); }
__device__ __forceinline__ float siluf(float x) { return x * __builtin_amdgcn_rcpf(1.0f + __builtin_amdgcn_exp2f(-x * LOG2E)); }
__device__ __forceinline__ float sigmf(float x) { return __builtin_amdgcn_rcpf(1.0f + __builtin_amdgcn_exp2f(-x * LOG2E)); }
__device__ __forceinline__ float row_rs(const float* ssq, int row) {
    const f32x4 a = *(const f32x4*)(ssq + (size_t)row * 4);
    return __builtin_amdgcn_rsqf(((a[0] + a[1]) + (a[2] + a[3])) * (1.0f / 1024.0f) + EPS);
}
__device__ __forceinline__ int opaque_tid() { int t = threadIdx.x; asm volatile("" : "+v"(t)); return t; }
__device__ __forceinline__ f32x4 mfma16(bf16x8 a, bf16x8 b, f32x4 c) { return __builtin_amdgcn_mfma_f32_16x16x32_bf16(a, b, c, 0, 0, 0); }

namespace pg8 {
constexpr int BM = 256, BK = 64, HALF = 128, HTB = HALF * BK * 2, STAGE_BYTES = 8 * HTB, NXCD = 8, WGM = 8;
__host__ __device__ __forceinline__ int lds_byte(int r, int c) { const int st = (r >> 4) * 2 + (c >> 5), rr = r & 15, cc = c & 31, ob = rr * 64 + cc * 2; return st * 1024 + (ob ^ (((ob >> 9) & 1) << 5)); }
__host__ __device__ __forceinline__ void stage_rc(int b, int& R, int& C) { const int st = b / 1024, sb = b % 1024, swz = sb ^ (((sb >> 9) & 1) << 5); R = (st >> 1) * 16 + swz / 64; C = (st & 1) * 32 + (swz % 64) / 2; }
struct Unit { int pm, pn, ui, ri, tag, K; const char* A; const char* Bt; };
struct Gemm { const bf16_t* A; const bf16_t* Bt; int M, N, K; };
struct StaticOrder {
    int nM, nN, nwg, G, c; Gemm g;
    __host__ __device__ void init(int M, int N, int G_, int c_) { nM = M / BM; nN = N / BM; nwg = nM * nN; G = G_; c = c_; g.A = nullptr; g.Bt = nullptr; g.M = M; g.N = N; g.K = 0; }
    __host__ __device__ void set(const Gemm& g_) { g = g_; }
    __host__ __device__ bool tile(int i, int& pm, int& pn) const {
        const long L = (long)i * G + c; if (L >= nwg) return false;
        int wgid = (int)L; { const int q = nwg / NXCD, r = nwg % NXCD, xcd = wgid % NXCD, off = wgid / NXCD; wgid = (xcd < r ? xcd * (q + 1) : r * (q + 1) + (xcd - r) * q) + off; }
        const int nig = WGM * nN, gid = wgid / nig, fm = gid * WGM, gsz = (nM - fm) < WGM ? (nM - fm) : WGM;
        pm = fm + ((wgid % nig) % gsz); pn = (wgid % nig) / gsz; return true;
    }
    __host__ __device__ bool next(int i, Unit& u) const {
        if (!tile(i, u.pm, u.pn)) return false;
        u.ui = i; u.ri = i; u.tag = 0; u.K = g.K;
        u.A = (const char*)g.A + (size_t)u.pm * 256 * g.K * 2; u.Bt = (const char*)g.Bt + (size_t)u.pn * 256 * g.K * 2; return true;
    }
};
struct NoHook { __device__ __forceinline__ void wait() const {} };
template <class Epi, class Sched, class Hook = NoHook>
__device__ __forceinline__ void gemm_phase(LAS unsigned char* lds, const Sched& S, const Epi& E, const Hook& H = Hook{}) {
    const int tid = opaque_tid(), wid = __builtin_amdgcn_readfirstlane(tid >> 6), lane = tid & 63, wr = wid >> 2, wc = wid & 3, fr = lane & 15, fq = lane >> 4;
    unsigned R2[2], C2[2];
#pragma unroll
    for (int i = 0; i < 2; ++i) { int R, C; stage_rc(tid * 16 + i * 8192, R, C); R2[i] = (unsigned)R * 2u; C2[i] = (unsigned)C * 2u; }
    const size_t kstep = (size_t)(BK * 2);
    const unsigned ldsw = (unsigned)wid * 1024u;
    const int aoff = lds_byte(wr * 64 + fr, fq * 8), boff = lds_byte(wc * 32 + fr, fq * 8);
#define PG8_SA(b, h) (((b) * 2 + (h)) * HTB)
#define PG8_SB(b, h) ((4 + (b) * 2 + (h)) * HTB)
#define PG8_STAGE(bufoff, gbase, voff) do { _Pragma("unroll") for (int _i = 0; _i < 2; ++_i) \
        __builtin_amdgcn_global_load_lds((const unsigned*)((const char*)(gbase) + (voff)[_i]), (LAS unsigned*)(lds + (bufoff) + ldsw + _i * 8192), 16, 0, 0); } while (0)
#define PG8_LDA(dst, b, h) do { _Pragma("unroll") for (int m = 0; m < 4; ++m) _Pragma("unroll") for (int k = 0; k < 2; ++k) dst[m][k] = *(const LAS bf16x8*)(lds + PG8_SA(b, h) + aoff + m * 2048 + k * 1024); } while (0)
#define PG8_LDB(dst, b, h) do { _Pragma("unroll") for (int n = 0; n < 2; ++n) _Pragma("unroll") for (int k = 0; k < 2; ++k) dst[n][k] = *(const LAS bf16x8*)(lds + PG8_SB(b, h) + boff + n * 2048 + k * 1024); } while (0)
#define PG8_MMA(ai, bj, At, Bt) do { __builtin_amdgcn_s_setprio(1); _Pragma("unroll") for (int m = 0; m < 4; ++m) _Pragma("unroll") for (int n = 0; n < 2; ++n) _Pragma("unroll") for (int k = 0; k < 2; ++k) \
        acc[ai][bj][m][n] = __builtin_amdgcn_mfma_f32_16x16x32_bf16(Bt[n][k], At[m][k], acc[ai][bj][m][n], 0, 0, 0); __builtin_amdgcn_s_setprio(0); } while (0)
#define PG8_WAIT_V(n) asm volatile("s_waitcnt vmcnt(" #n ")" ::: "memory")
#define PG8_WAIT_L(n) asm volatile("s_waitcnt lgkmcnt(" #n ")" ::: "memory")
#define PG8_BAR __builtin_amdgcn_s_barrier()
#define PG8_SCHED __builtin_amdgcn_sched_barrier(0)
    Unit cur, nxt; int ui = 0;
    if (!S.next(0, cur)) return;
    f32x4 acc[2][2][4][2];
#pragma unroll
    for (int a = 0; a < 2; ++a)
#pragma unroll
        for (int b = 0; b < 2; ++b)
#pragma unroll
            for (int m = 0; m < 4; ++m)
#pragma unroll
                for (int n = 0; n < 2; ++n) acc[a][b][m][n] = (f32x4){0.f, 0.f, 0.f, 0.f};
    bf16x8 At[4][2], B0[2][2], B1[2][2];
    const char* cA = cur.A; const char* cB = cur.Bt;
    unsigned vo[2] = {R2[0] * (unsigned)cur.K + C2[0], R2[1] * (unsigned)cur.K + C2[1]};
    size_t hstep = (size_t)HALF * cur.K * 2;
    PG8_STAGE(PG8_SB(0, 0), cB, vo); PG8_STAGE(PG8_SB(0, 1), cB + hstep, vo); PG8_STAGE(PG8_SA(0, 0), cA, vo); PG8_STAGE(PG8_SA(0, 1), cA + hstep, vo);
    if (wr == 1) PG8_BAR;
    PG8_WAIT_V(2); PG8_BAR;
    PG8_STAGE(PG8_SB(1, 0), cB + kstep, vo); PG8_STAGE(PG8_SA(1, 0), cA + kstep, vo); PG8_STAGE(PG8_SB(1, 1), cB + hstep + kstep, vo);
    PG8_WAIT_V(6); PG8_BAR;
    for (;;) {
        const bool has_next = S.next(ui + 1, nxt);
        if (!has_next) nxt = cur;
        const char* nA = nxt.A; const char* nB = nxt.Bt;
        const unsigned voN0 = R2[0] * (unsigned)nxt.K + C2[0], voN1 = R2[1] * (unsigned)nxt.K + C2[1]; const size_t hstepN = (size_t)HALF * nxt.K * 2;
        const int nt = cur.K / BK;
        for (int t = 0; t < nt; t += 2) {
            const bool last = (t == nt - 2);
            const char* a1 = cA + (size_t)(t + 1) * kstep;
            const char* a2 = last ? nA : cA + (size_t)(t + 2) * kstep; const char* b2 = last ? nB : cB + (size_t)(t + 2) * kstep;
            const char* a3 = a2 + kstep; const char* b3 = b2 + kstep;
            const unsigned v2[2] = {last ? voN0 : vo[0], last ? voN1 : vo[1]}; const size_t h2 = last ? hstepN : hstep;
            PG8_LDB(B0, 0, 0); PG8_LDB(B1, 0, 1); PG8_SCHED; PG8_LDA(At, 0, 0); PG8_STAGE(PG8_SA(1, 1), a1 + hstep, vo);
            PG8_WAIT_V(8); PG8_WAIT_L(0); PG8_BAR; PG8_MMA(0, 0, At, B0); PG8_MMA(0, 1, At, B1); PG8_BAR; PG8_SCHED;
            PG8_LDA(At, 0, 1); PG8_STAGE(PG8_SB(0, 0), b2, v2); PG8_STAGE(PG8_SB(0, 1), b2 + h2, v2); PG8_STAGE(PG8_SA(0, 0), a2, v2);
            PG8_WAIT_V(8); PG8_WAIT_L(0); PG8_BAR; PG8_MMA(1, 0, At, B0); PG8_MMA(1, 1, At, B1); PG8_BAR; PG8_SCHED;
            PG8_LDB(B0, 1, 0); PG8_LDB(B1, 1, 1); PG8_SCHED; PG8_LDA(At, 1, 0); PG8_STAGE(PG8_SA(0, 1), a2 + h2, v2);
            PG8_WAIT_V(8); PG8_WAIT_L(0); PG8_BAR; PG8_MMA(0, 0, At, B0); PG8_MMA(0, 1, At, B1); PG8_BAR; PG8_SCHED;
            PG8_LDA(At, 1, 1); PG8_STAGE(PG8_SB(1, 0), b3, v2); PG8_STAGE(PG8_SB(1, 1), b3 + h2, v2); PG8_STAGE(PG8_SA(1, 0), a3, v2);
            PG8_WAIT_V(8); PG8_WAIT_L(0); PG8_BAR; PG8_MMA(1, 0, At, B0); PG8_MMA(1, 1, At, B1); PG8_BAR; PG8_SCHED;
        }
        if (wr == 0) PG8_BAR;
        if (ui == 0 && (!Epi::AFTER_DRAIN || has_next)) H.wait();
        if (!Epi::AFTER_DRAIN || has_next) { int fr2 = fr, fq2 = fq; asm volatile("" : "+v"(fr2), "+v"(fq2)); E(acc, cur, wr, wc, fr2, fq2); }
        if (!has_next) break;
#pragma unroll
        for (int a = 0; a < 2; ++a)
#pragma unroll
            for (int b = 0; b < 2; ++b)
#pragma unroll
                for (int m = 0; m < 4; ++m)
#pragma unroll
                    for (int n = 0; n < 2; ++n) acc[a][b][m][n] = (f32x4){0.f, 0.f, 0.f, 0.f};
        cur = nxt; cA = nA; cB = nB; vo[0] = voN0; vo[1] = voN1; hstep = hstepN; ++ui;
        if (wr == 1) PG8_BAR;
    }
    PG8_WAIT_V(0);
    PG8_BAR;
    if constexpr (Epi::AFTER_DRAIN) { if (ui == 0) H.wait(); }
    if constexpr (Epi::AFTER_DRAIN) { int fr2 = fr, fq2 = fq; asm volatile("" : "+v"(fr2), "+v"(fq2)); E.fused(acc, cur, wr, wc, fr2, fq2, lds); }
#undef PG8_SA
#undef PG8_SB
#undef PG8_STAGE
#undef PG8_LDA
#undef PG8_LDB
#undef PG8_MMA
#undef PG8_WAIT_V
#undef PG8_WAIT_L
#undef PG8_BAR
#undef PG8_SCHED
}
}

__device__ __forceinline__ float wave_sum(float v);
#define ACC_ARG const f32x4 (&acc)[2][2][4][2]
#define EPI_FENCE() asm volatile("" ::: "memory")
constexpr int RTAB_OFF = RING_BYTES + 1024;
__device__ __forceinline__ void prep_rs(const float* ssq, int row_off, const pg8::StaticOrder& S, LAS unsigned char* lds) {
    const int tid = opaque_tid(); LAS float* rtab = (LAS float*)(lds + RTAB_OFF); pg8::Unit u;
    for (int i = 0; i < 6 && S.next(i, u); ++i) if (tid < 256) rtab[i * 256 + tid] = row_rs(ssq, row_off + u.pm * 256 + tid);
    __syncthreads();
}
struct EpiSwiglu {
    static constexpr bool AFTER_DRAIN = false;
    bf16_t* O; const LAS float* rtab;
    __device__ __forceinline__ void operator()(ACC_ARG, const pg8::Unit& u, int wr, int wc, int fr, int fq) const {
        const int lr0 = wr * 64 + fr, col0 = u.pn * 128 + wc * 32 + 8 * fq;
#pragma unroll
        for (int ai = 0; ai < 2; ++ai)
#pragma unroll
            for (int m = 0; m < 4; ++m) {
                const int lr = lr0 + ai * 128 + m * 16;
                const float rs = rtab ? rtab[u.ri * 256 + lr] : 1.0f;
                u32x4 w;
#pragma unroll
                for (int n = 0; n < 2; ++n) {
                    const f32x4 gt = acc[ai][0][m][n] * rs, up = acc[ai][1][m][n] * rs; f32x4 v;
#pragma unroll
                    for (int j = 0; j < 4; ++j) v[j] = siluf(gt[j]) * up[j];
                    const u32x2 p = pack4(v); if (n == 0) { w.x = p.x; w.y = p.y; } else { w.z = p.x; w.w = p.y; }
                }
                *(u32x4*)(O + (size_t)(u.pm * 256 + lr) * DFF + col0) = w;
            }
    }
};
template <bool BB, bool OF>
struct EpiResid {
    static constexpr bool AFTER_DRAIN = true;
    const void* base; float* out; bf16_t* xb; float* ssq; float scale; int skip;
    __device__ __forceinline__ f32x4 ldb(size_t off) const {
        if (BB) { const u32x2 w = __builtin_nontemporal_load((const u32x2*)((const bf16_t*)base + off));
                  return (f32x4){__uint_as_float(w.x << 16), __uint_as_float(w.x & 0xffff0000u), __uint_as_float(w.y << 16), __uint_as_float(w.y & 0xffff0000u)}; }
        return __builtin_nontemporal_load((const f32x4*)((const float*)base + off));
    }
    __device__ __forceinline__ void operator()(ACC_ARG, const pg8::Unit& u, int wr, int wc, int fr, int fq) const {
        if (skip) return;
        const int row0 = u.pm * 256 + wr * 64 + fr, col0 = u.pn * 256 + wc * 32 + 4 * fq;
#pragma unroll
        for (int ai = 0; ai < 2; ++ai)
#pragma unroll
            for (int m = 0; m < 4; ++m) {
                const int row = row0 + ai * 128 + m * 16; float ss = 0.f;
#pragma unroll
                for (int bj = 0; bj < 2; ++bj)
#pragma unroll
                    for (int n = 0; n < 2; ++n) {
                        const size_t off = (size_t)row * DM + col0 + bj * 128 + n * 16;
                        const f32x4 v = ldb(off) + acc[ai][bj][m][n] * scale;
                        if (OF) *(f32x4*)(out + off) = v; else *(u32x2*)(xb + off) = pack4(v);
                        ss += (v[0] * v[0] + v[1] * v[1]) + (v[2] * v[2] + v[3] * v[3]);
                    }
                if (!OF) { ss += __shfl_xor(ss, 16); ss += __shfl_xor(ss, 32); if (fq == 0) atomicAdd(ssq + (size_t)row * 4 + u.pn, ss); }
            }
    }
    __device__ __forceinline__ void fused(ACC_ARG, const pg8::Unit& u, int wr, int wc, int fr, int fq, LAS unsigned char* lds) const {
        if (skip) return;
        const int tid = opaque_tid(), lane = tid & 63, wave = __builtin_amdgcn_readfirstlane(tid >> 6);
        LAS float* tl = (LAS float*)lds;
#pragma unroll
        for (int ai = 0; ai < 2; ++ai)
#pragma unroll
            for (int wq = 0; wq < 2; ++wq) {
                if (wr == wq) {
#pragma unroll
                    for (int m = 0; m < 4; ++m)
#pragma unroll
                        for (int bj = 0; bj < 2; ++bj)
#pragma unroll
                            for (int n = 0; n < 2; ++n) *(LAS f32x4*)(tl + (16 * m + fr) * 260 + bj * 128 + wc * 32 + n * 16 + 4 * fq) = acc[ai][bj][m][n] * scale;
                }
                __syncthreads();
                const int rbase = u.pm * 256 + ai * 128 + wq * 64;
                f32x4 bv[8];
#pragma unroll
                for (int r = 0; r < 8; ++r) bv[r] = ldb((size_t)(rbase + wave * 8 + r) * DM + u.pn * 256 + lane * 4);
#pragma unroll
                for (int r = 0; r < 8; ++r) {
                    const int row = rbase + wave * 8 + r; const size_t off = (size_t)row * DM + u.pn * 256 + lane * 4;
                    const f32x4 v = bv[r] + *(const LAS f32x4*)(tl + (wave * 8 + r) * 260 + lane * 4);
                    if (OF) __builtin_nontemporal_store(v, (f32x4*)(out + off));
                    else {
                        *(u32x2*)(xb + off) = pack4(v);
                        const float ss = wave_sum((v[0] * v[0] + v[1] * v[1]) + (v[2] * v[2] + v[3] * v[3])); if (lane == 0) ssq[(size_t)row * 4 + u.pn] = ss;
                    }
                }
                __syncthreads();
            }
    }
};
struct EpiPlain {
    static constexpr bool AFTER_DRAIN = false;
    bf16_t* O; int ldo;
    __device__ __forceinline__ void operator()(ACC_ARG, const pg8::Unit& u, int wr, int wc, int fr, int fq) const {
        const int row0 = u.pm * 256 + wr * 64 + fr, col0 = u.pn * 256 + wc * 32 + 4 * fq;
#pragma unroll
        for (int ai = 0; ai < 2; ++ai)
#pragma unroll
            for (int m = 0; m < 4; ++m)
#pragma unroll
                for (int bj = 0; bj < 2; ++bj)
#pragma unroll
                    for (int n = 0; n < 2; ++n) *(u32x2*)(O + (size_t)(row0 + ai * 128 + m * 16) * ldo + col0 + bj * 128 + n * 16) = pack4(acc[ai][bj][m][n]);
    }
};
struct EpiMix {
    static constexpr bool AFTER_DRAIN = true;
    const LAS float* rtab; const float* rot;
    unsigned char* ws  ; bf16_t* mqb  ; const float *gdq, *gdk;
    static constexpr int TLD = 136;
    __device__ __forceinline__ void flushT(bf16_t* dst  , const LAS bf16_t* TS) const {
        const int tid = opaque_tid();
#pragma unroll
        for (int i = 0; i < 8; ++i) { const int p = tid + 512 * i, c = p >> 4, r8 = p & 15; *(u32x4*)(dst + (size_t)c * SEQ + r8 * 8) = *(const LAS u32x4*)(TS + c * TLD + r8 * 8); }
    }
    __device__ __forceinline__ void operator()(ACC_ARG, const pg8::Unit& u, int wr, int wc, int fr, int fq) const { body(acc, u, wr, wc, fr, fq, nullptr); }
    __device__ __forceinline__ void fused(ACC_ARG, const pg8::Unit& u, int wr, int wc, int fr, int fq, LAS unsigned char* lds) const {
        if (u.pn >= 4 && u.pn < 16) body(acc, u, wr, wc, fr, fq, (LAS bf16_t*)lds); else body(acc, u, wr, wc, fr, fq, nullptr);
    }
    __device__ __forceinline__ void body(ACC_ARG, const pg8::Unit& u, int wr, int wc, int fr, int fq, LAS bf16_t* TS) const {
        const int pn = u.pn, lr0 = wr * 64 + fr, lrow0 = u.pm * 256 + lr0;
        if (pn < 8) {
            const bool isk = pn >= 4; const int h = pn & 3; bf16_t* dst = (bf16_t*)(ws + (isk ? WS_K : WS_Q)); bf16_t* kts = (bf16_t*)(ws + WS_KTS);
            const float lg2 = log2f(1.0f - __builtin_amdgcn_exp2f(-5.0f - (float)h));
#pragma unroll
            for (int ai = 0; ai < 2; ++ai) {
                f32x4 cs0[4][2], cs1[4][2];
#pragma unroll
                for (int m = 0; m < 4; ++m)
#pragma unroll
                    for (int n = 0; n < 2; ++n) { const f32x4* cs = (const f32x4*)(rot + ((size_t)(lrow0 + ai * 128 + m * 16) * 128 + wc * 32 + 8 * fq + 4 * n) * 2); cs0[m][n] = cs[0]; cs1[m][n] = cs[1]; }
                EPI_FENCE();
#pragma unroll
                for (int m = 0; m < 4; ++m) {
                    int lrow = lrow0 + ai * 128 + m * 16; asm volatile("" : "+v"(lrow));
                    const float rs = rtab[u.ri * 256 + lr0 + ai * 128 + m * 16] * (isk ? 0.0625f : 1.0f);
                    const float dec = __builtin_amdgcn_exp2f(lg2 * (float)(127 - (lrow & 127)));
#pragma unroll
                    for (int n = 0; n < 2; ++n) {
                        const int i0 = wc * 32 + 8 * fq + 4 * n;
                        const f32x4 c01 = cs0[m][n], c23 = cs1[m][n];
                        const f32x4 cv = (f32x4){c01[0], c01[2], c23[0], c23[2]}, sv = (f32x4){c01[1], c01[3], c23[1], c23[3]};
                        const f32x4 x1 = acc[ai][0][m][n] * rs, x2 = acc[ai][1][m][n] * rs;
                        const f32x4 o1 = x1 * cv - x2 * sv, o2 = x1 * sv + x2 * cv;
                        *(u32x2*)(dst + (size_t)lrow * 1024 + h * 256 + i0) = pack4(o1);
                        *(u32x2*)(dst + (size_t)lrow * 1024 + h * 256 + 128 + i0) = pack4(o2);
                        if (isk) {
                            if (TS) {
                                const int rl = wr * 64 + m * 16 + fr;
#pragma unroll
                                for (int j = 0; j < 4; ++j) { TS[(i0 + j) * TLD + rl] = bf16_1(o1[j] * dec); TS[(128 + i0 + j) * TLD + rl] = bf16_1(o2[j] * dec); }
                            } else {
#pragma unroll
                                for (int j = 0; j < 4; ++j) {
                                    kts[(size_t)(h * 256 + i0 + j) * SEQ + lrow] = bf16_1(o1[j] * dec);
                                    kts[(size_t)(h * 256 + 128 + i0 + j) * SEQ + lrow] = bf16_1(o2[j] * dec);
                                }
                            }
                        }
                    }
                }
                EPI_FENCE();
                if (isk && TS) { __syncthreads(); flushT(kts + (size_t)(h * 256) * SEQ + u.pm * 256 + ai * 128, TS); __syncthreads(); }
            }
        } else if (pn < 16) {
            const int h = (pn - 8) >> 1, e0 = ((pn - 8) & 1) * 256; bf16_t* vt = (bf16_t*)(ws + WS_VT);
#pragma unroll
            for (int ai = 0; ai < 2; ++ai) {
#pragma unroll
                for (int m = 0; m < 4; ++m) {
                    int lrow = lrow0 + ai * 128 + m * 16; asm volatile("" : "+v"(lrow));
                    const float rs = rtab[u.ri * 256 + lr0 + ai * 128 + m * 16];
#pragma unroll
                    for (int bj = 0; bj < 2; ++bj)
#pragma unroll
                        for (int n = 0; n < 2; ++n) {
                            const int tc = bj * 128 + wc * 32 + 8 * fq + 4 * n, ec = e0 + tc; const f32x4 v = acc[ai][bj][m][n] * rs;
                            if (TS) {
                                const int rl = wr * 64 + m * 16 + fr;
#pragma unroll
                                for (int j = 0; j < 4; ++j) TS[(tc + j) * TLD + rl] = bf16_1(v[j]);
                            } else {
#pragma unroll
                                for (int j = 0; j < 4; ++j) vt[(size_t)(h * 512 + ec + j) * SEQ + lrow] = bf16_1(v[j]);
                            }
                        }
                    EPI_FENCE();
                }
                if (TS) { __syncthreads(); flushT(vt + (size_t)(h * 512 + e0) * SEQ + u.pm * 256 + ai * 128, TS); __syncthreads(); }
            }
        } else if (pn < 24) {
            const bool isk = pn >= 20; const int tile = (pn - 16) & 3; bf16_t* dst = (bf16_t*)(ws + (isk ? WS_DK : WS_DQ)); const float* gn = isk ? gdk : gdq; const float mul = isk ? 1.0f : C2Q;
            f32x4 gv[2][2];
#pragma unroll
            for (int bj = 0; bj < 2; ++bj)
#pragma unroll
                for (int n = 0; n < 2; ++n) gv[bj][n] = *(const f32x4*)(gn + 32 * bj + 8 * fq + 4 * n);
#pragma unroll
            for (int ai = 0; ai < 2; ++ai)
#pragma unroll
                for (int m = 0; m < 4; ++m) {
                    int lrow = lrow0 + ai * 128 + m * 16; asm volatile("" : "+v"(lrow));
                    const float rs = rtab[u.ri * 256 + lr0 + ai * 128 + m * 16];
                    f32x4 v[2][2]; float ss = 0.f;
#pragma unroll
                    for (int bj = 0; bj < 2; ++bj)
#pragma unroll
                        for (int n = 0; n < 2; ++n) { v[bj][n] = acc[ai][bj][m][n] * rs; const f32x4 t = v[bj][n]; ss += (t[0] * t[0] + t[1] * t[1]) + (t[2] * t[2] + t[3] * t[3]); }
                    ss += __shfl_xor(ss, 16); ss += __shfl_xor(ss, 32);
                    const float rn = __builtin_amdgcn_rsqf(ss * (1.0f / 64.0f) + EPS) * mul;
#pragma unroll
                    for (int bj = 0; bj < 2; ++bj) { const u32x2 p0 = pack4(v[bj][0] * rn * gv[bj][0]), p1 = pack4(v[bj][1] * rn * gv[bj][1]);
                        *(u32x4*)(dst + (size_t)lrow * 1024 + tile * 256 + 64 * wc + 32 * bj + 8 * fq) = (u32x4){p0.x, p0.y, p1.x, p1.y}; }
                    EPI_FENCE();
                }
        } else {
            bf16_t* dst = pn < 28 ? (bf16_t*)(ws + WS_DV) : mqb; const int tile = (pn - 24) & 3;
#pragma unroll
            for (int ai = 0; ai < 2; ++ai)
#pragma unroll
                for (int m = 0; m < 4; ++m) {
                    int lrow = lrow0 + ai * 128 + m * 16; asm volatile("" : "+v"(lrow));
                    const float rs = rtab[u.ri * 256 + lr0 + ai * 128 + m * 16];
#pragma unroll
                    for (int bj = 0; bj < 2; ++bj) { const u32x2 p0 = pack4(acc[ai][bj][m][0] * rs), p1 = pack4(acc[ai][bj][m][1] * rs);
                        *(u32x4*)(dst + (size_t)lrow * 1024 + tile * 256 + bj * 128 + wc * 32 + 8 * fq) = (u32x4){p0.x, p0.y, p1.x, p1.y}; }
                    EPI_FENCE();
                }
        }
    }
};
struct EpiRgG {
    static constexpr bool AFTER_DRAIN = false;
    const LAS float* rtab; bf16_t* ret; const float* rssq; unsigned char* ws;
    __device__ __forceinline__ void operator()(ACC_ARG, const pg8::Unit& u, int wr, int wc, int fr, int fq) const {
        const int lr0 = wr * 64 + fr;
        if (u.pn < 8) {
            const int col0 = u.pn * 256 + wc * 32 + 8 * fq;
#pragma unroll
            for (int ai = 0; ai < 2; ++ai) {
                u32x4 rv[4][2]; f32x2 rq2[4];
#pragma unroll
                for (int m = 0; m < 4; ++m) { const int lr = lr0 + ai * 128 + m * 16;
                    rq2[m] = *(const f32x2*)(rssq + (size_t)(u.pm * 256 + lr) * 8 + 2 * (u.pn >> 1));
#pragma unroll
                    for (int bj = 0; bj < 2; ++bj) rv[m][bj] = *(const u32x4*)(ret + (size_t)(u.pm * 256 + lr) * 2048 + col0 + bj * 128); }
                EPI_FENCE();
#pragma unroll
                for (int m = 0; m < 4; ++m) {
                    const int lr = lr0 + ai * 128 + m * 16; const float rs = rtab[u.ri * 256 + lr];
                    const float rr = __builtin_amdgcn_rsqf((rq2[m][0] + rq2[m][1]) * (1.0f / 512.0f) + EPS);
#pragma unroll
                    for (int bj = 0; bj < 2; ++bj) {
                        u32x4 o;
#pragma unroll
                        for (int n = 0; n < 2; ++n) {
                            const unsigned w0 = n == 0 ? rv[m][bj].x : rv[m][bj].z, w1 = n == 0 ? rv[m][bj].y : rv[m][bj].w; const f32x4 a = acc[ai][bj][m][n] * rs; f32x4 v;
                            v[0] = __uint_as_float(w0 << 16) * siluf(a[0]); v[1] = __uint_as_float(w0 & 0xffff0000u) * siluf(a[1]);
                            v[2] = __uint_as_float(w1 << 16) * siluf(a[2]); v[3] = __uint_as_float(w1 & 0xffff0000u) * siluf(a[3]);
                            const u32x2 p = pack4(v * rr); if (n == 0) { o.x = p.x; o.y = p.y; } else { o.z = p.x; o.w = p.y; }
                        }
                        *(u32x4*)(ret + (size_t)(u.pm * 256 + lr) * 2048 + col0 + bj * 128) = o;
                    }
                }
                EPI_FENCE();
            }
        } else {
            const int br = (u.pn - 8) >> 2, col0 = ((u.pn - 8) & 3) * 256 + wc * 32 + 8 * fq;
            unsigned char* g8 = ws + (br == 0 ? WS_G8A : br == 1 ? WS_G8B : WS_G8C);
#pragma unroll
            for (int ai = 0; ai < 2; ++ai)
#pragma unroll
                for (int m = 0; m < 4; ++m) {
                    const int lr = lr0 + ai * 128 + m * 16; const float rs = rtab[u.ri * 256 + lr];
#pragma unroll
                    for (int bj = 0; bj < 2; ++bj) {
                        u32x2 w2;
#pragma unroll
                        for (int n = 0; n < 2; ++n) {
                            const f32x4 a = acc[ai][bj][m][n] * rs; unsigned w = 0u;
#pragma unroll
                            for (int j = 0; j < 4; ++j) w |= (unsigned)__builtin_rintf(255.0f * sigmf(a[j])) << (8 * j);
                            if (n == 0) w2.x = w; else w2.y = w;
                        }
                        *(u32x2*)(g8 + (size_t)(u.pm * 256 + lr) * DM + col0 + bj * 128) = w2;
                    }
                }
        }
    }
};
struct EpiTerm3 {
    static constexpr bool AFTER_DRAIN = false;
    unsigned char* ws; bf16_t* y;
    __device__ __forceinline__ void operator()(ACC_ARG, const pg8::Unit& u, int wr, int wc, int fr, int fq) const {
        const int lr0 = wr * 64 + fr, col0 = u.pn * 256 + wc * 32 + 8 * fq, first = (u.tag == 0);
        const unsigned char* g8 = ws + (u.tag == 0 ? WS_G8A : u.tag == 1 ? WS_G8B : WS_G8C);
#pragma unroll
        for (int ai = 0; ai < 2; ++ai) {
            u32x2 gv[4][2]; u32x4 yv[4][2];
#pragma unroll
            for (int m = 0; m < 4; ++m)
#pragma unroll
                for (int bj = 0; bj < 2; ++bj) { const size_t off = (size_t)(u.pm * 256 + lr0 + ai * 128 + m * 16) * DM + col0 + bj * 128;
                    gv[m][bj] = *(const u32x2*)(g8 + off); yv[m][bj] = first ? (u32x4){0u, 0u, 0u, 0u} : *(const u32x4*)(y + off); }
            EPI_FENCE();
#pragma unroll
            for (int m = 0; m < 4; ++m)
#pragma unroll
                for (int bj = 0; bj < 2; ++bj) {
                    const size_t off = (size_t)(u.pm * 256 + lr0 + ai * 128 + m * 16) * DM + col0 + bj * 128;
                    u32x4 o;
#pragma unroll
                    for (int n = 0; n < 2; ++n) {
                        const f32x4 a = acc[ai][bj][m][n]; const unsigned gw = n == 0 ? gv[m][bj].x : gv[m][bj].y; const unsigned w0 = n == 0 ? yv[m][bj].x : yv[m][bj].z, w1 = n == 0 ? yv[m][bj].y : yv[m][bj].w; f32x4 v;
                        v[0] = (float)(gw & 255u) * (1.0f / 255.0f) * a[0] + __uint_as_float(w0 << 16); v[1] = (float)((gw >> 8) & 255u) * (1.0f / 255.0f) * a[1] + __uint_as_float(w0 & 0xffff0000u);
                        v[2] = (float)((gw >> 16) & 255u) * (1.0f / 255.0f) * a[2] + __uint_as_float(w1 << 16); v[3] = (float)(gw >> 24) * (1.0f / 255.0f) * a[3] + __uint_as_float(w1 & 0xffff0000u);
                        const u32x2 p = pack4(v); if (n == 0) { o.x = p.x; o.y = p.y; } else { o.z = p.x; o.w = p.y; }
                    }
                    *(u32x4*)(y + off) = o;
                }
            EPI_FENCE();
        }
    }
};

#include <hip/hip_bf16.h>
namespace attn_body {
using bf16=__hip_bfloat16;
using bf16x8=__attribute__((ext_vector_type(8)))short;
using s16x4=__attribute__((ext_vector_type(4)))short;
using f32x16=__attribute__((ext_vector_type(16)))float;
using u32x4=__attribute__((ext_vector_type(4)))unsigned;
constexpr int D=64,DM=1024;
constexpr int NW=8,QBLK=32,QB=QBLK*NW,KVBLK=64;
__device__ __forceinline__ int crow(int r,int hi){return (r&3)+8*(r>>2)+4*hi;}
#define SBAR() __builtin_amdgcn_sched_barrier(0)
__device__ __forceinline__ void cmask(f32x16&p0,f32x16&p1,int jb,int qrel,int hi){
  const float NEG=-INFINITY; int kb=64*jb+4*hi;
  #pragma unroll
  for(int r=0;r<16;++r){int kv=kb+(r&3)+8*(r>>2); if(kv>qrel)p0[r]=NEG; if(kv+32>qrel)p1[r]=NEG;}
}
constexpr int NSLOT=3, SLOTB=8192;
constexpr int LDS_K=0, LDS_V=NSLOT*SLOTB, LDS_WS=LDS_V+2*NSLOT*SLOTB, LDS_OST=LDS_WS+NW*64*4, LDS_BYTES=LDS_OST+NW*4096;
__device__ __forceinline__ void glds16(const void*gsrc,unsigned lds_dst){unsigned keep;
  asm volatile("s_mov_b32 %0, m0\n\ts_mov_b32 m0, %2\n\ts_nop 0\n\tglobal_load_lds_dwordx4 %1, off\n\ts_mov_b32 m0, %0":"=&s"(keep):"v"(gsrc),"s"(lds_dst):"memory");}
__device__ __forceinline__ float max3f(float a,float b,float c){float r;asm("v_max3_f32 %0, %1, %2, %3":"=v"(r):"v"(a),"v"(b),"v"(c));return r;}
__device__ __forceinline__ float max2f(float a,float b){float r;asm("v_max_f32_e32 %0, %1, %2":"=v"(r):"v"(a),"v"(b));return r;}
__device__ __forceinline__ float fadd_s(float a,float b){float r;asm("v_add_f32_e32 %0, %1, %2":"=v"(r):"v"(a),"v"(b));return r;}
__device__ __forceinline__ float fsub_s(float a,float b){float r;asm("v_sub_f32_e32 %0, %1, %2":"=v"(r):"v"(a),"v"(b));return r;}
typedef float f32x2_t __attribute__((ext_vector_type(2))); typedef __bf16 bf16x2_t __attribute__((ext_vector_type(2)));
__device__ __forceinline__ unsigned cvtpk_s(float lo,float hi){f32x2_t v={lo,hi};bf16x2_t b=__builtin_convertvector(v,bf16x2_t);return __builtin_bit_cast(unsigned,b);}
#define WAIT_BAR(N) asm volatile("s_waitcnt vmcnt(" #N ") lgkmcnt(0)\n\ts_barrier":::"memory")
__device__ __forceinline__ void qkt(f32x16&p0,f32x16&p1,const char*Kslot,const bf16x8*qr,const f32x16&negm,int r32,int hi){
  const char*kb=Kslot+hi*1024+r32*16;
  #pragma unroll
  for(int d0=0;d0<4;++d0){
    const bf16x8 b0=*reinterpret_cast<const bf16x8*>(kb+d0*2048);
    const bf16x8 b1=*reinterpret_cast<const bf16x8*>(kb+d0*2048+512);
    if(d0==0){p0=__builtin_amdgcn_mfma_f32_32x32x16_bf16(b0,qr[0],negm,0,0,0);p1=__builtin_amdgcn_mfma_f32_32x32x16_bf16(b1,qr[0],negm,0,0,0);}
    else{p0=__builtin_amdgcn_mfma_f32_32x32x16_bf16(b0,qr[d0],p0,0,0,0);p1=__builtin_amdgcn_mfma_f32_32x32x16_bf16(b1,qr[d0],p1,0,0,0);}}
}
typedef __attribute__((address_space(3))) const char* lds_cptr;
typedef short v4i16_t __attribute__((ext_vector_type(4)));
__device__ __forceinline__ void kload8(bf16x8*kf,lds_cptr kp){
  kf[0]=*(const __attribute__((address_space(3))) bf16x8*)(kp);      kf[1]=*(const __attribute__((address_space(3))) bf16x8*)(kp+512);
  kf[2]=*(const __attribute__((address_space(3))) bf16x8*)(kp+2048); kf[3]=*(const __attribute__((address_space(3))) bf16x8*)(kp+2560);
  kf[4]=*(const __attribute__((address_space(3))) bf16x8*)(kp+4096); kf[5]=*(const __attribute__((address_space(3))) bf16x8*)(kp+4608);
  kf[6]=*(const __attribute__((address_space(3))) bf16x8*)(kp+6144); kf[7]=*(const __attribute__((address_space(3))) bf16x8*)(kp+6656);
}
__device__ __forceinline__ void kload2(bf16x8*kf,lds_cptr kp,int j){ kf[2*j]=*(const __attribute__((address_space(3))) bf16x8*)(kp+j*2048); kf[2*j+1]=*(const __attribute__((address_space(3))) bf16x8*)(kp+j*2048+512); }
__device__ __forceinline__ s16x4 vtr(lds_cptr p){ return __builtin_bit_cast(s16x4,__builtin_amdgcn_ds_read_tr16_b64_v4i16((__attribute__((address_space(3))) v4i16_t*)p)); }
__device__ __forceinline__ float rowmax(const f32x16&p0,const f32x16&p1){
  float a=max3f(p0[0],p0[1],p1[0]),b=max3f(p0[2],p0[3],p1[1]);a=max3f(a,p1[2],p1[3]);
  #pragma unroll
  for(int r=4;r<16;r+=4){a=max3f(a,p0[r],p0[r+1]);b=max3f(b,p0[r+2],p0[r+3]);a=max3f(a,p1[r],p1[r+1]);b=max3f(b,p1[r+2],p1[r+3]);}
  const float m=max2f(a,b);
  auto rr=__builtin_amdgcn_permlane32_swap(__float_as_uint(m),__float_as_uint(m),false,false);
  return max2f(__uint_as_float(rr[0]),__uint_as_float(rr[1]));
}
__device__ __forceinline__ void pv(f32x16*o,int vb,bf16x8 pa0,bf16x8 pa1,bf16x8 pa2,bf16x8 pa3){
  #pragma unroll
  for(int d0=0;d0<4;++d0){s16x4 lo[4],hi[4];
    #pragma unroll
    for(int ks=0;ks<4;++ks){
      asm volatile("ds_read_b64_tr_b16 %0,%1 offset:%c2":"=&v"(lo[ks]):"v"(vb),"i"(d0*4096+ks*1024):"memory");
      asm volatile("ds_read_b64_tr_b16 %0,%1 offset:%c2":"=&v"(hi[ks]):"v"(vb),"i"(d0*4096+ks*1024+512):"memory");}
    asm volatile("s_waitcnt lgkmcnt(0)":::"memory");SBAR();
    #define PK(k) (bf16x8){lo[k][0],lo[k][1],lo[k][2],lo[k][3],hi[k][0],hi[k][1],hi[k][2],hi[k][3]}
    o[d0]=__builtin_amdgcn_mfma_f32_32x32x16_bf16(pa0,PK(0),o[d0],0,0,0);
    o[d0]=__builtin_amdgcn_mfma_f32_32x32x16_bf16(pa1,PK(1),o[d0],0,0,0);
    o[d0]=__builtin_amdgcn_mfma_f32_32x32x16_bf16(pa2,PK(2),o[d0],0,0,0);
    o[d0]=__builtin_amdgcn_mfma_f32_32x32x16_bf16(pa3,PK(3),o[d0],0,0,0);
    #undef PK
  }
}
#define ATTN_STORE16(p,v) (*(u32x4*)(p)=(v))
template<int THRL> __device__ __forceinline__ void attn_unit(int hq,int hv,int qb,const bf16*Q,const bf16*__restrict__ K,const bf16*__restrict__ V,bf16*O,char*shm){
  const int tid=opaque_tid(),lane=tid&63,r32=lane&31,hi=lane>>5; const int wid=__builtin_amdgcn_readfirstlane(tid>>6);
  const int q0=qb*QB;
  const bf16*Qw=Q+(long)(q0+wid*QBLK)*DM+hq*D;
  const bf16*Kh=K+hq*D,*Vh=V+hv*128;
  const unsigned lds0=(unsigned)(uintptr_t)shm;
  float*wsf=(float*)(shm+LDS_WS)+wid*64;
  const bf16*ksrc=Kh+(long)lane*DM+wid*8;
  const bf16*vsrc=Vh+(long)(16*(wid&3)+(lane>>2))*DM+(wid>>2)*32+(lane&3)*8;
  const unsigned kdst=lds0+LDS_K+wid*1024, vdst=lds0+LDS_V+wid*1024;
  #define DMA_K(t,slot) glds16(ksrc+(long)(t)*KVBLK*DM,(unsigned)__builtin_amdgcn_readfirstlane(kdst+(slot)))
  #define DMA_V(t,slot) do{ glds16(vsrc+(long)(t)*KVBLK*DM,(unsigned)__builtin_amdgcn_readfirstlane(vdst+2*(slot))); glds16(vsrc+(long)(t)*KVBLK*DM+64,(unsigned)__builtin_amdgcn_readfirstlane(vdst+2*(slot)+8192)); }while(0)
  const int vb0=(int)(lds0+LDS_V)+((lane>>4)&1)*32+(lane&3)*8+(4*hi+((lane&15)>>2))*64;
  const char*Kbase=shm+LDS_K; bf16x8 kf[8];
  const lds_cptr shm3=(lds_cptr)shm; const lds_cptr kp0=shm3+LDS_K+hi*1024+r32*16; const lds_cptr vp0=shm3+LDS_V+((lane>>4)&1)*32+(lane&3)*8+(4*hi+((lane&15)>>2))*64;
  const int NT=(q0+QB)/KVBLK;
  DMA_K(0,0);DMA_V(0,0);DMA_K(1,SLOTB);
  bf16x8 qr[4];
  #pragma unroll
  for(int d0=0;d0<4;++d0)qr[d0]=*reinterpret_cast<const bf16x8*>(&Qw[(long)r32*DM+d0*16+hi*8]);
  float mhat=0.f,l_reg=0.f;f32x16 o[4];o[0]=f32x16{};o[1]=f32x16{};o[2]=f32x16{};o[3]=f32x16{};asm volatile("":"+v"(o[0]),"+v"(o[1]),"+v"(o[2]),"+v"(o[3]));f32x16 negm=f32x16{};asm volatile("":"+v"(negm));
  const int qrel=wid*QBLK+r32;
  #define CMASK(P0,P1,t) do{int jb_=(t)-(NT-4); if(jb_>=0)cmask(P0,P1,jb_,qrel,hi);}while(0)
  bool resc=false;
  #define START(P0,P1) do{ const float rm=rowmax(P0,P1); resc=false; \
    { const float dl=rm; mhat=fadd_s(mhat,dl); \
      _Pragma("unroll") for(int r=0;r<16;++r){P0[r]=fsub_s(P0[r],dl);P1[r]=fsub_s(P1[r],dl);} \
      _Pragma("unroll") for(int r=0;r<16;++r)negm[r]=-mhat; asm volatile("":"+v"(negm)); } \
    _Pragma("unroll") for(int r=0;r<16;++r)P0[r]=__builtin_amdgcn_exp2f(P0[r]); }while(0)
  #define RESC() do{ if(resc){ asm volatile("s_waitcnt lgkmcnt(0)":::"memory"); \
      _Pragma("unroll") for(int d_=0;d_<4;++d_) _Pragma("unroll") for(int r=0;r<16;++r)o[d_][r]*=wsf[crow(r,hi)]; } }while(0)
  f32x16 pA0,pA1,pB0,pB1;
  int sl_prev=0,sl_cur=0,sl_next=SLOTB;
  #define ROT() do{sl_prev=sl_cur;sl_cur=sl_next;sl_next=(sl_next==(NSLOT-1)*SLOTB)?0:sl_next+SLOTB;}while(0)
  DMA_K(2,2*SLOTB);
  WAIT_BAR(3);
  qkt(pA0,pA1,Kbase,qr,negm,r32,hi);asm volatile("s_nop 15\n\ts_nop 7":"+v"(pA0),"+v"(pA1));CMASK(pA0,pA1,0);
  START(pA0,pA1);
  _Pragma("unroll") for(int r=0;r<16;++r)pA1[r]=__builtin_amdgcn_exp2f(pA1[r]);
  WAIT_BAR(0);
  DMA_K(3,0);DMA_V(1,SLOTB);
  ROT();
  kload8(kf,kp0+sl_cur);
  WAIT_BAR(3);
  s16x4 vlo[16],vhi[16]; u32x4 pw0,pw1,pw2,pw3;
  #define PKW(P,B) cvtpk_s(P[B],P[B+1])
  #define PAF(k) __builtin_bit_cast(bf16x8,pw##k)
  #define VFR(i) (bf16x8){vlo[i][0],vlo[i][1],vlo[i][2],vlo[i][3],vhi[i][0],vhi[i][1],vhi[i][2],vhi[i][3]}
  #define PIN(x) asm volatile("":"+v"(x))
  #define MX3(a,b,c) __builtin_fmaxf(__builtin_fmaxf((a),(b)),(c))
  #define GAPA(MF,A0,A1,A2,A3,W0,W1,PW) do{ MF; sacc+=A0; sacc+=A1; sacc+=A2; sacc+=A3; PIN(sacc); W0; W1; PIN(PW); SBAR(); }while(0)
  #define EX(v) __builtin_amdgcn_exp2f(v)
  #define GAPB(MF,X,B) do{ MF; X[B]=EX(X[B]); X[B+1]=EX(X[B+1]); PIN(X); SBAR(); }while(0)
  #define VRD(i) do{ vlo[i]=vtr(vp_+(((i)>>2)*4096+((i)&3)*1024)); vhi[i]=vtr(vp_+(((i)>>2)*4096+((i)&3)*1024+512)); }while(0)
  #define KRD(G,j) do{ if(G){ kload2(kf,kp0+sl_next,j); SBAR(); } }while(0)
  #define STEP(C0,C1,P0,P1,t,GK,GV,GL) do{ SBAR(); \
    const lds_cptr vp_=vp0+2*sl_prev; \
    float sacc=(P0[0]+P0[1]); \
    GAPA(C0=__builtin_amdgcn_mfma_f32_32x32x16_bf16(kf[0],qr[0],negm,0,0,0), P0[2],P0[3],P0[4],P0[5],     pw0[0]=PKW(P0,0), pw0[1]=PKW(P0,2), pw0); \
    GAPA(C1=__builtin_amdgcn_mfma_f32_32x32x16_bf16(kf[1],qr[0],negm,0,0,0), P0[6],P0[7],P0[8],P0[9],     pw0[2]=PKW(P0,4), pw0[3]=PKW(P0,6), pw0); \
    GAPA(C0=__builtin_amdgcn_mfma_f32_32x32x16_bf16(kf[2],qr[1],C0,0,0,0),   P0[10],P0[11],P0[12],P0[13], pw1[0]=PKW(P0,8), pw1[1]=PKW(P0,10), pw1); \
    GAPA(C1=__builtin_amdgcn_mfma_f32_32x32x16_bf16(kf[3],qr[1],C1,0,0,0),   P0[14],P0[15],P1[0],P1[1],   pw1[2]=PKW(P0,12),pw1[3]=PKW(P0,14), pw1); \
    GAPA(C0=__builtin_amdgcn_mfma_f32_32x32x16_bf16(kf[4],qr[2],C0,0,0,0),   P1[2],P1[3],P1[4],P1[5],     pw2[0]=PKW(P1,0), pw2[1]=PKW(P1,2), pw2); \
    GAPA(C1=__builtin_amdgcn_mfma_f32_32x32x16_bf16(kf[5],qr[2],C1,0,0,0),   P1[6],P1[7],P1[8],P1[9],     pw2[2]=PKW(P1,4), pw2[3]=PKW(P1,6), pw2); \
    GAPA(C0=__builtin_amdgcn_mfma_f32_32x32x16_bf16(kf[6],qr[3],C0,0,0,0),   P1[10],P1[11],P1[12],P1[13], pw3[0]=PKW(P1,8), pw3[1]=PKW(P1,10), pw3); \
    GAPA(C1=__builtin_amdgcn_mfma_f32_32x32x16_bf16(kf[7],qr[3],C1,0,0,0),   P1[14],P1[15],0.f,0.f,       pw3[2]=PKW(P1,12),pw3[3]=PKW(P1,14), pw3); \
    VRD(0); VRD(4); VRD(8); VRD(12); VRD(1); VRD(5); VRD(9); VRD(13); SBAR(); \
    l_reg+=sacc; \
    if(GK){DMA_K((t)+3,sl_cur);} if(GV){DMA_V((t)+1,sl_next);} \
    CMASK(C0,C1,t); \
    { float a=MX3(C0[0],C0[1],C1[0]),b=MX3(C0[2],C0[3],C1[1]); a=MX3(a,C1[2],C1[3]); \
      _Pragma("unroll") for(int r=4;r<16;r+=4){a=MX3(a,C0[r],C0[r+1]);b=MX3(b,C0[r+2],C0[r+3]);a=MX3(a,C1[r],C1[r+1]);b=MX3(b,C1[r+2],C1[r+3]);} \
      float rm=__builtin_fmaxf(a,b); { auto rr=__builtin_amdgcn_permlane32_swap(__float_as_uint(rm),__float_as_uint(rm),false,false); rm=__builtin_fmaxf(__uint_as_float(rr[0]),__uint_as_float(rr[1])); } \
      resc=false; \
      if(__builtin_expect(__any(rm>(float)THRL),0)){ const float dl=__builtin_fmaxf(rm,0.f); mhat+=dl; \
        _Pragma("unroll") for(int r=0;r<16;++r){C0[r]-=dl;C1[r]-=dl;} \
        _Pragma("unroll") for(int r=0;r<16;++r)negm[r]=-mhat; asm volatile("":"+v"(negm)); \
        const float f=__builtin_amdgcn_exp2f(-dl); l_reg*=f; if(hi==0)wsf[r32]=f; resc=true; } } \
    SBAR(); \
    GAPB(o[0]=__builtin_amdgcn_mfma_f32_32x32x16_bf16(PAF(0),VFR(0),o[0],0,0,0),  C0,0);  VRD(2);  SBAR(); \
    GAPB(o[1]=__builtin_amdgcn_mfma_f32_32x32x16_bf16(PAF(0),VFR(4),o[1],0,0,0),  C0,2);  VRD(6);  SBAR(); \
    GAPB(o[2]=__builtin_amdgcn_mfma_f32_32x32x16_bf16(PAF(0),VFR(8),o[2],0,0,0),  C0,4);  VRD(10); SBAR(); \
    GAPB(o[3]=__builtin_amdgcn_mfma_f32_32x32x16_bf16(PAF(0),VFR(12),o[3],0,0,0), C0,6);  VRD(14); SBAR(); \
    GAPB(o[0]=__builtin_amdgcn_mfma_f32_32x32x16_bf16(PAF(1),VFR(1),o[0],0,0,0),  C0,8);  VRD(3);  SBAR(); \
    GAPB(o[1]=__builtin_amdgcn_mfma_f32_32x32x16_bf16(PAF(1),VFR(5),o[1],0,0,0),  C0,10); VRD(7);  SBAR(); \
    GAPB(o[2]=__builtin_amdgcn_mfma_f32_32x32x16_bf16(PAF(1),VFR(9),o[2],0,0,0),  C0,12); VRD(11); SBAR(); \
    GAPB(o[3]=__builtin_amdgcn_mfma_f32_32x32x16_bf16(PAF(1),VFR(13),o[3],0,0,0), C0,14); VRD(15); SBAR(); \
    KRD(GL,0); GAPB(o[0]=__builtin_amdgcn_mfma_f32_32x32x16_bf16(PAF(2),VFR(2),o[0],0,0,0),  C1,0); \
    KRD(GL,1); GAPB(o[1]=__builtin_amdgcn_mfma_f32_32x32x16_bf16(PAF(2),VFR(6),o[1],0,0,0),  C1,2); \
    KRD(GL,2); GAPB(o[2]=__builtin_amdgcn_mfma_f32_32x32x16_bf16(PAF(2),VFR(10),o[2],0,0,0), C1,4); \
    KRD(GL,3); GAPB(o[3]=__builtin_amdgcn_mfma_f32_32x32x16_bf16(PAF(2),VFR(14),o[3],0,0,0), C1,6); \
    GAPB(o[0]=__builtin_amdgcn_mfma_f32_32x32x16_bf16(PAF(3),VFR(3),o[0],0,0,0),  C1,8); \
    GAPB(o[1]=__builtin_amdgcn_mfma_f32_32x32x16_bf16(PAF(3),VFR(7),o[1],0,0,0),  C1,10); \
    GAPB(o[2]=__builtin_amdgcn_mfma_f32_32x32x16_bf16(PAF(3),VFR(11),o[2],0,0,0), C1,12); \
    GAPB(o[3]=__builtin_amdgcn_mfma_f32_32x32x16_bf16(PAF(3),VFR(15),o[3],0,0,0), C1,14); \
    }while(0)
  int t=1;
  #undef CMASK
  #define CMASK(P0,P1,t) do{}while(0)
  for(;t+5<NT;t+=2){
    STEP(pB0,pB1,pA0,pA1,t,true,true,true);     WAIT_BAR(3); RESC(); ROT();
    STEP(pA0,pA1,pB0,pB1,t+1,true,true,true);   WAIT_BAR(3); RESC(); ROT();
  }
  #undef CMASK
  #define CMASK(P0,P1,t) do{int jb_=(t)-(NT-4); if(jb_>=0)cmask(P0,P1,jb_,qrel,hi);}while(0)
  #define ENDW(tt) do{ if((tt)+3<NT){WAIT_BAR(3);} else if((tt)+2<NT){WAIT_BAR(2);} else {WAIT_BAR(0);} }while(0)
  for(;t+1<NT;t+=2){
    STEP(pB0,pB1,pA0,pA1,t,(t+3<NT),(t+1<NT),(t+1<NT));       ENDW(t);   RESC(); ROT();
    STEP(pA0,pA1,pB0,pB1,t+1,(t+4<NT),(t+2<NT),(t+2<NT));     ENDW(t+1); RESC(); ROT();
  }
  STEP(pB0,pB1,pA0,pA1,NT-1,false,false,false); RESC();
  { float sacc=pB0[0]+pB0[1]; _Pragma("unroll") for(int r=2;r<16;++r)sacc+=pB0[r]; _Pragma("unroll") for(int r=0;r<16;++r)sacc+=pB1[r]; l_reg+=sacc;
    pw0=(u32x4){PKW(pB0,0),PKW(pB0,2),PKW(pB0,4),PKW(pB0,6)};pw1=(u32x4){PKW(pB0,8),PKW(pB0,10),PKW(pB0,12),PKW(pB0,14)};pw2=(u32x4){PKW(pB1,0),PKW(pB1,2),PKW(pB1,4),PKW(pB1,6)};pw3=(u32x4){PKW(pB1,8),PKW(pB1,10),PKW(pB1,12),PKW(pB1,14)};
    SBAR(); pv(o,vb0+2*sl_cur,PAF(0),PAF(1),PAF(2),PAF(3)); }
  #undef PKW
  #undef PAF
  #undef VFR
  #undef PIN
  #undef MX3
  #undef GAPA
  #undef GAPB
  #undef EX
  #undef VRD
  #undef KRD
  #undef STEP
  #undef ENDW
  {auto rr=__builtin_amdgcn_permlane32_swap(__float_as_uint(l_reg),__float_as_uint(l_reg),false,false);l_reg=__uint_as_float(rr[0])+__uint_as_float(rr[1]);}
  if(hi==0)wsf[32+r32]=l_reg;asm volatile("s_waitcnt lgkmcnt(0)":::"memory");
  float rli[16];
  #pragma unroll
  for(int r=0;r<16;++r)rli[r]=__builtin_amdgcn_rcpf(wsf[32+crow(r,hi)]);
  bf16*Ow=O+(long)(q0+wid*QBLK)*DM+hv*128;
  { bf16*stg=(bf16*)(shm+LDS_OST)+wid*2048;
    #pragma unroll
    for(int hf=0;hf<2;++hf){
      #pragma unroll
      for(int r=0;r<16;++r){const int orow=crow(r,hi);
        #pragma unroll
        for(int d0=0;d0<2;++d0)stg[orow*64+d0*32+r32]=__float2bfloat16(o[2*hf+d0][r]*rli[r]);}
      asm volatile("s_waitcnt lgkmcnt(0)":::"memory");
      u32x4 v4[4];
      #pragma unroll
      for(int i=0;i<4;++i){const int row=i*8+(lane>>3),ch=lane&7; v4[i]=*(const u32x4*)(stg+row*64+ch*8);}
      asm volatile("s_waitcnt lgkmcnt(0)":::"memory");
      #pragma unroll
      for(int i=0;i<4;++i){const int row=i*8+(lane>>3),ch=lane&7; ATTN_STORE16(Ow+(long)row*DM+hf*64+ch*8,v4[i]);} } }
  asm volatile("s_waitcnt lgkmcnt(0)\n\ts_barrier":::"memory");
  #undef DMA_K
  #undef DMA_V
  #undef CMASK
  #undef START
  #undef RESC
  #undef ROT
}
constexpr int ATTN_LDS_BYTES=LDS_BYTES;
#undef SBAR
#undef WAIT_BAR
}

typedef GAS unsigned gu32;
#define RLX_AGENT __ATOMIC_RELAXED, __HIP_MEMORY_SCOPE_AGENT
#define LDS_WAIT() asm volatile("s_waitcnt lgkmcnt(0)" ::: "memory")
#define XB_TMO      128
#define XB_XCNT(j)  (256  + 64 * (j))
#define XB_XSUB(j)  (1280 + 64 * (j))
#define XB_XGEN(j)  (2304 + 64 * (j))
#define XB_TOP      3328
#define XB_TOPGEN   3392
#define XCD_BAR_WORDS 3456
#define XB_SPIN_CAP (1u << 18)
__device__ __forceinline__ unsigned xb_ld(unsigned* p)              { return __hip_atomic_load(p, __ATOMIC_RELAXED, __HIP_MEMORY_SCOPE_AGENT); }
__device__ __forceinline__ unsigned xb_add(unsigned* p, unsigned v) { return __hip_atomic_fetch_add(p, v, __ATOMIC_RELAXED, __HIP_MEMORY_SCOPE_AGENT); }
__device__ __forceinline__ unsigned xb_xcc_id() { return (unsigned)__builtin_amdgcn_s_getreg((3 << 11) | 20) & 0xFu; }
#define XB_SPIN(cond, bar) do { unsigned _sp = 0; while (cond) { __builtin_amdgcn_s_sleep(1); \
    if ((++_sp & 255u) == 0u) { if (xb_ld(&(bar)[XB_TMO])) break; if (_sp > XB_SPIN_CAP) { atomicAdd(&(bar)[XB_TMO], 1u); break; } } } } while (0)
struct XcdBarrier { unsigned* bar; unsigned x; volatile LAS unsigned* st; };
__device__ __forceinline__ XcdBarrier xcd_barrier_post(unsigned* bar, volatile LAS unsigned* st) {
    XcdBarrier b; b.bar = bar; b.x = xb_xcc_id(); b.st = st;
    if (threadIdx.x == 0) (void)xb_add(&bar[XB_XCNT(b.x)], 1u);
    return b;
}
__device__ __forceinline__ void xcd_barrier_complete(unsigned* bar, unsigned x, unsigned& nloc, unsigned& nx) {
    const unsigned G = gridDim.x * gridDim.y * gridDim.z;
    unsigned sum, cnt, mine, sp = 0u;
    for (;;) {
        sum = 0u; cnt = 0u; mine = 0u;
#pragma unroll
        for (unsigned j = 0; j < 16; ++j) { const unsigned c = xb_ld(&bar[XB_XCNT(j)]); sum += c; cnt += (c > 0u) ? 1u : 0u; mine = (j == x) ? c : mine; }
        if (sum == G) break;
        __builtin_amdgcn_s_sleep(1);
        if ((++sp & 255u) == 0u) { if (xb_ld(&bar[XB_TMO])) break; if (sp > XB_SPIN_CAP) { atomicAdd(&bar[XB_TMO], 1u); break; } }
    }
    nloc = mine > 0u ? mine : 1u; nx = cnt > 0u ? cnt : 1u;
}
__device__ __forceinline__ void xcd_barrier(const XcdBarrier& b) {
    asm volatile("s_waitcnt vmcnt(0)" ::: "memory");
    __syncthreads();
    if (threadIdx.x == 0) {
        unsigned* bar = b.bar; asm volatile("" : "+v"(bar));
        __builtin_amdgcn_s_waitcnt(0);
        unsigned nloc = b.st[0], nx = b.st[1];
        if (nloc == 0u) { xcd_barrier_complete(bar, b.x, nloc, nx); b.st[0] = nloc; b.st[1] = nx; }
        const unsigned old = xb_add(&bar[XB_XSUB(b.x)], 1u);
        const unsigned gen = old / nloc;
        if (old + 1u == (gen + 1u) * nloc) {
            __builtin_amdgcn_fence(__ATOMIC_RELEASE, "agent");
            asm volatile("s_waitcnt vmcnt(0)" ::: "memory");
            const unsigned og = xb_add(&bar[XB_TOP], 1u);
            const unsigned tg = og / nx;
            if (og + 1u == (tg + 1u) * nx) xb_add(&bar[XB_TOPGEN], 1u);
            else XB_SPIN(xb_ld(&bar[XB_TOPGEN]) == tg, bar);
            __builtin_amdgcn_fence(__ATOMIC_ACQUIRE, "agent");
            xb_add(&bar[XB_XGEN(b.x)], 1u);
            asm volatile("s_waitcnt vmcnt(0)" ::: "memory");
        } else {
            XB_SPIN(xb_ld(&bar[XB_XGEN(b.x)]) == gen, bar);
            __builtin_amdgcn_fence(__ATOMIC_ACQUIRE, "agent");
            asm volatile("s_waitcnt vmcnt(0)" ::: "memory");
        }
    }
    __syncthreads();
}

#define XB2_XSUB(j) (64 * (j))
#define XB2_TOP     1024
#define XB2_TOPGEN  1088
__device__ __forceinline__ void xcd_split_arrive(unsigned* bar2, unsigned* bar, volatile LAS unsigned* st) {
    asm volatile("s_waitcnt vmcnt(0)" ::: "memory");
    __syncthreads();
    if (threadIdx.x == 0) {
        asm volatile("" : "+v"(bar2));
        __builtin_amdgcn_s_waitcnt(0);
        unsigned nloc = st[0], nx = st[1]; const unsigned x = xb_xcc_id();
        if (nloc == 0u) { xcd_barrier_complete(bar, x, nloc, nx); st[0] = nloc; st[1] = nx; }
        const unsigned old = xb_add(&bar2[XB2_XSUB(x)], 1u);
        if ((old + 1u) % nloc == 0u) {
            __builtin_amdgcn_fence(__ATOMIC_RELEASE, "agent");
            asm volatile("s_waitcnt vmcnt(0)" ::: "memory");
            const unsigned og = xb_add(&bar2[XB2_TOP], 1u);
            if ((og + 1u) % nx == 0u) xb_add(&bar2[XB2_TOPGEN], 1u);
            asm volatile("s_waitcnt vmcnt(0)" ::: "memory");
        }
    }
}
__device__ __forceinline__ void xcd_split_wait(unsigned* bar2, unsigned* bar, unsigned target) {
    if (threadIdx.x == 0) {
        asm volatile("" : "+v"(bar2));
        XB_SPIN(xb_ld(&bar2[XB2_TOPGEN]) < target, bar);
        __builtin_amdgcn_fence(__ATOMIC_ACQUIRE, "agent");
        asm volatile("s_waitcnt vmcnt(0)" ::: "memory");
    }
    __syncthreads();
}

__device__ __forceinline__ float wave_sum(float v) {
#pragma unroll
    for (int o = 1; o < 64; o <<= 1) v += __shfl_xor(v, o);
    return v;
}
template <class F>
__device__ __forceinline__ void transpose_load(const float* W, int ld, int nrows, F srccol, int item, int lane, f32x4 (&v)[8]) {
    const int nblk = nrows / 32, kb = item / nblk, nb = item % nblk, k0 = 64 * kb, s0 = srccol(32 * nb);
#pragma unroll
    for (int i = 0; i < 8; ++i) v[i] = __builtin_nontemporal_load((const f32x4*)(W + (size_t)(k0 + 8 * i + (lane >> 3)) * ld + s0 + 4 * (lane & 7)));
}
__host__ __device__ __forceinline__ int perm32(int rho) { const int n = rho >> 4, i = rho & 15; return 8 * (i >> 2) + 4 * n + (i & 3); }
template <bool PERM>
__device__ __forceinline__ void transpose_store(int K, bf16_t* WT, int nrows, const float* gk, LAS float* scr, int item, int lane, const f32x4 (&v)[8]) {
    const int nblk = nrows / 32, kb = item / nblk, nb = item % nblk, k0 = 64 * kb, n0 = 32 * nb;
#pragma unroll
    for (int i = 0; i < 8; ++i) { const int kk = 8 * i + (lane >> 3); const float g = gk ? gk[k0 + kk] : 1.0f;
#pragma unroll
        for (int e = 0; e < 4; ++e) scr[kk * 33 + 4 * (lane & 7) + e] = v[i][e] * g; }
    LDS_WAIT(); asm volatile("" ::: "memory");
    const int c = lane & 7;
#pragma unroll
    for (int j = 0; j < 4; ++j) { const int n = (lane >> 3) + 8 * j; const LAS float* s = scr + (8 * c) * 33 + (PERM ? perm32(n) : n);
        u32x4 o; o.x = cvt_pk_bf16(s[0 * 33], s[1 * 33]); o.y = cvt_pk_bf16(s[2 * 33], s[3 * 33]); o.z = cvt_pk_bf16(s[4 * 33], s[5 * 33]); o.w = cvt_pk_bf16(s[6 * 33], s[7 * 33]);
        *(u32x4*)(WT + (size_t)(n0 + n) * K + k0 + 8 * c) = o; }
    LDS_WAIT(); asm volatile("" ::: "memory");
}
struct ColIdent { int off; __device__ __forceinline__ int operator()(int r) const { return off + r; } };
struct ColSwiglu { __device__ __forceinline__ int operator()(int r) const { return ((r >> 7) & 1) * DFF + (r >> 8) * 128 + (r & 127); } };
struct ColMix { __device__ __forceinline__ int operator()(int r) const {
    const int tile = r >> 8, p = r & 255, o = 64 * ((p >> 5) & 3) + 32 * (p >> 7) + (p & 31);
    if (tile < 16) return r;
    if (tile < 20) return 6144 + (tile - 16) * 256 + o;
    if (tile < 24) return 7168 + (tile - 20) * 256 + o;
    if (tile < 28) return 8192 + (tile - 24) * 256 + p;
    return 9216 + (tile - 28) * 256 + p; } };
template <bool PERM = false, class F>
__device__ __forceinline__ void transpose_all(const float* W, int K, int ld, bf16_t* WT, int nrows, F srccol, const float* gk, LAS float* scr, int gw, int ngw, int lane) {
    const int nitems = (K / 64) * (nrows / 32);
    for (int it = gw; it < nitems; it += 2 * ngw) {
        f32x4 va[8], vb[8]; const int it2 = it + ngw;
        transpose_load(W, ld, nrows, srccol, it, lane, va);
        if (it2 < nitems) transpose_load(W, ld, nrows, srccol, it2, lane, vb);
        transpose_store<PERM>(K, WT, nrows, gk, scr, it, lane, va);
        if (it2 < nitems) transpose_store<PERM>(K, WT, nrows, gk, scr, it2, lane, vb);
    }
}
__device__ __forceinline__ void rms_rows_to_bf16(const float* x, const float* gain, bf16_t* o, int m0, int step, int nrows, int lane) {
    const f32x4* gr = (const f32x4*)gain + lane;
    for (int m = m0; m < nrows; m += 2 * step) {
        const int m2 = (m + step < nrows) ? m + step : m;
        const f32x4* xa = (const f32x4*)(x + (size_t)m * DM) + lane; const f32x4* xb2 = (const f32x4*)(x + (size_t)m2 * DM) + lane;
        f32x4 va[4], vb[4]; float sa = 0.f, sb = 0.f;
#pragma unroll
        for (int j = 0; j < 4; ++j) { va[j] = __builtin_nontemporal_load(xa + 64 * j); vb[j] = __builtin_nontemporal_load(xb2 + 64 * j); }
#pragma unroll
        for (int j = 0; j < 4; ++j) { sa += (va[j][0] * va[j][0] + va[j][1] * va[j][1]) + (va[j][2] * va[j][2] + va[j][3] * va[j][3]); sb += (vb[j][0] * vb[j][0] + vb[j][1] * vb[j][1]) + (vb[j][2] * vb[j][2] + vb[j][3] * vb[j][3]); }
        const float ra = __builtin_amdgcn_rsqf(wave_sum(sa) * (1.f / 1024.f) + EPS), rb = __builtin_amdgcn_rsqf(wave_sum(sb) * (1.f / 1024.f) + EPS);
        u32x2* oa = (u32x2*)(o + (size_t)m * DM) + lane; u32x2* ob = (u32x2*)(o + (size_t)m2 * DM) + lane;
#pragma unroll
        for (int j = 0; j < 4; ++j) { const f32x4 g = gr[64 * j]; oa[64 * j] = pack4(va[j] * ra * g); if (m2 != m) ob[64 * j] = pack4(vb[j] * rb * g); }
    }
}
__device__ __forceinline__ void rot_table(const int* pos, float* rot, int gt, int ngt) {
    for (int idx = gt; idx < SEQ * 128; idx += ngt) {
        const int s = idx >> 7, i = idx & 127;
        const float inv = exp2f(-(float)i * (13.287712379549449f / 128.0f));
        const float ang = (float)pos[s] * inv;
        const float kq = rintf(ang * 0.6366197723675814f);
        float r = fmaf(-kq, 1.5703125f, ang); r = fmaf(-kq, 4.837512969970703125e-4f, r); r = fmaf(-kq, 7.54978995489188216e-8f, r);
        const float r2 = r * r;
        const float sn = r + r * r2 * (-1.6666667e-1f + r2 * (8.3333333e-3f + r2 * (-1.9841270e-4f + r2 * 2.7557319e-6f)));
        const float cn = 1.0f + r2 * (-0.5f + r2 * (4.1666668e-2f + r2 * (-1.3888889e-3f + r2 * (2.4801587e-5f + r2 * -2.7557319e-7f))));
        const int qd = ((int)kq) & 3;
        const float c = (qd == 0) ? cn : (qd == 1) ? -sn : (qd == 2) ? -cn : sn;
        const float sv = (qd == 0) ? sn : (qd == 1) ? cn : (qd == 2) ? -sn : -cn;
        *(f32x2*)(rot + (size_t)idx * 2) = (f32x2){c, sv};
    }
}

constexpr int SCN_LD = 136, SCN_V_OFF = 64 * SCN_LD * 2, SCN_CH = 192 * SCN_LD * 2;
constexpr unsigned SCAN_UNITS_PER_FLAG = 8;
__device__ __forceinline__ void scan_unit(int u, const bf16_t* kts, const bf16_t* vt, bf16_t* S, LAS unsigned char* lds, unsigned* done  ) {
    const int tid = opaque_tid(), lane = tid & 63, wave = __builtin_amdgcn_readfirstlane(tid >> 6);
    const int fr = lane & 15, fq = lane >> 4, h = u >> 4, dg = (u >> 2) & 3, eg = u & 3, wd = wave & 1, we = wave >> 1;
    const float gC = __builtin_amdgcn_exp2f(128.0f * log2f(1.0f - __builtin_amdgcn_exp2f(-5.0f - (float)h)));
    f32x4 acc[2][2];
#pragma unroll
    for (int a = 0; a < 2; ++a)
#pragma unroll
        for (int b = 0; b < 2; ++b) acc[a][b] = (f32x4){0.f, 0.f, 0.f, 0.f};
    const bf16_t* ksrc = kts + (size_t)(h * 256 + 64 * dg + (tid >> 4)) * SEQ + (tid & 15) * 8;
    const bf16_t* vsrc = vt + (size_t)(h * 512 + 128 * eg + (tid >> 4)) * SEQ + (tid & 15) * 8;
    u32x4 pk[3][2][2], pv[3][2][4];
#pragma unroll
    for (int sb = 0; sb < 3; ++sb)
#pragma unroll
        for (int i = 0; i < 2; ++i) {
#pragma unroll
            for (int j = 0; j < 2; ++j) pk[sb][i][j] = *(const u32x4*)(ksrc + (size_t)(32 * j) * SEQ + (2 * sb + i) * 128);
#pragma unroll
            for (int j = 0; j < 4; ++j) pv[sb][i][j] = *(const u32x4*)(vsrc + (size_t)(32 * j) * SEQ + (2 * sb + i) * 128);
        }
    bf16_t* sdst = S + ((size_t)(h * 16) * 512 + 128 * eg + 32 * we + fr) * 256 + 64 * dg + 32 * wd + 4 * fq;
#pragma unroll
    for (int r = 0; r < 8; ++r) {
        __syncthreads();
#pragma unroll
        for (int i = 0; i < 2; ++i) {
            if (2 * r + i < 15) {
                LAS bf16_t* lk = (LAS bf16_t*)(lds + i * SCN_CH); LAS bf16_t* lv = (LAS bf16_t*)(lds + i * SCN_CH + SCN_V_OFF);
#pragma unroll
                for (int j = 0; j < 2; ++j) *(LAS u32x4*)(lk + (32 * j + (tid >> 4)) * SCN_LD + (tid & 15) * 8) = pk[r % 3][i][j];
#pragma unroll
                for (int j = 0; j < 4; ++j) *(LAS u32x4*)(lv + (32 * j + (tid >> 4)) * SCN_LD + (tid & 15) * 8) = pv[r % 3][i][j];
            }
        }
        __syncthreads();
        if (r < 5) {
#pragma unroll
            for (int i = 0; i < 2; ++i) { const int c = 2 * (r + 3) + i;
                if (c < 15) {
#pragma unroll
                    for (int j = 0; j < 2; ++j) pk[r % 3][i][j] = *(const u32x4*)(ksrc + (size_t)(32 * j) * SEQ + c * 128);
#pragma unroll
                    for (int j = 0; j < 4; ++j) pv[r % 3][i][j] = *(const u32x4*)(vsrc + (size_t)(32 * j) * SEQ + c * 128);
                } }
        }
#pragma unroll
        for (int i = 0; i < 2; ++i) {
            const int c = 2 * r + i;
#pragma unroll
            for (int td = 0; td < 2; ++td)
#pragma unroll
                for (int te = 0; te < 2; ++te) { const u32x2 w = pack4(acc[td][te]);
                    __hip_atomic_store((unsigned long long*)(sdst + (size_t)c * 512 * 256 + (size_t)(16 * te) * 256 + 16 * td), ((unsigned long long)w.y << 32) | w.x, __ATOMIC_RELAXED, __HIP_MEMORY_SCOPE_AGENT); }
            if (c < 15) {
                const LAS bf16_t* lk = (const LAS bf16_t*)(lds + i * SCN_CH); const LAS bf16_t* lv = (const LAS bf16_t*)(lds + i * SCN_CH + SCN_V_OFF);
                f32x4 tm[2][2];
#pragma unroll
                for (int td = 0; td < 2; ++td)
#pragma unroll
                    for (int te = 0; te < 2; ++te) tm[td][te] = (f32x4){0.f, 0.f, 0.f, 0.f};
#pragma unroll
                for (int ks = 0; ks < 4; ++ks) {
                    bf16x8 a[2], b[2];
#pragma unroll
                    for (int t = 0; t < 2; ++t) { a[t] = *(const LAS bf16x8*)(lk + (32 * wd + 16 * t + fr) * SCN_LD + 32 * ks + 8 * fq); b[t] = *(const LAS bf16x8*)(lv + (32 * we + 16 * t + fr) * SCN_LD + 32 * ks + 8 * fq); }
#pragma unroll
                    for (int td = 0; td < 2; ++td)
#pragma unroll
                        for (int te = 0; te < 2; ++te) tm[td][te] = mfma16(a[td], b[te], tm[td][te]);
                }
#pragma unroll
                for (int td = 0; td < 2; ++td)
#pragma unroll
                    for (int te = 0; te < 2; ++te) acc[td][te] = acc[td][te] * gC + tm[td][te];
            }
        }
    }
    asm volatile("s_waitcnt vmcnt(0)" ::: "memory");
    __syncthreads();
    if (tid == 0) __hip_atomic_fetch_add(done + ((h * 2 + (eg >> 1)) * 64), 1u, __ATOMIC_RELAXED, __HIP_MEMORY_SCOPE_AGENT);
}
constexpr int RQ_LD = 264, SC_LD = 136, RO_SC_OFF = 128 * RQ_LD * 2, RO_PART_OFF = RO_SC_OFF + 128 * SC_LD * 2;
__device__ __forceinline__ void retout_unit(int h, int c, int eh, const bf16_t* q, const bf16_t* k, const bf16_t* vt, const bf16_t* S, bf16_t* ret  , float* rssq, LAS unsigned char* lds, unsigned* done, unsigned* tmo) {
    const int tid = opaque_tid(), lane = tid & 63, wave = __builtin_amdgcn_readfirstlane(tid >> 6);
    const int fr = lane & 15, fq = lane >> 4;
    LAS bf16_t* ql = (LAS bf16_t*)lds; LAS bf16_t* sc = (LAS bf16_t*)(lds + RO_SC_OFF); LAS float* part = (LAS float*)(lds + RO_PART_OFF);
    const float lg2 = log2f(1.0f - __builtin_amdgcn_exp2f(-5.0f - (float)h));
    const int tok0 = c * 128;
    if (tid < 64) {
        unsigned* f = done + ((h * 2 + eh) * 64); unsigned sp = 0;
        while ((unsigned)__builtin_amdgcn_readfirstlane(__hip_atomic_load(f, __ATOMIC_RELAXED, __HIP_MEMORY_SCOPE_AGENT)) < SCAN_UNITS_PER_FLAG) {
            __builtin_amdgcn_s_sleep(2);
            if (++sp > (1u << 20)) { if (tid == 0) __hip_atomic_store(tmo, 1u, __ATOMIC_RELAXED, __HIP_MEMORY_SCOPE_AGENT); break; }
        }
        __builtin_amdgcn_fence(__ATOMIC_ACQUIRE, "agent");
        asm volatile("s_waitcnt vmcnt(0)" ::: "memory");
    }
    __syncthreads();
    const bf16_t* sp = S + ((size_t)((h * 16 + c) * 512 + 256 * eh + 32 * wave + fr)) * 256 + 8 * fq;
    const bf16_t* vp = vt + (size_t)(h * 512 + 256 * eh + 32 * wave + fr) * SEQ + tok0 + 8 * fq;
    const bf16_t* kp = k + (size_t)(tok0 + 16 * wave + fr) * 1024 + h * 256 + 8 * fq;
    u32x4 qv[8]; bf16x8 kf[8], sfa[8][2], vfa[4][2];
#pragma unroll
    for (int i = 0; i < 8; ++i) { const int p = tid + 512 * i, row = p >> 5, c16 = p & 31; qv[i] = *(const u32x4*)(q + (size_t)(tok0 + row) * 1024 + h * 256 + c16 * 8); }
#pragma unroll
    for (int ks = 0; ks < 8; ++ks) kf[ks] = *(const bf16x8*)(kp + 32 * ks);
#pragma unroll
    for (int ks = 0; ks < 8; ++ks)
#pragma unroll
        for (int t = 0; t < 2; ++t) sfa[ks][t] = *(const bf16x8*)(sp + (size_t)(16 * t) * 256 + 32 * ks);
#pragma unroll
    for (int i = 0; i < 8; ++i) { const int p = tid + 512 * i, row = p >> 5, c16 = p & 31; *(LAS u32x4*)(ql + row * RQ_LD + c16 * 8) = qv[i]; }
    __syncthreads();
    {
        const int tj = wave;
#pragma unroll
        for (int ti = 0; ti < 8; ++ti) {
            if (ti >= tj) {
                f32x4 s2 = (f32x4){0.f, 0.f, 0.f, 0.f};
#pragma unroll
                for (int ks = 0; ks < 8; ++ks) { const bf16x8 qf = *(const LAS bf16x8*)(ql + (16 * ti + fr) * RQ_LD + 32 * ks + 8 * fq); s2 = mfma16(kf[ks], qf, s2); }
                const int i = 16 * ti + fr; f32x4 v;
#pragma unroll
                for (int r = 0; r < 4; ++r) { const int j = 16 * tj + 4 * fq + r; v[r] = (i >= j) ? s2[r] * __builtin_amdgcn_exp2f(lg2 * (float)(i - j)) : 0.f; }
                *(LAS u32x2*)(sc + (16 * ti + fr) * SC_LD + 16 * tj + 4 * fq) = pack4(v);
            } else if (ti == tj - 1 && (tj & 1)) {
                u32x2 z = (u32x2){0u, 0u}; asm volatile("" : "+v"(z));
                *(LAS u32x2*)(sc + (16 * ti + fr) * SC_LD + 16 * tj + 4 * fq) = z;
            }
        }
    }
    __syncthreads();
    f32x4 acc[8][2];
#pragma unroll
    for (int a = 0; a < 8; ++a)
#pragma unroll
        for (int b = 0; b < 2; ++b) acc[a][b] = (f32x4){0.f, 0.f, 0.f, 0.f};
    {
        bf16x8 qf[2][8];
#pragma unroll
        for (int t = 0; t < 8; ++t) qf[0][t] = *(const LAS bf16x8*)(ql + (16 * t + fr) * RQ_LD + 8 * fq);
#pragma unroll
        for (int ks = 0; ks < 8; ++ks) {
            if (ks == 4) {
#pragma unroll
                for (int k2 = 0; k2 < 4; ++k2)
#pragma unroll
                    for (int t = 0; t < 2; ++t) vfa[k2][t] = *(const bf16x8*)(vp + (size_t)(16 * t) * SEQ + 32 * k2);
            }
            if (ks < 7) {
#pragma unroll
                for (int t = 0; t < 8; ++t) qf[(ks + 1) & 1][t] = *(const LAS bf16x8*)(ql + (16 * t + fr) * RQ_LD + 32 * (ks + 1) + 8 * fq);
            }
            __builtin_amdgcn_sched_barrier(0);
#pragma unroll
            for (int a = 0; a < 8; ++a)
#pragma unroll
                for (int b = 0; b < 2; ++b) acc[a][b] = mfma16(sfa[ks][b], qf[ks & 1][a], acc[a][b]);
            __builtin_amdgcn_sched_barrier(0);
        }
    }
#pragma unroll
    for (int a = 0; a < 8; ++a) { const float qd = __builtin_amdgcn_exp2f(lg2 * (float)(16 * a + fr + 1));
#pragma unroll
        for (int b = 0; b < 2; ++b) acc[a][b] = acc[a][b] * qd; }
#pragma unroll
    for (int ks = 0; ks < 4; ++ks) {
        bf16x8 pf[8];
#pragma unroll
        for (int a = 0; a < 8; ++a) if (a >= 2 * ks) pf[a] = *(const LAS bf16x8*)(sc + (16 * a + fr) * SC_LD + 32 * ks + 8 * fq);
        __builtin_amdgcn_sched_barrier(0);
#pragma unroll
        for (int a = 0; a < 8; ++a) {
            if (a >= 2 * ks) {
#pragma unroll
                for (int b = 0; b < 2; ++b) acc[a][b] = mfma16(vfa[ks][b], pf[a], acc[a][b]);
            }
        }
        __builtin_amdgcn_sched_barrier(0);
    }
#pragma unroll
    for (int a = 0; a < 8; ++a) {
        float ss = 0.f;
#pragma unroll
        for (int b = 0; b < 2; ++b) { const f32x4 t = acc[a][b]; ss += (t[0] * t[0] + t[1] * t[1]) + (t[2] * t[2] + t[3] * t[3]); }
        ss += __shfl_xor(ss, 16); ss += __shfl_xor(ss, 32);
        if (fq == 0) part[wave * 128 + 16 * a + fr] = ss;
    }
    __syncthreads();
    if (tid < 128) {
        float tot = 0.f;
#pragma unroll
        for (int w = 0; w < 8; ++w) tot += part[w * 128 + tid];
        rssq[(size_t)(tok0 + tid) * 8 + 2 * h + eh] = tot;
    }
#pragma unroll
    for (int a = 0; a < 8; ++a)
#pragma unroll
        for (int b = 0; b < 2; ++b)
            *(u32x2*)(ret + (size_t)(tok0 + 16 * a + fr) * 2048 + h * 512 + 256 * eh + 32 * wave + 16 * b + 4 * fq) = pack4(acc[a][b]);
    __syncthreads();
}
constexpr int PL_LD = 264, MA_KV_BYTES = 64 * 264 * 2, MA_P_OFF = MA_KV_BYTES;
__device__ __forceinline__ void memattn_unit(int b, int h, int rb, const bf16_t* mkn, const bf16_t* mvt, bf16_t* mo  , LAS unsigned char* lds) {
    const bf16_t* mq = mo;
    const int tid = opaque_tid(), lane = tid & 63, wave = __builtin_amdgcn_readfirstlane(tid >> 6);
    const int fr = lane & 15, fq = lane >> 4;
    LAS bf16_t* kv = (LAS bf16_t*)lds; LAS bf16_t* pl = (LAS bf16_t*)(lds + MA_P_OFF) + wave * (16 * PL_LD);
    const int row = 128 * rb + 16 * wave + fr;
    const bf16_t* ksrc = mkn + (size_t)(b * 256) * 1024 + h * 256;
    const bf16_t* vsrc = mvt + (size_t)((b * 4 + h) * 256) * 256;
    u32x4 pre[4];
#pragma unroll
    for (int i = 0; i < 4; ++i) { const int p = tid + 512 * i; pre[i] = *(const u32x4*)(ksrc + (size_t)(p >> 5) * 1024 + (p & 31) * 8); }
    bf16x8 qf[8]; float qs = 0.f;
#pragma unroll
    for (int ks = 0; ks < 8; ++ks) { qf[ks] = *(const bf16x8*)(mq + (size_t)row * 1024 + h * 256 + 32 * ks + 8 * fq);
#pragma unroll
        for (int j = 0; j < 8; ++j) { const float f = bf2f((unsigned short)qf[ks][j]); qs += f * f; } }
    qs += __shfl_xor(qs, 16); qs += __shfl_xor(qs, 32);
    const float scl = __builtin_amdgcn_rsqf(qs * (1.0f / 256.0f) + EPS) * (0.0625f * LOG2E);
    f32x4 sa[16];
#pragma unroll
    for (int kc = 0; kc < 4; ++kc) {
        __syncthreads();
#pragma unroll
        for (int i = 0; i < 4; ++i) { const int p = tid + 512 * i; *(LAS u32x4*)(kv + (p >> 5) * PL_LD + (p & 31) * 8) = pre[i]; }
        __syncthreads();
#pragma unroll
        for (int i = 0; i < 4; ++i) { const int p = tid + 512 * i;
            pre[i] = (kc < 3) ? *(const u32x4*)(ksrc + (size_t)(64 * (kc + 1) + (p >> 5)) * 1024 + (p & 31) * 8) : *(const u32x4*)(vsrc + (size_t)(p >> 5) * 256 + (p & 31) * 8); }
#pragma unroll
        for (int tl = 0; tl < 4; ++tl) {
            f32x4 a = (f32x4){0.f, 0.f, 0.f, 0.f};
#pragma unroll
            for (int ks = 0; ks < 8; ++ks) { const bf16x8 kf = *(const LAS bf16x8*)(kv + (16 * tl + fr) * PL_LD + 32 * ks + 8 * fq); a = mfma16(kf, qf[ks], a); }
            sa[4 * kc + tl] = a * scl;
        }
    }
    float mx = -INFINITY;
#pragma unroll
    for (int t = 0; t < 16; ++t) mx = fmaxf(mx, fmaxf(fmaxf(sa[t][0], sa[t][1]), fmaxf(sa[t][2], sa[t][3])));
    mx = fmaxf(mx, __shfl_xor(mx, 16)); mx = fmaxf(mx, __shfl_xor(mx, 32));
    float l = 0.f;
#pragma unroll
    for (int t = 0; t < 16; ++t) {
        f32x4 p;
#pragma unroll
        for (int r = 0; r < 4; ++r) { p[r] = __builtin_amdgcn_exp2f(sa[t][r] - mx); l += p[r]; }
        *(LAS u32x2*)(pl + fr * PL_LD + 16 * t + 4 * fq) = pack4(p);
    }
    l += __shfl_xor(l, 16); l += __shfl_xor(l, 32);
    const float rl = __builtin_amdgcn_rcpf(l);
    LDS_WAIT(); asm volatile("" ::: "memory");
    bf16x8 pf[8];
#pragma unroll
    for (int ks = 0; ks < 8; ++ks) pf[ks] = *(const LAS bf16x8*)(pl + fr * PL_LD + 32 * ks + 8 * fq);
#pragma unroll
    for (int dc = 0; dc < 4; ++dc) {
        __syncthreads();
#pragma unroll
        for (int i = 0; i < 4; ++i) { const int p = tid + 512 * i; *(LAS u32x4*)(kv + (p >> 5) * PL_LD + (p & 31) * 8) = pre[i]; }
        __syncthreads();
        if (dc < 3) {
#pragma unroll
            for (int i = 0; i < 4; ++i) { const int p = tid + 512 * i; pre[i] = *(const u32x4*)(vsrc + (size_t)(64 * (dc + 1) + (p >> 5)) * 256 + (p & 31) * 8); }
        }
#pragma unroll
        for (int tl = 0; tl < 4; ++tl) {
            f32x4 a = (f32x4){0.f, 0.f, 0.f, 0.f};
#pragma unroll
            for (int ks = 0; ks < 8; ++ks) { const bf16x8 vf = *(const LAS bf16x8*)(kv + (16 * tl + fr) * PL_LD + 32 * ks + 8 * fq); a = mfma16(vf, pf[ks], a); }
            *(u32x2*)(mo + (size_t)row * 1024 + h * 256 + 64 * dc + 16 * tl + 4 * fq) = pack4(a * rl);
        }
    }
    __syncthreads();
}
__device__ __forceinline__ void dif_row(const bf16_t* o0, const bf16_t* o1, bf16_t* dif, const float* gout, float lam, int lane) {
    const u32x4* a = (const u32x4*)o0 + 2 * lane; const u32x4* b = (const u32x4*)o1 + 2 * lane;
    float d[16]; float ss = 0.f;
#pragma unroll
    for (int v = 0; v < 2; ++v) { const u32x4 x = __builtin_nontemporal_load(a + v), y = __builtin_nontemporal_load(b + v);
#pragma unroll
        for (int w = 0; w < 4; ++w) { const float x0 = __uint_as_float(x[w] << 16), x1 = __uint_as_float(x[w] & 0xffff0000u), y0 = __uint_as_float(y[w] << 16), y1 = __uint_as_float(y[w] & 0xffff0000u);
            const float d0 = x0 - lam * y0, d1 = x1 - lam * y1; d[v * 8 + w * 2] = d0; d[v * 8 + w * 2 + 1] = d1; ss += d0 * d0 + d1 * d1; } }
    ss += __shfl_xor(ss, 1); ss += __shfl_xor(ss, 2); ss += __shfl_xor(ss, 4);
    const float rn = __builtin_amdgcn_rsqf(ss * (1.0f / 128.0f) + EPS) * (1.0f - LAM_INIT);
    const float* gp = gout + (lane & 7) * 16;
    u32x4 o[2];
#pragma unroll
    for (int v = 0; v < 2; ++v)
#pragma unroll
        for (int w = 0; w < 4; ++w) o[v][w] = cvt_pk_bf16(d[v * 8 + w * 2] * rn * gp[v * 8 + w * 2], d[v * 8 + w * 2 + 1] * rn * gp[v * 8 + w * 2 + 1]);
    u32x4* op = (u32x4*)dif + 2 * lane; op[0] = o[0]; op[1] = o[1];
}

struct P4bOrder {
    pg8::StaticOrder T; unsigned char* ws; const char* xa;
    __device__ __forceinline__ bool next(int i, pg8::Unit& u) const {
        int pm, pn; if (!T.tile(i, pm, pn)) return false;
        u.pm = pm; u.pn = pn; u.ui = i; u.ri = i; u.tag = 0; u.K = 1024;
        u.A = xa + (size_t)pm * 256 * 1024 * 2;
        u.Bt = (const char*)ws + (pn < 8 ? WS_WRG + (size_t)pn * 256 * 1024 * 2 : WS_WGATE + (size_t)(pn - 8) * 256 * 1024 * 2); return true;
    }
};
struct P5Order {
    pg8::StaticOrder T; unsigned char* ws;
    __device__ __forceinline__ bool next(int i, pg8::Unit& u) const {
        const int ti = i / 3, kbr = i - 3 * ti; int pm, pn; if (!T.tile(ti, pm, pn)) return false;
        const size_t offA = kbr == 0 ? WS_RET : kbr == 1 ? WS_DIF : WS_MO;
        const size_t offB = kbr == 0 ? WS_WBRR : kbr == 1 ? WS_WBRD : WS_WBRM;
        const int K = kbr == 0 ? 2048 : 1024;
        u.pm = pm; u.pn = pn; u.ui = i; u.ri = ti; u.tag = kbr; u.K = K;
        u.A = (const char*)ws + offA + (size_t)pm * 256 * K * 2; u.Bt = (const char*)ws + offB + (size_t)pn * 256 * K * 2; return true;
    }
};
#ifndef PH_MASK
#define PH_MASK 0xffffffffu
#endif
#define PH(n) ((PH_MASK >> (n)) & 1u)
#ifndef DUP_MASK
#define DUP_MASK 0u
#endif
#ifndef PROBE_K
#define PROBE_K (-1)
#endif
#define RUNP(k) (pass_ == 1 || (k) <= PROBE_K)
#define REPQ(n) _Pragma("unroll 1") for (int rq_ = 0; rq_ < 1 + (int)((DUP_MASK >> (n)) & 1u); ++rq_)
#define REP(n) _Pragma("unroll 1") for (int rep_ = 0; rep_ < 1 + (int)((DUP_MASK >> (n)) & 1u); ++rep_)
struct Args { const void* in[26]; float* out; unsigned char* ws; };
#define CAS __attribute__((address_space(4)))
__device__ __forceinline__ const void* karg(int i) { typedef const GAS void* gptr; const CAS gptr* p = (const CAS gptr*)__builtin_amdgcn_kernarg_segment_ptr(); asm volatile("" : "+s"(p)); return (const void*)p[i]; }
#define INP(i) ((const float*)karg(i))
#define WSP(T, off) ((T*)((unsigned char*)karg(27) + (off)))
#define OUTP ((float*)karg(26))
struct SplitWait {
    unsigned target;
    __device__ __forceinline__ void wait() const { if (target) xcd_split_wait((unsigned*)WSP(unsigned, WS_CTL) + CW_BAR2, (unsigned*)WSP(unsigned, WS_CTL) + CW_BAR, target); }
};
__global__ void __launch_bounds__(NWAVES * 64, 2) mk_fwd(Args args) {
    extern __shared__ __attribute__((aligned(16))) unsigned char lds_raw[];
    LAS unsigned char* lds = (LAS unsigned char*)lds_raw;
    volatile LAS unsigned* MISC = (volatile LAS unsigned*)(lds + MISC_OFF);
    const int G = gridDim.x, bx = blockIdx.x;
    for (int u = threadIdx.x; u < (LDS_BYTES - LDSCTL_OFF) / 4; u += NWAVES * 64) ((LAS unsigned*)(lds + LDSCTL_OFF))[u] = 0u;
    __syncthreads();
    (void)xcd_barrier_post((unsigned*)WSP(unsigned, WS_CTL) + CW_BAR, MISC + 8);
#define GRID_BAR() do { XcdBarrier b_; b_.bar = (unsigned*)WSP(unsigned, WS_CTL) + CW_BAR; b_.x = xb_xcc_id(); b_.st = (volatile LAS unsigned*)(lds + MISC_OFF) + 8; xcd_barrier(b_); } while (0)
#define SPLIT_ARRIVE() do { xcd_split_arrive((unsigned*)WSP(unsigned, WS_CTL) + CW_BAR2, (unsigned*)WSP(unsigned, WS_CTL) + CW_BAR, (volatile LAS unsigned*)(lds + MISC_OFF) + 8); ++sgen; } while (0)
    unsigned sgen = 0;
    const int NGW = G * NWAVES, NGT = G * NWAVES * 64;
#define LANE_VARS() const int tid = opaque_tid(), lane = tid & 63, wave = __builtin_amdgcn_readfirstlane(tid >> 6); LAS float* scr = (LAS float*)(lds + wave * 16384); \
    const int gw = bx * NWAVES + wave, gt = bx * (NWAVES * 64) + tid; (void)scr; (void)gw; (void)gt; (void)lane

#pragma unroll 1
    for (int pass_ = (PROBE_K >= 0 ? 0 : 1); pass_ < 2; ++pass_) {
    if (RUNP(0)) {
    REP(0) if (PH(0)) {
        LANE_VARS();
        transpose_all<true>(INP(4), 1024, 2 * DFF, WSP(bf16_t, WS_WF1I), 2 * DFF, ColSwiglu{}, nullptr, scr, gw, NGW, lane);
        transpose_all(INP(18), 1024, 2048, WSP(bf16_t, WS_WMKV), 2048, ColIdent{0}, nullptr, scr, gw, NGW, lane);
        { const float* x = INP(0); const float* g1 = INP(3); bf16_t* xb = WSP(bf16_t, WS_XBL);
          rms_rows_to_bf16(x, g1, xb, gw, NGW, TOK, lane); }
        { const float* mem = INP(1); const float* gm = INP(17); bf16_t* memn = WSP(bf16_t, WS_MEMN);
          rms_rows_to_bf16(mem, gm, memn, gw, NGW, NB * MEML, lane); }
        rot_table((const int*)karg(2), WSP(float, WS_ROT), gt, NGT);
    }
    GRID_BAR();
    }

    if (RUNP(1)) {
    REP(1) if (PH(1)) {
        pg8::Gemm g{WSP(bf16_t, WS_XBL), WSP(bf16_t, WS_WF1I), TOK, 2 * DFF, 1024}; pg8::StaticOrder S; S.init(TOK, 2 * DFF, G, bx);
        EpiSwiglu E{WSP(bf16_t, WS_ACT), nullptr};
        S.set(g); pg8::gemm_phase(lds, S, E);
    }
    if (PH(2)) {
        pg8::Gemm g{WSP(bf16_t, WS_MEMN), WSP(bf16_t, WS_WMKV), NB * MEML, 2048, 1024}; pg8::StaticOrder S; S.init(NB * MEML, 2048, G, (bx + G / 2) % G);
        EpiPlain E{WSP(bf16_t, WS_MKVRAW), 2048};
        S.set(g); pg8::gemm_phase(lds, S, E);
    }
    if (PH(0)) {
        const int q0 = (3 * G) / 4, nq = G - q0;
        if (bx >= q0) {
            LANE_VARS();
            const int gw2 = (bx - q0) * NWAVES + wave, ngw2 = nq * NWAVES;
            transpose_all(INP(5), DFF, 1024, WSP(bf16_t, WS_WF1O), 1024, ColIdent{0}, nullptr, scr, gw2, ngw2, lane);
            transpose_all<true>(INP(7), 1024, 13312, WSP(bf16_t, WS_WMIX), NMIX, ColMix{}, INP(6), scr, gw2, ngw2, lane);
        }
    }
    GRID_BAR();
    }

    if (RUNP(2)) {
    REP(3) if (PH(3)) {
        pg8::Gemm g{WSP(bf16_t, WS_ACT), WSP(bf16_t, WS_WF1O), TOK, 1024, DFF}; pg8::StaticOrder S; S.init(TOK, 1024, G, bx);
        EpiResid<false, false> E{INP(0), nullptr, (bf16_t*)OUTP, WSP(float, WS_SSQ1), 0.5f, (rep_ == 1 && ((DUP_MASK >> 23) & 1u)) ? 1 : 0};
        S.set(g); pg8::gemm_phase(lds, S, E);
    }
    SPLIT_ARRIVE();
    if (PH(0)) {
        LANE_VARS();
        const bf16_t* mkvraw = WSP(bf16_t, WS_MKVRAW); bf16_t* mkn = WSP(bf16_t, WS_MKN); bf16_t* mvt = WSP(bf16_t, WS_MVT);
        const float* g_mem_k = INP(16); const float* g_mem_q = INP(15);
        for (int j = gw; j < NB * MEML * 4; j += NGW) {
            const int row = j >> 2, h = j & 3;
            const u32x2 w = *((const u32x2*)(mkvraw + (size_t)row * 2048 + h * 256) + lane);
            f32x4 v = (f32x4){__uint_as_float(w.x << 16), __uint_as_float(w.x & 0xffff0000u), __uint_as_float(w.y << 16), __uint_as_float(w.y & 0xffff0000u)};
            const float ss = wave_sum((v[0] * v[0] + v[1] * v[1]) + (v[2] * v[2] + v[3] * v[3]));
            const float rn = __builtin_amdgcn_rsqf(ss * (1.0f / 256.0f) + EPS);
            const f32x4 gk = *((const f32x4*)g_mem_k + lane), gq = *((const f32x4*)g_mem_q + lane);
            *((u32x2*)(mkn + (size_t)row * 1024 + h * 256) + lane) = pack4(v * rn * gk * gq);
        }
        for (int idx = gt; idx < NB * 4 * 256 * 256; idx += NGT) {
            const int key = idx & 255, d = (idx >> 8) & 255, bh = idx >> 16, b = bh >> 2, h = bh & 3;
            mvt[idx] = mkvraw[(size_t)(b * 256 + key) * 2048 + 1024 + h * 256 + d];
        }
    }
    { SplitWait H{sgen}; H.wait(); }
    }

    if (RUNP(3))
    for (int ph = 0; ph <= NB; ++ph) {
        const int gp = ph, gm = ph - 1;
        unsigned char* const wsP = WSP(unsigned char, 0) - (((gp + 1) & 1) ? SET_DELTA : 0);
        unsigned char* const wsB = WSP(unsigned char, 0) - (((gm + 1) & 1) ? SET_DELTA : 0);
        unsigned* done = (unsigned*)WSP(unsigned, WS_CTL) + CW_SCAN + ((pass_ * NB + (gm < 0 ? 0 : gm)) * 8) * 64; unsigned* tmo = (unsigned*)WSP(unsigned, WS_CTL) + CW_BAR + XB_TMO;
        const bool early = (gm >= 0 && bx < 64) || gp >= NB;
        if (early) { SplitWait H{sgen}; H.wait(); }
        if (gm >= 0)
            for (int u = bx; u < 64; u += G) REPQ(26) { __syncthreads(); if (PH(5)) scan_unit(u, (const bf16_t*)(wsB + WS_KTS), (const bf16_t*)(wsB + WS_VT), WSP(bf16_t, WS_S), lds, done); }
        if (gp < NB) {
            REP(4) if (PH(4)) {
                pg8::Gemm g{(const bf16_t*)OUTP + (size_t)gp * SEQ * DM, WSP(bf16_t, WS_WMIX), SEQ, NMIX, 1024}; pg8::StaticOrder S; S.init(SEQ, NMIX, G, bx);
                prep_rs(WSP(float, WS_SSQ1), gp * SEQ, S, lds);
                EpiMix E{(const LAS float*)(lds + RTAB_OFF), WSP(float, (gp & 1) ? WS_ROTB : WS_ROT), wsP, WSP(bf16_t, WS_MO) + (size_t)gp * SEQ * 1024, INP(8), INP(9)};
                SplitWait H{early ? 0u : sgen};
                S.set(g); pg8::gemm_phase(lds, S, E, H);
                if (bx >= (SEQ / 256) * (NMIX / 256)) H.wait();
            }
        }
        if (gm >= 0) {
            const size_t oOff = (gm & 1) ? WS_OB : 0;
            unsigned* qctr = (unsigned*)WSP(unsigned, WS_CTL) + CW_QUEUE + (pass_ * NB + gm) * 64;
            volatile LAS unsigned* qslot = (volatile LAS unsigned*)(lds + MISC_OFF) + 16;
            for (;;) {
                __syncthreads();
                if (threadIdx.x == 0) qslot[0] = __hip_atomic_fetch_add(qctr, 1u, __ATOMIC_RELAXED, __HIP_MEMORY_SCOPE_AGENT);
                __syncthreads();
                const int id = __builtin_amdgcn_readfirstlane((int)qslot[0]);
                if (id >= 320) break;
                int aq = -1, aj = 0;
                if (id < 96) { aq = 7 - (id >> 4); aj = id & 15; }
                else if (id >= 192) { const int ro = id - 192;
                    if (PH(8)) REPQ(24) { __syncthreads(); retout_unit(ro >> 5, (ro >> 1) & 15, ro & 1, (const bf16_t*)(wsB + WS_Q), (const bf16_t*)(wsB + WS_K), (const bf16_t*)(wsB + WS_VT), WSP(bf16_t, WS_S),
                                           WSP(bf16_t, WS_RET) + (size_t)gm * SEQ * 2048, WSP(float, WS_SSQ2) + (size_t)gm * SEQ * 8, lds, done, tmo); } }
                else if (id < 160) { const int m = id - 96;
                    if (PH(7)) memattn_unit(gm, m >> 4, m & 15, WSP(bf16_t, WS_MKN), WSP(bf16_t, WS_MVT), WSP(bf16_t, WS_MO) + (size_t)gm * SEQ * 1024, lds); }
                else { aq = 1 - ((id - 160) >> 4); aj = (id - 160) & 15; }
                if (aq >= 0) {
                    const int hc = aj, hh = hc >> 1, cc = hc & 1;
                    if (PH(6)) REPQ(25) attn_body::attn_unit<8>(hc, hh, aq, (const attn_body::bf16*)(wsB + WS_DQ), (const attn_body::bf16*)(wsB + WS_DK), (const attn_body::bf16*)(wsB + WS_DV),
                                            WSP(attn_body::bf16, (cc ? WS_O1 : WS_O0) + oOff), (char*)lds_raw);
                }
            }
        }
        {
            LANE_VARS();
            if (ph >= 2) {
                const int gd = ph - 2; const size_t oD = (gd & 1) ? WS_OB : 0;
                const float s1 = wave_sum(INP(10)[lane] * INP(11)[lane]), s2 = wave_sum(INP(12)[lane] * INP(13)[lane]); const float lam = __expf(s1) - __expf(s2) + LAM_INIT;
                const bf16_t* bo0 = WSP(bf16_t, WS_O0 + oD); const bf16_t* bo1 = WSP(bf16_t, WS_O1 + oD); bf16_t* difb = WSP(bf16_t, WS_DIF); const float* gdo = INP(14);
                for (int r = gw; r < SEQ; r += NGW) dif_row(bo0 + (size_t)r * 1024, bo1 + (size_t)r * 1024, difb + ((size_t)gd * SEQ + r) * 1024, gdo, lam, lane);
            }
            if (ph + 1 < NB) rot_table((const int*)karg(2) + (ph + 1) * SEQ, WSP(float, ((ph + 1) & 1) ? WS_ROTB : WS_ROT), gt, NGT);
            if (ph == 0) transpose_all<true>(INP(7), 1024, 13312, WSP(bf16_t, WS_WRG), 2048, ColIdent{4096}, INP(6), scr, gw, NGW, lane);
            if (ph == NB) {
                transpose_all<true>(INP(7), 1024, 13312, WSP(bf16_t, WS_WGATE), 3072, ColIdent{10240}, INP(6), scr, gw, NGW, lane);
            }
        }
        SPLIT_ARRIVE();
    }

    if (RUNP(4)) {
    if (PH(9)) {
        pg8::StaticOrder T; T.init(TOK, 5120, G, bx);
        prep_rs(WSP(float, WS_SSQ1), 0, T, lds);
        P4bOrder S{T, WSP(unsigned char, 0), (const char*)OUTP};
        EpiRgG E{(const LAS float*)(lds + RTAB_OFF), WSP(bf16_t, WS_RET), WSP(float, WS_SSQ2), WSP(unsigned char, 0)};
        SplitWait H{sgen};
        pg8::gemm_phase(lds, S, E, H);
        if (bx >= (TOK / 256) * (5120 / 256)) H.wait();
    }
    if (PH(0)) {
        LANE_VARS();
        { const float s1 = wave_sum(INP(10)[lane] * INP(11)[lane]), s2 = wave_sum(INP(12)[lane] * INP(13)[lane]); const float lam = __expf(s1) - __expf(s2) + LAM_INIT;
          const bf16_t* bo0 = WSP(bf16_t, WS_O0 + (((NB - 1) & 1) ? WS_OB : 0)); const bf16_t* bo1 = WSP(bf16_t, WS_O1 + (((NB - 1) & 1) ? WS_OB : 0)); bf16_t* difb = WSP(bf16_t, WS_DIF); const float* gdo = INP(14);
          for (int r = gw; r < SEQ; r += NGW) dif_row(bo0 + (size_t)r * 1024, bo1 + (size_t)r * 1024, difb + ((size_t)(NB - 1) * SEQ + r) * 1024, gdo, lam, lane); }
        transpose_all<true>(INP(19), 2048, 1024, WSP(bf16_t, WS_WBRR), 1024, ColIdent{0}, nullptr, scr, gw, NGW, lane);
        transpose_all<true>(INP(20), 1024, 1024, WSP(bf16_t, WS_WBRD), 1024, ColIdent{0}, nullptr, scr, gw, NGW, lane);
        transpose_all<true>(INP(21), 1024, 1024, WSP(bf16_t, WS_WBRM), 1024, ColIdent{0}, nullptr, scr, gw, NGW, lane);
    }
    SPLIT_ARRIVE();
    if (PH(0)) {
        LANE_VARS();
        transpose_all(INP(22), 1024, 1024, WSP(bf16_t, WS_WO), 1024, ColIdent{0}, nullptr, scr, gw, NGW, lane);
        transpose_all(INP(25), DFF, 1024, WSP(bf16_t, WS_WF2O), 1024, ColIdent{0}, nullptr, scr, gw, NGW, lane);
    }
    { SplitWait H{sgen}; H.wait(); }
    }

    if (RUNP(5)) {
    REP(10) if (PH(10)) {
        pg8::StaticOrder T; T.init(TOK, 1024, G, bx);
        P5Order S{T, WSP(unsigned char, 0)};
        EpiTerm3 E{WSP(unsigned char, 0), WSP(bf16_t, WS_Y)};
        pg8::gemm_phase(lds, S, E);
    }
    SPLIT_ARRIVE();
    if (PH(0)) {
        LANE_VARS();
        transpose_all<true>(INP(24), 1024, 2 * DFF, WSP(bf16_t, WS_WF2I), 2 * DFF, ColSwiglu{}, INP(23), scr, gw, NGW, lane);
    }
    { SplitWait H{sgen}; H.wait(); }
    }

    if (RUNP(6)) {
    if (PH(11)) {
        pg8::Gemm g{WSP(bf16_t, WS_Y), WSP(bf16_t, WS_WO), TOK, 1024, 1024}; pg8::StaticOrder S; S.init(TOK, 1024, G, bx);
        EpiResid<true, false> E{OUTP, nullptr, WSP(bf16_t, WS_X2B), WSP(float, WS_SSQ2), 1.0f, 0};
        S.set(g); pg8::gemm_phase(lds, S, E);
    }
    GRID_BAR();
    }

    if (RUNP(7)) {
    if (PH(12)) {
        pg8::Gemm g{WSP(bf16_t, WS_X2B), WSP(bf16_t, WS_WF2I), TOK, 2 * DFF, 1024}; pg8::StaticOrder S; S.init(TOK, 2 * DFF, G, bx);
        prep_rs(WSP(float, WS_SSQ2), 0, S, lds);
        EpiSwiglu E{WSP(bf16_t, WS_ACT2), (const LAS float*)(lds + RTAB_OFF)};
        S.set(g); pg8::gemm_phase(lds, S, E);
    }
    GRID_BAR();
    }

    if (RUNP(8))
    if (PH(13)) {
        pg8::Gemm g{WSP(bf16_t, WS_ACT2), WSP(bf16_t, WS_WF2O), TOK, 1024, DFF}; pg8::StaticOrder S; S.init(TOK, 1024, G, bx);
        EpiResid<true, true> E{WSP(bf16_t, WS_X2B), OUTP, nullptr, nullptr, 0.5f, 0};
        S.set(g); pg8::gemm_phase(lds, S, E);
    }
    if (pass_ == 0) GRID_BAR();
    }
}

extern "C" void kernel_launch(void* const* d_in, const int* in_sizes, int n_in, void* d_out, int out_size, void* d_ws, size_t ws_size, hipStream_t stream) {
    static int grid = 0;
    if (grid == 0) {
        if (n_in != 26 || ws_size < WS_END) { fprintf(stderr, "kernel_launch: unexpected inputs (n_in %d, ws %zu)\n", n_in, ws_size); grid = -1; return; }
        int dev = 0, cus = 0;
        if (hipGetDevice(&dev) != hipSuccess || hipDeviceGetAttribute(&cus, hipDeviceAttributeMultiprocessorCount, dev) != hipSuccess) { grid = -1; return; }
        if (hipFuncSetAttribute((const void*)mk_fwd, hipFuncAttributeMaxDynamicSharedMemorySize, LDS_BYTES) != hipSuccess) { fprintf(stderr, "kernel_launch: hipFuncSetAttribute failed\n"); grid = -1; return; }
        grid = cus;
    }
    if (grid < 0) return;
    (void)hipMemsetAsync((char*)d_ws + WS_CTL, 0, CTL_ZERO_BYTES, stream);
    Args a{};
    for (int i = 0; i < 26; ++i) a.in[i] = d_in[i];
    a.out = (float*)d_out; a.ws = (unsigned char*)d_ws;
    hipLaunchKernelGGL(mk_fwd, dim3(grid), dim3(NWAVES * 64), LDS_BYTES, stream, a);
}
```

```cpp
#include <hip/hip_runtime.h>
#include <cstdio>
#include <cstdint>

#define LAS __attribute__((address_space(3)))
#define GAS __attribute__((address_space(1)))
typedef unsigned short bf16_t;
typedef short bf16x8 __attribute__((ext_vector_type(8)));
typedef float f32x4 __attribute__((ext_vector_type(4)));
typedef float f32x2 __attribute__((ext_vector_type(2)));
typedef unsigned u32x4 __attribute__((ext_vector_type(4)));
typedef unsigned u32x2 __attribute__((ext_vector_type(2)));

constexpr int NB = 8, SEQ = 2048, DM = 1024, TOK = NB * SEQ, MEML = 256, DFF = 2816;
constexpr int NMIX = 8192;
constexpr float EPS = 1e-6f;
constexpr float LOG2E = 1.4426950408889634f;
constexpr float C2Q = 0.125f * LOG2E;
constexpr float LAM_INIT = 0.2f;

constexpr size_t MiB = 1u << 20;
constexpr size_t KiB = 1u << 10;
constexpr size_t WS_CTL = 0, CTL_ZERO_BYTES = 256 * KiB;
constexpr size_t WS_SSQ1 = 256 * KiB, WS_SSQ2 = 512 * KiB;
constexpr size_t WS_ROT = 1 * MiB, WS_ROTB = 153 * MiB;
constexpr size_t WS_MKN = 3 * MiB, WS_MVT = 7 * MiB;
constexpr size_t WS_WMIX = 11 * MiB;
constexpr size_t WS_XB = 27 * MiB;
constexpr size_t WS_RET = 59 * MiB;
constexpr size_t WS_XBL = 91 * MiB;
constexpr size_t WS_DIF = 123 * MiB;
constexpr size_t WS_MO = 155 * MiB;
constexpr size_t WS_Q = 187 * MiB, WS_K = 191 * MiB, WS_KTS = 195 * MiB, WS_VT = 199 * MiB, WS_DQ = 207 * MiB, WS_DK = 211 * MiB,
                 WS_DV = 215 * MiB;
constexpr size_t SET_DELTA = 160 * MiB;
constexpr size_t WS_WRG = 219 * MiB;
constexpr size_t WS_O0 = 223 * MiB, WS_O1 = 227 * MiB, WS_S = 231 * MiB;
constexpr size_t WS_OB = 24 * MiB;
constexpr size_t WS_WF1I = 59 * MiB, WS_WF1O = 70 * MiB;
constexpr size_t WS_MEMN = 76 * MiB, WS_MKVRAW = 80 * MiB, WS_WMKV = 27 * MiB;
constexpr size_t WS_ACT = 155 * MiB;
constexpr size_t WS_WGATE = 11 * MiB, WS_WBRR = 17 * MiB, WS_WBRD = 21 * MiB, WS_WBRM = 23 * MiB, WS_WO = 25 * MiB;
constexpr size_t WS_G8A = 187 * MiB, WS_G8B = 203 * MiB, WS_G8C = 223 * MiB;
constexpr size_t WS_Y = 27 * MiB;
constexpr size_t WS_X2B = 187 * MiB;
constexpr size_t WS_WF2I = 239 * MiB, WS_WF2O = 1 * MiB, WS_ACT2 = 76 * MiB;
constexpr size_t WS_END = 256 * MiB;

constexpr int CW_BAR = 4096, CW_BAR2 = 8192;
constexpr int CW_QUEUE = 32768;
constexpr int CW_SCAN = 16384;

constexpr int RING_BYTES = 131072, LDSCTL_OFF = RING_BYTES, MISC_OFF = LDSCTL_OFF + 320, LDS_BYTES = 147456;
constexpr int NWAVES = 8;

__device__ __forceinline__ unsigned cvt_pk_bf16(float lo, float hi) { unsigned r; asm volatile("v_cvt_pk_bf16_f32 %0, %1, %2" : "=v"(r) : "v"(lo), "v"(hi)); return r; }
__device__ __forceinline__ u32x2 pack4(f32x4 v) { u32x2 w; w.x = cvt_pk_bf16(v[0], v[1]); w.y = cvt_pk_bf16(v[2], v[3]); return w; }
__device__ __forceinline__ unsigned short bf16_1(float v) { return (unsigned short)(cvt_pk_bf16(v, 0.f) & 0xffffu); }
__device__ __forceinline__ float bf2f(unsigned short b) { return __uint_as_float(((unsigned)b) << 16); }
__device__ __forceinline__ float siluf(float x) { return x * __builtin_amdgcn_rcpf(1.0f + __builtin_amdgcn_exp2f(-x * LOG2E)); }
__device__ __forceinline__ float sigmf(float x) { return __builtin_amdgcn_rcpf(1.0f + __builtin_amdgcn_exp2f(-x * LOG2E)); }
__device__ __forceinline__ float row_rs(const float* ssq, int row) {
    const f32x4 a = *(const f32x4*)(ssq + (size_t)row * 4);
    return __builtin_amdgcn_rsqf(((a[0] + a[1]) + (a[2] + a[3])) * (1.0f / 1024.0f) + EPS);
}
__device__ __forceinline__ int opaque_tid() { int t = threadIdx.x; asm volatile("" : "+v"(t)); return t; }
__device__ __forceinline__ f32x4 mfma16(bf16x8 a, bf16x8 b, f32x4 c) { return __builtin_amdgcn_mfma_f32_16x16x32_bf16(a, b, c, 0, 0, 0); }

namespace pg8 {
constexpr int BM = 256, BK = 64, HALF = 128, HTB = HALF * BK * 2, STAGE_BYTES = 8 * HTB, NXCD = 8, WGM = 8;
__host__ __device__ __forceinline__ int lds_byte(int r, int c) { const int st = (r >> 4) * 2 + (c >> 5), rr = r & 15, cc = c & 31, ob = rr * 64 + cc * 2; return st * 1024 + (ob ^ (((ob >> 9) & 1) << 5)); }
__host__ __device__ __forceinline__ void stage_rc(int b, int& R, int& C) { const int st = b / 1024, sb = b % 1024, swz = sb ^ (((sb >> 9) & 1) << 5); R = (st >> 1) * 16 + swz / 64; C = (st & 1) * 32 + (swz % 64) / 2; }
struct Unit { int pm, pn, ui, ri, tag, K; const char* A; const char* Bt; };
struct Gemm { const bf16_t* A; const bf16_t* Bt; int M, N, K; };
struct StaticOrder {
    int nM, nN, nwg, G, c; Gemm g;
    __host__ __device__ void init(int M, int N, int G_, int c_) { nM = M / BM; nN = N / BM; nwg = nM * nN; G = G_; c = c_; g.A = nullptr; g.Bt = nullptr; g.M = M; g.N = N; g.K = 0; }
    __host__ __device__ void set(const Gemm& g_) { g = g_; }
    __host__ __device__ bool tile(int i, int& pm, int& pn) const {
        const long L = (long)i * G + c; if (L >= nwg) return false;
        int wgid = (int)L; { const int q = nwg / NXCD, r = nwg % NXCD, xcd = wgid % NXCD, off = wgid / NXCD; wgid = (xcd < r ? xcd * (q + 1) : r * (q + 1) + (xcd - r) * q) + off; }
        const int nig = WGM * nN, gid = wgid / nig, fm = gid * WGM, gsz = (nM - fm) < WGM ? (nM - fm) : WGM;
        pm = fm + ((wgid % nig) % gsz); pn = (wgid % nig) / gsz; return true;
    }
    __host__ __device__ bool next(int i, Unit& u) const {
        if (!tile(i, u.pm, u.pn)) return false;
        u.ui = i; u.ri = i; u.tag = 0; u.K = g.K;
        u.A = (const char*)g.A + (size_t)u.pm * 256 * g.K * 2; u.Bt = (const char*)g.Bt + (size_t)u.pn * 256 * g.K * 2; return true;
    }
};
struct NoHook { __device__ __forceinline__ void wait() const {} };
template <class Epi, class Sched, class Hook = NoHook>
__device__ __forceinline__ void gemm_phase(LAS unsigned char* lds, const Sched& S, const Epi& E, const Hook& H = Hook{}) {
    const int tid = opaque_tid(), wid = __builtin_amdgcn_readfirstlane(tid >> 6), lane = tid & 63, wr = wid >> 2, wc = wid & 3, fr = lane & 15, fq = lane >> 4;
    unsigned R2[2], C2[2];
#pragma unroll
    for (int i = 0; i < 2; ++i) { int R, C; stage_rc(tid * 16 + i * 8192, R, C); R2[i] = (unsigned)R * 2u; C2[i] = (unsigned)C * 2u; }
    const size_t kstep = (size_t)(BK * 2);
    const unsigned ldsw = (unsigned)wid * 1024u;
    const int aoff = lds_byte(wr * 64 + fr, fq * 8), boff = lds_byte(wc * 32 + fr, fq * 8);
#define PG8_SA(b, h) (((b) * 2 + (h)) * HTB)
#define PG8_SB(b, h) ((4 + (b) * 2 + (h)) * HTB)
#define PG8_STAGE(bufoff, gbase, voff) do { _Pragma("unroll") for (int _i = 0; _i < 2; ++_i) \
        __builtin_amdgcn_global_load_lds((const unsigned*)((const char*)(gbase) + (voff)[_i]), (LAS unsigned*)(lds + (bufoff) + ldsw + _i * 8192), 16, 0, 0); } while (0)
#define PG8_LDA(dst, b, h) do { _Pragma("unroll") for (int m = 0; m < 4; ++m) _Pragma("unroll") for (int k = 0; k < 2; ++k) dst[m][k] = *(const LAS bf16x8*)(lds + PG8_SA(b, h) + aoff + m * 2048 + k * 1024); } while (0)
#define PG8_LDB(dst, b, h) do { _Pragma("unroll") for (int n = 0; n < 2; ++n) _Pragma("unroll") for (int k = 0; k < 2; ++k) dst[n][k] = *(const LAS bf16x8*)(lds + PG8_SB(b, h) + boff + n * 2048 + k * 1024); } while (0)
#define PG8_MMA(ai, bj, At, Bt) do { __builtin_amdgcn_s_setprio(1); _Pragma("unroll") for (int m = 0; m < 4; ++m) _Pragma("unroll") for (int n = 0; n < 2; ++n) _Pragma("unroll") for (int k = 0; k < 2; ++k) \
        acc[ai][bj][m][n] = __builtin_amdgcn_mfma_f32_16x16x32_bf16(Bt[n][k], At[m][k], acc[ai][bj][m][n], 0, 0, 0); __builtin_amdgcn_s_setprio(0); } while (0)
#define PG8_WAIT_V(n) asm volatile("s_waitcnt vmcnt(" #n ")" ::: "memory")
#define PG8_WAIT_L(n) asm volatile("s_waitcnt lgkmcnt(" #n ")" ::: "memory")
#define PG8_BAR __builtin_amdgcn_s_barrier()
#define PG8_SCHED __builtin_amdgcn_sched_barrier(0)
    Unit cur, nxt; int ui = 0;
    if (!S.next(0, cur)) return;
    f32x4 acc[2][2][4][2];
#pragma unroll
    for (int a = 0; a < 2; ++a)
#pragma unroll
        for (int b = 0; b < 2; ++b)
#pragma unroll
            for (int m = 0; m < 4; ++m)
#pragma unroll
                for (int n = 0; n < 2; ++n) acc[a][b][m][n] = (f32x4){0.f, 0.f, 0.f, 0.f};
    bf16x8 At[4][2], B0[2][2], B1[2][2];
    const char* cA = cur.A; const char* cB = cur.Bt;
    unsigned vo[2] = {R2[0] * (unsigned)cur.K + C2[0], R2[1] * (unsigned)cur.K + C2[1]};
    size_t hstep = (size_t)HALF * cur.K * 2;
    PG8_STAGE(PG8_SB(0, 0), cB, vo); PG8_STAGE(PG8_SB(0, 1), cB + hstep, vo); PG8_STAGE(PG8_SA(0, 0), cA, vo); PG8_STAGE(PG8_SA(0, 1), cA + hstep, vo);
    if (wr == 1) PG8_BAR;
    PG8_WAIT_V(2); PG8_BAR;
    PG8_STAGE(PG8_SB(1, 0), cB + kstep, vo); PG8_STAGE(PG8_SA(1, 0), cA + kstep, vo); PG8_STAGE(PG8_SB(1, 1), cB + hstep + kstep, vo);
    PG8_WAIT_V(6); PG8_BAR;
    for (;;) {
        const bool has_next = S.next(ui + 1, nxt);
        if (!has_next) nxt = cur;
        const char* nA = nxt.A; const char* nB = nxt.Bt;
        const unsigned voN0 = R2[0] * (unsigned)nxt.K + C2[0], voN1 = R2[1] * (unsigned)nxt.K + C2[1]; const size_t hstepN = (size_t)HALF * nxt.K * 2;
        const int nt = cur.K / BK;
        for (int t = 0; t < nt; t += 2) {
            const bool last = (t == nt - 2);
            const char* a1 = cA + (size_t)(t + 1) * kstep;
            const char* a2 = last ? nA : cA + (size_t)(t + 2) * kstep; const char* b2 = last ? nB : cB + (size_t)(t + 2) * kstep;
            const char* a3 = a2 + kstep; const char* b3 = b2 + kstep;
            const unsigned v2[2] = {last ? voN0 : vo[0], last ? voN1 : vo[1]}; const size_t h2 = last ? hstepN : hstep;
            PG8_LDB(B0, 0, 0); PG8_LDB(B1, 0, 1); PG8_SCHED; PG8_LDA(At, 0, 0); PG8_STAGE(PG8_SA(1, 1), a1 + hstep, vo);
            PG8_WAIT_V(8); PG8_WAIT_L(0); PG8_BAR; PG8_MMA(0, 0, At, B0); PG8_MMA(0, 1, At, B1); PG8_BAR; PG8_SCHED;
            PG8_LDA(At, 0, 1); PG8_STAGE(PG8_SB(0, 0), b2, v2); PG8_STAGE(PG8_SB(0, 1), b2 + h2, v2); PG8_STAGE(PG8_SA(0, 0), a2, v2);
            PG8_WAIT_V(8); PG8_WAIT_L(0); PG8_BAR; PG8_MMA(1, 0, At, B0); PG8_MMA(1, 1, At, B1); PG8_BAR; PG8_SCHED;
            PG8_LDB(B0, 1, 0); PG8_LDB(B1, 1, 1); PG8_SCHED; PG8_LDA(At, 1, 0); PG8_STAGE(PG8_SA(0, 1), a2 + h2, v2);
            PG8_WAIT_V(8); PG8_WAIT_L(0); PG8_BAR; PG8_MMA(0, 0, At, B0); PG8_MMA(0, 1, At, B1); PG8_BAR; PG8_SCHED;
            PG8_LDA(At, 1, 1); PG8_STAGE(PG8_SB(1, 0), b3, v2); PG8_STAGE(PG8_SB(1, 1), b3 + h2, v2); PG8_STAGE(PG8_SA(1, 0), a3, v2);
            PG8_WAIT_V(8); PG8_WAIT_L(0); PG8_BAR; PG8_MMA(1, 0, At, B0); PG8_MMA(1, 1, At, B1); PG8_BAR; PG8_SCHED;
        }
        if (wr == 0) PG8_BAR;
        if (ui == 0 && (!Epi::AFTER_DRAIN || has_next)) H.wait();
        if (!Epi::AFTER_DRAIN || has_next) { int fr2 = fr, fq2 = fq; asm volatile("" : "+v"(fr2), "+v"(fq2)); E(acc, cur, wr, wc, fr2, fq2); }
        if (!has_next) break;
#pragma unroll
        for (int a = 0; a < 2; ++a)
#pragma unroll
            for (int b = 0; b < 2; ++b)
#pragma unroll
                for (int m = 0; m < 4; ++m)
#pragma unroll
                    for (int n = 0; n < 2; ++n) acc[a][b][m][n] = (f32x4){0.f, 0.f, 0.f, 0.f};
        cur = nxt; cA = nA; cB = nB; vo[0] = voN0; vo[1] = voN1; hstep = hstepN; ++ui;
        if (wr == 1) PG8_BAR;
    }
    PG8_WAIT_V(0);
    PG8_BAR;
    if constexpr (Epi::AFTER_DRAIN) { if (ui == 0) H.wait(); }
    if constexpr (Epi::AFTER_DRAIN) { int fr2 = fr, fq2 = fq; asm volatile("" : "+v"(fr2), "+v"(fq2)); E.fused(acc, cur, wr, wc, fr2, fq2, lds); }
#undef PG8_SA
#undef PG8_SB
#undef PG8_STAGE
#undef PG8_LDA
#undef PG8_LDB
#undef PG8_MMA
#undef PG8_WAIT_V
#undef PG8_WAIT_L
#undef PG8_BAR
#undef PG8_SCHED
}
}

__device__ __forceinline__ float wave_sum(float v);
#define ACC_ARG const f32x4 (&acc)[2][2][4][2]
#define EPI_FENCE() asm volatile("" ::: "memory")
constexpr int RTAB_OFF = RING_BYTES + 1024;
__device__ __forceinline__ void prep_rs(const float* ssq, int row_off, const pg8::StaticOrder& S, LAS unsigned char* lds) {
    const int tid = opaque_tid(); LAS float* rtab = (LAS float*)(lds + RTAB_OFF); pg8::Unit u;
    for (int i = 0; i < 6 && S.next(i, u); ++i) if (tid < 256) rtab[i * 256 + tid] = row_rs(ssq, row_off + u.pm * 256 + tid);
    __syncthreads();
}
struct EpiSwiglu {
    static constexpr bool AFTER_DRAIN = false;
    bf16_t* O; const LAS float* rtab;
    __device__ __forceinline__ void operator()(ACC_ARG, const pg8::Unit& u, int wr, int wc, int fr, int fq) const {
        const int lr0 = wr * 64 + fr, col0 = u.pn * 128 + wc * 32 + 8 * fq;
#pragma unroll
        for (int ai = 0; ai < 2; ++ai)
#pragma unroll
            for (int m = 0; m < 4; ++m) {
                const int lr = lr0 + ai * 128 + m * 16;
                const float rs = rtab ? rtab[u.ri * 256 + lr] : 1.0f;
                u32x4 w;
#pragma unroll
                for (int n = 0; n < 2; ++n) {
                    const f32x4 gt = acc[ai][0][m][n] * rs, up = acc[ai][1][m][n] * rs; f32x4 v;
#pragma unroll
                    for (int j = 0; j < 4; ++j) v[j] = siluf(gt[j]) * up[j];
                    const u32x2 p = pack4(v); if (n == 0) { w.x = p.x; w.y = p.y; } else { w.z = p.x; w.w = p.y; }
                }
                *(u32x4*)(O + (size_t)(u.pm * 256 + lr) * DFF + col0) = w;
            }
    }
};
template <bool BB, bool OF>
struct EpiResid {
    static constexpr bool AFTER_DRAIN = true;
    const void* base; float* out; bf16_t* xb; float* ssq; float scale; int skip;
    __device__ __forceinline__ f32x4 ldb(size_t off) const {
        if (BB) { const u32x2 w = __builtin_nontemporal_load((const u32x2*)((const bf16_t*)base + off));
                  return (f32x4){__uint_as_float(w.x << 16), __uint_as_float(w.x & 0xffff0000u), __uint_as_float(w.y << 16), __uint_as_float(w.y & 0xffff0000u)}; }
        return __builtin_nontemporal_load((const f32x4*)((const float*)base + off));
    }
    __device__ __forceinline__ void operator()(ACC_ARG, const pg8::Unit& u, int wr, int wc, int fr, int fq) const {
        if (skip) return;
        const int row0 = u.pm * 256 + wr * 64 + fr, col0 = u.pn * 256 + wc * 32 + 4 * fq;
#pragma unroll
        for (int ai = 0; ai < 2; ++ai)
#pragma unroll
            for (int m = 0; m < 4; ++m) {
                const int row = row0 + ai * 128 + m * 16; float ss = 0.f;
#pragma unroll
                for (int bj = 0; bj < 2; ++bj)
#pragma unroll
                    for (int n = 0; n < 2; ++n) {
                        const size_t off = (size_t)row * DM + col0 + bj * 128 + n * 16;
                        const f32x4 v = ldb(off) + acc[ai][bj][m][n] * scale;
                        if (OF) *(f32x4*)(out + off) = v; else *(u32x2*)(xb + off) = pack4(v);
                        ss += (v[0] * v[0] + v[1] * v[1]) + (v[2] * v[2] + v[3] * v[3]);
                    }
                if (!OF) { ss += __shfl_xor(ss, 16); ss += __shfl_xor(ss, 32); if (fq == 0) atomicAdd(ssq + (size_t)row * 4 + u.pn, ss); }
            }
    }
    __device__ __forceinline__ void fused(ACC_ARG, const pg8::Unit& u, int wr, int wc, int fr, int fq, LAS unsigned char* lds) const {
        if (skip) return;
        const int tid = opaque_tid(), lane = tid & 63, wave = __builtin_amdgcn_readfirstlane(tid >> 6);
        LAS float* tl = (LAS float*)lds;
#pragma unroll
        for (int ai = 0; ai < 2; ++ai)
#pragma unroll
            for (int wq = 0; wq < 2; ++wq) {
                if (wr == wq) {
#pragma unroll
                    for (int m = 0; m < 4; ++m)
#pragma unroll
                        for (int bj = 0; bj < 2; ++bj)
#pragma unroll
                            for (int n = 0; n < 2; ++n) *(LAS f32x4*)(tl + (16 * m + fr) * 260 + bj * 128 + wc * 32 + n * 16 + 4 * fq) = acc[ai][bj][m][n] * scale;
                }
                __syncthreads();
                const int rbase = u.pm * 256 + ai * 128 + wq * 64;
                f32x4 bv[8];
#pragma unroll
                for (int r = 0; r < 8; ++r) bv[r] = ldb((size_t)(rbase + wave * 8 + r) * DM + u.pn * 256 + lane * 4);
#pragma unroll
                for (int r = 0; r < 8; ++r) {
                    const int row = rbase + wave * 8 + r; const size_t off = (size_t)row * DM + u.pn * 256 + lane * 4;
                    const f32x4 v = bv[r] + *(const LAS f32x4*)(tl + (wave * 8 + r) * 260 + lane * 4);
                    if (OF) __builtin_nontemporal_store(v, (f32x4*)(out + off));
                    else {
                        *(u32x2*)(xb + off) = pack4(v);
                        const float ss = wave_sum((v[0] * v[0] + v[1] * v[1]) + (v[2] * v[2] + v[3] * v[3])); if (lane == 0) ssq[(size_t)row * 4 + u.pn] = ss;
                    }
                }
                __syncthreads();
            }
    }
};
struct EpiPlain {
    static constexpr bool AFTER_DRAIN = false;
    bf16_t* O; int ldo;
    __device__ __forceinline__ void operator()(ACC_ARG, const pg8::Unit& u, int wr, int wc, int fr, int fq) const {
        const int row0 = u.pm * 256 + wr * 64 + fr, col0 = u.pn * 256 + wc * 32 + 4 * fq;
#pragma unroll
        for (int ai = 0; ai < 2; ++ai)
#pragma unroll
            for (int m = 0; m < 4; ++m)
#pragma unroll
                for (int bj = 0; bj < 2; ++bj)
#pragma unroll
                    for (int n = 0; n < 2; ++n) *(u32x2*)(O + (size_t)(row0 + ai * 128 + m * 16) * ldo + col0 + bj * 128 + n * 16) = pack4(acc[ai][bj][m][n]);
    }
};
struct EpiMix {
    static constexpr bool AFTER_DRAIN = true;
    const LAS float* rtab; const float* rot;
    unsigned char* ws  ; bf16_t* mqb  ; const float *gdq, *gdk;
    static constexpr int TLD = 136;
    __device__ __forceinline__ void flushT(bf16_t* dst  , const LAS bf16_t* TS) const {
        const int tid = opaque_tid();
#pragma unroll
        for (int i = 0; i < 8; ++i) { const int p = tid + 512 * i, c = p >> 4, r8 = p & 15; *(u32x4*)(dst + (size_t)c * SEQ + r8 * 8) = *(const LAS u32x4*)(TS + c * TLD + r8 * 8); }
    }
    __device__ __forceinline__ void operator()(ACC_ARG, const pg8::Unit& u, int wr, int wc, int fr, int fq) const { body(acc, u, wr, wc, fr, fq, nullptr); }
    __device__ __forceinline__ void fused(ACC_ARG, const pg8::Unit& u, int wr, int wc, int fr, int fq, LAS unsigned char* lds) const {
        if (u.pn >= 4 && u.pn < 16) body(acc, u, wr, wc, fr, fq, (LAS bf16_t*)lds); else body(acc, u, wr, wc, fr, fq, nullptr);
    }
    __device__ __forceinline__ void body(ACC_ARG, const pg8::Unit& u, int wr, int wc, int fr, int fq, LAS bf16_t* TS) const {
        const int pn = u.pn, lr0 = wr * 64 + fr, lrow0 = u.pm * 256 + lr0;
        if (pn < 8) {
            const bool isk = pn >= 4; const int h = pn & 3; bf16_t* dst = (bf16_t*)(ws + (isk ? WS_K : WS_Q)); bf16_t* kts = (bf16_t*)(ws + WS_KTS);
            const float lg2 = log2f(1.0f - __builtin_amdgcn_exp2f(-5.0f - (float)h));
#pragma unroll
            for (int ai = 0; ai < 2; ++ai) {
                f32x4 cs0[4][2], cs1[4][2];
#pragma unroll
                for (int m = 0; m < 4; ++m)
#pragma unroll
                    for (int n = 0; n < 2; ++n) { const f32x4* cs = (const f32x4*)(rot + ((size_t)(lrow0 + ai * 128 + m * 16) * 128 + wc * 32 + 8 * fq + 4 * n) * 2); cs0[m][n] = cs[0]; cs1[m][n] = cs[1]; }
                EPI_FENCE();
#pragma unroll
                for (int m = 0; m < 4; ++m) {
                    int lrow = lrow0 + ai * 128 + m * 16; asm volatile("" : "+v"(lrow));
                    const float rs = rtab[u.ri * 256 + lr0 + ai * 128 + m * 16] * (isk ? 0.0625f : 1.0f);
                    const float dec = __builtin_amdgcn_exp2f(lg2 * (float)(127 - (lrow & 127)));
#pragma unroll
                    for (int n = 0; n < 2; ++n) {
                        const int i0 = wc * 32 + 8 * fq + 4 * n;
                        const f32x4 c01 = cs0[m][n], c23 = cs1[m][n];
                        const f32x4 cv = (f32x4){c01[0], c01[2], c23[0], c23[2]}, sv = (f32x4){c01[1], c01[3], c23[1], c23[3]};
                        const f32x4 x1 = acc[ai][0][m][n] * rs, x2 = acc[ai][1][m][n] * rs;
                        const f32x4 o1 = x1 * cv - x2 * sv, o2 = x1 * sv + x2 * cv;
                        *(u32x2*)(dst + (size_t)lrow * 1024 + h * 256 + i0) = pack4(o1);
                        *(u32x2*)(dst + (size_t)lrow * 1024 + h * 256 + 128 + i0) = pack4(o2);
                        if (isk) {
                            if (TS) {
                                const int rl = wr * 64 + m * 16 + fr;
#pragma unroll
                                for (int j = 0; j < 4; ++j) { TS[(i0 + j) * TLD + rl] = bf16_1(o1[j] * dec); TS[(128 + i0 + j) * TLD + rl] = bf16_1(o2[j] * dec); }
                            } else {
#pragma unroll
                                for (int j = 0; j < 4; ++j) {
                                    kts[(size_t)(h * 256 + i0 + j) * SEQ + lrow] = bf16_1(o1[j] * dec);
                                    kts[(size_t)(h * 256 + 128 + i0 + j) * SEQ + lrow] = bf16_1(o2[j] * dec);
                                }
                            }
                        }
                    }
                }
                EPI_FENCE();
                if (isk && TS) { __syncthreads(); flushT(kts + (size_t)(h * 256) * SEQ + u.pm * 256 + ai * 128, TS); __syncthreads(); }
            }
        } else if (pn < 16) {
            const int h = (pn - 8) >> 1, e0 = ((pn - 8) & 1) * 256; bf16_t* vt = (bf16_t*)(ws + WS_VT);
#pragma unroll
            for (int ai = 0; ai < 2; ++ai) {
#pragma unroll
                for (int m = 0; m < 4; ++m) {
                    int lrow = lrow0 + ai * 128 + m * 16; asm volatile("" : "+v"(lrow));
                    const float rs = rtab[u.ri * 256 + lr0 + ai * 128 + m * 16];
#pragma unroll
                    for (int bj = 0; bj < 2; ++bj)
#pragma unroll
                        for (int n = 0; n < 2; ++n) {
                            const int tc = bj * 128 + wc * 32 + 8 * fq + 4 * n, ec = e0 + tc; const f32x4 v = acc[ai][bj][m][n] * rs;
                            if (TS) {
                                const int rl = wr * 64 + m * 16 + fr;
#pragma unroll
                                for (int j = 0; j < 4; ++j) TS[(tc + j) * TLD + rl] = bf16_1(v[j]);
                            } else {
#pragma unroll
                                for (int j = 0; j < 4; ++j) vt[(size_t)(h * 512 + ec + j) * SEQ + lrow] = bf16_1(v[j]);
                            }
                        }
                    EPI_FENCE();
                }
                if (TS) { __syncthreads(); flushT(vt + (size_t)(h * 512 + e0) * SEQ + u.pm * 256 + ai * 128, TS); __syncthreads(); }
            }
        } else if (pn < 24) {
            const bool isk = pn >= 20; const int tile = (pn - 16) & 3; bf16_t* dst = (bf16_t*)(ws + (isk ? WS_DK : WS_DQ)); const float* gn = isk ? gdk : gdq; const float mul = isk ? 1.0f : C2Q;
            f32x4 gv[2][2];
#pragma unroll
            for (int bj = 0; bj < 2; ++bj)
#pragma unroll
                for (int n = 0; n < 2; ++n) gv[bj][n] = *(const f32x4*)(gn + 32 * bj + 8 * fq + 4 * n);
#pragma unroll
            for (int ai = 0; ai < 2; ++ai)
#pragma unroll
                for (int m = 0; m < 4; ++m) {
                    int lrow = lrow0 + ai * 128 + m * 16; asm volatile("" : "+v"(lrow));
                    const float rs = rtab[u.ri * 256 + lr0 + ai * 128 + m * 16];
                    f32x4 v[2][2]; float ss = 0.f;
#pragma unroll
                    for (int bj = 0; bj < 2; ++bj)
#pragma unroll
                        for (int n = 0; n < 2; ++n) { v[bj][n] = acc[ai][bj][m][n] * rs; const f32x4 t = v[bj][n]; ss += (t[0] * t[0] + t[1] * t[1]) + (t[2] * t[2] + t[3] * t[3]); }
                    ss += __shfl_xor(ss, 16); ss += __shfl_xor(ss, 32);
                    const float rn = __builtin_amdgcn_rsqf(ss * (1.0f / 64.0f) + EPS) * mul;
#pragma unroll
                    for (int bj = 0; bj < 2; ++bj) { const u32x2 p0 = pack4(v[bj][0] * rn * gv[bj][0]), p1 = pack4(v[bj][1] * rn * gv[bj][1]);
                        *(u32x4*)(dst + (size_t)lrow * 1024 + tile * 256 + 64 * wc + 32 * bj + 8 * fq) = (u32x4){p0.x, p0.y, p1.x, p1.y}; }
                    EPI_FENCE();
                }
        } else {
            bf16_t* dst = pn < 28 ? (bf16_t*)(ws + WS_DV) : mqb; const int tile = (pn - 24) & 3;
#pragma unroll
            for (int ai = 0; ai < 2; ++ai)
#pragma unroll
                for (int m = 0; m < 4; ++m) {
                    int lrow = lrow0 + ai * 128 + m * 16; asm volatile("" : "+v"(lrow));
                    const float rs = rtab[u.ri * 256 + lr0 + ai * 128 + m * 16];
#pragma unroll
                    for (int bj = 0; bj < 2; ++bj) { const u32x2 p0 = pack4(acc[ai][bj][m][0] * rs), p1 = pack4(acc[ai][bj][m][1] * rs);
                        *(u32x4*)(dst + (size_t)lrow * 1024 + tile * 256 + bj * 128 + wc * 32 + 8 * fq) = (u32x4){p0.x, p0.y, p1.x, p1.y}; }
                    EPI_FENCE();
                }
        }
    }
};
struct EpiRgG {
    static constexpr bool AFTER_DRAIN = false;
    const LAS float* rtab; bf16_t* ret; const float* rssq; unsigned char* ws;
    __device__ __forceinline__ void operator()(ACC_ARG, const pg8::Unit& u, int wr, int wc, int fr, int fq) const {
        const int lr0 = wr * 64 + fr;
        if (u.pn < 8) {
            const int col0 = u.pn * 256 + wc * 32 + 8 * fq;
#pragma unroll
            for (int ai = 0; ai < 2; ++ai) {
                u32x4 rv[4][2]; f32x2 rq2[4];
#pragma unroll
                for (int m = 0; m < 4; ++m) { const int lr = lr0 + ai * 128 + m * 16;
                    rq2[m] = *(const f32x2*)(rssq + (size_t)(u.pm * 256 + lr) * 8 + 2 * (u.pn >> 1));
#pragma unroll
                    for (int bj = 0; bj < 2; ++bj) rv[m][bj] = *(const u32x4*)(ret + (size_t)(u.pm * 256 + lr) * 2048 + col0 + bj * 128); }
                EPI_FENCE();
#pragma unroll
                for (int m = 0; m < 4; ++m) {
                    const int lr = lr0 + ai * 128 + m * 16; const float rs = rtab[u.ri * 256 + lr];
                    const float rr = __builtin_amdgcn_rsqf((rq2[m][0] + rq2[m][1]) * (1.0f / 512.0f) + EPS);
#pragma unroll
                    for (int bj = 0; bj < 2; ++bj) {
                        u32x4 o;
#pragma unroll
                        for (int n = 0; n < 2; ++n) {
                            const unsigned w0 = n == 0 ? rv[m][bj].x : rv[m][bj].z, w1 = n == 0 ? rv[m][bj].y : rv[m][bj].w; const f32x4 a = acc[ai][bj][m][n] * rs; f32x4 v;
                            v[0] = __uint_as_float(w0 << 16) * siluf(a[0]); v[1] = __uint_as_float(w0 & 0xffff0000u) * siluf(a[1]);
                            v[2] = __uint_as_float(w1 << 16) * siluf(a[2]); v[3] = __uint_as_float(w1 & 0xffff0000u) * siluf(a[3]);
                            const u32x2 p = pack4(v * rr); if (n == 0) { o.x = p.x; o.y = p.y; } else { o.z = p.x; o.w = p.y; }
                        }
                        *(u32x4*)(ret + (size_t)(u.pm * 256 + lr) * 2048 + col0 + bj * 128) = o;
                    }
                }
                EPI_FENCE();
            }
        } else {
            const int br = (u.pn - 8) >> 2, col0 = ((u.pn - 8) & 3) * 256 + wc * 32 + 8 * fq;
            unsigned char* g8 = ws + (br == 0 ? WS_G8A : br == 1 ? WS_G8B : WS_G8C);
#pragma unroll
            for (int ai = 0; ai < 2; ++ai)
#pragma unroll
                for (int m = 0; m < 4; ++m) {
                    const int lr = lr0 + ai * 128 + m * 16; const float rs = rtab[u.ri * 256 + lr];
#pragma unroll
                    for (int bj = 0; bj < 2; ++bj) {
                        u32x2 w2;
#pragma unroll
                        for (int n = 0; n < 2; ++n) {
                            const f32x4 a = acc[ai][bj][m][n] * rs; unsigned w = 0u;
#pragma unroll
                            for (int j = 0; j < 4; ++j) w |= (unsigned)__builtin_rintf(255.0f * sigmf(a[j])) << (8 * j);
                            if (n == 0) w2.x = w; else w2.y = w;
                        }
                        *(u32x2*)(g8 + (size_t)(u.pm * 256 + lr) * DM + col0 + bj * 128) = w2;
                    }
                }
        }
    }
};
struct EpiTerm3 {
    static constexpr bool AFTER_DRAIN = false;
    unsigned char* ws; bf16_t* y;
    __device__ __forceinline__ void operator()(ACC_ARG, const pg8::Unit& u, int wr, int wc, int fr, int fq) const {
        const int lr0 = wr * 64 + fr, col0 = u.pn * 256 + wc * 32 + 8 * fq, first = (u.tag == 0);
        const unsigned char* g8 = ws + (u.tag == 0 ? WS_G8A : u.tag == 1 ? WS_G8B : WS_G8C);
#pragma unroll
        for (int ai = 0; ai < 2; ++ai) {
            u32x2 gv[4][2]; u32x4 yv[4][2];
#pragma unroll
            for (int m = 0; m < 4; ++m)
#pragma unroll
                for (int bj = 0; bj < 2; ++bj) { const size_t off = (size_t)(u.pm * 256 + lr0 + ai * 128 + m * 16) * DM + col0 + bj * 128;
                    gv[m][bj] = *(const u32x2*)(g8 + off); yv[m][bj] = first ? (u32x4){0u, 0u, 0u, 0u} : *(const u32x4*)(y + off); }
            EPI_FENCE();
#pragma unroll
            for (int m = 0; m < 4; ++m)
#pragma unroll
                for (int bj = 0; bj < 2; ++bj) {
                    const size_t off = (size_t)(u.pm * 256 + lr0 + ai * 128 + m * 16) * DM + col0 + bj * 128;
                    u32x4 o;
#pragma unroll
                    for (int n = 0; n < 2; ++n) {
                        const f32x4 a = acc[ai][bj][m][n]; const unsigned gw = n == 0 ? gv[m][bj].x : gv[m][bj].y; const unsigned w0 = n == 0 ? yv[m][bj].x : yv[m][bj].z, w1 = n == 0 ? yv[m][bj].y : yv[m][bj].w; f32x4 v;
                        v[0] = (float)(gw & 255u) * (1.0f / 255.0f) * a[0] + __uint_as_float(w0 << 16); v[1] = (float)((gw >> 8) & 255u) * (1.0f / 255.0f) * a[1] + __uint_as_float(w0 & 0xffff0000u);
                        v[2] = (float)((gw >> 16) & 255u) * (1.0f / 255.0f) * a[2] + __uint_as_float(w1 << 16); v[3] = (float)(gw >> 24) * (1.0f / 255.0f) * a[3] + __uint_as_float(w1 & 0xffff0000u);
                        const u32x2 p = pack4(v); if (n == 0) { o.x = p.x; o.y = p.y; } else { o.z = p.x; o.w = p.y; }
                    }
                    *(u32x4*)(y + off) = o;
                }
            EPI_FENCE();
        }
    }
};

#include <hip/hip_bf16.h>
namespace attn_body {
using bf16=__hip_bfloat16;
using bf16x8=__attribute__((ext_vector_type(8)))short;
using s16x4=__attribute__((ext_vector_type(4)))short;
using f32x16=__attribute__((ext_vector_type(16)))float;
using u32x4=__attribute__((ext_vector_type(4)))unsigned;
constexpr int D=64,DM=1024;
constexpr int NW=8,QBLK=32,QB=QBLK*NW,KVBLK=64;
__device__ __forceinline__ int crow(int r,int hi){return (r&3)+8*(r>>2)+4*hi;}
#define SBAR() __builtin_amdgcn_sched_barrier(0)
__device__ __forceinline__ void cmask(f32x16&p0,f32x16&p1,int jb,int qrel,int hi){
  const float NEG=-INFINITY; int kb=64*jb+4*hi;
  #pragma unroll
  for(int r=0;r<16;++r){int kv=kb+(r&3)+8*(r>>2); if(kv>qrel)p0[r]=NEG; if(kv+32>qrel)p1[r]=NEG;}
}
constexpr int NSLOT=3, SLOTB=8192;
constexpr int LDS_K=0, LDS_V=NSLOT*SLOTB, LDS_WS=LDS_V+2*NSLOT*SLOTB, LDS_OST=LDS_WS+NW*64*4, LDS_BYTES=LDS_OST+NW*4096;
__device__ __forceinline__ void glds16(const void*gsrc,unsigned lds_dst){unsigned keep;
  asm volatile("s_mov_b32 %0, m0\n\ts_mov_b32 m0, %2\n\ts_nop 0\n\tglobal_load_lds_dwordx4 %1, off\n\ts_mov_b32 m0, %0":"=&s"(keep):"v"(gsrc),"s"(lds_dst):"memory");}
__device__ __forceinline__ float max3f(float a,float b,float c){float r;asm("v_max3_f32 %0, %1, %2, %3":"=v"(r):"v"(a),"v"(b),"v"(c));return r;}
__device__ __forceinline__ float max2f(float a,float b){float r;asm("v_max_f32_e32 %0, %1, %2":"=v"(r):"v"(a),"v"(b));return r;}
__device__ __forceinline__ float fadd_s(float a,float b){float r;asm("v_add_f32_e32 %0, %1, %2":"=v"(r):"v"(a),"v"(b));return r;}
__device__ __forceinline__ float fsub_s(float a,float b){float r;asm("v_sub_f32_e32 %0, %1, %2":"=v"(r):"v"(a),"v"(b));return r;}
typedef float f32x2_t __attribute__((ext_vector_type(2))); typedef __bf16 bf16x2_t __attribute__((ext_vector_type(2)));
__device__ __forceinline__ unsigned cvtpk_s(float lo,float hi){f32x2_t v={lo,hi};bf16x2_t b=__builtin_convertvector(v,bf16x2_t);return __builtin_bit_cast(unsigned,b);}
#define WAIT_BAR(N) asm volatile("s_waitcnt vmcnt(" #N ") lgkmcnt(0)\n\ts_barrier":::"memory")
__device__ __forceinline__ void qkt(f32x16&p0,f32x16&p1,const char*Kslot,const bf16x8*qr,const f32x16&negm,int r32,int hi){
  const char*kb=Kslot+hi*1024+r32*16;
  #pragma unroll
  for(int d0=0;d0<4;++d0){
    const bf16x8 b0=*reinterpret_cast<const bf16x8*>(kb+d0*2048);
    const bf16x8 b1=*reinterpret_cast<const bf16x8*>(kb+d0*2048+512);
    if(d0==0){p0=__builtin_amdgcn_mfma_f32_32x32x16_bf16(b0,qr[0],negm,0,0,0);p1=__builtin_amdgcn_mfma_f32_32x32x16_bf16(b1,qr[0],negm,0,0,0);}
    else{p0=__builtin_amdgcn_mfma_f32_32x32x16_bf16(b0,qr[d0],p0,0,0,0);p1=__builtin_amdgcn_mfma_f32_32x32x16_bf16(b1,qr[d0],p1,0,0,0);}}
}
typedef __attribute__((address_space(3))) const char* lds_cptr;
typedef short v4i16_t __attribute__((ext_vector_type(4)));
__device__ __forceinline__ void kload8(bf16x8*kf,lds_cptr kp){
  kf[0]=*(const __attribute__((address_space(3))) bf16x8*)(kp);      kf[1]=*(const __attribute__((address_space(3))) bf16x8*)(kp+512);
  kf[2]=*(const __attribute__((address_space(3))) bf16x8*)(kp+2048); kf[3]=*(const __attribute__((address_space(3))) bf16x8*)(kp+2560);
  kf[4]=*(const __attribute__((address_space(3))) bf16x8*)(kp+4096); kf[5]=*(const __attribute__((address_space(3))) bf16x8*)(kp+4608);
  kf[6]=*(const __attribute__((address_space(3))) bf16x8*)(kp+6144); kf[7]=*(const __attribute__((address_space(3))) bf16x8*)(kp+6656);
}
__device__ __forceinline__ void kload2(bf16x8*kf,lds_cptr kp,int j){ kf[2*j]=*(const __attribute__((address_space(3))) bf16x8*)(kp+j*2048); kf[2*j+1]=*(const __attribute__((address_space(3))) bf16x8*)(kp+j*2048+512); }
__device__ __forceinline__ s16x4 vtr(lds_cptr p){ return __builtin_bit_cast(s16x4,__builtin_amdgcn_ds_read_tr16_b64_v4i16((__attribute__((address_space(3))) v4i16_t*)p)); }
__device__ __forceinline__ float rowmax(const f32x16&p0,const f32x16&p1){
  float a=max3f(p0[0],p0[1],p1[0]),b=max3f(p0[2],p0[3],p1[1]);a=max3f(a,p1[2],p1[3]);
  #pragma unroll
  for(int r=4;r<16;r+=4){a=max3f(a,p0[r],p0[r+1]);b=max3f(b,p0[r+2],p0[r+3]);a=max3f(a,p1[r],p1[r+1]);b=max3f(b,p1[r+2],p1[r+3]);}
  const float m=max2f(a,b);
  auto rr=__builtin_amdgcn_permlane32_swap(__float_as_uint(m),__float_as_uint(m),false,false);
  return max2f(__uint_as_float(rr[0]),__uint_as_float(rr[1]));
}
__device__ __forceinline__ void pv(f32x16*o,int vb,bf16x8 pa0,bf16x8 pa1,bf16x8 pa2,bf16x8 pa3){
  #pragma unroll
  for(int d0=0;d0<4;++d0){s16x4 lo[4],hi[4];
    #pragma unroll
    for(int ks=0;ks<4;++ks){
      asm volatile("ds_read_b64_tr_b16 %0,%1 offset:%c2":"=&v"(lo[ks]):"v"(vb),"i"(d0*4096+ks*1024):"memory");
      asm volatile("ds_read_b64_tr_b16 %0,%1 offset:%c2":"=&v"(hi[ks]):"v"(vb),"i"(d0*4096+ks*1024+512):"memory");}
    asm volatile("s_waitcnt lgkmcnt(0)":::"memory");SBAR();
    #define PK(k) (bf16x8){lo[k][0],lo[k][1],lo[k][2],lo[k][3],hi[k][0],hi[k][1],hi[k][2],hi[k][3]}
    o[d0]=__builtin_amdgcn_mfma_f32_32x32x16_bf16(pa0,PK(0),o[d0],0,0,0);
    o[d0]=__builtin_amdgcn_mfma_f32_32x32x16_bf16(pa1,PK(1),o[d0],0,0,0);
    o[d0]=__builtin_amdgcn_mfma_f32_32x32x16_bf16(pa2,PK(2),o[d0],0,0,0);
    o[d0]=__builtin_amdgcn_mfma_f32_32x32x16_bf16(pa3,PK(3),o[d0],0,0,0);
    #undef PK
  }
}
#define ATTN_STORE16(p,v) (*(u32x4*)(p)=(v))
template<int THRL> __device__ __forceinline__ void attn_unit(int hq,int hv,int qb,const bf16*Q,const bf16*__restrict__ K,const bf16*__restrict__ V,bf16*O,char*shm){
  const int tid=opaque_tid(),lane=tid&63,r32=lane&31,hi=lane>>5; const int wid=__builtin_amdgcn_readfirstlane(tid>>6);
  const int q0=qb*QB;
  const bf16*Qw=Q+(long)(q0+wid*QBLK)*DM+hq*D;
  const bf16*Kh=K+hq*D,*Vh=V+hv*128;
  const unsigned lds0=(unsigned)(uintptr_t)shm;
  float*wsf=(float*)(shm+LDS_WS)+wid*64;
  const bf16*ksrc=Kh+(long)lane*DM+wid*8;
  const bf16*vsrc=Vh+(long)(16*(wid&3)+(lane>>2))*DM+(wid>>2)*32+(lane&3)*8;
  const unsigned kdst=lds0+LDS_K+wid*1024, vdst=lds0+LDS_V+wid*1024;
  #define DMA_K(t,slot) glds16(ksrc+(long)(t)*KVBLK*DM,(unsigned)__builtin_amdgcn_readfirstlane(kdst+(slot)))
  #define DMA_V(t,slot) do{ glds16(vsrc+(long)(t)*KVBLK*DM,(unsigned)__builtin_amdgcn_readfirstlane(vdst+2*(slot))); glds16(vsrc+(long)(t)*KVBLK*DM+64,(unsigned)__builtin_amdgcn_readfirstlane(vdst+2*(slot)+8192)); }while(0)
  const int vb0=(int)(lds0+LDS_V)+((lane>>4)&1)*32+(lane&3)*8+(4*hi+((lane&15)>>2))*64;
  const char*Kbase=shm+LDS_K; bf16x8 kf[8];
  const lds_cptr shm3=(lds_cptr)shm; const lds_cptr kp0=shm3+LDS_K+hi*1024+r32*16; const lds_cptr vp0=shm3+LDS_V+((lane>>4)&1)*32+(lane&3)*8+(4*hi+((lane&15)>>2))*64;
  const int NT=(q0+QB)/KVBLK;
  DMA_K(0,0);DMA_V(0,0);DMA_K(1,SLOTB);
  bf16x8 qr[4];
  #pragma unroll
  for(int d0=0;d0<4;++d0)qr[d0]=*reinterpret_cast<const bf16x8*>(&Qw[(long)r32*DM+d0*16+hi*8]);
  float mhat=0.f,l_reg=0.f;f32x16 o[4];o[0]=f32x16{};o[1]=f32x16{};o[2]=f32x16{};o[3]=f32x16{};asm volatile("":"+v"(o[0]),"+v"(o[1]),"+v"(o[2]),"+v"(o[3]));f32x16 negm=f32x16{};asm volatile("":"+v"(negm));
  const int qrel=wid*QBLK+r32;
  #define CMASK(P0,P1,t) do{int jb_=(t)-(NT-4); if(jb_>=0)cmask(P0,P1,jb_,qrel,hi);}while(0)
  bool resc=false;
  #define START(P0,P1) do{ const float rm=rowmax(P0,P1); resc=false; \
    { const float dl=rm; mhat=fadd_s(mhat,dl); \
      _Pragma("unroll") for(int r=0;r<16;++r){P0[r]=fsub_s(P0[r],dl);P1[r]=fsub_s(P1[r],dl);} \
      _Pragma("unroll") for(int r=0;r<16;++r)negm[r]=-mhat; asm volatile("":"+v"(negm)); } \
    _Pragma("unroll") for(int r=0;r<16;++r)P0[r]=__builtin_amdgcn_exp2f(P0[r]); }while(0)
  #define RESC() do{ if(resc){ asm volatile("s_waitcnt lgkmcnt(0)":::"memory"); \
      _Pragma("unroll") for(int d_=0;d_<4;++d_) _Pragma("unroll") for(int r=0;r<16;++r)o[d_][r]*=wsf[crow(r,hi)]; } }while(0)
  f32x16 pA0,pA1,pB0,pB1;
  int sl_prev=0,sl_cur=0,sl_next=SLOTB;
  #define ROT() do{sl_prev=sl_cur;sl_cur=sl_next;sl_next=(sl_next==(NSLOT-1)*SLOTB)?0:sl_next+SLOTB;}while(0)
  DMA_K(2,2*SLOTB);
  WAIT_BAR(3);
  qkt(pA0,pA1,Kbase,qr,negm,r32,hi);asm volatile("s_nop 15\n\ts_nop 7":"+v"(pA0),"+v"(pA1));CMASK(pA0,pA1,0);
  START(pA0,pA1);
  _Pragma("unroll") for(int r=0;r<16;++r)pA1[r]=__builtin_amdgcn_exp2f(pA1[r]);
  WAIT_BAR(0);
  DMA_K(3,0);DMA_V(1,SLOTB);
  ROT();
  kload8(kf,kp0+sl_cur);
  WAIT_BAR(3);
  s16x4 vlo[16],vhi[16]; u32x4 pw0,pw1,pw2,pw3;
  #define PKW(P,B) cvtpk_s(P[B],P[B+1])
  #define PAF(k) __builtin_bit_cast(bf16x8,pw##k)
  #define VFR(i) (bf16x8){vlo[i][0],vlo[i][1],vlo[i][2],vlo[i][3],vhi[i][0],vhi[i][1],vhi[i][2],vhi[i][3]}
  #define PIN(x) asm volatile("":"+v"(x))
  #define MX3(a,b,c) __builtin_fmaxf(__builtin_fmaxf((a),(b)),(c))
  #define GAPA(MF,A0,A1,A2,A3,W0,W1,PW) do{ MF; sacc+=A0; sacc+=A1; sacc+=A2; sacc+=A3; PIN(sacc); W0; W1; PIN(PW); SBAR(); }while(0)
  #define EX(v) __builtin_amdgcn_exp2f(v)
  #define GAPB(MF,X,B) do{ MF; X[B]=EX(X[B]); X[B+1]=EX(X[B+1]); PIN(X); SBAR(); }while(0)
  #define VRD(i) do{ vlo[i]=vtr(vp_+(((i)>>2)*4096+((i)&3)*1024)); vhi[i]=vtr(vp_+(((i)>>2)*4096+((i)&3)*1024+512)); }while(0)
  #define KRD(G,j) do{ if(G){ kload2(kf,kp0+sl_next,j); SBAR(); } }while(0)
  #define STEP(C0,C1,P0,P1,t,GK,GV,GL) do{ SBAR(); \
    const lds_cptr vp_=vp0+2*sl_prev; \
    float sacc=(P0[0]+P0[1]); \
    GAPA(C0=__builtin_amdgcn_mfma_f32_32x32x16_bf16(kf[0],qr[0],negm,0,0,0), P0[2],P0[3],P0[4],P0[5],     pw0[0]=PKW(P0,0), pw0[1]=PKW(P0,2), pw0); \
    GAPA(C1=__builtin_amdgcn_mfma_f32_32x32x16_bf16(kf[1],qr[0],negm,0,0,0), P0[6],P0[7],P0[8],P0[9],     pw0[2]=PKW(P0,4), pw0[3]=PKW(P0,6), pw0); \
    GAPA(C0=__builtin_amdgcn_mfma_f32_32x32x16_bf16(kf[2],qr[1],C0,0,0,0),   P0[10],P0[11],P0[12],P0[13], pw1[0]=PKW(P0,8), pw1[1]=PKW(P0,10), pw1); \
    GAPA(C1=__builtin_amdgcn_mfma_f32_32x32x16_bf16(kf[3],qr[1],C1,0,0,0),   P0[14],P0[15],P1[0],P1[1],   pw1[2]=PKW(P0,12),pw1[3]=PKW(P0,14), pw1); \
    GAPA(C0=__builtin_amdgcn_mfma_f32_32x32x16_bf16(kf[4],qr[2],C0,0,0,0),   P1[2],P1[3],P1[4],P1[5],     pw2[0]=PKW(P1,0), pw2[1]=PKW(P1,2), pw2); \
    GAPA(C1=__builtin_amdgcn_mfma_f32_32x32x16_bf16(kf[5],qr[2],C1,0,0,0),   P1[6],P1[7],P1[8],P1[9],     pw2[2]=PKW(P1,4), pw2[3]=PKW(P1,6), pw2); \
    GAPA(C0=__builtin_amdgcn_mfma_f32_32x32x16_bf16(kf[6],qr[3],C0,0,0,0),   P1[10],P1[11],P1[12],P1[13], pw3[0]=PKW(P1,8), pw3[1]=PKW(P1,10), pw3); \
    GAPA(C1=__builtin_amdgcn_mfma_f32_32x32x16_bf16(kf[7],qr[3],C1,0,0,0),   P1[14],P1[15],0.f,0.f,       pw3[2]=PKW(P1,12),pw3[3]=PKW(P1,14), pw3); \
    VRD(0); VRD(4); VRD(8); VRD(12); VRD(1); VRD(5); VRD(9); VRD(13); SBAR(); \
    l_reg+=sacc; \
    if(GK){DMA_K((t)+3,sl_cur);} if(GV){DMA_V((t)+1,sl_next);} \
    CMASK(C0,C1,t); \
    { float a=MX3(C0[0],C0[1],C1[0]),b=MX3(C0[2],C0[3],C1[1]); a=MX3(a,C1[2],C1[3]); \
      _Pragma("unroll") for(int r=4;r<16;r+=4){a=MX3(a,C0[r],C0[r+1]);b=MX3(b,C0[r+2],C0[r+3]);a=MX3(a,C1[r],C1[r+1]);b=MX3(b,C1[r+2],C1[r+3]);} \
      float rm=__builtin_fmaxf(a,b); { auto rr=__builtin_amdgcn_permlane32_swap(__float_as_uint(rm),__float_as_uint(rm),false,false); rm=__builtin_fmaxf(__uint_as_float(rr[0]),__uint_as_float(rr[1])); } \
      resc=false; \
      if(__builtin_expect(__any(rm>(float)THRL),0)){ const float dl=__builtin_fmaxf(rm,0.f); mhat+=dl; \
        _Pragma("unroll") for(int r=0;r<16;++r){C0[r]-=dl;C1[r]-=dl;} \
        _Pragma("unroll") for(int r=0;r<16;++r)negm[r]=-mhat; asm volatile("":"+v"(negm)); \
        const float f=__builtin_amdgcn_exp2f(-dl); l_reg*=f; if(hi==0)wsf[r32]=f; resc=true; } } \
    SBAR(); \
    GAPB(o[0]=__builtin_amdgcn_mfma_f32_32x32x16_bf16(PAF(0),VFR(0),o[0],0,0,0),  C0,0);  VRD(2);  SBAR(); \
    GAPB(o[1]=__builtin_amdgcn_mfma_f32_32x32x16_bf16(PAF(0),VFR(4),o[1],0,0,0),  C0,2);  VRD(6);  SBAR(); \
    GAPB(o[2]=__builtin_amdgcn_mfma_f32_32x32x16_bf16(PAF(0),VFR(8),o[2],0,0,0),  C0,4);  VRD(10); SBAR(); \
    GAPB(o[3]=__builtin_amdgcn_mfma_f32_32x32x16_bf16(PAF(0),VFR(12),o[3],0,0,0), C0,6);  VRD(14); SBAR(); \
    GAPB(o[0]=__builtin_amdgcn_mfma_f32_32x32x16_bf16(PAF(1),VFR(1),o[0],0,0,0),  C0,8);  VRD(3);  SBAR(); \
    GAPB(o[1]=__builtin_amdgcn_mfma_f32_32x32x16_bf16(PAF(1),VFR(5),o[1],0,0,0),  C0,10); VRD(7);  SBAR(); \
    GAPB(o[2]=__builtin_amdgcn_mfma_f32_32x32x16_bf16(PAF(1),VFR(9),o[2],0,0,0),  C0,12); VRD(11); SBAR(); \
    GAPB(o[3]=__builtin_amdgcn_mfma_f32_32x32x16_bf16(PAF(1),VFR(13),o[3],0,0,0), C0,14); VRD(15); SBAR(); \
    KRD(GL,0); GAPB(o[0]=__builtin_amdgcn_mfma_f32_32x32x16_bf16(PAF(2),VFR(2),o[0],0,0,0),  C1,0); \
    KRD(GL,1); GAPB(o[1]=__builtin_amdgcn_mfma_f32_32x32x16_bf16(PAF(2),VFR(6),o[1],0,0,0),  C1,2); \
    KRD(GL,2); GAPB(o[2]=__builtin_amdgcn_mfma_f32_32x32x16_bf16(PAF(2),VFR(10),o[2],0,0,0), C1,4); \
    KRD(GL,3); GAPB(o[3]=__builtin_amdgcn_mfma_f32_32x32x16_bf16(PAF(2),VFR(14),o[3],0,0,0), C1,6); \
    GAPB(o[0]=__builtin_amdgcn_mfma_f32_32x32x16_bf16(PAF(3),VFR(3),o[0],0,0,0),  C1,8); \
    GAPB(o[1]=__builtin_amdgcn_mfma_f32_32x32x16_bf16(PAF(3),VFR(7),o[1],0,0,0),  C1,10); \
    GAPB(o[2]=__builtin_amdgcn_mfma_f32_32x32x16_bf16(PAF(3),VFR(11),o[2],0,0,0), C1,12); \
    GAPB(o[3]=__builtin_amdgcn_mfma_f32_32x32x16_bf16(PAF(3),VFR(15),o[3],0,0,0), C1,14); \
    }while(0)
  int t=1;
  #undef CMASK
  #define CMASK(P0,P1,t) do{}while(0)
  for(;t+5<NT;t+=2){
    STEP(pB0,pB1,pA0,pA1,t,true,true,true);     WAIT_BAR(3); RESC(); ROT();
    STEP(pA0,pA1,pB0,pB1,t+1,true,true,true);   WAIT_BAR(3); RESC(); ROT();
  }
  #undef CMASK
  #define CMASK(P0,P1,t) do{int jb_=(t)-(NT-4); if(jb_>=0)cmask(P0,P1,jb_,qrel,hi);}while(0)
  #define ENDW(tt) do{ if((tt)+3<NT){WAIT_BAR(3);} else if((tt)+2<NT){WAIT_BAR(2);} else {WAIT_BAR(0);} }while(0)
  for(;t+1<NT;t+=2){
    STEP(pB0,pB1,pA0,pA1,t,(t+3<NT),(t+1<NT),(t+1<NT));       ENDW(t);   RESC(); ROT();
    STEP(pA0,pA1,pB0,pB1,t+1,(t+4<NT),(t+2<NT),(t+2<NT));     ENDW(t+1); RESC(); ROT();
  }
  STEP(pB0,pB1,pA0,pA1,NT-1,false,false,false); RESC();
  { float sacc=pB0[0]+pB0[1]; _Pragma("unroll") for(int r=2;r<16;++r)sacc+=pB0[r]; _Pragma("unroll") for(int r=0;r<16;++r)sacc+=pB1[r]; l_reg+=sacc;
    pw0=(u32x4){PKW(pB0,0),PKW(pB0,2),PKW(pB0,4),PKW(pB0,6)};pw1=(u32x4){PKW(pB0,8),PKW(pB0,10),PKW(pB0,12),PKW(pB0,14)};pw2=(u32x4){PKW(pB1,0),PKW(pB1,2),PKW(pB1,4),PKW(pB1,6)};pw3=(u32x4){PKW(pB1,8),PKW(pB1,10),PKW(pB1,12),PKW(pB1,14)};
    SBAR(); pv(o,vb0+2*sl_cur,PAF(0),PAF(1),PAF(2),PAF(3)); }
  #undef PKW
  #undef PAF
  #undef VFR
  #undef PIN
  #undef MX3
  #undef GAPA
  #undef GAPB
  #undef EX
  #undef VRD
  #undef KRD
  #undef STEP
  #undef ENDW
  {auto rr=__builtin_amdgcn_permlane32_swap(__float_as_uint(l_reg),__float_as_uint(l_reg),false,false);l_reg=__uint_as_float(rr[0])+__uint_as_float(rr[1]);}
  if(hi==0)wsf[32+r32]=l_reg;asm volatile("s_waitcnt lgkmcnt(0)":::"memory");
  float rli[16];
  #pragma unroll
  for(int r=0;r<16;++r)rli[r]=__builtin_amdgcn_rcpf(wsf[32+crow(r,hi)]);
  bf16*Ow=O+(long)(q0+wid*QBLK)*DM+hv*128;
  { bf16*stg=(bf16*)(shm+LDS_OST)+wid*2048;
    #pragma unroll
    for(int hf=0;hf<2;++hf){
      #pragma unroll
      for(int r=0;r<16;++r){const int orow=crow(r,hi);
        #pragma unroll
        for(int d0=0;d0<2;++d0)stg[orow*64+d0*32+r32]=__float2bfloat16(o[2*hf+d0][r]*rli[r]);}
      asm volatile("s_waitcnt lgkmcnt(0)":::"memory");
      u32x4 v4[4];
      #pragma unroll
      for(int i=0;i<4;++i){const int row=i*8+(lane>>3),ch=lane&7; v4[i]=*(const u32x4*)(stg+row*64+ch*8);}
      asm volatile("s_waitcnt lgkmcnt(0)":::"memory");
      #pragma unroll
      for(int i=0;i<4;++i){const int row=i*8+(lane>>3),ch=lane&7; ATTN_STORE16(Ow+(long)row*DM+hf*64+ch*8,v4[i]);} } }
  asm volatile("s_waitcnt lgkmcnt(0)\n\ts_barrier":::"memory");
  #undef DMA_K
  #undef DMA_V
  #undef CMASK
  #undef START
  #undef RESC
  #undef ROT
}
constexpr int ATTN_LDS_BYTES=LDS_BYTES;
#undef SBAR
#undef WAIT_BAR
}

typedef GAS unsigned gu32;
#define RLX_AGENT __ATOMIC_RELAXED, __HIP_MEMORY_SCOPE_AGENT
#define LDS_WAIT() asm volatile("s_waitcnt lgkmcnt(0)" ::: "memory")
#define XB_TMO      128
#define XB_XCNT(j)  (256  + 64 * (j))
#define XB_XSUB(j)  (1280 + 64 * (j))
#define XB_XGEN(j)  (2304 + 64 * (j))
#define XB_TOP      3328
#define XB_TOPGEN   3392
#define XCD_BAR_WORDS 3456
#define XB_SPIN_CAP (1u << 18)
__device__ __forceinline__ unsigned xb_ld(unsigned* p)              { return __hip_atomic_load(p, __ATOMIC_RELAXED, __HIP_MEMORY_SCOPE_AGENT); }
__device__ __forceinline__ unsigned xb_add(unsigned* p, unsigned v) { return __hip_atomic_fetch_add(p, v, __ATOMIC_RELAXED, __HIP_MEMORY_SCOPE_AGENT); }
__device__ __forceinline__ unsigned xb_xcc_id() { return (unsigned)__builtin_amdgcn_s_getreg((3 << 11) | 20) & 0xFu; }
#define XB_SPIN(cond, bar) do { unsigned _sp = 0; while (cond) { __builtin_amdgcn_s_sleep(1); \
    if ((++_sp & 255u) == 0u) { if (xb_ld(&(bar)[XB_TMO])) break; if (_sp > XB_SPIN_CAP) { atomicAdd(&(bar)[XB_TMO], 1u); break; } } } } while (0)
struct XcdBarrier { unsigned* bar; unsigned x; volatile LAS unsigned* st; };
__device__ __forceinline__ XcdBarrier xcd_barrier_post(unsigned* bar, volatile LAS unsigned* st) {
    XcdBarrier b; b.bar = bar; b.x = xb_xcc_id(); b.st = st;
    if (threadIdx.x == 0) (void)xb_add(&bar[XB_XCNT(b.x)], 1u);
    return b;
}
__device__ __forceinline__ void xcd_barrier_complete(unsigned* bar, unsigned x, unsigned& nloc, unsigned& nx) {
    const unsigned G = gridDim.x * gridDim.y * gridDim.z;
    unsigned sum, cnt, mine, sp = 0u;
    for (;;) {
        sum = 0u; cnt = 0u; mine = 0u;
#pragma unroll
        for (unsigned j = 0; j < 16; ++j) { const unsigned c = xb_ld(&bar[XB_XCNT(j)]); sum += c; cnt += (c > 0u) ? 1u : 0u; mine = (j == x) ? c : mine; }
        if (sum == G) break;
        __builtin_amdgcn_s_sleep(1);
        if ((++sp & 255u) == 0u) { if (xb_ld(&bar[XB_TMO])) break; if (sp > XB_SPIN_CAP) { atomicAdd(&bar[XB_TMO], 1u); break; } }
    }
    nloc = mine > 0u ? mine : 1u; nx = cnt > 0u ? cnt : 1u;
}
__device__ __forceinline__ void xcd_barrier(const XcdBarrier& b) {
    asm volatile("s_waitcnt vmcnt(0)" ::: "memory");
    __syncthreads();
    if (threadIdx.x == 0) {
        unsigned* bar = b.bar; asm volatile("" : "+v"(bar));
        __builtin_amdgcn_s_waitcnt(0);
        unsigned nloc = b.st[0], nx = b.st[1];
        if (nloc == 0u) { xcd_barrier_complete(bar, b.x, nloc, nx); b.st[0] = nloc; b.st[1] = nx; }
        const unsigned old = xb_add(&bar[XB_XSUB(b.x)], 1u);
        const unsigned gen = old / nloc;
        if (old + 1u == (gen + 1u) * nloc) {
            __builtin_amdgcn_fence(__ATOMIC_RELEASE, "agent");
            asm volatile("s_waitcnt vmcnt(0)" ::: "memory");
            const unsigned og = xb_add(&bar[XB_TOP], 1u);
            const unsigned tg = og / nx;
            if (og + 1u == (tg + 1u) * nx) xb_add(&bar[XB_TOPGEN], 1u);
            else XB_SPIN(xb_ld(&bar[XB_TOPGEN]) == tg, bar);
            __builtin_amdgcn_fence(__ATOMIC_ACQUIRE, "agent");
            xb_add(&bar[XB_XGEN(b.x)], 1u);
            asm volatile("s_waitcnt vmcnt(0)" ::: "memory");
        } else {
            XB_SPIN(xb_ld(&bar[XB_XGEN(b.x)]) == gen, bar);
            __builtin_amdgcn_fence(__ATOMIC_ACQUIRE, "agent");
            asm volatile("s_waitcnt vmcnt(0)" ::: "memory");
        }
    }
    __syncthreads();
}

#define XB2_XSUB(j) (64 * (j))
#define XB2_TOP     1024
#define XB2_TOPGEN  1088
__device__ __forceinline__ void xcd_split_arrive(unsigned* bar2, unsigned* bar, volatile LAS unsigned* st) {
    asm volatile("s_waitcnt vmcnt(0)" ::: "memory");
    __syncthreads();
    if (threadIdx.x == 0) {
        asm volatile("" : "+v"(bar2));
        __builtin_amdgcn_s_waitcnt(0);
        unsigned nloc = st[0], nx = st[1]; const unsigned x = xb_xcc_id();
        if (nloc == 0u) { xcd_barrier_complete(bar, x, nloc, nx); st[0] = nloc; st[1] = nx; }
        const unsigned old = xb_add(&bar2[XB2_XSUB(x)], 1u);
        if ((old + 1u) % nloc == 0u) {
            __builtin_amdgcn_fence(__ATOMIC_RELEASE, "agent");
            asm volatile("s_waitcnt vmcnt(0)" ::: "memory");
            const unsigned og = xb_add(&bar2[XB2_TOP], 1u);
            if ((og + 1u) % nx == 0u) xb_add(&bar2[XB2_TOPGEN], 1u);
            asm volatile("s_waitcnt vmcnt(0)" ::: "memory");
        }
    }
}
__device__ __forceinline__ void xcd_split_wait(unsigned* bar2, unsigned* bar, unsigned target) {
    if (threadIdx.x == 0) {
        asm volatile("" : "+v"(bar2));
        XB_SPIN(xb_ld(&bar2[XB2_TOPGEN]) < target, bar);
        __builtin_amdgcn_fence(__ATOMIC_ACQUIRE, "agent");
        asm volatile("s_waitcnt vmcnt(0)" ::: "memory");
    }
    __syncthreads();
}

__device__ __forceinline__ float wave_sum(float v) {
#pragma unroll
    for (int o = 1; o < 64; o <<= 1) v += __shfl_xor(v, o);
    return v;
}
template <class F>
__device__ __forceinline__ void transpose_load(const float* W, int ld, int nrows, F srccol, int item, int lane, f32x4 (&v)[8]) {
    const int nblk = nrows / 32, kb = item / nblk, nb = item % nblk, k0 = 64 * kb, s0 = srccol(32 * nb);
#pragma unroll
    for (int i = 0; i < 8; ++i) v[i] = __builtin_nontemporal_load((const f32x4*)(W + (size_t)(k0 + 8 * i + (lane >> 3)) * ld + s0 + 4 * (lane & 7)));
}
__host__ __device__ __forceinline__ int perm32(int rho) { const int n = rho >> 4, i = rho & 15; return 8 * (i >> 2) + 4 * n + (i & 3); }
template <bool PERM>
__device__ __forceinline__ void transpose_store(int K, bf16_t* WT, int nrows, const float* gk, LAS float* scr, int item, int lane, const f32x4 (&v)[8]) {
    const int nblk = nrows / 32, kb = item / nblk, nb = item % nblk, k0 = 64 * kb, n0 = 32 * nb;
#pragma unroll
    for (int i = 0; i < 8; ++i) { const int kk = 8 * i + (lane >> 3); const float g = gk ? gk[k0 + kk] : 1.0f;
#pragma unroll
        for (int e = 0; e < 4; ++e) scr[kk * 33 + 4 * (lane & 7) + e] = v[i][e] * g; }
    LDS_WAIT(); asm volatile("" ::: "memory");
    const int c = lane & 7;
#pragma unroll
    for (int j = 0; j < 4; ++j) { const int n = (lane >> 3) + 8 * j; const LAS float* s = scr + (8 * c) * 33 + (PERM ? perm32(n) : n);
        u32x4 o; o.x = cvt_pk_bf16(s[0 * 33], s[1 * 33]); o.y = cvt_pk_bf16(s[2 * 33], s[3 * 33]); o.z = cvt_pk_bf16(s[4 * 33], s[5 * 33]); o.w = cvt_pk_bf16(s[6 * 33], s[7 * 33]);
        *(u32x4*)(WT + (size_t)(n0 + n) * K + k0 + 8 * c) = o; }
    LDS_WAIT(); asm volatile("" ::: "memory");
}
struct ColIdent { int off; __device__ __forceinline__ int operator()(int r) const { return off + r; } };
struct ColSwiglu { __device__ __forceinline__ int operator()(int r) const { return ((r >> 7) & 1) * DFF + (r >> 8) * 128 + (r & 127); } };
struct ColSwigluOff { int r0; __device__ __forceinline__ int operator()(int r) const { return ColSwiglu{}(r + r0); } };
struct ColMix { __device__ __forceinline__ int operator()(int r) const {
    const int tile = r >> 8, p = r & 255, o = 64 * ((p >> 5) & 3) + 32 * (p >> 7) + (p & 31);
    if (tile < 16) return r;
    if (tile < 20) return 6144 + (tile - 16) * 256 + o;
    if (tile < 24) return 7168 + (tile - 20) * 256 + o;
    if (tile < 28) return 8192 + (tile - 24) * 256 + p;
    return 9216 + (tile - 28) * 256 + p; } };
template <bool PERM = false, class F>
__device__ __forceinline__ void transpose_all(const float* W, int K, int ld, bf16_t* WT, int nrows, F srccol, const float* gk, LAS float* scr, int gw, int ngw, int lane) {
    const int nitems = (K / 64) * (nrows / 32);
    for (int it = gw; it < nitems; it += 2 * ngw) {
        f32x4 va[8], vb[8]; const int it2 = it + ngw;
        transpose_load(W, ld, nrows, srccol, it, lane, va);
        if (it2 < nitems) transpose_load(W, ld, nrows, srccol, it2, lane, vb);
        transpose_store<PERM>(K, WT, nrows, gk, scr, it, lane, va);
        if (it2 < nitems) transpose_store<PERM>(K, WT, nrows, gk, scr, it2, lane, vb);
    }
}
__device__ __forceinline__ void rms_rows_to_bf16(const float* x, const float* gain, bf16_t* o, int m0, int step, int nrows, int lane) {
    const f32x4* gr = (const f32x4*)gain + lane;
    for (int m = m0; m < nrows; m += 2 * step) {
        const int m2 = (m + step < nrows) ? m + step : m;
        const f32x4* xa = (const f32x4*)(x + (size_t)m * DM) + lane; const f32x4* xb2 = (const f32x4*)(x + (size_t)m2 * DM) + lane;
        f32x4 va[4], vb[4]; float sa = 0.f, sb = 0.f;
#pragma unroll
        for (int j = 0; j < 4; ++j) { va[j] = __builtin_nontemporal_load(xa + 64 * j); vb[j] = __builtin_nontemporal_load(xb2 + 64 * j); }
#pragma unroll
        for (int j = 0; j < 4; ++j) { sa += (va[j][0] * va[j][0] + va[j][1] * va[j][1]) + (va[j][2] * va[j][2] + va[j][3] * va[j][3]); sb += (vb[j][0] * vb[j][0] + vb[j][1] * vb[j][1]) + (vb[j][2] * vb[j][2] + vb[j][3] * vb[j][3]); }
        const float ra = __builtin_amdgcn_rsqf(wave_sum(sa) * (1.f / 1024.f) + EPS), rb = __builtin_amdgcn_rsqf(wave_sum(sb) * (1.f / 1024.f) + EPS);
        u32x2* oa = (u32x2*)(o + (size_t)m * DM) + lane; u32x2* ob = (u32x2*)(o + (size_t)m2 * DM) + lane;
#pragma unroll
        for (int j = 0; j < 4; ++j) { const f32x4 g = gr[64 * j]; oa[64 * j] = pack4(va[j] * ra * g); if (m2 != m) ob[64 * j] = pack4(vb[j] * rb * g); }
    }
}
__device__ __forceinline__ void rot_table(const int* pos, float* rot, int gt, int ngt) {
    for (int idx = gt; idx < SEQ * 128; idx += ngt) {
        const int s = idx >> 7, i = idx & 127;
        const float inv = exp2f(-(float)i * (13.287712379549449f / 128.0f));
        const float ang = (float)pos[s] * inv;
        const float kq = rintf(ang * 0.6366197723675814f);
        float r = fmaf(-kq, 1.5703125f, ang); r = fmaf(-kq, 4.837512969970703125e-4f, r); r = fmaf(-kq, 7.54978995489188216e-8f, r);
        const float r2 = r * r;
        const float sn = r + r * r2 * (-1.6666667e-1f + r2 * (8.3333333e-3f + r2 * (-1.9841270e-4f + r2 * 2.7557319e-6f)));
        const float cn = 1.0f + r2 * (-0.5f + r2 * (4.1666668e-2f + r2 * (-1.3888889e-3f + r2 * (2.4801587e-5f + r2 * -2.7557319e-7f))));
        const int qd = ((int)kq) & 3;
        const float c = (qd == 0) ? cn : (qd == 1) ? -sn : (qd == 2) ? -cn : sn;
        const float sv = (qd == 0) ? sn : (qd == 1) ? cn : (qd == 2) ? -sn : -cn;
        *(f32x2*)(rot + (size_t)idx * 2) = (f32x2){c, sv};
    }
}

constexpr int SCN_LD = 136, SCN_V_OFF = 64 * SCN_LD * 2, SCN_CH = 192 * SCN_LD * 2;
constexpr unsigned SCAN_UNITS_PER_FLAG = 8;
__device__ __forceinline__ void scan_unit(int u, const bf16_t* kts, const bf16_t* vt, bf16_t* S, LAS unsigned char* lds, unsigned* done  ) {
    const int tid = opaque_tid(), lane = tid & 63, wave = __builtin_amdgcn_readfirstlane(tid >> 6);
    const int fr = lane & 15, fq = lane >> 4, h = u >> 4, dg = (u >> 2) & 3, eg = u & 3, wd = wave & 1, we = wave >> 1;
    const float gC = __builtin_amdgcn_exp2f(128.0f * log2f(1.0f - __builtin_amdgcn_exp2f(-5.0f - (float)h)));
    f32x4 acc[2][2];
#pragma unroll
    for (int a = 0; a < 2; ++a)
#pragma unroll
        for (int b = 0; b < 2; ++b) acc[a][b] = (f32x4){0.f, 0.f, 0.f, 0.f};
    const bf16_t* ksrc = kts + (size_t)(h * 256 + 64 * dg + (tid >> 4)) * SEQ + (tid & 15) * 8;
    const bf16_t* vsrc = vt + (size_t)(h * 512 + 128 * eg + (tid >> 4)) * SEQ + (tid & 15) * 8;
    u32x4 pk[3][2][2], pv[3][2][4];
#pragma unroll
    for (int sb = 0; sb < 3; ++sb)
#pragma unroll
        for (int i = 0; i < 2; ++i) {
#pragma unroll
            for (int j = 0; j < 2; ++j) pk[sb][i][j] = *(const u32x4*)(ksrc + (size_t)(32 * j) * SEQ + (2 * sb + i) * 128);
#pragma unroll
            for (int j = 0; j < 4; ++j) pv[sb][i][j] = *(const u32x4*)(vsrc + (size_t)(32 * j) * SEQ + (2 * sb + i) * 128);
        }
    bf16_t* sdst = S + ((size_t)(h * 16) * 512 + 128 * eg + 32 * we + fr) * 256 + 64 * dg + 32 * wd + 4 * fq;
#pragma unroll
    for (int r = 0; r < 8; ++r) {
        __syncthreads();
#pragma unroll
        for (int i = 0; i < 2; ++i) {
            if (2 * r + i < 15) {
                LAS bf16_t* lk = (LAS bf16_t*)(lds + i * SCN_CH); LAS bf16_t* lv = (LAS bf16_t*)(lds + i * SCN_CH + SCN_V_OFF);
#pragma unroll
                for (int j = 0; j < 2; ++j) *(LAS u32x4*)(lk + (32 * j + (tid >> 4)) * SCN_LD + (tid & 15) * 8) = pk[r % 3][i][j];
#pragma unroll
                for (int j = 0; j < 4; ++j) *(LAS u32x4*)(lv + (32 * j + (tid >> 4)) * SCN_LD + (tid & 15) * 8) = pv[r % 3][i][j];
            }
        }
        __syncthreads();
        if (r < 5) {
#pragma unroll
            for (int i = 0; i < 2; ++i) { const int c = 2 * (r + 3) + i;
                if (c < 15) {
#pragma unroll
                    for (int j = 0; j < 2; ++j) pk[r % 3][i][j] = *(const u32x4*)(ksrc + (size_t)(32 * j) * SEQ + c * 128);
#pragma unroll
                    for (int j = 0; j < 4; ++j) pv[r % 3][i][j] = *(const u32x4*)(vsrc + (size_t)(32 * j) * SEQ + c * 128);
                } }
        }
#pragma unroll
        for (int i = 0; i < 2; ++i) {
            const int c = 2 * r + i;
#pragma unroll
            for (int td = 0; td < 2; ++td)
#pragma unroll
                for (int te = 0; te < 2; ++te) { const u32x2 w = pack4(acc[td][te]);
                    __hip_atomic_store((unsigned long long*)(sdst + (size_t)c * 512 * 256 + (size_t)(16 * te) * 256 + 16 * td), ((unsigned long long)w.y << 32) | w.x, __ATOMIC_RELAXED, __HIP_MEMORY_SCOPE_AGENT); }
            if (c < 15) {
                const LAS bf16_t* lk = (const LAS bf16_t*)(lds + i * SCN_CH); const LAS bf16_t* lv = (const LAS bf16_t*)(lds + i * SCN_CH + SCN_V_OFF);
                f32x4 tm[2][2];
#pragma unroll
                for (int td = 0; td < 2; ++td)
#pragma unroll
                    for (int te = 0; te < 2; ++te) tm[td][te] = (f32x4){0.f, 0.f, 0.f, 0.f};
#pragma unroll
                for (int ks = 0; ks < 4; ++ks) {
                    bf16x8 a[2], b[2];
#pragma unroll
                    for (int t = 0; t < 2; ++t) { a[t] = *(const LAS bf16x8*)(lk + (32 * wd + 16 * t + fr) * SCN_LD + 32 * ks + 8 * fq); b[t] = *(const LAS bf16x8*)(lv + (32 * we + 16 * t + fr) * SCN_LD + 32 * ks + 8 * fq); }
#pragma unroll
                    for (int td = 0; td < 2; ++td)
#pragma unroll
                        for (int te = 0; te < 2; ++te) tm[td][te] = mfma16(a[td], b[te], tm[td][te]);
                }
#pragma unroll
                for (int td = 0; td < 2; ++td)
#pragma unroll
                    for (int te = 0; te < 2; ++te) acc[td][te] = acc[td][te] * gC + tm[td][te];
            }
        }
    }
    asm volatile("s_waitcnt vmcnt(0)" ::: "memory");
    __syncthreads();
    if (tid == 0) __hip_atomic_fetch_add(done + ((h * 2 + (eg >> 1)) * 64), 1u, __ATOMIC_RELAXED, __HIP_MEMORY_SCOPE_AGENT);
}
constexpr int RQ_LD = 264, SC_LD = 136, RO_SC_OFF = 128 * RQ_LD * 2, RO_PART_OFF = RO_SC_OFF + 128 * SC_LD * 2;
__device__ __forceinline__ void retout_unit(int h, int c, int eh, const bf16_t* q, const bf16_t* k, const bf16_t* vt, const bf16_t* S, bf16_t* ret  , float* rssq, LAS unsigned char* lds, unsigned* done, unsigned* tmo) {
    const int tid = opaque_tid(), lane = tid & 63, wave = __builtin_amdgcn_readfirstlane(tid >> 6);
    const int fr = lane & 15, fq = lane >> 4;
    LAS bf16_t* ql = (LAS bf16_t*)lds; LAS bf16_t* sc = (LAS bf16_t*)(lds + RO_SC_OFF); LAS float* part = (LAS float*)(lds + RO_PART_OFF);
    const float lg2 = log2f(1.0f - __builtin_amdgcn_exp2f(-5.0f - (float)h));
    const int tok0 = c * 128;
    if (tid < 64) {
        unsigned* f = done + ((h * 2 + eh) * 64); unsigned sp = 0;
        while ((unsigned)__builtin_amdgcn_readfirstlane(__hip_atomic_load(f, __ATOMIC_RELAXED, __HIP_MEMORY_SCOPE_AGENT)) < SCAN_UNITS_PER_FLAG) {
            __builtin_amdgcn_s_sleep(2);
            if (++sp > (1u << 20)) { if (tid == 0) __hip_atomic_store(tmo, 1u, __ATOMIC_RELAXED, __HIP_MEMORY_SCOPE_AGENT); break; }
        }
        __builtin_amdgcn_fence(__ATOMIC_ACQUIRE, "agent");
        asm volatile("s_waitcnt vmcnt(0)" ::: "memory");
    }
    __syncthreads();
    const bf16_t* sp = S + ((size_t)((h * 16 + c) * 512 + 256 * eh + 32 * wave + fr)) * 256 + 8 * fq;
    const bf16_t* vp = vt + (size_t)(h * 512 + 256 * eh + 32 * wave + fr) * SEQ + tok0 + 8 * fq;
    const bf16_t* kp = k + (size_t)(tok0 + 16 * wave + fr) * 1024 + h * 256 + 8 * fq;
    u32x4 qv[8]; bf16x8 kf[8], sfa[8][2], vfa[4][2];
#pragma unroll
    for (int i = 0; i < 8; ++i) { const int p = tid + 512 * i, row = p >> 5, c16 = p & 31; qv[i] = *(const u32x4*)(q + (size_t)(tok0 + row) * 1024 + h * 256 + c16 * 8); }
#pragma unroll
    for (int ks = 0; ks < 8; ++ks) kf[ks] = *(const bf16x8*)(kp + 32 * ks);
#pragma unroll
    for (int ks = 0; ks < 8; ++ks)
#pragma unroll
        for (int t = 0; t < 2; ++t) sfa[ks][t] = *(const bf16x8*)(sp + (size_t)(16 * t) * 256 + 32 * ks);
#pragma unroll
    for (int i = 0; i < 8; ++i) { const int p = tid + 512 * i, row = p >> 5, c16 = p & 31; *(LAS u32x4*)(ql + row * RQ_LD + c16 * 8) = qv[i]; }
    __syncthreads();
    {
        const int tj = wave;
#pragma unroll
        for (int ti = 0; ti < 8; ++ti) {
            if (ti >= tj) {
                f32x4 s2 = (f32x4){0.f, 0.f, 0.f, 0.f};
#pragma unroll
                for (int ks = 0; ks < 8; ++ks) { const bf16x8 qf = *(const LAS bf16x8*)(ql + (16 * ti + fr) * RQ_LD + 32 * ks + 8 * fq); s2 = mfma16(kf[ks], qf, s2); }
                const int i = 16 * ti + fr; f32x4 v;
#pragma unroll
                for (int r = 0; r < 4; ++r) { const int j = 16 * tj + 4 * fq + r; v[r] = (i >= j) ? s2[r] * __builtin_amdgcn_exp2f(lg2 * (float)(i - j)) : 0.f; }
                *(LAS u32x2*)(sc + (16 * ti + fr) * SC_LD + 16 * tj + 4 * fq) = pack4(v);
            } else if (ti == tj - 1 && (tj & 1)) {
                u32x2 z = (u32x2){0u, 0u}; asm volatile("" : "+v"(z));
                *(LAS u32x2*)(sc + (16 * ti + fr) * SC_LD + 16 * tj + 4 * fq) = z;
            }
        }
    }
    __syncthreads();
    f32x4 acc[8][2];
#pragma unroll
    for (int a = 0; a < 8; ++a)
#pragma unroll
        for (int b = 0; b < 2; ++b) acc[a][b] = (f32x4){0.f, 0.f, 0.f, 0.f};
    {
        bf16x8 qf[2][8];
#pragma unroll
        for (int t = 0; t < 8; ++t) qf[0][t] = *(const LAS bf16x8*)(ql + (16 * t + fr) * RQ_LD + 8 * fq);
#pragma unroll
        for (int ks = 0; ks < 8; ++ks) {
            if (ks == 4) {
#pragma unroll
                for (int k2 = 0; k2 < 4; ++k2)
#pragma unroll
                    for (int t = 0; t < 2; ++t) vfa[k2][t] = *(const bf16x8*)(vp + (size_t)(16 * t) * SEQ + 32 * k2);
            }
            if (ks < 7) {
#pragma unroll
                for (int t = 0; t < 8; ++t) qf[(ks + 1) & 1][t] = *(const LAS bf16x8*)(ql + (16 * t + fr) * RQ_LD + 32 * (ks + 1) + 8 * fq);
            }
            __builtin_amdgcn_sched_barrier(0);
#pragma unroll
            for (int a = 0; a < 8; ++a)
#pragma unroll
                for (int b = 0; b < 2; ++b) acc[a][b] = mfma16(sfa[ks][b], qf[ks & 1][a], acc[a][b]);
            __builtin_amdgcn_sched_barrier(0);
        }
    }
#pragma unroll
    for (int a = 0; a < 8; ++a) { const float qd = __builtin_amdgcn_exp2f(lg2 * (float)(16 * a + fr + 1));
#pragma unroll
        for (int b = 0; b < 2; ++b) acc[a][b] = acc[a][b] * qd; }
#pragma unroll
    for (int ks = 0; ks < 4; ++ks) {
        bf16x8 pf[8];
#pragma unroll
        for (int a = 0; a < 8; ++a) if (a >= 2 * ks) pf[a] = *(const LAS bf16x8*)(sc + (16 * a + fr) * SC_LD + 32 * ks + 8 * fq);
        __builtin_amdgcn_sched_barrier(0);
#pragma unroll
        for (int a = 0; a < 8; ++a) {
            if (a >= 2 * ks) {
#pragma unroll
                for (int b = 0; b < 2; ++b) acc[a][b] = mfma16(vfa[ks][b], pf[a], acc[a][b]);
            }
        }
        __builtin_amdgcn_sched_barrier(0);
    }
#pragma unroll
    for (int a = 0; a < 8; ++a) {
        float ss = 0.f;
#pragma unroll
        for (int b = 0; b < 2; ++b) { const f32x4 t = acc[a][b]; ss += (t[0] * t[0] + t[1] * t[1]) + (t[2] * t[2] + t[3] * t[3]); }
        ss += __shfl_xor(ss, 16); ss += __shfl_xor(ss, 32);
        if (fq == 0) part[wave * 128 + 16 * a + fr] = ss;
    }
    __syncthreads();
    if (tid < 128) {
        float tot = 0.f;
#pragma unroll
        for (int w = 0; w < 8; ++w) tot += part[w * 128 + tid];
        rssq[(size_t)(tok0 + tid) * 8 + 2 * h + eh] = tot;
    }
#pragma unroll
    for (int a = 0; a < 8; ++a)
#pragma unroll
        for (int b = 0; b < 2; ++b)
            *(u32x2*)(ret + (size_t)(tok0 + 16 * a + fr) * 2048 + h * 512 + 256 * eh + 32 * wave + 16 * b + 4 * fq) = pack4(acc[a][b]);
    __syncthreads();
}
constexpr int PL_LD = 264, MA_KV_BYTES = 64 * 264 * 2, MA_P_OFF = MA_KV_BYTES;
__device__ __forceinline__ void memattn_unit(int b, int h, int rb, const bf16_t* mkn, const bf16_t* mvt, bf16_t* mo  , LAS unsigned char* lds) {
    const bf16_t* mq = mo;
    const int tid = opaque_tid(), lane = tid & 63, wave = __builtin_amdgcn_readfirstlane(tid >> 6);
    const int fr = lane & 15, fq = lane >> 4;
    LAS bf16_t* kv = (LAS bf16_t*)lds; LAS bf16_t* pl = (LAS bf16_t*)(lds + MA_P_OFF) + wave * (16 * PL_LD);
    const int row = 128 * rb + 16 * wave + fr;
    const bf16_t* ksrc = mkn + (size_t)(b * 256) * 1024 + h * 256;
    const bf16_t* vsrc = mvt + (size_t)((b * 4 + h) * 256) * 256;
    u32x4 pre[4];
#pragma unroll
    for (int i = 0; i < 4; ++i) { const int p = tid + 512 * i; pre[i] = *(const u32x4*)(ksrc + (size_t)(p >> 5) * 1024 + (p & 31) * 8); }
    bf16x8 qf[8]; float qs = 0.f;
#pragma unroll
    for (int ks = 0; ks < 8; ++ks) { qf[ks] = *(const bf16x8*)(mq + (size_t)row * 1024 + h * 256 + 32 * ks + 8 * fq);
#pragma unroll
        for (int j = 0; j < 8; ++j) { const float f = bf2f((unsigned short)qf[ks][j]); qs += f * f; } }
    qs += __shfl_xor(qs, 16); qs += __shfl_xor(qs, 32);
    const float scl = __builtin_amdgcn_rsqf(qs * (1.0f / 256.0f) + EPS) * (0.0625f * LOG2E);
    f32x4 sa[16];
#pragma unroll
    for (int kc = 0; kc < 4; ++kc) {
        __syncthreads();
#pragma unroll
        for (int i = 0; i < 4; ++i) { const int p = tid + 512 * i; *(LAS u32x4*)(kv + (p >> 5) * PL_LD + (p & 31) * 8) = pre[i]; }
        __syncthreads();
#pragma unroll
        for (int i = 0; i < 4; ++i) { const int p = tid + 512 * i;
            pre[i] = (kc < 3) ? *(const u32x4*)(ksrc + (size_t)(64 * (kc + 1) + (p >> 5)) * 1024 + (p & 31) * 8) : *(const u32x4*)(vsrc + (size_t)(p >> 5) * 256 + (p & 31) * 8); }
#pragma unroll
        for (int tl = 0; tl < 4; ++tl) {
            f32x4 a = (f32x4){0.f, 0.f, 0.f, 0.f};
#pragma unroll
            for (int ks = 0; ks < 8; ++ks) { const bf16x8 kf = *(const LAS bf16x8*)(kv + (16 * tl + fr) * PL_LD + 32 * ks + 8 * fq); a = mfma16(kf, qf[ks], a); }
            sa[4 * kc + tl] = a * scl;
        }
    }
    float mx = -INFINITY;
#pragma unroll
    for (int t = 0; t < 16; ++t) mx = fmaxf(mx, fmaxf(fmaxf(sa[t][0], sa[t][1]), fmaxf(sa[t][2], sa[t][3])));
    mx = fmaxf(mx, __shfl_xor(mx, 16)); mx = fmaxf(mx, __shfl_xor(mx, 32));
    float l = 0.f;
#pragma unroll
    for (int t = 0; t < 16; ++t) {
        f32x4 p;
#pragma unroll
        for (int r = 0; r < 4; ++r) { p[r] = __builtin_amdgcn_exp2f(sa[t][r] - mx); l += p[r]; }
        *(LAS u32x2*)(pl + fr * PL_LD + 16 * t + 4 * fq) = pack4(p);
    }
    l += __shfl_xor(l, 16); l += __shfl_xor(l, 32);
    const float rl = __builtin_amdgcn_rcpf(l);
    LDS_WAIT(); asm volatile("" ::: "memory");
    bf16x8 pf[8];
#pragma unroll
    for (int ks = 0; ks < 8; ++ks) pf[ks] = *(const LAS bf16x8*)(pl + fr * PL_LD + 32 * ks + 8 * fq);
#pragma unroll
    for (int dc = 0; dc < 4; ++dc) {
        __syncthreads();
#pragma unroll
        for (int i = 0; i < 4; ++i) { const int p = tid + 512 * i; *(LAS u32x4*)(kv + (p >> 5) * PL_LD + (p & 31) * 8) = pre[i]; }
        __syncthreads();
        if (dc < 3) {
#pragma unroll
            for (int i = 0; i < 4; ++i) { const int p = tid + 512 * i; pre[i] = *(const u32x4*)(vsrc + (size_t)(64 * (dc + 1) + (p >> 5)) * 256 + (p & 31) * 8); }
        }
#pragma unroll
        for (int tl = 0; tl < 4; ++tl) {
            f32x4 a = (f32x4){0.f, 0.f, 0.f, 0.f};
#pragma unroll
            for (int ks = 0; ks < 8; ++ks) { const bf16x8 vf = *(const LAS bf16x8*)(kv + (16 * tl + fr) * PL_LD + 32 * ks + 8 * fq); a = mfma16(vf, pf[ks], a); }
            *(u32x2*)(mo + (size_t)row * 1024 + h * 256 + 64 * dc + 16 * tl + 4 * fq) = pack4(a * rl);
        }
    }
    __syncthreads();
}
__device__ __forceinline__ void dif_row(const bf16_t* o0, const bf16_t* o1, bf16_t* dif, const float* gout, float lam, int lane) {
    const u32x4* a = (const u32x4*)o0 + 2 * lane; const u32x4* b = (const u32x4*)o1 + 2 * lane;
    float d[16]; float ss = 0.f;
#pragma unroll
    for (int v = 0; v < 2; ++v) { const u32x4 x = __builtin_nontemporal_load(a + v), y = __builtin_nontemporal_load(b + v);
#pragma unroll
        for (int w = 0; w < 4; ++w) { const float x0 = __uint_as_float(x[w] << 16), x1 = __uint_as_float(x[w] & 0xffff0000u), y0 = __uint_as_float(y[w] << 16), y1 = __uint_as_float(y[w] & 0xffff0000u);
            const float d0 = x0 - lam * y0, d1 = x1 - lam * y1; d[v * 8 + w * 2] = d0; d[v * 8 + w * 2 + 1] = d1; ss += d0 * d0 + d1 * d1; } }
    ss += __shfl_xor(ss, 1); ss += __shfl_xor(ss, 2); ss += __shfl_xor(ss, 4);
    const float rn = __builtin_amdgcn_rsqf(ss * (1.0f / 128.0f) + EPS) * (1.0f - LAM_INIT);
    const float* gp = gout + (lane & 7) * 16;
    u32x4 o[2];
#pragma unroll
    for (int v = 0; v < 2; ++v)
#pragma unroll
        for (int w = 0; w < 4; ++w) o[v][w] = cvt_pk_bf16(d[v * 8 + w * 2] * rn * gp[v * 8 + w * 2], d[v * 8 + w * 2 + 1] * rn * gp[v * 8 + w * 2 + 1]);
    u32x4* op = (u32x4*)dif + 2 * lane; op[0] = o[0]; op[1] = o[1];
}

struct P4bOrder {
    pg8::StaticOrder T; unsigned char* ws; const char* xa;
    __device__ __forceinline__ bool next(int i, pg8::Unit& u) const {
        int pm, pn; if (!T.tile(i, pm, pn)) return false;
        u.pm = pm; u.pn = pn; u.ui = i; u.ri = i; u.tag = 0; u.K = 1024;
        u.A = xa + (size_t)pm * 256 * 1024 * 2;
        u.Bt = (const char*)ws + (pn < 8 ? WS_WRG + (size_t)pn * 256 * 1024 * 2 : WS_WGATE + (size_t)(pn - 8) * 256 * 1024 * 2); return true;
    }
};
struct P5Order {
    pg8::StaticOrder T; unsigned char* ws;
    __device__ __forceinline__ bool next(int i, pg8::Unit& u) const {
        const int ti = i / 3, kbr = i - 3 * ti; int pm, pn; if (!T.tile(ti, pm, pn)) return false;
        const size_t offA = kbr == 0 ? WS_RET : kbr == 1 ? WS_DIF : WS_MO;
        const size_t offB = kbr == 0 ? WS_WBRR : kbr == 1 ? WS_WBRD : WS_WBRM;
        const int K = kbr == 0 ? 2048 : 1024;
        u.pm = pm; u.pn = pn; u.ui = i; u.ri = ti; u.tag = kbr; u.K = K;
        u.A = (const char*)ws + offA + (size_t)pm * 256 * K * 2; u.Bt = (const char*)ws + offB + (size_t)pn * 256 * K * 2; return true;
    }
};
#ifndef PH_MASK
#define PH_MASK 0xffffffffu
#endif
#define PH(n) ((PH_MASK >> (n)) & 1u)
#ifndef DUP_MASK
#define DUP_MASK 0u
#endif
#ifndef PROBE_K
#define PROBE_K (-1)
#endif
#define RUNP(k) (pass_ == 1 || (k) <= PROBE_K)
#define REPQ(n) _Pragma("unroll 1") for (int rq_ = 0; rq_ < 1 + (int)((DUP_MASK >> (n)) & 1u); ++rq_)
#define REP(n) _Pragma("unroll 1") for (int rep_ = 0; rep_ < 1 + (int)((DUP_MASK >> (n)) & 1u); ++rep_)
struct Args { const void* in[26]; float* out; unsigned char* ws; };
#define CAS __attribute__((address_space(4)))
__device__ __forceinline__ const void* karg(int i) { typedef const GAS void* gptr; const CAS gptr* p = (const CAS gptr*)__builtin_amdgcn_kernarg_segment_ptr(); asm volatile("" : "+s"(p)); return (const void*)p[i]; }
#define INP(i) ((const float*)karg(i))
#define WSP(T, off) ((T*)((unsigned char*)karg(27) + (off)))
#define OUTP ((float*)karg(26))
struct SplitWait {
    unsigned target;
    __device__ __forceinline__ void wait() const { if (target) xcd_split_wait((unsigned*)WSP(unsigned, WS_CTL) + CW_BAR2, (unsigned*)WSP(unsigned, WS_CTL) + CW_BAR, target); }
};
__global__ void __launch_bounds__(NWAVES * 64, 2) mk_fwd(Args args) {
    extern __shared__ __attribute__((aligned(16))) unsigned char lds_raw[];
    LAS unsigned char* lds = (LAS unsigned char*)lds_raw;
    volatile LAS unsigned* MISC = (volatile LAS unsigned*)(lds + MISC_OFF);
    const int G = gridDim.x, bx = blockIdx.x;
    for (int u = threadIdx.x; u < (LDS_BYTES - LDSCTL_OFF) / 4; u += NWAVES * 64) ((LAS unsigned*)(lds + LDSCTL_OFF))[u] = 0u;
    __syncthreads();
    (void)xcd_barrier_post((unsigned*)WSP(unsigned, WS_CTL) + CW_BAR, MISC + 8);
#define GRID_BAR() do { XcdBarrier b_; b_.bar = (unsigned*)WSP(unsigned, WS_CTL) + CW_BAR; b_.x = xb_xcc_id(); b_.st = (volatile LAS unsigned*)(lds + MISC_OFF) + 8; xcd_barrier(b_); } while (0)
#define SPLIT_ARRIVE() do { xcd_split_arrive((unsigned*)WSP(unsigned, WS_CTL) + CW_BAR2, (unsigned*)WSP(unsigned, WS_CTL) + CW_BAR, (volatile LAS unsigned*)(lds + MISC_OFF) + 8); ++sgen; } while (0)
    unsigned sgen = 0;
    const int NGW = G * NWAVES, NGT = G * NWAVES * 64;
#define LANE_VARS() const int tid = opaque_tid(), lane = tid & 63, wave = __builtin_amdgcn_readfirstlane(tid >> 6); LAS float* scr = (LAS float*)(lds + wave * 16384); \
    const int gw = bx * NWAVES + wave, gt = bx * (NWAVES * 64) + tid; (void)scr; (void)gw; (void)gt; (void)lane

#pragma unroll 1
    for (int pass_ = (PROBE_K >= 0 ? 0 : 1); pass_ < 2; ++pass_) {
    if (RUNP(0)) {
    REP(0) if (PH(0)) {
        LANE_VARS();
        transpose_all<true>(INP(4), 1024, 2 * DFF, WSP(bf16_t, WS_WF1I), 2 * DFF, ColSwiglu{}, nullptr, scr, gw, NGW, lane);
        transpose_all(INP(18), 1024, 2048, WSP(bf16_t, WS_WMKV), 2048, ColIdent{0}, nullptr, scr, gw, NGW, lane);
        { const float* x = INP(0); const float* g1 = INP(3); bf16_t* xb = WSP(bf16_t, WS_XBL);
          rms_rows_to_bf16(x, g1, xb, gw, NGW, TOK, lane); }
        { const float* mem = INP(1); const float* gm = INP(17); bf16_t* memn = WSP(bf16_t, WS_MEMN);
          rms_rows_to_bf16(mem, gm, memn, gw, NGW, NB * MEML, lane); }
        rot_table((const int*)karg(2), WSP(float, WS_ROT), gt, NGT);
    }
    GRID_BAR();
    }

    if (RUNP(1)) {
    REP(1) if (PH(1)) {
        pg8::Gemm g{WSP(bf16_t, WS_XBL), WSP(bf16_t, WS_WF1I), TOK, 2 * DFF, 1024}; pg8::StaticOrder S; S.init(TOK, 2 * DFF, G, bx);
        EpiSwiglu E{WSP(bf16_t, WS_ACT), nullptr};
        S.set(g); pg8::gemm_phase(lds, S, E);
    }
    if (PH(2)) {
        pg8::Gemm g{WSP(bf16_t, WS_MEMN), WSP(bf16_t, WS_WMKV), NB * MEML, 2048, 1024}; pg8::StaticOrder S; S.init(NB * MEML, 2048, G, (bx + G / 2) % G);
        EpiPlain E{WSP(bf16_t, WS_MKVRAW), 2048};
        S.set(g); pg8::gemm_phase(lds, S, E);
    }
    if (PH(0)) {
        const int q0 = (3 * G) / 4, nq = G - q0;
        if (bx >= q0) {
            LANE_VARS();
            const int gw2 = (bx - q0) * NWAVES + wave, ngw2 = nq * NWAVES;
            transpose_all(INP(5), DFF, 1024, WSP(bf16_t, WS_WF1O), 1024, ColIdent{0}, nullptr, scr, gw2, ngw2, lane);
            transpose_all<true>(INP(7), 1024, 13312, WSP(bf16_t, WS_WMIX), NMIX, ColMix{}, INP(6), scr, gw2, ngw2, lane);
        }
    }
    GRID_BAR();
    }

    if (RUNP(2)) {
    REP(3) if (PH(3)) {
        pg8::Gemm g{WSP(bf16_t, WS_ACT), WSP(bf16_t, WS_WF1O), TOK, 1024, DFF}; pg8::StaticOrder S; S.init(TOK, 1024, G, bx);
        EpiResid<false, false> E{INP(0), nullptr, (bf16_t*)OUTP, WSP(float, WS_SSQ1), 0.5f, (rep_ == 1 && ((DUP_MASK >> 23) & 1u)) ? 1 : 0};
        S.set(g); pg8::gemm_phase(lds, S, E);
    }
    SPLIT_ARRIVE();
    if (PH(0)) {
        LANE_VARS();
        const bf16_t* mkvraw = WSP(bf16_t, WS_MKVRAW); bf16_t* mkn = WSP(bf16_t, WS_MKN); bf16_t* mvt = WSP(bf16_t, WS_MVT);
        const float* g_mem_k = INP(16); const float* g_mem_q = INP(15);
        for (int j = gw; j < NB * MEML * 4; j += NGW) {
            const int row = j >> 2, h = j & 3;
            const u32x2 w = *((const u32x2*)(mkvraw + (size_t)row * 2048 + h * 256) + lane);
            f32x4 v = (f32x4){__uint_as_float(w.x << 16), __uint_as_float(w.x & 0xffff0000u), __uint_as_float(w.y << 16), __uint_as_float(w.y & 0xffff0000u)};
            const float ss = wave_sum((v[0] * v[0] + v[1] * v[1]) + (v[2] * v[2] + v[3] * v[3]));
            const float rn = __builtin_amdgcn_rsqf(ss * (1.0f / 256.0f) + EPS);
            const f32x4 gk = *((const f32x4*)g_mem_k + lane), gq = *((const f32x4*)g_mem_q + lane);
            *((u32x2*)(mkn + (size_t)row * 1024 + h * 256) + lane) = pack4(v * rn * gk * gq);
        }
        for (int idx = gt; idx < NB * 4 * 256 * 256; idx += NGT) {
            const int key = idx & 255, d = (idx >> 8) & 255, bh = idx >> 16, b = bh >> 2, h = bh & 3;
            mvt[idx] = mkvraw[(size_t)(b * 256 + key) * 2048 + 1024 + h * 256 + d];
        }
    }
    { SplitWait H{sgen}; H.wait(); }
    }

    if (RUNP(3))
    for (int ph = 0; ph <= NB; ++ph) {
        const int gp = ph, gm = ph - 1;
        unsigned char* const wsP = WSP(unsigned char, 0) - (((gp + 1) & 1) ? SET_DELTA : 0);
        unsigned char* const wsB = WSP(unsigned char, 0) - (((gm + 1) & 1) ? SET_DELTA : 0);
        unsigned* done = (unsigned*)WSP(unsigned, WS_CTL) + CW_SCAN + ((pass_ * NB + (gm < 0 ? 0 : gm)) * 8) * 64; unsigned* tmo = (unsigned*)WSP(unsigned, WS_CTL) + CW_BAR + XB_TMO;
        const bool early = (gm >= 0 && bx < 64) || gp >= NB;
        if (early) { SplitWait H{sgen}; H.wait(); }
        if (gm >= 0)
            for (int u = bx; u < 64; u += G) REPQ(26) { __syncthreads(); if (PH(5)) scan_unit(u, (const bf16_t*)(wsB + WS_KTS), (const bf16_t*)(wsB + WS_VT), WSP(bf16_t, WS_S), lds, done); }
        if (gp < NB) {
            REP(4) if (PH(4)) {
                pg8::Gemm g{(const bf16_t*)OUTP + (size_t)gp * SEQ * DM, WSP(bf16_t, WS_WMIX), SEQ, NMIX, 1024}; pg8::StaticOrder S; S.init(SEQ, NMIX, G, bx);
                prep_rs(WSP(float, WS_SSQ1), gp * SEQ, S, lds);
                EpiMix E{(const LAS float*)(lds + RTAB_OFF), WSP(float, (gp & 1) ? WS_ROTB : WS_ROT), wsP, WSP(bf16_t, WS_MO) + (size_t)gp * SEQ * 1024, INP(8), INP(9)};
                SplitWait H{early ? 0u : sgen};
                S.set(g); pg8::gemm_phase(lds, S, E, H);
                if (bx >= (SEQ / 256) * (NMIX / 256)) H.wait();
            }
        }
        if (gm >= 0) {
            const size_t oOff = (gm & 1) ? WS_OB : 0;
            unsigned* qctr = (unsigned*)WSP(unsigned, WS_CTL) + CW_QUEUE + (pass_ * NB + gm) * 64;
            volatile LAS unsigned* qslot = (volatile LAS unsigned*)(lds + MISC_OFF) + 16;
            for (;;) {
                __syncthreads();
                if (threadIdx.x == 0) qslot[0] = __hip_atomic_fetch_add(qctr, 1u, __ATOMIC_RELAXED, __HIP_MEMORY_SCOPE_AGENT);
                __syncthreads();
                const int id = __builtin_amdgcn_readfirstlane((int)qslot[0]);
                if (id >= 320) break;
                int aq = -1, aj = 0;
                if (id < 96) { aq = 7 - (id >> 4); aj = id & 15; }
                else if (id >= 192) { const int ro = id - 192;
                    if (PH(8)) REPQ(24) { __syncthreads(); retout_unit(ro >> 5, (ro >> 1) & 15, ro & 1, (const bf16_t*)(wsB + WS_Q), (const bf16_t*)(wsB + WS_K), (const bf16_t*)(wsB + WS_VT), WSP(bf16_t, WS_S),
                                           WSP(bf16_t, WS_RET) + (size_t)gm * SEQ * 2048, WSP(float, WS_SSQ2) + (size_t)gm * SEQ * 8, lds, done, tmo); } }
                else if (id < 160) { const int m = id - 96;
                    if (PH(7)) memattn_unit(gm, m >> 4, m & 15, WSP(bf16_t, WS_MKN), WSP(bf16_t, WS_MVT), WSP(bf16_t, WS_MO) + (size_t)gm * SEQ * 1024, lds); }
                else { aq = 1 - ((id - 160) >> 4); aj = (id - 160) & 15; }
                if (aq >= 0) {
                    const int hc = aj, hh = hc >> 1, cc = hc & 1;
                    if (PH(6)) REPQ(25) attn_body::attn_unit<8>(hc, hh, aq, (const attn_body::bf16*)(wsB + WS_DQ), (const attn_body::bf16*)(wsB + WS_DK), (const attn_body::bf16*)(wsB + WS_DV),
                                            WSP(attn_body::bf16, (cc ? WS_O1 : WS_O0) + oOff), (char*)lds_raw);
                }
            }
        }
        {
            LANE_VARS();
            if (ph >= 2) {
                const int gd = ph - 2; const size_t oD = (gd & 1) ? WS_OB : 0;
                const float s1 = wave_sum(INP(10)[lane] * INP(11)[lane]), s2 = wave_sum(INP(12)[lane] * INP(13)[lane]); const float lam = __expf(s1) - __expf(s2) + LAM_INIT;
                const bf16_t* bo0 = WSP(bf16_t, WS_O0 + oD); const bf16_t* bo1 = WSP(bf16_t, WS_O1 + oD); bf16_t* difb = WSP(bf16_t, WS_DIF); const float* gdo = INP(14);
                for (int r = gw; r < SEQ; r += NGW) dif_row(bo0 + (size_t)r * 1024, bo1 + (size_t)r * 1024, difb + ((size_t)gd * SEQ + r) * 1024, gdo, lam, lane);
            }
            if (ph + 1 < NB) rot_table((const int*)karg(2) + (ph + 1) * SEQ, WSP(float, ((ph + 1) & 1) ? WS_ROTB : WS_ROT), gt, NGT);
            if (ph == 0) transpose_all<true>(INP(7), 1024, 13312, WSP(bf16_t, WS_WRG), 2048, ColIdent{4096}, INP(6), scr, gw, NGW, lane);
            if (ph == NB) {
                transpose_all<true>(INP(7), 1024, 13312, WSP(bf16_t, WS_WGATE), 3072, ColIdent{10240}, INP(6), scr, gw, NGW, lane);
            }
        }
        SPLIT_ARRIVE();
    }

    if (RUNP(4)) {
    if (PH(9)) {
        pg8::StaticOrder T; T.init(TOK, 5120, G, bx);
        prep_rs(WSP(float, WS_SSQ1), 0, T, lds);
        P4bOrder S{T, WSP(unsigned char, 0), (const char*)OUTP};
        EpiRgG E{(const LAS float*)(lds + RTAB_OFF), WSP(bf16_t, WS_RET), WSP(float, WS_SSQ2), WSP(unsigned char, 0)};
        SplitWait H{sgen};
        pg8::gemm_phase(lds, S, E, H);
        if (bx >= (TOK / 256) * (5120 / 256)) H.wait();
    }
    if (PH(0)) {
        LANE_VARS();
        { const float s1 = wave_sum(INP(10)[lane] * INP(11)[lane]), s2 = wave_sum(INP(12)[lane] * INP(13)[lane]); const float lam = __expf(s1) - __expf(s2) + LAM_INIT;
          const bf16_t* bo0 = WSP(bf16_t, WS_O0 + (((NB - 1) & 1) ? WS_OB : 0)); const bf16_t* bo1 = WSP(bf16_t, WS_O1 + (((NB - 1) & 1) ? WS_OB : 0)); bf16_t* difb = WSP(bf16_t, WS_DIF); const float* gdo = INP(14);
          for (int r = gw; r < SEQ; r += NGW) dif_row(bo0 + (size_t)r * 1024, bo1 + (size_t)r * 1024, difb + ((size_t)(NB - 1) * SEQ + r) * 1024, gdo, lam, lane); }
        transpose_all<true>(INP(19), 2048, 1024, WSP(bf16_t, WS_WBRR), 1024, ColIdent{0}, nullptr, scr, gw, NGW, lane);
        transpose_all<true>(INP(20), 1024, 1024, WSP(bf16_t, WS_WBRD), 1024, ColIdent{0}, nullptr, scr, gw, NGW, lane);
        transpose_all<true>(INP(21), 1024, 1024, WSP(bf16_t, WS_WBRM), 1024, ColIdent{0}, nullptr, scr, gw, NGW, lane);
    }
    SPLIT_ARRIVE();
    if (PH(0)) {
        LANE_VARS();
        transpose_all(INP(22), 1024, 1024, WSP(bf16_t, WS_WO), 1024, ColIdent{0}, nullptr, scr, gw, NGW, lane);
        transpose_all<true>(INP(24), 1024, 2 * DFF, WSP(bf16_t, WS_WF2I), DFF, ColSwigluOff{0}, INP(23), scr, gw, NGW, lane);
    }
    { SplitWait H{sgen}; H.wait(); }
    }

    if (RUNP(5)) {
    REP(10) if (PH(10)) {
        pg8::StaticOrder T; T.init(TOK, 1024, G, bx);
        P5Order S{T, WSP(unsigned char, 0)};
        EpiTerm3 E{WSP(unsigned char, 0), WSP(bf16_t, WS_Y)};
        pg8::gemm_phase(lds, S, E);
    }
    SPLIT_ARRIVE();
    if (PH(0)) {
        LANE_VARS();
        transpose_all<true>(INP(24), 1024, 2 * DFF, WSP(bf16_t, WS_WF2I) + (size_t)DFF * 1024, DFF, ColSwigluOff{DFF}, INP(23), scr, gw, NGW, lane);
    }
    { SplitWait H{sgen}; H.wait(); }
    }

    if (RUNP(6)) {
    if (PH(11)) {
        pg8::Gemm g{WSP(bf16_t, WS_Y), WSP(bf16_t, WS_WO), TOK, 1024, 1024}; pg8::StaticOrder S; S.init(TOK, 1024, G, bx);
        EpiResid<true, false> E{OUTP, nullptr, WSP(bf16_t, WS_X2B), WSP(float, WS_SSQ2), 1.0f, 0};
        S.set(g); pg8::gemm_phase(lds, S, E);
    }
    SPLIT_ARRIVE();
    if (PH(0)) {
        LANE_VARS();
        transpose_all(INP(25), DFF, 1024, WSP(bf16_t, WS_WF2O), 1024, ColIdent{0}, nullptr, scr, gw, NGW, lane);
    }
    { SplitWait H{sgen}; H.wait(); }
    }

    if (RUNP(7)) {
    if (PH(12)) {
        pg8::Gemm g{WSP(bf16_t, WS_X2B), WSP(bf16_t, WS_WF2I), TOK, 2 * DFF, 1024}; pg8::StaticOrder S; S.init(TOK, 2 * DFF, G, bx);
        prep_rs(WSP(float, WS_SSQ2), 0, S, lds);
        EpiSwiglu E{WSP(bf16_t, WS_ACT2), (const LAS float*)(lds + RTAB_OFF)};
        S.set(g); pg8::gemm_phase(lds, S, E);
    }
    GRID_BAR();
    }

    if (RUNP(8))
    if (PH(13)) {
        pg8::Gemm g{WSP(bf16_t, WS_ACT2), WSP(bf16_t, WS_WF2O), TOK, 1024, DFF}; pg8::StaticOrder S; S.init(TOK, 1024, G, bx);
        EpiResid<true, true> E{WSP(bf16_t, WS_X2B), OUTP, nullptr, nullptr, 0.5f, 0};
        S.set(g); pg8::gemm_phase(lds, S, E);
    }
    if (pass_ == 0) GRID_BAR();
    }
}

extern "C" void kernel_launch(void* const* d_in, const int* in_sizes, int n_in, void* d_out, int out_size, void* d_ws, size_t ws_size, hipStream_t stream) {
    static int grid = 0;
    if (grid == 0) {
        if (n_in != 26 || ws_size < WS_END) { fprintf(stderr, "kernel_launch: unexpected inputs (n_in %d, ws %zu)\n", n_in, ws_size); grid = -1; return; }
        int dev = 0, cus = 0;
        if (hipGetDevice(&dev) != hipSuccess || hipDeviceGetAttribute(&cus, hipDeviceAttributeMultiprocessorCount, dev) != hipSuccess) { grid = -1; return; }
        if (hipFuncSetAttribute((const void*)mk_fwd, hipFuncAttributeMaxDynamicSharedMemorySize, LDS_BYTES) != hipSuccess) { fprintf(stderr, "kernel_launch: hipFuncSetAttribute failed\n"); grid = -1; return; }
        grid = cus;
    }
    if (grid < 0) return;
    (void)hipMemsetAsync((char*)d_ws + WS_CTL, 0, CTL_ZERO_BYTES, stream);
    Args a{};
    for (int i = 0; i < 26; ++i) a.in[i] = d_in[i];
    a.out = (float*)d_out; a.ws = (unsigned char*)d_ws;
    hipLaunchKernelGGL(mk_fwd, dim3(grid), dim3(NWAVES * 64), LDS_BYTES, stream, a);
}
```

```cpp
#include <hip/hip_runtime.h>
#include <cstdio>
#include <cstdint>

#define LAS __attribute__((address_space(3)))
#define GAS __attribute__((address_space(1)))
typedef unsigned short bf16_t;
typedef short bf16x8 __attribute__((ext_vector_type(8)));
typedef float f32x4 __attribute__((ext_vector_type(4)));
typedef float f32x2 __attribute__((ext_vector_type(2)));
typedef unsigned u32x4 __attribute__((ext_vector_type(4)));
typedef unsigned u32x2 __attribute__((ext_vector_type(2)));

constexpr int NB = 8, SEQ = 2048, DM = 1024, TOK = NB * SEQ, MEML = 256, DFF = 2816;
constexpr int NMIX = 8192;
constexpr float EPS = 1e-6f;
constexpr float LOG2E = 1.4426950408889634f;
constexpr float C2Q = 0.125f * LOG2E;
constexpr float LAM_INIT = 0.2f;

constexpr size_t MiB = 1u << 20;
constexpr size_t KiB = 1u << 10;
constexpr size_t WS_CTL = 0, CTL_ZERO_BYTES = 256 * KiB;
constexpr size_t WS_SSQ1 = 256 * KiB, WS_SSQ2 = 512 * KiB;
constexpr size_t WS_ROT = 1 * MiB, WS_ROTB = 153 * MiB;
constexpr size_t WS_MKN = 3 * MiB, WS_MVT = 7 * MiB;
constexpr size_t WS_WMIX = 11 * MiB;
constexpr size_t WS_XB = 27 * MiB;
constexpr size_t WS_RET = 59 * MiB;
constexpr size_t WS_XBL = 91 * MiB;
constexpr size_t WS_DIF = 123 * MiB;
constexpr size_t WS_MO = 155 * MiB;
constexpr size_t WS_Q = 187 * MiB, WS_K = 191 * MiB, WS_KTS = 195 * MiB, WS_VT = 199 * MiB, WS_DQ = 207 * MiB, WS_DK = 211 * MiB,
                 WS_DV = 215 * MiB;
constexpr size_t SET_DELTA = 160 * MiB;
constexpr size_t WS_WRG = 219 * MiB;
constexpr size_t WS_O0 = 223 * MiB, WS_O1 = 227 * MiB, WS_S = 231 * MiB;
constexpr size_t WS_OB = 24 * MiB;
constexpr size_t WS_WF1I = 59 * MiB, WS_WF1O = 70 * MiB;
constexpr size_t WS_MEMN = 76 * MiB, WS_MKVRAW = 80 * MiB, WS_WMKV = 27 * MiB;
constexpr size_t WS_ACT = 155 * MiB;
constexpr size_t WS_WGATE = 11 * MiB, WS_WBRR = 17 * MiB, WS_WBRD = 21 * MiB, WS_WBRM = 23 * MiB, WS_WO = 25 * MiB;
constexpr size_t WS_G8A = 187 * MiB, WS_G8B = 203 * MiB, WS_G8C = 223 * MiB;
constexpr size_t WS_Y = 27 * MiB;
constexpr size_t WS_X2B = 187 * MiB;
constexpr size_t WS_WF2I = 239 * MiB, WS_WF2O = 1 * MiB, WS_ACT2 = 76 * MiB;
constexpr size_t WS_END = 256 * MiB;

constexpr int CW_BAR = 4096, CW_BAR2 = 8192;
constexpr int CW_QUEUE = 32768;
constexpr int CW_SCAN = 16384;

constexpr int RING_BYTES = 131072, LDSCTL_OFF = RING_BYTES, MISC_OFF = LDSCTL_OFF + 320, LDS_BYTES = 147456;
constexpr int NWAVES = 8;

__device__ __forceinline__ unsigned cvt_pk_bf16(float lo, float hi) { unsigned r; asm volatile("v_cvt_pk_bf16_f32 %0, %1, %2" : "=v"(r) : "v"(lo), "v"(hi)); return r; }
__device__ __forceinline__ u32x2 pack4(f32x4 v) { u32x2 w; w.x = cvt_pk_bf16(v[0], v[1]); w.y = cvt_pk_bf16(v[2], v[3]); return w; }
__device__ __forceinline__ unsigned short bf16_1(float v) { return (unsigned short)(cvt_pk_bf16(v, 0.f) & 0xffffu); }
__device__ __forceinline__ float bf2f(unsigned short b) { return __uint_as_float(((unsigned)b) << 16); }
__device__ __forceinline__ float siluf(float x) { return x * __builtin_amdgcn_rcpf(1.0f + __builtin_amdgcn_exp2f(-x * LOG2E)); }
__device__ __forceinline__ float sigmf(float x) { return __builtin_amdgcn_rcpf(1.0f + __builtin_amdgcn_exp2f(-x * LOG2E)); }
__device__ __forceinline__ float row_rs(const float* ssq, int row) {
    const f32x4 a = *(const f32x4*)(ssq + (size_t)row * 4);
    return __builtin_amdgcn_rsqf(((a[0] + a[1]) + (a[2] + a[3])) * (1.0f / 1024.0f) + EPS);
}
__device__ __forceinline__ int opaque_tid() { int t = threadIdx.x; asm volatile("" : "+v"(t)); return t; }
__device__ __forceinline__ f32x4 mfma16(bf16x8 a, bf16x8 b, f32x4 c) { return __builtin_amdgcn_mfma_f32_16x16x32_bf16(a, b, c, 0, 0, 0); }

namespace pg8 {
constexpr int BM = 256, BK = 64, HALF = 128, HTB = HALF * BK * 2, STAGE_BYTES = 8 * HTB, NXCD = 8, WGM = 8;
__host__ __device__ __forceinline__ int lds_byte(int r, int c) { const int st = (r >> 4) * 2 + (c >> 5), rr = r & 15, cc = c & 31, ob = rr * 64 + cc * 2; return st * 1024 + (ob ^ (((ob >> 9) & 1) << 5)); }
__host__ __device__ __forceinline__ void stage_rc(int b, int& R, int& C) { const int st = b / 1024, sb = b % 1024, swz = sb ^ (((sb >> 9) & 1) << 5); R = (st >> 1) * 16 + swz / 64; C = (st & 1) * 32 + (swz % 64) / 2; }
struct Unit { int pm, pn, ui, ri, tag, K; const char* A; const char* Bt; };
struct Gemm { const bf16_t* A; const bf16_t* Bt; int M, N, K; };
struct StaticOrder {
    int nM, nN, nwg, G, c; Gemm g;
    __host__ __device__ void init(int M, int N, int G_, int c_) { nM = M / BM; nN = N / BM; nwg = nM * nN; G = G_; c = c_; g.A = nullptr; g.Bt = nullptr; g.M = M; g.N = N; g.K = 0; }
    __host__ __device__ void set(const Gemm& g_) { g = g_; }
    __host__ __device__ bool tile(int i, int& pm, int& pn) const {
        const long L = (long)i * G + c; if (L >= nwg) return false;
        int wgid = (int)L; { const int q = nwg / NXCD, r = nwg % NXCD, xcd = wgid % NXCD, off = wgid / NXCD; wgid = (xcd < r ? xcd * (q + 1) : r * (q + 1) + (xcd - r) * q) + off; }
        const int nig = WGM * nN, gid = wgid / nig, fm = gid * WGM, gsz = (nM - fm) < WGM ? (nM - fm) : WGM;
        pm = fm + ((wgid % nig) % gsz); pn = (wgid % nig) / gsz; return true;
    }
    __host__ __device__ bool next(int i, Unit& u) const {
        if (!tile(i, u.pm, u.pn)) return false;
        u.ui = i; u.ri = i; u.tag = 0; u.K = g.K;
        u.A = (const char*)g.A + (size_t)u.pm * 256 * g.K * 2; u.Bt = (const char*)g.Bt + (size_t)u.pn * 256 * g.K * 2; return true;
    }
};
struct NoHook { __device__ __forceinline__ void wait() const {} };
template <class Epi, class Sched, class Hook = NoHook>
__device__ __forceinline__ void gemm_phase(LAS unsigned char* lds, const Sched& S, const Epi& E, const Hook& H = Hook{}) {
    const int tid = opaque_tid(), wid = __builtin_amdgcn_readfirstlane(tid >> 6), lane = tid & 63, wr = wid >> 2, wc = wid & 3, fr = lane & 15, fq = lane >> 4;
    unsigned R2[2], C2[2];
#pragma unroll
    for (int i = 0; i < 2; ++i) { int R, C; stage_rc(tid * 16 + i * 8192, R, C); R2[i] = (unsigned)R * 2u; C2[i] = (unsigned)C * 2u; }
    const size_t kstep = (size_t)(BK * 2);
    const unsigned ldsw = (unsigned)wid * 1024u;
    const int aoff = lds_byte(wr * 64 + fr, fq * 8), boff = lds_byte(wc * 32 + fr, fq * 8);
#define PG8_SA(b, h) (((b) * 2 + (h)) * HTB)
#define PG8_SB(b, h) ((4 + (b) * 2 + (h)) * HTB)
#define PG8_STAGE(bufoff, gbase, voff) do { _Pragma("unroll") for (int _i = 0; _i < 2; ++_i) \
        __builtin_amdgcn_global_load_lds((const unsigned*)((const char*)(gbase) + (voff)[_i]), (LAS unsigned*)(lds + (bufoff) + ldsw + _i * 8192), 16, 0, 0); } while (0)
#define PG8_LDA(dst, b, h) do { _Pragma("unroll") for (int m = 0; m < 4; ++m) _Pragma("unroll") for (int k = 0; k < 2; ++k) dst[m][k] = *(const LAS bf16x8*)(lds + PG8_SA(b, h) + aoff + m * 2048 + k * 1024); } while (0)
#define PG8_LDB(dst, b, h) do { _Pragma("unroll") for (int n = 0; n < 2; ++n) _Pragma("unroll") for (int k = 0; k < 2; ++k) dst[n][k] = *(const LAS bf16x8*)(lds + PG8_SB(b, h) + boff + n * 2048 + k * 1024); } while (0)
#define PG8_MMA(ai, bj, At, Bt) do { __builtin_amdgcn_s_setprio(1); _Pragma("unroll") for (int m = 0; m < 4; ++m) _Pragma("unroll") for (int n = 0; n < 2; ++n) _Pragma("unroll") for (int k = 0; k < 2; ++k) \
        acc[ai][bj][m][n] = __builtin_amdgcn_mfma_f32_16x16x32_bf16(Bt[n][k], At[m][k], acc[ai][bj][m][n], 0, 0, 0); __builtin_amdgcn_s_setprio(0); } while (0)
#define PG8_WAIT_V(n) asm volatile("s_waitcnt vmcnt(" #n ")" ::: "memory")
#define PG8_WAIT_L(n) asm volatile("s_waitcnt lgkmcnt(" #n ")" ::: "memory")
#define PG8_BAR __builtin_amdgcn_s_barrier()
#define PG8_SCHED __builtin_amdgcn_sched_barrier(0)
    Unit cur, nxt; int ui = 0;
    if (!S.next(0, cur)) return;
    f32x4 acc[2][2][4][2];
#pragma unroll
    for (int a = 0; a < 2; ++a)
#pragma unroll
        for (int b = 0; b < 2; ++b)
#pragma unroll
            for (int m = 0; m < 4; ++m)
#pragma unroll
                for (int n = 0; n < 2; ++n) acc[a][b][m][n] = (f32x4){0.f, 0.f, 0.f, 0.f};
    bf16x8 At[4][2], B0[2][2], B1[2][2];
    const char* cA = cur.A; const char* cB = cur.Bt;
    unsigned vo[2] = {R2[0] * (unsigned)cur.K + C2[0], R2[1] * (unsigned)cur.K + C2[1]};
    size_t hstep = (size_t)HALF * cur.K * 2;
    PG8_STAGE(PG8_SB(0, 0), cB, vo); PG8_STAGE(PG8_SB(0, 1), cB + hstep, vo); PG8_STAGE(PG8_SA(0, 0), cA, vo); PG8_STAGE(PG8_SA(0, 1), cA + hstep, vo);
    if (wr == 1) PG8_BAR;
    PG8_WAIT_V(2); PG8_BAR;
    PG8_STAGE(PG8_SB(1, 0), cB + kstep, vo); PG8_STAGE(PG8_SA(1, 0), cA + kstep, vo); PG8_STAGE(PG8_SB(1, 1), cB + hstep + kstep, vo);
    PG8_WAIT_V(6); PG8_BAR;
    for (;;) {
        const bool has_next = S.next(ui + 1, nxt);
        if (!has_next) nxt = cur;
        const char* nA = nxt.A; const char* nB = nxt.Bt;
        const unsigned voN0 = R2[0] * (unsigned)nxt.K + C2[0], voN1 = R2[1] * (unsigned)nxt.K + C2[1]; const size_t hstepN = (size_t)HALF * nxt.K * 2;
        const int nt = cur.K / BK;
        for (int t = 0; t < nt; t += 2) {
            const bool last = (t == nt - 2);
            const char* a1 = cA + (size_t)(t + 1) * kstep;
            const char* a2 = last ? nA : cA + (size_t)(t + 2) * kstep; const char* b2 = last ? nB : cB + (size_t)(t + 2) * kstep;
            const char* a3 = a2 + kstep; const char* b3 = b2 + kstep;
            const unsigned v2[2] = {last ? voN0 : vo[0], last ? voN1 : vo[1]}; const size_t h2 = last ? hstepN : hstep;
            PG8_LDB(B0, 0, 0); PG8_LDB(B1, 0, 1); PG8_SCHED; PG8_LDA(At, 0, 0); PG8_STAGE(PG8_SA(1, 1), a1 + hstep, vo);
            PG8_WAIT_V(8); PG8_WAIT_L(0); PG8_BAR; PG8_MMA(0, 0, At, B0); PG8_MMA(0, 1, At, B1); PG8_BAR; PG8_SCHED;
            PG8_LDA(At, 0, 1); PG8_STAGE(PG8_SB(0, 0), b2, v2); PG8_STAGE(PG8_SB(0, 1), b2 + h2, v2); PG8_STAGE(PG8_SA(0, 0), a2, v2);
            PG8_WAIT_V(8); PG8_WAIT_L(0); PG8_BAR; PG8_MMA(1, 0, At, B0); PG8_MMA(1, 1, At, B1); PG8_BAR; PG8_SCHED;
            PG8_LDB(B0, 1, 0); PG8_LDB(B1, 1, 1); PG8_SCHED; PG8_LDA(At, 1, 0); PG8_STAGE(PG8_SA(0, 1), a2 + h2, v2);
            PG8_WAIT_V(8); PG8_WAIT_L(0); PG8_BAR; PG8_MMA(0, 0, At, B0); PG8_MMA(0, 1, At, B1); PG8_BAR; PG8_SCHED;
            PG8_LDA(At, 1, 1); PG8_STAGE(PG8_SB(1, 0), b3, v2); PG8_STAGE(PG8_SB(1, 1), b3 + h2, v2); PG8_STAGE(PG8_SA(1, 0), a3, v2);
            PG8_WAIT_V(8); PG8_WAIT_L(0); PG8_BAR; PG8_MMA(1, 0, At, B0); PG8_MMA(1, 1, At, B1); PG8_BAR; PG8_SCHED;
        }
        if (wr == 0) PG8_BAR;
        if (ui == 0 && (!Epi::AFTER_DRAIN || has_next)) H.wait();
        if (!Epi::AFTER_DRAIN || has_next) { int fr2 = fr, fq2 = fq; asm volatile("" : "+v"(fr2), "+v"(fq2)); E(acc, cur, wr, wc, fr2, fq2); }
        if (!has_next) break;
#pragma unroll
        for (int a = 0; a < 2; ++a)
#pragma unroll
            for (int b = 0; b < 2; ++b)
#pragma unroll
                for (int m = 0; m < 4; ++m)
#pragma unroll
                    for (int n = 0; n < 2; ++n) acc[a][b][m][n] = (f32x4){0.f, 0.f, 0.f, 0.f};
        cur = nxt; cA = nA; cB = nB; vo[0] = voN0; vo[1] = voN1; hstep = hstepN; ++ui;
        if (wr == 1) PG8_BAR;
    }
    PG8_WAIT_V(0);
    PG8_BAR;
    if constexpr (Epi::AFTER_DRAIN) { if (ui == 0) H.wait(); }
    if constexpr (Epi::AFTER_DRAIN) { int fr2 = fr, fq2 = fq; asm volatile("" : "+v"(fr2), "+v"(fq2)); E.fused(acc, cur, wr, wc, fr2, fq2, lds); }
#undef PG8_SA
#undef PG8_SB
#undef PG8_STAGE
#undef PG8_LDA
#undef PG8_LDB
#undef PG8_MMA
#undef PG8_WAIT_V
#undef PG8_WAIT_L
#undef PG8_BAR
#undef PG8_SCHED
}
}

__device__ __forceinline__ float wave_sum(float v);
#define ACC_ARG const f32x4 (&acc)[2][2][4][2]
#define EPI_FENCE() asm volatile("" ::: "memory")
constexpr int RTAB_OFF = RING_BYTES + 1024;
__device__ __forceinline__ void prep_rs(const float* ssq, int row_off, const pg8::StaticOrder& S, LAS unsigned char* lds) {
    const int tid = opaque_tid(); LAS float* rtab = (LAS float*)(lds + RTAB_OFF); pg8::Unit u;
    for (int i = 0; i < 6 && S.next(i, u); ++i) if (tid < 256) rtab[i * 256 + tid] = row_rs(ssq, row_off + u.pm * 256 + tid);
    __syncthreads();
}
struct EpiSwiglu {
    static constexpr bool AFTER_DRAIN = false;
    bf16_t* O; const LAS float* rtab;
    __device__ __forceinline__ void operator()(ACC_ARG, const pg8::Unit& u, int wr, int wc, int fr, int fq) const {
        const int lr0 = wr * 64 + fr, col0 = u.pn * 128 + wc * 32 + 8 * fq;
#pragma unroll
        for (int ai = 0; ai < 2; ++ai)
#pragma unroll
            for (int m = 0; m < 4; ++m) {
                const int lr = lr0 + ai * 128 + m * 16;
                const float rs = rtab ? rtab[u.ri * 256 + lr] : 1.0f;
                u32x4 w;
#pragma unroll
                for (int n = 0; n < 2; ++n) {
                    const f32x4 gt = acc[ai][0][m][n] * rs, up = acc[ai][1][m][n] * rs; f32x4 v;
#pragma unroll
                    for (int j = 0; j < 4; ++j) v[j] = siluf(gt[j]) * up[j];
                    const u32x2 p = pack4(v); if (n == 0) { w.x = p.x; w.y = p.y; } else { w.z = p.x; w.w = p.y; }
                }
                *(u32x4*)(O + (size_t)(u.pm * 256 + lr) * DFF + col0) = w;
            }
    }
};
template <bool BB, bool OF>
struct EpiResid {
    static constexpr bool AFTER_DRAIN = true;
    const void* base; float* out; bf16_t* xb; float* ssq; float scale; int skip;
    __device__ __forceinline__ f32x4 ldb(size_t off) const {
        if (BB) { const u32x2 w = __builtin_nontemporal_load((const u32x2*)((const bf16_t*)base + off));
                  return (f32x4){__uint_as_float(w.x << 16), __uint_as_float(w.x & 0xffff0000u), __uint_as_float(w.y << 16), __uint_as_float(w.y & 0xffff0000u)}; }
        return __builtin_nontemporal_load((const f32x4*)((const float*)base + off));
    }
    __device__ __forceinline__ void operator()(ACC_ARG, const pg8::Unit& u, int wr, int wc, int fr, int fq) const {
        if (skip) return;
        const int row0 = u.pm * 256 + wr * 64 + fr, col0 = u.pn * 256 + wc * 32 + 4 * fq;
#pragma unroll
        for (int ai = 0; ai < 2; ++ai)
#pragma unroll
            for (int m = 0; m < 4; ++m) {
                const int row = row0 + ai * 128 + m * 16; float ss = 0.f;
#pragma unroll
                for (int bj = 0; bj < 2; ++bj)
#pragma unroll
                    for (int n = 0; n < 2; ++n) {
                        const size_t off = (size_t)row * DM + col0 + bj * 128 + n * 16;
                        const f32x4 v = ldb(off) + acc[ai][bj][m][n] * scale;
                        if (OF) *(f32x4*)(out + off) = v; else *(u32x2*)(xb + off) = pack4(v);
                        ss += (v[0] * v[0] + v[1] * v[1]) + (v[2] * v[2] + v[3] * v[3]);
                    }
                if (!OF) { ss += __shfl_xor(ss, 16); ss += __shfl_xor(ss, 32); if (fq == 0) atomicAdd(ssq + (size_t)row * 4 + u.pn, ss); }
            }
    }
    __device__ __forceinline__ void fused(ACC_ARG, const pg8::Unit& u, int wr, int wc, int fr, int fq, LAS unsigned char* lds) const {
        if (skip) return;
        const int tid = opaque_tid(), lane = tid & 63, wave = __builtin_amdgcn_readfirstlane(tid >> 6);
        LAS float* tl = (LAS float*)lds;
#pragma unroll
        for (int ai = 0; ai < 2; ++ai)
#pragma unroll
            for (int wq = 0; wq < 2; ++wq) {
                if (wr == wq) {
#pragma unroll
                    for (int m = 0; m < 4; ++m)
#pragma unroll
                        for (int bj = 0; bj < 2; ++bj)
#pragma unroll
                            for (int n = 0; n < 2; ++n) *(LAS f32x4*)(tl + (16 * m + fr) * 260 + bj * 128 + wc * 32 + n * 16 + 4 * fq) = acc[ai][bj][m][n] * scale;
                }
                __syncthreads();
                const int rbase = u.pm * 256 + ai * 128 + wq * 64;
                f32x4 bv[8];
#pragma unroll
                for (int r = 0; r < 8; ++r) bv[r] = ldb((size_t)(rbase + wave * 8 + r) * DM + u.pn * 256 + lane * 4);
#pragma unroll
                for (int r = 0; r < 8; ++r) {
                    const int row = rbase + wave * 8 + r; const size_t off = (size_t)row * DM + u.pn * 256 + lane * 4;
                    const f32x4 v = bv[r] + *(const LAS f32x4*)(tl + (wave * 8 + r) * 260 + lane * 4);
                    if (OF) __builtin_nontemporal_store(v, (f32x4*)(out + off));
                    else {
                        *(u32x2*)(xb + off) = pack4(v);
                        const float ss = wave_sum((v[0] * v[0] + v[1] * v[1]) + (v[2] * v[2] + v[3] * v[3])); if (lane == 0) ssq[(size_t)row * 4 + u.pn] = ss;
                    }
                }
                __syncthreads();
            }
    }
};
struct EpiPlain {
    static constexpr bool AFTER_DRAIN = false;
    bf16_t* O; int ldo;
    __device__ __forceinline__ void operator()(ACC_ARG, const pg8::Unit& u, int wr, int wc, int fr, int fq) const {
        const int row0 = u.pm * 256 + wr * 64 + fr, col0 = u.pn * 256 + wc * 32 + 4 * fq;
#pragma unroll
        for (int ai = 0; ai < 2; ++ai)
#pragma unroll
            for (int m = 0; m < 4; ++m)
#pragma unroll
                for (int bj = 0; bj < 2; ++bj)
#pragma unroll
                    for (int n = 0; n < 2; ++n) *(u32x2*)(O + (size_t)(row0 + ai * 128 + m * 16) * ldo + col0 + bj * 128 + n * 16) = pack4(acc[ai][bj][m][n]);
    }
};
struct EpiMix {
    static constexpr bool AFTER_DRAIN = true;
    const LAS float* rtab; const float* rot;
    unsigned char* ws  ; bf16_t* mqb  ; const float *gdq, *gdk;
    static constexpr int TLD = 136;
    __device__ __forceinline__ void flushT(bf16_t* dst  , const LAS bf16_t* TS) const {
        const int tid = opaque_tid();
#pragma unroll
        for (int i = 0; i < 8; ++i) { const int p = tid + 512 * i, c = p >> 4, r8 = p & 15; *(u32x4*)(dst + (size_t)c * SEQ + r8 * 8) = *(const LAS u32x4*)(TS + c * TLD + r8 * 8); }
    }
    __device__ __forceinline__ void operator()(ACC_ARG, const pg8::Unit& u, int wr, int wc, int fr, int fq) const { body(acc, u, wr, wc, fr, fq, nullptr); }
    __device__ __forceinline__ void fused(ACC_ARG, const pg8::Unit& u, int wr, int wc, int fr, int fq, LAS unsigned char* lds) const {
        if (u.pn >= 4 && u.pn < 16) body(acc, u, wr, wc, fr, fq, (LAS bf16_t*)lds); else body(acc, u, wr, wc, fr, fq, nullptr);
    }
    __device__ __forceinline__ void body(ACC_ARG, const pg8::Unit& u, int wr, int wc, int fr, int fq, LAS bf16_t* TS) const {
        const int pn = u.pn, lr0 = wr * 64 + fr, lrow0 = u.pm * 256 + lr0;
        if (pn < 8) {
            const bool isk = pn >= 4; const int h = pn & 3; bf16_t* dst = (bf16_t*)(ws + (isk ? WS_K : WS_Q)); bf16_t* kts = (bf16_t*)(ws + WS_KTS);
            const float lg2 = log2f(1.0f - __builtin_amdgcn_exp2f(-5.0f - (float)h));
#pragma unroll
            for (int ai = 0; ai < 2; ++ai) {
                f32x4 cs0[4][2], cs1[4][2];
#pragma unroll
                for (int m = 0; m < 4; ++m)
#pragma unroll
                    for (int n = 0; n < 2; ++n) { const f32x4* cs = (const f32x4*)(rot + ((size_t)(lrow0 + ai * 128 + m * 16) * 128 + wc * 32 + 8 * fq + 4 * n) * 2); cs0[m][n] = cs[0]; cs1[m][n] = cs[1]; }
                EPI_FENCE();
#pragma unroll
                for (int m = 0; m < 4; ++m) {
                    int lrow = lrow0 + ai * 128 + m * 16; asm volatile("" : "+v"(lrow));
                    const float rs = rtab[u.ri * 256 + lr0 + ai * 128 + m * 16] * (isk ? 0.0625f : 1.0f);
                    const float dec = __builtin_amdgcn_exp2f(lg2 * (float)(127 - (lrow & 127)));
#pragma unroll
                    for (int n = 0; n < 2; ++n) {
                        const int i0 = wc * 32 + 8 * fq + 4 * n;
                        const f32x4 c01 = cs0[m][n], c23 = cs1[m][n];
                        const f32x4 cv = (f32x4){c01[0], c01[2], c23[0], c23[2]}, sv = (f32x4){c01[1], c01[3], c23[1], c23[3]};
                        const f32x4 x1 = acc[ai][0][m][n] * rs, x2 = acc[ai][1][m][n] * rs;
                        const f32x4 o1 = x1 * cv - x2 * sv, o2 = x1 * sv + x2 * cv;
                        *(u32x2*)(dst + (size_t)lrow * 1024 + h * 256 + i0) = pack4(o1);
                        *(u32x2*)(dst + (size_t)lrow * 1024 + h * 256 + 128 + i0) = pack4(o2);
                        if (isk) {
                            if (TS) {
                                const int rl = wr * 64 + m * 16 + fr;
#pragma unroll
                                for (int j = 0; j < 4; ++j) { TS[(i0 + j) * TLD + rl] = bf16_1(o1[j] * dec); TS[(128 + i0 + j) * TLD + rl] = bf16_1(o2[j] * dec); }
                            } else {
#pragma unroll
                                for (int j = 0; j < 4; ++j) {
                                    kts[(size_t)(h * 256 + i0 + j) * SEQ + lrow] = bf16_1(o1[j] * dec);
                                    kts[(size_t)(h * 256 + 128 + i0 + j) * SEQ + lrow] = bf16_1(o2[j] * dec);
                                }
                            }
                        }
                    }
                }
                EPI_FENCE();
                if (isk && TS) { __syncthreads(); flushT(kts + (size_t)(h * 256) * SEQ + u.pm * 256 + ai * 128, TS); __syncthreads(); }
            }
        } else if (pn < 16) {
            const int h = (pn - 8) >> 1, e0 = ((pn - 8) & 1) * 256; bf16_t* vt = (bf16_t*)(ws + WS_VT);
#pragma unroll
            for (int ai = 0; ai < 2; ++ai) {
#pragma unroll
                for (int m = 0; m < 4; ++m) {
                    int lrow = lrow0 + ai * 128 + m * 16; asm volatile("" : "+v"(lrow));
                    const float rs = rtab[u.ri * 256 + lr0 + ai * 128 + m * 16];
#pragma unroll
                    for (int bj = 0; bj < 2; ++bj)
#pragma unroll
                        for (int n = 0; n < 2; ++n) {
                            const int tc = bj * 128 + wc * 32 + 8 * fq + 4 * n, ec = e0 + tc; const f32x4 v = acc[ai][bj][m][n] * rs;
                            if (TS) {
                                const int rl = wr * 64 + m * 16 + fr;
#pragma unroll
                                for (int j = 0; j < 4; ++j) TS[(tc + j) * TLD + rl] = bf16_1(v[j]);
                            } else {
#pragma unroll
                                for (int j = 0; j < 4; ++j) vt[(size_t)(h * 512 + ec + j) * SEQ + lrow] = bf16_1(v[j]);
                            }
                        }
                    EPI_FENCE();
                }
                if (TS) { __syncthreads(); flushT(vt + (size_t)(h * 512 + e0) * SEQ + u.pm * 256 + ai * 128, TS); __syncthreads(); }
            }
        } else if (pn < 24) {
            const bool isk = pn >= 20; const int tile = (pn - 16) & 3; bf16_t* dst = (bf16_t*)(ws + (isk ? WS_DK : WS_DQ)); const float* gn = isk ? gdk : gdq; const float mul = isk ? 1.0f : C2Q;
            f32x4 gv[2][2];
#pragma unroll
            for (int bj = 0; bj < 2; ++bj)
#pragma unroll
                for (int n = 0; n < 2; ++n) gv[bj][n] = *(const f32x4*)(gn + 32 * bj + 8 * fq + 4 * n);
#pragma unroll
            for (int ai = 0; ai < 2; ++ai)
#pragma unroll
                for (int m = 0; m < 4; ++m) {
                    int lrow = lrow0 + ai * 128 + m * 16; asm volatile("" : "+v"(lrow));
                    const float rs = rtab[u.ri * 256 + lr0 + ai * 128 + m * 16];
                    f32x4 v[2][2]; float ss = 0.f;
#pragma unroll
                    for (int bj = 0; bj < 2; ++bj)
#pragma unroll
                        for (int n = 0; n < 2; ++n) { v[bj][n] = acc[ai][bj][m][n] * rs; const f32x4 t = v[bj][n]; ss += (t[0] * t[0] + t[1] * t[1]) + (t[2] * t[2] + t[3] * t[3]); }
                    ss += __shfl_xor(ss, 16); ss += __shfl_xor(ss, 32);
                    const float rn = __builtin_amdgcn_rsqf(ss * (1.0f / 64.0f) + EPS) * mul;
#pragma unroll
                    for (int bj = 0; bj < 2; ++bj) { const u32x2 p0 = pack4(v[bj][0] * rn * gv[bj][0]), p1 = pack4(v[bj][1] * rn * gv[bj][1]);
                        *(u32x4*)(dst + (size_t)lrow * 1024 + tile * 256 + 64 * wc + 32 * bj + 8 * fq) = (u32x4){p0.x, p0.y, p1.x, p1.y}; }
                    EPI_FENCE();
                }
        } else {
            bf16_t* dst = pn < 28 ? (bf16_t*)(ws + WS_DV) : mqb; const int tile = (pn - 24) & 3;
#pragma unroll
            for (int ai = 0; ai < 2; ++ai)
#pragma unroll
                for (int m = 0; m < 4; ++m) {
                    int lrow = lrow0 + ai * 128 + m * 16; asm volatile("" : "+v"(lrow));
                    const float rs = rtab[u.ri * 256 + lr0 + ai * 128 + m * 16];
#pragma unroll
                    for (int bj = 0; bj < 2; ++bj) { const u32x2 p0 = pack4(acc[ai][bj][m][0] * rs), p1 = pack4(acc[ai][bj][m][1] * rs);
                        *(u32x4*)(dst + (size_t)lrow * 1024 + tile * 256 + bj * 128 + wc * 32 + 8 * fq) = (u32x4){p0.x, p0.y, p1.x, p1.y}; }
                    EPI_FENCE();
                }
        }
    }
};
struct EpiRgG {
    static constexpr bool AFTER_DRAIN = false;
    const LAS float* rtab; bf16_t* ret; const float* rssq; unsigned char* ws;
    __device__ __forceinline__ void operator()(ACC_ARG, const pg8::Unit& u, int wr, int wc, int fr, int fq) const {
        const int lr0 = wr * 64 + fr;
        if (u.pn < 8) {
            const int col0 = u.pn * 256 + wc * 32 + 8 * fq;
#pragma unroll
            for (int ai = 0; ai < 2; ++ai) {
                u32x4 rv[4][2]; f32x2 rq2[4];
#pragma unroll
                for (int m = 0; m < 4; ++m) { const int lr = lr0 + ai * 128 + m * 16;
                    rq2[m] = *(const f32x2*)(rssq + (size_t)(u.pm * 256 + lr) * 8 + 2 * (u.pn >> 1));
#pragma unroll
                    for (int bj = 0; bj < 2; ++bj) rv[m][bj] = *(const u32x4*)(ret + (size_t)(u.pm * 256 + lr) * 2048 + col0 + bj * 128); }
                EPI_FENCE();
#pragma unroll
                for (int m = 0; m < 4; ++m) {
                    const int lr = lr0 + ai * 128 + m * 16; const float rs = rtab[u.ri * 256 + lr];
                    const float rr = __builtin_amdgcn_rsqf((rq2[m][0] + rq2[m][1]) * (1.0f / 512.0f) + EPS);
#pragma unroll
                    for (int bj = 0; bj < 2; ++bj) {
                        u32x4 o;
#pragma unroll
                        for (int n = 0; n < 2; ++n) {
                            const unsigned w0 = n == 0 ? rv[m][bj].x : rv[m][bj].z, w1 = n == 0 ? rv[m][bj].y : rv[m][bj].w; const f32x4 a = acc[ai][bj][m][n] * rs; f32x4 v;
                            v[0] = __uint_as_float(w0 << 16) * siluf(a[0]); v[1] = __uint_as_float(w0 & 0xffff0000u) * siluf(a[1]);
                            v[2] = __uint_as_float(w1 << 16) * siluf(a[2]); v[3] = __uint_as_float(w1 & 0xffff0000u) * siluf(a[3]);
                            const u32x2 p = pack4(v * rr); if (n == 0) { o.x = p.x; o.y = p.y; } else { o.z = p.x; o.w = p.y; }
                        }
                        *(u32x4*)(ret + (size_t)(u.pm * 256 + lr) * 2048 + col0 + bj * 128) = o;
                    }
                }
                EPI_FENCE();
            }
        } else {
            const int br = (u.pn - 8) >> 2, col0 = ((u.pn - 8) & 3) * 256 + wc * 32 + 8 * fq;
            unsigned char* g8 = ws + (br == 0 ? WS_G8A : br == 1 ? WS_G8B : WS_G8C);
#pragma unroll
            for (int ai = 0; ai < 2; ++ai)
#pragma unroll
                for (int m = 0; m < 4; ++m) {
                    const int lr = lr0 + ai * 128 + m * 16; const float rs = rtab[u.ri * 256 + lr];
#pragma unroll
                    for (int bj = 0; bj < 2; ++bj) {
                        u32x2 w2;
#pragma unroll
                        for (int n = 0; n < 2; ++n) {
                            const f32x4 a = acc[ai][bj][m][n] * rs; unsigned w = 0u;
#pragma unroll
                            for (int j = 0; j < 4; ++j) w |= (unsigned)__builtin_rintf(255.0f * sigmf(a[j])) << (8 * j);
                            if (n == 0) w2.x = w; else w2.y = w;
                        }
                        *(u32x2*)(g8 + (size_t)(u.pm * 256 + lr) * DM + col0 + bj * 128) = w2;
                    }
                }
        }
    }
};
struct EpiTerm3 {
    static constexpr bool AFTER_DRAIN = false;
    unsigned char* ws; bf16_t* y;
    __device__ __forceinline__ void operator()(ACC_ARG, const pg8::Unit& u, int wr, int wc, int fr, int fq) const {
        const int lr0 = wr * 64 + fr, col0 = u.pn * 256 + wc * 32 + 8 * fq, first = (u.tag == 0);
        const unsigned char* g8 = ws + (u.tag == 0 ? WS_G8A : u.tag == 1 ? WS_G8B : WS_G8C);
#pragma unroll
        for (int ai = 0; ai < 2; ++ai) {
            u32x2 gv[4][2]; u32x4 yv[4][2];
#pragma unroll
            for (int m = 0; m < 4; ++m)
#pragma unroll
                for (int bj = 0; bj < 2; ++bj) { const size_t off = (size_t)(u.pm * 256 + lr0 + ai * 128 + m * 16) * DM + col0 + bj * 128;
                    gv[m][bj] = *(const u32x2*)(g8 + off); yv[m][bj] = first ? (u32x4){0u, 0u, 0u, 0u} : *(const u32x4*)(y + off); }
            EPI_FENCE();
#pragma unroll
            for (int m = 0; m < 4; ++m)
#pragma unroll
                for (int bj = 0; bj < 2; ++bj) {
                    const size_t off = (size_t)(u.pm * 256 + lr0 + ai * 128 + m * 16) * DM + col0 + bj * 128;
                    u32x4 o;
#pragma unroll
                    for (int n = 0; n < 2; ++n) {
                        const f32x4 a = acc[ai][bj][m][n]; const unsigned gw = n == 0 ? gv[m][bj].x : gv[m][bj].y; const unsigned w0 = n == 0 ? yv[m][bj].x : yv[m][bj].z, w1 = n == 0 ? yv[m][bj].y : yv[m][bj].w; f32x4 v;
                        v[0] = (float)(gw & 255u) * (1.0f / 255.0f) * a[0] + __uint_as_float(w0 << 16); v[1] = (float)((gw >> 8) & 255u) * (1.0f / 255.0f) * a[1] + __uint_as_float(w0 & 0xffff0000u);
                        v[2] = (float)((gw >> 16) & 255u) * (1.0f / 255.0f) * a[2] + __uint_as_float(w1 << 16); v[3] = (float)(gw >> 24) * (1.0f / 255.0f) * a[3] + __uint_as_float(w1 & 0xffff0000u);
                        const u32x2 p = pack4(v); if (n == 0) { o.x = p.x; o.y = p.y; } else { o.z = p.x; o.w = p.y; }
                    }
                    *(u32x4*)(y + off) = o;
                }
            EPI_FENCE();
        }
    }
};

#include <hip/hip_bf16.h>
namespace attn_body {
using bf16=__hip_bfloat16;
using bf16x8=__attribute__((ext_vector_type(8)))short;
using s16x4=__attribute__((ext_vector_type(4)))short;
using f32x16=__attribute__((ext_vector_type(16)))float;
using u32x4=__attribute__((ext_vector_type(4)))unsigned;
constexpr int D=64,DM=1024;
constexpr int NW=8,QBLK=32,QB=QBLK*NW,KVBLK=64;
__device__ __forceinline__ int crow(int r,int hi){return (r&3)+8*(r>>2)+4*hi;}
#define SBAR() __builtin_amdgcn_sched_barrier(0)
__device__ __forceinline__ void cmask(f32x16&p0,f32x16&p1,int jb,int qrel,int hi){
  const float NEG=-INFINITY; int kb=64*jb+4*hi;
  #pragma unroll
  for(int r=0;r<16;++r){int kv=kb+(r&3)+8*(r>>2); if(kv>qrel)p0[r]=NEG; if(kv+32>qrel)p1[r]=NEG;}
}
constexpr int NSLOT=3, SLOTB=8192;
constexpr int LDS_K=0, LDS_V=NSLOT*SLOTB, LDS_WS=LDS_V+2*NSLOT*SLOTB, LDS_OST=LDS_WS+NW*64*4, LDS_BYTES=LDS_OST+NW*4096;
__device__ __forceinline__ void glds16(const void*gsrc,unsigned lds_dst){unsigned keep;
  asm volatile("s_mov_b32 %0, m0\n\ts_mov_b32 m0, %2\n\ts_nop 0\n\tglobal_load_lds_dwordx4 %1, off\n\ts_mov_b32 m0, %0":"=&s"(keep):"v"(gsrc),"s"(lds_dst):"memory");}
__device__ __forceinline__ float max3f(float a,float b,float c){float r;asm("v_max3_f32 %0, %1, %2, %3":"=v"(r):"v"(a),"v"(b),"v"(c));return r;}
__device__ __forceinline__ float max2f(float a,float b){float r;asm("v_max_f32_e32 %0, %1, %2":"=v"(r):"v"(a),"v"(b));return r;}
__device__ __forceinline__ float fadd_s(float a,float b){float r;asm("v_add_f32_e32 %0, %1, %2":"=v"(r):"v"(a),"v"(b));return r;}
__device__ __forceinline__ float fsub_s(float a,float b){float r;asm("v_sub_f32_e32 %0, %1, %2":"=v"(r):"v"(a),"v"(b));return r;}
typedef float f32x2_t __attribute__((ext_vector_type(2))); typedef __bf16 bf16x2_t __attribute__((ext_vector_type(2)));
__device__ __forceinline__ unsigned cvtpk_s(float lo,float hi){f32x2_t v={lo,hi};bf16x2_t b=__builtin_convertvector(v,bf16x2_t);return __builtin_bit_cast(unsigned,b);}
#define WAIT_BAR(N) asm volatile("s_waitcnt vmcnt(" #N ") lgkmcnt(0)\n\ts_barrier":::"memory")
__device__ __forceinline__ void qkt(f32x16&p0,f32x16&p1,const char*Kslot,const bf16x8*qr,const f32x16&negm,int r32,int hi){
  const char*kb=Kslot+hi*1024+r32*16;
  #pragma unroll
  for(int d0=0;d0<4;++d0){
    const bf16x8 b0=*reinterpret_cast<const bf16x8*>(kb+d0*2048);
    const bf16x8 b1=*reinterpret_cast<const bf16x8*>(kb+d0*2048+512);
    if(d0==0){p0=__builtin_amdgcn_mfma_f32_32x32x16_bf16(b0,qr[0],negm,0,0,0);p1=__builtin_amdgcn_mfma_f32_32x32x16_bf16(b1,qr[0],negm,0,0,0);}
    else{p0=__builtin_amdgcn_mfma_f32_32x32x16_bf16(b0,qr[d0],p0,0,0,0);p1=__builtin_amdgcn_mfma_f32_32x32x16_bf16(b1,qr[d0],p1,0,0,0);}}
}
typedef __attribute__((address_space(3))) const char* lds_cptr;
typedef short v4i16_t __attribute__((ext_vector_type(4)));
__device__ __forceinline__ void kload8(bf16x8*kf,lds_cptr kp){
  kf[0]=*(const __attribute__((address_space(3))) bf16x8*)(kp);      kf[1]=*(const __attribute__((address_space(3))) bf16x8*)(kp+512);
  kf[2]=*(const __attribute__((address_space(3))) bf16x8*)(kp+2048); kf[3]=*(const __attribute__((address_space(3))) bf16x8*)(kp+2560);
  kf[4]=*(const __attribute__((address_space(3))) bf16x8*)(kp+4096); kf[5]=*(const __attribute__((address_space(3))) bf16x8*)(kp+4608);
  kf[6]=*(const __attribute__((address_space(3))) bf16x8*)(kp+6144); kf[7]=*(const __attribute__((address_space(3))) bf16x8*)(kp+6656);
}
__device__ __forceinline__ void kload2(bf16x8*kf,lds_cptr kp,int j){ kf[2*j]=*(const __attribute__((address_space(3))) bf16x8*)(kp+j*2048); kf[2*j+1]=*(const __attribute__((address_space(3))) bf16x8*)(kp+j*2048+512); }
__device__ __forceinline__ s16x4 vtr(lds_cptr p){ return __builtin_bit_cast(s16x4,__builtin_amdgcn_ds_read_tr16_b64_v4i16((__attribute__((address_space(3))) v4i16_t*)p)); }
__device__ __forceinline__ float rowmax(const f32x16&p0,const f32x16&p1){
  float a=max3f(p0[0],p0[1],p1[0]),b=max3f(p0[2],p0[3],p1[1]);a=max3f(a,p1[2],p1[3]);
  #pragma unroll
  for(int r=4;r<16;r+=4){a=max3f(a,p0[r],p0[r+1]);b=max3f(b,p0[r+2],p0[r+3]);a=max3f(a,p1[r],p1[r+1]);b=max3f(b,p1[r+2],p1[r+3]);}
  const float m=max2f(a,b);
  auto rr=__builtin_amdgcn_permlane32_swap(__float_as_uint(m),__float_as_uint(m),false,false);
  return max2f(__uint_as_float(rr[0]),__uint_as_float(rr[1]));
}
__device__ __forceinline__ void pv(f32x16*o,int vb,bf16x8 pa0,bf16x8 pa1,bf16x8 pa2,bf16x8 pa3){
  #pragma unroll
  for(int d0=0;d0<4;++d0){s16x4 lo[4],hi[4];
    #pragma unroll
    for(int ks=0;ks<4;++ks){
      asm volatile("ds_read_b64_tr_b16 %0,%1 offset:%c2":"=&v"(lo[ks]):"v"(vb),"i"(d0*4096+ks*1024):"memory");
      asm volatile("ds_read_b64_tr_b16 %0,%1 offset:%c2":"=&v"(hi[ks]):"v"(vb),"i"(d0*4096+ks*1024+512):"memory");}
    asm volatile("s_waitcnt lgkmcnt(0)":::"memory");SBAR();
    #define PK(k) (bf16x8){lo[k][0],lo[k][1],lo[k][2],lo[k][3],hi[k][0],hi[k][1],hi[k][2],hi[k][3]}
    o[d0]=__builtin_amdgcn_mfma_f32_32x32x16_bf16(pa0,PK(0),o[d0],0,0,0);
    o[d0]=__builtin_amdgcn_mfma_f32_32x32x16_bf16(pa1,PK(1),o[d0],0,0,0);
    o[d0]=__builtin_amdgcn_mfma_f32_32x32x16_bf16(pa2,PK(2),o[d0],0,0,0);
    o[d0]=__builtin_amdgcn_mfma_f32_32x32x16_bf16(pa3,PK(3),o[d0],0,0,0);
    #undef PK
  }
}
#define ATTN_STORE16(p,v) (*(u32x4*)(p)=(v))
template<int THRL> __device__ __forceinline__ void attn_unit(int hq,int hv,int qb,const bf16*Q,const bf16*__restrict__ K,const bf16*__restrict__ V,bf16*O,char*shm){
  const int tid=opaque_tid(),lane=tid&63,r32=lane&31,hi=lane>>5; const int wid=__builtin_amdgcn_readfirstlane(tid>>6);
  const int q0=qb*QB;
  const bf16*Qw=Q+(long)(q0+wid*QBLK)*DM+hq*D;
  const bf16*Kh=K+hq*D,*Vh=V+hv*128;
  const unsigned lds0=(unsigned)(uintptr_t)shm;
  float*wsf=(float*)(shm+LDS_WS)+wid*64;
  const bf16*ksrc=Kh+(long)lane*DM+wid*8;
  const bf16*vsrc=Vh+(long)(16*(wid&3)+(lane>>2))*DM+(wid>>2)*32+(lane&3)*8;
  const unsigned kdst=lds0+LDS_K+wid*1024, vdst=lds0+LDS_V+wid*1024;
  #define DMA_K(t,slot) glds16(ksrc+(long)(t)*KVBLK*DM,(unsigned)__builtin_amdgcn_readfirstlane(kdst+(slot)))
  #define DMA_V(t,slot) do{ glds16(vsrc+(long)(t)*KVBLK*DM,(unsigned)__builtin_amdgcn_readfirstlane(vdst+2*(slot))); glds16(vsrc+(long)(t)*KVBLK*DM+64,(unsigned)__builtin_amdgcn_readfirstlane(vdst+2*(slot)+8192)); }while(0)
  const int vb0=(int)(lds0+LDS_V)+((lane>>4)&1)*32+(lane&3)*8+(4*hi+((lane&15)>>2))*64;
  const char*Kbase=shm+LDS_K; bf16x8 kf[8];
  const lds_cptr shm3=(lds_cptr)shm; const lds_cptr kp0=shm3+LDS_K+hi*1024+r32*16; const lds_cptr vp0=shm3+LDS_V+((lane>>4)&1)*32+(lane&3)*8+(4*hi+((lane&15)>>2))*64;
  const int NT=(q0+QB)/KVBLK;
  DMA_K(0,0);DMA_V(0,0);DMA_K(1,SLOTB);
  bf16x8 qr[4];
  #pragma unroll
  for(int d0=0;d0<4;++d0)qr[d0]=*reinterpret_cast<const bf16x8*>(&Qw[(long)r32*DM+d0*16+hi*8]);
  float mhat=0.f,l_reg=0.f;f32x16 o[4];o[0]=f32x16{};o[1]=f32x16{};o[2]=f32x16{};o[3]=f32x16{};asm volatile("":"+v"(o[0]),"+v"(o[1]),"+v"(o[2]),"+v"(o[3]));f32x16 negm=f32x16{};asm volatile("":"+v"(negm));
  const int qrel=wid*QBLK+r32;
  #define CMASK(P0,P1,t) do{int jb_=(t)-(NT-4); if(jb_>=0)cmask(P0,P1,jb_,qrel,hi);}while(0)
  bool resc=false;
  #define START(P0,P1) do{ const float rm=rowmax(P0,P1); resc=false; \
    { const float dl=rm; mhat=fadd_s(mhat,dl); \
      _Pragma("unroll") for(int r=0;r<16;++r){P0[r]=fsub_s(P0[r],dl);P1[r]=fsub_s(P1[r],dl);} \
      _Pragma("unroll") for(int r=0;r<16;++r)negm[r]=-mhat; asm volatile("":"+v"(negm)); } \
    _Pragma("unroll") for(int r=0;r<16;++r)P0[r]=__builtin_amdgcn_exp2f(P0[r]); }while(0)
  #define RESC() do{ if(resc){ asm volatile("s_waitcnt lgkmcnt(0)":::"memory"); \
      _Pragma("unroll") for(int d_=0;d_<4;++d_) _Pragma("unroll") for(int r=0;r<16;++r)o[d_][r]*=wsf[crow(r,hi)]; } }while(0)
  f32x16 pA0,pA1,pB0,pB1;
  int sl_prev=0,sl_cur=0,sl_next=SLOTB;
  #define ROT() do{sl_prev=sl_cur;sl_cur=sl_next;sl_next=(sl_next==(NSLOT-1)*SLOTB)?0:sl_next+SLOTB;}while(0)
  DMA_K(2,2*SLOTB);
  WAIT_BAR(3);
  qkt(pA0,pA1,Kbase,qr,negm,r32,hi);asm volatile("s_nop 15\n\ts_nop 7":"+v"(pA0),"+v"(pA1));CMASK(pA0,pA1,0);
  START(pA0,pA1);
  _Pragma("unroll") for(int r=0;r<16;++r)pA1[r]=__builtin_amdgcn_exp2f(pA1[r]);
  WAIT_BAR(0);
  DMA_K(3,0);DMA_V(1,SLOTB);
  ROT();
  kload8(kf,kp0+sl_cur);
  WAIT_BAR(3);
  s16x4 vlo[16],vhi[16]; u32x4 pw0,pw1,pw2,pw3;
  #define PKW(P,B) cvtpk_s(P[B],P[B+1])
  #define PAF(k) __builtin_bit_cast(bf16x8,pw##k)
  #define VFR(i) (bf16x8){vlo[i][0],vlo[i][1],vlo[i][2],vlo[i][3],vhi[i][0],vhi[i][1],vhi[i][2],vhi[i][3]}
  #define PIN(x) asm volatile("":"+v"(x))
  #define MX3(a,b,c) __builtin_fmaxf(__builtin_fmaxf((a),(b)),(c))
  #define GAPA(MF,A0,A1,A2,A3,W0,W1,PW) do{ MF; sacc+=A0; sacc+=A1; sacc+=A2; sacc+=A3; PIN(sacc); W0; W1; PIN(PW); SBAR(); }while(0)
  #define EX(v) __builtin_amdgcn_exp2f(v)
  #define GAPB(MF,X,B) do{ MF; X[B]=EX(X[B]); X[B+1]=EX(X[B+1]); PIN(X); SBAR(); }while(0)
  #define VRD(i) do{ vlo[i]=vtr(vp_+(((i)>>2)*4096+((i)&3)*1024)); vhi[i]=vtr(vp_+(((i)>>2)*4096+((i)&3)*1024+512)); }while(0)
  #define KRD(G,j) do{ if(G){ kload2(kf,kp0+sl_next,j); SBAR(); } }while(0)
  #define STEP(C0,C1,P0,P1,t,GK,GV,GL) do{ SBAR(); \
    const lds_cptr vp_=vp0+2*sl_prev; \
    float sacc=(P0[0]+P0[1]); \
    GAPA(C0=__builtin_amdgcn_mfma_f32_32x32x16_bf16(kf[0],qr[0],negm,0,0,0), P0[2],P0[3],P0[4],P0[5],     pw0[0]=PKW(P0,0), pw0[1]=PKW(P0,2), pw0); \
    GAPA(C1=__builtin_amdgcn_mfma_f32_32x32x16_bf16(kf[1],qr[0],negm,0,0,0), P0[6],P0[7],P0[8],P0[9],     pw0[2]=PKW(P0,4), pw0[3]=PKW(P0,6), pw0); \
    GAPA(C0=__builtin_amdgcn_mfma_f32_32x32x16_bf16(kf[2],qr[1],C0,0,0,0),   P0[10],P0[11],P0[12],P0[13], pw1[0]=PKW(P0,8), pw1[1]=PKW(P0,10), pw1); \
    GAPA(C1=__builtin_amdgcn_mfma_f32_32x32x16_bf16(kf[3],qr[1],C1,0,0,0),   P0[14],P0[15],P1[0],P1[1],   pw1[2]=PKW(P0,12),pw1[3]=PKW(P0,14), pw1); \
    GAPA(C0=__builtin_amdgcn_mfma_f32_32x32x16_bf16(kf[4],qr[2],C0,0,0,0),   P1[2],P1[3],P1[4],P1[5],     pw2[0]=PKW(P1,0), pw2[1]=PKW(P1,2), pw2); \
    GAPA(C1=__builtin_amdgcn_mfma_f32_32x32x16_bf16(kf[5],qr[2],C1,0,0,0),   P1[6],P1[7],P1[8],P1[9],     pw2[2]=PKW(P1,4), pw2[3]=PKW(P1,6), pw2); \
    GAPA(C0=__builtin_amdgcn_mfma_f32_32x32x16_bf16(kf[6],qr[3],C0,0,0,0),   P1[10],P1[11],P1[12],P1[13], pw3[0]=PKW(P1,8), pw3[1]=PKW(P1,10), pw3); \
    GAPA(C1=__builtin_amdgcn_mfma_f32_32x32x16_bf16(kf[7],qr[3],C1,0,0,0),   P1[14],P1[15],0.f,0.f,       pw3[2]=PKW(P1,12),pw3[3]=PKW(P1,14), pw3); \
    VRD(0); VRD(4); VRD(8); VRD(12); VRD(1); VRD(5); VRD(9); VRD(13); SBAR(); \
    l_reg+=sacc; \
    if(GK){DMA_K((t)+3,sl_cur);} if(GV){DMA_V((t)+1,sl_next);} \
    CMASK(C0,C1,t); \
    { float a=MX3(C0[0],C0[1],C1[0]),b=MX3(C0[2],C0[3],C1[1]); a=MX3(a,C1[2],C1[3]); \
      _Pragma("unroll") for(int r=4;r<16;r+=4){a=MX3(a,C0[r],C0[r+1]);b=MX3(b,C0[r+2],C0[r+3]);a=MX3(a,C1[r],C1[r+1]);b=MX3(b,C1[r+2],C1[r+3]);} \
      float rm=__builtin_fmaxf(a,b); { auto rr=__builtin_amdgcn_permlane32_swap(__float_as_uint(rm),__float_as_uint(rm),false,false); rm=__builtin_fmaxf(__uint_as_float(rr[0]),__uint_as_float(rr[1])); } \
      resc=false; \
      if(__builtin_expect(__any(rm>(float)THRL),0)){ const float dl=__builtin_fmaxf(rm,0.f); mhat+=dl; \
        _Pragma("unroll") for(int r=0;r<16;++r){C0[r]-=dl;C1[r]-=dl;} \
        _Pragma("unroll") for(int r=0;r<16;++r)negm[r]=-mhat; asm volatile("":"+v"(negm)); \
        const float f=__builtin_amdgcn_exp2f(-dl); l_reg*=f; if(hi==0)wsf[r32]=f; resc=true; } } \
    SBAR(); \
    GAPB(o[0]=__builtin_amdgcn_mfma_f32_32x32x16_bf16(PAF(0),VFR(0),o[0],0,0,0),  C0,0);  VRD(2);  SBAR(); \
    GAPB(o[1]=__builtin_amdgcn_mfma_f32_32x32x16_bf16(PAF(0),VFR(4),o[1],0,0,0),  C0,2);  VRD(6);  SBAR(); \
    GAPB(o[2]=__builtin_amdgcn_mfma_f32_32x32x16_bf16(PAF(0),VFR(8),o[2],0,0,0),  C0,4);  VRD(10); SBAR(); \
    GAPB(o[3]=__builtin_amdgcn_mfma_f32_32x32x16_bf16(PAF(0),VFR(12),o[3],0,0,0), C0,6);  VRD(14); SBAR(); \
    GAPB(o[0]=__builtin_amdgcn_mfma_f32_32x32x16_bf16(PAF(1),VFR(1),o[0],0,0,0),  C0,8);  VRD(3);  SBAR(); \
    GAPB(o[1]=__builtin_amdgcn_mfma_f32_32x32x16_bf16(PAF(1),VFR(5),o[1],0,0,0),  C0,10); VRD(7);  SBAR(); \
    GAPB(o[2]=__builtin_amdgcn_mfma_f32_32x32x16_bf16(PAF(1),VFR(9),o[2],0,0,0),  C0,12); VRD(11); SBAR(); \
    GAPB(o[3]=__builtin_amdgcn_mfma_f32_32x32x16_bf16(PAF(1),VFR(13),o[3],0,0,0), C0,14); VRD(15); SBAR(); \
    KRD(GL,0); GAPB(o[0]=__builtin_amdgcn_mfma_f32_32x32x16_bf16(PAF(2),VFR(2),o[0],0,0,0),  C1,0); \
    KRD(GL,1); GAPB(o[1]=__builtin_amdgcn_mfma_f32_32x32x16_bf16(PAF(2),VFR(6),o[1],0,0,0),  C1,2); \
    KRD(GL,2); GAPB(o[2]=__builtin_amdgcn_mfma_f32_32x32x16_bf16(PAF(2),VFR(10),o[2],0,0,0), C1,4); \
    KRD(GL,3); GAPB(o[3]=__builtin_amdgcn_mfma_f32_32x32x16_bf16(PAF(2),VFR(14),o[3],0,0,0), C1,6); \
    GAPB(o[0]=__builtin_amdgcn_mfma_f32_32x32x16_bf16(PAF(3),VFR(3),o[0],0,0,0),  C1,8); \
    GAPB(o[1]=__builtin_amdgcn_mfma_f32_32x32x16_bf16(PAF(3),VFR(7),o[1],0,0,0),  C1,10); \
    GAPB(o[2]=__builtin_amdgcn_mfma_f32_32x32x16_bf16(PAF(3),VFR(11),o[2],0,0,0), C1,12); \
    GAPB(o[3]=__builtin_amdgcn_mfma_f32_32x32x16_bf16(PAF(3),VFR(15),o[3],0,0,0), C1,14); \
    }while(0)
  int t=1;
  #undef CMASK
  #define CMASK(P0,P1,t) do{}while(0)
  for(;t+5<NT;t+=2){
    STEP(pB0,pB1,pA0,pA1,t,true,true,true);     WAIT_BAR(3); RESC(); ROT();
    STEP(pA0,pA1,pB0,pB1,t+1,true,true,true);   WAIT_BAR(3); RESC(); ROT();
  }
  #undef CMASK
  #define CMASK(P0,P1,t) do{int jb_=(t)-(NT-4); if(jb_>=0)cmask(P0,P1,jb_,qrel,hi);}while(0)
  #define ENDW(tt) do{ if((tt)+3<NT){WAIT_BAR(3);} else if((tt)+2<NT){WAIT_BAR(2);} else {WAIT_BAR(0);} }while(0)
  for(;t+1<NT;t+=2){
    STEP(pB0,pB1,pA0,pA1,t,(t+3<NT),(t+1<NT),(t+1<NT));       ENDW(t);   RESC(); ROT();
    STEP(pA0,pA1,pB0,pB1,t+1,(t+4<NT),(t+2<NT),(t+2<NT));     ENDW(t+1); RESC(); ROT();
  }
  STEP(pB0,pB1,pA0,pA1,NT-1,false,false,false); RESC();
  { float sacc=pB0[0]+pB0[1]; _Pragma("unroll") for(int r=2;r<16;++r)sacc+=pB0[r]; _Pragma("unroll") for(int r=0;r<16;++r)sacc+=pB1[r]; l_reg+=sacc;
    pw0=(u32x4){PKW(pB0,0),PKW(pB0,2),PKW(pB0,4),PKW(pB0,6)};pw1=(u32x4){PKW(pB0,8),PKW(pB0,10),PKW(pB0,12),PKW(pB0,14)};pw2=(u32x4){PKW(pB1,0),PKW(pB1,2),PKW(pB1,4),PKW(pB1,6)};pw3=(u32x4){PKW(pB1,8),PKW(pB1,10),PKW(pB1,12),PKW(pB1,14)};
    SBAR(); pv(o,vb0+2*sl_cur,PAF(0),PAF(1),PAF(2),PAF(3)); }
  #undef PKW
  #undef PAF
  #undef VFR
  #undef PIN
  #undef MX3
  #undef GAPA
  #undef GAPB
  #undef EX
  #undef VRD
  #undef KRD
  #undef STEP
  #undef ENDW
  {auto rr=__builtin_amdgcn_permlane32_swap(__float_as_uint(l_reg),__float_as_uint(l_reg),false,false);l_reg=__uint_as_float(rr[0])+__uint_as_float(rr[1]);}
  if(hi==0)wsf[32+r32]=l_reg;asm volatile("s_waitcnt lgkmcnt(0)":::"memory");
  float rli[16];
  #pragma unroll
  for(int r=0;r<16;++r)rli[r]=__builtin_amdgcn_rcpf(wsf[32+crow(r,hi)]);
  bf16*Ow=O+(long)(q0+wid*QBLK)*DM+hv*128;
  { bf16*stg=(bf16*)(shm+LDS_OST)+wid*2048;
    #pragma unroll
    for(int hf=0;hf<2;++hf){
      #pragma unroll
      for(int r=0;r<16;++r){const int orow=crow(r,hi);
        #pragma unroll
        for(int d0=0;d0<2;++d0)stg[orow*64+d0*32+r32]=__float2bfloat16(o[2*hf+d0][r]*rli[r]);}
      asm volatile("s_waitcnt lgkmcnt(0)":::"memory");
      u32x4 v4[4];
      #pragma unroll
      for(int i=0;i<4;++i){const int row=i*8+(lane>>3),ch=lane&7; v4[i]=*(const u32x4*)(stg+row*64+ch*8);}
      asm volatile("s_waitcnt lgkmcnt(0)":::"memory");
      #pragma unroll
      for(int i=0;i<4;++i){const int row=i*8+(lane>>3),ch=lane&7; ATTN_STORE16(Ow+(long)row*DM+hf*64+ch*8,v4[i]);} } }
  asm volatile("s_waitcnt lgkmcnt(0)\n\ts_barrier":::"memory");
  #undef DMA_K
  #undef DMA_V
  #undef CMASK
  #undef START
  #undef RESC
  #undef ROT
}
constexpr int ATTN_LDS_BYTES=LDS_BYTES;
#undef SBAR
#undef WAIT_BAR
}

typedef GAS unsigned gu32;
#define RLX_AGENT __ATOMIC_RELAXED, __HIP_MEMORY_SCOPE_AGENT
#define LDS_WAIT() asm volatile("s_waitcnt lgkmcnt(0)" ::: "memory")
#define XB_TMO      128
#define XB_XCNT(j)  (256  + 64 * (j))
#define XB_XSUB(j)  (1280 + 64 * (j))
#define XB_XGEN(j)  (2304 + 64 * (j))
#define XB_TOP      3328
#define XB_TOPGEN   3392
#define XCD_BAR_WORDS 3456
#define XB_SPIN_CAP (1u << 18)
__device__ __forceinline__ unsigned xb_ld(unsigned* p)              { return __hip_atomic_load(p, __ATOMIC_RELAXED, __HIP_MEMORY_SCOPE_AGENT); }
__device__ __forceinline__ unsigned xb_add(unsigned* p, unsigned v) { return __hip_atomic_fetch_add(p, v, __ATOMIC_RELAXED, __HIP_MEMORY_SCOPE_AGENT); }
__device__ __forceinline__ unsigned xb_xcc_id() { return (unsigned)__builtin_amdgcn_s_getreg((3 << 11) | 20) & 0xFu; }
#define XB_SPIN(cond, bar) do { unsigned _sp = 0; while (cond) { __builtin_amdgcn_s_sleep(1); \
    if ((++_sp & 255u) == 0u) { if (xb_ld(&(bar)[XB_TMO])) break; if (_sp > XB_SPIN_CAP) { atomicAdd(&(bar)[XB_TMO], 1u); break; } } } } while (0)
struct XcdBarrier { unsigned* bar; unsigned x; volatile LAS unsigned* st; };
__device__ __forceinline__ XcdBarrier xcd_barrier_post(unsigned* bar, volatile LAS unsigned* st) {
    XcdBarrier b; b.bar = bar; b.x = xb_xcc_id(); b.st = st;
    if (threadIdx.x == 0) (void)xb_add(&bar[XB_XCNT(b.x)], 1u);
    return b;
}
__device__ __forceinline__ void xcd_barrier_complete(unsigned* bar, unsigned x, unsigned& nloc, unsigned& nx) {
    const unsigned G = gridDim.x * gridDim.y * gridDim.z;
    unsigned sum, cnt, mine, sp = 0u;
    for (;;) {
        sum = 0u; cnt = 0u; mine = 0u;
#pragma unroll
        for (unsigned j = 0; j < 16; ++j) { const unsigned c = xb_ld(&bar[XB_XCNT(j)]); sum += c; cnt += (c > 0u) ? 1u : 0u; mine = (j == x) ? c : mine; }
        if (sum == G) break;
        __builtin_amdgcn_s_sleep(1);
        if ((++sp & 255u) == 0u) { if (xb_ld(&bar[XB_TMO])) break; if (sp > XB_SPIN_CAP) { atomicAdd(&bar[XB_TMO], 1u); break; } }
    }
    nloc = mine > 0u ? mine : 1u; nx = cnt > 0u ? cnt : 1u;
}
__device__ __forceinline__ void xcd_barrier(const XcdBarrier& b) {
    asm volatile("s_waitcnt vmcnt(0)" ::: "memory");
    __syncthreads();
    if (threadIdx.x == 0) {
        unsigned* bar = b.bar; asm volatile("" : "+v"(bar));
        __builtin_amdgcn_s_waitcnt(0);
        unsigned nloc = b.st[0], nx = b.st[1];
        if (nloc == 0u) { xcd_barrier_complete(bar, b.x, nloc, nx); b.st[0] = nloc; b.st[1] = nx; }
        const unsigned old = xb_add(&bar[XB_XSUB(b.x)], 1u);
        const unsigned gen = old / nloc;
        if (old + 1u == (gen + 1u) * nloc) {
            __builtin_amdgcn_fence(__ATOMIC_RELEASE, "agent");
            asm volatile("s_waitcnt vmcnt(0)" ::: "memory");
            const unsigned og = xb_add(&bar[XB_TOP], 1u);
            const unsigned tg = og / nx;
            if (og + 1u == (tg + 1u) * nx) xb_add(&bar[XB_TOPGEN], 1u);
            else XB_SPIN(xb_ld(&bar[XB_TOPGEN]) == tg, bar);
            __builtin_amdgcn_fence(__ATOMIC_ACQUIRE, "agent");
            xb_add(&bar[XB_XGEN(b.x)], 1u);
            asm volatile("s_waitcnt vmcnt(0)" ::: "memory");
        } else {
            XB_SPIN(xb_ld(&bar[XB_XGEN(b.x)]) == gen, bar);
            __builtin_amdgcn_fence(__ATOMIC_ACQUIRE, "agent");
            asm volatile("s_waitcnt vmcnt(0)" ::: "memory");
        }
    }
    __syncthreads();
}

#define XB2_XSUB(j) (64 * (j))
#define XB2_TOP     1024
#define XB2_TOPGEN  1088
__device__ __forceinline__ void xcd_split_arrive(unsigned* bar2, unsigned* bar, volatile LAS unsigned* st) {
    asm volatile("s_waitcnt vmcnt(0)" ::: "memory");
    __syncthreads();
    if (threadIdx.x == 0) {
        asm volatile("" : "+v"(bar2));
        __builtin_amdgcn_s_waitcnt(0);
        unsigned nloc = st[0], nx = st[1]; const unsigned x = xb_xcc_id();
        if (nloc == 0u) { xcd_barrier_complete(bar, x, nloc, nx); st[0] = nloc; st[1] = nx; }
        const unsigned old = xb_add(&bar2[XB2_XSUB(x)], 1u);
        if ((old + 1u) % nloc == 0u) {
            __builtin_amdgcn_fence(__ATOMIC_RELEASE, "agent");
            asm volatile("s_waitcnt vmcnt(0)" ::: "memory");
            const unsigned og = xb_add(&bar2[XB2_TOP], 1u);
            if ((og + 1u) % nx == 0u) xb_add(&bar2[XB2_TOPGEN], 1u);
            asm volatile("s_waitcnt vmcnt(0)" ::: "memory");
        }
    }
}
__device__ __forceinline__ void xcd_split_wait(unsigned* bar2, unsigned* bar, unsigned target) {
    if (threadIdx.x == 0) {
        asm volatile("" : "+v"(bar2));
        XB_SPIN(xb_ld(&bar2[XB2_TOPGEN]) < target, bar);
        __builtin_amdgcn_fence(__ATOMIC_ACQUIRE, "agent");
        asm volatile("s_waitcnt vmcnt(0)" ::: "memory");
    }
    __syncthreads();
}

__device__ __forceinline__ float wave_sum(float v) {
#pragma unroll
    for (int o = 1; o < 64; o <<= 1) v += __shfl_xor(v, o);
    return v;
}
template <class F>
__device__ __forceinline__ void transpose_load(const float* W, int ld, int nrows, F srccol, int item, int lane, f32x4 (&v)[8]) {
    const int nblk = nrows / 32, kb = item / nblk, nb = item % nblk, k0 = 64 * kb, s0 = srccol(32 * nb);
#pragma unroll
    for (int i = 0; i < 8; ++i) v[i] = __builtin_nontemporal_load((const f32x4*)(W + (size_t)(k0 + 8 * i + (lane >> 3)) * ld + s0 + 4 * (lane & 7)));
}
__host__ __device__ __forceinline__ int perm32(int rho) { const int n = rho >> 4, i = rho & 15; return 8 * (i >> 2) + 4 * n + (i & 3); }
template <bool PERM>
__device__ __forceinline__ void transpose_store(int K, bf16_t* WT, int nrows, const float* gk, LAS float* scr, int item, int lane, const f32x4 (&v)[8]) {
    const int nblk = nrows / 32, kb = item / nblk, nb = item % nblk, k0 = 64 * kb, n0 = 32 * nb;
#pragma unroll
    for (int i = 0; i < 8; ++i) { const int kk = 8 * i + (lane >> 3); const float g = gk ? gk[k0 + kk] : 1.0f;
#pragma unroll
        for (int e = 0; e < 4; ++e) scr[kk * 33 + 4 * (lane & 7) + e] = v[i][e] * g; }
    LDS_WAIT(); asm volatile("" ::: "memory");
    const int c = lane & 7;
#pragma unroll
    for (int j = 0; j < 4; ++j) { const int n = (lane >> 3) + 8 * j; const LAS float* s = scr + (8 * c) * 33 + (PERM ? perm32(n) : n);
        u32x4 o; o.x = cvt_pk_bf16(s[0 * 33], s[1 * 33]); o.y = cvt_pk_bf16(s[2 * 33], s[3 * 33]); o.z = cvt_pk_bf16(s[4 * 33], s[5 * 33]); o.w = cvt_pk_bf16(s[6 * 33], s[7 * 33]);
        *(u32x4*)(WT + (size_t)(n0 + n) * K + k0 + 8 * c) = o; }
    LDS_WAIT(); asm volatile("" ::: "memory");
}
struct ColIdent { int off; __device__ __forceinline__ int operator()(int r) const { return off + r; } };
struct ColSwiglu { __device__ __forceinline__ int operator()(int r) const { return ((r >> 7) & 1) * DFF + (r >> 8) * 128 + (r & 127); } };
struct ColSwigluOff { int r0; __device__ __forceinline__ int operator()(int r) const { return ColSwiglu{}(r + r0); } };
struct ColMix { __device__ __forceinline__ int operator()(int r) const {
    const int tile = r >> 8, p = r & 255, o = 64 * ((p >> 5) & 3) + 32 * (p >> 7) + (p & 31);
    if (tile < 16) return r;
    if (tile < 20) return 6144 + (tile - 16) * 256 + o;
    if (tile < 24) return 7168 + (tile - 20) * 256 + o;
    if (tile < 28) return 8192 + (tile - 24) * 256 + p;
    return 9216 + (tile - 28) * 256 + p; } };
template <bool PERM = false, class F>
__device__ __forceinline__ void transpose_all(const float* W, int K, int ld, bf16_t* WT, int nrows, F srccol, const float* gk, LAS float* scr, int gw, int ngw, int lane) {
    const int nitems = (K / 64) * (nrows / 32);
    for (int it = gw; it < nitems; it += 2 * ngw) {
        f32x4 va[8], vb[8]; const int it2 = it + ngw;
        transpose_load(W, ld, nrows, srccol, it, lane, va);
        if (it2 < nitems) transpose_load(W, ld, nrows, srccol, it2, lane, vb);
        transpose_store<PERM>(K, WT, nrows, gk, scr, it, lane, va);
        if (it2 < nitems) transpose_store<PERM>(K, WT, nrows, gk, scr, it2, lane, vb);
    }
}
__device__ __forceinline__ void rms_rows_to_bf16(const float* x, const float* gain, bf16_t* o, int m0, int step, int nrows, int lane) {
    const f32x4* gr = (const f32x4*)gain + lane;
    for (int m = m0; m < nrows; m += 2 * step) {
        const int m2 = (m + step < nrows) ? m + step : m;
        const f32x4* xa = (const f32x4*)(x + (size_t)m * DM) + lane; const f32x4* xb2 = (const f32x4*)(x + (size_t)m2 * DM) + lane;
        f32x4 va[4], vb[4]; float sa = 0.f, sb = 0.f;
#pragma unroll
        for (int j = 0; j < 4; ++j) { va[j] = __builtin_nontemporal_load(xa + 64 * j); vb[j] = __builtin_nontemporal_load(xb2 + 64 * j); }
#pragma unroll
        for (int j = 0; j < 4; ++j) { sa += (va[j][0] * va[j][0] + va[j][1] * va[j][1]) + (va[j][2] * va[j][2] + va[j][3] * va[j][3]); sb += (vb[j][0] * vb[j][0] + vb[j][1] * vb[j][1]) + (vb[j][2] * vb[j][2] + vb[j][3] * vb[j][3]); }
        const float ra = __builtin_amdgcn_rsqf(wave_sum(sa) * (1.f / 1024.f) + EPS), rb = __builtin_amdgcn_rsqf(wave_sum(sb) * (1.f / 1024.f) + EPS);
        u32x2* oa = (u32x2*)(o + (size_t)m * DM) + lane; u32x2* ob = (u32x2*)(o + (size_t)m2 * DM) + lane;
#pragma unroll
        for (int j = 0; j < 4; ++j) { const f32x4 g = gr[64 * j]; oa[64 * j] = pack4(va[j] * ra * g); if (m2 != m) ob[64 * j] = pack4(vb[j] * rb * g); }
    }
}
__device__ __forceinline__ void rot_table(const int* pos, float* rot, int gt, int ngt, int idx0 = 0, int idx1 = SEQ * 128) {
    for (int idx = idx0 + gt; idx < idx1; idx += ngt) {
        const int s = idx >> 7, i = idx & 127;
        const float inv = exp2f(-(float)i * (13.287712379549449f / 128.0f));
        const float ang = (float)pos[s] * inv;
        const float kq = rintf(ang * 0.6366197723675814f);
        float r = fmaf(-kq, 1.5703125f, ang); r = fmaf(-kq, 4.837512969970703125e-4f, r); r = fmaf(-kq, 7.54978995489188216e-8f, r);
        const float r2 = r * r;
        const float sn = r + r * r2 * (-1.6666667e-1f + r2 * (8.3333333e-3f + r2 * (-1.9841270e-4f + r2 * 2.7557319e-6f)));
        const float cn = 1.0f + r2 * (-0.5f + r2 * (4.1666668e-2f + r2 * (-1.3888889e-3f + r2 * (2.4801587e-5f + r2 * -2.7557319e-7f))));
        const int qd = ((int)kq) & 3;
        const float c = (qd == 0) ? cn : (qd == 1) ? -sn : (qd == 2) ? -cn : sn;
        const float sv = (qd == 0) ? sn : (qd == 1) ? cn : (qd == 2) ? -sn : -cn;
        *(f32x2*)(rot + (size_t)idx * 2) = (f32x2){c, sv};
    }
}

constexpr int SCN_LD = 136, SCN_V_OFF = 64 * SCN_LD * 2, SCN_CH = 192 * SCN_LD * 2;
constexpr unsigned SCAN_UNITS_PER_FLAG = 8;
__device__ __forceinline__ void scan_unit(int u, const bf16_t* kts, const bf16_t* vt, bf16_t* S, LAS unsigned char* lds, unsigned* done  ) {
    const int tid = opaque_tid(), lane = tid & 63, wave = __builtin_amdgcn_readfirstlane(tid >> 6);
    const int fr = lane & 15, fq = lane >> 4, h = u >> 4, dg = (u >> 2) & 3, eg = u & 3, wd = wave & 1, we = wave >> 1;
    const float gC = __builtin_amdgcn_exp2f(128.0f * log2f(1.0f - __builtin_amdgcn_exp2f(-5.0f - (float)h)));
    f32x4 acc[2][2];
#pragma unroll
    for (int a = 0; a < 2; ++a)
#pragma unroll
        for (int b = 0; b < 2; ++b) acc[a][b] = (f32x4){0.f, 0.f, 0.f, 0.f};
    const bf16_t* ksrc = kts + (size_t)(h * 256 + 64 * dg + (tid >> 4)) * SEQ + (tid & 15) * 8;
    const bf16_t* vsrc = vt + (size_t)(h * 512 + 128 * eg + (tid >> 4)) * SEQ + (tid & 15) * 8;
    u32x4 pk[3][2][2], pv[3][2][4];
#pragma unroll
    for (int sb = 0; sb < 3; ++sb)
#pragma unroll
        for (int i = 0; i < 2; ++i) {
#pragma unroll
            for (int j = 0; j < 2; ++j) pk[sb][i][j] = *(const u32x4*)(ksrc + (size_t)(32 * j) * SEQ + (2 * sb + i) * 128);
#pragma unroll
            for (int j = 0; j < 4; ++j) pv[sb][i][j] = *(const u32x4*)(vsrc + (size_t)(32 * j) * SEQ + (2 * sb + i) * 128);
        }
    bf16_t* sdst = S + ((size_t)(h * 16) * 512 + 128 * eg + 32 * we + fr) * 256 + 64 * dg + 32 * wd + 4 * fq;
#pragma unroll
    for (int r = 0; r < 8; ++r) {
        __syncthreads();
#pragma unroll
        for (int i = 0; i < 2; ++i) {
            if (2 * r + i < 15) {
                LAS bf16_t* lk = (LAS bf16_t*)(lds + i * SCN_CH); LAS bf16_t* lv = (LAS bf16_t*)(lds + i * SCN_CH + SCN_V_OFF);
#pragma unroll
                for (int j = 0; j < 2; ++j) *(LAS u32x4*)(lk + (32 * j + (tid >> 4)) * SCN_LD + (tid & 15) * 8) = pk[r % 3][i][j];
#pragma unroll
                for (int j = 0; j < 4; ++j) *(LAS u32x4*)(lv + (32 * j + (tid >> 4)) * SCN_LD + (tid & 15) * 8) = pv[r % 3][i][j];
            }
        }
        __syncthreads();
        if (r < 5) {
#pragma unroll
            for (int i = 0; i < 2; ++i) { const int c = 2 * (r + 3) + i;
                if (c < 15) {
#pragma unroll
                    for (int j = 0; j < 2; ++j) pk[r % 3][i][j] = *(const u32x4*)(ksrc + (size_t)(32 * j) * SEQ + c * 128);
#pragma unroll
                    for (int j = 0; j < 4; ++j) pv[r % 3][i][j] = *(const u32x4*)(vsrc + (size_t)(32 * j) * SEQ + c * 128);
                } }
        }
#pragma unroll
        for (int i = 0; i < 2; ++i) {
            const int c = 2 * r + i;
#pragma unroll
            for (int td = 0; td < 2; ++td)
#pragma unroll
                for (int te = 0; te < 2; ++te) { const u32x2 w = pack4(acc[td][te]);
                    __hip_atomic_store((unsigned long long*)(sdst + (size_t)c * 512 * 256 + (size_t)(16 * te) * 256 + 16 * td), ((unsigned long long)w.y << 32) | w.x, __ATOMIC_RELAXED, __HIP_MEMORY_SCOPE_AGENT); }
            if (c < 15) {
                const LAS bf16_t* lk = (const LAS bf16_t*)(lds + i * SCN_CH); const LAS bf16_t* lv = (const LAS bf16_t*)(lds + i * SCN_CH + SCN_V_OFF);
                f32x4 tm[2][2];
#pragma unroll
                for (int td = 0; td < 2; ++td)
#pragma unroll
                    for (int te = 0; te < 2; ++te) tm[td][te] = (f32x4){0.f, 0.f, 0.f, 0.f};
#pragma unroll
                for (int ks = 0; ks < 4; ++ks) {
                    bf16x8 a[2], b[2];
#pragma unroll
                    for (int t = 0; t < 2; ++t) { a[t] = *(const LAS bf16x8*)(lk + (32 * wd + 16 * t + fr) * SCN_LD + 32 * ks + 8 * fq); b[t] = *(const LAS bf16x8*)(lv + (32 * we + 16 * t + fr) * SCN_LD + 32 * ks + 8 * fq); }
#pragma unroll
                    for (int td = 0; td < 2; ++td)
#pragma unroll
                        for (int te = 0; te < 2; ++te) tm[td][te] = mfma16(a[td], b[te], tm[td][te]);
                }
#pragma unroll
                for (int td = 0; td < 2; ++td)
#pragma unroll
                    for (int te = 0; te < 2; ++te) acc[td][te] = acc[td][te] * gC + tm[td][te];
            }
        }
    }
    asm volatile("s_waitcnt vmcnt(0)" ::: "memory");
    __syncthreads();
    if (tid == 0) __hip_atomic_fetch_add(done + ((h * 2 + (eg >> 1)) * 64), 1u, __ATOMIC_RELAXED, __HIP_MEMORY_SCOPE_AGENT);
}
constexpr int RQ_LD = 264, SC_LD = 136, RO_SC_OFF = 128 * RQ_LD * 2, RO_PART_OFF = RO_SC_OFF + 128 * SC_LD * 2;
__device__ __forceinline__ void retout_unit(int h, int c, int eh, const bf16_t* q, const bf16_t* k, const bf16_t* vt, const bf16_t* S, bf16_t* ret  , float* rssq, LAS unsigned char* lds, unsigned* done, unsigned* tmo) {
    const int tid = opaque_tid(), lane = tid & 63, wave = __builtin_amdgcn_readfirstlane(tid >> 6);
    const int fr = lane & 15, fq = lane >> 4;
    LAS bf16_t* ql = (LAS bf16_t*)lds; LAS bf16_t* sc = (LAS bf16_t*)(lds + RO_SC_OFF); LAS float* part = (LAS float*)(lds + RO_PART_OFF);
    const float lg2 = log2f(1.0f - __builtin_amdgcn_exp2f(-5.0f - (float)h));
    const int tok0 = c * 128;
    if (tid < 64) {
        unsigned* f = done + ((h * 2 + eh) * 64); unsigned sp = 0;
        while ((unsigned)__builtin_amdgcn_readfirstlane(__hip_atomic_load(f, __ATOMIC_RELAXED, __HIP_MEMORY_SCOPE_AGENT)) < SCAN_UNITS_PER_FLAG) {
            __builtin_amdgcn_s_sleep(2);
            if (++sp > (1u << 20)) { if (tid == 0) __hip_atomic_store(tmo, 1u, __ATOMIC_RELAXED, __HIP_MEMORY_SCOPE_AGENT); break; }
        }
        __builtin_amdgcn_fence(__ATOMIC_ACQUIRE, "agent");
        asm volatile("s_waitcnt vmcnt(0)" ::: "memory");
    }
    __syncthreads();
    const bf16_t* sp = S + ((size_t)((h * 16 + c) * 512 + 256 * eh + 32 * wave + fr)) * 256 + 8 * fq;
    const bf16_t* vp = vt + (size_t)(h * 512 + 256 * eh + 32 * wave + fr) * SEQ + tok0 + 8 * fq;
    const bf16_t* kp = k + (size_t)(tok0 + 16 * wave + fr) * 1024 + h * 256 + 8 * fq;
    u32x4 qv[8]; bf16x8 kf[8], sfa[8][2], vfa[4][2];
#pragma unroll
    for (int i = 0; i < 8; ++i) { const int p = tid + 512 * i, row = p >> 5, c16 = p & 31; qv[i] = *(const u32x4*)(q + (size_t)(tok0 + row) * 1024 + h * 256 + c16 * 8); }
#pragma unroll
    for (int ks = 0; ks < 8; ++ks) kf[ks] = *(const bf16x8*)(kp + 32 * ks);
#pragma unroll
    for (int ks = 0; ks < 8; ++ks)
#pragma unroll
        for (int t = 0; t < 2; ++t) sfa[ks][t] = *(const bf16x8*)(sp + (size_t)(16 * t) * 256 + 32 * ks);
#pragma unroll
    for (int i = 0; i < 8; ++i) { const int p = tid + 512 * i, row = p >> 5, c16 = p & 31; *(LAS u32x4*)(ql + row * RQ_LD + c16 * 8) = qv[i]; }
    __syncthreads();
    {
        const int tj = wave;
#pragma unroll
        for (int ti = 0; ti < 8; ++ti) {
            if (ti >= tj) {
                f32x4 s2 = (f32x4){0.f, 0.f, 0.f, 0.f};
#pragma unroll
                for (int ks = 0; ks < 8; ++ks) { const bf16x8 qf = *(const LAS bf16x8*)(ql + (16 * ti + fr) * RQ_LD + 32 * ks + 8 * fq); s2 = mfma16(kf[ks], qf, s2); }
                const int i = 16 * ti + fr; f32x4 v;
#pragma unroll
                for (int r = 0; r < 4; ++r) { const int j = 16 * tj + 4 * fq + r; v[r] = (i >= j) ? s2[r] * __builtin_amdgcn_exp2f(lg2 * (float)(i - j)) : 0.f; }
                *(LAS u32x2*)(sc + (16 * ti + fr) * SC_LD + 16 * tj + 4 * fq) = pack4(v);
            } else if (ti == tj - 1 && (tj & 1)) {
                u32x2 z = (u32x2){0u, 0u}; asm volatile("" : "+v"(z));
                *(LAS u32x2*)(sc + (16 * ti + fr) * SC_LD + 16 * tj + 4 * fq) = z;
            }
        }
    }
    __syncthreads();
    f32x4 acc[8][2];
#pragma unroll
    for (int a = 0; a < 8; ++a)
#pragma unroll
        for (int b = 0; b < 2; ++b) acc[a][b] = (f32x4){0.f, 0.f, 0.f, 0.f};
    {
        bf16x8 qf[2][8];
#pragma unroll
        for (int t = 0; t < 8; ++t) qf[0][t] = *(const LAS bf16x8*)(ql + (16 * t + fr) * RQ_LD + 8 * fq);
#pragma unroll
        for (int ks = 0; ks < 8; ++ks) {
            if (ks == 4) {
#pragma unroll
                for (int k2 = 0; k2 < 4; ++k2)
#pragma unroll
                    for (int t = 0; t < 2; ++t) vfa[k2][t] = *(const bf16x8*)(vp + (size_t)(16 * t) * SEQ + 32 * k2);
            }
            if (ks < 7) {
#pragma unroll
                for (int t = 0; t < 8; ++t) qf[(ks + 1) & 1][t] = *(const LAS bf16x8*)(ql + (16 * t + fr) * RQ_LD + 32 * (ks + 1) + 8 * fq);
            }
            __builtin_amdgcn_sched_barrier(0);
#pragma unroll
            for (int a = 0; a < 8; ++a)
#pragma unroll
                for (int b = 0; b < 2; ++b) acc[a][b] = mfma16(sfa[ks][b], qf[ks & 1][a], acc[a][b]);
            __builtin_amdgcn_sched_barrier(0);
        }
    }
#pragma unroll
    for (int a = 0; a < 8; ++a) { const float qd = __builtin_amdgcn_exp2f(lg2 * (float)(16 * a + fr + 1));
#pragma unroll
        for (int b = 0; b < 2; ++b) acc[a][b] = acc[a][b] * qd; }
#pragma unroll
    for (int ks = 0; ks < 4; ++ks) {
        bf16x8 pf[8];
#pragma unroll
        for (int a = 0; a < 8; ++a) if (a >= 2 * ks) pf[a] = *(const LAS bf16x8*)(sc + (16 * a + fr) * SC_LD + 32 * ks + 8 * fq);
        __builtin_amdgcn_sched_barrier(0);
#pragma unroll
        for (int a = 0; a < 8; ++a) {
            if (a >= 2 * ks) {
#pragma unroll
                for (int b = 0; b < 2; ++b) acc[a][b] = mfma16(vfa[ks][b], pf[a], acc[a][b]);
            }
        }
        __builtin_amdgcn_sched_barrier(0);
    }
#pragma unroll
    for (int a = 0; a < 8; ++a) {
        float ss = 0.f;
#pragma unroll
        for (int b = 0; b < 2; ++b) { const f32x4 t = acc[a][b]; ss += (t[0] * t[0] + t[1] * t[1]) + (t[2] * t[2] + t[3] * t[3]); }
        ss += __shfl_xor(ss, 16); ss += __shfl_xor(ss, 32);
        if (fq == 0) part[wave * 128 + 16 * a + fr] = ss;
    }
    __syncthreads();
    if (tid < 128) {
        float tot = 0.f;
#pragma unroll
        for (int w = 0; w < 8; ++w) tot += part[w * 128 + tid];
        rssq[(size_t)(tok0 + tid) * 8 + 2 * h + eh] = tot;
    }
#pragma unroll
    for (int a = 0; a < 8; ++a)
#pragma unroll
        for (int b = 0; b < 2; ++b)
            *(u32x2*)(ret + (size_t)(tok0 + 16 * a + fr) * 2048 + h * 512 + 256 * eh + 32 * wave + 16 * b + 4 * fq) = pack4(acc[a][b]);
    __syncthreads();
}
constexpr int PL_LD = 264, MA_KV_BYTES = 64 * 264 * 2, MA_P_OFF = MA_KV_BYTES;
__device__ __forceinline__ void memattn_unit(int b, int h, int rb, const bf16_t* mkn, const bf16_t* mvt, bf16_t* mo  , LAS unsigned char* lds) {
    const bf16_t* mq = mo;
    const int tid = opaque_tid(), lane = tid & 63, wave = __builtin_amdgcn_readfirstlane(tid >> 6);
    const int fr = lane & 15, fq = lane >> 4;
    LAS bf16_t* kv = (LAS bf16_t*)lds; LAS bf16_t* pl = (LAS bf16_t*)(lds + MA_P_OFF) + wave * (16 * PL_LD);
    const int row = 128 * rb + 16 * wave + fr;
    const bf16_t* ksrc = mkn + (size_t)(b * 256) * 1024 + h * 256;
    const bf16_t* vsrc = mvt + (size_t)((b * 4 + h) * 256) * 256;
    u32x4 pre[4];
#pragma unroll
    for (int i = 0; i < 4; ++i) { const int p = tid + 512 * i; pre[i] = *(const u32x4*)(ksrc + (size_t)(p >> 5) * 1024 + (p & 31) * 8); }
    bf16x8 qf[8]; float qs = 0.f;
#pragma unroll
    for (int ks = 0; ks < 8; ++ks) { qf[ks] = *(const bf16x8*)(mq + (size_t)row * 1024 + h * 256 + 32 * ks + 8 * fq);
#pragma unroll
        for (int j = 0; j < 8; ++j) { const float f = bf2f((unsigned short)qf[ks][j]); qs += f * f; } }
    qs += __shfl_xor(qs, 16); qs += __shfl_xor(qs, 32);
    const float scl = __builtin_amdgcn_rsqf(qs * (1.0f / 256.0f) + EPS) * (0.0625f * LOG2E);
    f32x4 sa[16];
#pragma unroll
    for (int kc = 0; kc < 4; ++kc) {
        __syncthreads();
#pragma unroll
        for (int i = 0; i < 4; ++i) { const int p = tid + 512 * i; *(LAS u32x4*)(kv + (p >> 5) * PL_LD + (p & 31) * 8) = pre[i]; }
        __syncthreads();
#pragma unroll
        for (int i = 0; i < 4; ++i) { const int p = tid + 512 * i;
            pre[i] = (kc < 3) ? *(const u32x4*)(ksrc + (size_t)(64 * (kc + 1) + (p >> 5)) * 1024 + (p & 31) * 8) : *(const u32x4*)(vsrc + (size_t)(p >> 5) * 256 + (p & 31) * 8); }
#pragma unroll
        for (int tl = 0; tl < 4; ++tl) {
            f32x4 a = (f32x4){0.f, 0.f, 0.f, 0.f};
#pragma unroll
            for (int ks = 0; ks < 8; ++ks) { const bf16x8 kf = *(const LAS bf16x8*)(kv + (16 * tl + fr) * PL_LD + 32 * ks + 8 * fq); a = mfma16(kf, qf[ks], a); }
            sa[4 * kc + tl] = a * scl;
        }
    }
    float mx = -INFINITY;
#pragma unroll
    for (int t = 0; t < 16; ++t) mx = fmaxf(mx, fmaxf(fmaxf(sa[t][0], sa[t][1]), fmaxf(sa[t][2], sa[t][3])));
    mx = fmaxf(mx, __shfl_xor(mx, 16)); mx = fmaxf(mx, __shfl_xor(mx, 32));
    float l = 0.f;
#pragma unroll
    for (int t = 0; t < 16; ++t) {
        f32x4 p;
#pragma unroll
        for (int r = 0; r < 4; ++r) { p[r] = __builtin_amdgcn_exp2f(sa[t][r] - mx); l += p[r]; }
        *(LAS u32x2*)(pl + fr * PL_LD + 16 * t + 4 * fq) = pack4(p);
    }
    l += __shfl_xor(l, 16); l += __shfl_xor(l, 32);
    const float rl = __builtin_amdgcn_rcpf(l);
    LDS_WAIT(); asm volatile("" ::: "memory");
    bf16x8 pf[8];
#pragma unroll
    for (int ks = 0; ks < 8; ++ks) pf[ks] = *(const LAS bf16x8*)(pl + fr * PL_LD + 32 * ks + 8 * fq);
#pragma unroll
    for (int dc = 0; dc < 4; ++dc) {
        __syncthreads();
#pragma unroll
        for (int i = 0; i < 4; ++i) { const int p = tid + 512 * i; *(LAS u32x4*)(kv + (p >> 5) * PL_LD + (p & 31) * 8) = pre[i]; }
        __syncthreads();
        if (dc < 3) {
#pragma unroll
            for (int i = 0; i < 4; ++i) { const int p = tid + 512 * i; pre[i] = *(const u32x4*)(vsrc + (size_t)(64 * (dc + 1) + (p >> 5)) * 256 + (p & 31) * 8); }
        }
#pragma unroll
        for (int tl = 0; tl < 4; ++tl) {
            f32x4 a = (f32x4){0.f, 0.f, 0.f, 0.f};
#pragma unroll
            for (int ks = 0; ks < 8; ++ks) { const bf16x8 vf = *(const LAS bf16x8*)(kv + (16 * tl + fr) * PL_LD + 32 * ks + 8 * fq); a = mfma16(vf, pf[ks], a); }
            *(u32x2*)(mo + (size_t)row * 1024 + h * 256 + 64 * dc + 16 * tl + 4 * fq) = pack4(a * rl);
        }
    }
    __syncthreads();
}
__device__ __forceinline__ void dif_row(const bf16_t* o0, const bf16_t* o1, bf16_t* dif, const float* gout, float lam, int lane) {
    const u32x4* a = (const u32x4*)o0 + 2 * lane; const u32x4* b = (const u32x4*)o1 + 2 * lane;
    float d[16]; float ss = 0.f;
#pragma unroll
    for (int v = 0; v < 2; ++v) { const u32x4 x = __builtin_nontemporal_load(a + v), y = __builtin_nontemporal_load(b + v);
#pragma unroll
        for (int w = 0; w < 4; ++w) { const float x0 = __uint_as_float(x[w] << 16), x1 = __uint_as_float(x[w] & 0xffff0000u), y0 = __uint_as_float(y[w] << 16), y1 = __uint_as_float(y[w] & 0xffff0000u);
            const float d0 = x0 - lam * y0, d1 = x1 - lam * y1; d[v * 8 + w * 2] = d0; d[v * 8 + w * 2 + 1] = d1; ss += d0 * d0 + d1 * d1; } }
    ss += __shfl_xor(ss, 1); ss += __shfl_xor(ss, 2); ss += __shfl_xor(ss, 4);
    const float rn = __builtin_amdgcn_rsqf(ss * (1.0f / 128.0f) + EPS) * (1.0f - LAM_INIT);
    const float* gp = gout + (lane & 7) * 16;
    u32x4 o[2];
#pragma unroll
    for (int v = 0; v < 2; ++v)
#pragma unroll
        for (int w = 0; w < 4; ++w) o[v][w] = cvt_pk_bf16(d[v * 8 + w * 2] * rn * gp[v * 8 + w * 2], d[v * 8 + w * 2 + 1] * rn * gp[v * 8 + w * 2 + 1]);
    u32x4* op = (u32x4*)dif + 2 * lane; op[0] = o[0]; op[1] = o[1];
}

struct P4bOrder {
    pg8::StaticOrder T; unsigned char* ws; const char* xa;
    __device__ __forceinline__ bool next(int i, pg8::Unit& u) const {
        int pm, pn; if (!T.tile(i, pm, pn)) return false;
        u.pm = pm; u.pn = pn; u.ui = i; u.ri = i; u.tag = 0; u.K = 1024;
        u.A = xa + (size_t)pm * 256 * 1024 * 2;
        u.Bt = (const char*)ws + (pn < 8 ? WS_WRG + (size_t)pn * 256 * 1024 * 2 : WS_WGATE + (size_t)(pn - 8) * 256 * 1024 * 2); return true;
    }
};
struct P5Order {
    pg8::StaticOrder T; unsigned char* ws;
    __device__ __forceinline__ bool next(int i, pg8::Unit& u) const {
        const int ti = i / 3, kbr = i - 3 * ti; int pm, pn; if (!T.tile(ti, pm, pn)) return false;
        const size_t offA = kbr == 0 ? WS_RET : kbr == 1 ? WS_DIF : WS_MO;
        const size_t offB = kbr == 0 ? WS_WBRR : kbr == 1 ? WS_WBRD : WS_WBRM;
        const int K = kbr == 0 ? 2048 : 1024;
        u.pm = pm; u.pn = pn; u.ui = i; u.ri = ti; u.tag = kbr; u.K = K;
        u.A = (const char*)ws + offA + (size_t)pm * 256 * K * 2; u.Bt = (const char*)ws + offB + (size_t)pn * 256 * K * 2; return true;
    }
};
#ifndef PH_MASK
#define PH_MASK 0xffffffffu
#endif
#define PH(n) ((PH_MASK >> (n)) & 1u)
#ifndef DUP_MASK
#define DUP_MASK 0u
#endif
#ifndef PROBE_K
#define PROBE_K (-1)
#endif
#define RUNP(k) (pass_ == 1 || (k) <= PROBE_K)
#define REPQ(n) _Pragma("unroll 1") for (int rq_ = 0; rq_ < 1 + (int)((DUP_MASK >> (n)) & 1u); ++rq_)
#define REP(n) _Pragma("unroll 1") for (int rep_ = 0; rep_ < 1 + (int)((DUP_MASK >> (n)) & 1u); ++rep_)
struct Args { const void* in[26]; float* out; unsigned char* ws; };
#define CAS __attribute__((address_space(4)))
__device__ __forceinline__ const void* karg(int i) { typedef const GAS void* gptr; const CAS gptr* p = (const CAS gptr*)__builtin_amdgcn_kernarg_segment_ptr(); asm volatile("" : "+s"(p)); return (const void*)p[i]; }
#define INP(i) ((const float*)karg(i))
#define WSP(T, off) ((T*)((unsigned char*)karg(27) + (off)))
#define OUTP ((float*)karg(26))
struct SplitWait {
    unsigned target;
    __device__ __forceinline__ void wait() const { if (target) xcd_split_wait((unsigned*)WSP(unsigned, WS_CTL) + CW_BAR2, (unsigned*)WSP(unsigned, WS_CTL) + CW_BAR, target); }
};
__global__ void __launch_bounds__(NWAVES * 64, 2) mk_fwd(Args args) {
    extern __shared__ __attribute__((aligned(16))) unsigned char lds_raw[];
    LAS unsigned char* lds = (LAS unsigned char*)lds_raw;
    volatile LAS unsigned* MISC = (volatile LAS unsigned*)(lds + MISC_OFF);
    const int G = gridDim.x, bx = blockIdx.x;
    for (int u = threadIdx.x; u < (LDS_BYTES - LDSCTL_OFF) / 4; u += NWAVES * 64) ((LAS unsigned*)(lds + LDSCTL_OFF))[u] = 0u;
    __syncthreads();
    (void)xcd_barrier_post((unsigned*)WSP(unsigned, WS_CTL) + CW_BAR, MISC + 8);
#define GRID_BAR() do { XcdBarrier b_; b_.bar = (unsigned*)WSP(unsigned, WS_CTL) + CW_BAR; b_.x = xb_xcc_id(); b_.st = (volatile LAS unsigned*)(lds + MISC_OFF) + 8; xcd_barrier(b_); } while (0)
#define SPLIT_ARRIVE() do { xcd_split_arrive((unsigned*)WSP(unsigned, WS_CTL) + CW_BAR2, (unsigned*)WSP(unsigned, WS_CTL) + CW_BAR, (volatile LAS unsigned*)(lds + MISC_OFF) + 8); ++sgen; } while (0)
    unsigned sgen = 0;
    const int NGW = G * NWAVES, NGT = G * NWAVES * 64;
#define LANE_VARS() const int tid = opaque_tid(), lane = tid & 63, wave = __builtin_amdgcn_readfirstlane(tid >> 6); LAS float* scr = (LAS float*)(lds + wave * 16384); \
    const int gw = bx * NWAVES + wave, gt = bx * (NWAVES * 64) + tid; (void)scr; (void)gw; (void)gt; (void)lane

#pragma unroll 1
    for (int pass_ = (PROBE_K >= 0 ? 0 : 1); pass_ < 2; ++pass_) {
    if (RUNP(0)) {
    REP(0) if (PH(0)) {
        LANE_VARS();
        transpose_all<true>(INP(4), 1024, 2 * DFF, WSP(bf16_t, WS_WF1I), 2 * DFF, ColSwiglu{}, nullptr, scr, gw, NGW, lane);
        transpose_all(INP(18), 1024, 2048, WSP(bf16_t, WS_WMKV), 2048, ColIdent{0}, nullptr, scr, gw, NGW, lane);
        { const float* x = INP(0); const float* g1 = INP(3); bf16_t* xb = WSP(bf16_t, WS_XBL);
          rms_rows_to_bf16(x, g1, xb, gw, NGW, TOK, lane); }
        { const float* mem = INP(1); const float* gm = INP(17); bf16_t* memn = WSP(bf16_t, WS_MEMN);
          rms_rows_to_bf16(mem, gm, memn, gw, NGW, NB * MEML, lane); }
        rot_table((const int*)karg(2), WSP(float, WS_ROT), gt, NGT);
    }
    GRID_BAR();
    }

    if (RUNP(1)) {
    REP(1) if (PH(1)) {
        pg8::Gemm g{WSP(bf16_t, WS_XBL), WSP(bf16_t, WS_WF1I), TOK, 2 * DFF, 1024}; pg8::StaticOrder S; S.init(TOK, 2 * DFF, G, bx);
        EpiSwiglu E{WSP(bf16_t, WS_ACT), nullptr};
        S.set(g); pg8::gemm_phase(lds, S, E);
    }
    if (PH(2)) {
        pg8::Gemm g{WSP(bf16_t, WS_MEMN), WSP(bf16_t, WS_WMKV), NB * MEML, 2048, 1024}; pg8::StaticOrder S; S.init(NB * MEML, 2048, G, (bx + G / 2) % G);
        EpiPlain E{WSP(bf16_t, WS_MKVRAW), 2048};
        S.set(g); pg8::gemm_phase(lds, S, E);
    }
    if (PH(0)) {
        const int q0 = (3 * G) / 4, nq = G - q0;
        if (bx >= q0) {
            LANE_VARS();
            const int gw2 = (bx - q0) * NWAVES + wave, ngw2 = nq * NWAVES;
            transpose_all(INP(5), DFF, 1024, WSP(bf16_t, WS_WF1O), 1024, ColIdent{0}, nullptr, scr, gw2, ngw2, lane);
            transpose_all<true>(INP(7), 1024, 13312, WSP(bf16_t, WS_WMIX), NMIX, ColMix{}, INP(6), scr, gw2, ngw2, lane);
        }
    }
    GRID_BAR();
    }

    if (RUNP(2)) {
    REP(3) if (PH(3)) {
        pg8::Gemm g{WSP(bf16_t, WS_ACT), WSP(bf16_t, WS_WF1O), TOK, 1024, DFF}; pg8::StaticOrder S; S.init(TOK, 1024, G, bx);
        EpiResid<false, false> E{INP(0), nullptr, (bf16_t*)OUTP, WSP(float, WS_SSQ1), 0.5f, (rep_ == 1 && ((DUP_MASK >> 23) & 1u)) ? 1 : 0};
        S.set(g); pg8::gemm_phase(lds, S, E);
    }
    SPLIT_ARRIVE();
    if (PH(0)) {
        LANE_VARS();
        const bf16_t* mkvraw = WSP(bf16_t, WS_MKVRAW); bf16_t* mkn = WSP(bf16_t, WS_MKN); bf16_t* mvt = WSP(bf16_t, WS_MVT);
        const float* g_mem_k = INP(16); const float* g_mem_q = INP(15);
        for (int j = gw; j < NB * MEML * 4; j += NGW) {
            const int row = j >> 2, h = j & 3;
            const u32x2 w = *((const u32x2*)(mkvraw + (size_t)row * 2048 + h * 256) + lane);
            f32x4 v = (f32x4){__uint_as_float(w.x << 16), __uint_as_float(w.x & 0xffff0000u), __uint_as_float(w.y << 16), __uint_as_float(w.y & 0xffff0000u)};
            const float ss = wave_sum((v[0] * v[0] + v[1] * v[1]) + (v[2] * v[2] + v[3] * v[3]));
            const float rn = __builtin_amdgcn_rsqf(ss * (1.0f / 256.0f) + EPS);
            const f32x4 gk = *((const f32x4*)g_mem_k + lane), gq = *((const f32x4*)g_mem_q + lane);
            *((u32x2*)(mkn + (size_t)row * 1024 + h * 256) + lane) = pack4(v * rn * gk * gq);
        }
        for (int idx = gt; idx < NB * 4 * 256 * 256; idx += NGT) {
            const int key = idx & 255, d = (idx >> 8) & 255, bh = idx >> 16, b = bh >> 2, h = bh & 3;
            mvt[idx] = mkvraw[(size_t)(b * 256 + key) * 2048 + 1024 + h * 256 + d];
        }
    }
    { SplitWait H{sgen}; H.wait(); }
    }

    if (RUNP(3))
    for (int ph = 0; ph <= NB; ++ph) {
        const int gp = ph, gm = ph - 1;
        unsigned char* const wsP = WSP(unsigned char, 0) - (((gp + 1) & 1) ? SET_DELTA : 0);
        unsigned char* const wsB = WSP(unsigned char, 0) - (((gm + 1) & 1) ? SET_DELTA : 0);
        unsigned* done = (unsigned*)WSP(unsigned, WS_CTL) + CW_SCAN + ((pass_ * NB + (gm < 0 ? 0 : gm)) * 8) * 64; unsigned* tmo = (unsigned*)WSP(unsigned, WS_CTL) + CW_BAR + XB_TMO;
        const bool early = (gm >= 0 && bx < 64) || gp >= NB;
        if (early) { SplitWait H{sgen}; H.wait(); }
        if (gm >= 0)
            for (int u = bx; u < 64; u += G) REPQ(26) { __syncthreads(); if (PH(5)) scan_unit(u, (const bf16_t*)(wsB + WS_KTS), (const bf16_t*)(wsB + WS_VT), WSP(bf16_t, WS_S), lds, done); }
        if (gp < NB) {
            REP(4) if (PH(4)) {
                pg8::Gemm g{(const bf16_t*)OUTP + (size_t)gp * SEQ * DM, WSP(bf16_t, WS_WMIX), SEQ, NMIX, 1024}; pg8::StaticOrder S; S.init(SEQ, NMIX, G, bx);
                prep_rs(WSP(float, WS_SSQ1), gp * SEQ, S, lds);
                EpiMix E{(const LAS float*)(lds + RTAB_OFF), WSP(float, (gp & 1) ? WS_ROTB : WS_ROT), wsP, WSP(bf16_t, WS_MO) + (size_t)gp * SEQ * 1024, INP(8), INP(9)};
                SplitWait H{early ? 0u : sgen};
                S.set(g); pg8::gemm_phase(lds, S, E, H);
                if (bx >= (SEQ / 256) * (NMIX / 256)) H.wait();
            }
        }
        if (gm >= 0) {
            const size_t oOff = (gm & 1) ? WS_OB : 0;
            unsigned* qctr = (unsigned*)WSP(unsigned, WS_CTL) + CW_QUEUE + (pass_ * NB + gm) * 64;
            volatile LAS unsigned* qslot = (volatile LAS unsigned*)(lds + MISC_OFF) + 16;
            for (;;) {
                __syncthreads();
                if (threadIdx.x == 0) qslot[0] = __hip_atomic_fetch_add(qctr, 1u, __ATOMIC_RELAXED, __HIP_MEMORY_SCOPE_AGENT);
                __syncthreads();
                const int id = __builtin_amdgcn_readfirstlane((int)qslot[0]);
                if (id >= 448) break;
                if (id >= 320) {
                    LANE_VARS();
                    if (id < 384) { if (ph >= 2) {
                        const int gd = ph - 2; const size_t oD = (gd & 1) ? WS_OB : 0;
                        const float s1 = wave_sum(INP(10)[lane] * INP(11)[lane]), s2 = wave_sum(INP(12)[lane] * INP(13)[lane]); const float lam = __expf(s1) - __expf(s2) + LAM_INIT;
                        const bf16_t* bo0 = WSP(bf16_t, WS_O0 + oD); const bf16_t* bo1 = WSP(bf16_t, WS_O1 + oD); bf16_t* difb = WSP(bf16_t, WS_DIF); const float* gdo = INP(14);
                        for (int k = 0; k < 4; ++k) { const int r = (id - 320) * 32 + wave * 4 + k; dif_row(bo0 + (size_t)r * 1024, bo1 + (size_t)r * 1024, difb + ((size_t)gd * SEQ + r) * 1024, gdo, lam, lane); } } }
                    else if (ph + 1 < NB) rot_table((const int*)karg(2) + (ph + 1) * SEQ, WSP(float, ((ph + 1) & 1) ? WS_ROTB : WS_ROT), tid, NWAVES * 64, (id - 384) * 4096, (id - 383) * 4096);
                    continue;
                }
                int aq = -1, aj = 0;
                if (id < 96) { aq = 7 - (id >> 4); aj = id & 15; }
                else if (id >= 192) { const int ro = id - 192;
                    if (PH(8)) REPQ(24) { __syncthreads(); retout_unit(ro >> 5, (ro >> 1) & 15, ro & 1, (const bf16_t*)(wsB + WS_Q), (const bf16_t*)(wsB + WS_K), (const bf16_t*)(wsB + WS_VT), WSP(bf16_t, WS_S),
                                           WSP(bf16_t, WS_RET) + (size_t)gm * SEQ * 2048, WSP(float, WS_SSQ2) + (size_t)gm * SEQ * 8, lds, done, tmo); } }
                else if (id < 160) { const int m = id - 96;
                    if (PH(7)) memattn_unit(gm, m >> 4, m & 15, WSP(bf16_t, WS_MKN), WSP(bf16_t, WS_MVT), WSP(bf16_t, WS_MO) + (size_t)gm * SEQ * 1024, lds); }
                else { aq = 1 - ((id - 160) >> 4); aj = (id - 160) & 15; }
                if (aq >= 0) {
                    const int hc = aj, hh = hc >> 1, cc = hc & 1;
                    if (PH(6)) REPQ(25) attn_body::attn_unit<8>(hc, hh, aq, (const attn_body::bf16*)(wsB + WS_DQ), (const attn_body::bf16*)(wsB + WS_DK), (const attn_body::bf16*)(wsB + WS_DV),
                                            WSP(attn_body::bf16, (cc ? WS_O1 : WS_O0) + oOff), (char*)lds_raw);
                }
            }
        }
        {
            LANE_VARS();
            if (ph == 0) rot_table((const int*)karg(2) + (ph + 1) * SEQ, WSP(float, ((ph + 1) & 1) ? WS_ROTB : WS_ROT), gt, NGT);
            if (ph == 0) transpose_all<true>(INP(7), 1024, 13312, WSP(bf16_t, WS_WRG), 2048, ColIdent{4096}, INP(6), scr, gw, NGW, lane);
            if (ph == NB) {
                transpose_all<true>(INP(7), 1024, 13312, WSP(bf16_t, WS_WGATE), 3072, ColIdent{10240}, INP(6), scr, gw, NGW, lane);
            }
        }
        SPLIT_ARRIVE();
    }

    if (RUNP(4)) {
    if (PH(9)) {
        pg8::StaticOrder T; T.init(TOK, 5120, G, bx);
        prep_rs(WSP(float, WS_SSQ1), 0, T, lds);
        P4bOrder S{T, WSP(unsigned char, 0), (const char*)OUTP};
        EpiRgG E{(const LAS float*)(lds + RTAB_OFF), WSP(bf16_t, WS_RET), WSP(float, WS_SSQ2), WSP(unsigned char, 0)};
        SplitWait H{sgen};
        pg8::gemm_phase(lds, S, E, H);
        if (bx >= (TOK / 256) * (5120 / 256)) H.wait();
    }
    if (PH(0)) {
        LANE_VARS();
        { const float s1 = wave_sum(INP(10)[lane] * INP(11)[lane]), s2 = wave_sum(INP(12)[lane] * INP(13)[lane]); const float lam = __expf(s1) - __expf(s2) + LAM_INIT;
          const bf16_t* bo0 = WSP(bf16_t, WS_O0 + (((NB - 1) & 1) ? WS_OB : 0)); const bf16_t* bo1 = WSP(bf16_t, WS_O1 + (((NB - 1) & 1) ? WS_OB : 0)); bf16_t* difb = WSP(bf16_t, WS_DIF); const float* gdo = INP(14);
          for (int r = gw; r < SEQ; r += NGW) dif_row(bo0 + (size_t)r * 1024, bo1 + (size_t)r * 1024, difb + ((size_t)(NB - 1) * SEQ + r) * 1024, gdo, lam, lane); }
        transpose_all<true>(INP(19), 2048, 1024, WSP(bf16_t, WS_WBRR), 1024, ColIdent{0}, nullptr, scr, gw, NGW, lane);
        transpose_all<true>(INP(20), 1024, 1024, WSP(bf16_t, WS_WBRD), 1024, ColIdent{0}, nullptr, scr, gw, NGW, lane);
        transpose_all<true>(INP(21), 1024, 1024, WSP(bf16_t, WS_WBRM), 1024, ColIdent{0}, nullptr, scr, gw, NGW, lane);
    }
    SPLIT_ARRIVE();
    if (PH(0)) {
        LANE_VARS();
        transpose_all(INP(22), 1024, 1024, WSP(bf16_t, WS_WO), 1024, ColIdent{0}, nullptr, scr, gw, NGW, lane);
        transpose_all<true>(INP(24), 1024, 2 * DFF, WSP(bf16_t, WS_WF2I), DFF, ColSwigluOff{0}, INP(23), scr, gw, NGW, lane);
    }
    { SplitWait H{sgen}; H.wait(); }
    }

    if (RUNP(5)) {
    REP(10) if (PH(10)) {
        pg8::StaticOrder T; T.init(TOK, 1024, G, bx);
        P5Order S{T, WSP(unsigned char, 0)};
        EpiTerm3 E{WSP(unsigned char, 0), WSP(bf16_t, WS_Y)};
        pg8::gemm_phase(lds, S, E);
    }
    SPLIT_ARRIVE();
    if (PH(0)) {
        LANE_VARS();
        transpose_all<true>(INP(24), 1024, 2 * DFF, WSP(bf16_t, WS_WF2I) + (size_t)DFF * 1024, DFF, ColSwigluOff{DFF}, INP(23), scr, gw, NGW, lane);
    }
    { SplitWait H{sgen}; H.wait(); }
    }

    if (RUNP(6)) {
    if (PH(11)) {
        pg8::Gemm g{WSP(bf16_t, WS_Y), WSP(bf16_t, WS_WO), TOK, 1024, 1024}; pg8::StaticOrder S; S.init(TOK, 1024, G, bx);
        EpiResid<true, false> E{OUTP, nullptr, WSP(bf16_t, WS_X2B), WSP(float, WS_SSQ2), 1.0f, 0};
        S.set(g); pg8::gemm_phase(lds, S, E);
    }
    SPLIT_ARRIVE();
    if (PH(0)) {
        LANE_VARS();
        transpose_all(INP(25), DFF, 1024, WSP(bf16_t, WS_WF2O), 1024, ColIdent{0}, nullptr, scr, gw, NGW, lane);
    }
    { SplitWait H{sgen}; H.wait(); }
    }

    if (RUNP(7)) {
    if (PH(12)) {
        pg8::Gemm g{WSP(bf16_t, WS_X2B), WSP(bf16_t, WS_WF2I), TOK, 2 * DFF, 1024}; pg8::StaticOrder S; S.init(TOK, 2 * DFF, G, bx);
        prep_rs(WSP(float, WS_SSQ2), 0, S, lds);
        EpiSwiglu E{WSP(bf16_t, WS_ACT2), (const LAS float*)(lds + RTAB_OFF)};
        S.set(g); pg8::gemm_phase(lds, S, E);
    }
    GRID_BAR();
    }

    if (RUNP(8))
    if (PH(13)) {
        pg8::Gemm g{WSP(bf16_t, WS_ACT2), WSP(bf16_t, WS_WF2O), TOK, 1024, DFF}; pg8::StaticOrder S; S.init(TOK, 1024, G, bx);
        EpiResid<true, true> E{WSP(bf16_t, WS_X2B), OUTP, nullptr, nullptr, 0.5f, 0};
        S.set(g); pg8::gemm_phase(lds, S, E);
    }
    if (pass_ == 0) GRID_BAR();
    }
}

extern "C" void kernel_launch(void* const* d_in, const int* in_sizes, int n_in, void* d_out, int out_size, void* d_ws, size_t ws_size, hipStream_t stream) {
    static int grid = 0;
    if (grid == 0) {
        if (n_in != 26 || ws_size < WS_END) { fprintf(stderr, "kernel_launch: unexpected inputs (n_in %d, ws %zu)\n", n_in, ws_size); grid = -1; return; }
        int dev = 0, cus = 0;
        if (hipGetDevice(&dev) != hipSuccess || hipDeviceGetAttribute(&cus, hipDeviceAttributeMultiprocessorCount, dev) != hipSuccess) { grid = -1; return; }
        if (hipFuncSetAttribute((const void*)mk_fwd, hipFuncAttributeMaxDynamicSharedMemorySize, LDS_BYTES) != hipSuccess) { fprintf(stderr, "kernel_launch: hipFuncSetAttribute failed\n"); grid = -1; return; }
        grid = cus;
    }
    if (grid < 0) return;
    (void)hipMemsetAsync((char*)d_ws + WS_CTL, 0, CTL_ZERO_BYTES, stream);
    Args a{};
    for (int i = 0; i < 26; ++i) a.in[i] = d_in[i];
    a.out = (float*)d_out; a.ws = (unsigned char*)d_ws;
    hipLaunchKernelGGL(mk_fwd, dim3(grid), dim3(NWAVES * 64), LDS_BYTES, stream, a);
}
```

```cpp
#include <hip/hip_runtime.h>
#include <cstdio>
#include <cstdint>

#define LAS __attribute__((address_space(3)))
#define GAS __attribute__((address_space(1)))
typedef unsigned short bf16_t;
typedef short bf16x8 __attribute__((ext_vector_type(8)));
typedef float f32x4 __attribute__((ext_vector_type(4)));
typedef float f32x2 __attribute__((ext_vector_type(2)));
typedef unsigned u32x4 __attribute__((ext_vector_type(4)));
typedef unsigned u32x2 __attribute__((ext_vector_type(2)));

constexpr int NB = 8, SEQ = 2048, DM = 1024, TOK = NB * SEQ, MEML = 256, DFF = 2816;
constexpr int NMIX = 8192;
constexpr float EPS = 1e-6f;
constexpr float LOG2E = 1.4426950408889634f;
constexpr float C2Q = 0.125f * LOG2E;
constexpr float LAM_INIT = 0.2f;

constexpr size_t MiB = 1u << 20;
constexpr size_t KiB = 1u << 10;
constexpr size_t WS_CTL = 0, CTL_ZERO_BYTES = 256 * KiB;
constexpr size_t WS_SSQ1 = 256 * KiB, WS_SSQ2 = 512 * KiB;
constexpr size_t WS_ROT = 1 * MiB, WS_ROTB = 153 * MiB;
constexpr size_t WS_MKN = 3 * MiB, WS_MVT = 7 * MiB;
constexpr size_t WS_WMIX = 11 * MiB;
constexpr size_t WS_XB = 27 * MiB;
constexpr size_t WS_RET = 59 * MiB;
constexpr size_t WS_XBL = 91 * MiB;
constexpr size_t WS_DIF = 123 * MiB;
constexpr size_t WS_MO = 155 * MiB;
constexpr size_t WS_Q = 187 * MiB, WS_K = 191 * MiB, WS_KTS = 195 * MiB, WS_VT = 199 * MiB, WS_DQ = 207 * MiB, WS_DK = 211 * MiB,
                 WS_DV = 215 * MiB;
constexpr size_t SET_DELTA = 160 * MiB;
constexpr size_t WS_WRG = 219 * MiB;
constexpr size_t WS_O0 = 223 * MiB, WS_O1 = 227 * MiB, WS_S = 231 * MiB;
constexpr size_t WS_OB = 24 * MiB;
constexpr size_t WS_WF1I = 59 * MiB, WS_WF1O = 70 * MiB;
constexpr size_t WS_MEMN = 76 * MiB, WS_MKVRAW = 80 * MiB, WS_WMKV = 27 * MiB;
constexpr size_t WS_ACT = 155 * MiB;
constexpr size_t WS_WGATE = 11 * MiB, WS_WBRR = 17 * MiB, WS_WBRD = 21 * MiB, WS_WBRM = 23 * MiB, WS_WO = 25 * MiB;
constexpr size_t WS_G8A = 187 * MiB, WS_G8B = 203 * MiB, WS_G8C = 223 * MiB;
constexpr size_t WS_Y = 27 * MiB;
constexpr size_t WS_X2B = 187 * MiB;
constexpr size_t WS_WF2I = 239 * MiB, WS_WF2O = 1 * MiB, WS_ACT2 = 76 * MiB;
constexpr size_t WS_END = 256 * MiB;

constexpr int CW_BAR = 4096, CW_BAR2 = 8192;
constexpr int CW_QUEUE = 32768;
constexpr int CW_SCAN = 16384;

constexpr int RING_BYTES = 131072, LDSCTL_OFF = RING_BYTES, MISC_OFF = LDSCTL_OFF + 320, LDS_BYTES = 147456;
constexpr int NWAVES = 8;

__device__ __forceinline__ unsigned cvt_pk_bf16(float lo, float hi) { unsigned r; asm volatile("v_cvt_pk_bf16_f32 %0, %1, %2" : "=v"(r) : "v"(lo), "v"(hi)); return r; }
__device__ __forceinline__ u32x2 pack4(f32x4 v) { u32x2 w; w.x = cvt_pk_bf16(v[0], v[1]); w.y = cvt_pk_bf16(v[2], v[3]); return w; }
__device__ __forceinline__ unsigned short bf16_1(float v) { return (unsigned short)(cvt_pk_bf16(v, 0.f) & 0xffffu); }
__device__ __forceinline__ float bf2f(unsigned short b) { return __uint_as_float(((unsigned)b) << 16); }
__device__ __forceinline__ float siluf(float x) { return x * __builtin_amdgcn_rcpf(1.0f + __builtin_amdgcn_exp2f(-x * LOG2E)); }
__device__ __forceinline__ float sigmf(float x) { return __builtin_amdgcn_rcpf(1.0f + __builtin_amdgcn_exp2f(-x * LOG2E)); }
__device__ __forceinline__ float row_rs(const float* ssq, int row) {
    const f32x4 a = *(const f32x4*)(ssq + (size_t)row * 4);
    return __builtin_amdgcn_rsqf(((a[0] + a[1]) + (a[2] + a[3])) * (1.0f / 1024.0f) + EPS);
}
__device__ __forceinline__ int opaque_tid() { int t = threadIdx.x; asm volatile("" : "+v"(t)); return t; }
__device__ __forceinline__ f32x4 mfma16(bf16x8 a, bf16x8 b, f32x4 c) { return __builtin_amdgcn_mfma_f32_16x16x32_bf16(a, b, c, 0, 0, 0); }

namespace pg8 {
constexpr int BM = 256, BK = 64, HALF = 128, HTB = HALF * BK * 2, STAGE_BYTES = 8 * HTB, NXCD = 8, WGM = 8;
__host__ __device__ __forceinline__ int lds_byte(int r, int c) { const int st = (r >> 4) * 2 + (c >> 5), rr = r & 15, cc = c & 31, ob = rr * 64 + cc * 2; return st * 1024 + (ob ^ (((ob >> 9) & 1) << 5)); }
__host__ __device__ __forceinline__ void stage_rc(int b, int& R, int& C) { const int st = b / 1024, sb = b % 1024, swz = sb ^ (((sb >> 9) & 1) << 5); R = (st >> 1) * 16 + swz / 64; C = (st & 1) * 32 + (swz % 64) / 2; }
struct Unit { int pm, pn, ui, ri, tag, K; const char* A; const char* Bt; };
struct Gemm { const bf16_t* A; const bf16_t* Bt; int M, N, K; };
struct StaticOrder {
    int nM, nN, nwg, G, c; Gemm g;
    __host__ __device__ void init(int M, int N, int G_, int c_) { nM = M / BM; nN = N / BM; nwg = nM * nN; G = G_; c = c_; g.A = nullptr; g.Bt = nullptr; g.M = M; g.N = N; g.K = 0; }
    __host__ __device__ void set(const Gemm& g_) { g = g_; }
    __host__ __device__ bool tile(int i, int& pm, int& pn) const {
        const long L = (long)i * G + c; if (L >= nwg) return false;
        int wgid = (int)L; { const int q = nwg / NXCD, r = nwg % NXCD, xcd = wgid % NXCD, off = wgid / NXCD; wgid = (xcd < r ? xcd * (q + 1) : r * (q + 1) + (xcd - r) * q) + off; }
        const int nig = WGM * nN, gid = wgid / nig, fm = gid * WGM, gsz = (nM - fm) < WGM ? (nM - fm) : WGM;
        pm = fm + ((wgid % nig) % gsz); pn = (wgid % nig) / gsz; return true;
    }
    __host__ __device__ bool next(int i, Unit& u) const {
        if (!tile(i, u.pm, u.pn)) return false;
        u.ui = i; u.ri = i; u.tag = 0; u.K = g.K;
        u.A = (const char*)g.A + (size_t)u.pm * 256 * g.K * 2; u.Bt = (const char*)g.Bt + (size_t)u.pn * 256 * g.K * 2; return true;
    }
};
struct NoHook { __device__ __forceinline__ void wait() const {} };
template <class Epi, class Sched, class Hook = NoHook>
__device__ __forceinline__ void gemm_phase(LAS unsigned char* lds, const Sched& S, const Epi& E, const Hook& H = Hook{}) {
    const int tid = opaque_tid(), wid = __builtin_amdgcn_readfirstlane(tid >> 6), lane = tid & 63, wr = wid >> 2, wc = wid & 3, fr = lane & 15, fq = lane >> 4;
    unsigned R2[2], C2[2];
#pragma unroll
    for (int i = 0; i < 2; ++i) { int R, C; stage_rc(tid * 16 + i * 8192, R, C); R2[i] = (unsigned)R * 2u; C2[i] = (unsigned)C * 2u; }
    const size_t kstep = (size_t)(BK * 2);
    const unsigned ldsw = (unsigned)wid * 1024u;
    const int aoff = lds_byte(wr * 64 + fr, fq * 8), boff = lds_byte(wc * 32 + fr, fq * 8);
#define PG8_SA(b, h) (((b) * 2 + (h)) * HTB)
#define PG8_SB(b, h) ((4 + (b) * 2 + (h)) * HTB)
#define PG8_STAGE(bufoff, gbase, voff) do { _Pragma("unroll") for (int _i = 0; _i < 2; ++_i) \
        __builtin_amdgcn_global_load_lds((const unsigned*)((const char*)(gbase) + (voff)[_i]), (LAS unsigned*)(lds + (bufoff) + ldsw + _i * 8192), 16, 0, 0); } while (0)
#define PG8_LDA(dst, b, h) do { _Pragma("unroll") for (int m = 0; m < 4; ++m) _Pragma("unroll") for (int k = 0; k < 2; ++k) dst[m][k] = *(const LAS bf16x8*)(lds + PG8_SA(b, h) + aoff + m * 2048 + k * 1024); } while (0)
#define PG8_LDB(dst, b, h) do { _Pragma("unroll") for (int n = 0; n < 2; ++n) _Pragma("unroll") for (int k = 0; k < 2; ++k) dst[n][k] = *(const LAS bf16x8*)(lds + PG8_SB(b, h) + boff + n * 2048 + k * 1024); } while (0)
#define PG8_MMA(ai, bj, At, Bt) do { __builtin_amdgcn_s_setprio(1); _Pragma("unroll") for (int m = 0; m < 4; ++m) _Pragma("unroll") for (int n = 0; n < 2; ++n) _Pragma("unroll") for (int k = 0; k < 2; ++k) \
        acc[ai][bj][m][n] = __builtin_amdgcn_mfma_f32_16x16x32_bf16(Bt[n][k], At[m][k], acc[ai][bj][m][n], 0, 0, 0); __builtin_amdgcn_s_setprio(0); } while (0)
#define PG8_WAIT_V(n) asm volatile("s_waitcnt vmcnt(" #n ")" ::: "memory")
#define PG8_WAIT_L(n) asm volatile("s_waitcnt lgkmcnt(" #n ")" ::: "memory")
#define PG8_BAR __builtin_amdgcn_s_barrier()
#define PG8_SCHED __builtin_amdgcn_sched_barrier(0)
    Unit cur, nxt; int ui = 0;
    if (!S.next(0, cur)) return;
    f32x4 acc[2][2][4][2];
#pragma unroll
    for (int a = 0; a < 2; ++a)
#pragma unroll
        for (int b = 0; b < 2; ++b)
#pragma unroll
            for (int m = 0; m < 4; ++m)
#pragma unroll
                for (int n = 0; n < 2; ++n) acc[a][b][m][n] = (f32x4){0.f, 0.f, 0.f, 0.f};
    bf16x8 At[4][2], B0[2][2], B1[2][2];
    const char* cA = cur.A; const char* cB = cur.Bt;
    unsigned vo[2] = {R2[0] * (unsigned)cur.K + C2[0], R2[1] * (unsigned)cur.K + C2[1]};
    size_t hstep = (size_t)HALF * cur.K * 2;
    PG8_STAGE(PG8_SB(0, 0), cB, vo); PG8_STAGE(PG8_SB(0, 1), cB + hstep, vo); PG8_STAGE(PG8_SA(0, 0), cA, vo); PG8_STAGE(PG8_SA(0, 1), cA + hstep, vo);
    if (wr == 1) PG8_BAR;
    PG8_WAIT_V(2); PG8_BAR;
    PG8_STAGE(PG8_SB(1, 0), cB + kstep, vo); PG8_STAGE(PG8_SA(1, 0), cA + kstep, vo); PG8_STAGE(PG8_SB(1, 1), cB + hstep + kstep, vo);
    PG8_WAIT_V(6); PG8_BAR;
    for (;;) {
        const bool has_next = S.next(ui + 1, nxt);
        if (!has_next) nxt = cur;
        const char* nA = nxt.A; const char* nB = nxt.Bt;
        const unsigned voN0 = R2[0] * (unsigned)nxt.K + C2[0], voN1 = R2[1] * (unsigned)nxt.K + C2[1]; const size_t hstepN = (size_t)HALF * nxt.K * 2;
        const int nt = cur.K / BK;
        for (int t = 0; t < nt; t += 2) {
            const bool last = (t == nt - 2);
            const char* a1 = cA + (size_t)(t + 1) * kstep;
            const char* a2 = last ? nA : cA + (size_t)(t + 2) * kstep; const char* b2 = last ? nB : cB + (size_t)(t + 2) * kstep;
            const char* a3 = a2 + kstep; const char* b3 = b2 + kstep;
            const unsigned v2[2] = {last ? voN0 : vo[0], last ? voN1 : vo[1]}; const size_t h2 = last ? hstepN : hstep;
            PG8_LDB(B0, 0, 0); PG8_LDB(B1, 0, 1); PG8_SCHED; PG8_LDA(At, 0, 0); PG8_STAGE(PG8_SA(1, 1), a1 + hstep, vo);
            PG8_WAIT_V(8); PG8_WAIT_L(0); PG8_BAR; PG8_MMA(0, 0, At, B0); PG8_MMA(0, 1, At, B1); PG8_BAR; PG8_SCHED;
            PG8_LDA(At, 0, 1); PG8_STAGE(PG8_SB(0, 0), b2, v2); PG8_STAGE(PG8_SB(0, 1), b2 + h2, v2); PG8_STAGE(PG8_SA(0, 0), a2, v2);
            PG8_WAIT_V(8); PG8_WAIT_L(0); PG8_BAR; PG8_MMA(1, 0, At, B0); PG8_MMA(1, 1, At, B1); PG8_BAR; PG8_SCHED;
            PG8_LDB(B0, 1, 0); PG8_LDB(B1, 1, 1); PG8_SCHED; PG8_LDA(At, 1, 0); PG8_STAGE(PG8_SA(0, 1), a2 + h2, v2);
            PG8_WAIT_V(8); PG8_WAIT_L(0); PG8_BAR; PG8_MMA(0, 0, At, B0); PG8_MMA(0, 1, At, B1); PG8_BAR; PG8_SCHED;
            PG8_LDA(At, 1, 1); PG8_STAGE(PG8_SB(1, 0), b3, v2); PG8_STAGE(PG8_SB(1, 1), b3 + h2, v2); PG8_STAGE(PG8_SA(1, 0), a3, v2);
            PG8_WAIT_V(8); PG8_WAIT_L(0); PG8_BAR; PG8_MMA(1, 0, At, B0); PG8_MMA(1, 1, At, B1); PG8_BAR; PG8_SCHED;
        }
        if (wr == 0) PG8_BAR;
        if (ui == 0 && (!Epi::AFTER_DRAIN || has_next)) H.wait();
        if (!Epi::AFTER_DRAIN || has_next) { int fr2 = fr, fq2 = fq; asm volatile("" : "+v"(fr2), "+v"(fq2)); E(acc, cur, wr, wc, fr2, fq2); }
        if (!has_next) break;
#pragma unroll
        for (int a = 0; a < 2; ++a)
#pragma unroll
            for (int b = 0; b < 2; ++b)
#pragma unroll
                for (int m = 0; m < 4; ++m)
#pragma unroll
                    for (int n = 0; n < 2; ++n) acc[a][b][m][n] = (f32x4){0.f, 0.f, 0.f, 0.f};
        cur = nxt; cA = nA; cB = nB; vo[0] = voN0; vo[1] = voN1; hstep = hstepN; ++ui;
        if (wr == 1) PG8_BAR;
    }
    PG8_WAIT_V(0);
    PG8_BAR;
    if constexpr (Epi::AFTER_DRAIN) { if (ui == 0) H.wait(); }
    if constexpr (Epi::AFTER_DRAIN) { int fr2 = fr, fq2 = fq; asm volatile("" : "+v"(fr2), "+v"(fq2)); E.fused(acc, cur, wr, wc, fr2, fq2, lds); }
#undef PG8_SA
#undef PG8_SB
#undef PG8_STAGE
#undef PG8_LDA
#undef PG8_LDB
#undef PG8_MMA
#undef PG8_WAIT_V
#undef PG8_WAIT_L
#undef PG8_BAR
#undef PG8_SCHED
}
}

__device__ __forceinline__ float wave_sum(float v);
#define ACC_ARG const f32x4 (&acc)[2][2][4][2]
#define EPI_FENCE() asm volatile("" ::: "memory")
constexpr int RTAB_OFF = RING_BYTES + 1024;
__device__ __forceinline__ void prep_rs(const float* ssq, int row_off, const pg8::StaticOrder& S, LAS unsigned char* lds) {
    const int tid = opaque_tid(); LAS float* rtab = (LAS float*)(lds + RTAB_OFF); pg8::Unit u;
    for (int i = 0; i < 6 && S.next(i, u); ++i) if (tid < 256) rtab[i * 256 + tid] = row_rs(ssq, row_off + u.pm * 256 + tid);
    __syncthreads();
}
struct EpiSwiglu {
    static constexpr bool AFTER_DRAIN = false;
    bf16_t* O; const LAS float* rtab;
    __device__ __forceinline__ void operator()(ACC_ARG, const pg8::Unit& u, int wr, int wc, int fr, int fq) const {
        const int lr0 = wr * 64 + fr, col0 = u.pn * 128 + wc * 32 + 8 * fq;
#pragma unroll
        for (int ai = 0; ai < 2; ++ai)
#pragma unroll
            for (int m = 0; m < 4; ++m) {
                const int lr = lr0 + ai * 128 + m * 16;
                const float rs = rtab ? rtab[u.ri * 256 + lr] : 1.0f;
                u32x4 w;
#pragma unroll
                for (int n = 0; n < 2; ++n) {
                    const f32x4 gt = acc[ai][0][m][n] * rs, up = acc[ai][1][m][n] * rs; f32x4 v;
#pragma unroll
                    for (int j = 0; j < 4; ++j) v[j] = siluf(gt[j]) * up[j];
                    const u32x2 p = pack4(v); if (n == 0) { w.x = p.x; w.y = p.y; } else { w.z = p.x; w.w = p.y; }
                }
                *(u32x4*)(O + (size_t)(u.pm * 256 + lr) * DFF + col0) = w;
            }
    }
};
template <bool BB, bool OF>
struct EpiResid {
    static constexpr bool AFTER_DRAIN = true;
    const void* base; float* out; bf16_t* xb; float* ssq; float scale; int skip;
    __device__ __forceinline__ f32x4 ldb(size_t off) const {
        if (BB) { const u32x2 w = __builtin_nontemporal_load((const u32x2*)((const bf16_t*)base + off));
                  return (f32x4){__uint_as_float(w.x << 16), __uint_as_float(w.x & 0xffff0000u), __uint_as_float(w.y << 16), __uint_as_float(w.y & 0xffff0000u)}; }
        return __builtin_nontemporal_load((const f32x4*)((const float*)base + off));
    }
    __device__ __forceinline__ void operator()(ACC_ARG, const pg8::Unit& u, int wr, int wc, int fr, int fq) const {
        if (skip) return;
        const int row0 = u.pm * 256 + wr * 64 + fr, col0 = u.pn * 256 + wc * 32 + 4 * fq;
#pragma unroll
        for (int ai = 0; ai < 2; ++ai)
#pragma unroll
            for (int m = 0; m < 4; ++m) {
                const int row = row0 + ai * 128 + m * 16; float ss = 0.f;
#pragma unroll
                for (int bj = 0; bj < 2; ++bj)
#pragma unroll
                    for (int n = 0; n < 2; ++n) {
                        const size_t off = (size_t)row * DM + col0 + bj * 128 + n * 16;
                        const f32x4 v = ldb(off) + acc[ai][bj][m][n] * scale;
                        if (OF) *(f32x4*)(out + off) = v; else *(u32x2*)(xb + off) = pack4(v);
                        ss += (v[0] * v[0] + v[1] * v[1]) + (v[2] * v[2] + v[3] * v[3]);
                    }
                if (!OF) { ss += __shfl_xor(ss, 16); ss += __shfl_xor(ss, 32); if (fq == 0) atomicAdd(ssq + (size_t)row * 4 + u.pn, ss); }
            }
    }
    __device__ __forceinline__ void fused(ACC_ARG, const pg8::Unit& u, int wr, int wc, int fr, int fq, LAS unsigned char* lds) const {
        if (skip) return;
        const int tid = opaque_tid(), lane = tid & 63, wave = __builtin_amdgcn_readfirstlane(tid >> 6);
        LAS float* tl = (LAS float*)lds;
#pragma unroll
        for (int ai = 0; ai < 2; ++ai)
#pragma unroll
            for (int wq = 0; wq < 2; ++wq) {
                if (wr == wq) {
#pragma unroll
                    for (int m = 0; m < 4; ++m)
#pragma unroll
                        for (int bj = 0; bj < 2; ++bj)
#pragma unroll
                            for (int n = 0; n < 2; ++n) *(LAS f32x4*)(tl + (16 * m + fr) * 260 + bj * 128 + wc * 32 + n * 16 + 4 * fq) = acc[ai][bj][m][n] * scale;
                }
                __syncthreads();
                const int rbase = u.pm * 256 + ai * 128 + wq * 64;
                f32x4 bv[8];
#pragma unroll
                for (int r = 0; r < 8; ++r) bv[r] = ldb((size_t)(rbase + wave * 8 + r) * DM + u.pn * 256 + lane * 4);
#pragma unroll
                for (int r = 0; r < 8; ++r) {
                    const int row = rbase + wave * 8 + r; const size_t off = (size_t)row * DM + u.pn * 256 + lane * 4;
                    const f32x4 v = bv[r] + *(const LAS f32x4*)(tl + (wave * 8 + r) * 260 + lane * 4);
                    if (OF) __builtin_nontemporal_store(v, (f32x4*)(out + off));
                    else {
                        *(u32x2*)(xb + off) = pack4(v);
                        const float ss = wave_sum((v[0] * v[0] + v[1] * v[1]) + (v[2] * v[2] + v[3] * v[3])); if (lane == 0) ssq[(size_t)row * 4 + u.pn] = ss;
                    }
                }
                __syncthreads();
            }
    }
};
struct EpiPlain {
    static constexpr bool AFTER_DRAIN = false;
    bf16_t* O; int ldo;
    __device__ __forceinline__ void operator()(ACC_ARG, const pg8::Unit& u, int wr, int wc, int fr, int fq) const {
        const int row0 = u.pm * 256 + wr * 64 + fr, col0 = u.pn * 256 + wc * 32 + 4 * fq;
#pragma unroll
        for (int ai = 0; ai < 2; ++ai)
#pragma unroll
            for (int m = 0; m < 4; ++m)
#pragma unroll
                for (int bj = 0; bj < 2; ++bj)
#pragma unroll
                    for (int n = 0; n < 2; ++n) *(u32x2*)(O + (size_t)(row0 + ai * 128 + m * 16) * ldo + col0 + bj * 128 + n * 16) = pack4(acc[ai][bj][m][n]);
    }
};
struct EpiMix {
    static constexpr bool AFTER_DRAIN = true;
    const LAS float* rtab; const float* rot;
    unsigned char* ws  ; bf16_t* mqb  ; const float *gdq, *gdk;
    static constexpr int TLD = 136;
    __device__ __forceinline__ void flushT(bf16_t* dst  , const LAS bf16_t* TS) const {
        const int tid = opaque_tid();
#pragma unroll
        for (int i = 0; i < 8; ++i) { const int p = tid + 512 * i, c = p >> 4, r8 = p & 15; *(u32x4*)(dst + (size_t)c * SEQ + r8 * 8) = *(const LAS u32x4*)(TS + c * TLD + r8 * 8); }
    }
    __device__ __forceinline__ void operator()(ACC_ARG, const pg8::Unit& u, int wr, int wc, int fr, int fq) const { body(acc, u, wr, wc, fr, fq, nullptr); }
    __device__ __forceinline__ void fused(ACC_ARG, const pg8::Unit& u, int wr, int wc, int fr, int fq, LAS unsigned char* lds) const {
        if (u.pn >= 4 && u.pn < 16) body(acc, u, wr, wc, fr, fq, (LAS bf16_t*)lds); else body(acc, u, wr, wc, fr, fq, nullptr);
    }
    __device__ __forceinline__ void body(ACC_ARG, const pg8::Unit& u, int wr, int wc, int fr, int fq, LAS bf16_t* TS) const {
        const int pn = u.pn, lr0 = wr * 64 + fr, lrow0 = u.pm * 256 + lr0;
        if (pn < 8) {
            const bool isk = pn >= 4; const int h = pn & 3; bf16_t* dst = (bf16_t*)(ws + (isk ? WS_K : WS_Q)); bf16_t* kts = (bf16_t*)(ws + WS_KTS);
            const float lg2 = log2f(1.0f - __builtin_amdgcn_exp2f(-5.0f - (float)h));
#pragma unroll
            for (int ai = 0; ai < 2; ++ai) {
                f32x4 cs0[4][2], cs1[4][2];
#pragma unroll
                for (int m = 0; m < 4; ++m)
#pragma unroll
                    for (int n = 0; n < 2; ++n) { const f32x4* cs = (const f32x4*)(rot + ((size_t)(lrow0 + ai * 128 + m * 16) * 128 + wc * 32 + 8 * fq + 4 * n) * 2); cs0[m][n] = cs[0]; cs1[m][n] = cs[1]; }
                EPI_FENCE();
#pragma unroll
                for (int m = 0; m < 4; ++m) {
                    int lrow = lrow0 + ai * 128 + m * 16; asm volatile("" : "+v"(lrow));
                    const float rs = rtab[u.ri * 256 + lr0 + ai * 128 + m * 16] * (isk ? 0.0625f : 1.0f);
                    const float dec = __builtin_amdgcn_exp2f(lg2 * (float)(127 - (lrow & 127)));
#pragma unroll
                    for (int n = 0; n < 2; ++n) {
                        const int i0 = wc * 32 + 8 * fq + 4 * n;
                        const f32x4 c01 = cs0[m][n], c23 = cs1[m][n];
                        const f32x4 cv = (f32x4){c01[0], c01[2], c23[0], c23[2]}, sv = (f32x4){c01[1], c01[3], c23[1], c23[3]};
                        const f32x4 x1 = acc[ai][0][m][n] * rs, x2 = acc[ai][1][m][n] * rs;
                        const f32x4 o1 = x1 * cv - x2 * sv, o2 = x1 * sv + x2 * cv;
                        *(u32x2*)(dst + (size_t)lrow * 1024 + h * 256 + i0) = pack4(o1);
                        *(u32x2*)(dst + (size_t)lrow * 1024 + h * 256 + 128 + i0) = pack4(o2);
                        if (isk) {
                            if (TS) {
                                const int rl = wr * 64 + m * 16 + fr;
#pragma unroll
                                for (int j = 0; j < 4; ++j) { TS[(i0 + j) * TLD + rl] = bf16_1(o1[j] * dec); TS[(128 + i0 + j) * TLD + rl] = bf16_1(o2[j] * dec); }
                            } else {
#pragma unroll
                                for (int j = 0; j < 4; ++j) {
                                    kts[(size_t)(h * 256 + i0 + j) * SEQ + lrow] = bf16_1(o1[j] * dec);
                                    kts[(size_t)(h * 256 + 128 + i0 + j) * SEQ + lrow] = bf16_1(o2[j] * dec);
                                }
                            }
                        }
                    }
                }
                EPI_FENCE();
                if (isk && TS) { __syncthreads(); flushT(kts + (size_t)(h * 256) * SEQ + u.pm * 256 + ai * 128, TS); __syncthreads(); }
            }
        } else if (pn < 16) {
            const int h = (pn - 8) >> 1, e0 = ((pn - 8) & 1) * 256; bf16_t* vt = (bf16_t*)(ws + WS_VT);
#pragma unroll
            for (int ai = 0; ai < 2; ++ai) {
#pragma unroll
                for (int m = 0; m < 4; ++m) {
                    int lrow = lrow0 + ai * 128 + m * 16; asm volatile("" : "+v"(lrow));
                    const float rs = rtab[u.ri * 256 + lr0 + ai * 128 + m * 16];
#pragma unroll
                    for (int bj = 0; bj < 2; ++bj)
#pragma unroll
                        for (int n = 0; n < 2; ++n) {
                            const int tc = bj * 128 + wc * 32 + 8 * fq + 4 * n, ec = e0 + tc; const f32x4 v = acc[ai][bj][m][n] * rs;
                            if (TS) {
                                const int rl = wr * 64 + m * 16 + fr;
#pragma unroll
                                for (int j = 0; j < 4; ++j) TS[(tc + j) * TLD + rl] = bf16_1(v[j]);
                            } else {
#pragma unroll
                                for (int j = 0; j < 4; ++j) vt[(size_t)(h * 512 + ec + j) * SEQ + lrow] = bf16_1(v[j]);
                            }
                        }
                    EPI_FENCE();
                }
                if (TS) { __syncthreads(); flushT(vt + (size_t)(h * 512 + e0) * SEQ + u.pm * 256 + ai * 128, TS); __syncthreads(); }
            }
        } else if (pn < 24) {
            const bool isk = pn >= 20; const int tile = (pn - 16) & 3; bf16_t* dst = (bf16_t*)(ws + (isk ? WS_DK : WS_DQ)); const float* gn = isk ? gdk : gdq; const float mul = isk ? 1.0f : C2Q;
            f32x4 gv[2][2];
#pragma unroll
            for (int bj = 0; bj < 2; ++bj)
#pragma unroll
                for (int n = 0; n < 2; ++n) gv[bj][n] = *(const f32x4*)(gn + 32 * bj + 8 * fq + 4 * n);
#pragma unroll
            for (int ai = 0; ai < 2; ++ai)
#pragma unroll
                for (int m = 0; m < 4; ++m) {
                    int lrow = lrow0 + ai * 128 + m * 16; asm volatile("" : "+v"(lrow));
                    const float rs = rtab[u.ri * 256 + lr0 + ai * 128 + m * 16];
                    f32x4 v[2][2]; float ss = 0.f;
#pragma unroll
                    for (int bj = 0; bj < 2; ++bj)
#pragma unroll
                        for (int n = 0; n < 2; ++n) { v[bj][n] = acc[ai][bj][m][n] * rs; const f32x4 t = v[bj][n]; ss += (t[0] * t[0] + t[1] * t[1]) + (t[2] * t[2] + t[3] * t[3]); }
                    ss += __shfl_xor(ss, 16); ss += __shfl_xor(ss, 32);
                    const float rn = __builtin_amdgcn_rsqf(ss * (1.0f / 64.0f) + EPS) * mul;
#pragma unroll
                    for (int bj = 0; bj < 2; ++bj) { const u32x2 p0 = pack4(v[bj][0] * rn * gv[bj][0]), p1 = pack4(v[bj][1] * rn * gv[bj][1]);
                        *(u32x4*)(dst + (size_t)lrow * 1024 + tile * 256 + 64 * wc + 32 * bj + 8 * fq) = (u32x4){p0.x, p0.y, p1.x, p1.y}; }
                    EPI_FENCE();
                }
        } else {
            bf16_t* dst = pn < 28 ? (bf16_t*)(ws + WS_DV) : mqb; const int tile = (pn - 24) & 3;
#pragma unroll
            for (int ai = 0; ai < 2; ++ai)
#pragma unroll
                for (int m = 0; m < 4; ++m) {
                    int lrow = lrow0 + ai * 128 + m * 16; asm volatile("" : "+v"(lrow));
                    const float rs = rtab[u.ri * 256 + lr0 + ai * 128 + m * 16];
#pragma unroll
                    for (int bj = 0; bj < 2; ++bj) { const u32x2 p0 = pack4(acc[ai][bj][m][0] * rs), p1 = pack4(acc[ai][bj][m][1] * rs);
                        *(u32x4*)(dst + (size_t)lrow * 1024 + tile * 256 + bj * 128 + wc * 32 + 8 * fq) = (u32x4){p0.x, p0.y, p1.x, p1.y}; }
                    EPI_FENCE();
                }
        }
    }
};
struct EpiRgG {
    static constexpr bool AFTER_DRAIN = false;
    const LAS float* rtab; bf16_t* ret; const float* rssq; unsigned char* ws;
    __device__ __forceinline__ void operator()(ACC_ARG, const pg8::Unit& u, int wr, int wc, int fr, int fq) const {
        const int lr0 = wr * 64 + fr;
        if (u.pn < 8) {
            const int col0 = u.pn * 256 + wc * 32 + 8 * fq;
#pragma unroll
            for (int ai = 0; ai < 2; ++ai) {
                u32x4 rv[4][2]; f32x2 rq2[4];
#pragma unroll
                for (int m = 0; m < 4; ++m) { const int lr = lr0 + ai * 128 + m * 16;
                    rq2[m] = *(const f32x2*)(rssq + (size_t)(u.pm * 256 + lr) * 8 + 2 * (u.pn >> 1));
#pragma unroll
                    for (int bj = 0; bj < 2; ++bj) rv[m][bj] = *(const u32x4*)(ret + (size_t)(u.pm * 256 + lr) * 2048 + col0 + bj * 128); }
                EPI_FENCE();
#pragma unroll
                for (int m = 0; m < 4; ++m) {
                    const int lr = lr0 + ai * 128 + m * 16; const float rs = rtab[u.ri * 256 + lr];
                    const float rr = __builtin_amdgcn_rsqf((rq2[m][0] + rq2[m][1]) * (1.0f / 512.0f) + EPS);
#pragma unroll
                    for (int bj = 0; bj < 2; ++bj) {
                        u32x4 o;
#pragma unroll
                        for (int n = 0; n < 2; ++n) {
                            const unsigned w0 = n == 0 ? rv[m][bj].x : rv[m][bj].z, w1 = n == 0 ? rv[m][bj].y : rv[m][bj].w; const f32x4 a = acc[ai][bj][m][n] * rs; f32x4 v;
                            v[0] = __uint_as_float(w0 << 16) * siluf(a[0]); v[1] = __uint_as_float(w0 & 0xffff0000u) * siluf(a[1]);
                            v[2] = __uint_as_float(w1 << 16) * siluf(a[2]); v[3] = __uint_as_float(w1 & 0xffff0000u) * siluf(a[3]);
                            const u32x2 p = pack4(v * rr); if (n == 0) { o.x = p.x; o.y = p.y; } else { o.z = p.x; o.w = p.y; }
                        }
                        *(u32x4*)(ret + (size_t)(u.pm * 256 + lr) * 2048 + col0 + bj * 128) = o;
                    }
                }
                EPI_FENCE();
            }
        } else {
            const int br = (u.pn - 8) >> 2, col0 = ((u.pn - 8) & 3) * 256 + wc * 32 + 8 * fq;
            unsigned char* g8 = ws + (br == 0 ? WS_G8A : br == 1 ? WS_G8B : WS_G8C);
#pragma unroll
            for (int ai = 0; ai < 2; ++ai)
#pragma unroll
                for (int m = 0; m < 4; ++m) {
                    const int lr = lr0 + ai * 128 + m * 16; const float rs = rtab[u.ri * 256 + lr];
#pragma unroll
                    for (int bj = 0; bj < 2; ++bj) {
                        u32x2 w2;
#pragma unroll
                        for (int n = 0; n < 2; ++n) {
                            const f32x4 a = acc[ai][bj][m][n] * rs; unsigned w = 0u;
#pragma unroll
                            for (int j = 0; j < 4; ++j) w |= (unsigned)__builtin_rintf(255.0f * sigmf(a[j])) << (8 * j);
                            if (n == 0) w2.x = w; else w2.y = w;
                        }
                        *(u32x2*)(g8 + (size_t)(u.pm * 256 + lr) * DM + col0 + bj * 128) = w2;
                    }
                }
        }
    }
};
struct EpiTerm3 {
    static constexpr bool AFTER_DRAIN = false;
    unsigned char* ws; bf16_t* y;
    __device__ __forceinline__ void operator()(ACC_ARG, const pg8::Unit& u, int wr, int wc, int fr, int fq) const {
        const int lr0 = wr * 64 + fr, col0 = u.pn * 256 + wc * 32 + 8 * fq, first = (u.tag == 0);
        const unsigned char* g8 = ws + (u.tag == 0 ? WS_G8A : u.tag == 1 ? WS_G8B : WS_G8C);
#pragma unroll
        for (int ai = 0; ai < 2; ++ai) {
            u32x2 gv[4][2]; u32x4 yv[4][2];
#pragma unroll
            for (int m = 0; m < 4; ++m)
#pragma unroll
                for (int bj = 0; bj < 2; ++bj) { const size_t off = (size_t)(u.pm * 256 + lr0 + ai * 128 + m * 16) * DM + col0 + bj * 128;
                    gv[m][bj] = *(const u32x2*)(g8 + off); yv[m][bj] = first ? (u32x4){0u, 0u, 0u, 0u} : *(const u32x4*)(y + off); }
            EPI_FENCE();
#pragma unroll
            for (int m = 0; m < 4; ++m)
#pragma unroll
                for (int bj = 0; bj < 2; ++bj) {
                    const size_t off = (size_t)(u.pm * 256 + lr0 + ai * 128 + m * 16) * DM + col0 + bj * 128;
                    u32x4 o;
#pragma unroll
                    for (int n = 0; n < 2; ++n) {
                        const f32x4 a = acc[ai][bj][m][n]; const unsigned gw = n == 0 ? gv[m][bj].x : gv[m][bj].y; const unsigned w0 = n == 0 ? yv[m][bj].x : yv[m][bj].z, w1 = n == 0 ? yv[m][bj].y : yv[m][bj].w; f32x4 v;
                        v[0] = (float)(gw & 255u) * (1.0f / 255.0f) * a[0] + __uint_as_float(w0 << 16); v[1] = (float)((gw >> 8) & 255u) * (1.0f / 255.0f) * a[1] + __uint_as_float(w0 & 0xffff0000u);
                        v[2] = (float)((gw >> 16) & 255u) * (1.0f / 255.0f) * a[2] + __uint_as_float(w1 << 16); v[3] = (float)(gw >> 24) * (1.0f / 255.0f) * a[3] + __uint_as_float(w1 & 0xffff0000u);
                        const u32x2 p = pack4(v); if (n == 0) { o.x = p.x; o.y = p.y; } else { o.z = p.x; o.w = p.y; }
                    }
                    *(u32x4*)(y + off) = o;
                }
            EPI_FENCE();
        }
    }
};

#include <hip/hip_bf16.h>
namespace attn_body {
using bf16=__hip_bfloat16;
using bf16x8=__attribute__((ext_vector_type(8)))short;
using s16x4=__attribute__((ext_vector_type(4)))short;
using f32x16=__attribute__((ext_vector_type(16)))float;
using u32x4=__attribute__((ext_vector_type(4)))unsigned;
constexpr int D=64,DM=1024;
constexpr int NW=8,QBLK=32,QB=QBLK*NW,KVBLK=64;
__device__ __forceinline__ int crow(int r,int hi){return (r&3)+8*(r>>2)+4*hi;}
#define SBAR() __builtin_amdgcn_sched_barrier(0)
__device__ __forceinline__ void cmask(f32x16&p0,f32x16&p1,int jb,int qrel,int hi){
  const float NEG=-INFINITY; int kb=64*jb+4*hi;
  #pragma unroll
  for(int r=0;r<16;++r){int kv=kb+(r&3)+8*(r>>2); if(kv>qrel)p0[r]=NEG; if(kv+32>qrel)p1[r]=NEG;}
}
constexpr int NSLOT=3, SLOTB=8192;
constexpr int LDS_K=0, LDS_V=NSLOT*SLOTB, LDS_WS=LDS_V+2*NSLOT*SLOTB, LDS_OST=LDS_WS+NW*64*4, LDS_BYTES=LDS_OST+NW*4096;
__device__ __forceinline__ void glds16(const void*gsrc,unsigned lds_dst){unsigned keep;
  asm volatile("s_mov_b32 %0, m0\n\ts_mov_b32 m0, %2\n\ts_nop 0\n\tglobal_load_lds_dwordx4 %1, off\n\ts_mov_b32 m0, %0":"=&s"(keep):"v"(gsrc),"s"(lds_dst):"memory");}
__device__ __forceinline__ float max3f(float a,float b,float c){float r;asm("v_max3_f32 %0, %1, %2, %3":"=v"(r):"v"(a),"v"(b),"v"(c));return r;}
__device__ __forceinline__ float max2f(float a,float b){float r;asm("v_max_f32_e32 %0, %1, %2":"=v"(r):"v"(a),"v"(b));return r;}
__device__ __forceinline__ float fadd_s(float a,float b){float r;asm("v_add_f32_e32 %0, %1, %2":"=v"(r):"v"(a),"v"(b));return r;}
__device__ __forceinline__ float fsub_s(float a,float b){float r;asm("v_sub_f32_e32 %0, %1, %2":"=v"(r):"v"(a),"v"(b));return r;}
typedef float f32x2_t __attribute__((ext_vector_type(2))); typedef __bf16 bf16x2_t __attribute__((ext_vector_type(2)));
__device__ __forceinline__ unsigned cvtpk_s(float lo,float hi){f32x2_t v={lo,hi};bf16x2_t b=__builtin_convertvector(v,bf16x2_t);return __builtin_bit_cast(unsigned,b);}
#define WAIT_BAR(N) asm volatile("s_waitcnt vmcnt(" #N ") lgkmcnt(0)\n\ts_barrier":::"memory")
__device__ __forceinline__ void qkt(f32x16&p0,f32x16&p1,const char*Kslot,const bf16x8*qr,const f32x16&negm,int r32,int hi){
  const char*kb=Kslot+hi*1024+r32*16;
  #pragma unroll
  for(int d0=0;d0<4;++d0){
    const bf16x8 b0=*reinterpret_cast<const bf16x8*>(kb+d0*2048);
    const bf16x8 b1=*reinterpret_cast<const bf16x8*>(kb+d0*2048+512);
    if(d0==0){p0=__builtin_amdgcn_mfma_f32_32x32x16_bf16(b0,qr[0],negm,0,0,0);p1=__builtin_amdgcn_mfma_f32_32x32x16_bf16(b1,qr[0],negm,0,0,0);}
    else{p0=__builtin_amdgcn_mfma_f32_32x32x16_bf16(b0,qr[d0],p0,0,0,0);p1=__builtin_amdgcn_mfma_f32_32x32x16_bf16(b1,qr[d0],p1,0,0,0);}}
}
typedef __attribute__((address_space(3))) const char* lds_cptr;
typedef short v4i16_t __attribute__((ext_vector_type(4)));
__device__ __forceinline__ void kload8(bf16x8*kf,lds_cptr kp){
  kf[0]=*(const __attribute__((address_space(3))) bf16x8*)(kp);      kf[1]=*(const __attribute__((address_space(3))) bf16x8*)(kp+512);
  kf[2]=*(const __attribute__((address_space(3))) bf16x8*)(kp+2048); kf[3]=*(const __attribute__((address_space(3))) bf16x8*)(kp+2560);
  kf[4]=*(const __attribute__((address_space(3))) bf16x8*)(kp+4096); kf[5]=*(const __attribute__((address_space(3))) bf16x8*)(kp+4608);
  kf[6]=*(const __attribute__((address_space(3))) bf16x8*)(kp+6144); kf[7]=*(const __attribute__((address_space(3))) bf16x8*)(kp+6656);
}
__device__ __forceinline__ void kload2(bf16x8*kf,lds_cptr kp,int j){ kf[2*j]=*(const __attribute__((address_space(3))) bf16x8*)(kp+j*2048); kf[2*j+1]=*(const __attribute__((address_space(3))) bf16x8*)(kp+j*2048+512); }
__device__ __forceinline__ s16x4 vtr(lds_cptr p){ return __builtin_bit_cast(s16x4,__builtin_amdgcn_ds_read_tr16_b64_v4i16((__attribute__((address_space(3))) v4i16_t*)p)); }
__device__ __forceinline__ float rowmax(const f32x16&p0,const f32x16&p1){
  float a=max3f(p0[0],p0[1],p1[0]),b=max3f(p0[2],p0[3],p1[1]);a=max3f(a,p1[2],p1[3]);
  #pragma unroll
  for(int r=4;r<16;r+=4){a=max3f(a,p0[r],p0[r+1]);b=max3f(b,p0[r+2],p0[r+3]);a=max3f(a,p1[r],p1[r+1]);b=max3f(b,p1[r+2],p1[r+3]);}
  const float m=max2f(a,b);
  auto rr=__builtin_amdgcn_permlane32_swap(__float_as_uint(m),__float_as_uint(m),false,false);
  return max2f(__uint_as_float(rr[0]),__uint_as_float(rr[1]));
}
__device__ __forceinline__ void pv(f32x16*o,int vb,bf16x8 pa0,bf16x8 pa1,bf16x8 pa2,bf16x8 pa3){
  #pragma unroll
  for(int d0=0;d0<4;++d0){s16x4 lo[4],hi[4];
    #pragma unroll
    for(int ks=0;ks<4;++ks){
      asm volatile("ds_read_b64_tr_b16 %0,%1 offset:%c2":"=&v"(lo[ks]):"v"(vb),"i"(d0*4096+ks*1024):"memory");
      asm volatile("ds_read_b64_tr_b16 %0,%1 offset:%c2":"=&v"(hi[ks]):"v"(vb),"i"(d0*4096+ks*1024+512):"memory");}
    asm volatile("s_waitcnt lgkmcnt(0)":::"memory");SBAR();
    #define PK(k) (bf16x8){lo[k][0],lo[k][1],lo[k][2],lo[k][3],hi[k][0],hi[k][1],hi[k][2],hi[k][3]}
    o[d0]=__builtin_amdgcn_mfma_f32_32x32x16_bf16(pa0,PK(0),o[d0],0,0,0);
    o[d0]=__builtin_amdgcn_mfma_f32_32x32x16_bf16(pa1,PK(1),o[d0],0,0,0);
    o[d0]=__builtin_amdgcn_mfma_f32_32x32x16_bf16(pa2,PK(2),o[d0],0,0,0);
    o[d0]=__builtin_amdgcn_mfma_f32_32x32x16_bf16(pa3,PK(3),o[d0],0,0,0);
    #undef PK
  }
}
#define ATTN_STORE16(p,v) (*(u32x4*)(p)=(v))
template<int THRL> __device__ __forceinline__ void attn_unit(int hq,int hv,int qb,const bf16*Q,const bf16*__restrict__ K,const bf16*__restrict__ V,bf16*O,char*shm){
  const int tid=opaque_tid(),lane=tid&63,r32=lane&31,hi=lane>>5; const int wid=__builtin_amdgcn_readfirstlane(tid>>6);
  const int q0=qb*QB;
  const bf16*Qw=Q+(long)(q0+wid*QBLK)*DM+hq*D;
  const bf16*Kh=K+hq*D,*Vh=V+hv*128;
  const unsigned lds0=(unsigned)(uintptr_t)shm;
  float*wsf=(float*)(shm+LDS_WS)+wid*64;
  const bf16*ksrc=Kh+(long)lane*DM+wid*8;
  const bf16*vsrc=Vh+(long)(16*(wid&3)+(lane>>2))*DM+(wid>>2)*32+(lane&3)*8;
  const unsigned kdst=lds0+LDS_K+wid*1024, vdst=lds0+LDS_V+wid*1024;
  #define DMA_K(t,slot) glds16(ksrc+(long)(t)*KVBLK*DM,(unsigned)__builtin_amdgcn_readfirstlane(kdst+(slot)))
  #define DMA_V(t,slot) do{ glds16(vsrc+(long)(t)*KVBLK*DM,(unsigned)__builtin_amdgcn_readfirstlane(vdst+2*(slot))); glds16(vsrc+(long)(t)*KVBLK*DM+64,(unsigned)__builtin_amdgcn_readfirstlane(vdst+2*(slot)+8192)); }while(0)
  const int vb0=(int)(lds0+LDS_V)+((lane>>4)&1)*32+(lane&3)*8+(4*hi+((lane&15)>>2))*64;
  const char*Kbase=shm+LDS_K; bf16x8 kf[8];
  const lds_cptr shm3=(lds_cptr)shm; const lds_cptr kp0=shm3+LDS_K+hi*1024+r32*16; const lds_cptr vp0=shm3+LDS_V+((lane>>4)&1)*32+(lane&3)*8+(4*hi+((lane&15)>>2))*64;
  const int NT=(q0+QB)/KVBLK;
  DMA_K(0,0);DMA_V(0,0);DMA_K(1,SLOTB);
  bf16x8 qr[4];
  #pragma unroll
  for(int d0=0;d0<4;++d0)qr[d0]=*reinterpret_cast<const bf16x8*>(&Qw[(long)r32*DM+d0*16+hi*8]);
  float mhat=0.f,l_reg=0.f;f32x16 o[4];o[0]=f32x16{};o[1]=f32x16{};o[2]=f32x16{};o[3]=f32x16{};asm volatile("":"+v"(o[0]),"+v"(o[1]),"+v"(o[2]),"+v"(o[3]));f32x16 negm=f32x16{};asm volatile("":"+v"(negm));
  const int qrel=wid*QBLK+r32;
  #define CMASK(P0,P1,t) do{int jb_=(t)-(NT-4); if(jb_>=0)cmask(P0,P1,jb_,qrel,hi);}while(0)
  bool resc=false;
  #define START(P0,P1) do{ const float rm=rowmax(P0,P1); resc=false; \
    { const float dl=rm; mhat=fadd_s(mhat,dl); \
      _Pragma("unroll") for(int r=0;r<16;++r){P0[r]=fsub_s(P0[r],dl);P1[r]=fsub_s(P1[r],dl);} \
      _Pragma("unroll") for(int r=0;r<16;++r)negm[r]=-mhat; asm volatile("":"+v"(negm)); } \
    _Pragma("unroll") for(int r=0;r<16;++r)P0[r]=__builtin_amdgcn_exp2f(P0[r]); }while(0)
  #define RESC() do{ if(resc){ asm volatile("s_waitcnt lgkmcnt(0)":::"memory"); \
      _Pragma("unroll") for(int d_=0;d_<4;++d_) _Pragma("unroll") for(int r=0;r<16;++r)o[d_][r]*=wsf[crow(r,hi)]; } }while(0)
  f32x16 pA0,pA1,pB0,pB1;
  int sl_prev=0,sl_cur=0,sl_next=SLOTB;
  #define ROT() do{sl_prev=sl_cur;sl_cur=sl_next;sl_next=(sl_next==(NSLOT-1)*SLOTB)?0:sl_next+SLOTB;}while(0)
  DMA_K(2,2*SLOTB);
  WAIT_BAR(3);
  qkt(pA0,pA1,Kbase,qr,negm,r32,hi);asm volatile("s_nop 15\n\ts_nop 7":"+v"(pA0),"+v"(pA1));CMASK(pA0,pA1,0);
  START(pA0,pA1);
  _Pragma("unroll") for(int r=0;r<16;++r)pA1[r]=__builtin_amdgcn_exp2f(pA1[r]);
  WAIT_BAR(0);
  DMA_K(3,0);DMA_V(1,SLOTB);
  ROT();
  kload8(kf,kp0+sl_cur);
  WAIT_BAR(3);
  s16x4 vlo[16],vhi[16]; u32x4 pw0,pw1,pw2,pw3;
  #define PKW(P,B) cvtpk_s(P[B],P[B+1])
  #define PAF(k) __builtin_bit_cast(bf16x8,pw##k)
  #define VFR(i) (bf16x8){vlo[i][0],vlo[i][1],vlo[i][2],vlo[i][3],vhi[i][0],vhi[i][1],vhi[i][2],vhi[i][3]}
  #define PIN(x) asm volatile("":"+v"(x))
  #define MX3(a,b,c) __builtin_fmaxf(__builtin_fmaxf((a),(b)),(c))
  #define GAPA(MF,A0,A1,A2,A3,W0,W1,PW) do{ MF; sacc+=A0; sacc+=A1; sacc+=A2; sacc+=A3; PIN(sacc); W0; W1; PIN(PW); SBAR(); }while(0)
  #define EX(v) __builtin_amdgcn_exp2f(v)
  #define GAPB(MF,X,B) do{ MF; X[B]=EX(X[B]); X[B+1]=EX(X[B+1]); PIN(X); SBAR(); }while(0)
  #define VRD(i) do{ vlo[i]=vtr(vp_+(((i)>>2)*4096+((i)&3)*1024)); vhi[i]=vtr(vp_+(((i)>>2)*4096+((i)&3)*1024+512)); }while(0)
  #define KRD(G,j) do{ if(G){ kload2(kf,kp0+sl_next,j); SBAR(); } }while(0)
  #define STEP(C0,C1,P0,P1,t,GK,GV,GL) do{ SBAR(); \
    const lds_cptr vp_=vp0+2*sl_prev; \
    float sacc=(P0[0]+P0[1]); \
    GAPA(C0=__builtin_amdgcn_mfma_f32_32x32x16_bf16(kf[0],qr[0],negm,0,0,0), P0[2],P0[3],P0[4],P0[5],     pw0[0]=PKW(P0,0), pw0[1]=PKW(P0,2), pw0); \
    GAPA(C1=__builtin_amdgcn_mfma_f32_32x32x16_bf16(kf[1],qr[0],negm,0,0,0), P0[6],P0[7],P0[8],P0[9],     pw0[2]=PKW(P0,4), pw0[3]=PKW(P0,6), pw0); \
    GAPA(C0=__builtin_amdgcn_mfma_f32_32x32x16_bf16(kf[2],qr[1],C0,0,0,0),   P0[10],P0[11],P0[12],P0[13], pw1[0]=PKW(P0,8), pw1[1]=PKW(P0,10), pw1); \
    GAPA(C1=__builtin_amdgcn_mfma_f32_32x32x16_bf16(kf[3],qr[1],C1,0,0,0),   P0[14],P0[15],P1[0],P1[1],   pw1[2]=PKW(P0,12),pw1[3]=PKW(P0,14), pw1); \
    GAPA(C0=__builtin_amdgcn_mfma_f32_32x32x16_bf16(kf[4],qr[2],C0,0,0,0),   P1[2],P1[3],P1[4],P1[5],     pw2[0]=PKW(P1,0), pw2[1]=PKW(P1,2), pw2); \
    GAPA(C1=__builtin_amdgcn_mfma_f32_32x32x16_bf16(kf[5],qr[2],C1,0,0,0),   P1[6],P1[7],P1[8],P1[9],     pw2[2]=PKW(P1,4), pw2[3]=PKW(P1,6), pw2); \
    GAPA(C0=__builtin_amdgcn_mfma_f32_32x32x16_bf16(kf[6],qr[3],C0,0,0,0),   P1[10],P1[11],P1[12],P1[13], pw3[0]=PKW(P1,8), pw3[1]=PKW(P1,10), pw3); \
    GAPA(C1=__builtin_amdgcn_mfma_f32_32x32x16_bf16(kf[7],qr[3],C1,0,0,0),   P1[14],P1[15],0.f,0.f,       pw3[2]=PKW(P1,12),pw3[3]=PKW(P1,14), pw3); \
    VRD(0); VRD(4); VRD(8); VRD(12); VRD(1); VRD(5); VRD(9); VRD(13); SBAR(); \
    l_reg+=sacc; \
    if(GK){DMA_K((t)+3,sl_cur);} if(GV){DMA_V((t)+1,sl_next);} \
    CMASK(C0,C1,t); \
    { float a=MX3(C0[0],C0[1],C1[0]),b=MX3(C0[2],C0[3],C1[1]); a=MX3(a,C1[2],C1[3]); \
      _Pragma("unroll") for(int r=4;r<16;r+=4){a=MX3(a,C0[r],C0[r+1]);b=MX3(b,C0[r+2],C0[r+3]);a=MX3(a,C1[r],C1[r+1]);b=MX3(b,C1[r+2],C1[r+3]);} \
      float rm=__builtin_fmaxf(a,b); { auto rr=__builtin_amdgcn_permlane32_swap(__float_as_uint(rm),__float_as_uint(rm),false,false); rm=__builtin_fmaxf(__uint_as_float(rr[0]),__uint_as_float(rr[1])); } \
      resc=false; \
      if(__builtin_expect(__any(rm>(float)THRL),0)){ const float dl=__builtin_fmaxf(rm,0.f); mhat+=dl; \
        _Pragma("unroll") for(int r=0;r<16;++r){C0[r]-=dl;C1[r]-=dl;} \
        _Pragma("unroll") for(int r=0;r<16;++r)negm[r]=-mhat; asm volatile("":"+v"(negm)); \
        const float f=__builtin_amdgcn_exp2f(-dl); l_reg*=f; if(hi==0)wsf[r32]=f; resc=true; } } \
    SBAR(); \
    GAPB(o[0]=__builtin_amdgcn_mfma_f32_32x32x16_bf16(PAF(0),VFR(0),o[0],0,0,0),  C0,0);  VRD(2);  SBAR(); \
    GAPB(o[1]=__builtin_amdgcn_mfma_f32_32x32x16_bf16(PAF(0),VFR(4),o[1],0,0,0),  C0,2);  VRD(6);  SBAR(); \
    GAPB(o[2]=__builtin_amdgcn_mfma_f32_32x32x16_bf16(PAF(0),VFR(8),o[2],0,0,0),  C0,4);  VRD(10); SBAR(); \
    GAPB(o[3]=__builtin_amdgcn_mfma_f32_32x32x16_bf16(PAF(0),VFR(12),o[3],0,0,0), C0,6);  VRD(14); SBAR(); \
    GAPB(o[0]=__builtin_amdgcn_mfma_f32_32x32x16_bf16(PAF(1),VFR(1),o[0],0,0,0),  C0,8);  VRD(3);  SBAR(); \
    GAPB(o[1]=__builtin_amdgcn_mfma_f32_32x32x16_bf16(PAF(1),VFR(5),o[1],0,0,0),  C0,10); VRD(7);  SBAR(); \
    GAPB(o[2]=__builtin_amdgcn_mfma_f32_32x32x16_bf16(PAF(1),VFR(9),o[2],0,0,0),  C0,12); VRD(11); SBAR(); \
    GAPB(o[3]=__builtin_amdgcn_mfma_f32_32x32x16_bf16(PAF(1),VFR(13),o[3],0,0,0), C0,14); VRD(15); SBAR(); \
    KRD(GL,0); GAPB(o[0]=__builtin_amdgcn_mfma_f32_32x32x16_bf16(PAF(2),VFR(2),o[0],0,0,0),  C1,0); \
    KRD(GL,1); GAPB(o[1]=__builtin_amdgcn_mfma_f32_32x32x16_bf16(PAF(2),VFR(6),o[1],0,0,0),  C1,2); \
    KRD(GL,2); GAPB(o[2]=__builtin_amdgcn_mfma_f32_32x32x16_bf16(PAF(2),VFR(10),o[2],0,0,0), C1,4); \
    KRD(GL,3); GAPB(o[3]=__builtin_amdgcn_mfma_f32_32x32x16_bf16(PAF(2),VFR(14),o[3],0,0,0), C1,6); \
    GAPB(o[0]=__builtin_amdgcn_mfma_f32_32x32x16_bf16(PAF(3),VFR(3),o[0],0,0,0),  C1,8); \
    GAPB(o[1]=__builtin_amdgcn_mfma_f32_32x32x16_bf16(PAF(3),VFR(7),o[1],0,0,0),  C1,10); \
    GAPB(o[2]=__builtin_amdgcn_mfma_f32_32x32x16_bf16(PAF(3),VFR(11),o[2],0,0,0), C1,12); \
    GAPB(o[3]=__builtin_amdgcn_mfma_f32_32x32x16_bf16(PAF(3),VFR(15),o[3],0,0,0), C1,14); \
    }while(0)
  int t=1;
  #undef CMASK
  #define CMASK(P0,P1,t) do{}while(0)
  for(;t+5<NT;t+=2){
    STEP(pB0,pB1,pA0,pA1,t,true,true,true);     WAIT_BAR(3); RESC(); ROT();
    STEP(pA0,pA1,pB0,pB1,t+1,true,true,true);   WAIT_BAR(3); RESC(); ROT();
  }
  #undef CMASK
  #define CMASK(P0,P1,t) do{int jb_=(t)-(NT-4); if(jb_>=0)cmask(P0,P1,jb_,qrel,hi);}while(0)
  #define ENDW(tt) do{ if((tt)+3<NT){WAIT_BAR(3);} else if((tt)+2<NT){WAIT_BAR(2);} else {WAIT_BAR(0);} }while(0)
  for(;t+1<NT;t+=2){
    STEP(pB0,pB1,pA0,pA1,t,(t+3<NT),(t+1<NT),(t+1<NT));       ENDW(t);   RESC(); ROT();
    STEP(pA0,pA1,pB0,pB1,t+1,(t+4<NT),(t+2<NT),(t+2<NT));     ENDW(t+1); RESC(); ROT();
  }
  STEP(pB0,pB1,pA0,pA1,NT-1,false,false,false); RESC();
  { float sacc=pB0[0]+pB0[1]; _Pragma("unroll") for(int r=2;r<16;++r)sacc+=pB0[r]; _Pragma("unroll") for(int r=0;r<16;++r)sacc+=pB1[r]; l_reg+=sacc;
    pw0=(u32x4){PKW(pB0,0),PKW(pB0,2),PKW(pB0,4),PKW(pB0,6)};pw1=(u32x4){PKW(pB0,8),PKW(pB0,10),PKW(pB0,12),PKW(pB0,14)};pw2=(u32x4){PKW(pB1,0),PKW(pB1,2),PKW(pB1,4),PKW(pB1,6)};pw3=(u32x4){PKW(pB1,8),PKW(pB1,10),PKW(pB1,12),PKW(pB1,14)};
    SBAR(); pv(o,vb0+2*sl_cur,PAF(0),PAF(1),PAF(2),PAF(3)); }
  #undef PKW
  #undef PAF
  #undef VFR
  #undef PIN
  #undef MX3
  #undef GAPA
  #undef GAPB
  #undef EX
  #undef VRD
  #undef KRD
  #undef STEP
  #undef ENDW
  {auto rr=__builtin_amdgcn_permlane32_swap(__float_as_uint(l_reg),__float_as_uint(l_reg),false,false);l_reg=__uint_as_float(rr[0])+__uint_as_float(rr[1]);}
  if(hi==0)wsf[32+r32]=l_reg;asm volatile("s_waitcnt lgkmcnt(0)":::"memory");
  float rli[16];
  #pragma unroll
  for(int r=0;r<16;++r)rli[r]=__builtin_amdgcn_rcpf(wsf[32+crow(r,hi)]);
  bf16*Ow=O+(long)(q0+wid*QBLK)*DM+hv*128;
  { bf16*stg=(bf16*)(shm+LDS_OST)+wid*2048;
    #pragma unroll
    for(int hf=0;hf<2;++hf){
      #pragma unroll
      for(int r=0;r<16;++r){const int orow=crow(r,hi);
        #pragma unroll
        for(int d0=0;d0<2;++d0)stg[orow*64+d0*32+r32]=__float2bfloat16(o[2*hf+d0][r]*rli[r]);}
      asm volatile("s_waitcnt lgkmcnt(0)":::"memory");
      u32x4 v4[4];
      #pragma unroll
      for(int i=0;i<4;++i){const int row=i*8+(lane>>3),ch=lane&7; v4[i]=*(const u32x4*)(stg+row*64+ch*8);}
      asm volatile("s_waitcnt lgkmcnt(0)":::"memory");
      #pragma unroll
      for(int i=0;i<4;++i){const int row=i*8+(lane>>3),ch=lane&7; ATTN_STORE16(Ow+(long)row*DM+hf*64+ch*8,v4[i]);} } }
  asm volatile("s_waitcnt lgkmcnt(0)\n\ts_barrier":::"memory");
  #undef DMA_K
  #undef DMA_V
  #undef CMASK
  #undef START
  #undef RESC
  #undef ROT
}
constexpr int ATTN_LDS_BYTES=LDS_BYTES;
#undef SBAR
#undef WAIT_BAR
}

typedef GAS unsigned gu32;
#define RLX_AGENT __ATOMIC_RELAXED, __HIP_MEMORY_SCOPE_AGENT
#define LDS_WAIT() asm volatile("s_waitcnt lgkmcnt(0)" ::: "memory")
#define XB_TMO      128
#define XB_XCNT(j)  (256  + 64 * (j))
#define XB_XSUB(j)  (1280 + 64 * (j))
#define XB_XGEN(j)  (2304 + 64 * (j))
#define XB_TOP      3328
#define XB_TOPGEN   3392
#define XCD_BAR_WORDS 3456
#define XB_SPIN_CAP (1u << 18)
__device__ __forceinline__ unsigned xb_ld(unsigned* p)              { return __hip_atomic_load(p, __ATOMIC_RELAXED, __HIP_MEMORY_SCOPE_AGENT); }
__device__ __forceinline__ unsigned xb_add(unsigned* p, unsigned v) { return __hip_atomic_fetch_add(p, v, __ATOMIC_RELAXED, __HIP_MEMORY_SCOPE_AGENT); }
__device__ __forceinline__ unsigned xb_xcc_id() { return (unsigned)__builtin_amdgcn_s_getreg((3 << 11) | 20) & 0xFu; }
#define XB_SPIN(cond, bar) do { unsigned _sp = 0; while (cond) { __builtin_amdgcn_s_sleep(1); \
    if ((++_sp & 255u) == 0u) { if (xb_ld(&(bar)[XB_TMO])) break; if (_sp > XB_SPIN_CAP) { atomicAdd(&(bar)[XB_TMO], 1u); break; } } } } while (0)
struct XcdBarrier { unsigned* bar; unsigned x; volatile LAS unsigned* st; };
__device__ __forceinline__ XcdBarrier xcd_barrier_post(unsigned* bar, volatile LAS unsigned* st) {
    XcdBarrier b; b.bar = bar; b.x = xb_xcc_id(); b.st = st;
    if (threadIdx.x == 0) (void)xb_add(&bar[XB_XCNT(b.x)], 1u);
    return b;
}
__device__ __forceinline__ void xcd_barrier_complete(unsigned* bar, unsigned x, unsigned& nloc, unsigned& nx) {
    const unsigned G = gridDim.x * gridDim.y * gridDim.z;
    unsigned sum, cnt, mine, sp = 0u;
    for (;;) {
        sum = 0u; cnt = 0u; mine = 0u;
#pragma unroll
        for (unsigned j = 0; j < 16; ++j) { const unsigned c = xb_ld(&bar[XB_XCNT(j)]); sum += c; cnt += (c > 0u) ? 1u : 0u; mine = (j == x) ? c : mine; }
        if (sum == G) break;
        __builtin_amdgcn_s_sleep(1);
        if ((++sp & 255u) == 0u) { if (xb_ld(&bar[XB_TMO])) break; if (sp > XB_SPIN_CAP) { atomicAdd(&bar[XB_TMO], 1u); break; } }
    }
    nloc = mine > 0u ? mine : 1u; nx = cnt > 0u ? cnt : 1u;
}
__device__ __forceinline__ void xcd_barrier(const XcdBarrier& b) {
    asm volatile("s_waitcnt vmcnt(0)" ::: "memory");
    __syncthreads();
    if (threadIdx.x == 0) {
        unsigned* bar = b.bar; asm volatile("" : "+v"(bar));
        __builtin_amdgcn_s_waitcnt(0);
        unsigned nloc = b.st[0], nx = b.st[1];
        if (nloc == 0u) { xcd_barrier_complete(bar, b.x, nloc, nx); b.st[0] = nloc; b.st[1] = nx; }
        const unsigned old = xb_add(&bar[XB_XSUB(b.x)], 1u);
        const unsigned gen = old / nloc;
        if (old + 1u == (gen + 1u) * nloc) {
            __builtin_amdgcn_fence(__ATOMIC_RELEASE, "agent");
            asm volatile("s_waitcnt vmcnt(0)" ::: "memory");
            const unsigned og = xb_add(&bar[XB_TOP], 1u);
            const unsigned tg = og / nx;
            if (og + 1u == (tg + 1u) * nx) xb_add(&bar[XB_TOPGEN], 1u);
            else XB_SPIN(xb_ld(&bar[XB_TOPGEN]) == tg, bar);
            __builtin_amdgcn_fence(__ATOMIC_ACQUIRE, "agent");
            xb_add(&bar[XB_XGEN(b.x)], 1u);
            asm volatile("s_waitcnt vmcnt(0)" ::: "memory");
        } else {
            XB_SPIN(xb_ld(&bar[XB_XGEN(b.x)]) == gen, bar);
            __builtin_amdgcn_fence(__ATOMIC_ACQUIRE, "agent");
            asm volatile("s_waitcnt vmcnt(0)" ::: "memory");
        }
    }
    __syncthreads();
}

#define XB2_XSUB(j) (64 * (j))
#define XB2_TOP     1024
#define XB2_TOPGEN  1088
__device__ __forceinline__ void xcd_split_arrive(unsigned* bar2, unsigned* bar, volatile LAS unsigned* st) {
    asm volatile("s_waitcnt vmcnt(0)" ::: "memory");
    __syncthreads();
    if (threadIdx.x == 0) {
        asm volatile("" : "+v"(bar2));
        __builtin_amdgcn_s_waitcnt(0);
        unsigned nloc = st[0], nx = st[1]; const unsigned x = xb_xcc_id();
        if (nloc == 0u) { xcd_barrier_complete(bar, x, nloc, nx); st[0] = nloc; st[1] = nx; }
        const unsigned old = xb_add(&bar2[XB2_XSUB(x)], 1u);
        if ((old + 1u) % nloc == 0u) {
            __builtin_amdgcn_fence(__ATOMIC_RELEASE, "agent");
            asm volatile("s_waitcnt vmcnt(0)" ::: "memory");
            const unsigned og = xb_add(&bar2[XB2_TOP], 1u);
            if ((og + 1u) % nx == 0u) xb_add(&bar2[XB2_TOPGEN], 1u);
            asm volatile("s_waitcnt vmcnt(0)" ::: "memory");
        }
    }
}
__device__ __forceinline__ void xcd_split_wait(unsigned* bar2, unsigned* bar, unsigned target) {
    if (threadIdx.x == 0) {
        asm volatile("" : "+v"(bar2));
        XB_SPIN(xb_ld(&bar2[XB2_TOPGEN]) < target, bar);
        __builtin_amdgcn_fence(__ATOMIC_ACQUIRE, "agent");
        asm volatile("s_waitcnt vmcnt(0)" ::: "memory");
    }
    __syncthreads();
}

__device__ __forceinline__ float wave_sum(float v) {
#pragma unroll
    for (int o = 1; o < 64; o <<= 1) v += __shfl_xor(v, o);
    return v;
}
template <class F>
__device__ __forceinline__ void transpose_load(const float* W, int ld, int nrows, F srccol, int item, int lane, f32x4 (&v)[8]) {
    const int nblk = nrows / 32, kb = item / nblk, nb = item % nblk, k0 = 64 * kb, s0 = srccol(32 * nb);
#pragma unroll
    for (int i = 0; i < 8; ++i) v[i] = __builtin_nontemporal_load((const f32x4*)(W + (size_t)(k0 + 8 * i + (lane >> 3)) * ld + s0 + 4 * (lane & 7)));
}
__host__ __device__ __forceinline__ int perm32(int rho) { const int n = rho >> 4, i = rho & 15; return 8 * (i >> 2) + 4 * n + (i & 3); }
template <bool PERM>
__device__ __forceinline__ void transpose_store(int K, bf16_t* WT, int nrows, const float* gk, LAS float* scr, int item, int lane, const f32x4 (&v)[8]) {
    const int nblk = nrows / 32, kb = item / nblk, nb = item % nblk, k0 = 64 * kb, n0 = 32 * nb;
#pragma unroll
    for (int i = 0; i < 8; ++i) { const int kk = 8 * i + (lane >> 3); const float g = gk ? gk[k0 + kk] : 1.0f;
#pragma unroll
        for (int e = 0; e < 4; ++e) scr[kk * 33 + 4 * (lane & 7) + e] = v[i][e] * g; }
    LDS_WAIT(); asm volatile("" ::: "memory");
    const int c = lane & 7;
#pragma unroll
    for (int j = 0; j < 4; ++j) { const int n = (lane >> 3) + 8 * j; const LAS float* s = scr + (8 * c) * 33 + (PERM ? perm32(n) : n);
        u32x4 o; o.x = cvt_pk_bf16(s[0 * 33], s[1 * 33]); o.y = cvt_pk_bf16(s[2 * 33], s[3 * 33]); o.z = cvt_pk_bf16(s[4 * 33], s[5 * 33]); o.w = cvt_pk_bf16(s[6 * 33], s[7 * 33]);
        *(u32x4*)(WT + (size_t)(n0 + n) * K + k0 + 8 * c) = o; }
    LDS_WAIT(); asm volatile("" ::: "memory");
}
struct ColIdent { int off; __device__ __forceinline__ int operator()(int r) const { return off + r; } };
struct ColSwiglu { __device__ __forceinline__ int operator()(int r) const { return ((r >> 7) & 1) * DFF + (r >> 8) * 128 + (r & 127); } };
struct ColSwigluOff { int r0; __device__ __forceinline__ int operator()(int r) const { return ColSwiglu{}(r + r0); } };
struct ColMix { __device__ __forceinline__ int operator()(int r) const {
    const int tile = r >> 8, p = r & 255, o = 64 * ((p >> 5) & 3) + 32 * (p >> 7) + (p & 31);
    if (tile < 16) return r;
    if (tile < 20) return 6144 + (tile - 16) * 256 + o;
    if (tile < 24) return 7168 + (tile - 20) * 256 + o;
    if (tile < 28) return 8192 + (tile - 24) * 256 + p;
    return 9216 + (tile - 28) * 256 + p; } };
template <bool PERM = false, class F>
__device__ __forceinline__ void transpose_all(const float* W, int K, int ld, bf16_t* WT, int nrows, F srccol, const float* gk, LAS float* scr, int gw, int ngw, int lane) {
    const int nitems = (K / 64) * (nrows / 32);
    for (int it = gw; it < nitems; it += 2 * ngw) {
        f32x4 va[8], vb[8]; const int it2 = it + ngw;
        transpose_load(W, ld, nrows, srccol, it, lane, va);
        if (it2 < nitems) transpose_load(W, ld, nrows, srccol, it2, lane, vb);
        transpose_store<PERM>(K, WT, nrows, gk, scr, it, lane, va);
        if (it2 < nitems) transpose_store<PERM>(K, WT, nrows, gk, scr, it2, lane, vb);
    }
}
__device__ __forceinline__ void rms_rows_to_bf16(const float* x, const float* gain, bf16_t* o, int m0, int step, int nrows, int lane) {
    const f32x4* gr = (const f32x4*)gain + lane;
    for (int m = m0; m < nrows; m += 2 * step) {
        const int m2 = (m + step < nrows) ? m + step : m;
        const f32x4* xa = (const f32x4*)(x + (size_t)m * DM) + lane; const f32x4* xb2 = (const f32x4*)(x + (size_t)m2 * DM) + lane;
        f32x4 va[4], vb[4]; float sa = 0.f, sb = 0.f;
#pragma unroll
        for (int j = 0; j < 4; ++j) { va[j] = __builtin_nontemporal_load(xa + 64 * j); vb[j] = __builtin_nontemporal_load(xb2 + 64 * j); }
#pragma unroll
        for (int j = 0; j < 4; ++j) { sa += (va[j][0] * va[j][0] + va[j][1] * va[j][1]) + (va[j][2] * va[j][2] + va[j][3] * va[j][3]); sb += (vb[j][0] * vb[j][0] + vb[j][1] * vb[j][1]) + (vb[j][2] * vb[j][2] + vb[j][3] * vb[j][3]); }
        const float ra = __builtin_amdgcn_rsqf(wave_sum(sa) * (1.f / 1024.f) + EPS), rb = __builtin_amdgcn_rsqf(wave_sum(sb) * (1.f / 1024.f) + EPS);
        u32x2* oa = (u32x2*)(o + (size_t)m * DM) + lane; u32x2* ob = (u32x2*)(o + (size_t)m2 * DM) + lane;
#pragma unroll
        for (int j = 0; j < 4; ++j) { const f32x4 g = gr[64 * j]; oa[64 * j] = pack4(va[j] * ra * g); if (m2 != m) ob[64 * j] = pack4(vb[j] * rb * g); }
    }
}
__device__ __forceinline__ void rot_table(const int* pos, float* rot, int gt, int ngt, int idx0 = 0, int idx1 = SEQ * 128) {
    for (int idx = idx0 + gt; idx < idx1; idx += ngt) {
        const int s = idx >> 7, i = idx & 127;
        const float inv = exp2f(-(float)i * (13.287712379549449f / 128.0f));
        const float ang = (float)pos[s] * inv;
        const float kq = rintf(ang * 0.6366197723675814f);
        float r = fmaf(-kq, 1.5703125f, ang); r = fmaf(-kq, 4.837512969970703125e-4f, r); r = fmaf(-kq, 7.54978995489188216e-8f, r);
        const float r2 = r * r;
        const float sn = r + r * r2 * (-1.6666667e-1f + r2 * (8.3333333e-3f + r2 * (-1.9841270e-4f + r2 * 2.7557319e-6f)));
        const float cn = 1.0f + r2 * (-0.5f + r2 * (4.1666668e-2f + r2 * (-1.3888889e-3f + r2 * (2.4801587e-5f + r2 * -2.7557319e-7f))));
        const int qd = ((int)kq) & 3;
        const float c = (qd == 0) ? cn : (qd == 1) ? -sn : (qd == 2) ? -cn : sn;
        const float sv = (qd == 0) ? sn : (qd == 1) ? cn : (qd == 2) ? -sn : -cn;
        *(f32x2*)(rot + (size_t)idx * 2) = (f32x2){c, sv};
    }
}

constexpr int SCN_LD = 136, SCN_V_OFF = 64 * SCN_LD * 2, SCN_CH = 192 * SCN_LD * 2;
constexpr unsigned SCAN_UNITS_PER_FLAG = 8;
__device__ __forceinline__ void scan_unit(int u, const bf16_t* kts, const bf16_t* vt, bf16_t* S, LAS unsigned char* lds, unsigned* done  ) {
    const int tid = opaque_tid(), lane = tid & 63, wave = __builtin_amdgcn_readfirstlane(tid >> 6);
    const int fr = lane & 15, fq = lane >> 4, h = u >> 4, dg = (u >> 2) & 3, eg = u & 3, wd = wave & 1, we = wave >> 1;
    const float gC = __builtin_amdgcn_exp2f(128.0f * log2f(1.0f - __builtin_amdgcn_exp2f(-5.0f - (float)h)));
    f32x4 acc[2][2];
#pragma unroll
    for (int a = 0; a < 2; ++a)
#pragma unroll
        for (int b = 0; b < 2; ++b) acc[a][b] = (f32x4){0.f, 0.f, 0.f, 0.f};
    const bf16_t* ksrc = kts + (size_t)(h * 256 + 64 * dg + (tid >> 4)) * SEQ + (tid & 15) * 8;
    const bf16_t* vsrc = vt + (size_t)(h * 512 + 128 * eg + (tid >> 4)) * SEQ + (tid & 15) * 8;
    u32x4 pk[3][2][2], pv[3][2][4];
#pragma unroll
    for (int sb = 0; sb < 3; ++sb)
#pragma unroll
        for (int i = 0; i < 2; ++i) {
#pragma unroll
            for (int j = 0; j < 2; ++j) pk[sb][i][j] = *(const u32x4*)(ksrc + (size_t)(32 * j) * SEQ + (2 * sb + i) * 128);
#pragma unroll
            for (int j = 0; j < 4; ++j) pv[sb][i][j] = *(const u32x4*)(vsrc + (size_t)(32 * j) * SEQ + (2 * sb + i) * 128);
        }
    bf16_t* sdst = S + ((size_t)(h * 16) * 512 + 128 * eg + 32 * we + fr) * 256 + 64 * dg + 32 * wd + 4 * fq;
#pragma unroll
    for (int r = 0; r < 8; ++r) {
        __syncthreads();
#pragma unroll
        for (int i = 0; i < 2; ++i) {
            if (2 * r + i < 15) {
                LAS bf16_t* lk = (LAS bf16_t*)(lds + i * SCN_CH); LAS bf16_t* lv = (LAS bf16_t*)(lds + i * SCN_CH + SCN_V_OFF);
#pragma unroll
                for (int j = 0; j < 2; ++j) *(LAS u32x4*)(lk + (32 * j + (tid >> 4)) * SCN_LD + (tid & 15) * 8) = pk[r % 3][i][j];
#pragma unroll
                for (int j = 0; j < 4; ++j) *(LAS u32x4*)(lv + (32 * j + (tid >> 4)) * SCN_LD + (tid & 15) * 8) = pv[r % 3][i][j];
            }
        }
        __syncthreads();
        if (r < 5) {
#pragma unroll
            for (int i = 0; i < 2; ++i) { const int c = 2 * (r + 3) + i;
                if (c < 15) {
#pragma unroll
                    for (int j = 0; j < 2; ++j) pk[r % 3][i][j] = *(const u32x4*)(ksrc + (size_t)(32 * j) * SEQ + c * 128);
#pragma unroll
                    for (int j = 0; j < 4; ++j) pv[r % 3][i][j] = *(const u32x4*)(vsrc + (size_t)(32 * j) * SEQ + c * 128);
                } }
        }
#pragma unroll
        for (int i = 0; i < 2; ++i) {
            const int c = 2 * r + i;
#pragma unroll
            for (int td = 0; td < 2; ++td)
#pragma unroll
                for (int te = 0; te < 2; ++te) { const u32x2 w = pack4(acc[td][te]);
                    __hip_atomic_store((unsigned long long*)(sdst + (size_t)c * 512 * 256 + (size_t)(16 * te) * 256 + 16 * td), ((unsigned long long)w.y << 32) | w.x, __ATOMIC_RELAXED, __HIP_MEMORY_SCOPE_AGENT); }
            if (c < 15) {
                const LAS bf16_t* lk = (const LAS bf16_t*)(lds + i * SCN_CH); const LAS bf16_t* lv = (const LAS bf16_t*)(lds + i * SCN_CH + SCN_V_OFF);
                f32x4 tm[2][2];
#pragma unroll
                for (int td = 0; td < 2; ++td)
#pragma unroll
                    for (int te = 0; te < 2; ++te) tm[td][te] = (f32x4){0.f, 0.f, 0.f, 0.f};
#pragma unroll
                for (int ks = 0; ks < 4; ++ks) {
                    bf16x8 a[2], b[2];
#pragma unroll
                    for (int t = 0; t < 2; ++t) { a[t] = *(const LAS bf16x8*)(lk + (32 * wd + 16 * t + fr) * SCN_LD + 32 * ks + 8 * fq); b[t] = *(const LAS bf16x8*)(lv + (32 * we + 16 * t + fr) * SCN_LD + 32 * ks + 8 * fq); }
#pragma unroll
                    for (int td = 0; td < 2; ++td)
#pragma unroll
                        for (int te = 0; te < 2; ++te) tm[td][te] = mfma16(a[td], b[te], tm[td][te]);
                }
#pragma unroll
                for (int td = 0; td < 2; ++td)
#pragma unroll
                    for (int te = 0; te < 2; ++te) acc[td][te] = acc[td][te] * gC + tm[td][te];
            }
        }
    }
    asm volatile("s_waitcnt vmcnt(0)" ::: "memory");
    __syncthreads();
    if (tid == 0) __hip_atomic_fetch_add(done + ((h * 2 + (eg >> 1)) * 64), 1u, __ATOMIC_RELAXED, __HIP_MEMORY_SCOPE_AGENT);
}
constexpr int RQ_LD = 264, SC_LD = 136, RO_SC_OFF = 128 * RQ_LD * 2, RO_PART_OFF = RO_SC_OFF + 128 * SC_LD * 2;
__device__ __forceinline__ void retout_unit(int h, int c, const bf16_t* q, const bf16_t* k, const bf16_t* vt, const bf16_t* S, bf16_t* ret  , float* rssq, LAS unsigned char* lds, unsigned* done, unsigned* tmo) {
    const int tid = opaque_tid(), lane = tid & 63, wave = __builtin_amdgcn_readfirstlane(tid >> 6);
    const int fr = lane & 15, fq = lane >> 4;
    LAS bf16_t* ql = (LAS bf16_t*)lds; LAS bf16_t* sc = (LAS bf16_t*)(lds + RO_SC_OFF); LAS float* part = (LAS float*)(lds + RO_PART_OFF);
    const float lg2 = log2f(1.0f - __builtin_amdgcn_exp2f(-5.0f - (float)h));
    const int tok0 = c * 128;
    if (tid < 64) {
        unsigned* f = done + ((h * 2) * 64); unsigned sp = 0;
        while ((unsigned)__builtin_amdgcn_readfirstlane(__hip_atomic_load(f, __ATOMIC_RELAXED, __HIP_MEMORY_SCOPE_AGENT)) < SCAN_UNITS_PER_FLAG ||
               (unsigned)__builtin_amdgcn_readfirstlane(__hip_atomic_load(f + 64, __ATOMIC_RELAXED, __HIP_MEMORY_SCOPE_AGENT)) < SCAN_UNITS_PER_FLAG) {
            __builtin_amdgcn_s_sleep(2);
            if (++sp > (1u << 20)) { if (tid == 0) __hip_atomic_store(tmo, 1u, __ATOMIC_RELAXED, __HIP_MEMORY_SCOPE_AGENT); break; }
        }
        __builtin_amdgcn_fence(__ATOMIC_ACQUIRE, "agent");
        asm volatile("s_waitcnt vmcnt(0)" ::: "memory");
    }
    __syncthreads();
    const bf16_t* sp = S + ((size_t)((h * 16 + c) * 512 + 32 * wave + fr)) * 256 + 8 * fq;
    const bf16_t* kp = k + (size_t)(tok0 + 16 * wave + fr) * 1024 + h * 256 + 8 * fq;
    u32x4 qv[8]; bf16x8 kf[8];
#pragma unroll
    for (int i = 0; i < 8; ++i) { const int p = tid + 512 * i, row = p >> 5, c16 = p & 31; qv[i] = *(const u32x4*)(q + (size_t)(tok0 + row) * 1024 + h * 256 + c16 * 8); }
#pragma unroll
    for (int ks = 0; ks < 8; ++ks) kf[ks] = *(const bf16x8*)(kp + 32 * ks);
#pragma unroll
    for (int i = 0; i < 8; ++i) { const int p = tid + 512 * i, row = p >> 5, c16 = p & 31; *(LAS u32x4*)(ql + row * RQ_LD + c16 * 8) = qv[i]; }
    __syncthreads();
    {
        const int tj = wave;
#pragma unroll
        for (int ti = 0; ti < 8; ++ti) {
            if (ti >= tj) {
                f32x4 s2 = (f32x4){0.f, 0.f, 0.f, 0.f};
#pragma unroll
                for (int ks = 0; ks < 8; ++ks) { const bf16x8 qf = *(const LAS bf16x8*)(ql + (16 * ti + fr) * RQ_LD + 32 * ks + 8 * fq); s2 = mfma16(kf[ks], qf, s2); }
                const int i = 16 * ti + fr; f32x4 v;
#pragma unroll
                for (int r = 0; r < 4; ++r) { const int j = 16 * tj + 4 * fq + r; v[r] = (i >= j) ? s2[r] * __builtin_amdgcn_exp2f(lg2 * (float)(i - j)) : 0.f; }
                *(LAS u32x2*)(sc + (16 * ti + fr) * SC_LD + 16 * tj + 4 * fq) = pack4(v);
            } else if (ti == tj - 1 && (tj & 1)) {
                u32x2 z = (u32x2){0u, 0u}; asm volatile("" : "+v"(z));
                *(LAS u32x2*)(sc + (16 * ti + fr) * SC_LD + 16 * tj + 4 * fq) = z;
            }
        }
    }
    __syncthreads();
#pragma unroll 1
    for (int eh = 0; eh < 2; ++eh) {
    const bf16_t* vp = vt + (size_t)(h * 512 + 256 * eh + 32 * wave + fr) * SEQ + tok0 + 8 * fq;
    bf16x8 sfa[8][2], vfa[4][2];
#pragma unroll
    for (int ks = 0; ks < 8; ++ks)
#pragma unroll
        for (int t = 0; t < 2; ++t) sfa[ks][t] = *(const bf16x8*)(sp + (size_t)(256 * eh + 16 * t) * 256 + 32 * ks);
    f32x4 acc[8][2];
#pragma unroll
    for (int a = 0; a < 8; ++a)
#pragma unroll
        for (int b = 0; b < 2; ++b) acc[a][b] = (f32x4){0.f, 0.f, 0.f, 0.f};
    {
#pragma unroll
        for (int ks = 0; ks < 8; ++ks) {
            bf16x8 qf[8];
            if (ks == 4) {
#pragma unroll
                for (int k2 = 0; k2 < 4; ++k2)
#pragma unroll
                    for (int t = 0; t < 2; ++t) vfa[k2][t] = *(const bf16x8*)(vp + (size_t)(16 * t) * SEQ + 32 * k2);
            }
#pragma unroll
            for (int t = 0; t < 8; ++t) qf[t] = *(const LAS bf16x8*)(ql + (16 * t + fr) * RQ_LD + 32 * ks + 8 * fq);
            __builtin_amdgcn_sched_barrier(0);
#pragma unroll
            for (int a = 0; a < 8; ++a)
#pragma unroll
                for (int b = 0; b < 2; ++b) acc[a][b] = mfma16(sfa[ks][b], qf[a], acc[a][b]);
            __builtin_amdgcn_sched_barrier(0);
        }
    }
#pragma unroll
    for (int a = 0; a < 8; ++a) { const float qd = __builtin_amdgcn_exp2f(lg2 * (float)(16 * a + fr + 1));
#pragma unroll
        for (int b = 0; b < 2; ++b) acc[a][b] = acc[a][b] * qd; }
#pragma unroll
    for (int ks = 0; ks < 4; ++ks) {
        bf16x8 pf[8];
#pragma unroll
        for (int a = 0; a < 8; ++a) if (a >= 2 * ks) pf[a] = *(const LAS bf16x8*)(sc + (16 * a + fr) * SC_LD + 32 * ks + 8 * fq);
        __builtin_amdgcn_sched_barrier(0);
#pragma unroll
        for (int a = 0; a < 8; ++a) {
            if (a >= 2 * ks) {
#pragma unroll
                for (int b = 0; b < 2; ++b) acc[a][b] = mfma16(vfa[ks][b], pf[a], acc[a][b]);
            }
        }
        __builtin_amdgcn_sched_barrier(0);
    }
#pragma unroll
    for (int a = 0; a < 8; ++a) {
        float ss = 0.f;
#pragma unroll
        for (int b = 0; b < 2; ++b) { const f32x4 t = acc[a][b]; ss += (t[0] * t[0] + t[1] * t[1]) + (t[2] * t[2] + t[3] * t[3]); }
        ss += __shfl_xor(ss, 16); ss += __shfl_xor(ss, 32);
        if (fq == 0) part[wave * 128 + 16 * a + fr] = ss;
    }
    __syncthreads();
    if (tid < 128) {
        float tot = 0.f;
#pragma unroll
        for (int w = 0; w < 8; ++w) tot += part[w * 128 + tid];
        rssq[(size_t)(tok0 + tid) * 8 + 2 * h + eh] = tot;
    }
#pragma unroll
    for (int a = 0; a < 8; ++a)
#pragma unroll
        for (int b = 0; b < 2; ++b)
            *(u32x2*)(ret + (size_t)(tok0 + 16 * a + fr) * 2048 + h * 512 + 256 * eh + 32 * wave + 16 * b + 4 * fq) = pack4(acc[a][b]);
    __syncthreads();
    }
}
constexpr int PL_LD = 264, MA_KV_BYTES = 64 * 264 * 2, MA_P_OFF = MA_KV_BYTES;
__device__ __forceinline__ void memattn_unit(int b, int h, int rb, const bf16_t* mkn, const bf16_t* mvt, bf16_t* mo  , LAS unsigned char* lds) {
    const bf16_t* mq = mo;
    const int tid = opaque_tid(), lane = tid & 63, wave = __builtin_amdgcn_readfirstlane(tid >> 6);
    const int fr = lane & 15, fq = lane >> 4;
    LAS bf16_t* kv = (LAS bf16_t*)lds; LAS bf16_t* pl = (LAS bf16_t*)(lds + MA_P_OFF) + wave * (16 * PL_LD);
    const int row = 128 * rb + 16 * wave + fr;
    const bf16_t* ksrc = mkn + (size_t)(b * 256) * 1024 + h * 256;
    const bf16_t* vsrc = mvt + (size_t)((b * 4 + h) * 256) * 256;
    u32x4 pre[4];
#pragma unroll
    for (int i = 0; i < 4; ++i) { const int p = tid + 512 * i; pre[i] = *(const u32x4*)(ksrc + (size_t)(p >> 5) * 1024 + (p & 31) * 8); }
    bf16x8 qf[8]; float qs = 0.f;
#pragma unroll
    for (int ks = 0; ks < 8; ++ks) { qf[ks] = *(const bf16x8*)(mq + (size_t)row * 1024 + h * 256 + 32 * ks + 8 * fq);
#pragma unroll
        for (int j = 0; j < 8; ++j) { const float f = bf2f((unsigned short)qf[ks][j]); qs += f * f; } }
    qs += __shfl_xor(qs, 16); qs += __shfl_xor(qs, 32);
    const float scl = __builtin_amdgcn_rsqf(qs * (1.0f / 256.0f) + EPS) * (0.0625f * LOG2E);
    f32x4 sa[16];
#pragma unroll
    for (int kc = 0; kc < 4; ++kc) {
        __syncthreads();
#pragma unroll
        for (int i = 0; i < 4; ++i) { const int p = tid + 512 * i; *(LAS u32x4*)(kv + (p >> 5) * PL_LD + (p & 31) * 8) = pre[i]; }
        __syncthreads();
#pragma unroll
        for (int i = 0; i < 4; ++i) { const int p = tid + 512 * i;
            pre[i] = (kc < 3) ? *(const u32x4*)(ksrc + (size_t)(64 * (kc + 1) + (p >> 5)) * 1024 + (p & 31) * 8) : *(const u32x4*)(vsrc + (size_t)(p >> 5) * 256 + (p & 31) * 8); }
#pragma unroll
        for (int tl = 0; tl < 4; ++tl) {
            f32x4 a = (f32x4){0.f, 0.f, 0.f, 0.f};
#pragma unroll
            for (int ks = 0; ks < 8; ++ks) { const bf16x8 kf = *(const LAS bf16x8*)(kv + (16 * tl + fr) * PL_LD + 32 * ks + 8 * fq); a = mfma16(kf, qf[ks], a); }
            sa[4 * kc + tl] = a * scl;
        }
    }
    float mx = -INFINITY;
#pragma unroll
    for (int t = 0; t < 16; ++t) mx = fmaxf(mx, fmaxf(fmaxf(sa[t][0], sa[t][1]), fmaxf(sa[t][2], sa[t][3])));
    mx = fmaxf(mx, __shfl_xor(mx, 16)); mx = fmaxf(mx, __shfl_xor(mx, 32));
    float l = 0.f;
#pragma unroll
    for (int t = 0; t < 16; ++t) {
        f32x4 p;
#pragma unroll
        for (int r = 0; r < 4; ++r) { p[r] = __builtin_amdgcn_exp2f(sa[t][r] - mx); l += p[r]; }
        *(LAS u32x2*)(pl + fr * PL_LD + 16 * t + 4 * fq) = pack4(p);
    }
    l += __shfl_xor(l, 16); l += __shfl_xor(l, 32);
    const float rl = __builtin_amdgcn_rcpf(l);
    LDS_WAIT(); asm volatile("" ::: "memory");
    bf16x8 pf[8];
#pragma unroll
    for (int ks = 0; ks < 8; ++ks) pf[ks] = *(const LAS bf16x8*)(pl + fr * PL_LD + 32 * ks + 8 * fq);
#pragma unroll
    for (int dc = 0; dc < 4; ++dc) {
        __syncthreads();
#pragma unroll
        for (int i = 0; i < 4; ++i) { const int p = tid + 512 * i; *(LAS u32x4*)(kv + (p >> 5) * PL_LD + (p & 31) * 8) = pre[i]; }
        __syncthreads();
        if (dc < 3) {
#pragma unroll
            for (int i = 0; i < 4; ++i) { const int p = tid + 512 * i; pre[i] = *(const u32x4*)(vsrc + (size_t)(64 * (dc + 1) + (p >> 5)) * 256 + (p & 31) * 8); }
        }
#pragma unroll
        for (int tl = 0; tl < 4; ++tl) {
            f32x4 a = (f32x4){0.f, 0.f, 0.f, 0.f};
#pragma unroll
            for (int ks = 0; ks < 8; ++ks) { const bf16x8 vf = *(const LAS bf16x8*)(kv + (16 * tl + fr) * PL_LD + 32 * ks + 8 * fq); a = mfma16(vf, pf[ks], a); }
            *(u32x2*)(mo + (size_t)row * 1024 + h * 256 + 64 * dc + 16 * tl + 4 * fq) = pack4(a * rl);
        }
    }
    __syncthreads();
}
__device__ __forceinline__ void dif_row(const bf16_t* o0, const bf16_t* o1, bf16_t* dif, const float* gout, float lam, int lane) {
    const u32x4* a = (const u32x4*)o0 + 2 * lane; const u32x4* b = (const u32x4*)o1 + 2 * lane;
    float d[16]; float ss = 0.f;
#pragma unroll
    for (int v = 0; v < 2; ++v) { const u32x4 x = __builtin_nontemporal_load(a + v), y = __builtin_nontemporal_load(b + v);
#pragma unroll
        for (int w = 0; w < 4; ++w) { const float x0 = __uint_as_float(x[w] << 16), x1 = __uint_as_float(x[w] & 0xffff0000u), y0 = __uint_as_float(y[w] << 16), y1 = __uint_as_float(y[w] & 0xffff0000u);
            const float d0 = x0 - lam * y0, d1 = x1 - lam * y1; d[v * 8 + w * 2] = d0; d[v * 8 + w * 2 + 1] = d1; ss += d0 * d0 + d1 * d1; } }
    ss += __shfl_xor(ss, 1); ss += __shfl_xor(ss, 2); ss += __shfl_xor(ss, 4);
    const float rn = __builtin_amdgcn_rsqf(ss * (1.0f / 128.0f) + EPS) * (1.0f - LAM_INIT);
    const float* gp = gout + (lane & 7) * 16;
    u32x4 o[2];
#pragma unroll
    for (int v = 0; v < 2; ++v)
#pragma unroll
        for (int w = 0; w < 4; ++w) o[v][w] = cvt_pk_bf16(d[v * 8 + w * 2] * rn * gp[v * 8 + w * 2], d[v * 8 + w * 2 + 1] * rn * gp[v * 8 + w * 2 + 1]);
    u32x4* op = (u32x4*)dif + 2 * lane; op[0] = o[0]; op[1] = o[1];
}

struct P4bOrder {
    pg8::StaticOrder T; unsigned char* ws; const char* xa;
    __device__ __forceinline__ bool next(int i, pg8::Unit& u) const {
        int pm, pn; if (!T.tile(i, pm, pn)) return false;
        u.pm = pm; u.pn = pn; u.ui = i; u.ri = i; u.tag = 0; u.K = 1024;
        u.A = xa + (size_t)pm * 256 * 1024 * 2;
        u.Bt = (const char*)ws + (pn < 8 ? WS_WRG + (size_t)pn * 256 * 1024 * 2 : WS_WGATE + (size_t)(pn - 8) * 256 * 1024 * 2); return true;
    }
};
struct P5Order {
    pg8::StaticOrder T; unsigned char* ws;
    __device__ __forceinline__ bool next(int i, pg8::Unit& u) const {
        const int ti = i / 3, kbr = i - 3 * ti; int pm, pn; if (!T.tile(ti, pm, pn)) return false;
        const size_t offA = kbr == 0 ? WS_RET : kbr == 1 ? WS_DIF : WS_MO;
        const size_t offB = kbr == 0 ? WS_WBRR : kbr == 1 ? WS_WBRD : WS_WBRM;
        const int K = kbr == 0 ? 2048 : 1024;
        u.pm = pm; u.pn = pn; u.ui = i; u.ri = ti; u.tag = kbr; u.K = K;
        u.A = (const char*)ws + offA + (size_t)pm * 256 * K * 2; u.Bt = (const char*)ws + offB + (size_t)pn * 256 * K * 2; return true;
    }
};
#ifndef PH_MASK
#define PH_MASK 0xffffffffu
#endif
#define PH(n) ((PH_MASK >> (n)) & 1u)
#ifndef DUP_MASK
#define DUP_MASK 0u
#endif
#ifndef PROBE_K
#define PROBE_K (-1)
#endif
#define RUNP(k) (pass_ == 1 || (k) <= PROBE_K)
#define REPQ(n) _Pragma("unroll 1") for (int rq_ = 0; rq_ < 1 + (int)((DUP_MASK >> (n)) & 1u); ++rq_)
#define REP(n) _Pragma("unroll 1") for (int rep_ = 0; rep_ < 1 + (int)((DUP_MASK >> (n)) & 1u); ++rep_)
struct Args { const void* in[26]; float* out; unsigned char* ws; };
#define CAS __attribute__((address_space(4)))
__device__ __forceinline__ const void* karg(int i) { typedef const GAS void* gptr; const CAS gptr* p = (const CAS gptr*)__builtin_amdgcn_kernarg_segment_ptr(); asm volatile("" : "+s"(p)); return (const void*)p[i]; }
#define INP(i) ((const float*)karg(i))
#define WSP(T, off) ((T*)((unsigned char*)karg(27) + (off)))
#define OUTP ((float*)karg(26))
struct SplitWait {
    unsigned target;
    __device__ __forceinline__ void wait() const { if (target) xcd_split_wait((unsigned*)WSP(unsigned, WS_CTL) + CW_BAR2, (unsigned*)WSP(unsigned, WS_CTL) + CW_BAR, target); }
};
__global__ void __launch_bounds__(NWAVES * 64, 2) mk_fwd(Args args) {
    extern __shared__ __attribute__((aligned(16))) unsigned char lds_raw[];
    LAS unsigned char* lds = (LAS unsigned char*)lds_raw;
    volatile LAS unsigned* MISC = (volatile LAS unsigned*)(lds + MISC_OFF);
    const int G = gridDim.x, bx = blockIdx.x;
    for (int u = threadIdx.x; u < (LDS_BYTES - LDSCTL_OFF) / 4; u += NWAVES * 64) ((LAS unsigned*)(lds + LDSCTL_OFF))[u] = 0u;
    __syncthreads();
    (void)xcd_barrier_post((unsigned*)WSP(unsigned, WS_CTL) + CW_BAR, MISC + 8);
#define GRID_BAR() do { XcdBarrier b_; b_.bar = (unsigned*)WSP(unsigned, WS_CTL) + CW_BAR; b_.x = xb_xcc_id(); b_.st = (volatile LAS unsigned*)(lds + MISC_OFF) + 8; xcd_barrier(b_); } while (0)
#define SPLIT_ARRIVE() do { xcd_split_arrive((unsigned*)WSP(unsigned, WS_CTL) + CW_BAR2, (unsigned*)WSP(unsigned, WS_CTL) + CW_BAR, (volatile LAS unsigned*)(lds + MISC_OFF) + 8); ++sgen; } while (0)
    unsigned sgen = 0;
    const int NGW = G * NWAVES, NGT = G * NWAVES * 64;
#define LANE_VARS() const int tid = opaque_tid(), lane = tid & 63, wave = __builtin_amdgcn_readfirstlane(tid >> 6); LAS float* scr = (LAS float*)(lds + wave * 16384); \
    const int gw = bx * NWAVES + wave, gt = bx * (NWAVES * 64) + tid; (void)scr; (void)gw; (void)gt; (void)lane

#pragma unroll 1
    for (int pass_ = (PROBE_K >= 0 ? 0 : 1); pass_ < 2; ++pass_) {
    if (RUNP(0)) {
    REP(0) if (PH(0)) {
        LANE_VARS();
        transpose_all<true>(INP(4), 1024, 2 * DFF, WSP(bf16_t, WS_WF1I), 2 * DFF, ColSwiglu{}, nullptr, scr, gw, NGW, lane);
        transpose_all(INP(18), 1024, 2048, WSP(bf16_t, WS_WMKV), 2048, ColIdent{0}, nullptr, scr, gw, NGW, lane);
        { const float* x = INP(0); const float* g1 = INP(3); bf16_t* xb = WSP(bf16_t, WS_XBL);
          rms_rows_to_bf16(x, g1, xb, gw, NGW, TOK, lane); }
        { const float* mem = INP(1); const float* gm = INP(17); bf16_t* memn = WSP(bf16_t, WS_MEMN);
          rms_rows_to_bf16(mem, gm, memn, gw, NGW, NB * MEML, lane); }
        rot_table((const int*)karg(2), WSP(float, WS_ROT), gt, NGT);
    }
    GRID_BAR();
    }

    if (RUNP(1)) {
    REP(1) if (PH(1)) {
        pg8::Gemm g{WSP(bf16_t, WS_XBL), WSP(bf16_t, WS_WF1I), TOK, 2 * DFF, 1024}; pg8::StaticOrder S; S.init(TOK, 2 * DFF, G, bx);
        EpiSwiglu E{WSP(bf16_t, WS_ACT), nullptr};
        S.set(g); pg8::gemm_phase(lds, S, E);
    }
    if (PH(2)) {
        pg8::Gemm g{WSP(bf16_t, WS_MEMN), WSP(bf16_t, WS_WMKV), NB * MEML, 2048, 1024}; pg8::StaticOrder S; S.init(NB * MEML, 2048, G, (bx + G / 2) % G);
        EpiPlain E{WSP(bf16_t, WS_MKVRAW), 2048};
        S.set(g); pg8::gemm_phase(lds, S, E);
    }
    if (PH(0)) {
        const int q0 = (3 * G) / 4, nq = G - q0;
        if (bx >= q0) {
            LANE_VARS();
            const int gw2 = (bx - q0) * NWAVES + wave, ngw2 = nq * NWAVES;
            transpose_all(INP(5), DFF, 1024, WSP(bf16_t, WS_WF1O), 1024, ColIdent{0}, nullptr, scr, gw2, ngw2, lane);
            transpose_all<true>(INP(7), 1024, 13312, WSP(bf16_t, WS_WMIX), NMIX, ColMix{}, INP(6), scr, gw2, ngw2, lane);
        }
    }
    GRID_BAR();
    }

    if (RUNP(2)) {
    REP(3) if (PH(3)) {
        pg8::Gemm g{WSP(bf16_t, WS_ACT), WSP(bf16_t, WS_WF1O), TOK, 1024, DFF}; pg8::StaticOrder S; S.init(TOK, 1024, G, bx);
        EpiResid<false, false> E{INP(0), nullptr, (bf16_t*)OUTP, WSP(float, WS_SSQ1), 0.5f, (rep_ == 1 && ((DUP_MASK >> 23) & 1u)) ? 1 : 0};
        S.set(g); pg8::gemm_phase(lds, S, E);
    }
    SPLIT_ARRIVE();
    if (PH(0)) {
        LANE_VARS();
        const bf16_t* mkvraw = WSP(bf16_t, WS_MKVRAW); bf16_t* mkn = WSP(bf16_t, WS_MKN); bf16_t* mvt = WSP(bf16_t, WS_MVT);
        const float* g_mem_k = INP(16); const float* g_mem_q = INP(15);
        for (int j = gw; j < NB * MEML * 4; j += NGW) {
            const int row = j >> 2, h = j & 3;
            const u32x2 w = *((const u32x2*)(mkvraw + (size_t)row * 2048 + h * 256) + lane);
            f32x4 v = (f32x4){__uint_as_float(w.x << 16), __uint_as_float(w.x & 0xffff0000u), __uint_as_float(w.y << 16), __uint_as_float(w.y & 0xffff0000u)};
            const float ss = wave_sum((v[0] * v[0] + v[1] * v[1]) + (v[2] * v[2] + v[3] * v[3]));
            const float rn = __builtin_amdgcn_rsqf(ss * (1.0f / 256.0f) + EPS);
            const f32x4 gk = *((const f32x4*)g_mem_k + lane), gq = *((const f32x4*)g_mem_q + lane);
            *((u32x2*)(mkn + (size_t)row * 1024 + h * 256) + lane) = pack4(v * rn * gk * gq);
        }
        for (int idx = gt; idx < NB * 4 * 256 * 256; idx += NGT) {
            const int key = idx & 255, d = (idx >> 8) & 255, bh = idx >> 16, b = bh >> 2, h = bh & 3;
            mvt[idx] = mkvraw[(size_t)(b * 256 + key) * 2048 + 1024 + h * 256 + d];
        }
    }
    { SplitWait H{sgen}; H.wait(); }
    }

    if (RUNP(3))
    for (int ph = 0; ph <= NB; ++ph) {
        const int gp = ph, gm = ph - 1;
        unsigned char* const wsP = WSP(unsigned char, 0) - (((gp + 1) & 1) ? SET_DELTA : 0);
        unsigned char* const wsB = WSP(unsigned char, 0) - (((gm + 1) & 1) ? SET_DELTA : 0);
        unsigned* done = (unsigned*)WSP(unsigned, WS_CTL) + CW_SCAN + ((pass_ * NB + (gm < 0 ? 0 : gm)) * 8) * 64; unsigned* tmo = (unsigned*)WSP(unsigned, WS_CTL) + CW_BAR + XB_TMO;
        const bool early = (gm >= 0 && bx < 64) || gp >= NB;
        if (early) { SplitWait H{sgen}; H.wait(); }
        if (gm >= 0)
            for (int u = bx; u < 64; u += G) REPQ(26) { __syncthreads(); if (PH(5)) scan_unit(u, (const bf16_t*)(wsB + WS_KTS), (const bf16_t*)(wsB + WS_VT), WSP(bf16_t, WS_S), lds, done); }
        if (gp < NB) {
            REP(4) if (PH(4)) {
                pg8::Gemm g{(const bf16_t*)OUTP + (size_t)gp * SEQ * DM, WSP(bf16_t, WS_WMIX), SEQ, NMIX, 1024}; pg8::StaticOrder S; S.init(SEQ, NMIX, G, bx);
                prep_rs(WSP(float, WS_SSQ1), gp * SEQ, S, lds);
                EpiMix E{(const LAS float*)(lds + RTAB_OFF), WSP(float, (gp & 1) ? WS_ROTB : WS_ROT), wsP, WSP(bf16_t, WS_MO) + (size_t)gp * SEQ * 1024, INP(8), INP(9)};
                SplitWait H{early ? 0u : sgen};
                S.set(g); pg8::gemm_phase(lds, S, E, H);
                if (bx >= (SEQ / 256) * (NMIX / 256)) H.wait();
            }
        }
        if (gm >= 0) {
            const size_t oOff = (gm & 1) ? WS_OB : 0;
            unsigned* qctr = (unsigned*)WSP(unsigned, WS_CTL) + CW_QUEUE + (pass_ * NB + gm) * 64;
            volatile LAS unsigned* qslot = (volatile LAS unsigned*)(lds + MISC_OFF) + 16;
            for (;;) {
                __syncthreads();
                if (threadIdx.x == 0) qslot[0] = __hip_atomic_fetch_add(qctr, 1u, __ATOMIC_RELAXED, __HIP_MEMORY_SCOPE_AGENT);
                __syncthreads();
                const int id = __builtin_amdgcn_readfirstlane((int)qslot[0]);
                if (id >= 384) break;
                if (id >= 256) {
                    LANE_VARS();
                    if (id < 320) { if (ph >= 2) {
                        const int gd = ph - 2; const size_t oD = (gd & 1) ? WS_OB : 0;
                        const float s1 = wave_sum(INP(10)[lane] * INP(11)[lane]), s2 = wave_sum(INP(12)[lane] * INP(13)[lane]); const float lam = __expf(s1) - __expf(s2) + LAM_INIT;
                        const bf16_t* bo0 = WSP(bf16_t, WS_O0 + oD); const bf16_t* bo1 = WSP(bf16_t, WS_O1 + oD); bf16_t* difb = WSP(bf16_t, WS_DIF); const float* gdo = INP(14);
                        for (int k = 0; k < 4; ++k) { const int r = (id - 256) * 32 + wave * 4 + k; dif_row(bo0 + (size_t)r * 1024, bo1 + (size_t)r * 1024, difb + ((size_t)gd * SEQ + r) * 1024, gdo, lam, lane); } } }
                    else if (ph + 1 < NB) rot_table((const int*)karg(2) + (ph + 1) * SEQ, WSP(float, ((ph + 1) & 1) ? WS_ROTB : WS_ROT), tid, NWAVES * 64, (id - 320) * 4096, (id - 319) * 4096);
                    continue;
                }
                int aq = -1, aj = 0;
                if (id < 96) { aq = 7 - (id >> 4); aj = id & 15; }
                else if (id >= 192) { const int ro = id - 192;
                    if (PH(8)) REPQ(24) { __syncthreads(); retout_unit(ro >> 4, ro & 15, (const bf16_t*)(wsB + WS_Q), (const bf16_t*)(wsB + WS_K), (const bf16_t*)(wsB + WS_VT), WSP(bf16_t, WS_S),
                                           WSP(bf16_t, WS_RET) + (size_t)gm * SEQ * 2048, WSP(float, WS_SSQ2) + (size_t)gm * SEQ * 8, lds, done, tmo); } }
                else if (id < 160) { const int m = id - 96;
                    if (PH(7)) memattn_unit(gm, m >> 4, m & 15, WSP(bf16_t, WS_MKN), WSP(bf16_t, WS_MVT), WSP(bf16_t, WS_MO) + (size_t)gm * SEQ * 1024, lds); }
                else { aq = 1 - ((id - 160) >> 4); aj = (id - 160) & 15; }
                if (aq >= 0) {
                    const int hc = aj, hh = hc >> 1, cc = hc & 1;
                    if (PH(6)) REPQ(25) attn_body::attn_unit<8>(hc, hh, aq, (const attn_body::bf16*)(wsB + WS_DQ), (const attn_body::bf16*)(wsB + WS_DK), (const attn_body::bf16*)(wsB + WS_DV),
                                            WSP(attn_body::bf16, (cc ? WS_O1 : WS_O0) + oOff), (char*)lds_raw);
                }
            }
        }
        {
            LANE_VARS();
            if (ph == 0) rot_table((const int*)karg(2) + (ph + 1) * SEQ, WSP(float, ((ph + 1) & 1) ? WS_ROTB : WS_ROT), gt, NGT);
            if (ph == 0) transpose_all<true>(INP(7), 1024, 13312, WSP(bf16_t, WS_WRG), 2048, ColIdent{4096}, INP(6), scr, gw, NGW, lane);
            if (ph == NB) {
                transpose_all<true>(INP(7), 1024, 13312, WSP(bf16_t, WS_WGATE), 3072, ColIdent{10240}, INP(6), scr, gw, NGW, lane);
            }
        }
        SPLIT_ARRIVE();
    }

    if (RUNP(4)) {
    if (PH(9)) {
        pg8::StaticOrder T; T.init(TOK, 5120, G, bx);
        prep_rs(WSP(float, WS_SSQ1), 0, T, lds);
        P4bOrder S{T, WSP(unsigned char, 0), (const char*)OUTP};
        EpiRgG E{(const LAS float*)(lds + RTAB_OFF), WSP(bf16_t, WS_RET), WSP(float, WS_SSQ2), WSP(unsigned char, 0)};
        SplitWait H{sgen};
        pg8::gemm_phase(lds, S, E, H);
        if (bx >= (TOK / 256) * (5120 / 256)) H.wait();
    }
    if (PH(0)) {
        LANE_VARS();
        { const float s1 = wave_sum(INP(10)[lane] * INP(11)[lane]), s2 = wave_sum(INP(12)[lane] * INP(13)[lane]); const float lam = __expf(s1) - __expf(s2) + LAM_INIT;
          const bf16_t* bo0 = WSP(bf16_t, WS_O0 + (((NB - 1) & 1) ? WS_OB : 0)); const bf16_t* bo1 = WSP(bf16_t, WS_O1 + (((NB - 1) & 1) ? WS_OB : 0)); bf16_t* difb = WSP(bf16_t, WS_DIF); const float* gdo = INP(14);
          for (int r = gw; r < SEQ; r += NGW) dif_row(bo0 + (size_t)r * 1024, bo1 + (size_t)r * 1024, difb + ((size_t)(NB - 1) * SEQ + r) * 1024, gdo, lam, lane); }
        transpose_all<true>(INP(19), 2048, 1024, WSP(bf16_t, WS_WBRR), 1024, ColIdent{0}, nullptr, scr, gw, NGW, lane);
        transpose_all<true>(INP(20), 1024, 1024, WSP(bf16_t, WS_WBRD), 1024, ColIdent{0}, nullptr, scr, gw, NGW, lane);
        transpose_all<true>(INP(21), 1024, 1024, WSP(bf16_t, WS_WBRM), 1024, ColIdent{0}, nullptr, scr, gw, NGW, lane);
    }
    SPLIT_ARRIVE();
    if (PH(0)) {
        LANE_VARS();
        transpose_all(INP(22), 1024, 1024, WSP(bf16_t, WS_WO), 1024, ColIdent{0}, nullptr, scr, gw, NGW, lane);
        transpose_all<true>(INP(24), 1024, 2 * DFF, WSP(bf16_t, WS_WF2I), DFF, ColSwigluOff{0}, INP(23), scr, gw, NGW, lane);
    }
    { SplitWait H{sgen}; H.wait(); }
    }

    if (RUNP(5)) {
    REP(10) if (PH(10)) {
        pg8::StaticOrder T; T.init(TOK, 1024, G, bx);
        P5Order S{T, WSP(unsigned char, 0)};
        EpiTerm3 E{WSP(unsigned char, 0), WSP(bf16_t, WS_Y)};
        pg8::gemm_phase(lds, S, E);
    }
    SPLIT_ARRIVE();
    if (PH(0)) {
        LANE_VARS();
        transpose_all<true>(INP(24), 1024, 2 * DFF, WSP(bf16_t, WS_WF2I) + (size_t)DFF * 1024, DFF, ColSwigluOff{DFF}, INP(23), scr, gw, NGW, lane);
    }
    { SplitWait H{sgen}; H.wait(); }
    }

    if (RUNP(6)) {
    if (PH(11)) {
        pg8::Gemm g{WSP(bf16_t, WS_Y), WSP(bf16_t, WS_WO), TOK, 1024, 1024}; pg8::StaticOrder S; S.init(TOK, 1024, G, bx);
        EpiResid<true, false> E{OUTP, nullptr, WSP(bf16_t, WS_X2B), WSP(float, WS_SSQ2), 1.0f, 0};
        S.set(g); pg8::gemm_phase(lds, S, E);
    }
    SPLIT_ARRIVE();
    if (PH(0)) {
        LANE_VARS();
        transpose_all(INP(25), DFF, 1024, WSP(bf16_t, WS_WF2O), 1024, ColIdent{0}, nullptr, scr, gw, NGW, lane);
    }
    { SplitWait H{sgen}; H.wait(); }
    }

    if (RUNP(7)) {
    if (PH(12)) {
        pg8::Gemm g{WSP(bf16_t, WS_X2B), WSP(bf16_t, WS_WF2I), TOK, 2 * DFF, 1024}; pg8::StaticOrder S; S.init(TOK, 2 * DFF, G, bx);
        prep_rs(WSP(float, WS_SSQ2), 0, S, lds);
        EpiSwiglu E{WSP(bf16_t, WS_ACT2), (const LAS float*)(lds + RTAB_OFF)};
        S.set(g); pg8::gemm_phase(lds, S, E);
    }
    GRID_BAR();
    }

    if (RUNP(8))
    if (PH(13)) {
        pg8::Gemm g{WSP(bf16_t, WS_ACT2), WSP(bf16_t, WS_WF2O), TOK, 1024, DFF}; pg8::StaticOrder S; S.init(TOK, 1024, G, bx);
        EpiResid<true, true> E{WSP(bf16_t, WS_X2B), OUTP, nullptr, nullptr, 0.5f, 0};
        S.set(g); pg8::gemm_phase(lds, S, E);
    }
    if (pass_ == 0) GRID_BAR();
    }
}

extern "C" void kernel_launch(void* const* d_in, const int* in_sizes, int n_in, void* d_out, int out_size, void* d_ws, size_t ws_size, hipStream_t stream) {
    static int grid = 0;
    if (grid == 0) {
        if (n_in != 26 || ws_size < WS_END) { fprintf(stderr, "kernel_launch: unexpected inputs (n_in %d, ws %zu)\n", n_in, ws_size); grid = -1; return; }
        int dev = 0, cus = 0;
        if (hipGetDevice(&dev) != hipSuccess || hipDeviceGetAttribute(&cus, hipDeviceAttributeMultiprocessorCount, dev) != hipSuccess) { grid = -1; return; }
        if (hipFuncSetAttribute((const void*)mk_fwd, hipFuncAttributeMaxDynamicSharedMemorySize, LDS_BYTES) != hipSuccess) { fprintf(stderr, "kernel_launch: hipFuncSetAttribute failed\n"); grid = -1; return; }
        grid = cus;
    }
    if (grid < 0) return;
    (void)hipMemsetAsync((char*)d_ws + WS_CTL, 0, CTL_ZERO_BYTES, stream);
    Args a{};
    for (int i = 0; i < 26; ++i) a.in[i] = d_in[i];
    a.out = (float*)d_out; a.ws = (unsigned char*)d_ws;
    hipLaunchKernelGGL(mk_fwd, dim3(grid), dim3(NWAVES * 64), LDS_BYTES, stream, a);
}
```

```cpp
#include <hip/hip_runtime.h>
#include <cstdio>
#include <cstdint>

#define LAS __attribute__((address_space(3)))
#define GAS __attribute__((address_space(1)))
typedef unsigned short bf16_t;
typedef short bf16x8 __attribute__((ext_vector_type(8)));
typedef float f32x4 __attribute__((ext_vector_type(4)));
typedef float f32x2 __attribute__((ext_vector_type(2)));
typedef unsigned u32x4 __attribute__((ext_vector_type(4)));
typedef unsigned u32x2 __attribute__((ext_vector_type(2)));

constexpr int NB = 8, SEQ = 2048, DM = 1024, TOK = NB * SEQ, MEML = 256, DFF = 2816;
constexpr int NMIX = 8192;
constexpr float EPS = 1e-6f;
constexpr float LOG2E = 1.4426950408889634f;
constexpr float C2Q = 0.125f * LOG2E;
constexpr float LAM_INIT = 0.2f;

constexpr size_t MiB = 1u << 20;
constexpr size_t KiB = 1u << 10;
constexpr size_t WS_CTL = 0, CTL_ZERO_BYTES = 256 * KiB;
constexpr size_t WS_SSQ1 = 256 * KiB, WS_SSQ2 = 512 * KiB;
constexpr size_t WS_ROT = 1 * MiB, WS_ROTB = 153 * MiB;
constexpr size_t WS_MKN = 3 * MiB, WS_MVT = 7 * MiB;
constexpr size_t WS_WMIX = 11 * MiB;
constexpr size_t WS_XB = 27 * MiB;
constexpr size_t WS_RET = 59 * MiB;
constexpr size_t WS_XBL = 91 * MiB;
constexpr size_t WS_DIF = 123 * MiB;
constexpr size_t WS_MO = 155 * MiB;
constexpr size_t WS_Q = 187 * MiB, WS_K = 191 * MiB, WS_KTS = 195 * MiB, WS_VT = 199 * MiB, WS_DQ = 207 * MiB, WS_DK = 211 * MiB,
                 WS_DV = 215 * MiB;
constexpr size_t SET_DELTA = 160 * MiB;
constexpr size_t WS_WRG = 219 * MiB;
constexpr size_t WS_O0 = 223 * MiB, WS_O1 = 227 * MiB, WS_S = 231 * MiB;
constexpr size_t WS_OB = 24 * MiB;
constexpr size_t WS_WF1I = 59 * MiB, WS_WF1O = 70 * MiB;
constexpr size_t WS_MEMN = 76 * MiB, WS_MKVRAW = 80 * MiB, WS_WMKV = 27 * MiB;
constexpr size_t WS_ACT = 155 * MiB;
constexpr size_t WS_WGATE = 11 * MiB, WS_WBRR = 17 * MiB, WS_WBRD = 21 * MiB, WS_WBRM = 23 * MiB, WS_WO = 25 * MiB;
constexpr size_t WS_G8A = 187 * MiB, WS_G8B = 203 * MiB, WS_G8C = 223 * MiB;
constexpr size_t WS_Y = 27 * MiB;
constexpr size_t WS_X2B = 187 * MiB;
constexpr size_t WS_WF2I = 239 * MiB, WS_WF2O = 1 * MiB, WS_ACT2 = 76 * MiB;
constexpr size_t WS_END = 256 * MiB;
constexpr size_t DO_X8 = 32 * MiB, DO_WG8 = 48 * MiB;

constexpr int CW_BAR = 4096, CW_BAR2 = 8192;
constexpr int CW_QUEUE = 32768;
constexpr int CW_SCAN = 16384;

constexpr int RING_BYTES = 131072, LDSCTL_OFF = RING_BYTES, MISC_OFF = LDSCTL_OFF + 320, LDS_BYTES = 147456;
constexpr int NWAVES = 8;

__device__ __forceinline__ unsigned cvt_pk_bf16(float lo, float hi) { unsigned r; asm volatile("v_cvt_pk_bf16_f32 %0, %1, %2" : "=v"(r) : "v"(lo), "v"(hi)); return r; }
__device__ __forceinline__ unsigned pack4_fp8(f32x4 v) { int w = __builtin_amdgcn_cvt_pk_fp8_f32(v[0], v[1], 0, false); w = __builtin_amdgcn_cvt_pk_fp8_f32(v[2], v[3], w, true); return (unsigned)w; }
__device__ __forceinline__ u32x2 pack4(f32x4 v) { u32x2 w; w.x = cvt_pk_bf16(v[0], v[1]); w.y = cvt_pk_bf16(v[2], v[3]); return w; }
__device__ __forceinline__ unsigned short bf16_1(float v) { return (unsigned short)(cvt_pk_bf16(v, 0.f) & 0xffffu); }
__device__ __forceinline__ float bf2f(unsigned short b) { return __uint_as_float(((unsigned)b) << 16); }
__device__ __forceinline__ float siluf(float x) { return x * __builtin_amdgcn_rcpf(1.0f + __builtin_amdgcn_exp2f(-x * LOG2E)); }
__device__ __forceinline__ float sigmf(float x) { return __builtin_amdgcn_rcpf(1.0f + __builtin_amdgcn_exp2f(-x * LOG2E)); }
__device__ __forceinline__ float row_rs(const float* ssq, int row) {
    const f32x4 a = *(const f32x4*)(ssq + (size_t)row * 4);
    return __builtin_amdgcn_rsqf(((a[0] + a[1]) + (a[2] + a[3])) * (1.0f / 1024.0f) + EPS);
}
__device__ __forceinline__ int opaque_tid() { int t = threadIdx.x; asm volatile("" : "+v"(t)); return t; }
__device__ __forceinline__ f32x4 mfma16(bf16x8 a, bf16x8 b, f32x4 c) { return __builtin_amdgcn_mfma_f32_16x16x32_bf16(a, b, c, 0, 0, 0); }

namespace pg8 {
constexpr int BM = 256, BK = 64, HALF = 128, HTB = HALF * BK * 2, STAGE_BYTES = 8 * HTB, NXCD = 8, WGM = 8;
__host__ __device__ __forceinline__ int lds_byte(int r, int c) { const int st = (r >> 4) * 2 + (c >> 5), rr = r & 15, cc = c & 31, ob = rr * 64 + cc * 2; return st * 1024 + (ob ^ (((ob >> 9) & 1) << 5)); }
__host__ __device__ __forceinline__ void stage_rc(int b, int& R, int& C) { const int st = b / 1024, sb = b % 1024, swz = sb ^ (((sb >> 9) & 1) << 5); R = (st >> 1) * 16 + swz / 64; C = (st & 1) * 32 + (swz % 64) / 2; }
struct Unit { int pm, pn, ui, ri, tag, K; const char* A; const char* Bt; };
struct Gemm { const bf16_t* A; const bf16_t* Bt; int M, N, K; };
struct StaticOrder {
    int nM, nN, nwg, G, c; Gemm g;
    __host__ __device__ void init(int M, int N, int G_, int c_) { nM = M / BM; nN = N / BM; nwg = nM * nN; G = G_; c = c_; g.A = nullptr; g.Bt = nullptr; g.M = M; g.N = N; g.K = 0; }
    __host__ __device__ void set(const Gemm& g_) { g = g_; }
    __host__ __device__ bool tile(int i, int& pm, int& pn) const {
        const long L = (long)i * G + c; if (L >= nwg) return false;
        int wgid = (int)L; { const int q = nwg / NXCD, r = nwg % NXCD, xcd = wgid % NXCD, off = wgid / NXCD; wgid = (xcd < r ? xcd * (q + 1) : r * (q + 1) + (xcd - r) * q) + off; }
        const int nig = WGM * nN, gid = wgid / nig, fm = gid * WGM, gsz = (nM - fm) < WGM ? (nM - fm) : WGM;
        pm = fm + ((wgid % nig) % gsz); pn = (wgid % nig) / gsz; return true;
    }
    __host__ __device__ bool next(int i, Unit& u) const {
        if (!tile(i, u.pm, u.pn)) return false;
        u.ui = i; u.ri = i; u.tag = 0; u.K = g.K;
        u.A = (const char*)g.A + (size_t)u.pm * 256 * g.K * 2; u.Bt = (const char*)g.Bt + (size_t)u.pn * 256 * g.K * 2; return true;
    }
};
struct NoHook { __device__ __forceinline__ void wait() const {} };
typedef int v8i_t __attribute__((ext_vector_type(8)));
typedef int v4i_t __attribute__((ext_vector_type(4)));
__device__ __forceinline__ v8i_t cat8(bf16x8 a, bf16x8 b) { const v4i_t x = __builtin_bit_cast(v4i_t, a), y = __builtin_bit_cast(v4i_t, b); return (v8i_t){x[0], x[1], x[2], x[3], y[0], y[1], y[2], y[3]}; }
template <class Epi, class Sched, class Hook = NoHook, bool F8 = false>
__device__ __forceinline__ void gemm_phase(LAS unsigned char* lds, const Sched& S, const Epi& E, const Hook& H = Hook{}) {
    const int tid = opaque_tid(), wid = __builtin_amdgcn_readfirstlane(tid >> 6), lane = tid & 63, wr = wid >> 2, wc = wid & 3, fr = lane & 15, fq = lane >> 4;
    unsigned R2[2], C2[2];
#pragma unroll
    for (int i = 0; i < 2; ++i) { int R, C; stage_rc(tid * 16 + i * 8192, R, C); R2[i] = (unsigned)R * 2u; C2[i] = (unsigned)C * 2u; }
    const size_t kstep = (size_t)(BK * 2);
    const unsigned ldsw = (unsigned)wid * 1024u;
    const int aoff = lds_byte(wr * 64 + fr, fq * 8), boff = lds_byte(wc * 32 + fr, fq * 8);
#define PG8_SA(b, h) (((b) * 2 + (h)) * HTB)
#define PG8_SB(b, h) ((4 + (b) * 2 + (h)) * HTB)
#define PG8_STAGE(bufoff, gbase, voff) do { _Pragma("unroll") for (int _i = 0; _i < 2; ++_i) { unsigned o_ = (voff)[_i]; if constexpr (F8) asm volatile("" : "+v"(o_));     \
        __builtin_amdgcn_global_load_lds((const unsigned*)((const char*)(gbase) + o_), (LAS unsigned*)(lds + (bufoff) + ldsw + _i * 8192), 16, 0, 0); } } while (0)
#define PG8_LDA(dst, b, h) do { _Pragma("unroll") for (int m = 0; m < 4; ++m) _Pragma("unroll") for (int k = 0; k < 2; ++k) dst[m][k] = *(const LAS bf16x8*)(lds + PG8_SA(b, h) + aoff + m * 2048 + k * 1024); } while (0)
#define PG8_LDB(dst, b, h) do { _Pragma("unroll") for (int n = 0; n < 2; ++n) _Pragma("unroll") for (int k = 0; k < 2; ++k) dst[n][k] = *(const LAS bf16x8*)(lds + PG8_SB(b, h) + boff + n * 2048 + k * 1024); } while (0)
#define PG8_MMA(ai, bj, At, Bt) do { __builtin_amdgcn_s_setprio(1); _Pragma("unroll") for (int m = 0; m < 4; ++m) _Pragma("unroll") for (int n = 0; n < 2; ++n) { \
        if constexpr (F8) acc[ai][bj][m][n] = __builtin_amdgcn_mfma_scale_f32_16x16x128_f8f6f4(cat8(Bt[n][0], Bt[n][1]), cat8(At[m][0], At[m][1]), acc[ai][bj][m][n], 0, 0, 0, 0, 0, 0); \
        else { _Pragma("unroll") for (int k = 0; k < 2; ++k) acc[ai][bj][m][n] = __builtin_amdgcn_mfma_f32_16x16x32_bf16(Bt[n][k], At[m][k], acc[ai][bj][m][n], 0, 0, 0); } } __builtin_amdgcn_s_setprio(0); } while (0)
#define PG8_WAIT_V(n) asm volatile("s_waitcnt vmcnt(" #n ")" ::: "memory")
#define PG8_WAIT_L(n) asm volatile("s_waitcnt lgkmcnt(" #n ")" ::: "memory")
#define PG8_BAR __builtin_amdgcn_s_barrier()
#define PG8_SCHED __builtin_amdgcn_sched_barrier(0)
    Unit cur, nxt; int ui = 0;
    if (!S.next(0, cur)) return;
    f32x4 acc[2][2][4][2];
#pragma unroll
    for (int a = 0; a < 2; ++a)
#pragma unroll
        for (int b = 0; b < 2; ++b)
#pragma unroll
            for (int m = 0; m < 4; ++m)
#pragma unroll
                for (int n = 0; n < 2; ++n) acc[a][b][m][n] = (f32x4){0.f, 0.f, 0.f, 0.f};
    bf16x8 At[4][2], B0[2][2], B1[2][2];
    const char* cA = cur.A; const char* cB = cur.Bt;
    unsigned vo[2] = {R2[0] * (unsigned)cur.K + C2[0], R2[1] * (unsigned)cur.K + C2[1]};
    size_t hstep = (size_t)HALF * cur.K * 2;
    PG8_STAGE(PG8_SB(0, 0), cB, vo); PG8_STAGE(PG8_SB(0, 1), cB + hstep, vo); PG8_STAGE(PG8_SA(0, 0), cA, vo); PG8_STAGE(PG8_SA(0, 1), cA + hstep, vo);
    if (wr == 1) PG8_BAR;
    PG8_WAIT_V(2); PG8_BAR;
    PG8_STAGE(PG8_SB(1, 0), cB + kstep, vo); PG8_STAGE(PG8_SA(1, 0), cA + kstep, vo); PG8_STAGE(PG8_SB(1, 1), cB + hstep + kstep, vo);
    PG8_WAIT_V(6); PG8_BAR;
    for (;;) {
        const bool has_next = S.next(ui + 1, nxt);
        if (!has_next) nxt = cur;
        const char* nA = nxt.A; const char* nB = nxt.Bt;
        unsigned voN0, voN1;
        if constexpr (F8) { voN0 = vo[0]; voN1 = vo[1]; } else { voN0 = R2[0] * (unsigned)nxt.K + C2[0]; voN1 = R2[1] * (unsigned)nxt.K + C2[1]; }
        const size_t hstepN = (size_t)HALF * nxt.K * 2;
        const int nt = cur.K / BK;
        for (int t = 0; t < nt; t += 2) {
            const bool last = (t == nt - 2);
            const char* a1 = cA + (size_t)(t + 1) * kstep;
            const char* a2 = last ? nA : cA + (size_t)(t + 2) * kstep; const char* b2 = last ? nB : cB + (size_t)(t + 2) * kstep;
            const char* a3 = a2 + kstep; const char* b3 = b2 + kstep;
            const unsigned v2[2] = {last ? voN0 : vo[0], last ? voN1 : vo[1]}; const size_t h2 = last ? hstepN : hstep;
            if constexpr (!F8) {
            PG8_LDB(B0, 0, 0); PG8_LDB(B1, 0, 1); PG8_SCHED; PG8_LDA(At, 0, 0); PG8_STAGE(PG8_SA(1, 1), a1 + hstep, vo);
            PG8_WAIT_V(8); PG8_WAIT_L(0); PG8_BAR; PG8_MMA(0, 0, At, B0); PG8_MMA(0, 1, At, B1); PG8_BAR; PG8_SCHED;
            PG8_LDA(At, 0, 1); PG8_STAGE(PG8_SB(0, 0), b2, v2); PG8_STAGE(PG8_SB(0, 1), b2 + h2, v2); PG8_STAGE(PG8_SA(0, 0), a2, v2);
            PG8_WAIT_V(8); PG8_WAIT_L(0); PG8_BAR; PG8_MMA(1, 0, At, B0); PG8_MMA(1, 1, At, B1); PG8_BAR; PG8_SCHED;
            PG8_LDB(B0, 1, 0); PG8_LDB(B1, 1, 1); PG8_SCHED; PG8_LDA(At, 1, 0); PG8_STAGE(PG8_SA(0, 1), a2 + h2, v2);
            PG8_WAIT_V(8); PG8_WAIT_L(0); PG8_BAR; PG8_MMA(0, 0, At, B0); PG8_MMA(0, 1, At, B1); PG8_BAR; PG8_SCHED;
            PG8_LDA(At, 1, 1); PG8_STAGE(PG8_SB(1, 0), b3, v2); PG8_STAGE(PG8_SB(1, 1), b3 + h2, v2); PG8_STAGE(PG8_SA(1, 0), a3, v2);
            PG8_WAIT_V(8); PG8_WAIT_L(0); PG8_BAR; PG8_MMA(1, 0, At, B0); PG8_MMA(1, 1, At, B1); PG8_BAR; PG8_SCHED;
            } else {
            PG8_LDB(B0, 0, 0); PG8_LDB(B1, 0, 1); PG8_SCHED; PG8_LDA(At, 0, 0); PG8_STAGE(PG8_SA(1, 1), a1 + hstep, vo);
            PG8_WAIT_V(8); PG8_WAIT_L(0); PG8_BAR; PG8_MMA(0, 0, At, B0); PG8_MMA(0, 1, At, B1); PG8_BAR; PG8_SCHED;
            PG8_LDA(At, 0, 1); PG8_STAGE(PG8_SB(0, 0), b2, v2); PG8_STAGE(PG8_SB(0, 1), b2 + h2, v2); PG8_STAGE(PG8_SA(0, 0), a2, v2);
            PG8_WAIT_V(8); PG8_WAIT_L(0); PG8_BAR; PG8_MMA(1, 0, At, B0); PG8_MMA(1, 1, At, B1); PG8_BAR; PG8_SCHED;
            PG8_LDB(B0, 1, 0); PG8_LDB(B1, 1, 1); PG8_SCHED; PG8_LDA(At, 1, 0); PG8_STAGE(PG8_SA(0, 1), a2 + h2, v2);
            PG8_WAIT_V(8); PG8_WAIT_L(0); PG8_BAR; PG8_MMA(0, 0, At, B0); PG8_MMA(0, 1, At, B1); PG8_BAR; PG8_SCHED;
            PG8_LDA(At, 1, 1); PG8_STAGE(PG8_SB(1, 0), b3, v2); PG8_STAGE(PG8_SB(1, 1), b3 + h2, v2); PG8_STAGE(PG8_SA(1, 0), a3, v2);
            PG8_WAIT_V(8); PG8_WAIT_L(0); PG8_BAR; PG8_MMA(1, 0, At, B0); PG8_MMA(1, 1, At, B1); PG8_BAR; PG8_SCHED;
            }
        }
        if (wr == 0) PG8_BAR;
        if (ui == 0 && (!Epi::AFTER_DRAIN || has_next)) H.wait();
        if (!Epi::AFTER_DRAIN || has_next) { const int t2_ = opaque_tid(); int fr2 = t2_ & 15, fq2 = (t2_ >> 4) & 3; asm volatile("" : "+v"(fr2), "+v"(fq2)); E(acc, cur, wr, wc, fr2, fq2); }
        if (!has_next) break;
#pragma unroll
        for (int a = 0; a < 2; ++a)
#pragma unroll
            for (int b = 0; b < 2; ++b)
#pragma unroll
                for (int m = 0; m < 4; ++m)
#pragma unroll
                    for (int n = 0; n < 2; ++n) acc[a][b][m][n] = (f32x4){0.f, 0.f, 0.f, 0.f};
        cur = nxt; cA = nA; cB = nB; vo[0] = voN0; vo[1] = voN1; hstep = hstepN; ++ui;
        if (wr == 1) PG8_BAR;
    }
    PG8_WAIT_V(0);
    PG8_BAR;
    if constexpr (Epi::AFTER_DRAIN) { if (ui == 0) H.wait(); }
    if constexpr (Epi::AFTER_DRAIN) { const int t2_ = opaque_tid(); int fr2 = t2_ & 15, fq2 = (t2_ >> 4) & 3; asm volatile("" : "+v"(fr2), "+v"(fq2)); E.fused(acc, cur, wr, wc, fr2, fq2, lds); }
#undef PG8_SA
#undef PG8_SB
#undef PG8_STAGE
#undef PG8_LDA
#undef PG8_LDB
#undef PG8_MMA
#undef PG8_WAIT_V
#undef PG8_WAIT_L
#undef PG8_BAR
#undef PG8_SCHED
}
}

__device__ __forceinline__ float wave_sum(float v);
#define ACC_ARG const f32x4 (&acc)[2][2][4][2]
#define EPI_FENCE() asm volatile("" ::: "memory")
constexpr int RTAB_OFF = RING_BYTES + 1024;
__device__ __forceinline__ void prep_rs(const float* ssq, int row_off, const pg8::StaticOrder& S, LAS unsigned char* lds, int ri0 = 0, int nmax = 6) {
    const int tid = opaque_tid(); LAS float* rtab = (LAS float*)(lds + RTAB_OFF); pg8::Unit u;
    for (int i = 0; i < nmax && S.next(i, u); ++i) if (tid < 256) rtab[(ri0 + i) * 256 + tid] = row_rs(ssq, row_off + u.pm * 256 + tid);
    __syncthreads();
}
struct EpiSwiglu {
    static constexpr bool AFTER_DRAIN = false;
    bf16_t* O; const LAS float* rtab;
    __device__ __forceinline__ void operator()(ACC_ARG, const pg8::Unit& u, int wr, int wc, int fr, int fq) const {
        const int lr0 = wr * 64 + fr, col0 = u.pn * 128 + wc * 32 + 8 * fq;
#pragma unroll
        for (int ai = 0; ai < 2; ++ai)
#pragma unroll
            for (int m = 0; m < 4; ++m) {
                const int lr = lr0 + ai * 128 + m * 16;
                const float rs = rtab ? rtab[u.ri * 256 + lr] : 1.0f;
                u32x4 w;
#pragma unroll
                for (int n = 0; n < 2; ++n) {
                    const f32x4 gt = acc[ai][0][m][n] * rs, up = acc[ai][1][m][n] * rs; f32x4 v;
#pragma unroll
                    for (int j = 0; j < 4; ++j) v[j] = siluf(gt[j]) * up[j];
                    const u32x2 p = pack4(v); if (n == 0) { w.x = p.x; w.y = p.y; } else { w.z = p.x; w.w = p.y; }
                }
                *(u32x4*)(O + (size_t)(u.pm * 256 + lr) * DFF + col0) = w;
            }
    }
};
template <bool BB, bool OF, bool X8 = false>
struct EpiResid {
    static constexpr bool AFTER_DRAIN = true;
    const void* base; float* out; bf16_t* xb; float* ssq; float scale; int skip;
    __device__ __forceinline__ f32x4 ldb(size_t off) const {
        if (BB) { const u32x2 w = __builtin_nontemporal_load((const u32x2*)((const bf16_t*)base + off));
                  return (f32x4){__uint_as_float(w.x << 16), __uint_as_float(w.x & 0xffff0000u), __uint_as_float(w.y << 16), __uint_as_float(w.y & 0xffff0000u)}; }
        return __builtin_nontemporal_load((const f32x4*)((const float*)base + off));
    }
    __device__ __forceinline__ void operator()(ACC_ARG, const pg8::Unit& u, int wr, int wc, int fr, int fq) const {
        if (skip) return;
        const int row0 = u.pm * 256 + wr * 64 + fr, col0 = u.pn * 256 + wc * 32 + 4 * fq;
#pragma unroll
        for (int ai = 0; ai < 2; ++ai)
#pragma unroll
            for (int m = 0; m < 4; ++m) {
                const int row = row0 + ai * 128 + m * 16; float ss = 0.f;
#pragma unroll
                for (int bj = 0; bj < 2; ++bj)
#pragma unroll
                    for (int n = 0; n < 2; ++n) {
                        const size_t off = (size_t)row * DM + col0 + bj * 128 + n * 16;
                        const f32x4 v = ldb(off) + acc[ai][bj][m][n] * scale;
                        if (OF) *(f32x4*)(out + off) = v; else { *(u32x2*)(xb + off) = pack4(v); if constexpr (X8) *(unsigned*)((unsigned char*)out + off) = pack4_fp8(v); }
                        ss += (v[0] * v[0] + v[1] * v[1]) + (v[2] * v[2] + v[3] * v[3]);
                    }
                if (!OF) { ss += __shfl_xor(ss, 16); ss += __shfl_xor(ss, 32); if (fq == 0) atomicAdd(ssq + (size_t)row * 4 + u.pn, ss); }
            }
    }
    __device__ __forceinline__ void fused(ACC_ARG, const pg8::Unit& u, int wr, int wc, int fr, int fq, LAS unsigned char* lds) const {
        if (skip) return;
        const int tid = opaque_tid(), lane = tid & 63, wave = __builtin_amdgcn_readfirstlane(tid >> 6);
        LAS float* tl = (LAS float*)lds;
        u32x2 bvq[2][8];
        if constexpr (BB) {
#pragma unroll
            for (int r = 0; r < 8; ++r) bvq[0][r] = __builtin_nontemporal_load((const u32x2*)((const bf16_t*)base + (size_t)(u.pm * 256 + wave * 8 + r) * DM + u.pn * 256 + lane * 4));
        }
#pragma unroll
        for (int ai = 0; ai < 2; ++ai)
#pragma unroll
            for (int wq = 0; wq < 2; ++wq) {
                const int q = ai * 2 + wq;
                if (wr == wq) {
#pragma unroll
                    for (int m = 0; m < 4; ++m)
#pragma unroll
                        for (int bj = 0; bj < 2; ++bj)
#pragma unroll
                            for (int n = 0; n < 2; ++n) *(LAS f32x4*)(tl + (16 * m + fr) * 260 + bj * 128 + wc * 32 + n * 16 + 4 * fq) = acc[ai][bj][m][n] * scale;
                }
                __syncthreads();
                const int rbase = u.pm * 256 + ai * 128 + wq * 64;
                f32x4 bv[8];
                if constexpr (BB) {
                    if (q < 3) {
#pragma unroll
                        for (int r = 0; r < 8; ++r) bvq[(q + 1) & 1][r] = __builtin_nontemporal_load((const u32x2*)((const bf16_t*)base + (size_t)(rbase + 64 + wave * 8 + r) * DM + u.pn * 256 + lane * 4));
                    }
#pragma unroll
                    for (int r = 0; r < 8; ++r) { const u32x2 w = bvq[q & 1][r];
                        bv[r] = (f32x4){__uint_as_float(w.x << 16), __uint_as_float(w.x & 0xffff0000u), __uint_as_float(w.y << 16), __uint_as_float(w.y & 0xffff0000u)}; }
                } else {
#pragma unroll
                    for (int r = 0; r < 8; ++r) bv[r] = ldb((size_t)(rbase + wave * 8 + r) * DM + u.pn * 256 + lane * 4);
                }
#pragma unroll
                for (int r = 0; r < 8; ++r) {
                    const int row = rbase + wave * 8 + r; const size_t off = (size_t)row * DM + u.pn * 256 + lane * 4;
                    const f32x4 v = bv[r] + *(const LAS f32x4*)(tl + (wave * 8 + r) * 260 + lane * 4);
                    if (OF) __builtin_nontemporal_store(v, (f32x4*)(out + off));
                    else {
                        *(u32x2*)(xb + off) = pack4(v); if constexpr (X8) *(unsigned*)((unsigned char*)out + off) = pack4_fp8(v);
                        const float ss = wave_sum((v[0] * v[0] + v[1] * v[1]) + (v[2] * v[2] + v[3] * v[3])); if (lane == 0) ssq[(size_t)row * 4 + u.pn] = ss;
                    }
                }
                __syncthreads();
            }
    }
};
struct EpiPlain {
    static constexpr bool AFTER_DRAIN = false;
    bf16_t* O; int ldo;
    __device__ __forceinline__ void operator()(ACC_ARG, const pg8::Unit& u, int wr, int wc, int fr, int fq) const {
        const int row0 = u.pm * 256 + wr * 64 + fr, col0 = u.pn * 256 + wc * 32 + 4 * fq;
#pragma unroll
        for (int ai = 0; ai < 2; ++ai)
#pragma unroll
            for (int m = 0; m < 4; ++m)
#pragma unroll
                for (int bj = 0; bj < 2; ++bj)
#pragma unroll
                    for (int n = 0; n < 2; ++n) *(u32x2*)(O + (size_t)(row0 + ai * 128 + m * 16) * ldo + col0 + bj * 128 + n * 16) = pack4(acc[ai][bj][m][n]);
    }
};
struct EpiMix {
    static constexpr bool AFTER_DRAIN = true;
    const LAS float* rtab; const float* rot;
    unsigned char* ws  ; bf16_t* mqb  ; const float *gdq, *gdk;
    static constexpr int TLD = 136;
    __device__ __forceinline__ void flushT(bf16_t* dst  , const LAS bf16_t* TS) const {
        const int tid = opaque_tid();
#pragma unroll
        for (int i = 0; i < 8; ++i) { const int p = tid + 512 * i, c = p >> 4, r8 = p & 15; *(u32x4*)(dst + (size_t)c * SEQ + r8 * 8) = *(const LAS u32x4*)(TS + c * TLD + r8 * 8); }
    }
    __device__ __forceinline__ void operator()(ACC_ARG, const pg8::Unit& u, int wr, int wc, int fr, int fq) const { body(acc, u, wr, wc, fr, fq, nullptr); }
    __device__ __forceinline__ void fused(ACC_ARG, const pg8::Unit& u, int wr, int wc, int fr, int fq, LAS unsigned char* lds) const {
        if (u.pn >= 4 && u.pn < 16) body(acc, u, wr, wc, fr, fq, (LAS bf16_t*)lds); else body(acc, u, wr, wc, fr, fq, nullptr);
    }
    __device__ __forceinline__ void body(ACC_ARG, const pg8::Unit& u, int wr, int wc, int fr, int fq, LAS bf16_t* TS) const {
        const int pn = u.pn, lr0 = wr * 64 + fr, lrow0 = u.pm * 256 + lr0;
        if (pn < 8) {
            const bool isk = pn >= 4; const int h = pn & 3; bf16_t* dst = (bf16_t*)(ws + (isk ? WS_K : WS_Q)); bf16_t* kts = (bf16_t*)(ws + WS_KTS);
            const float lg2 = log2f(1.0f - __builtin_amdgcn_exp2f(-5.0f - (float)h));
#pragma unroll
            for (int ai = 0; ai < 2; ++ai) { const int aim = 2 * ai + 1;
                u32x4 csw[4][2];
#pragma unroll
                for (int m = 0; m < 4; ++m)
#pragma unroll
                    for (int n = 0; n < 2; ++n) csw[m][n] = *(const u32x4*)((const unsigned*)rot + ((size_t)(lrow0 + ai * 128 + m * 16) * 128 + wc * 32 + 8 * fq + 4 * n));
                EPI_FENCE();
#pragma unroll
                for (int m = 0; m < 4; ++m) {
                    int lrow = lrow0 + ai * 128 + m * 16; asm volatile("" : "+v"(lrow));
                    const float rs = rtab[u.ri * 256 + lr0 + ai * 128 + m * 16] * (isk ? 0.0625f : 1.0f);
                    const float dec = __builtin_amdgcn_exp2f(lg2 * (float)(127 - (lrow & 127)));
                    u32x2 q1[2], q2[2];
#pragma unroll
                    for (int n = 0; n < 2; ++n) {
                        const int i0 = wc * 32 + 8 * fq + 4 * n;
                        const u32x4 cw = csw[m][n];
                        const f32x4 cv = (f32x4){__uint_as_float(cw.x << 16), __uint_as_float(cw.y << 16), __uint_as_float(cw.z << 16), __uint_as_float(cw.w << 16)};
                        const f32x4 sv = (f32x4){__uint_as_float(cw.x & 0xffff0000u), __uint_as_float(cw.y & 0xffff0000u), __uint_as_float(cw.z & 0xffff0000u), __uint_as_float(cw.w & 0xffff0000u)};
                        const f32x4 x1 = acc[ai][0][m][n] * rs, x2 = acc[ai][1][m][n] * rs;
                        const f32x4 o1 = x1 * cv - x2 * sv, o2 = x1 * sv + x2 * cv;
                        q1[n] = pack4(o1); q2[n] = pack4(o2);
                        if (isk) {
                            if (TS) {
                                const int rl = wr * 64 + m * 16 + fr;
#pragma unroll
                                for (int j = 0; j < 4; ++j) { TS[(i0 + j) * TLD + rl] = bf16_1(o1[j] * dec); TS[(128 + i0 + j) * TLD + rl] = bf16_1(o2[j] * dec); }
                            } else {
#pragma unroll
                                for (int j = 0; j < 4; ++j) {
                                    kts[(size_t)(h * 256 + i0 + j) * SEQ + lrow] = bf16_1(o1[j] * dec);
                                    kts[(size_t)(h * 256 + 128 + i0 + j) * SEQ + lrow] = bf16_1(o2[j] * dec);
                                }
                            }
                        }
                    }
                    *(u32x4*)(dst + (size_t)lrow * 1024 + h * 256 + wc * 32 + 8 * fq) = (u32x4){q1[0].x, q1[0].y, q1[1].x, q1[1].y};
                    *(u32x4*)(dst + (size_t)lrow * 1024 + h * 256 + 128 + wc * 32 + 8 * fq) = (u32x4){q2[0].x, q2[0].y, q2[1].x, q2[1].y};
                }
                EPI_FENCE();
                if (isk && TS && (aim & 1)) { __syncthreads(); flushT(kts + (size_t)(h * 256) * SEQ + u.pm * 256 + ai * 128, TS); __syncthreads(); }
            }
        } else if (pn < 16) {
            const int h = (pn - 8) >> 1, e0 = ((pn - 8) & 1) * 256; bf16_t* vt = (bf16_t*)(ws + WS_VT);
#pragma unroll
            for (int ai = 0; ai < 2; ++ai) {
#pragma unroll
                for (int m = 0; m < 4; ++m) {
                    int lrow = lrow0 + ai * 128 + m * 16; asm volatile("" : "+v"(lrow));
                    const float rs = rtab[u.ri * 256 + lr0 + ai * 128 + m * 16];
#pragma unroll
                    for (int bj = 0; bj < 2; ++bj)
#pragma unroll
                        for (int n = 0; n < 2; ++n) {
                            const int tc = bj * 128 + wc * 32 + 8 * fq + 4 * n, ec = e0 + tc; const f32x4 v = acc[ai][bj][m][n] * rs;
                            if (TS) {
                                const int rl = wr * 64 + m * 16 + fr;
#pragma unroll
                                for (int j = 0; j < 4; ++j) TS[(tc + j) * TLD + rl] = bf16_1(v[j]);
                            } else {
#pragma unroll
                                for (int j = 0; j < 4; ++j) vt[(size_t)(h * 512 + ec + j) * SEQ + lrow] = bf16_1(v[j]);
                            }
                        }
                    EPI_FENCE();
                }
                if (TS) { __syncthreads(); flushT(vt + (size_t)(h * 512 + e0) * SEQ + u.pm * 256 + ai * 128, TS); __syncthreads(); }
            }
        } else if (pn < 24) {
            const bool isk = pn >= 20; const int tile = (pn - 16) & 3; bf16_t* dst = (bf16_t*)(ws + (isk ? WS_DK : WS_DQ)); const float* gn = isk ? gdk : gdq; const float mul = isk ? 1.0f : C2Q;
            f32x4 gv[2][2];
#pragma unroll
            for (int bj = 0; bj < 2; ++bj)
#pragma unroll
                for (int n = 0; n < 2; ++n) gv[bj][n] = *(const f32x4*)(gn + 32 * bj + 8 * fq + 4 * n);
#pragma unroll
            for (int ai = 0; ai < 2; ++ai)
#pragma unroll
                for (int m = 0; m < 4; ++m) {
                    int lrow = lrow0 + ai * 128 + m * 16; asm volatile("" : "+v"(lrow));
                    const float rs = rtab[u.ri * 256 + lr0 + ai * 128 + m * 16];
                    f32x4 v[2][2]; float ss = 0.f;
#pragma unroll
                    for (int bj = 0; bj < 2; ++bj)
#pragma unroll
                        for (int n = 0; n < 2; ++n) { v[bj][n] = acc[ai][bj][m][n] * rs; const f32x4 t = v[bj][n]; ss += (t[0] * t[0] + t[1] * t[1]) + (t[2] * t[2] + t[3] * t[3]); }
                    ss += __shfl_xor(ss, 16); ss += __shfl_xor(ss, 32);
                    const float rn = __builtin_amdgcn_rsqf(ss * (1.0f / 64.0f) + EPS) * mul;
#pragma unroll
                    for (int bj = 0; bj < 2; ++bj) { const u32x2 p0 = pack4(v[bj][0] * rn * gv[bj][0]), p1 = pack4(v[bj][1] * rn * gv[bj][1]);
                        *(u32x4*)(dst + (size_t)lrow * 1024 + tile * 256 + 64 * wc + 32 * bj + 8 * fq) = (u32x4){p0.x, p0.y, p1.x, p1.y}; }
                    EPI_FENCE();
                }
        } else {
            bf16_t* dst = pn < 28 ? (bf16_t*)(ws + WS_DV) : mqb; const int tile = (pn - 24) & 3;
#pragma unroll
            for (int ai = 0; ai < 2; ++ai)
#pragma unroll
                for (int m = 0; m < 4; ++m) {
                    int lrow = lrow0 + ai * 128 + m * 16; asm volatile("" : "+v"(lrow));
                    const float rs = rtab[u.ri * 256 + lr0 + ai * 128 + m * 16];
#pragma unroll
                    for (int bj = 0; bj < 2; ++bj) { const u32x2 p0 = pack4(acc[ai][bj][m][0] * rs), p1 = pack4(acc[ai][bj][m][1] * rs);
                        *(u32x4*)(dst + (size_t)lrow * 1024 + tile * 256 + bj * 128 + wc * 32 + 8 * fq) = (u32x4){p0.x, p0.y, p1.x, p1.y}; }
                    EPI_FENCE();
                }
        }
    }
};
struct EpiRgG {
    static constexpr bool AFTER_DRAIN = false;
    const LAS float* rtab; bf16_t* ret; const float* rssq; unsigned char* ws;
    __device__ __forceinline__ void operator()(ACC_ARG, const pg8::Unit& u, int wr, int wc, int fr, int fq) const {
        const int lr0 = wr * 64 + fr;
        if (u.pn < 8) {
            const int col0 = u.pn * 256 + wc * 32 + 8 * fq;
            u32x4 rv[2][4][2]; f32x2 rq2[2][4];
#pragma unroll
            for (int ai = 0; ai < 2; ++ai)
#pragma unroll
                for (int m = 0; m < 4; ++m) { const int lr = lr0 + ai * 128 + m * 16;
                    rq2[ai][m] = *(const f32x2*)(rssq + (size_t)(u.pm * 256 + lr) * 8 + 2 * (u.pn >> 1));
#pragma unroll
                    for (int bj = 0; bj < 2; ++bj) rv[ai][m][bj] = *(const u32x4*)(ret + (size_t)(u.pm * 256 + lr) * 2048 + col0 + bj * 128); }
            EPI_FENCE();
#pragma unroll
            for (int ai = 0; ai < 2; ++ai) {
#pragma unroll
                for (int m = 0; m < 4; ++m) {
                    const int lr = lr0 + ai * 128 + m * 16; const float rs = rtab[u.ri * 256 + lr];
                    const float rr = __builtin_amdgcn_rsqf((rq2[ai][m][0] + rq2[ai][m][1]) * (1.0f / 512.0f) + EPS);
#pragma unroll
                    for (int bj = 0; bj < 2; ++bj) {
                        u32x4 o;
#pragma unroll
                        for (int n = 0; n < 2; ++n) {
                            const unsigned w0 = n == 0 ? rv[ai][m][bj].x : rv[ai][m][bj].z, w1 = n == 0 ? rv[ai][m][bj].y : rv[ai][m][bj].w; const f32x4 a = acc[ai][bj][m][n] * rs; f32x4 v;
                            v[0] = __uint_as_float(w0 << 16) * siluf(a[0]); v[1] = __uint_as_float(w0 & 0xffff0000u) * siluf(a[1]);
                            v[2] = __uint_as_float(w1 << 16) * siluf(a[2]); v[3] = __uint_as_float(w1 & 0xffff0000u) * siluf(a[3]);
                            const u32x2 p = pack4(v * rr); if (n == 0) { o.x = p.x; o.y = p.y; } else { o.z = p.x; o.w = p.y; }
                        }
                        *(u32x4*)(ret + (size_t)(u.pm * 256 + lr) * 2048 + col0 + bj * 128) = o;
                    }
                }
                EPI_FENCE();
            }
        } else {
            const int br = (u.pn - 8) >> 2, col0 = ((u.pn - 8) & 3) * 256 + wc * 32 + 8 * fq;
            unsigned char* g8 = ws + (br == 0 ? WS_G8A : br == 1 ? WS_G8B : WS_G8C);
#pragma unroll
            for (int ai = 0; ai < 2; ++ai)
#pragma unroll
                for (int m = 0; m < 4; ++m) {
                    const int lr = lr0 + ai * 128 + m * 16; const float c1 = rtab[u.ri * 256 + lr] * (-LOG2E / 64.0f);
#pragma unroll
                    for (int bj = 0; bj < 2; ++bj) {
                        u32x2 w2;
#pragma unroll
                        for (int n = 0; n < 2; ++n) {
                            const f32x4 a = acc[ai][bj][m][n]; unsigned w = 0u;
#pragma unroll
                            for (int j = 0; j < 4; ++j) { const float g = 255.0f * __builtin_amdgcn_rcpf(1.0f + __builtin_amdgcn_exp2f(a[j] * c1));
                                asm("v_cvt_pk_u8_f32 %0, %1, %2, %0" : "+v"(w) : "v"(g), "n"(j)); }
                            if (n == 0) w2.x = w; else w2.y = w;
                        }
                        *(u32x2*)(g8 + (size_t)(u.pm * 256 + lr) * DM + col0 + bj * 128) = w2;
                    }
                }
        }
    }
};
struct EpiTerm3 {
    static constexpr bool AFTER_DRAIN = false;
    unsigned char* ws; bf16_t* y;
    __device__ __forceinline__ void operator()(ACC_ARG, const pg8::Unit& u, int wr, int wc, int fr, int fq) const {
        const int lr0 = wr * 64 + fr, col0 = u.pn * 256 + wc * 32 + 8 * fq, first = (u.tag == 0);
        unsigned char* g8 = ws + (u.tag == 0 ? WS_G8A : u.tag == 1 ? WS_G8B : WS_G8C);
        const __amdgpu_buffer_rsrc_t rg = __builtin_amdgcn_make_buffer_rsrc(g8, 0, 16 * 1024 * 1024, 0x00020000);
        const __amdgpu_buffer_rsrc_t ry = __builtin_amdgcn_make_buffer_rsrc(y, 0, 32 * 1024 * 1024, 0x00020000);
        const unsigned vo = (unsigned)((u.pm * 256 + lr0) * DM + col0);
        u32x2 gva[2][4][2]; u32x4 yva[2][4][2];
#pragma unroll
        for (int ai = 0; ai < 2; ++ai)
#pragma unroll
            for (int m = 0; m < 4; ++m)
#pragma unroll
                for (int bj = 0; bj < 2; ++bj) { const unsigned so = (unsigned)((ai * 128 + m * 16) * DM + bj * 128);
                    gva[ai][m][bj] = __builtin_amdgcn_raw_buffer_load_b64(rg, vo, so, 0);
                    if (first) yva[ai][m][bj] = (u32x4){0u, 0u, 0u, 0u}; else yva[ai][m][bj] = __builtin_amdgcn_raw_buffer_load_b128(ry, 2 * vo, 2 * so, 0); }
        EPI_FENCE();
#pragma unroll
        for (int ai = 0; ai < 2; ++ai) {
#pragma unroll
            for (int m = 0; m < 4; ++m)
#pragma unroll
                for (int bj = 0; bj < 2; ++bj) {
                    const unsigned so = (unsigned)((ai * 128 + m * 16) * DM + bj * 128);
                    const u32x2 gv = gva[ai][m][bj]; const u32x4 yv = yva[ai][m][bj];
                    u32x4 o;
#pragma unroll
                    for (int n = 0; n < 2; ++n) {
                        const f32x4 a = acc[ai][bj][m][n]; const unsigned gw = n == 0 ? gv.x : gv.y; const unsigned w0 = n == 0 ? yv.x : yv.z, w1 = n == 0 ? yv.y : yv.w; f32x4 v;
                        v[0] = (float)(gw & 255u) * (1.0f / 255.0f) * a[0] + __uint_as_float(w0 << 16); v[1] = (float)((gw >> 8) & 255u) * (1.0f / 255.0f) * a[1] + __uint_as_float(w0 & 0xffff0000u);
                        v[2] = (float)((gw >> 16) & 255u) * (1.0f / 255.0f) * a[2] + __uint_as_float(w1 << 16); v[3] = (float)(gw >> 24) * (1.0f / 255.0f) * a[3] + __uint_as_float(w1 & 0xffff0000u);
                        const u32x2 p = pack4(v); if (n == 0) { o.x = p.x; o.y = p.y; } else { o.z = p.x; o.w = p.y; }
                    }
                    __builtin_amdgcn_raw_buffer_store_b128(o, ry, 2 * vo, 2 * so, 0);
                }
            EPI_FENCE();
        }
    }
};

#include <hip/hip_bf16.h>
namespace attn_body {
using bf16=__hip_bfloat16;
using bf16x8=__attribute__((ext_vector_type(8)))short;
using s16x4=__attribute__((ext_vector_type(4)))short;
using f32x16=__attribute__((ext_vector_type(16)))float;
using u32x4=__attribute__((ext_vector_type(4)))unsigned;
constexpr int D=64,DM=1024;
constexpr int NW=8,QBLK=32,QB=QBLK*NW,KVBLK=64;
__device__ __forceinline__ int crow(int r,int hi){return (r&3)+8*(r>>2)+4*hi;}
#define SBAR() __builtin_amdgcn_sched_barrier(0)
__device__ __forceinline__ void cmask(f32x16&p0,f32x16&p1,int jb,int qrel,int hi){
  const float NEG=-INFINITY; int kb=64*jb+4*hi;
  #pragma unroll
  for(int r=0;r<16;++r){int kv=kb+(r&3)+8*(r>>2); if(kv>qrel)p0[r]=NEG; if(kv+32>qrel)p1[r]=NEG;}
}
constexpr int NSLOT=3, SLOTB=8192;
constexpr int LDS_K=0, LDS_V=NSLOT*SLOTB, LDS_WS=LDS_V+2*NSLOT*SLOTB, LDS_OST=LDS_WS+NW*64*4, LDS_BYTES=LDS_OST+NW*4096;
__device__ __forceinline__ void glds16(const void*gsrc,unsigned lds_dst){unsigned keep;
  asm volatile("s_mov_b32 %0, m0\n\ts_mov_b32 m0, %2\n\ts_nop 0\n\tglobal_load_lds_dwordx4 %1, off\n\ts_mov_b32 m0, %0":"=&s"(keep):"v"(gsrc),"s"(lds_dst):"memory");}
__device__ __forceinline__ float max3f(float a,float b,float c){float r;asm("v_max3_f32 %0, %1, %2, %3":"=v"(r):"v"(a),"v"(b),"v"(c));return r;}
__device__ __forceinline__ float max2f(float a,float b){float r;asm("v_max_f32_e32 %0, %1, %2":"=v"(r):"v"(a),"v"(b));return r;}
__device__ __forceinline__ float fadd_s(float a,float b){float r;asm("v_add_f32_e32 %0, %1, %2":"=v"(r):"v"(a),"v"(b));return r;}
__device__ __forceinline__ float fsub_s(float a,float b){float r;asm("v_sub_f32_e32 %0, %1, %2":"=v"(r):"v"(a),"v"(b));return r;}
typedef float f32x2_t __attribute__((ext_vector_type(2))); typedef __bf16 bf16x2_t __attribute__((ext_vector_type(2)));
__device__ __forceinline__ unsigned cvtpk_s(float lo,float hi){f32x2_t v={lo,hi};bf16x2_t b=__builtin_convertvector(v,bf16x2_t);return __builtin_bit_cast(unsigned,b);}
#define WAIT_BAR(N) asm volatile("s_waitcnt vmcnt(" #N ") lgkmcnt(0)\n\ts_barrier":::"memory")
__device__ __forceinline__ void qkt(f32x16&p0,f32x16&p1,const char*Kslot,const bf16x8*qr,const f32x16&negm,int r32,int hi){
  const char*kb=Kslot+hi*1024+r32*16;
  #pragma unroll
  for(int d0=0;d0<4;++d0){
    const bf16x8 b0=*reinterpret_cast<const bf16x8*>(kb+d0*2048);
    const bf16x8 b1=*reinterpret_cast<const bf16x8*>(kb+d0*2048+512);
    if(d0==0){p0=__builtin_amdgcn_mfma_f32_32x32x16_bf16(b0,qr[0],negm,0,0,0);p1=__builtin_amdgcn_mfma_f32_32x32x16_bf16(b1,qr[0],negm,0,0,0);}
    else{p0=__builtin_amdgcn_mfma_f32_32x32x16_bf16(b0,qr[d0],p0,0,0,0);p1=__builtin_amdgcn_mfma_f32_32x32x16_bf16(b1,qr[d0],p1,0,0,0);}}
}
typedef __attribute__((address_space(3))) const char* lds_cptr;
typedef short v4i16_t __attribute__((ext_vector_type(4)));
__device__ __forceinline__ void kload8(bf16x8*kf,lds_cptr kp){
  kf[0]=*(const __attribute__((address_space(3))) bf16x8*)(kp);      kf[1]=*(const __attribute__((address_space(3))) bf16x8*)(kp+512);
  kf[2]=*(const __attribute__((address_space(3))) bf16x8*)(kp+2048); kf[3]=*(const __attribute__((address_space(3))) bf16x8*)(kp+2560);
  kf[4]=*(const __attribute__((address_space(3))) bf16x8*)(kp+4096); kf[5]=*(const __attribute__((address_space(3))) bf16x8*)(kp+4608);
  kf[6]=*(const __attribute__((address_space(3))) bf16x8*)(kp+6144); kf[7]=*(const __attribute__((address_space(3))) bf16x8*)(kp+6656);
}
__device__ __forceinline__ void kload2(bf16x8*kf,lds_cptr kp,int j){ kf[2*j]=*(const __attribute__((address_space(3))) bf16x8*)(kp+j*2048); kf[2*j+1]=*(const __attribute__((address_space(3))) bf16x8*)(kp+j*2048+512); }
__device__ __forceinline__ s16x4 vtr(lds_cptr p){ return __builtin_bit_cast(s16x4,__builtin_amdgcn_ds_read_tr16_b64_v4i16((__attribute__((address_space(3))) v4i16_t*)p)); }
__device__ __forceinline__ float rowmax(const f32x16&p0,const f32x16&p1){
  float a=max3f(p0[0],p0[1],p1[0]),b=max3f(p0[2],p0[3],p1[1]);a=max3f(a,p1[2],p1[3]);
  #pragma unroll
  for(int r=4;r<16;r+=4){a=max3f(a,p0[r],p0[r+1]);b=max3f(b,p0[r+2],p0[r+3]);a=max3f(a,p1[r],p1[r+1]);b=max3f(b,p1[r+2],p1[r+3]);}
  const float m=max2f(a,b);
  auto rr=__builtin_amdgcn_permlane32_swap(__float_as_uint(m),__float_as_uint(m),false,false);
  return max2f(__uint_as_float(rr[0]),__uint_as_float(rr[1]));
}
__device__ __forceinline__ void pv(f32x16*o,int vb,bf16x8 pa0,bf16x8 pa1,bf16x8 pa2,bf16x8 pa3){
  #pragma unroll
  for(int d0=0;d0<4;++d0){s16x4 lo[4],hi[4];
    #pragma unroll
    for(int ks=0;ks<4;++ks){
      asm volatile("ds_read_b64_tr_b16 %0,%1 offset:%c2":"=&v"(lo[ks]):"v"(vb),"i"(d0*4096+ks*1024):"memory");
      asm volatile("ds_read_b64_tr_b16 %0,%1 offset:%c2":"=&v"(hi[ks]):"v"(vb),"i"(d0*4096+ks*1024+512):"memory");}
    asm volatile("s_waitcnt lgkmcnt(0)":::"memory");SBAR();
    #define PK(k) (bf16x8){lo[k][0],lo[k][1],lo[k][2],lo[k][3],hi[k][0],hi[k][1],hi[k][2],hi[k][3]}
    o[d0]=__builtin_amdgcn_mfma_f32_32x32x16_bf16(pa0,PK(0),o[d0],0,0,0);
    o[d0]=__builtin_amdgcn_mfma_f32_32x32x16_bf16(pa1,PK(1),o[d0],0,0,0);
    o[d0]=__builtin_amdgcn_mfma_f32_32x32x16_bf16(pa2,PK(2),o[d0],0,0,0);
    o[d0]=__builtin_amdgcn_mfma_f32_32x32x16_bf16(pa3,PK(3),o[d0],0,0,0);
    #undef PK
  }
}
#define ATTN_STORE16(p,v) (*(u32x4*)(p)=(v))
template<int THRL> __device__ __forceinline__ void attn_unit(int hq,int hv,int qb,const bf16*Q,const bf16*__restrict__ K,const bf16*__restrict__ V,bf16*O,char*shm){
  const int tid=opaque_tid(),lane=tid&63,r32=lane&31,hi=lane>>5; const int wid=__builtin_amdgcn_readfirstlane(tid>>6);
  const int q0=qb*QB;
  const bf16*Qw=Q+(long)(q0+wid*QBLK)*DM+hq*D;
  const bf16*Kh=K+hq*D,*Vh=V+hv*128;
  const unsigned lds0=(unsigned)(uintptr_t)shm;
  float*wsf=(float*)(shm+LDS_WS)+wid*64;
  const bf16*ksrc=Kh+(long)lane*DM+wid*8;
  const bf16*vsrc=Vh+(long)(16*(wid&3)+(lane>>2))*DM+(wid>>2)*32+(lane&3)*8;
  const unsigned kdst=lds0+LDS_K+wid*1024, vdst=lds0+LDS_V+wid*1024;
  #define DMA_K(t,slot) glds16(ksrc+(long)(t)*KVBLK*DM,(unsigned)__builtin_amdgcn_readfirstlane(kdst+(slot)))
  #define DMA_V(t,slot) do{ glds16(vsrc+(long)(t)*KVBLK*DM,(unsigned)__builtin_amdgcn_readfirstlane(vdst+2*(slot))); glds16(vsrc+(long)(t)*KVBLK*DM+64,(unsigned)__builtin_amdgcn_readfirstlane(vdst+2*(slot)+8192)); }while(0)
  const int vb0=(int)(lds0+LDS_V)+((lane>>4)&1)*32+(lane&3)*8+(4*hi+((lane&15)>>2))*64;
  const char*Kbase=shm+LDS_K; bf16x8 kf[8];
  const lds_cptr shm3=(lds_cptr)shm; const lds_cptr kp0=shm3+LDS_K+hi*1024+r32*16; const lds_cptr vp0=shm3+LDS_V+((lane>>4)&1)*32+(lane&3)*8+(4*hi+((lane&15)>>2))*64;
  const int NT=(q0+QB)/KVBLK;
  DMA_K(0,0);DMA_V(0,0);DMA_K(1,SLOTB);
  bf16x8 qr[4];
  #pragma unroll
  for(int d0=0;d0<4;++d0)qr[d0]=*reinterpret_cast<const bf16x8*>(&Qw[(long)r32*DM+d0*16+hi*8]);
  float mhat=0.f,l_reg=0.f;f32x16 o[4];o[0]=f32x16{};o[1]=f32x16{};o[2]=f32x16{};o[3]=f32x16{};asm volatile("":"+v"(o[0]),"+v"(o[1]),"+v"(o[2]),"+v"(o[3]));f32x16 negm=f32x16{};asm volatile("":"+v"(negm));
  const int qrel=wid*QBLK+r32;
  #define CMASK(P0,P1,t) do{int jb_=(t)-(NT-4); if(jb_>=0)cmask(P0,P1,jb_,qrel,hi);}while(0)
  bool resc=false;
  #define START(P0,P1) do{ const float rm=rowmax(P0,P1); resc=false; \
    { const float dl=rm; mhat=fadd_s(mhat,dl); \
      _Pragma("unroll") for(int r=0;r<16;++r){P0[r]=fsub_s(P0[r],dl);P1[r]=fsub_s(P1[r],dl);} \
      _Pragma("unroll") for(int r=0;r<16;++r)negm[r]=-mhat; asm volatile("":"+v"(negm)); } \
    _Pragma("unroll") for(int r=0;r<16;++r)P0[r]=__builtin_amdgcn_exp2f(P0[r]); }while(0)
  #define RESC() do{ if(resc){ asm volatile("s_waitcnt lgkmcnt(0)":::"memory"); \
      _Pragma("unroll") for(int d_=0;d_<4;++d_) _Pragma("unroll") for(int r=0;r<16;++r)o[d_][r]*=wsf[crow(r,hi)]; } }while(0)
  f32x16 pA0,pA1,pB0,pB1;
  int sl_prev=0,sl_cur=0,sl_next=SLOTB;
  #define ROT() do{sl_prev=sl_cur;sl_cur=sl_next;sl_next=(sl_next==(NSLOT-1)*SLOTB)?0:sl_next+SLOTB;}while(0)
  DMA_K(2,2*SLOTB);
  WAIT_BAR(3);
  qkt(pA0,pA1,Kbase,qr,negm,r32,hi);asm volatile("s_nop 15\n\ts_nop 7":"+v"(pA0),"+v"(pA1));CMASK(pA0,pA1,0);
  START(pA0,pA1);
  _Pragma("unroll") for(int r=0;r<16;++r)pA1[r]=__builtin_amdgcn_exp2f(pA1[r]);
  WAIT_BAR(0);
  DMA_K(3,0);DMA_V(1,SLOTB);
  ROT();
  kload8(kf,kp0+sl_cur);
  WAIT_BAR(3);
  s16x4 vlo[16],vhi[16]; u32x4 pw0,pw1,pw2,pw3;
  #define PKW(P,B) cvtpk_s(P[B],P[B+1])
  #define PAF(k) __builtin_bit_cast(bf16x8,pw##k)
  #define VFR(i) (bf16x8){vlo[i][0],vlo[i][1],vlo[i][2],vlo[i][3],vhi[i][0],vhi[i][1],vhi[i][2],vhi[i][3]}
  #define PIN(x) asm volatile("":"+v"(x))
  #define MX3(a,b,c) __builtin_fmaxf(__builtin_fmaxf((a),(b)),(c))
  #define GAPA(MF,A0,A1,A2,A3,W0,W1,PW) do{ MF; sacc+=A0; sacc+=A1; sacc+=A2; sacc+=A3; PIN(sacc); W0; W1; PIN(PW); SBAR(); }while(0)
  #define EX(v) __builtin_amdgcn_exp2f(v)
  #define GAPB(MF,X,B) do{ MF; X[B]=EX(X[B]); X[B+1]=EX(X[B+1]); PIN(X); SBAR(); }while(0)
  #define VRD(i) do{ vlo[i]=vtr(vp_+(((i)>>2)*4096+((i)&3)*1024)); vhi[i]=vtr(vp_+(((i)>>2)*4096+((i)&3)*1024+512)); }while(0)
  #define KRD(G,j) do{ if(G){ kload2(kf,kp0+sl_next,j); SBAR(); } }while(0)
  #define STEP(C0,C1,P0,P1,t,GK,GV,GL) do{ SBAR(); \
    const lds_cptr vp_=vp0+2*sl_prev; \
    float sacc=(P0[0]+P0[1]); \
    GAPA(C0=__builtin_amdgcn_mfma_f32_32x32x16_bf16(kf[0],qr[0],negm,0,0,0), P0[2],P0[3],P0[4],P0[5],     pw0[0]=PKW(P0,0), pw0[1]=PKW(P0,2), pw0); \
    GAPA(C1=__builtin_amdgcn_mfma_f32_32x32x16_bf16(kf[1],qr[0],negm,0,0,0), P0[6],P0[7],P0[8],P0[9],     pw0[2]=PKW(P0,4), pw0[3]=PKW(P0,6), pw0); \
    GAPA(C0=__builtin_amdgcn_mfma_f32_32x32x16_bf16(kf[2],qr[1],C0,0,0,0),   P0[10],P0[11],P0[12],P0[13], pw1[0]=PKW(P0,8), pw1[1]=PKW(P0,10), pw1); \
    GAPA(C1=__builtin_amdgcn_mfma_f32_32x32x16_bf16(kf[3],qr[1],C1,0,0,0),   P0[14],P0[15],P1[0],P1[1],   pw1[2]=PKW(P0,12),pw1[3]=PKW(P0,14), pw1); \
    GAPA(C0=__builtin_amdgcn_mfma_f32_32x32x16_bf16(kf[4],qr[2],C0,0,0,0),   P1[2],P1[3],P1[4],P1[5],     pw2[0]=PKW(P1,0), pw2[1]=PKW(P1,2), pw2); \
    GAPA(C1=__builtin_amdgcn_mfma_f32_32x32x16_bf16(kf[5],qr[2],C1,0,0,0),   P1[6],P1[7],P1[8],P1[9],     pw2[2]=PKW(P1,4), pw2[3]=PKW(P1,6), pw2); \
    GAPA(C0=__builtin_amdgcn_mfma_f32_32x32x16_bf16(kf[6],qr[3],C0,0,0,0),   P1[10],P1[11],P1[12],P1[13], pw3[0]=PKW(P1,8), pw3[1]=PKW(P1,10), pw3); \
    GAPA(C1=__builtin_amdgcn_mfma_f32_32x32x16_bf16(kf[7],qr[3],C1,0,0,0),   P1[14],P1[15],0.f,0.f,       pw3[2]=PKW(P1,12),pw3[3]=PKW(P1,14), pw3); \
    VRD(0); VRD(4); VRD(8); VRD(12); VRD(1); VRD(5); VRD(9); VRD(13); SBAR(); \
    l_reg+=sacc; \
    if(GK){DMA_K((t)+3,sl_cur);} if(GV){DMA_V((t)+1,sl_next);} \
    CMASK(C0,C1,t); \
    { float a=MX3(C0[0],C0[1],C1[0]),b=MX3(C0[2],C0[3],C1[1]); a=MX3(a,C1[2],C1[3]); \
      _Pragma("unroll") for(int r=4;r<16;r+=4){a=MX3(a,C0[r],C0[r+1]);b=MX3(b,C0[r+2],C0[r+3]);a=MX3(a,C1[r],C1[r+1]);b=MX3(b,C1[r+2],C1[r+3]);} \
      float rm=__builtin_fmaxf(a,b); { auto rr=__builtin_amdgcn_permlane32_swap(__float_as_uint(rm),__float_as_uint(rm),false,false); rm=__builtin_fmaxf(__uint_as_float(rr[0]),__uint_as_float(rr[1])); } \
      resc=false; \
      if(__builtin_expect(__any(rm>(float)THRL),0)){ const float dl=__builtin_fmaxf(rm,0.f); mhat+=dl; \
        _Pragma("unroll") for(int r=0;r<16;++r){C0[r]-=dl;C1[r]-=dl;} \
        _Pragma("unroll") for(int r=0;r<16;++r)negm[r]=-mhat; asm volatile("":"+v"(negm)); \
        const float f=__builtin_amdgcn_exp2f(-dl); l_reg*=f; if(hi==0)wsf[r32]=f; resc=true; } } \
    SBAR(); \
    GAPB(o[0]=__builtin_amdgcn_mfma_f32_32x32x16_bf16(PAF(0),VFR(0),o[0],0,0,0),  C0,0);  VRD(2);  SBAR(); \
    GAPB(o[1]=__builtin_amdgcn_mfma_f32_32x32x16_bf16(PAF(0),VFR(4),o[1],0,0,0),  C0,2);  VRD(6);  SBAR(); \
    GAPB(o[2]=__builtin_amdgcn_mfma_f32_32x32x16_bf16(PAF(0),VFR(8),o[2],0,0,0),  C0,4);  VRD(10); SBAR(); \
    GAPB(o[3]=__builtin_amdgcn_mfma_f32_32x32x16_bf16(PAF(0),VFR(12),o[3],0,0,0), C0,6);  VRD(14); SBAR(); \
    GAPB(o[0]=__builtin_amdgcn_mfma_f32_32x32x16_bf16(PAF(1),VFR(1),o[0],0,0,0),  C0,8);  VRD(3);  SBAR(); \
    GAPB(o[1]=__builtin_amdgcn_mfma_f32_32x32x16_bf16(PAF(1),VFR(5),o[1],0,0,0),  C0,10); VRD(7);  SBAR(); \
    GAPB(o[2]=__builtin_amdgcn_mfma_f32_32x32x16_bf16(PAF(1),VFR(9),o[2],0,0,0),  C0,12); VRD(11); SBAR(); \
    GAPB(o[3]=__builtin_amdgcn_mfma_f32_32x32x16_bf16(PAF(1),VFR(13),o[3],0,0,0), C0,14); VRD(15); SBAR(); \
    KRD(GL,0); GAPB(o[0]=__builtin_amdgcn_mfma_f32_32x32x16_bf16(PAF(2),VFR(2),o[0],0,0,0),  C1,0); \
    KRD(GL,1); GAPB(o[1]=__builtin_amdgcn_mfma_f32_32x32x16_bf16(PAF(2),VFR(6),o[1],0,0,0),  C1,2); \
    KRD(GL,2); GAPB(o[2]=__builtin_amdgcn_mfma_f32_32x32x16_bf16(PAF(2),VFR(10),o[2],0,0,0), C1,4); \
    KRD(GL,3); GAPB(o[3]=__builtin_amdgcn_mfma_f32_32x32x16_bf16(PAF(2),VFR(14),o[3],0,0,0), C1,6); \
    GAPB(o[0]=__builtin_amdgcn_mfma_f32_32x32x16_bf16(PAF(3),VFR(3),o[0],0,0,0),  C1,8); \
    GAPB(o[1]=__builtin_amdgcn_mfma_f32_32x32x16_bf16(PAF(3),VFR(7),o[1],0,0,0),  C1,10); \
    GAPB(o[2]=__builtin_amdgcn_mfma_f32_32x32x16_bf16(PAF(3),VFR(11),o[2],0,0,0), C1,12); \
    GAPB(o[3]=__builtin_amdgcn_mfma_f32_32x32x16_bf16(PAF(3),VFR(15),o[3],0,0,0), C1,14); \
    }while(0)
  int t=1;
  #undef CMASK
  #define CMASK(P0,P1,t) do{}while(0)
  for(;t+5<NT;t+=2){
    STEP(pB0,pB1,pA0,pA1,t,true,true,true);     WAIT_BAR(3); RESC(); ROT();
    STEP(pA0,pA1,pB0,pB1,t+1,true,true,true);   WAIT_BAR(3); RESC(); ROT();
  }
  #undef CMASK
  #define CMASK(P0,P1,t) do{int jb_=(t)-(NT-4); if(jb_>=0)cmask(P0,P1,jb_,qrel,hi);}while(0)
  #define ENDW(tt) do{ if((tt)+3<NT){WAIT_BAR(3);} else if((tt)+2<NT){WAIT_BAR(2);} else {WAIT_BAR(0);} }while(0)
  for(;t+1<NT;t+=2){
    STEP(pB0,pB1,pA0,pA1,t,(t+3<NT),(t+1<NT),(t+1<NT));       ENDW(t);   RESC(); ROT();
    STEP(pA0,pA1,pB0,pB1,t+1,(t+4<NT),(t+2<NT),(t+2<NT));     ENDW(t+1); RESC(); ROT();
  }
  STEP(pB0,pB1,pA0,pA1,NT-1,false,false,false); RESC();
  { float sacc=pB0[0]+pB0[1]; _Pragma("unroll") for(int r=2;r<16;++r)sacc+=pB0[r]; _Pragma("unroll") for(int r=0;r<16;++r)sacc+=pB1[r]; l_reg+=sacc;
    pw0=(u32x4){PKW(pB0,0),PKW(pB0,2),PKW(pB0,4),PKW(pB0,6)};pw1=(u32x4){PKW(pB0,8),PKW(pB0,10),PKW(pB0,12),PKW(pB0,14)};pw2=(u32x4){PKW(pB1,0),PKW(pB1,2),PKW(pB1,4),PKW(pB1,6)};pw3=(u32x4){PKW(pB1,8),PKW(pB1,10),PKW(pB1,12),PKW(pB1,14)};
    SBAR(); pv(o,vb0+2*sl_cur,PAF(0),PAF(1),PAF(2),PAF(3)); }
  #undef PKW
  #undef PAF
  #undef VFR
  #undef PIN
  #undef MX3
  #undef GAPA
  #undef GAPB
  #undef EX
  #undef VRD
  #undef KRD
  #undef STEP
  #undef ENDW
  {auto rr=__builtin_amdgcn_permlane32_swap(__float_as_uint(l_reg),__float_as_uint(l_reg),false,false);l_reg=__uint_as_float(rr[0])+__uint_as_float(rr[1]);}
  if(hi==0)wsf[32+r32]=l_reg;asm volatile("s_waitcnt lgkmcnt(0)":::"memory");
  float rli[16];
  #pragma unroll
  for(int r=0;r<16;++r)rli[r]=__builtin_amdgcn_rcpf(wsf[32+crow(r,hi)]);
  bf16*Ow=O+(long)(q0+wid*QBLK)*DM+hv*128;
  { bf16*stg=(bf16*)(shm+LDS_OST)+wid*2048;
    #pragma unroll
    for(int hf=0;hf<2;++hf){
      #pragma unroll
      for(int r=0;r<16;++r){const int orow=crow(r,hi);
        #pragma unroll
        for(int d0=0;d0<2;++d0)stg[orow*64+d0*32+r32]=__float2bfloat16(o[2*hf+d0][r]*rli[r]);}
      asm volatile("s_waitcnt lgkmcnt(0)":::"memory");
      u32x4 v4[4];
      #pragma unroll
      for(int i=0;i<4;++i){const int row=i*8+(lane>>3),ch=lane&7; v4[i]=*(const u32x4*)(stg+row*64+ch*8);}
      asm volatile("s_waitcnt lgkmcnt(0)":::"memory");
      #pragma unroll
      for(int i=0;i<4;++i){const int row=i*8+(lane>>3),ch=lane&7; ATTN_STORE16(Ow+(long)row*DM+hf*64+ch*8,v4[i]);} } }
  asm volatile("s_waitcnt lgkmcnt(0)\n\ts_barrier":::"memory");
  #undef DMA_K
  #undef DMA_V
  #undef CMASK
  #undef START
  #undef RESC
  #undef ROT
}
constexpr int ATTN_LDS_BYTES=LDS_BYTES;
#undef SBAR
#undef WAIT_BAR
}

typedef GAS unsigned gu32;
#define RLX_AGENT __ATOMIC_RELAXED, __HIP_MEMORY_SCOPE_AGENT
#define LDS_WAIT() asm volatile("s_waitcnt lgkmcnt(0)" ::: "memory")
#define XB_TMO      128
#define XB_XCNT(j)  (256  + 64 * (j))
#define XB_XSUB(j)  (1280 + 64 * (j))
#define XB_XGEN(j)  (2304 + 64 * (j))
#define XB_TOP      3328
#define XB_TOPGEN   3392
#define XCD_BAR_WORDS 3456
#define XB_SPIN_CAP (1u << 18)
__device__ __forceinline__ unsigned xb_ld(unsigned* p)              { return __hip_atomic_load(p, __ATOMIC_RELAXED, __HIP_MEMORY_SCOPE_AGENT); }
__device__ __forceinline__ unsigned xb_add(unsigned* p, unsigned v) { return __hip_atomic_fetch_add(p, v, __ATOMIC_RELAXED, __HIP_MEMORY_SCOPE_AGENT); }
__device__ __forceinline__ unsigned xb_xcc_id() { return (unsigned)__builtin_amdgcn_s_getreg((3 << 11) | 20) & 0xFu; }
#define XB_SPIN(cond, bar) do { unsigned _sp = 0; while (cond) { __builtin_amdgcn_s_sleep(1); \
    if ((++_sp & 255u) == 0u) { if (xb_ld(&(bar)[XB_TMO])) break; if (_sp > XB_SPIN_CAP) { atomicAdd(&(bar)[XB_TMO], 1u); break; } } } } while (0)
struct XcdBarrier { unsigned* bar; unsigned x; volatile LAS unsigned* st; };
__device__ __forceinline__ XcdBarrier xcd_barrier_post(unsigned* bar, volatile LAS unsigned* st) {
    XcdBarrier b; b.bar = bar; b.x = xb_xcc_id(); b.st = st;
    if (threadIdx.x == 0) (void)xb_add(&bar[XB_XCNT(b.x)], 1u);
    return b;
}
__device__ __forceinline__ void xcd_barrier_complete(unsigned* bar, unsigned x, unsigned& nloc, unsigned& nx) {
    const unsigned G = gridDim.x * gridDim.y * gridDim.z;
    unsigned sum, cnt, mine, sp = 0u;
    for (;;) {
        sum = 0u; cnt = 0u; mine = 0u;
#pragma unroll
        for (unsigned j = 0; j < 16; ++j) { const unsigned c = xb_ld(&bar[XB_XCNT(j)]); sum += c; cnt += (c > 0u) ? 1u : 0u; mine = (j == x) ? c : mine; }
        if (sum == G) break;
        __builtin_amdgcn_s_sleep(1);
        if ((++sp & 255u) == 0u) { if (xb_ld(&bar[XB_TMO])) break; if (sp > XB_SPIN_CAP) { atomicAdd(&bar[XB_TMO], 1u); break; } }
    }
    nloc = mine > 0u ? mine : 1u; nx = cnt > 0u ? cnt : 1u;
}
__device__ __forceinline__ void xcd_barrier(const XcdBarrier& b) {
    asm volatile("s_waitcnt vmcnt(0)" ::: "memory");
    __syncthreads();
    if (threadIdx.x == 0) {
        unsigned* bar = b.bar; asm volatile("" : "+v"(bar));
        __builtin_amdgcn_s_waitcnt(0);
        unsigned nloc = b.st[0], nx = b.st[1];
        if (nloc == 0u) { xcd_barrier_complete(bar, b.x, nloc, nx); b.st[0] = nloc; b.st[1] = nx; }
        const unsigned old = xb_add(&bar[XB_XSUB(b.x)], 1u);
        const unsigned gen = old / nloc;
        if (old + 1u == (gen + 1u) * nloc) {
            __builtin_amdgcn_fence(__ATOMIC_RELEASE, "agent");
            asm volatile("s_waitcnt vmcnt(0)" ::: "memory");
            const unsigned og = xb_add(&bar[XB_TOP], 1u);
            const unsigned tg = og / nx;
            if (og + 1u == (tg + 1u) * nx) xb_add(&bar[XB_TOPGEN], 1u);
            else XB_SPIN(xb_ld(&bar[XB_TOPGEN]) == tg, bar);
            __builtin_amdgcn_fence(__ATOMIC_ACQUIRE, "agent");
            xb_add(&bar[XB_XGEN(b.x)], 1u);
            asm volatile("s_waitcnt vmcnt(0)" ::: "memory");
        } else {
            XB_SPIN(xb_ld(&bar[XB_XGEN(b.x)]) == gen, bar);
            __builtin_amdgcn_fence(__ATOMIC_ACQUIRE, "agent");
            asm volatile("s_waitcnt vmcnt(0)" ::: "memory");
        }
    }
    __syncthreads();
}

#define XB2_XSUB(j) (64 * (j))
#define XB2_TOP     1024
#define XB2_TOPGEN  1088
__device__ __forceinline__ void xcd_split_arrive(unsigned* bar2, unsigned* bar, volatile LAS unsigned* st) {
    asm volatile("s_waitcnt vmcnt(0)" ::: "memory");
    __syncthreads();
    if (threadIdx.x == 0) {
        asm volatile("" : "+v"(bar2));
        __builtin_amdgcn_s_waitcnt(0);
        unsigned nloc = st[0], nx = st[1]; const unsigned x = xb_xcc_id();
        if (nloc == 0u) { xcd_barrier_complete(bar, x, nloc, nx); st[0] = nloc; st[1] = nx; }
        const unsigned old = xb_add(&bar2[XB2_XSUB(x)], 1u);
        if ((old + 1u) % nloc == 0u) {
            __builtin_amdgcn_fence(__ATOMIC_RELEASE, "agent");
            asm volatile("s_waitcnt vmcnt(0)" ::: "memory");
            const unsigned og = xb_add(&bar2[XB2_TOP], 1u);
            if ((og + 1u) % nx == 0u) xb_add(&bar2[XB2_TOPGEN], 1u);
            asm volatile("s_waitcnt vmcnt(0)" ::: "memory");
        }
    }
}
__device__ __forceinline__ void xcd_split_wait(unsigned* bar2, unsigned* bar, unsigned target) {
    if (threadIdx.x == 0) {
        asm volatile("" : "+v"(bar2));
        XB_SPIN(xb_ld(&bar2[XB2_TOPGEN]) < target, bar);
        __builtin_amdgcn_fence(__ATOMIC_ACQUIRE, "agent");
        asm volatile("s_waitcnt vmcnt(0)" ::: "memory");
    }
    __syncthreads();
}

__device__ __forceinline__ float wave_sum(float v) {
#pragma unroll
    for (int o = 1; o < 64; o <<= 1) v += __shfl_xor(v, o);
    return v;
}
template <class F>
__device__ __forceinline__ void transpose_load(const float* W, int ld, int nrows, F srccol, int item, int lane, f32x4 (&v)[8]) {
    const int nblk = nrows / 32, kb = item / nblk, nb = item % nblk, k0 = 64 * kb, s0 = srccol(32 * nb);
#pragma unroll
    for (int i = 0; i < 8; ++i) v[i] = __builtin_nontemporal_load((const f32x4*)(W + (size_t)(k0 + 8 * i + (lane >> 3)) * ld + s0 + 4 * (lane & 7)));
}
__host__ __device__ __forceinline__ int perm32(int rho) { const int n = rho >> 4, i = rho & 15; return 8 * (i >> 2) + 4 * n + (i & 3); }
template <bool PERM>
__device__ __forceinline__ void transpose_store(int K, bf16_t* WT, int nrows, const float* gk, LAS float* scr, int item, int lane, const f32x4 (&v)[8]) {
    const int nblk = nrows / 32, kb = item / nblk, nb = item % nblk, k0 = 64 * kb, n0 = 32 * nb;
#pragma unroll
    for (int i = 0; i < 8; ++i) { const int kk = 8 * i + (lane >> 3); const float g = gk ? gk[k0 + kk] : 1.0f;
#pragma unroll
        for (int e = 0; e < 4; ++e) scr[kk * 33 + 4 * (lane & 7) + e] = v[i][e] * g; }
    LDS_WAIT(); asm volatile("" ::: "memory");
    const int c = lane & 7;
#pragma unroll
    for (int j = 0; j < 4; ++j) { const int n = (lane >> 3) + 8 * j; const LAS float* s = scr + (8 * c) * 33 + (PERM ? perm32(n) : n);
        u32x4 o; o.x = cvt_pk_bf16(s[0 * 33], s[1 * 33]); o.y = cvt_pk_bf16(s[2 * 33], s[3 * 33]); o.z = cvt_pk_bf16(s[4 * 33], s[5 * 33]); o.w = cvt_pk_bf16(s[6 * 33], s[7 * 33]);
        *(u32x4*)(WT + (size_t)(n0 + n) * K + k0 + 8 * c) = o; }
    LDS_WAIT(); asm volatile("" ::: "memory");
}
template <bool PERM>
__device__ __forceinline__ void transpose_store_f8(int K, unsigned char* WT, int nrows, const float* gk, float mul, LAS float* scr, int item, int lane, const f32x4 (&v)[8]) {
    const int nblk = nrows / 32, kb = item / nblk, nb = item % nblk, k0 = 64 * kb, n0 = 32 * nb;
#pragma unroll
    for (int i = 0; i < 8; ++i) { const int kk = 8 * i + (lane >> 3); const float g = (gk ? gk[k0 + kk] : 1.0f) * mul;
#pragma unroll
        for (int e = 0; e < 4; ++e) scr[kk * 33 + 4 * (lane & 7) + e] = v[i][e] * g; }
    LDS_WAIT(); asm volatile("" ::: "memory");
    const int c = lane & 7;
#pragma unroll
    for (int j = 0; j < 4; ++j) { const int n = (lane >> 3) + 8 * j; const LAS float* s = scr + (8 * c) * 33 + (PERM ? perm32(n) : n);
        u32x2 o; o.x = pack4_fp8((f32x4){s[0 * 33], s[1 * 33], s[2 * 33], s[3 * 33]}); o.y = pack4_fp8((f32x4){s[4 * 33], s[5 * 33], s[6 * 33], s[7 * 33]});
        *(u32x2*)(WT + (size_t)(n0 + n) * K + k0 + 8 * c) = o; }
    LDS_WAIT(); asm volatile("" ::: "memory");
}
struct ColIdent { int off; __device__ __forceinline__ int operator()(int r) const { return off + r; } };
struct ColSwiglu { __device__ __forceinline__ int operator()(int r) const { return ((r >> 7) & 1) * DFF + (r >> 8) * 128 + (r & 127); } };
struct ColSwigluOff { int r0; __device__ __forceinline__ int operator()(int r) const { return ColSwiglu{}(r + r0); } };
struct ColMix { __device__ __forceinline__ int operator()(int r) const {
    const int tile = r >> 8, p = r & 255, o = 64 * ((p >> 5) & 3) + 32 * (p >> 7) + (p & 31);
    if (tile < 16) return r;
    if (tile < 20) return 6144 + (tile - 16) * 256 + o;
    if (tile < 24) return 7168 + (tile - 20) * 256 + o;
    if (tile < 28) return 8192 + (tile - 24) * 256 + p;
    return 9216 + (tile - 28) * 256 + p; } };
template <bool PERM = false, class F>
__device__ __forceinline__ void transpose_all(const float* W, int K, int ld, bf16_t* WT, int nrows, F srccol, const float* gk, LAS float* scr, int gw, int ngw, int lane) {
    const int nitems = (K / 64) * (nrows / 32);
    for (int it = gw; it < nitems; it += 2 * ngw) {
        f32x4 va[8], vb[8]; const int it2 = it + ngw;
        transpose_load(W, ld, nrows, srccol, it, lane, va);
        if (it2 < nitems) transpose_load(W, ld, nrows, srccol, it2, lane, vb);
        transpose_store<PERM>(K, WT, nrows, gk, scr, it, lane, va);
        if (it2 < nitems) transpose_store<PERM>(K, WT, nrows, gk, scr, it2, lane, vb);
    }
}
template <bool PERM = false, class F>
__device__ __forceinline__ void transpose_all_f8(const float* W, int K, int ld, unsigned char* WT, int nrows, F srccol, const float* gk, float mul, LAS float* scr, int gw, int ngw, int lane) {
    const int nitems = (K / 64) * (nrows / 32);
    for (int it = gw; it < nitems; it += 2 * ngw) {
        f32x4 va[8], vb[8]; const int it2 = it + ngw;
        transpose_load(W, ld, nrows, srccol, it, lane, va);
        if (it2 < nitems) transpose_load(W, ld, nrows, srccol, it2, lane, vb);
        transpose_store_f8<PERM>(K, WT, nrows, gk, mul, scr, it, lane, va);
        if (it2 < nitems) transpose_store_f8<PERM>(K, WT, nrows, gk, mul, scr, it2, lane, vb);
    }
}
__device__ __forceinline__ void rms_rows_to_bf16(const float* x, const float* gain, bf16_t* o, int m0, int step, int nrows, int lane) {
    const f32x4* gr = (const f32x4*)gain + lane;
    for (int m = m0; m < nrows; m += 2 * step) {
        const int m2 = (m + step < nrows) ? m + step : m;
        const f32x4* xa = (const f32x4*)(x + (size_t)m * DM) + lane; const f32x4* xb2 = (const f32x4*)(x + (size_t)m2 * DM) + lane;
        f32x4 va[4], vb[4]; float sa = 0.f, sb = 0.f;
#pragma unroll
        for (int j = 0; j < 4; ++j) { va[j] = __builtin_nontemporal_load(xa + 64 * j); vb[j] = __builtin_nontemporal_load(xb2 + 64 * j); }
#pragma unroll
        for (int j = 0; j < 4; ++j) { sa += (va[j][0] * va[j][0] + va[j][1] * va[j][1]) + (va[j][2] * va[j][2] + va[j][3] * va[j][3]); sb += (vb[j][0] * vb[j][0] + vb[j][1] * vb[j][1]) + (vb[j][2] * vb[j][2] + vb[j][3] * vb[j][3]); }
        const float ra = __builtin_amdgcn_rsqf(wave_sum(sa) * (1.f / 1024.f) + EPS), rb = __builtin_amdgcn_rsqf(wave_sum(sb) * (1.f / 1024.f) + EPS);
        u32x2* oa = (u32x2*)(o + (size_t)m * DM) + lane; u32x2* ob = (u32x2*)(o + (size_t)m2 * DM) + lane;
#pragma unroll
        for (int j = 0; j < 4; ++j) { const f32x4 g = gr[64 * j]; oa[64 * j] = pack4(va[j] * ra * g); if (m2 != m) ob[64 * j] = pack4(vb[j] * rb * g); }
    }
}
__device__ __forceinline__ void rot_table(const int* pos, float* rot, int gt, int ngt, int idx0 = 0, int idx1 = SEQ * 128) {
    for (int idx = idx0 + gt; idx < idx1; idx += ngt) {
        const int s = idx >> 7, i = idx & 127;
        const float inv = exp2f(-(float)i * (13.287712379549449f / 128.0f));
        const float ang = (float)pos[s] * inv;
        const float kq = rintf(ang * 0.6366197723675814f);
        float r = fmaf(-kq, 1.5703125f, ang); r = fmaf(-kq, 4.837512969970703125e-4f, r); r = fmaf(-kq, 7.54978995489188216e-8f, r);
        const float r2 = r * r;
        const float sn = r + r * r2 * (-1.6666667e-1f + r2 * (8.3333333e-3f + r2 * (-1.9841270e-4f + r2 * 2.7557319e-6f)));
        const float cn = 1.0f + r2 * (-0.5f + r2 * (4.1666668e-2f + r2 * (-1.3888889e-3f + r2 * (2.4801587e-5f + r2 * -2.7557319e-7f))));
        const int qd = ((int)kq) & 3;
        const float c = (qd == 0) ? cn : (qd == 1) ? -sn : (qd == 2) ? -cn : sn;
        const float sv = (qd == 0) ? sn : (qd == 1) ? cn : (qd == 2) ? -sn : -cn;
        ((unsigned*)rot)[idx] = cvt_pk_bf16(c, sv);
    }
}

constexpr int SNP_LD = 72;
constexpr int SCN_LD = 136, SCN_V_OFF = 64 * SCN_LD * 2, SCN_CH = 192 * SCN_LD * 2;
constexpr unsigned SCAN_UNITS_PER_FLAG = 8;
__device__ __forceinline__ void scan_unit(int u, const bf16_t* kts, const bf16_t* vt, bf16_t* S, LAS unsigned char* lds, unsigned* done  ) {
    const int tid = opaque_tid(), lane = tid & 63, wave = __builtin_amdgcn_readfirstlane(tid >> 6);
    const int fr = lane & 15, fq = lane >> 4, h = u >> 4, dg = (u >> 2) & 3, eg = u & 3, wd = wave & 1, we = wave >> 1;
    const float gC = __builtin_amdgcn_exp2f(128.0f * log2f(1.0f - __builtin_amdgcn_exp2f(-5.0f - (float)h)));
    f32x4 acc[2][2];
#pragma unroll
    for (int a = 0; a < 2; ++a)
#pragma unroll
        for (int b = 0; b < 2; ++b) acc[a][b] = (f32x4){0.f, 0.f, 0.f, 0.f};
    const bf16_t* ksrc = kts + (size_t)(h * 256 + 64 * dg + (tid >> 4)) * SEQ + (tid & 15) * 8;
    const bf16_t* vsrc = vt + (size_t)(h * 512 + 128 * eg + (tid >> 4)) * SEQ + (tid & 15) * 8;
    u32x4 pk[3][2][2], pv[3][2][4];
#pragma unroll
    for (int sb = 0; sb < 3; ++sb)
#pragma unroll
        for (int i = 0; i < 2; ++i) {
#pragma unroll
            for (int j = 0; j < 2; ++j) pk[sb][i][j] = *(const u32x4*)(ksrc + (size_t)(32 * j) * SEQ + (2 * sb + i) * 128);
#pragma unroll
            for (int j = 0; j < 4; ++j) pv[sb][i][j] = *(const u32x4*)(vsrc + (size_t)(32 * j) * SEQ + (2 * sb + i) * 128);
        }
    LAS bf16_t* stg = (LAS bf16_t*)(lds + 2 * SCN_CH);
    const __amdgpu_buffer_rsrc_t srs = __builtin_amdgcn_make_buffer_rsrc(S, 0, 16 * 1024 * 1024, 0x00020000);
    const unsigned sbase = (unsigned)((((size_t)(h * 16) * 512 + 128 * eg) * 256 + 64 * dg) * 2);
#define SCN_SNAP_W() do { _Pragma("unroll") for (int td = 0; td < 2; ++td) _Pragma("unroll") for (int te = 0; te < 2; ++te) \
        *(LAS u32x2*)(stg + (32 * we + 16 * te + fr) * SNP_LD + 32 * wd + 16 * td + 4 * fq) = pack4(acc[td][te]); } while (0)
#define SCN_SNAP_ST(c_) do { _Pragma("unroll") for (int k = 0; k < 2; ++k) { const int p_ = tid + 512 * k, row_ = p_ >> 3, c16_ = p_ & 7; \
        const u32x4 v_ = *(const LAS u32x4*)(stg + row_ * SNP_LD + c16_ * 8); \
        __builtin_amdgcn_raw_buffer_store_b128(v_, srs, sbase + (unsigned)(((c_) * 512 + row_) * 512 + c16_ * 16), 0, 16  ); } } while (0)
#define SCN_UPD(i_) do { const LAS bf16_t* lk = (const LAS bf16_t*)(lds + (i_) * SCN_CH); const LAS bf16_t* lv = (const LAS bf16_t*)(lds + (i_) * SCN_CH + SCN_V_OFF); \
        f32x4 tm[2][2]; _Pragma("unroll") for (int td = 0; td < 2; ++td) _Pragma("unroll") for (int te = 0; te < 2; ++te) tm[td][te] = (f32x4){0.f, 0.f, 0.f, 0.f}; \
        _Pragma("unroll") for (int ks = 0; ks < 4; ++ks) { bf16x8 a[2], b[2]; \
            _Pragma("unroll") for (int t = 0; t < 2; ++t) { a[t] = *(const LAS bf16x8*)(lk + (32 * wd + 16 * t + fr) * SCN_LD + 32 * ks + 8 * fq); b[t] = *(const LAS bf16x8*)(lv + (32 * we + 16 * t + fr) * SCN_LD + 32 * ks + 8 * fq); } \
            _Pragma("unroll") for (int td = 0; td < 2; ++td) _Pragma("unroll") for (int te = 0; te < 2; ++te) tm[td][te] = mfma16(a[td], b[te], tm[td][te]); }        \
        _Pragma("unroll") for (int td = 0; td < 2; ++td) _Pragma("unroll") for (int te = 0; te < 2; ++te) acc[td][te] = acc[td][te] * gC + tm[td][te]; } while (0)
#pragma unroll
    for (int r = 0; r < 8; ++r) {
        __syncthreads();
#pragma unroll
        for (int i = 0; i < 2; ++i) {
            if (2 * r + i < 15) {
                LAS bf16_t* lk = (LAS bf16_t*)(lds + i * SCN_CH); LAS bf16_t* lv = (LAS bf16_t*)(lds + i * SCN_CH + SCN_V_OFF);
#pragma unroll
                for (int j = 0; j < 2; ++j) *(LAS u32x4*)(lk + (32 * j + (tid >> 4)) * SCN_LD + (tid & 15) * 8) = pk[r % 3][i][j];
#pragma unroll
                for (int j = 0; j < 4; ++j) *(LAS u32x4*)(lv + (32 * j + (tid >> 4)) * SCN_LD + (tid & 15) * 8) = pv[r % 3][i][j];
            }
        }
        SCN_SNAP_W();
        __syncthreads();
        if (r < 5) {
#pragma unroll
            for (int i = 0; i < 2; ++i) { const int c = 2 * (r + 3) + i;
                if (c < 15) {
#pragma unroll
                    for (int j = 0; j < 2; ++j) pk[r % 3][i][j] = *(const u32x4*)(ksrc + (size_t)(32 * j) * SEQ + c * 128);
#pragma unroll
                    for (int j = 0; j < 4; ++j) pv[r % 3][i][j] = *(const u32x4*)(vsrc + (size_t)(32 * j) * SEQ + c * 128);
                } }
        }
        SCN_SNAP_ST(2 * r);
        SCN_UPD(0);
        __syncthreads();
        SCN_SNAP_W();
        __syncthreads();
        SCN_SNAP_ST(2 * r + 1);
        if (2 * r + 1 < 15) SCN_UPD(1);
    }
#undef SCN_SNAP_W
#undef SCN_SNAP_ST
#undef SCN_UPD
    asm volatile("s_waitcnt vmcnt(0)" ::: "memory");
    __syncthreads();
    if (tid == 0) __hip_atomic_fetch_add(done + ((h * 2 + (eg >> 1)) * 64), 1u, __ATOMIC_RELAXED, __HIP_MEMORY_SCOPE_AGENT);
}
constexpr int RQ_LD = 264, SC_LD = 136, RO_SC_OFF = 128 * RQ_LD * 2, RO_PART_OFF = RO_SC_OFF + 128 * SC_LD * 2;
__device__ __forceinline__ void retout_unit(int h, int c, const bf16_t* q, const bf16_t* k, const bf16_t* vt, const bf16_t* S, bf16_t* ret  , float* rssq, LAS unsigned char* lds, unsigned* done, unsigned* tmo) {
    const int tid = opaque_tid(), lane = tid & 63, wave = __builtin_amdgcn_readfirstlane(tid >> 6);
    const int fr = lane & 15, fq = lane >> 4;
    LAS bf16_t* ql = (LAS bf16_t*)lds; LAS bf16_t* sc = (LAS bf16_t*)(lds + RO_SC_OFF); LAS float* part = (LAS float*)(lds + RO_PART_OFF);
    const float lg2 = log2f(1.0f - __builtin_amdgcn_exp2f(-5.0f - (float)h));
    const int tok0 = c * 128;
    if (tid < 64) {
        unsigned* f = done + ((h * 2) * 64); unsigned sp = 0;
        while ((unsigned)__builtin_amdgcn_readfirstlane(__hip_atomic_load(f, __ATOMIC_RELAXED, __HIP_MEMORY_SCOPE_AGENT)) < SCAN_UNITS_PER_FLAG ||
               (unsigned)__builtin_amdgcn_readfirstlane(__hip_atomic_load(f + 64, __ATOMIC_RELAXED, __HIP_MEMORY_SCOPE_AGENT)) < SCAN_UNITS_PER_FLAG) {
            __builtin_amdgcn_s_sleep(2);
            if (++sp > (1u << 20)) { if (tid == 0) __hip_atomic_store(tmo, 1u, __ATOMIC_RELAXED, __HIP_MEMORY_SCOPE_AGENT); break; }
        }
        __builtin_amdgcn_fence(__ATOMIC_ACQUIRE, "agent");
        asm volatile("s_waitcnt vmcnt(0)" ::: "memory");
    }
    __syncthreads();
    const bf16_t* sp = S + ((size_t)((h * 16 + c) * 512 + 32 * wave + fr)) * 256 + 8 * fq;
    const bf16_t* kp = k + (size_t)(tok0 + 16 * wave + fr) * 1024 + h * 256 + 8 * fq;
    u32x4 qv[8]; bf16x8 kf[8];
#pragma unroll
    for (int i = 0; i < 8; ++i) { const int p = tid + 512 * i, row = p >> 5, c16 = p & 31; qv[i] = *(const u32x4*)(q + (size_t)(tok0 + row) * 1024 + h * 256 + c16 * 8); }
#pragma unroll
    for (int ks = 0; ks < 8; ++ks) kf[ks] = *(const bf16x8*)(kp + 32 * ks);
#pragma unroll
    for (int i = 0; i < 8; ++i) { const int p = tid + 512 * i, row = p >> 5, c16 = p & 31; *(LAS u32x4*)(ql + row * RQ_LD + c16 * 8) = qv[i]; }
    __syncthreads();
    {
        const int tj = wave;
#pragma unroll
        for (int ti = 0; ti < 8; ++ti) {
            if (ti >= tj) {
                f32x4 s2 = (f32x4){0.f, 0.f, 0.f, 0.f};
#pragma unroll
                for (int ks = 0; ks < 8; ++ks) { const bf16x8 qf = *(const LAS bf16x8*)(ql + (16 * ti + fr) * RQ_LD + 32 * ks + 8 * fq); s2 = mfma16(kf[ks], qf, s2); }
                const int i = 16 * ti + fr; f32x4 v;
#pragma unroll
                for (int r = 0; r < 4; ++r) { const int j = 16 * tj + 4 * fq + r; v[r] = (i >= j) ? s2[r] * __builtin_amdgcn_exp2f(lg2 * (float)(i - j)) : 0.f; }
                *(LAS u32x2*)(sc + (16 * ti + fr) * SC_LD + 16 * tj + 4 * fq) = pack4(v);
            } else if (ti == tj - 1 && (tj & 1)) {
                u32x2 z = (u32x2){0u, 0u}; asm volatile("" : "+v"(z));
                *(LAS u32x2*)(sc + (16 * ti + fr) * SC_LD + 16 * tj + 4 * fq) = z;
            }
        }
    }
    __syncthreads();
#pragma unroll 1
    for (int eh = 0; eh < 2; ++eh) {
    const bf16_t* vp = vt + (size_t)(h * 512 + 256 * eh + 32 * wave + fr) * SEQ + tok0 + 8 * fq;
    bf16x8 sfa[8][2], vfa[4][2];
#pragma unroll
    for (int ks = 0; ks < 8; ++ks)
#pragma unroll
        for (int t = 0; t < 2; ++t) sfa[ks][t] = *(const bf16x8*)(sp + (size_t)(256 * eh + 16 * t) * 256 + 32 * ks);
    f32x4 acc[8][2];
#pragma unroll
    for (int a = 0; a < 8; ++a)
#pragma unroll
        for (int b = 0; b < 2; ++b) acc[a][b] = (f32x4){0.f, 0.f, 0.f, 0.f};
    {
#pragma unroll
        for (int ks = 0; ks < 8; ++ks) {
            bf16x8 qf[8];
            if (ks == 4) {
#pragma unroll
                for (int k2 = 0; k2 < 4; ++k2)
#pragma unroll
                    for (int t = 0; t < 2; ++t) vfa[k2][t] = *(const bf16x8*)(vp + (size_t)(16 * t) * SEQ + 32 * k2);
            }
#pragma unroll
            for (int t = 0; t < 8; ++t) qf[t] = *(const LAS bf16x8*)(ql + (16 * t + fr) * RQ_LD + 32 * ks + 8 * fq);
            __builtin_amdgcn_sched_barrier(0);
#pragma unroll
            for (int a = 0; a < 8; ++a)
#pragma unroll
                for (int b = 0; b < 2; ++b) acc[a][b] = mfma16(sfa[ks][b], qf[a], acc[a][b]);
            __builtin_amdgcn_sched_barrier(0);
        }
    }
#pragma unroll
    for (int a = 0; a < 8; ++a) { const float qd = __builtin_amdgcn_exp2f(lg2 * (float)(16 * a + fr + 1));
#pragma unroll
        for (int b = 0; b < 2; ++b) acc[a][b] = acc[a][b] * qd; }
#pragma unroll
    for (int ks = 0; ks < 4; ++ks) {
        bf16x8 pf[8];
#pragma unroll
        for (int a = 0; a < 8; ++a) if (a >= 2 * ks) pf[a] = *(const LAS bf16x8*)(sc + (16 * a + fr) * SC_LD + 32 * ks + 8 * fq);
        __builtin_amdgcn_sched_barrier(0);
#pragma unroll
        for (int a = 0; a < 8; ++a) {
            if (a >= 2 * ks) {
#pragma unroll
                for (int b = 0; b < 2; ++b) acc[a][b] = mfma16(vfa[ks][b], pf[a], acc[a][b]);
            }
        }
        __builtin_amdgcn_sched_barrier(0);
    }
#pragma unroll
    for (int a = 0; a < 8; ++a) {
        float ss = 0.f;
#pragma unroll
        for (int b = 0; b < 2; ++b) { const f32x4 t = acc[a][b]; ss += (t[0] * t[0] + t[1] * t[1]) + (t[2] * t[2] + t[3] * t[3]); }
        ss += __shfl_xor(ss, 16); ss += __shfl_xor(ss, 32);
        if (fq == 0) part[wave * 128 + 16 * a + fr] = ss;
    }
    __syncthreads();
    if (tid < 128) {
        float tot = 0.f;
#pragma unroll
        for (int w = 0; w < 8; ++w) tot += part[w * 128 + tid];
        rssq[(size_t)(tok0 + tid) * 8 + 2 * h + eh] = tot;
    }
    const int scol = ((fq & 1) ? 16 : 0) + (fq >> 1) * 8;
#pragma unroll
    for (int a = 0; a < 8; ++a) {
        u32x2 pa = pack4(acc[a][0]), pb = pack4(acc[a][1]);
        { auto r0 = __builtin_amdgcn_permlane16_swap(pa.x, pb.x, false, false); pa.x = r0[0]; pb.x = r0[1]; }
        { auto r1 = __builtin_amdgcn_permlane16_swap(pa.y, pb.y, false, false); pa.y = r1[0]; pb.y = r1[1]; }
        *(u32x4*)(ret + (size_t)(tok0 + 16 * a + fr) * 2048 + h * 512 + 256 * eh + 32 * wave + scol) = (u32x4){pa.x, pa.y, pb.x, pb.y};
    }
    __syncthreads();
    }
}
constexpr int PL_LD = 264, MA_KV_BYTES = 64 * 264 * 2, MA_P_OFF = MA_KV_BYTES;
__device__ __forceinline__ void memattn_unit(int b, int h, int rb, const bf16_t* mkn, const bf16_t* mvt, bf16_t* mo  , LAS unsigned char* lds) {
    const bf16_t* mq = mo;
    const int tid = opaque_tid(), lane = tid & 63, wave = __builtin_amdgcn_readfirstlane(tid >> 6);
    const int fr = lane & 15, fq = lane >> 4;
    LAS bf16_t* kv = (LAS bf16_t*)lds; LAS bf16_t* pl = (LAS bf16_t*)(lds + MA_P_OFF) + wave * (16 * PL_LD);
    const int row = 128 * rb + 16 * wave + fr;
    const bf16_t* ksrc = mkn + (size_t)(b * 256) * 1024 + h * 256;
    const bf16_t* vsrc = mvt + (size_t)((b * 4 + h) * 256) * 256;
    u32x4 pre[4];
#pragma unroll
    for (int i = 0; i < 4; ++i) { const int p = tid + 512 * i; pre[i] = *(const u32x4*)(ksrc + (size_t)(p >> 5) * 1024 + (p & 31) * 8); }
    bf16x8 qf[8]; float qs = 0.f;
#pragma unroll
    for (int ks = 0; ks < 8; ++ks) { qf[ks] = *(const bf16x8*)(mq + (size_t)row * 1024 + h * 256 + 32 * ks + 8 * fq);
#pragma unroll
        for (int j = 0; j < 8; ++j) { const float f = bf2f((unsigned short)qf[ks][j]); qs += f * f; } }
    qs += __shfl_xor(qs, 16); qs += __shfl_xor(qs, 32);
    const float scl = __builtin_amdgcn_rsqf(qs * (1.0f / 256.0f) + EPS) * (0.0625f * LOG2E);
    f32x4 sa[16];
#pragma unroll
    for (int kc = 0; kc < 4; ++kc) {
        __syncthreads();
#pragma unroll
        for (int i = 0; i < 4; ++i) { const int p = tid + 512 * i; *(LAS u32x4*)(kv + (p >> 5) * PL_LD + (p & 31) * 8) = pre[i]; }
        __syncthreads();
#pragma unroll
        for (int i = 0; i < 4; ++i) { const int p = tid + 512 * i;
            pre[i] = (kc < 3) ? *(const u32x4*)(ksrc + (size_t)(64 * (kc + 1) + (p >> 5)) * 1024 + (p & 31) * 8) : *(const u32x4*)(vsrc + (size_t)(p >> 5) * 256 + (p & 31) * 8); }
#pragma unroll
        for (int tl = 0; tl < 4; ++tl) {
            f32x4 a = (f32x4){0.f, 0.f, 0.f, 0.f};
#pragma unroll
            for (int ks = 0; ks < 8; ++ks) { const bf16x8 kf = *(const LAS bf16x8*)(kv + (16 * tl + fr) * PL_LD + 32 * ks + 8 * fq); a = mfma16(kf, qf[ks], a); }
            sa[4 * kc + tl] = a * scl;
        }
    }
    float mx = -INFINITY;
#pragma unroll
    for (int t = 0; t < 16; ++t) mx = fmaxf(mx, fmaxf(fmaxf(sa[t][0], sa[t][1]), fmaxf(sa[t][2], sa[t][3])));
    mx = fmaxf(mx, __shfl_xor(mx, 16)); mx = fmaxf(mx, __shfl_xor(mx, 32));
    float l = 0.f;
#pragma unroll
    for (int t = 0; t < 16; ++t) {
        f32x4 p;
#pragma unroll
        for (int r = 0; r < 4; ++r) { p[r] = __builtin_amdgcn_exp2f(sa[t][r] - mx); l += p[r]; }
        *(LAS u32x2*)(pl + fr * PL_LD + 16 * t + 4 * fq) = pack4(p);
    }
    l += __shfl_xor(l, 16); l += __shfl_xor(l, 32);
    const float rl = __builtin_amdgcn_rcpf(l);
    LDS_WAIT(); asm volatile("" ::: "memory");
    bf16x8 pf[8];
#pragma unroll
    for (int ks = 0; ks < 8; ++ks) pf[ks] = *(const LAS bf16x8*)(pl + fr * PL_LD + 32 * ks + 8 * fq);
#pragma unroll
    for (int dc = 0; dc < 4; ++dc) {
        __syncthreads();
#pragma unroll
        for (int i = 0; i < 4; ++i) { const int p = tid + 512 * i; *(LAS u32x4*)(kv + (p >> 5) * PL_LD + (p & 31) * 8) = pre[i]; }
        __syncthreads();
        if (dc < 3) {
#pragma unroll
            for (int i = 0; i < 4; ++i) { const int p = tid + 512 * i; pre[i] = *(const u32x4*)(vsrc + (size_t)(64 * (dc + 1) + (p >> 5)) * 256 + (p & 31) * 8); }
        }
#pragma unroll
        for (int tp = 0; tp < 2; ++tp) {
            u32x2 pp[2];
#pragma unroll
            for (int t2 = 0; t2 < 2; ++t2) { const int tl = 2 * tp + t2;
                f32x4 a = (f32x4){0.f, 0.f, 0.f, 0.f};
#pragma unroll
                for (int ks = 0; ks < 8; ++ks) { const bf16x8 vf = *(const LAS bf16x8*)(kv + (16 * tl + fr) * PL_LD + 32 * ks + 8 * fq); a = mfma16(vf, pf[ks], a); }
                pp[t2] = pack4(a * rl); }
            { auto r0 = __builtin_amdgcn_permlane16_swap(pp[0].x, pp[1].x, false, false); pp[0].x = r0[0]; pp[1].x = r0[1]; }
            { auto r1 = __builtin_amdgcn_permlane16_swap(pp[0].y, pp[1].y, false, false); pp[0].y = r1[0]; pp[1].y = r1[1]; }
            *(u32x4*)(mo + (size_t)row * 1024 + h * 256 + 64 * dc + 32 * tp + ((fq & 1) ? 16 : 0) + (fq >> 1) * 8) = (u32x4){pp[0].x, pp[0].y, pp[1].x, pp[1].y};
        }
    }
    __syncthreads();
}
__device__ __forceinline__ void dif_row(const bf16_t* o0, const bf16_t* o1, bf16_t* dif, const float* gout, float lam, int lane) {
    const u32x4* a = (const u32x4*)o0 + 2 * lane; const u32x4* b = (const u32x4*)o1 + 2 * lane;
    float d[16]; float ss = 0.f;
#pragma unroll
    for (int v = 0; v < 2; ++v) { const u32x4 x = __builtin_nontemporal_load(a + v), y = __builtin_nontemporal_load(b + v);
#pragma unroll
        for (int w = 0; w < 4; ++w) { const float x0 = __uint_as_float(x[w] << 16), x1 = __uint_as_float(x[w] & 0xffff0000u), y0 = __uint_as_float(y[w] << 16), y1 = __uint_as_float(y[w] & 0xffff0000u);
            const float d0 = x0 - lam * y0, d1 = x1 - lam * y1; d[v * 8 + w * 2] = d0; d[v * 8 + w * 2 + 1] = d1; ss += d0 * d0 + d1 * d1; } }
    ss += __shfl_xor(ss, 1); ss += __shfl_xor(ss, 2); ss += __shfl_xor(ss, 4);
    const float rn = __builtin_amdgcn_rsqf(ss * (1.0f / 128.0f) + EPS) * (1.0f - LAM_INIT);
    const float* gp = gout + (lane & 7) * 16;
    u32x4 o[2];
#pragma unroll
    for (int v = 0; v < 2; ++v)
#pragma unroll
        for (int w = 0; w < 4; ++w) o[v][w] = cvt_pk_bf16(d[v * 8 + w * 2] * rn * gp[v * 8 + w * 2], d[v * 8 + w * 2 + 1] * rn * gp[v * 8 + w * 2 + 1]);
    u32x4* op = (u32x4*)dif + 2 * lane; op[0] = o[0]; op[1] = o[1];
}

struct P4bOrder {
    pg8::StaticOrder T; unsigned char* ws; const char* xa;
    __device__ __forceinline__ bool next(int i, pg8::Unit& u) const {
        int pm, pn; if (!T.tile(i, pm, pn)) return false;
        u.pm = pm; u.pn = pn; u.ui = i; u.ri = i; u.tag = 0; u.K = 1024;
        u.A = xa + (size_t)pm * 256 * 1024 * 2;
        u.Bt = (const char*)ws + (pn < 8 ? WS_WRG + (size_t)pn * 256 * 1024 * 2 : WS_WGATE + (size_t)(pn - 8) * 256 * 1024 * 2); return true;
    }
};
struct GateOrder8 {
    pg8::StaticOrder T; const char* xa;
    __device__ __forceinline__ bool next(int i, pg8::Unit& u) const {
        int pm, pn; if (!T.tile(i, pm, pn)) return false;
        u.pm = pm; u.pn = 8 + pn; u.ui = i; u.ri = i + 2; u.tag = 0; u.K = 512;
        u.A = xa + DO_X8 + (size_t)pm * 256 * 1024; u.Bt = xa + DO_WG8 + (size_t)pn * 256 * 1024; return true;
    }
};
struct P5Order {
    pg8::StaticOrder T; unsigned char* ws;
    __device__ __forceinline__ bool next(int i, pg8::Unit& u) const {
        const int ti = i / 3, kbr = i - 3 * ti; int pm, pn; if (!T.tile(ti, pm, pn)) return false;
        const size_t offA = kbr == 0 ? WS_RET : kbr == 1 ? WS_DIF : WS_MO;
        const size_t offB = kbr == 0 ? WS_WBRR : kbr == 1 ? WS_WBRD : WS_WBRM;
        const int K = kbr == 0 ? 2048 : 1024;
        u.pm = pm; u.pn = pn; u.ui = i; u.ri = ti; u.tag = kbr; u.K = K;
        u.A = (const char*)ws + offA + (size_t)pm * 256 * K * 2; u.Bt = (const char*)ws + offB + (size_t)pn * 256 * K * 2; return true;
    }
};
#ifndef PH_MASK
#define PH_MASK 0xffffffffu
#endif
#define PH(n) ((PH_MASK >> (n)) & 1u)
#ifndef DUP_MASK
#define DUP_MASK 0u
#endif
#ifndef PROBE_K
#define PROBE_K (-1)
#endif
#define RUNP(k) (pass_ == 1 || (k) <= PROBE_K)
#define REPQ(n) _Pragma("unroll 1") for (int rq_ = 0; rq_ < 1 + (int)((DUP_MASK >> (n)) & 1u); ++rq_)
#define REP(n) _Pragma("unroll 1") for (int rep_ = 0; rep_ < 1 + (int)((DUP_MASK >> (n)) & 1u); ++rep_)
struct Args { const void* in[26]; float* out; unsigned char* ws; };
#define CAS __attribute__((address_space(4)))
__device__ __forceinline__ const void* karg(int i) { typedef const GAS void* gptr; const CAS gptr* p = (const CAS gptr*)__builtin_amdgcn_kernarg_segment_ptr(); asm volatile("" : "+s"(p)); return (const void*)p[i]; }
#define INP(i) ((const float*)karg(i))
#define WSP(T, off) ((T*)((unsigned char*)karg(27) + (off)))
#define OUTP ((float*)karg(26))
struct SplitWait {
    unsigned target;
    __device__ __forceinline__ void wait() const { if (target) xcd_split_wait((unsigned*)WSP(unsigned, WS_CTL) + CW_BAR2, (unsigned*)WSP(unsigned, WS_CTL) + CW_BAR, target); }
};
__global__ void __launch_bounds__(NWAVES * 64, 2) mk_fwd(Args args) {
    extern __shared__ __attribute__((aligned(16))) unsigned char lds_raw[];
    LAS unsigned char* lds = (LAS unsigned char*)lds_raw;
    volatile LAS unsigned* MISC = (volatile LAS unsigned*)(lds + MISC_OFF);
    const int G = gridDim.x, bx = blockIdx.x;
    for (int u = threadIdx.x; u < (LDS_BYTES - LDSCTL_OFF) / 4; u += NWAVES * 64) ((LAS unsigned*)(lds + LDSCTL_OFF))[u] = 0u;
    __syncthreads();
    (void)xcd_barrier_post((unsigned*)WSP(unsigned, WS_CTL) + CW_BAR, MISC + 8);
#define GRID_BAR() do { XcdBarrier b_; b_.bar = (unsigned*)WSP(unsigned, WS_CTL) + CW_BAR; b_.x = xb_xcc_id(); b_.st = (volatile LAS unsigned*)(lds + MISC_OFF) + 8; xcd_barrier(b_); } while (0)
#define SPLIT_ARRIVE() do { xcd_split_arrive((unsigned*)WSP(unsigned, WS_CTL) + CW_BAR2, (unsigned*)WSP(unsigned, WS_CTL) + CW_BAR, (volatile LAS unsigned*)(lds + MISC_OFF) + 8); ++sgen; } while (0)
    unsigned sgen = 0;
    const int NGW = G * NWAVES, NGT = G * NWAVES * 64;
#define LANE_VARS() const int tid = opaque_tid(), lane = tid & 63, wave = __builtin_amdgcn_readfirstlane(tid >> 6); LAS float* scr = (LAS float*)(lds + wave * 16384); \
    const int gw = bx * NWAVES + wave, gt = bx * (NWAVES * 64) + tid; (void)scr; (void)gw; (void)gt; (void)lane

#pragma unroll 1
    for (int pass_ = (PROBE_K >= 0 ? 0 : 1); pass_ < 2; ++pass_) {
    if (RUNP(0)) {
    REP(0) if (PH(0)) {
        LANE_VARS();
        transpose_all<true>(INP(4), 1024, 2 * DFF, WSP(bf16_t, WS_WF1I), 2 * DFF, ColSwiglu{}, nullptr, scr, gw, NGW, lane);
        transpose_all(INP(18), 1024, 2048, WSP(bf16_t, WS_WMKV), 2048, ColIdent{0}, nullptr, scr, gw, NGW, lane);
        { const float* x = INP(0); const float* g1 = INP(3); bf16_t* xb = WSP(bf16_t, WS_XBL);
          rms_rows_to_bf16(x, g1, xb, gw, NGW, TOK, lane); }
        { const float* mem = INP(1); const float* gm = INP(17); bf16_t* memn = WSP(bf16_t, WS_MEMN);
          rms_rows_to_bf16(mem, gm, memn, gw, NGW, NB * MEML, lane); }
        rot_table((const int*)karg(2), WSP(float, WS_ROT), gt, NGT);
    }
    GRID_BAR();
    }

    if (RUNP(1)) {
    REP(1) if (PH(1)) {
        pg8::Gemm g{WSP(bf16_t, WS_XBL), WSP(bf16_t, WS_WF1I), TOK, 2 * DFF, 1024}; pg8::StaticOrder S; S.init(TOK, 2 * DFF, G, bx);
        EpiSwiglu E{WSP(bf16_t, WS_ACT), nullptr};
        S.set(g); pg8::gemm_phase(lds, S, E);
    }
    if (PH(2)) {
        pg8::Gemm g{WSP(bf16_t, WS_MEMN), WSP(bf16_t, WS_WMKV), NB * MEML, 2048, 1024}; pg8::StaticOrder S; S.init(NB * MEML, 2048, G, (bx + G / 2) % G);
        EpiPlain E{WSP(bf16_t, WS_MKVRAW), 2048};
        S.set(g); pg8::gemm_phase(lds, S, E);
    }
    if (PH(0)) {
        const int q0 = (3 * G) / 4, nq = G - q0;
        if (bx >= q0) {
            LANE_VARS();
            const int gw2 = (bx - q0) * NWAVES + wave, ngw2 = nq * NWAVES;
            transpose_all(INP(5), DFF, 1024, WSP(bf16_t, WS_WF1O), 1024, ColIdent{0}, nullptr, scr, gw2, ngw2, lane);
            transpose_all<true>(INP(7), 1024, 13312, WSP(bf16_t, WS_WMIX), NMIX, ColMix{}, INP(6), scr, gw2, ngw2, lane);
        }
    }
    GRID_BAR();
    }

    if (RUNP(2)) {
    REP(3) if (PH(3)) {
        pg8::Gemm g{WSP(bf16_t, WS_ACT), WSP(bf16_t, WS_WF1O), TOK, 1024, DFF}; pg8::StaticOrder S; S.init(TOK, 1024, G, bx);
        EpiResid<false, false, true> E{INP(0), (float*)((unsigned char*)OUTP + DO_X8), (bf16_t*)OUTP, WSP(float, WS_SSQ1), 0.5f, (rep_ == 1 && ((DUP_MASK >> 23) & 1u)) ? 1 : 0};
        S.set(g); pg8::gemm_phase(lds, S, E);
    }
    SPLIT_ARRIVE();
    if (PH(0)) {
        LANE_VARS();
        const bf16_t* mkvraw = WSP(bf16_t, WS_MKVRAW); bf16_t* mkn = WSP(bf16_t, WS_MKN); bf16_t* mvt = WSP(bf16_t, WS_MVT);
        const float* g_mem_k = INP(16); const float* g_mem_q = INP(15);
        for (int j = gw; j < NB * MEML * 4; j += NGW) {
            const int row = j >> 2, h = j & 3;
            const u32x2 w = *((const u32x2*)(mkvraw + (size_t)row * 2048 + h * 256) + lane);
            f32x4 v = (f32x4){__uint_as_float(w.x << 16), __uint_as_float(w.x & 0xffff0000u), __uint_as_float(w.y << 16), __uint_as_float(w.y & 0xffff0000u)};
            const float ss = wave_sum((v[0] * v[0] + v[1] * v[1]) + (v[2] * v[2] + v[3] * v[3]));
            const float rn = __builtin_amdgcn_rsqf(ss * (1.0f / 256.0f) + EPS);
            const f32x4 gk = *((const f32x4*)g_mem_k + lane), gq = *((const f32x4*)g_mem_q + lane);
            *((u32x2*)(mkn + (size_t)row * 1024 + h * 256) + lane) = pack4(v * rn * gk * gq);
        }
        for (int idx = gt; idx < NB * 4 * 256 * 256; idx += NGT) {
            const int key = idx & 255, d = (idx >> 8) & 255, bh = idx >> 16, b = bh >> 2, h = bh & 3;
            mvt[idx] = mkvraw[(size_t)(b * 256 + key) * 2048 + 1024 + h * 256 + d];
        }
    }
    { SplitWait H{sgen}; H.wait(); }
    }

    if (RUNP(3))
    for (int ph = 0; ph <= NB; ++ph) {
        const int gp = ph, gm = ph - 1;
        unsigned char* const wsP = WSP(unsigned char, 0) - (((gp + 1) & 1) ? SET_DELTA : 0);
        unsigned char* const wsB = WSP(unsigned char, 0) - (((gm + 1) & 1) ? SET_DELTA : 0);
        unsigned* done = (unsigned*)WSP(unsigned, WS_CTL) + CW_SCAN + ((pass_ * NB + (gm < 0 ? 0 : gm)) * 8) * 64; unsigned* tmo = (unsigned*)WSP(unsigned, WS_CTL) + CW_BAR + XB_TMO;
        const bool early = (gm >= 0 && bx < 64) || gp >= NB;
        if (early) { SplitWait H{sgen}; H.wait(); }
        if (gm >= 0)
            for (int u = bx; u < 64; u += G) REPQ(26) { __syncthreads(); if (PH(5)) scan_unit(u, (const bf16_t*)(wsB + WS_KTS), (const bf16_t*)(wsB + WS_VT), WSP(bf16_t, WS_S), lds, done); }
        if (gp < NB) {
            REP(4) if (PH(4)) {
                pg8::Gemm g{(const bf16_t*)OUTP + (size_t)gp * SEQ * DM, WSP(bf16_t, WS_WMIX), SEQ, NMIX, 1024}; pg8::StaticOrder S; S.init(SEQ, NMIX, G, bx);
                prep_rs(WSP(float, WS_SSQ1), gp * SEQ, S, lds);
                EpiMix E{(const LAS float*)(lds + RTAB_OFF), WSP(float, (gp & 1) ? WS_ROTB : WS_ROT), wsP, WSP(bf16_t, WS_MO) + (size_t)gp * SEQ * 1024, INP(8), INP(9)};
                SplitWait H{early ? 0u : sgen};
                S.set(g); pg8::gemm_phase(lds, S, E, H);
                if (bx >= (SEQ / 256) * (NMIX / 256)) H.wait();
            }
        }
        if (gm >= 0) {
            const size_t oOff = (gm & 1) ? WS_OB : 0;
            unsigned* qctr = (unsigned*)WSP(unsigned, WS_CTL) + CW_QUEUE + (pass_ * NB + gm) * 64;
            volatile LAS unsigned* qslot = (volatile LAS unsigned*)(lds + MISC_OFF) + 16;
            for (;;) {
                __syncthreads();
                if (threadIdx.x == 0) qslot[0] = __hip_atomic_fetch_add(qctr, 1u, __ATOMIC_RELAXED, __HIP_MEMORY_SCOPE_AGENT);
                __syncthreads();
                const int id = __builtin_amdgcn_readfirstlane((int)qslot[0]);
                if (id >= 384) break;
                if (id >= 256) {
                    LANE_VARS();
                    if (id < 320) { if (ph >= 2) {
                        const int gd = ph - 2; const size_t oD = (gd & 1) ? WS_OB : 0;
                        const float s1 = wave_sum(INP(10)[lane] * INP(11)[lane]), s2 = wave_sum(INP(12)[lane] * INP(13)[lane]); const float lam = __expf(s1) - __expf(s2) + LAM_INIT;
                        const bf16_t* bo0 = WSP(bf16_t, WS_O0 + oD); const bf16_t* bo1 = WSP(bf16_t, WS_O1 + oD); bf16_t* difb = WSP(bf16_t, WS_DIF); const float* gdo = INP(14);
                        for (int k = 0; k < 4; ++k) { const int r = (id - 256) * 32 + wave * 4 + k; dif_row(bo0 + (size_t)r * 1024, bo1 + (size_t)r * 1024, difb + ((size_t)gd * SEQ + r) * 1024, gdo, lam, lane); } } }
                    else if (ph + 1 < NB) rot_table((const int*)karg(2) + (ph + 1) * SEQ, WSP(float, ((ph + 1) & 1) ? WS_ROTB : WS_ROT), tid, NWAVES * 64, (id - 320) * 4096, (id - 319) * 4096);
                    continue;
                }
                int aq = -1, aj = 0;
                if (id < 96) { aq = 7 - (id >> 4); aj = id & 15; }
                else if (id >= 192) { const int ro = id - 192;
                    if (PH(8)) REPQ(24) { __syncthreads(); retout_unit(ro >> 4, ro & 15, (const bf16_t*)(wsB + WS_Q), (const bf16_t*)(wsB + WS_K), (const bf16_t*)(wsB + WS_VT), WSP(bf16_t, WS_S),
                                           WSP(bf16_t, WS_RET) + (size_t)gm * SEQ * 2048, WSP(float, WS_SSQ2) + (size_t)gm * SEQ * 8, lds, done, tmo); } }
                else if (id < 160) { const int m = id - 96;
                    if (PH(7)) memattn_unit(gm, m >> 4, m & 15, WSP(bf16_t, WS_MKN), WSP(bf16_t, WS_MVT), WSP(bf16_t, WS_MO) + (size_t)gm * SEQ * 1024, lds); }
                else { aq = 1 - ((id - 160) >> 4); aj = (id - 160) & 15; }
                if (aq >= 0) {
                    const int hc = aj, hh = hc >> 1, cc = hc & 1;
                    if (PH(6)) REPQ(25) attn_body::attn_unit<8>(hc, hh, aq, (const attn_body::bf16*)(wsB + WS_DQ), (const attn_body::bf16*)(wsB + WS_DK), (const attn_body::bf16*)(wsB + WS_DV),
                                            WSP(attn_body::bf16, (cc ? WS_O1 : WS_O0) + oOff), (char*)lds_raw);
                }
            }
        }
        {
            LANE_VARS();
            if (ph == 0) rot_table((const int*)karg(2) + (ph + 1) * SEQ, WSP(float, ((ph + 1) & 1) ? WS_ROTB : WS_ROT), gt, NGT);
            if (ph == 0) transpose_all<true>(INP(7), 1024, 13312, WSP(bf16_t, WS_WRG), 2048, ColIdent{4096}, INP(6), scr, gw, NGW, lane);
            if (ph == 0) transpose_all_f8<true>(INP(7), 1024, 13312, (unsigned char*)OUTP + DO_WG8, 3072, ColIdent{10240}, INP(6), 64.0f, scr, gw, NGW, lane);
        }
        SPLIT_ARRIVE();
    }

    if (RUNP(4)) {
    if (PH(9)) {
        SplitWait H{sgen};
        {
            pg8::StaticOrder T; T.init(TOK, 2048, G, bx);
            { pg8::StaticOrder T2; T2.init(TOK, 3072, G, bx); prep_rs(WSP(float, WS_SSQ1), 0, T2, lds, 2, 3); }
            prep_rs(WSP(float, WS_SSQ1), 0, T, lds, 0, 2);
            P4bOrder S{T, WSP(unsigned char, 0), (const char*)OUTP};
            EpiRgG E{(const LAS float*)(lds + RTAB_OFF), WSP(bf16_t, WS_RET), WSP(float, WS_SSQ2), WSP(unsigned char, 0)};
            pg8::gemm_phase(lds, S, E, H);
            if (bx >= (TOK / 256) * (2048 / 256)) H.wait();
        }
        __syncthreads();
        {
            pg8::StaticOrder T; T.init(TOK, 3072, G, bx);
            GateOrder8 S{T, (const char*)OUTP};
            EpiRgG E{(const LAS float*)(lds + RTAB_OFF), WSP(bf16_t, WS_RET), WSP(float, WS_SSQ2), WSP(unsigned char, 0)};
            pg8::gemm_phase<EpiRgG, GateOrder8, pg8::NoHook, true>(lds, S, E);
        }
    }
    if (PH(0)) {
        LANE_VARS();
        { const float s1 = wave_sum(INP(10)[lane] * INP(11)[lane]), s2 = wave_sum(INP(12)[lane] * INP(13)[lane]); const float lam = __expf(s1) - __expf(s2) + LAM_INIT;
          const bf16_t* bo0 = WSP(bf16_t, WS_O0 + (((NB - 1) & 1) ? WS_OB : 0)); const bf16_t* bo1 = WSP(bf16_t, WS_O1 + (((NB - 1) & 1) ? WS_OB : 0)); bf16_t* difb = WSP(bf16_t, WS_DIF); const float* gdo = INP(14);
          for (int r = gw; r < SEQ; r += NGW) dif_row(bo0 + (size_t)r * 1024, bo1 + (size_t)r * 1024, difb + ((size_t)(NB - 1) * SEQ + r) * 1024, gdo, lam, lane); }
        transpose_all<true>(INP(19), 2048, 1024, WSP(bf16_t, WS_WBRR), 1024, ColIdent{0}, nullptr, scr, gw, NGW, lane);
        transpose_all<true>(INP(20), 1024, 1024, WSP(bf16_t, WS_WBRD), 1024, ColIdent{0}, nullptr, scr, gw, NGW, lane);
        transpose_all<true>(INP(21), 1024, 1024, WSP(bf16_t, WS_WBRM), 1024, ColIdent{0}, nullptr, scr, gw, NGW, lane);
    }
    SPLIT_ARRIVE();
    if (PH(0)) {
        LANE_VARS();
        transpose_all(INP(22), 1024, 1024, WSP(bf16_t, WS_WO), 1024, ColIdent{0}, nullptr, scr, gw, NGW, lane);
        transpose_all<true>(INP(24), 1024, 2 * DFF, WSP(bf16_t, WS_WF2I), DFF, ColSwigluOff{0}, INP(23), scr, gw, NGW, lane);
    }
    { SplitWait H{sgen}; H.wait(); }
    }

    if (RUNP(5)) {
    REP(10) if (PH(10)) {
        pg8::StaticOrder T; T.init(TOK, 1024, G, bx);
        P5Order S{T, WSP(unsigned char, 0)};
        EpiTerm3 E{WSP(unsigned char, 0), WSP(bf16_t, WS_Y)};
        pg8::gemm_phase(lds, S, E);
    }
    SPLIT_ARRIVE();
    if (PH(0)) {
        LANE_VARS();
        transpose_all<true>(INP(24), 1024, 2 * DFF, WSP(bf16_t, WS_WF2I) + (size_t)DFF * 1024, DFF, ColSwigluOff{DFF}, INP(23), scr, gw, NGW, lane);
    }
    { SplitWait H{sgen}; H.wait(); }
    }

    if (RUNP(6)) {
    if (PH(11)) {
        pg8::Gemm g{WSP(bf16_t, WS_Y), WSP(bf16_t, WS_WO), TOK, 1024, 1024}; pg8::StaticOrder S; S.init(TOK, 1024, G, bx);
        EpiResid<true, false> E{OUTP, nullptr, WSP(bf16_t, WS_X2B), WSP(float, WS_SSQ2), 1.0f, 0};
        S.set(g); pg8::gemm_phase(lds, S, E);
    }
    SPLIT_ARRIVE();
    if (PH(0)) {
        LANE_VARS();
        transpose_all(INP(25), DFF, 1024, WSP(bf16_t, WS_WF2O), 1024, ColIdent{0}, nullptr, scr, gw, NGW, lane);
    }
    { SplitWait H{sgen}; H.wait(); }
    }

    if (RUNP(7)) {
    if (PH(12)) {
        pg8::Gemm g{WSP(bf16_t, WS_X2B), WSP(bf16_t, WS_WF2I), TOK, 2 * DFF, 1024}; pg8::StaticOrder S; S.init(TOK, 2 * DFF, G, bx);
        prep_rs(WSP(float, WS_SSQ2), 0, S, lds);
        EpiSwiglu E{WSP(bf16_t, WS_ACT2), (const LAS float*)(lds + RTAB_OFF)};
        S.set(g); pg8::gemm_phase(lds, S, E);
    }
    GRID_BAR();
    }

    if (RUNP(8))
    if (PH(13)) {
        pg8::Gemm g{WSP(bf16_t, WS_ACT2), WSP(bf16_t, WS_WF2O), TOK, 1024, DFF}; pg8::StaticOrder S; S.init(TOK, 1024, G, bx);
        EpiResid<true, true> E{WSP(bf16_t, WS_X2B), OUTP, nullptr, nullptr, 0.5f, 0};
        S.set(g); pg8::gemm_phase(lds, S, E);
    }
    if (pass_ == 0) GRID_BAR();
    }
}

extern "C" void kernel_launch(void* const* d_in, const int* in_sizes, int n_in, void* d_out, int out_size, void* d_ws, size_t ws_size, hipStream_t stream) {
    static int grid = 0;
    if (grid == 0) {
        if (n_in != 26 || ws_size < WS_END) { fprintf(stderr, "kernel_launch: unexpected inputs (n_in %d, ws %zu)\n", n_in, ws_size); grid = -1; return; }
        int dev = 0, cus = 0;
        if (hipGetDevice(&dev) != hipSuccess || hipDeviceGetAttribute(&cus, hipDeviceAttributeMultiprocessorCount, dev) != hipSuccess) { grid = -1; return; }
        if (hipFuncSetAttribute((const void*)mk_fwd, hipFuncAttributeMaxDynamicSharedMemorySize, LDS_BYTES) != hipSuccess) { fprintf(stderr, "kernel_launch: hipFuncSetAttribute failed\n"); grid = -1; return; }
        grid = cus;
    }
    if (grid < 0) return;
    (void)hipMemsetAsync((char*)d_ws + WS_CTL, 0, CTL_ZERO_BYTES, stream);
    Args a{};
    for (int i = 0; i < 26; ++i) a.in[i] = d_in[i];
    a.out = (float*)d_out; a.ws = (unsigned char*)d_ws;
    hipLaunchKernelGGL(mk_fwd, dim3(grid), dim3(NWAVES * 64), LDS_BYTES, stream, a);
}
```
